# Optimizing an MI355X kernel written in HIP

```python
import math
import jax
import jax.numpy as jnp
from jax import lax
import numpy as np

D_MODEL = 1024
BATCH = 4
SEQ = 4096
DEPTH = 2

CTX_LEN = 256
GRID_W = 64
BLOCK = 128
WINDOW = 128
ROPE_BASE = 10000.0
NORM_EPS = 1e-6
NEG_INF = -1e30
F32 = jnp.float32

MIX_W = D_MODEL
RW_HEAD = 64
RW_W = MIX_W // 4
RW_HEADS = RW_W // RW_HEAD
RW_DECAY_LORA = 32
RW_ICLR_LORA = 32
RW_GATE_LORA = 64
RW_GN_EPS = 64e-5
DF_W = MIX_W // 4
DF_HEADS = 4
DF_V = DF_W // DF_HEADS
DF_QK = DF_V // 2
GQ_W = MIX_W - RW_W - DF_W
GQ_HEAD = 64
GQ_HEADS = GQ_W // GQ_HEAD
GQ_KV = 2
GQ_GROUP = GQ_HEADS // GQ_KV
D_FF = ((8 * D_MODEL // 3 + 127) // 128) * 128

IN_SIZES = (RW_W, RW_W, RW_W, RW_GATE_LORA, 2 * RW_DECAY_LORA, 2 * RW_ICLR_LORA,
            DF_HEADS * 2 * DF_QK, DF_HEADS * 2 * DF_QK, DF_W,
            GQ_HEADS * GQ_HEAD, GQ_KV * GQ_HEAD, GQ_KV * GQ_HEAD)
IN_W = sum(IN_SIZES)

kernel_name = 'hybrid_rwkv7_diffattn_swa_prefix_dit'


def rms_norm(x, g):
    xf = x.astype(F32)
    y = xf * lax.rsqrt(jnp.mean(xf * xf, axis=-1, keepdims=True) + NORM_EPS)
    return (y * g.astype(F32)).astype(x.dtype)


def dwconv3(x, w):
    xp = jnp.pad(x, ((0, 0), (1, 1), (0, 0)))
    return xp[:, :-2] * w[0] + xp[:, 1:-1] * w[1] + xp[:, 2:] * w[2]


def split_cols(p):
    cuts, off = [], 0
    for n in IN_SIZES[:-1]:
        off += n
        cuts.append(off)
    return jnp.split(p, cuts, axis=-1)


def axial_rope_tables(rows, dim):
    row = jnp.repeat(jnp.arange(rows, dtype=F32), GRID_W)
    col = jnp.tile(jnp.arange(GRID_W, dtype=F32), rows)
    n_freq = dim // 4
    inv = ROPE_BASE ** (-jnp.arange(n_freq, dtype=F32) / n_freq)
    ang = jnp.stack([row, col], axis=-1)[:, :, None] * inv
    return jnp.cos(ang), jnp.sin(ang)


def apply_axial_rope(x, cos, sin):
    shp = x.shape
    xs = x.astype(F32).reshape(shp[:3] + (2, 2, shp[-1] // 4))
    x1, x2 = xs[..., 0, :], xs[..., 1, :]
    cs, sn = cos[None, :, None], sin[None, :, None]
    out = jnp.stack([x1 * cs - x2 * sn, x2 * cs + x1 * sn], axis=-2)
    return out.reshape(shp).astype(x.dtype)


def rwkv_features(r, k, v, wd, ad, conv_w, w0, w_up, a0, a_up, k_k, k_a):
    B, T, _ = r.shape
    r, k, v = jnp.split(dwconv3(jnp.concatenate([r, k, v], axis=-1), conv_w).astype(F32), 3, axis=-1)
    wl = w0 + jnp.einsum('btdr,drc->btdc', jnp.tanh(wd.reshape(B, T, 2, RW_DECAY_LORA)), w_up)
    decay = jnp.exp(-jnp.exp(-jax.nn.softplus(-wl.astype(F32)) - 0.5))
    a = jax.nn.sigmoid((a0 + jnp.einsum('btdr,drc->btdc', ad.reshape(B, T, 2, RW_ICLR_LORA), a_up)).astype(F32))
    kk = (k * k_k).reshape(B, T, RW_HEADS, RW_HEAD)
    kk = kk / jnp.maximum(jnp.linalg.norm(kk, axis=-1, keepdims=True), 1e-12)
    kd = k[:, :, None] * (1.0 + (a - 1.0) * k_a)
    hd = lambda t: t.reshape(t.shape[:-1] + (RW_HEADS, RW_HEAD))
    return hd(r), hd(decay), hd(kd), hd(v), kk, hd(a)


def rwkv_scan(s0, decay, kd, v, kk, a, r):
    dir_tm = lambda t: jnp.stack([t[:, :, 0], t[:, ::-1, 1]], 0).transpose(2, 0, 1, 3, 4)
    both_tm = lambda t: jnp.stack([t, t[:, ::-1]], 0).transpose(2, 0, 1, 3, 4)
    emit = r is not None

    def step(state, inp):
        w_t, k_t, v_t, kk_t, a_t = inp[:5]
        sk = jnp.einsum('dbhvk,dbhk->dbhv', state, kk_t)
        state = (state * w_t[..., None, :] - sk[..., :, None] * (kk_t * a_t)[..., None, :]
                 + v_t[..., :, None] * k_t[..., None, :])
        out = jnp.einsum('dbhvk,dbhk->dbhv', state, inp[5]) if emit else None
        return state, out

    xs = (dir_tm(decay), dir_tm(kd), both_tm(v), both_tm(kk), dir_tm(a))
    if emit:
        xs = xs + (both_tm(r),)
    s_fin, o = lax.scan(step, s0, xs)
    if not emit:
        return s_fin, None
    return s_fin, (o[:, 0] + o[::-1, 1]).transpose(1, 0, 2, 3)


def rwkv_readout(o, r, kd, v, gd, g_up, r_k, ln_g, ln_b):
    B, T = o.shape[:2]
    mu = jnp.mean(o, axis=-1, keepdims=True)
    var = jnp.mean(jnp.square(o - mu), axis=-1, keepdims=True)
    o = ((o - mu) * lax.rsqrt(var + RW_GN_EPS)).reshape(B, T, RW_W) * ln_g + ln_b
    bonus = jnp.einsum('bthn,btdhn,hn->bth', r, kd, r_k.astype(F32))[..., None] * v
    g = jax.nn.sigmoid(gd) @ g_up
    return (o + bonus.reshape(B, T, RW_W)) * g


def diff_core(q, k, v, lam):
    s = jnp.einsum('bqhmd,bkhmd->bhmqk', q, k, preferred_element_type=F32) * (DF_QK ** -0.5)
    p = jax.nn.softmax(s, axis=-1)
    p = p[:, :, 0] - lam * p[:, :, 1]
    return jnp.einsum('bhqk,bkhd->bqhd', p.astype(v.dtype), v)


def diff_attention(q, k, v, qc, kc, vc, cos, sin, lam_vecs, norm_g, lam_init, emit_ctx):
    B, S, _ = q.shape
    nb = S // BLOCK
    qk_shape = lambda t: t.reshape(t.shape[:2] + (DF_HEADS, 2, DF_QK))
    v_shape = lambda t: t.reshape(t.shape[:2] + (DF_HEADS, DF_V))
    rope = lambda t: apply_axial_rope(t.reshape(B, S, DF_HEADS * 2, DF_QK), cos, sin).reshape(B, S, DF_HEADS, 2, DF_QK)
    lv = lam_vecs.astype(F32)
    lam = jnp.exp(jnp.sum(lv[0] * lv[1])) - jnp.exp(jnp.sum(lv[2] * lv[3])) + lam_init
    kc, vc = qk_shape(kc), v_shape(vc)
    k_all = jnp.concatenate([kc, rope(k)], axis=1)
    v_all = jnp.concatenate([vc, v_shape(v)], axis=1)
    q_blocks = rope(q).reshape(B, nb, BLOCK, DF_HEADS, 2, DF_QK).swapaxes(0, 1)
    o = lax.map(lambda qb: diff_core(qb, k_all, v_all, lam), q_blocks)
    o = o.swapaxes(0, 1).reshape(B, S, DF_HEADS, DF_V)
    head_out = lambda t: (rms_norm(t, norm_g) * (1.0 - lam_init)).reshape(t.shape[:2] + (DF_W,))
    oc = head_out(diff_core(qk_shape(qc), kc, vc, lam)) if emit_ctx else None
    return head_out(o), oc


def band_blocks(t, nb):
    tb = t.reshape((t.shape[0], nb, BLOCK) + t.shape[2:])
    tp = jnp.pad(tb, ((0, 0), (1, 1), (0, 0), (0, 0), (0, 0)))
    return jnp.concatenate([tp[:, :-2], tp[:, 1:-1], tp[:, 2:]], axis=2)


def window_gqa(q, k, v, qc, kc, vc, cos, sin, sink, emit_ctx):
    B, S, _ = q.shape
    C = kc.shape[1]
    nb = S // BLOCK
    scale = GQ_HEAD ** -0.5
    q = apply_axial_rope(q.reshape(B, S, GQ_HEADS, GQ_HEAD), cos, sin).reshape(B, nb, BLOCK, GQ_KV, GQ_GROUP, GQ_HEAD)
    k = apply_axial_rope(k.reshape(B, S, GQ_KV, GQ_HEAD), cos, sin)
    v = v.reshape(B, S, GQ_KV, GQ_HEAD)
    kc = kc.reshape(B, C, GQ_KV, GQ_HEAD)
    vc = vc.reshape(B, C, GQ_KV, GQ_HEAD)
    sink_l = sink.reshape(GQ_KV, GQ_GROUP)[..., None, None].astype(F32)
    kw, vw = band_blocks(k, nb), band_blocks(v, nb)
    s_loc = jnp.einsum('bnqkgd,bnskd->bnkgqs', q, kw, preferred_element_type=F32) * scale
    blk = jnp.arange(nb)[:, None, None]
    qpos = blk * BLOCK + jnp.arange(BLOCK)[None, :, None]
    kpos = (blk - 1) * BLOCK + jnp.arange(3 * BLOCK)[None, None, :]
    mask = (jnp.abs(kpos - qpos) <= WINDOW) & (kpos >= 0) & (kpos < S)
    s_loc = jnp.where(mask[None, :, None, None], s_loc, NEG_INF)
    s_ctx = jnp.einsum('bnqkgd,bckd->bnkgqc', q, kc, preferred_element_type=F32) * scale
    s_snk = jnp.broadcast_to(sink_l, s_ctx.shape[:-1] + (1,))
    p = jax.nn.softmax(jnp.concatenate([s_snk, s_ctx, s_loc], axis=-1), axis=-1).astype(v.dtype)
    o = (jnp.einsum('bnkgqc,bckd->bnqkgd', p[..., 1:1 + C], vc)
         + jnp.einsum('bnkgqs,bnskd->bnqkgd', p[..., 1 + C:], vw))
    oc = None
    if emit_ctx:
        qcs = qc.reshape(B, C, GQ_KV, GQ_GROUP, GQ_HEAD)
        sc = jnp.einsum('bqkgd,bckd->bkgqc', qcs, kc, preferred_element_type=F32) * scale
        snk = jnp.broadcast_to(sink_l, sc.shape[:-1] + (1,))
        pc = jax.nn.softmax(jnp.concatenate([snk, sc], axis=-1), axis=-1)[..., 1:].astype(vc.dtype)
        oc = jnp.einsum('bkgqc,bckd->bqkgd', pc, vc).reshape(B, C, GQ_W)
    return o.reshape(B, S, GQ_W), oc


def conv_ffn(h, w_gate, w_up, w_down, conv_w, conv_b):
    gate = dwconv3(h @ w_gate, conv_w) + conv_b
    return (jax.nn.silu(gate) * (h @ w_up)) @ w_down


def setup_inputs(seed: int = 0) -> dict:
    key = jax.random.key(seed)
    ks = iter(jax.random.split(key, 28))
    nrm = lambda shape, s: jax.random.normal(next(ks), shape, F32) * s
    L, D = DEPTH, D_MODEL
    return {
        'x': nrm((BATCH, SEQ, D), 1.0),
        'c': nrm((BATCH, D), 1.0),
        'ctx': nrm((BATCH, CTX_LEN, D), 1.0),
        'c_ctx': nrm((D,), 1.0),
        'ada_w': nrm((L, D, 6 * D), 0.5 * D ** -0.5),
        'ada_b': nrm((L, 6 * D), 0.02),
        'norm_g': 1.0 + nrm((L, 4, D), 0.05),
        'w_in': nrm((L, D, IN_W), D ** -0.5),
        'w_out': nrm((L, MIX_W, D), MIX_W ** -0.5),
        'rw_conv': nrm((L, 3, 3 * RW_W), 0.6),
        'rw_w0': -2.5 + nrm((L, 2, RW_W), 1.5),
        'rw_w_up': nrm((L, 2, RW_DECAY_LORA, RW_W), 0.5 * RW_DECAY_LORA ** -0.5),
        'rw_a0': nrm((L, 2, RW_W), 0.5),
        'rw_a_up': nrm((L, 2, RW_ICLR_LORA, RW_W), 0.5 * RW_ICLR_LORA ** -0.5),
        'rw_g_up': nrm((L, RW_GATE_LORA, RW_W), RW_GATE_LORA ** -0.5),
        'rw_k_k': 0.85 + nrm((L, RW_W), 0.05),
        'rw_k_a': 1.0 + nrm((L, RW_W), 0.05),
        'rw_r_k': nrm((L, RW_HEADS, RW_HEAD), 0.1),
        'rw_ln_g': 1.0 + nrm((L, RW_W), 0.05),
        'rw_ln_b': nrm((L, RW_W), 0.02),
        'df_lambda': nrm((L, 4, DF_QK), 0.1),
        'df_norm_g': 1.0 + nrm((L, DF_V), 0.05),
        'gq_sink': nrm((L, GQ_HEADS), 0.5),
        'ff_w_gate': nrm((L, D, D_FF), D ** -0.5),
        'ff_w_up': nrm((L, D, D_FF), D ** -0.5),
        'ff_w_down': nrm((L, D_FF, D), D_FF ** -0.5),
        'ff_conv_w': nrm((L, 3, D_FF), 0.6),
        'ff_conv_b': nrm((L, D_FF), 0.02),
    }


def reference(x, c, ctx, c_ctx, ada_w, ada_b, norm_g, w_in, w_out,
              rw_conv, rw_w0, rw_w_up, rw_a0, rw_a_up, rw_g_up, rw_k_k, rw_k_a, rw_r_k, rw_ln_g, rw_ln_b,
              df_lambda, df_norm_g, gq_sink,
              ff_w_gate, ff_w_up, ff_w_down, ff_conv_w, ff_conv_b):
    B, S, D = x.shape
    rows = S // GRID_W
    cos_df, sin_df = axial_rope_tables(rows, DF_QK)
    cos_gq, sin_gq = axial_rope_tables(rows, GQ_HEAD)
    s_zero = jnp.zeros((2, B, RW_HEADS, RW_HEAD, RW_HEAD), F32)
    xc = ctx
    for l in range(DEPTH):
        last = l == DEPTH - 1
        lam_init = 0.8 - 0.6 * math.exp(-0.3 * l)
        mod = (jax.nn.silu(c) @ ada_w[l] + ada_b[l]).reshape(B, 1, 6, D)
        mod_c = (jax.nn.silu(c_ctx) @ ada_w[l] + ada_b[l]).reshape(6, D)
        sh1, sc1, ga1, sh2, sc2, ga2 = (mod[:, :, i] for i in range(6))
        sh1c, sc1c, ga1c, sh2c, sc2c, ga2c = (mod_c[i] for i in range(6))

        h = rms_norm(x, norm_g[l, 0]) * (1.0 + sc1) + sh1
        hc = rms_norm(xc, norm_g[l, 0]) * (1.0 + sc1c) + sh1c
        p = split_cols(h @ w_in[l])
        pc = split_cols(hc @ w_in[l])

        rw_args = (rw_conv[l], rw_w0[l], rw_w_up[l], rw_a0[l], rw_a_up[l], rw_k_k[l], rw_k_a[l])
        rd_args = (rw_g_up[l], rw_r_k[l], rw_ln_g[l], rw_ln_b[l])
        r_c, dec_c, kd_c, v_c, kk_c, a_c = rwkv_features(pc[0], pc[1], pc[2], pc[4], pc[5], *rw_args)
        s_ctx, o_c = rwkv_scan(s_zero, dec_c, kd_c, v_c, kk_c, a_c, None if last else r_c)
        r_x, dec_x, kd_x, v_x, kk_x, a_x = rwkv_features(p[0], p[1], p[2], p[4], p[5], *rw_args)
        _, o_x = rwkv_scan(s_ctx, dec_x, kd_x, v_x, kk_x, a_x, r_x)
        y_a = rwkv_readout(o_x, r_x, kd_x, v_x, p[3], *rd_args)

        y_b, yc_b = diff_attention(p[6], p[7], p[8], pc[6], pc[7], pc[8], cos_df, sin_df,
                                   df_lambda[l], df_norm_g[l], lam_init, not last)
        y_c, yc_c = window_gqa(p[9], p[10], p[11], pc[9], pc[10], pc[11], cos_gq, sin_gq,
                               gq_sink[l], not last)

        y = jnp.concatenate([y_a.astype(x.dtype), y_b.astype(x.dtype), y_c.astype(x.dtype)], axis=-1) @ w_out[l]
        x = x + ga1 * rms_norm(y, norm_g[l, 1])

        h2 = rms_norm(x, norm_g[l, 2]) * (1.0 + sc2) + sh2
        x = x + ga2 * rms_norm(conv_ffn(h2, ff_w_gate[l], ff_w_up[l], ff_w_down[l], ff_conv_w[l], ff_conv_b[l]),
                               norm_g[l, 3])

        if not last:
            y_ac = rwkv_readout(o_c, r_c, kd_c, v_c, pc[3], *rd_args)
            yc = jnp.concatenate([y_ac.astype(xc.dtype), yc_b.astype(xc.dtype), yc_c.astype(xc.dtype)], axis=-1) @ w_out[l]
            xc = xc + ga1c * rms_norm(yc, norm_g[l, 1])
            h2c = rms_norm(xc, norm_g[l, 2]) * (1.0 + sc2c) + sh2c
            xc = xc + ga2c * rms_norm(conv_ffn(h2c, ff_w_gate[l], ff_w_up[l], ff_w_down[l], ff_conv_w[l], ff_conv_b[l]),
                                      norm_g[l, 3])
    return x
```

```cpp
#include <hip/hip_runtime.h>
#include <hip/hip_cooperative_groups.h>
#include <cstdio>
#include <cstdint>
#ifndef MK_PER_PHASE
#define MK_PER_PHASE 1
#endif
#ifndef MK_KINDS
#define MK_KINDS 0xFFF
#endif
namespace pg8 {
#define PG8_LAS __attribute__((address_space(3)))
typedef unsigned short bf16_t;
typedef short bf16x8 __attribute__((ext_vector_type(8)));
typedef float f32x4 __attribute__((ext_vector_type(4)));
typedef unsigned u32x4 __attribute__((ext_vector_type(4)));
constexpr int BM = 256, BK = 64, HALF = 128, HTB = HALF * BK * 2  , STAGE_BYTES = 8 * HTB, NXCD = 8, WGM = 8;

__host__ __device__ __forceinline__ int lds_byte(int r, int c) { const int st = (r >> 4) * 2 + (c >> 5), rr = r & 15, cc = c & 31, ob = rr * 64 + cc * 2; return st * 1024 + (ob ^ (((ob >> 9) & 1) << 5)); }
__host__ __device__ __forceinline__ void stage_rc(int b, int& R, int& C) { const int st = b / 1024, sb = b % 1024, swz = sb ^ (((sb >> 9) & 1) << 5); R = (st >> 1) * 16 + swz / 64; C = (st & 1) * 32 + (swz % 64) / 2; }
__host__ __device__ __forceinline__ int perm32(int rho) { const int n = rho >> 4, i = rho & 15; return 8 * (i >> 2) + 4 * n + (i & 3); }

__device__ __forceinline__ float pg8_zero() { float z = 0.f; asm volatile("" : "+v"(z)); return z; }
struct Unit { int pm, pn; };
struct Gemm { const bf16_t* A; const bf16_t* Bt; int M, N, K; };

struct StaticOrder {
    int nM, nN, nwg, G, c;
    __host__ __device__ void init(int M, int N, int G_, int c_) { nM = M / BM; nN = N / BM; nwg = nM * nN; G = G_; c = c_; }
    __host__ __device__ bool next(int i, Unit& u) const {
        const long L = (long)i * G + c; if (L >= nwg) return false;
        int wgid = (int)L; { const int q = nwg / NXCD, r = nwg % NXCD, xcd = wgid % NXCD, off = wgid / NXCD; wgid = (xcd < r ? xcd * (q + 1) : r * (q + 1) + (xcd - r) * q) + off; }
        const int nig = WGM * nN, gid = wgid / nig, fm = gid * WGM, gsz = (nM - fm) < WGM ? (nM - fm) : WGM;
        u.pm = fm + ((wgid % nig) % gsz); u.pn = (wgid % nig) / gsz; return true;
    }
    __device__ __forceinline__ void a_ready(const Unit&) const {}
    __device__ __forceinline__ void done(const Unit&) const {}
};

__device__ __forceinline__ unsigned cvt_pk_bf16(float lo, float hi) { unsigned r; asm volatile("v_cvt_pk_bf16_f32 %0, %1, %2" : "=v"(r) : "v"(lo), "v"(hi)); return r; }
typedef float f32x2 __attribute__((ext_vector_type(2)));
__device__ __forceinline__ f32x2 gelu_pk(f32x2 v) {
    const f32x2 av = __builtin_elementwise_abs(v), d = av * 0.2316418882f + 1.0f;
    f32x2 t; t.x = __builtin_amdgcn_rcpf(d.x); t.y = __builtin_amdgcn_rcpf(d.y);
    f32x2 q = t * 0.5307027145f + (-0.7265760135f); q = q * t + 0.7107068705f; q = q * t + (-0.142248368f); q = q * t + 0.127414796f; q = q * t;
    const f32x2 s = (v * v) * (-0.72134752044f);
    f32x2 e; e.x = __builtin_amdgcn_exp2f(s.x); e.y = __builtin_amdgcn_exp2f(s.y);
    const f32x2 m = v * (q * e), r = v - m;
    f32x2 o; o.x = v.x < 0.f ? m.x : r.x; o.y = v.y < 0.f ? m.y : r.y; return o;
}

template <int ACT  > struct EpiBf16 {
    static constexpr bool PERM = true, AFTER_DRAIN = false; static_assert(ACT == 0 || ACT == 1, "EpiBf16: ACT is 0 (none) or 1 (gelu_pk)");
    bf16_t* O; int ldc; const float* bias; int split_cols; size_t split_stride; float scale0;
    __device__ __forceinline__ void operator()(const f32x4 (&acc)[2][2][4][2], const Unit& u, int wr, int wc, int fr, int fq) const {
        const int row0 = u.pm * BM + wr * 64 + fr; int colt = u.pn * BM; bf16_t* base = O;
        float sc = 1.f; if (split_cols) { const int t = colt / split_cols; base += (size_t)t * split_stride; colt -= t * split_cols; if (t == 0) sc = scale0; }
        const int col0 = colt + wc * 32 + 8 * fq, bcol0 = u.pn * BM + wc * 32 + 8 * fq;
        f32x4 bv[2][2];
#pragma unroll
        for (int bj = 0; bj < 2; ++bj)
#pragma unroll
            for (int n = 0; n < 2; ++n) bv[bj][n] = bias ? *(const f32x4*)(bias + bcol0 + bj * HALF + 4 * n) : (f32x4){0.f, 0.f, 0.f, 0.f};
#pragma unroll
        for (int ai = 0; ai < 2; ++ai)
#pragma unroll
            for (int m = 0; m < 4; ++m) { bf16_t* rowp = base + (size_t)(row0 + ai * HALF + m * 16) * ldc + col0;
#pragma unroll
                for (int bj = 0; bj < 2; ++bj) { f32x4 v0 = acc[ai][bj][m][0] + bv[bj][0], v1 = acc[ai][bj][m][1] + bv[bj][1];
                    if (ACT == 1) { f32x2 a = gelu_pk((f32x2){v0[0], v0[1]}), b = gelu_pk((f32x2){v0[2], v0[3]}), c = gelu_pk((f32x2){v1[0], v1[1]}), d = gelu_pk((f32x2){v1[2], v1[3]});
                        v0 = (f32x4){a.x, a.y, b.x, b.y}; v1 = (f32x4){c.x, c.y, d.x, d.y}; }
                    v0 = v0 * sc; v1 = v1 * sc; u32x4 w; w.x = cvt_pk_bf16(v0[0], v0[1]); w.y = cvt_pk_bf16(v0[2], v0[3]); w.z = cvt_pk_bf16(v1[0], v1[1]); w.w = cvt_pk_bf16(v1[2], v1[3]);
                    *(u32x4*)(rowp + bj * HALF) = w; } }
    }
};

template <class Epi, class Sched, bool ALIGN_EPI = false, bool SP2 = false>
__device__ __forceinline__ void gemm_phase(PG8_LAS unsigned char* lds, const Gemm g, const Sched& S, const Epi& E) {
    int tid_ = threadIdx.x; asm volatile("" : "+v"(tid_));
    const int tid = tid_, wid = __builtin_amdgcn_readfirstlane(tid >> 6), lane = tid & 63, wr = wid >> 2, wc = wid & 3, fr = lane & 15, fq = lane >> 4;
    const int K = g.K, nt = K / BK;
    unsigned voffA[2], voffB[2];
#pragma unroll
    for (int i = 0; i < 2; ++i) { int R, C; stage_rc(tid * 16 + i * 8192, R, C); const int Rb = Epi::PERM ? ((R & ~31) + perm32(R & 31)) : R;
        voffA[i] = (unsigned)(R * K + C) * 2u; voffB[i] = (unsigned)(Rb * K + C) * 2u; }
    const size_t kstep = (size_t)(BK * 2);
    const size_t hstep = (size_t)HALF * K * 2;
    const size_t tstep = 2 * hstep;
    const unsigned ldsw = (unsigned)wid * 1024u;
    const int aoff = lds_byte(wr * 64 + fr, fq * 8), boff = lds_byte(wc * 32 + fr, fq * 8);
#define PG8_SA(b, h) (((b) * 2 + (h)) * HTB)
#define PG8_SB(b, h) ((4 + (b) * 2 + (h)) * HTB)
#define PG8_STAGE(bufoff, gbase, voff) do { _Pragma("unroll") for (int _i = 0; _i < 2; ++_i) \
        __builtin_amdgcn_global_load_lds((const unsigned*)((const char*)(gbase) + (voff)[_i]), (PG8_LAS unsigned*)(lds + (bufoff) + ldsw + _i * 8192), 16, 0, 0); } while (0)
#define PG8_LDA(dst, b, h) do { _Pragma("unroll") for (int m = 0; m < 4; ++m) _Pragma("unroll") for (int k = 0; k < 2; ++k) dst[m][k] = *(const PG8_LAS bf16x8*)(lds + PG8_SA(b, h) + aoff + m * 2048 + k * 1024); } while (0)
#define PG8_LDB(dst, b, h) do { _Pragma("unroll") for (int n = 0; n < 2; ++n) _Pragma("unroll") for (int k = 0; k < 2; ++k) dst[n][k] = *(const PG8_LAS bf16x8*)(lds + PG8_SB(b, h) + boff + n * 2048 + k * 1024); } while (0)
#define PG8_MMA(ai, bj, At, Bt) do { __builtin_amdgcn_s_setprio(1); _Pragma("unroll") for (int m = 0; m < 4; ++m) _Pragma("unroll") for (int n = 0; n < 2; ++n) _Pragma("unroll") for (int k = 0; k < 2; ++k) \
        acc[ai][bj][m][n] = __builtin_amdgcn_mfma_f32_16x16x32_bf16(Bt[n][k], At[m][k], acc[ai][bj][m][n], 0, 0, 0); __builtin_amdgcn_s_setprio(0); } while (0)
#define PG8_WAIT_V(n) asm volatile("s_waitcnt vmcnt(" #n ")" ::: "memory")
#define PG8_WAIT_L(n) asm volatile("s_waitcnt lgkmcnt(" #n ")" ::: "memory")
#define PG8_BAR __builtin_amdgcn_s_barrier()
#define PG8_SCHED __builtin_amdgcn_sched_barrier(0)
    Unit cur, nxt; int ui = 0;
    if (!S.next(0, cur)) return;
    f32x4 acc[2][2][4][2];
#pragma unroll
    for (int a = 0; a < 2; ++a)
#pragma unroll
        for (int b = 0; b < 2; ++b)
#pragma unroll
            for (int m = 0; m < 4; ++m)
#pragma unroll
                for (int n = 0; n < 2; ++n) acc[a][b][m][n] = (f32x4){pg8_zero(), pg8_zero(), pg8_zero(), pg8_zero()};
    bf16x8 At[4][2], B0[2][2], B1[2][2];
    const char* cA = (const char*)g.A + (size_t)cur.pm * tstep; const char* cB = (const char*)g.Bt + (size_t)cur.pn * tstep;
    S.a_ready(cur);
    if constexpr (SP2) {
        PG8_STAGE(PG8_SB(0, 0), cB, voffB); PG8_STAGE(PG8_SB(0, 1), cB + hstep, voffB); PG8_STAGE(PG8_SA(0, 0), cA, voffA); PG8_STAGE(PG8_SA(0, 1), cA + hstep, voffA);
        if (wr == 1) PG8_BAR;
        PG8_WAIT_V(2); PG8_BAR;
        PG8_STAGE(PG8_SB(1, 0), cB + kstep, voffB); PG8_STAGE(PG8_SA(1, 0), cA + kstep, voffA); PG8_STAGE(PG8_SB(1, 1), cB + hstep + kstep, voffB);
        PG8_WAIT_V(6); PG8_BAR;
    } else {
        PG8_STAGE(PG8_SB(0, 0), cB, voffB); PG8_STAGE(PG8_SA(0, 0), cA, voffA); PG8_STAGE(PG8_SB(0, 1), cB + hstep, voffB); PG8_STAGE(PG8_SA(0, 1), cA + hstep, voffA);
        if (wr == 1) PG8_BAR;
        PG8_WAIT_V(4); PG8_BAR;
        PG8_STAGE(PG8_SB(1, 0), cB + kstep, voffB); PG8_STAGE(PG8_SA(1, 0), cA + kstep, voffA); PG8_STAGE(PG8_SB(1, 1), cB + hstep + kstep, voffB);
        PG8_WAIT_V(6); PG8_BAR;
    }
    for (;;) {
        const bool has_next = S.next(ui + 1, nxt);
        const char* nA = has_next ? (const char*)g.A + (size_t)nxt.pm * tstep : cA; const char* nB = has_next ? (const char*)g.Bt + (size_t)nxt.pn * tstep : cB;
        for (int t = 0; t < nt; t += 2) {
            const bool last = (t == nt - 2);
            const char* a1 = cA + (size_t)(t + 1) * kstep;
            const char* a2 = last ? nA : cA + (size_t)(t + 2) * kstep; const char* b2 = last ? nB : cB + (size_t)(t + 2) * kstep;
            const char* a3 = a2 + kstep; const char* b3 = b2 + kstep;
            if (last && has_next) S.a_ready(nxt);
            if constexpr (SP2) {
            PG8_LDB(B0, 0, 0); PG8_LDB(B1, 0, 1); PG8_SCHED; PG8_LDA(At, 0, 0); PG8_STAGE(PG8_SA(1, 1), a1 + hstep, voffA);
            PG8_WAIT_V(8); PG8_WAIT_L(0); PG8_BAR; PG8_MMA(0, 0, At, B0); PG8_MMA(0, 1, At, B1); PG8_BAR; PG8_SCHED;
            PG8_LDA(At, 0, 1); PG8_STAGE(PG8_SB(0, 0), b2, voffB); PG8_STAGE(PG8_SB(0, 1), b2 + hstep, voffB); PG8_STAGE(PG8_SA(0, 0), a2, voffA);
            PG8_WAIT_V(8); PG8_WAIT_L(0); PG8_BAR; PG8_MMA(1, 0, At, B0); PG8_MMA(1, 1, At, B1); PG8_BAR; PG8_SCHED;
            PG8_LDB(B0, 1, 0); PG8_LDB(B1, 1, 1); PG8_SCHED; PG8_LDA(At, 1, 0); PG8_STAGE(PG8_SA(0, 1), a2 + hstep, voffA);
            PG8_WAIT_V(8); PG8_WAIT_L(0); PG8_BAR; PG8_MMA(0, 0, At, B0); PG8_MMA(0, 1, At, B1); PG8_BAR; PG8_SCHED;
            PG8_LDA(At, 1, 1); PG8_STAGE(PG8_SB(1, 0), b3, voffB); PG8_STAGE(PG8_SB(1, 1), b3 + hstep, voffB); PG8_STAGE(PG8_SA(1, 0), a3, voffA);
            PG8_WAIT_V(8); PG8_WAIT_L(0); PG8_BAR; PG8_MMA(1, 0, At, B0); PG8_MMA(1, 1, At, B1); PG8_BAR; PG8_SCHED;
            } else {
            PG8_LDB(B0, 0, 0); PG8_SCHED; PG8_LDA(At, 0, 0); PG8_STAGE(PG8_SA(1, 1), a1 + hstep, voffA);
            PG8_WAIT_L(8); PG8_BAR; PG8_WAIT_L(0); PG8_MMA(0, 0, At, B0); PG8_BAR; PG8_SCHED;
            PG8_LDB(B1, 0, 1); PG8_STAGE(PG8_SB(0, 0), b2, voffB);
            PG8_BAR; PG8_WAIT_L(0); PG8_MMA(0, 1, At, B1); PG8_BAR;
            PG8_LDA(At, 0, 1); PG8_STAGE(PG8_SA(0, 0), a2, voffA);
            PG8_BAR; PG8_WAIT_L(0); PG8_MMA(1, 0, At, B0); PG8_BAR; PG8_SCHED;
            PG8_STAGE(PG8_SB(0, 1), b2 + hstep, voffB);
            PG8_WAIT_V(6); PG8_BAR; PG8_MMA(1, 1, At, B1); PG8_BAR;
            PG8_LDB(B0, 1, 0); PG8_SCHED; PG8_LDA(At, 1, 0); PG8_STAGE(PG8_SA(0, 1), a2 + hstep, voffA);
            PG8_WAIT_L(8); PG8_BAR; PG8_WAIT_L(0); PG8_MMA(0, 0, At, B0); PG8_BAR; PG8_SCHED;
            PG8_LDB(B1, 1, 1); PG8_STAGE(PG8_SB(1, 0), b3, voffB);
            PG8_BAR; PG8_WAIT_L(0); PG8_MMA(0, 1, At, B1); PG8_BAR;
            PG8_LDA(At, 1, 1); PG8_STAGE(PG8_SA(1, 0), a3, voffA);
            PG8_BAR; PG8_WAIT_L(0); PG8_MMA(1, 0, At, B0); PG8_BAR; PG8_SCHED;
            PG8_STAGE(PG8_SB(1, 1), b3 + hstep, voffB);
            PG8_WAIT_V(6); PG8_BAR; PG8_MMA(1, 1, At, B1); PG8_BAR;
            }
        }
        if constexpr (ALIGN_EPI) { if (wr == 0) PG8_BAR; }
        if constexpr (!Epi::AFTER_DRAIN) { E(acc, cur, wr, wc, fr, fq); S.done(cur); }
        if (!has_next) break;
#pragma unroll
        for (int a = 0; a < 2; ++a)
#pragma unroll
            for (int b = 0; b < 2; ++b)
#pragma unroll
                for (int m = 0; m < 4; ++m)
#pragma unroll
                    for (int n = 0; n < 2; ++n) acc[a][b][m][n] = (f32x4){pg8_zero(), pg8_zero(), pg8_zero(), pg8_zero()};
        cur = nxt; cA = nA; cB = nB; ++ui;
        if constexpr (ALIGN_EPI) { if (wr == 1) PG8_BAR; }
    }
    PG8_WAIT_V(0);
    if constexpr (!ALIGN_EPI) { if (wr == 0) PG8_BAR; }
    PG8_BAR;
    if constexpr (Epi::AFTER_DRAIN) { E.fused(acc, cur, wr, wc, fr, fq, lds, wid, lane); S.done(cur); }
#undef PG8_SA
#undef PG8_SB
#undef PG8_STAGE
#undef PG8_LDA
#undef PG8_LDB
#undef PG8_MMA
#undef PG8_WAIT_V
#undef PG8_WAIT_L
#undef PG8_BAR
#undef PG8_SCHED
}
}
#define GAS __attribute__((address_space(1)))
#define LAS __attribute__((address_space(3)))
typedef unsigned short bf16;
typedef unsigned v4u __attribute__((ext_vector_type(4)));
typedef float f32x4 __attribute__((ext_vector_type(4)));
typedef short bf16x8 __attribute__((ext_vector_type(8)));
typedef GAS unsigned gu32;
typedef GAS unsigned long long gu64;
#define RLX_AGENT __ATOMIC_RELAXED, __HIP_MEMORY_SCOPE_AGENT
#define LDS_WAIT() asm volatile("s_waitcnt lgkmcnt(0)" ::: "memory")
#define VM_WAIT() asm volatile("s_waitcnt vmcnt(0)" ::: "memory")
__device__ __forceinline__ unsigned long long rt() { return __builtin_amdgcn_s_memrealtime(); }
__device__ __forceinline__ unsigned f2bf(float f) { unsigned u = __builtin_bit_cast(unsigned, f); return (u + 0x7fffu + ((u >> 16) & 1u)) >> 16; }
__device__ __forceinline__ unsigned pk2(float lo, float hi) { return f2bf(lo) | (f2bf(hi) << 16); }
#define XB_TMO      128
#define XB_XCNT(j)  (256  + 64 * (j))
#define XB_XSUB(j)  (1280 + 64 * (j))
#define XB_XGEN(j)  (2304 + 64 * (j))
#define XB_TOP      3328
#define XB_TOPGEN   3392
#define XCD_BAR_WORDS 3456
#define XB_SPIN_CAP (1u << 18)

__device__ __forceinline__ unsigned xb_ld(unsigned* p)              { return __hip_atomic_load(p, __ATOMIC_RELAXED, __HIP_MEMORY_SCOPE_AGENT); }
__device__ __forceinline__ unsigned xb_add(unsigned* p, unsigned v) { return __hip_atomic_fetch_add(p, v, __ATOMIC_RELAXED, __HIP_MEMORY_SCOPE_AGENT); }
__device__ __forceinline__ unsigned xb_xcc_id() { return (unsigned)__builtin_amdgcn_s_getreg((3 << 11) | 20) & 0xFu; }
#define XB_SPIN(cond, bar) do { unsigned _sp = 0; while (cond) { __builtin_amdgcn_s_sleep(1); \
    if ((++_sp & 255u) == 0u) { if (xb_ld(&(bar)[XB_TMO])) break; if (_sp > XB_SPIN_CAP) { atomicAdd(&(bar)[XB_TMO], 1u); break; } } } } while (0)

struct XcdBarrier {
    int tid; unsigned* bar; unsigned x;
    volatile LAS unsigned* st;
};

__device__ __forceinline__ XcdBarrier xcd_barrier_post(unsigned* bar, volatile LAS unsigned* st, int tid) {
    XcdBarrier b; b.bar = bar; b.x = xb_xcc_id(); b.st = st; b.tid = tid;
    if (tid == 0) (void)xb_add(&bar[XB_XCNT(b.x)], 1u);
    return b;
}
__device__ __forceinline__ void xcd_barrier_complete(unsigned* bar, unsigned x, unsigned& nloc, unsigned& nx) {
    const unsigned G = gridDim.x * gridDim.y * gridDim.z;
    unsigned sum, cnt, mine, sp = 0u;
    for (;;) {
        sum = 0u; cnt = 0u; mine = 0u;
#pragma unroll
        for (unsigned j = 0; j < 16; ++j) { const unsigned c = xb_ld(&bar[XB_XCNT(j)]); sum += c; cnt += (c > 0u) ? 1u : 0u; mine = (j == x) ? c : mine; }
        if (sum == G) break;
        __builtin_amdgcn_s_sleep(1);
        if ((++sp & 255u) == 0u) { if (xb_ld(&bar[XB_TMO])) break; if (sp > XB_SPIN_CAP) { atomicAdd(&bar[XB_TMO], 1u); break; } }
    }
    nloc = mine > 0u ? mine : 1u; nx = cnt > 0u ? cnt : 1u;
}

__device__ __forceinline__ void xcd_barrier(const XcdBarrier& b) {
    asm volatile("s_waitcnt vmcnt(0)" ::: "memory");
    __syncthreads();
    if (b.tid == 0) {
        unsigned* bar = b.bar;
        __builtin_amdgcn_s_waitcnt(0);
        unsigned nloc = b.st[0], nx = b.st[1];
        if (nloc == 0u) { xcd_barrier_complete(bar, b.x, nloc, nx); b.st[0] = nloc; b.st[1] = nx; }
        const unsigned old = xb_add(&bar[XB_XSUB(b.x)], 1u);
        const unsigned gen = old / nloc;
        if (old + 1u == (gen + 1u) * nloc) {
            __builtin_amdgcn_fence(__ATOMIC_RELEASE, "agent");
            asm volatile("s_waitcnt vmcnt(0)" ::: "memory");
            const unsigned og = xb_add(&bar[XB_TOP], 1u);
            const unsigned tg = og / nx;
            if (og + 1u == (tg + 1u) * nx) xb_add(&bar[XB_TOPGEN], 1u);
            else XB_SPIN(xb_ld(&bar[XB_TOPGEN]) == tg, bar);
            __builtin_amdgcn_fence(__ATOMIC_ACQUIRE, "agent");
            xb_add(&bar[XB_XGEN(b.x)], 1u);
            asm volatile("s_waitcnt vmcnt(0)" ::: "memory");
        } else {
            XB_SPIN(xb_ld(&bar[XB_XGEN(b.x)]) == gen, bar);
            __builtin_amdgcn_fence(__ATOMIC_ACQUIRE, "agent");
            asm volatile("s_waitcnt vmcnt(0)" ::: "memory");
        }
    }
    __syncthreads();
}

namespace mk {
constexpr int NWAVES = 8, NTHR = 512;
constexpr int D = 1024, NBATCH = 4, SEQ = 4096, CTXL = 256;
constexpr int MLAT = NBATCH * SEQ, MCTX = NBATCH * CTXL, MALL = MLAT + MCTX;
constexpr int INW = 2496, INP = 2560, DFF = 2816, NGU = 2 * DFF;
constexpr int C_R = 0, C_K = 256, C_V = 512, C_GD = 768, C_WD = 832, C_AD = 896, C_DFQ = 960, C_DFK = 1216, C_DFV = 1472, C_GQQ = 1728, C_GQK = 2240, C_GQV = 2368;
constexpr float NORM_EPS = 1e-6f, LOG2E = 1.4426950408889634f;
constexpr float SC_DF = 0.17677669529663687f * LOG2E;
constexpr float SC_GQ = 0.125f * LOG2E;

enum { I_X = 0, I_C, I_CTX, I_CCTX, I_ADAW, I_ADAB, I_NORMG, I_WIN, I_WOUT, I_RWCONV, I_RWW0, I_RWWUP, I_RWA0, I_RWAUP, I_RWGUP, I_RWKK, I_RWKA, I_RWRK, I_RWLNG, I_RWLNB,
       I_DFLAM, I_DFNG, I_GQSINK, I_FFG, I_FFU, I_FFD, I_FFCW, I_FFCB, N_IN };

constexpr size_t MiB = 1u << 20;
constexpr size_t WS_CTL = 0, CTL_ZERO_BYTES = 1 * MiB;
constexpr int CW_BAR = 4096;
constexpr size_t WS_MOD = 1 * MiB;
constexpr size_t WS_TAB = 1 * MiB + 256 * 1024;
constexpr size_t WS_WIN = 2 * MiB, WIN_BYTES = (size_t)INP * D * 2;
constexpr size_t WS_WOUT = 12 * MiB, WOUT_BYTES = (size_t)D * D * 2;
constexpr size_t WS_WGU = 16 * MiB, WGU_BYTES = (size_t)NGU * D * 2;
constexpr size_t WS_WD = 38 * MiB, WD_BYTES = (size_t)D * DFF * 2;
constexpr size_t WS_XSC = 49 * MiB;
constexpr size_t WS_XN = 53 * MiB;
constexpr size_t WS_RP = 87 * MiB;
constexpr size_t WS_RF = 172 * MiB;
constexpr size_t FEAT1 = (size_t)MALL * 256 * 2;
constexpr size_t WS_FR = WS_RF, WS_FK = WS_FR + FEAT1, WS_FV = WS_FK + FEAT1, WS_FW = WS_FV + FEAT1  , WS_FA = WS_FW + 2 * FEAT1  , WS_O = WS_FA + 2 * FEAT1  ;
constexpr size_t WS_INVN = WS_O + 2 * FEAT1;
constexpr size_t WS_AB = WS_INVN + (size_t)MALL * 4 * 4;
constexpr size_t WS_BON = WS_AB + (size_t)MALL * 16 * 4;
constexpr size_t WS_RF_END = WS_BON + (size_t)MALL * 4 * 4;
constexpr size_t WS_ACT = 186 * MiB;
constexpr size_t WS_END = 256 * MiB;
static_assert(WS_RF_END <= WS_END, "feature region");
static_assert(WS_RP + (size_t)9216 * NGU * 2 <= WS_ACT && WS_ACT + (size_t)9216 * DFF * 2 <= WS_END, "ffn overlays");
static_assert(WS_XN + (size_t)MALL * D * 2 <= WS_RP && WS_RP + (size_t)MALL * INP * 2 <= WS_RF, "map");

constexpr int RING_BYTES = 131072;
constexpr int LDSCTL_OFF = RING_BYTES, MISC_OFF = LDSCTL_OFF + 320;
constexpr int LDS_BYTES = 147456;

struct Args { const float* in[N_IN]; float* out; unsigned char* ws; int ph_lo, ph_hi; };


typedef const __attribute__((address_space(4))) char* kptr_t;
__device__ __forceinline__ kptr_t karg_base() { kptr_t k = (kptr_t)__builtin_amdgcn_kernarg_segment_ptr(); asm volatile("" : "+s"(k)); return k; }
__device__ __forceinline__ const float* kin(int i) { return *(const float* const __attribute__((address_space(4)))*)(karg_base() + 8 * i); }
__device__ __forceinline__ float* kout() { return *(float* const __attribute__((address_space(4)))*)(karg_base() + 8 * N_IN); }
__device__ __forceinline__ unsigned char* kws() { return *(unsigned char* const __attribute__((address_space(4)))*)(karg_base() + 8 * N_IN + 8); }

struct Frame {
    LAS unsigned char* lds;
    int tid, lane, wave, G, bid;
};

__device__ __forceinline__ float bf2f(bf16 h) { return __uint_as_float(((unsigned)h) << 16); }
__device__ __forceinline__ float wave_sum(float v) {
#pragma unroll
    for (int o = 1; o < 64; o <<= 1) v += __shfl_xor(v, o);
    return v;
}
__device__ __forceinline__ float rdlane(float v, int l) { return __int_as_float(__builtin_amdgcn_readlane(__float_as_int(v), l)); }
__device__ __forceinline__ float sigmoidf_(float x) { return 1.0f / (1.0f + __expf(-x)); }
typedef unsigned v2u __attribute__((ext_vector_type(2)));

__device__ __forceinline__ void p0_transpose_item(const float* W, int K, int N, bf16* WT, int row_off, LAS float* scr, int item, int lane) {
    const int nblk = N / 32, kb = item / nblk, nb = item % nblk, k0 = 64 * kb, n0 = 32 * nb;
#pragma unroll 8
    for (int i = 0; i < 32; ++i) { const int kk = 2 * i + (lane >> 5); scr[kk * 33 + (lane & 31)] = W[(size_t)(k0 + kk) * N + n0 + (lane & 31)]; }
    LDS_WAIT(); asm volatile("" ::: "memory");
    const int c = lane & 7;
#pragma unroll
    for (int j = 0; j < 4; ++j) { const int n = (lane >> 3) + 8 * j; const LAS float* s = scr + (8 * c) * 33 + n;
        v4u o; o.x = pk2(s[0 * 33], s[1 * 33]); o.y = pk2(s[2 * 33], s[3 * 33]); o.z = pk2(s[4 * 33], s[5 * 33]); o.w = pk2(s[6 * 33], s[7 * 33]);
        *(GAS v4u*)(WT + (size_t)(row_off + n0 + n) * K + k0 + 8 * c) = o; }
    LDS_WAIT(); asm volatile("" ::: "memory");
}

__device__ __forceinline__ void p0_prologue(const Args& A, Frame& F) {
    unsigned char* ws = kws();
    {
        LAS float* sc = (LAS float*)F.lds;
        LAS float* red = (LAS float*)(F.lds + 20480);
        float* mod = (float*)(ws + WS_MOD);
        for (int u = F.bid; u < 192; u += F.G) {
            __syncthreads();
            for (int i = F.tid; i < 5 * 1024; i += NTHR) { const int bb = i >> 10, k = i & 1023; const float v = bb < 4 ? kin(I_C)[bb * 1024 + k] : kin(I_CCTX)[k]; sc[i] = v / (1.0f + __expf(-v)); }
            __syncthreads();
            const int l = u / 96, cc = u % 96, col = cc * 64 + (F.tid & 63), ks = F.tid >> 6;
            const float* w = kin(I_ADAW) + (size_t)l * 1024 * 6144 + col;
            float acc[5] = {0.f, 0.f, 0.f, 0.f, 0.f};
            for (int k = ks * 128; k < ks * 128 + 128; ++k) { const float wv = w[(size_t)k * 6144];
#pragma unroll
                for (int bb = 0; bb < 5; ++bb) acc[bb] += sc[bb * 1024 + k] * wv; }
#pragma unroll
            for (int bb = 0; bb < 5; ++bb) red[(ks * 5 + bb) * 64 + (F.tid & 63)] = acc[bb];
            __syncthreads();
            if (F.tid < 320) { const int bb = F.tid >> 6, c = F.tid & 63; float s = kin(I_ADAB)[l * 6144 + cc * 64 + c];
#pragma unroll
                for (int k8 = 0; k8 < 8; ++k8) s += red[(k8 * 5 + bb) * 64 + c];
                mod[(size_t)(l * 5 + bb) * 6144 + cc * 64 + c] = s; }
        }
        __syncthreads();
    }
    {
        LAS float* scr = (LAS float*)(F.lds + F.wave * 16384);
        const int gw = F.bid * NWAVES + F.wave, NGW = F.G * NWAVES;
        constexpr int I_IN = 16 * (INW / 32), I_OUT = 16 * 32, I_G = 16 * (DFF / 32), I_DN = (DFF / 64) * 32, I_LAYER = I_IN + I_OUT + 2 * I_G + I_DN;
        for (int it = gw; it < 2 * I_LAYER; it += NGW) {
            const int l = it / I_LAYER; int r = it % I_LAYER;
            if (r < I_IN) { p0_transpose_item(kin(I_WIN) + (size_t)l * D * INW, D, INW, (bf16*)(ws + WS_WIN + l * WIN_BYTES), 0, scr, r, F.lane); continue; } r -= I_IN;
            if (r < I_OUT) { p0_transpose_item(kin(I_WOUT) + (size_t)l * D * D, D, D, (bf16*)(ws + WS_WOUT + l * WOUT_BYTES), 0, scr, r, F.lane); continue; } r -= I_OUT;
            if (r < I_G) { p0_transpose_item(kin(I_FFG) + (size_t)l * D * DFF, D, DFF, (bf16*)(ws + WS_WGU + l * WGU_BYTES), 0, scr, r, F.lane); continue; } r -= I_G;
            if (r < I_G) { p0_transpose_item(kin(I_FFU) + (size_t)l * D * DFF, D, DFF, (bf16*)(ws + WS_WGU + l * WGU_BYTES), DFF, scr, r, F.lane); continue; } r -= I_G;
            p0_transpose_item(kin(I_FFD) + (size_t)l * DFF * D, DFF, D, (bf16*)(ws + WS_WD + l * WD_BYTES), 0, scr, r, F.lane);
        }
        const int gt = F.bid * NTHR + F.tid, NGT = F.G * NTHR;
        for (int i = gt; i < 2 * 8192; i += NGT) { const int l = i >> 13, j = i & 8191;
            *(GAS v4u*)(ws + WS_WIN + l * WIN_BYTES + (size_t)INW * D * 2 + (size_t)j * 16) = (v4u){0u, 0u, 0u, 0u}; }
    }
    if (F.bid == 0) {
        float* tab = (float*)(ws + WS_TAB);
        for (int i = F.tid; i < 512; i += NTHR) { const int pos = i >> 3, f = i & 7; const float inv = __builtin_amdgcn_exp2f(-(float)f * (13.287712379549449f / 8.0f)), ang = (float)pos * inv; tab[i] = __cosf(ang); tab[512 + i] = __sinf(ang); }
        for (int i = F.tid; i < 1024; i += NTHR) { const int pos = i >> 4, f = i & 15; const float inv = __builtin_amdgcn_exp2f(-(float)f * (13.287712379549449f / 16.0f)), ang = (float)pos * inv; tab[1024 + i] = __cosf(ang); tab[2048 + i] = __sinf(ang); }
        if (F.tid < 2) { const int l = F.tid; const float* lv = kin(I_DFLAM) + l * 128; float s1 = 0.f, s2 = 0.f;
            for (int i = 0; i < 32; ++i) { s1 += lv[i] * lv[32 + i]; s2 += lv[64 + i] * lv[96 + i]; }
            const float lam_init = 0.8f - 0.6f * __expf(-0.3f * (float)l);
            tab[3072 + l] = __expf(s1) - __expf(s2) + lam_init; tab[3074 + l] = lam_init; }
    }
}

__device__ __forceinline__ const float* mod_vec(const Args& A, int l, int bb, int i) { return (const float*)(kws() + WS_MOD) + ((size_t)(l * 5 + bb) * 6 + i) * 1024; }
__device__ __forceinline__ const float* normg_vec(const Args& A, int l, int i) { return kin(I_NORMG) + (size_t)(l * 4 + i) * 1024; }
__device__ __forceinline__ int row_bb(int row) { return row < MLAT ? (row >> 12) : 4; }
__device__ __forceinline__ void ld16(const float* p, int lane, f32x4 (&v)[4]) {
#pragma unroll
    for (int j = 0; j < 4; ++j) v[j] = *(const f32x4*)(p + 4 * lane + 256 * j);
}
__device__ __forceinline__ void st16(float* p, int lane, const f32x4 (&v)[4]) {
#pragma unroll
    for (int j = 0; j < 4; ++j) *(f32x4*)(p + 4 * lane + 256 * j) = v[j];
}
__device__ __forceinline__ float sumsq16(const f32x4 (&v)[4]) {
    float s = 0.f;
#pragma unroll
    for (int j = 0; j < 4; ++j) s += (v[j].x * v[j].x + v[j].y * v[j].y) + (v[j].z * v[j].z + v[j].w * v[j].w);
    return wave_sum(s);
}
__device__ __forceinline__ void norm_mod_store(const f32x4 (&v)[4], float rstd, const float* g, const float* sc, const float* sh, bf16* orow, int lane) {
#pragma unroll
    for (int j = 0; j < 4; ++j) {
        const int c = 4 * lane + 256 * j;
        const f32x4 gg = *(const f32x4*)(g + c), s1 = *(const f32x4*)(sc + c), s0 = *(const f32x4*)(sh + c);
        const f32x4 h = v[j] * rstd * gg * (s1 + 1.0f) + s0;
        v2u o; o.x = pk2(h.x, h.y); o.y = pk2(h.z, h.w);
        *(v2u*)(orow + c) = o;
    }
}
__device__ __forceinline__ float* xs_row(const Args& A, int row) { return row < MLAT ? kout() + (size_t)row * D : (float*)(kws() + WS_XSC) + (size_t)(row - MLAT) * D; }
__device__ __forceinline__ const float* xin_row(const Args& A, int row) { return row < MLAT ? kin(I_X) + (size_t)row * D : kin(I_CTX) + (size_t)(row - MLAT) * D; }

__device__ __forceinline__ void phase_prep(const Args& A, Frame& F) {
    const int gw = F.bid * NWAVES + F.wave, NGW = F.G * NWAVES;
    bf16* XN = (bf16*)(kws() + WS_XN);
    for (int row = gw; row < MALL; row += NGW) {
        f32x4 v[4]; ld16(xin_row(A, row), F.lane, v);
        const float rstd = rsqrtf(sumsq16(v) * (1.0f / D) + NORM_EPS);
        const int bb = row_bb(row);
        norm_mod_store(v, rstd, normg_vec(A, 0, 0), mod_vec(A, 0, bb, 1), mod_vec(A, 0, bb, 0), XN + (size_t)row * D, F.lane);
    }
}
__device__ __forceinline__ void phase_e1(const Args& A, Frame& F, int l) {
    const int gw = F.bid * NWAVES + F.wave, NGW = F.G * NWAVES, nrows = l == 0 ? MALL : MLAT;
    bf16* XN = (bf16*)(kws() + WS_XN); const float* YP = (const float*)(kws() + WS_RP);
    for (int row = gw; row < nrows; row += NGW) {
        const int bb = row_bb(row);
        f32x4 y[4], x[4]; ld16(YP + (size_t)row * D, F.lane, y);
        if (l == 0) ld16(xin_row(A, row), F.lane, x); else ld16(xs_row(A, row), F.lane, x);
        const float ry = rsqrtf(sumsq16(y) * (1.0f / D) + NORM_EPS);
        const float* g1 = normg_vec(A, l, 1); const float* ga = mod_vec(A, l, bb, 2);
#pragma unroll
        for (int j = 0; j < 4; ++j) { const int c = 4 * F.lane + 256 * j; x[j] = x[j] + *(const f32x4*)(ga + c) * (y[j] * ry * *(const f32x4*)(g1 + c)); }
        st16(xs_row(A, row), F.lane, x);
        const float rx = rsqrtf(sumsq16(x) * (1.0f / D) + NORM_EPS);
        norm_mod_store(x, rx, normg_vec(A, l, 2), mod_vec(A, l, bb, 4), mod_vec(A, l, bb, 3), XN + (size_t)row * D, F.lane);
    }
}
__device__ __forceinline__ void phase_e2(const Args& A, Frame& F, int l, int r0, int r1) {
    const int gw = F.bid * NWAVES + F.wave, NGW = F.G * NWAVES;
    bf16* XN = (bf16*)(kws() + WS_XN); const float* FP = (const float*)(kws() + WS_RP);
    for (int row = r0 + gw; row < r1; row += NGW) {
        const int bb = row_bb(row);
        f32x4 y[4], x[4]; ld16(FP + (size_t)(row - r0) * D, F.lane, y); ld16(xs_row(A, row), F.lane, x);
        const float ry = rsqrtf(sumsq16(y) * (1.0f / D) + NORM_EPS);
        const float* g3 = normg_vec(A, l, 3); const float* ga = mod_vec(A, l, bb, 5);
#pragma unroll
        for (int j = 0; j < 4; ++j) { const int c = 4 * F.lane + 256 * j; x[j] = x[j] + *(const f32x4*)(ga + c) * (y[j] * ry * *(const f32x4*)(g3 + c)); }
        st16(xs_row(A, row), F.lane, x);
        if (l == 0) {
            const float rx = rsqrtf(sumsq16(x) * (1.0f / D) + NORM_EPS);
            norm_mod_store(x, rx, normg_vec(A, 1, 0), mod_vec(A, 1, bb, 1), mod_vec(A, 1, bb, 0), XN + (size_t)row * D, F.lane);
        }
    }
}
__device__ __forceinline__ void phase_act(const Args& A, Frame& F, int l, int r0, int r1) {
    const bf16* GU = (const bf16*)(kws() + WS_RP); bf16* ACT = (bf16*)(kws() + WS_ACT);
    const float* cw = kin(I_FFCW) + (size_t)l * 3 * DFF; const float* cb = kin(I_FFCB) + (size_t)l * DFF;
    const int nch = DFF / 8, total = (r1 - r0) * nch;
    for (int i = F.bid * NTHR + F.tid; i < total; i += F.G * NTHR) {
        const int rr = i / nch, ch = i % nch, row = r0 + rr, j0 = ch * 8;
        const int t = row < MLAT ? (row & (SEQ - 1)) : ((row - MLAT) & (CTXL - 1)), T = row < MLAT ? SEQ : CTXL;
        const bf16* gp = GU + (size_t)rr * NGU + j0;
        const v4u gc = *(const v4u*)gp, uu = *(const v4u*)(gp + DFF);
        v4u gm = (v4u){0u, 0u, 0u, 0u}, gn = (v4u){0u, 0u, 0u, 0u};
        if (t > 0) gm = *(const v4u*)(gp - NGU);
        if (t < T - 1) gn = *(const v4u*)(gp + NGU);
        unsigned o[4];
#pragma unroll
        for (int q = 0; q < 4; ++q) {
            float r2[2];
#pragma unroll
            for (int e = 0; e < 2; ++e) {
                const int j = j0 + 2 * q + e;
                const float a = __uint_as_float(e ? (gm[q] & 0xffff0000u) : (gm[q] << 16)), b = __uint_as_float(e ? (gc[q] & 0xffff0000u) : (gc[q] << 16)), c = __uint_as_float(e ? (gn[q] & 0xffff0000u) : (gn[q] << 16));
                const float u = __uint_as_float(e ? (uu[q] & 0xffff0000u) : (uu[q] << 16));
                const float z = a * cw[j] + b * cw[DFF + j] + c * cw[2 * DFF + j] + cb[j];
                r2[e] = z / (1.0f + __expf(-z)) * u;
            }
            o[q] = pk2(r2[0], r2[1]);
        }
        *(v4u*)(ACT + (size_t)rr * DFF + j0) = (v4u){o[0], o[1], o[2], o[3]};
    }
}

struct EpiMulti {
    static constexpr bool PERM = false, AFTER_DRAIN = false;
    int mode;
    bf16* ob; float* of; int ld; const float* tab;
    __device__ __forceinline__ void operator()(const pg8::f32x4 (&acc)[2][2][4][2], const pg8::Unit& u, int wr, int wc, int fr_, int fq_) const {
        int fr = fr_, fq = fq_; asm volatile("" : "+v"(fr), "+v"(fq));
        if (mode == 1) {
#pragma unroll
            for (int ai = 0; ai < 2; ++ai)
#pragma unroll
                for (int m = 0; m < 4; ++m) { float* rp = of + (size_t)(u.pm * 256 + ai * 128 + wr * 64 + m * 16 + fr) * ld + u.pn * 256 + wc * 32 + 4 * fq;
#pragma unroll
                    for (int bj = 0; bj < 2; ++bj)
#pragma unroll
                        for (int n = 0; n < 2; ++n) *(pg8::f32x4*)(rp + bj * 128 + n * 16) = acc[ai][bj][m][n]; }
        } else if (mode == 2) {
#pragma unroll
            for (int ai = 0; ai < 2; ++ai)
#pragma unroll
                for (int m = 0; m < 4; ++m) { bf16* rp = ob + (size_t)(u.pm * 256 + ai * 128 + wr * 64 + m * 16 + fr) * ld + u.pn * 256 + wc * 32 + 4 * fq;
#pragma unroll
                    for (int bj = 0; bj < 2; ++bj)
#pragma unroll
                        for (int n = 0; n < 2; ++n) { const pg8::f32x4 v = acc[ai][bj][m][n]; v2u o; o.x = pk2(v[0], v[1]); o.y = pk2(v[2], v[3]); *(v2u*)(rp + bj * 128 + n * 16) = o; } }
        } else {
            const bool latent = u.pm < (MLAT / 256);
#pragma unroll
            for (int bj = 0; bj < 2; ++bj) {
                const int g32 = u.pn * 8 + bj * 4 + wc;
                if (g32 >= INW / 32) continue;
                const bool isdf = (g32 >= C_DFQ / 32 && g32 < C_DFV / 32), isgq = (g32 >= C_GQQ / 32 && g32 < C_GQV / 32);
                const float qs = (g32 >= C_DFQ / 32 && g32 < C_DFK / 32) ? SC_DF : ((g32 >= C_GQQ / 32 && g32 < C_GQK / 32) ? SC_GQ : 1.0f);
#pragma unroll
                for (int ai = 0; ai < 2; ++ai)
#pragma unroll
                    for (int m = 0; m < 4; ++m) {
                        const int row = u.pm * 256 + ai * 128 + wr * 64 + m * 16 + fr, s = row & (SEQ - 1), prow = s >> 6, pcol = s & 63;
                        pg8::f32x4 v0 = acc[ai][bj][m][0], v1 = acc[ai][bj][m][1];
                        if (isdf) {
                            pg8::f32x4 p0, p1;
#pragma unroll
                            for (int i = 0; i < 4; ++i) { p0[i] = __shfl_xor(v0[i], 32); p1[i] = __shfl_xor(v1[i], 32); }
                            if (latent) {
                                const int f0 = 4 * (fq & 1);
                                const pg8::f32x4 c0 = *(const pg8::f32x4*)(tab + prow * 8 + f0), s0 = *(const pg8::f32x4*)(tab + 512 + prow * 8 + f0);
                                const pg8::f32x4 c1 = *(const pg8::f32x4*)(tab + pcol * 8 + f0), s1 = *(const pg8::f32x4*)(tab + 512 + pcol * 8 + f0);
                                if (fq & 2) { v0 = v0 * c0 + p0 * s0; v1 = v1 * c1 + p1 * s1; } else { v0 = v0 * c0 - p0 * s0; v1 = v1 * c1 - p1 * s1; }
                            }
                        } else if (isgq) {
                            if (latent) {
                                const int pos = (g32 & 1) ? pcol : prow;
                                const pg8::f32x4 cc = *(const pg8::f32x4*)(tab + 1024 + pos * 16 + 4 * fq), ss = *(const pg8::f32x4*)(tab + 2048 + pos * 16 + 4 * fq);
                                const pg8::f32x4 a = v0 * cc - v1 * ss, b = v1 * cc + v0 * ss; v0 = a; v1 = b;
                            }
                        }
                        v0 = v0 * qs; v1 = v1 * qs;
                        bf16* rp = ob + (size_t)row * INP + g32 * 32 + 4 * fq;
                        v2u o; o.x = pk2(v0[0], v0[1]); o.y = pk2(v0[2], v0[3]); *(v2u*)rp = o;
                        o.x = pk2(v1[0], v1[1]); o.y = pk2(v1[2], v1[3]); *(v2u*)(rp + 16) = o;
                        asm volatile("" ::: "memory");
                    }
            }
        }
    }
};

__device__ __forceinline__ void seq_pos(int row, int& t, int& T) { if (row < MLAT) { t = row & (SEQ - 1); T = SEQ; } else { t = (row - MLAT) & (CTXL - 1); T = CTXL; } }

__device__ __forceinline__ void rwkv_features(const Args& A, Frame& F, int l) {
    const int gw = F.bid * NWAVES + F.wave, NGW = F.G * NWAVES;
    const int h = gw & 3, n = F.lane, c = h * 64 + n;
    const bf16* P = (const bf16*)(kws() + WS_RP);
    bf16* FR = (bf16*)(kws() + WS_FR); bf16* FK = (bf16*)(kws() + WS_FK); bf16* FV = (bf16*)(kws() + WS_FV); bf16* FW = (bf16*)(kws() + WS_FW); bf16* FA = (bf16*)(kws() + WS_FA);
    float* INVN = (float*)(kws() + WS_INVN); float* AB = (float*)(kws() + WS_AB); float* BON = (float*)(kws() + WS_BON);
    float wupr[2][32], aupr[2][32], w0r[2], a0r[2], cw[3][3];
#pragma unroll
    for (int d = 0; d < 2; ++d) {
#pragma unroll
        for (int r = 0; r < 32; ++r) { wupr[d][r] = kin(I_RWWUP)[((size_t)(l * 2 + d) * 32 + r) * 256 + c]; aupr[d][r] = kin(I_RWAUP)[((size_t)(l * 2 + d) * 32 + r) * 256 + c]; }
        w0r[d] = kin(I_RWW0)[(l * 2 + d) * 256 + c]; a0r[d] = kin(I_RWA0)[(l * 2 + d) * 256 + c];
    }
#pragma unroll
    for (int tp = 0; tp < 3; ++tp)
#pragma unroll
        for (int j = 0; j < 3; ++j) cw[tp][j] = kin(I_RWCONV)[(size_t)(l * 3 + tp) * 768 + j * 256 + c];
    const float kkc = kin(I_RWKK)[l * 256 + c], kac = kin(I_RWKA)[l * 256 + c], rkc = kin(I_RWRK)[l * 256 + c];
    for (int row = gw >> 2; row < MALL; row += NGW >> 2) {
        int t, T; seq_pos(row, t, T);
        const bf16* p0 = P + (size_t)row * INP;
        float xr[3], xk[3], xv[3];
#pragma unroll
        for (int tp = 0; tp < 3; ++tp) {
            const bool ok = (tp == 1) || (tp == 0 ? t > 0 : t < T - 1);
            const bf16* pp = p0 + (ptrdiff_t)(tp - 1) * INP;
            xr[tp] = ok ? bf2f(pp[C_R + c]) : 0.f; xk[tp] = ok ? bf2f(pp[C_K + c]) : 0.f; xv[tp] = ok ? bf2f(pp[C_V + c]) : 0.f;
        }
        const bf16 rb = (bf16)f2bf(xr[0] * cw[0][0] + xr[1] * cw[1][0] + xr[2] * cw[2][0]);
        const bf16 kb = (bf16)f2bf(xk[0] * cw[0][1] + xk[1] * cw[1][1] + xk[2] * cw[2][1]);
        const bf16 vb = (bf16)f2bf(xv[0] * cw[0][2] + xv[1] * cw[1][2] + xv[2] * cw[2][2]);
        const float rq = bf2f(rb), kq = bf2f(kb);
        const float twd = 1.0f - 2.0f / (1.0f + __expf(2.0f * bf2f(p0[C_WD + n]))), xad = bf2f(p0[C_AD + n]);
        const float kkraw = kq * kkc;
        const float invn = 1.0f / fmaxf(sqrtf(wave_sum(kkraw * kkraw)), 1e-12f);
        const float kk = kkraw * invn;
        float bon = 0.f, Asum[2], Bsum[2];
        const size_t o = (size_t)row * 256 + c;
#pragma unroll
        for (int d = 0; d < 2; ++d) {
            float wl = w0r[d], al = a0r[d];
#pragma unroll
            for (int r = 0; r < 32; ++r) { wl = fmaf(rdlane(twd, d * 32 + r), wupr[d][r], wl); al = fmaf(rdlane(xad, d * 32 + r), aupr[d][r], al); }
            const float wm1 = __expf(-0.6065306597126334f * sigmoidf_(wl)) - 1.0f;
            const bf16 wb = (bf16)f2bf(wm1), ab = (bf16)f2bf(sigmoidf_(al));
            FW[(size_t)d * MALL * 256 + o] = wb; FA[(size_t)d * MALL * 256 + o] = ab;
            const float aq = bf2f(ab);
            const float kd = kq * (1.0f + (aq - 1.0f) * kac), ka = kk * aq;
            Asum[d] = wave_sum(ka * rq); Bsum[d] = wave_sum(kd * rq); bon += wave_sum(rq * kd * rkc);
        }
        FR[o] = rb; FK[o] = kb; FV[o] = vb;
        if (n == 0) { INVN[row * 4 + h] = invn; BON[row * 4 + h] = bon;
            AB[((size_t)row * 2 + 0) * 8 + h * 2 + 0] = Asum[0]; AB[((size_t)row * 2 + 0) * 8 + h * 2 + 1] = Bsum[0];
            AB[((size_t)row * 2 + 1) * 8 + h * 2 + 0] = Asum[1]; AB[((size_t)row * 2 + 1) * 8 + h * 2 + 1] = Bsum[1]; }
    }
}

constexpr int SC_TS = 32;
constexpr int SC_V4 = 0, SC_V1 = 32768, SC_RV = 40960, SC_AB = 49152, SC_BUF = 50176;
__device__ __forceinline__ int scan_row(int d, int b, int i) { if (i < CTXL) { const int t = d ? CTXL - 1 - i : i; return MLAT + b * CTXL + t; } const int j = i - CTXL, t = d ? SEQ - 1 - j : j; return b * SEQ + t; }
template <int CTRL, int RM> __device__ __forceinline__ float dpp_add(float x) {
    return x + __int_as_float(__builtin_amdgcn_update_dpp(0, __float_as_int(x), CTRL, RM, 0xF, false));
}
__device__ __forceinline__ void phase_scan(const Args& A, Frame& F, int l) {
    const bool last = (l == 1);
    const bf16* FR = (const bf16*)(kws() + WS_FR); const bf16* FK = (const bf16*)(kws() + WS_FK); const bf16* FV = (const bf16*)(kws() + WS_FV);
    const float* INVN = (const float*)(kws() + WS_INVN); const float* AB = (const float*)(kws() + WS_AB);
    bf16* O = (bf16*)(kws() + WS_O);
    const int n = F.lane, tsub = F.tid >> 6;
    constexpr int NCH = (CTXL + SEQ) / SC_TS;
    for (int unit = F.bid; unit < 256; unit += F.G) {
        const int sc = unit >> 3, rg = unit & 7, d = sc >> 4, b = (sc >> 2) & 3, h = sc & 3, c = h * 64 + n;
        const int myrow = rg * 8 + F.wave;
        const bf16* FWd = (const bf16*)(kws() + WS_FW) + (size_t)d * MALL * 256; const bf16* FAd = (const bf16*)(kws() + WS_FA) + (size_t)d * MALL * 256;
        const float kkc = kin(I_RWKK)[l * 256 + c], kac = kin(I_RWKA)[l * 256 + c];
        float s = 0.f;
        bf16 sr[4], sk_[4], sv[4], sw[4], sa[4]; float sinv[4]; float sA = 0.f, sB = 0.f;
#define SC_LOAD(ci) do { _Pragma("unroll") for (int q = 0; q < 4; ++q) { const int st = tsub + 8 * q; const int row = scan_row(d, b, (ci) * SC_TS + st); const size_t o = (size_t)row * 256 + c; \
            sr[q] = FR[o]; sk_[q] = FK[o]; sv[q] = FV[o]; sw[q] = FWd[o]; sa[q] = FAd[o]; sinv[q] = INVN[row * 4 + h]; } \
            if (F.tid < SC_TS) { const int row = scan_row(d, b, (ci) * SC_TS + F.tid); sA = AB[((size_t)row * 2 + d) * 8 + h * 2]; sB = AB[((size_t)row * 2 + d) * 8 + h * 2 + 1]; } } while (0)
#define SC_WRITE(bufi) do { LAS unsigned char* bb_ = F.lds + (bufi) * SC_BUF; _Pragma("unroll") for (int q = 0; q < 4; ++q) { const int st = tsub + 8 * q; \
            const float rq = bf2f(sr[q]), kq = bf2f(sk_[q]), aq = bf2f(sa[q]), w = 1.0f + bf2f(sw[q]); const float kk = kq * kkc * sinv[q]; \
            *(LAS f32x4*)(bb_ + SC_V4 + (st * 64 + n) * 16) = (f32x4){kk, w * rq, w, kk * aq}; \
            *(LAS float*)(bb_ + SC_V1 + (st * 64 + n) * 4) = kq * (1.0f + (aq - 1.0f) * kac); \
            *(LAS float*)(bb_ + SC_RV + (st * 64 + n) * 4) = bf2f(sv[q]); } \
            if (F.tid < SC_TS) { *(LAS float*)(bb_ + SC_AB + F.tid * 8) = sA; *(LAS float*)(bb_ + SC_AB + F.tid * 8 + 4) = sB; } } while (0)
        __syncthreads();
        SC_LOAD(0); SC_WRITE(0);
        __syncthreads();
        for (int ci = 0; ci < NCH; ++ci) {
            { const int cn_ = ci + 1 < NCH ? ci + 1 : NCH - 1; SC_LOAD(cn_); }
            LAS unsigned char* bb = F.lds + (ci & 1) * SC_BUF;
            float osk = 0.f, oq = 0.f;
#pragma unroll 1
            for (int st0 = 0; st0 < SC_TS; st0 += 8)
#pragma unroll
            for (int sj = 0; sj < 8; ++sj) { const int st = st0 + sj;
                const f32x4 cv = *(LAS f32x4*)(bb + SC_V4 + (st * 64 + n) * 16);
                const float kd = *(LAS float*)(bb + SC_V1 + (st * 64 + n) * 4);
                const float vv = *(LAS float*)(bb + SC_RV + (st * 64 + myrow) * 4);
                const float p1 = s * cv.x, p2 = s * cv.y;
                auto sw2 = __builtin_amdgcn_permlane32_swap(__float_as_uint(p1), __float_as_uint(p2), false, false);
                float x = __uint_as_float(sw2[0]) + __uint_as_float(sw2[1]);
                x = dpp_add<0xB1, 0xF>(x); x = dpp_add<0x4E, 0xF>(x); x = dpp_add<0x124, 0xF>(x); x = dpp_add<0x128, 0xF>(x);
                x = dpp_add<0x142, 0xA>(x);
                const float skv = rdlane(x, 31), qv = rdlane(x, 63);
                osk = (n == st) ? skv : osk; oq = (n == st) ? qv : oq;
                s = fmaf(s, cv.z, fmaf(-skv, cv.w, vv * kd));
            }
            const bool ctxchunk = ci < CTXL / SC_TS;
            if (!(ctxchunk && last) && n < SC_TS) {
                const float Aj = *(LAS float*)(bb + SC_AB + n * 8), Bj = *(LAS float*)(bb + SC_AB + n * 8 + 4), vj = *(LAS float*)(bb + SC_RV + (n * 64 + myrow) * 4);
                const float o = oq - osk * Aj + vj * Bj;
                const int row = scan_row(d, b, ci * SC_TS + n);
                O[(size_t)d * MALL * 256 + (size_t)row * 256 + h * 64 + myrow] = (bf16)f2bf(o);
            }
            SC_WRITE((ci + 1) & 1);
            __syncthreads();
        }
#undef SC_LOAD
#undef SC_WRITE
    }
}

__device__ __forceinline__ void rwkv_readout(const Args& A, Frame& F, int l) {
    const int gw = F.bid * NWAVES + F.wave, NGW = F.G * NWAVES, nrows = l == 0 ? MALL : MLAT;
    const int h = gw & 3, n = F.lane, c = h * 64 + n;
    const bf16* P = (const bf16*)(kws() + WS_RP); const bf16* FV = (const bf16*)(kws() + WS_FV); const bf16* O = (const bf16*)(kws() + WS_O);
    const float* BON = (const float*)(kws() + WS_BON); bf16* Y = (bf16*)(kws() + WS_XN);
    float gupr[64];
#pragma unroll
    for (int j = 0; j < 64; ++j) gupr[j] = kin(I_RWGUP)[((size_t)l * 64 + j) * 256 + c];
    const float lng = kin(I_RWLNG)[l * 256 + c], lnb = kin(I_RWLNB)[l * 256 + c];
    for (int row = gw >> 2; row < nrows; row += NGW >> 2) {
        const size_t o = (size_t)row * 256 + c;
        const float ov = bf2f(O[o]) + bf2f(O[(size_t)MALL * 256 + o]);
        const float mu = wave_sum(ov) * (1.0f / 64.0f), dv = ov - mu, var = wave_sum(dv * dv) * (1.0f / 64.0f);
        const float on = dv * rsqrtf(var + 64e-5f) * lng + lnb;
        const float sg = sigmoidf_(bf2f(P[(size_t)row * INP + C_GD + n]));
        float g = 0.f;
#pragma unroll
        for (int j = 0; j < 64; ++j) g = fmaf(rdlane(sg, j), gupr[j], g);
        const float y = (on + BON[row * 4 + h] * bf2f(FV[o])) * g;
        Y[(size_t)row * D + c] = (bf16)f2bf(y);
    }
}

struct KeyStream { int ctx_row0, nloc, loc_row0, loc_pos0; };
constexpr int AT_K = 0, AT_V = 4608, AT_BUF = 9728;
typedef float f32x4a __attribute__((ext_vector_type(4)));

template <int NMAP, int DK, int QS, bool MASK>
__device__ __forceinline__ void attn_core(Frame& F, const bf16* P, int kcol, int vcol, const KeyStream ks, const bf16x8 (&qf)[QS][NMAP][DK / 32], int qpos0,
                                          f32x4 (&o)[QS][NMAP][4], float (&m)[QS][NMAP], float (&lsum)[QS][NMAP]) {
    const int c15 = F.lane & 15, g = F.lane >> 4;
    const int sub = F.tid & 255, lkey = sub >> 3, lch = sub & 7; const bool isk = F.tid < 256;
    const int ntiles = 8 + ks.nloc;
#pragma unroll
    for (int qs = 0; qs < QS; ++qs)
#pragma unroll
        for (int mp = 0; mp < NMAP; ++mp) { m[qs][mp] = -1e30f; lsum[qs][mp] = 0.f;
#pragma unroll
            for (int dt = 0; dt < 4; ++dt) o[qs][mp][dt] = (f32x4){0.f, 0.f, 0.f, 0.f}; }
    v4u stg;
#define AT_LOAD(ti) do { const int rb_ = (ti) < 8 ? ks.ctx_row0 + 32 * (ti) : ks.loc_row0 + 32 * ((ti) - 8); \
        stg = *(const v4u*)(P + (size_t)(rb_ + lkey) * INP + (isk ? kcol : vcol) + 8 * lch); } while (0)
#define AT_WRITE(bi) do { LAS unsigned char* b_ = F.lds + (bi) * AT_BUF; \
        if (isk) *(LAS v4u*)(b_ + AT_K + lkey * 144 + lch * 16) = stg; \
        else { _Pragma("unroll") for (int i_ = 0; i_ < 8; ++i_) { const unsigned w_ = stg[i_ >> 1]; *(LAS bf16*)(b_ + AT_V + (8 * lch + i_) * 80 + lkey * 2) = (bf16)((i_ & 1) ? (w_ >> 16) : (w_ & 0xffffu)); } } } while (0)
    __syncthreads();
    AT_LOAD(0); AT_WRITE(0);
    __syncthreads();
    for (int ti = 0; ti < ntiles; ++ti) {
        { const int tn_ = ti + 1 < ntiles ? ti + 1 : ntiles - 1; AT_LOAD(tn_); }
        LAS unsigned char* bb = F.lds + (ti & 1) * AT_BUF;
        bf16x8 kf[2][NMAP][DK / 32];
#pragma unroll
        for (int kh = 0; kh < 2; ++kh)
#pragma unroll
            for (int mp = 0; mp < NMAP; ++mp)
#pragma unroll
                for (int kx = 0; kx < DK / 32; ++kx) kf[kh][mp][kx] = *(LAS bf16x8*)(bb + AT_K + (c15 + 16 * kh) * 144 + (mp * DK + 32 * kx + 8 * g) * 2);
        bf16x8 vf[4];
#pragma unroll
        for (int dt = 0; dt < 4; ++dt) { const v2u a = *(LAS v2u*)(bb + AT_V + (c15 + 16 * dt) * 80 + (4 * g) * 2), b2 = *(LAS v2u*)(bb + AT_V + (c15 + 16 * dt) * 80 + (16 + 4 * g) * 2);
            const v4u w = (v4u){a.x, a.y, b2.x, b2.y}; vf[dt] = __builtin_bit_cast(bf16x8, w); }
        const int kpos0 = ks.loc_pos0 + 32 * (ti - 8) + 4 * g;
#pragma unroll
        for (int qs = 0; qs < QS; ++qs)
#pragma unroll
            for (int mp = 0; mp < NMAP; ++mp) {
                f32x4 st[2];
#pragma unroll
                for (int kh = 0; kh < 2; ++kh) { st[kh] = (f32x4){0.f, 0.f, 0.f, 0.f};
#pragma unroll
                    for (int kx = 0; kx < DK / 32; ++kx) st[kh] = __builtin_amdgcn_mfma_f32_16x16x32_bf16(kf[kh][mp][kx], qf[qs][mp][kx], st[kh], 0, 0, 0); }
                if (MASK && ti >= 8) {
                    const int qp = qpos0 + 16 * qs + c15;
#pragma unroll
                    for (int kh = 0; kh < 2; ++kh)
#pragma unroll
                        for (int r = 0; r < 4; ++r) { const int dd = kpos0 + 16 * kh + r - qp; if (dd > 128 || dd < -128) st[kh][r] = -INFINITY; }
                }
                float mt = fmaxf(fmaxf(fmaxf(st[0][0], st[0][1]), fmaxf(st[0][2], st[0][3])), fmaxf(fmaxf(st[1][0], st[1][1]), fmaxf(st[1][2], st[1][3])));
                mt = fmaxf(mt, __shfl_xor(mt, 16)); mt = fmaxf(mt, __shfl_xor(mt, 32));
                const float mn = fmaxf(m[qs][mp], mt), alpha = __builtin_amdgcn_exp2f(m[qs][mp] - mn);
                m[qs][mp] = mn;
                float ps = 0.f; float p[8];
#pragma unroll
                for (int kh = 0; kh < 2; ++kh)
#pragma unroll
                    for (int r = 0; r < 4; ++r) { p[kh * 4 + r] = __builtin_amdgcn_exp2f(st[kh][r] - mn); ps += p[kh * 4 + r]; }
                lsum[qs][mp] = lsum[qs][mp] * alpha + ps;
                const v4u pw = (v4u){pk2(p[0], p[1]), pk2(p[2], p[3]), pk2(p[4], p[5]), pk2(p[6], p[7])};
                const bf16x8 pf = __builtin_bit_cast(bf16x8, pw);
#pragma unroll
                for (int dt = 0; dt < 4; ++dt) { o[qs][mp][dt] = o[qs][mp][dt] * alpha; o[qs][mp][dt] = __builtin_amdgcn_mfma_f32_16x16x32_bf16(vf[dt], pf, o[qs][mp][dt], 0, 0, 0); }
            }
        AT_WRITE((ti + 1) & 1);
        __syncthreads();
    }
#undef AT_LOAD
#undef AT_WRITE
}

__device__ __forceinline__ void diff_unit(const Args& A, Frame& F, int l, int b, int h, int qrow0, int nloc) {
    const bf16* P = (const bf16*)(kws() + WS_RP); bf16* Y = (bf16*)(kws() + WS_XN); const float* tab = (const float*)(kws() + WS_TAB);
    const int c15 = F.lane & 15, g = F.lane >> 4;
    bf16x8 qf[2][2][1];
#pragma unroll
    for (int qs = 0; qs < 2; ++qs)
#pragma unroll
        for (int mp = 0; mp < 2; ++mp) qf[qs][mp][0] = *(const bf16x8*)(P + (size_t)(qrow0 + 32 * F.wave + 16 * qs + c15) * INP + C_DFQ + h * 64 + mp * 32 + 8 * g);
    f32x4 o[2][2][4]; float m[2][2], ls[2][2];
    const KeyStream ks{MLAT + b * CTXL, nloc, b * SEQ, 0};
    attn_core<2, 32, 2, false>(F, P, C_DFK + h * 64, C_DFV + h * 64, ks, qf, 0, o, m, ls);
    const float lam = tab[3072 + l], oscale = 1.0f - tab[3074 + l];
    const float* ng = kin(I_DFNG) + l * 64;
#pragma unroll
    for (int qs = 0; qs < 2; ++qs) {
        float inv[2];
#pragma unroll
        for (int mp = 0; mp < 2; ++mp) { float t = ls[qs][mp]; t += __shfl_xor(t, 16); t += __shfl_xor(t, 32); inv[mp] = 1.0f / t; }
        f32x4 ov[4]; float ss = 0.f;
#pragma unroll
        for (int dt = 0; dt < 4; ++dt) { ov[dt] = o[qs][0][dt] * inv[0] - o[qs][1][dt] * (lam * inv[1]); ss += (ov[dt][0] * ov[dt][0] + ov[dt][1] * ov[dt][1]) + (ov[dt][2] * ov[dt][2] + ov[dt][3] * ov[dt][3]); }
        ss += __shfl_xor(ss, 16); ss += __shfl_xor(ss, 32);
        const float r = rsqrtf(ss * (1.0f / 64.0f) + NORM_EPS) * oscale;
        bf16* yp = Y + (size_t)(qrow0 + 32 * F.wave + 16 * qs + c15) * D + 256 + h * 64 + 4 * g;
#pragma unroll
        for (int dt = 0; dt < 4; ++dt) { const f32x4 gg = *(const f32x4*)(ng + 16 * dt + 4 * g); const f32x4 v = ov[dt] * r * gg;
            v2u w; w.x = pk2(v[0], v[1]); w.y = pk2(v[2], v[3]); *(v2u*)(yp + 16 * dt) = w; }
    }
}
__device__ __forceinline__ void gq_unit(const Args& A, Frame& F, int l, int b, int kv, int qrow0, int qpos_blk  ) {
    const bf16* P = (const bf16*)(kws() + WS_RP); bf16* Y = (bf16*)(kws() + WS_XN);
    const int c15 = F.lane & 15, g = F.lane >> 4;
    const int hq = kv * 4 + (F.wave >> 1), rbase = qrow0 + 64 * (F.wave & 1);
    bf16x8 qf[4][1][2];
#pragma unroll
    for (int qs = 0; qs < 4; ++qs)
#pragma unroll
        for (int kx = 0; kx < 2; ++kx) qf[qs][0][kx] = *(const bf16x8*)(P + (size_t)(rbase + 16 * qs + c15) * INP + C_GQQ + hq * 64 + 32 * kx + 8 * g);
    KeyStream ks{MLAT + b * CTXL, 0, 0, 0}; int qpos0 = 0;
    if (qpos_blk >= 0) { const int lo = qpos_blk > 0 ? (qpos_blk - 1) * 128 : 0, hi = qpos_blk < 31 ? (qpos_blk + 2) * 128 : SEQ;
        ks.nloc = (hi - lo) / 32; ks.loc_row0 = b * SEQ + lo; ks.loc_pos0 = lo; qpos0 = qpos_blk * 128 + 64 * (F.wave & 1); }
    f32x4 o[4][1][4]; float m[4][1], ls[4][1];
    attn_core<1, 64, 4, true>(F, P, C_GQK + kv * 64, C_GQV + kv * 64, ks, qf, qpos0, o, m, ls);
    const float sink2 = kin(I_GQSINK)[l * 8 + hq] * LOG2E;
#pragma unroll
    for (int qs = 0; qs < 4; ++qs) {
        float t = ls[qs][0]; t += __shfl_xor(t, 16); t += __shfl_xor(t, 32);
        const float mf = fmaxf(m[qs][0], sink2), e = __builtin_amdgcn_exp2f(m[qs][0] - mf), den = t * e + __builtin_amdgcn_exp2f(sink2 - mf), scl = e / den;
        bf16* yp = Y + (size_t)(rbase + 16 * qs + c15) * D + 512 + hq * 64 + 4 * g;
#pragma unroll
        for (int dt = 0; dt < 4; ++dt) { const f32x4 v = o[qs][0][dt] * scl; v2u w; w.x = pk2(v[0], v[1]); w.y = pk2(v[2], v[3]); *(v2u*)(yp + 16 * dt) = w; }
    }
}
__device__ __forceinline__ void phase_mix(const Args& A, Frame& F, int l) {
    rwkv_features(A, F, l);
    const int nunits = 512 + (l == 0 ? 32 : 0);
    for (int u = F.bid; u < nunits; u += F.G) {
        if (u < 256) { const int b = u >> 6, h = (u >> 4) & 3, qb = u & 15; diff_unit(A, F, l, b, h, b * SEQ + qb * 256, SEQ / 32); }
        else if (u < 512) { const int v = u - 256, b = v >> 6, kv = (v >> 5) & 1, nb = v & 31; gq_unit(A, F, l, b, kv, b * SEQ + nb * 128, nb); }
        else if (u < 528) { const int v = u - 512, b = v >> 2, h = v & 3; diff_unit(A, F, l, b, h, MLAT + b * CTXL, 0); }
        else { const int v = u - 528, b = v >> 2, kv = (v >> 1) & 1, hf = v & 1; gq_unit(A, F, l, b, kv, MLAT + b * CTXL + hf * 128, -1); }
    }
}

constexpr int N_PHASES = 31;
}

__global__ void __launch_bounds__(mk::NTHR, 2) mega_fwd(mk::Args A) {
    using namespace mk;
    extern __shared__ __attribute__((aligned(16))) unsigned char lds_raw[];
    Frame F;
    F.lds = (LAS unsigned char*)lds_raw;
    F.tid = threadIdx.x; asm volatile("" : "+v"(F.tid)); F.lane = F.tid & 63; F.wave = __builtin_amdgcn_readfirstlane(F.tid >> 6);
    F.G = gridDim.x; F.bid = blockIdx.x;
    for (int u = F.tid; u < (LDS_BYTES - LDSCTL_OFF) / 4; u += NTHR) ((LAS unsigned*)(F.lds + LDSCTL_OFF))[u] = 0u;
    __syncthreads();
    gu32* ctl = (gu32*)(kws() + WS_CTL);
    XcdBarrier bar; bar.bar = (unsigned*)(ctl + CW_BAR); bar.x = 0; bar.st = nullptr; bar.tid = F.tid;
    const bool multi = (A.ph_hi - A.ph_lo) > 1;
    if (multi) bar = xcd_barrier_post((unsigned*)(ctl + CW_BAR), (volatile LAS unsigned*)(F.lds + MISC_OFF) + 8, F.tid);

    for (int ph = A.ph_lo; ph < A.ph_hi; ++ph) {
        { int t_ = F.tid, l_ = F.lane, w_ = F.wave, g_ = F.G, b_ = F.bid; unsigned p_ = (unsigned)(uintptr_t)F.lds;
          w_ = __builtin_amdgcn_readfirstlane(w_); g_ = __builtin_amdgcn_readfirstlane(g_); b_ = __builtin_amdgcn_readfirstlane(b_); p_ = __builtin_amdgcn_readfirstlane(p_);
          asm volatile("" : "+v"(t_), "+v"(l_)); asm volatile("" : "+s"(w_), "+s"(g_), "+s"(b_), "+s"(p_));
          F.tid = t_; F.lane = l_; F.wave = w_; F.G = g_; F.bid = b_; F.lds = (LAS unsigned char*)(uintptr_t)p_; }
        int kind = 0, l = 0, hf = 0;
        if (ph > 0) { const int q = ph - 1; l = q / 15; const int r = q % 15; if (r < 7) kind = 1 + r; else { hf = (r - 7) >> 2; kind = 8 + ((r - 7) & 3); } }
        const int nrows = (l == 0) ? MALL : MLAT;
        const int r0 = hf ? 8192 : 0, r1 = hf ? nrows : 8192;
        const bool is_gemm = (kind == 2 || kind == 6 || kind == 8 || kind == 10);
        if (is_gemm) { if (MK_KINDS & 0x544) {
            pg8::Gemm g; EpiMulti E; E.tab = (const float*)(kws() + WS_TAB); E.ob = nullptr; E.of = nullptr; E.ld = 0; E.mode = 0;
            if (kind == 2) { g = pg8::Gemm{(const pg8::bf16_t*)(kws() + WS_XN), (const pg8::bf16_t*)(kws() + WS_WIN + l * WIN_BYTES), MALL, INP, D}; E.mode = 0; E.ob = (bf16*)(kws() + WS_RP); E.ld = INP; }
            else if (kind == 6) { g = pg8::Gemm{(const pg8::bf16_t*)(kws() + WS_XN), (const pg8::bf16_t*)(kws() + WS_WOUT + l * WOUT_BYTES), nrows, D, D}; E.mode = 1; E.of = (float*)(kws() + WS_RP); E.ld = D; }
            else if (kind == 8) { g = pg8::Gemm{(const pg8::bf16_t*)(kws() + WS_XN) + (size_t)r0 * D, (const pg8::bf16_t*)(kws() + WS_WGU + l * WGU_BYTES), r1 - r0, NGU, D}; E.mode = 2; E.ob = (bf16*)(kws() + WS_RP); E.ld = NGU; }
            else { g = pg8::Gemm{(const pg8::bf16_t*)(kws() + WS_ACT), (const pg8::bf16_t*)(kws() + WS_WD + l * WD_BYTES), r1 - r0, D, DFF}; E.mode = 1; E.of = (float*)(kws() + WS_RP); E.ld = D; }
            pg8::StaticOrder S; S.init(g.M, g.N, F.G, F.bid);
            pg8::gemm_phase<EpiMulti, pg8::StaticOrder, true, true>(F.lds, g, S, E);
        } } else {
            switch (kind) {
                case 0: if ((MK_KINDS >> 0) & 1) p0_prologue(A, F); break;
                case 1: if (((MK_KINDS >> 1) & 1) && l == 0) phase_prep(A, F); break;
                case 3: if ((MK_KINDS >> 3) & 1) phase_mix(A, F, l); break;
                case 4: if ((MK_KINDS >> 4) & 1) phase_scan(A, F, l); break;
                case 5: if ((MK_KINDS >> 5) & 1) rwkv_readout(A, F, l); break;
                case 7: if ((MK_KINDS >> 7) & 1) phase_e1(A, F, l); break;
                case 9: if ((MK_KINDS >> 9) & 1) phase_act(A, F, l, r0, r1); break;
                case 11: if ((MK_KINDS >> 11) & 1) phase_e2(A, F, l, r0, r1); break;
                default: break;
            }
        }
        if (ph + 1 < A.ph_hi) { bar.bar = (unsigned*)((gu32*)(kws() + WS_CTL) + CW_BAR); bar.tid = F.tid; xcd_barrier(bar); }
    }
}

extern "C" void kernel_launch(void* const* d_in, const int* in_sizes, int n_in, void* d_out, int out_size, void* d_ws, size_t ws_size, hipStream_t stream) {
    using namespace mk;
    static int grid = 0;
    if (grid == 0) {
        if (n_in != N_IN || out_size != MLAT * D || ws_size < WS_END) { fprintf(stderr, "kernel_launch: unexpected shapes (n_in %d, out %d, ws %zu); nothing launched\n", n_in, out_size, ws_size); grid = -1; return; }
        int dev = 0, cus = 0, per_cu = 0;
        if (hipGetDevice(&dev) != hipSuccess || hipDeviceGetAttribute(&cus, hipDeviceAttributeMultiprocessorCount, dev) != hipSuccess) { grid = -1; return; }
        if (hipFuncSetAttribute((const void*)mega_fwd, hipFuncAttributeMaxDynamicSharedMemorySize, LDS_BYTES) != hipSuccess) { fprintf(stderr, "kernel_launch: hipFuncSetAttribute failed\n"); grid = -1; return; }
        if (hipOccupancyMaxActiveBlocksPerMultiprocessor(&per_cu, (const void*)mega_fwd, NTHR, LDS_BYTES) != hipSuccess || per_cu < 1) { fprintf(stderr, "kernel_launch: occupancy query says %d blocks/CU\n", per_cu); per_cu = 1; }
        (void)hipGetLastError();
        grid = cus;
    }
    if (grid < 0) return;
    (void)hipMemsetAsync((char*)d_ws + WS_CTL, 0, CTL_ZERO_BYTES, stream);
    Args a{};
    for (int i = 0; i < N_IN; ++i) a.in[i] = (const float*)d_in[i];
    a.out = (float*)d_out; a.ws = (unsigned char*)d_ws;
#if MK_PER_PHASE
    for (int ph = 0; ph < N_PHASES; ++ph) { a.ph_lo = ph; a.ph_hi = ph + 1; hipLaunchKernelGGL(mega_fwd, dim3(grid), dim3(NTHR), LDS_BYTES, stream, a); }
#else
    a.ph_lo = 0; a.ph_hi = N_PHASES;
    void* args[] = {&a};
    hipError_t e = hipLaunchCooperativeKernel((const void*)mega_fwd, dim3(grid), dim3(NTHR), args, LDS_BYTES, stream);
    if (e != hipSuccess) fprintf(stderr, "kernel_launch: cooperative launch failed: %s (grid %d)\n", hipGetErrorString(e), grid);
#endif
}
```

```cpp
#include <hip/hip_runtime.h>
#include <hip/hip_cooperative_groups.h>
#include <cstdio>
#include <cstdint>
#ifndef MK_PER_PHASE
#define MK_PER_PHASE 0
#endif
#ifndef MK_KINDS
#define MK_KINDS 0xFFF
#endif
#ifndef MK_REPEAT
#define MK_REPEAT 0
#endif
namespace pg8 {
#define PG8_LAS __attribute__((address_space(3)))
typedef unsigned short bf16_t;
typedef short bf16x8 __attribute__((ext_vector_type(8)));
typedef float f32x4 __attribute__((ext_vector_type(4)));
typedef unsigned u32x4 __attribute__((ext_vector_type(4)));
constexpr int BM = 256, BK = 64, HALF = 128, HTB = HALF * BK * 2  , STAGE_BYTES = 8 * HTB, NXCD = 8, WGM = 8;

__host__ __device__ __forceinline__ int lds_byte(int r, int c) { const int st = (r >> 4) * 2 + (c >> 5), rr = r & 15, cc = c & 31, ob = rr * 64 + cc * 2; return st * 1024 + (ob ^ (((ob >> 9) & 1) << 5)); }
__host__ __device__ __forceinline__ void stage_rc(int b, int& R, int& C) { const int st = b / 1024, sb = b % 1024, swz = sb ^ (((sb >> 9) & 1) << 5); R = (st >> 1) * 16 + swz / 64; C = (st & 1) * 32 + (swz % 64) / 2; }
__host__ __device__ __forceinline__ int perm32(int rho) { const int n = rho >> 4, i = rho & 15; return 8 * (i >> 2) + 4 * n + (i & 3); }

__device__ __forceinline__ float pg8_zero() { float z = 0.f; asm volatile("" : "+v"(z)); return z; }
struct Unit { int pm, pn; };
struct Gemm { const bf16_t* A; const bf16_t* Bt; int M, N, K; int trows; };

struct StaticOrder {
    int nM, nN, nwg, G, c;
    __host__ __device__ void init(int M, int N, int G_, int c_) { nM = M / BM; nN = N / BM; nwg = nM * nN; G = G_; c = c_; }
    __host__ __device__ bool next(int i, Unit& u) const {
        const long L = (long)i * G + c; if (L >= nwg) return false;
        int wgid = (int)L; { const int q = nwg / NXCD, r = nwg % NXCD, xcd = wgid % NXCD, off = wgid / NXCD; wgid = (xcd < r ? xcd * (q + 1) : r * (q + 1) + (xcd - r) * q) + off; }
        const int nig = WGM * nN, gid = wgid / nig, fm = gid * WGM, gsz = (nM - fm) < WGM ? (nM - fm) : WGM;
        u.pm = fm + ((wgid % nig) % gsz); u.pn = (wgid % nig) / gsz; return true;
    }
    __device__ __forceinline__ void a_ready(const Unit&) const {}
    __device__ __forceinline__ void done(const Unit&) const {}
};

__device__ __forceinline__ unsigned cvt_pk_bf16(float lo, float hi) { unsigned r; asm volatile("v_cvt_pk_bf16_f32 %0, %1, %2" : "=v"(r) : "v"(lo), "v"(hi)); return r; }
typedef float f32x2 __attribute__((ext_vector_type(2)));
__device__ __forceinline__ f32x2 gelu_pk(f32x2 v) {
    const f32x2 av = __builtin_elementwise_abs(v), d = av * 0.2316418882f + 1.0f;
    f32x2 t; t.x = __builtin_amdgcn_rcpf(d.x); t.y = __builtin_amdgcn_rcpf(d.y);
    f32x2 q = t * 0.5307027145f + (-0.7265760135f); q = q * t + 0.7107068705f; q = q * t + (-0.142248368f); q = q * t + 0.127414796f; q = q * t;
    const f32x2 s = (v * v) * (-0.72134752044f);
    f32x2 e; e.x = __builtin_amdgcn_exp2f(s.x); e.y = __builtin_amdgcn_exp2f(s.y);
    const f32x2 m = v * (q * e), r = v - m;
    f32x2 o; o.x = v.x < 0.f ? m.x : r.x; o.y = v.y < 0.f ? m.y : r.y; return o;
}

template <int ACT  > struct EpiBf16 {
    static constexpr bool PERM = true, AFTER_DRAIN = false; static_assert(ACT == 0 || ACT == 1, "EpiBf16: ACT is 0 (none) or 1 (gelu_pk)");
    bf16_t* O; int ldc; const float* bias; int split_cols; size_t split_stride; float scale0;
    __device__ __forceinline__ void operator()(const f32x4 (&acc)[2][2][4][2], const Unit& u, int wr, int wc, int fr, int fq) const {
        const int row0 = u.pm * BM + wr * 64 + fr; int colt = u.pn * BM; bf16_t* base = O;
        float sc = 1.f; if (split_cols) { const int t = colt / split_cols; base += (size_t)t * split_stride; colt -= t * split_cols; if (t == 0) sc = scale0; }
        const int col0 = colt + wc * 32 + 8 * fq, bcol0 = u.pn * BM + wc * 32 + 8 * fq;
        f32x4 bv[2][2];
#pragma unroll
        for (int bj = 0; bj < 2; ++bj)
#pragma unroll
            for (int n = 0; n < 2; ++n) bv[bj][n] = bias ? *(const f32x4*)(bias + bcol0 + bj * HALF + 4 * n) : (f32x4){0.f, 0.f, 0.f, 0.f};
#pragma unroll
        for (int ai = 0; ai < 2; ++ai)
#pragma unroll
            for (int m = 0; m < 4; ++m) { bf16_t* rowp = base + (size_t)(row0 + ai * HALF + m * 16) * ldc + col0;
#pragma unroll
                for (int bj = 0; bj < 2; ++bj) { f32x4 v0 = acc[ai][bj][m][0] + bv[bj][0], v1 = acc[ai][bj][m][1] + bv[bj][1];
                    if (ACT == 1) { f32x2 a = gelu_pk((f32x2){v0[0], v0[1]}), b = gelu_pk((f32x2){v0[2], v0[3]}), c = gelu_pk((f32x2){v1[0], v1[1]}), d = gelu_pk((f32x2){v1[2], v1[3]});
                        v0 = (f32x4){a.x, a.y, b.x, b.y}; v1 = (f32x4){c.x, c.y, d.x, d.y}; }
                    v0 = v0 * sc; v1 = v1 * sc; u32x4 w; w.x = cvt_pk_bf16(v0[0], v0[1]); w.y = cvt_pk_bf16(v0[2], v0[3]); w.z = cvt_pk_bf16(v1[0], v1[1]); w.w = cvt_pk_bf16(v1[2], v1[3]);
                    *(u32x4*)(rowp + bj * HALF) = w; } }
    }
};

template <class Epi, class Sched, bool ALIGN_EPI = false, bool SP2 = false>
__device__ __forceinline__ void gemm_phase(PG8_LAS unsigned char* lds, const Gemm g, const Sched& S, const Epi& E, int tid_in) {
    int tid_ = tid_in; asm volatile("" : "+v"(tid_));
    const int tid = tid_, wid = __builtin_amdgcn_readfirstlane(tid >> 6), lane = tid & 63, wr = wid >> 2, wc = wid & 3, fr = lane & 15, fq = lane >> 4;
    const int K = g.K, nt = K / BK;
    unsigned voffA[2], voffB[2];
#pragma unroll
    for (int i = 0; i < 2; ++i) { int R, C; stage_rc(tid * 16 + i * 8192, R, C); const int Rb = Epi::PERM ? ((R & ~31) + perm32(R & 31)) : R;
        voffA[i] = (unsigned)(R * K + C) * 2u; voffB[i] = (unsigned)(Rb * K + C) * 2u; }
    const size_t kstep = (size_t)(BK * 2);
    const size_t hstep = (size_t)HALF * K * 2;
    const size_t tstep = 2 * hstep;
    const size_t tstepA = (size_t)g.trows * K * 2;
    const unsigned ldsw = (unsigned)wid * 1024u;
    const int aoff = lds_byte(wr * 64 + fr, fq * 8), boff = lds_byte(wc * 32 + fr, fq * 8);
#define PG8_SA(b, h) (((b) * 2 + (h)) * HTB)
#define PG8_SB(b, h) ((4 + (b) * 2 + (h)) * HTB)
#define PG8_STAGE(bufoff, gbase, voff) do { _Pragma("unroll") for (int _i = 0; _i < 2; ++_i) \
        __builtin_amdgcn_global_load_lds((const unsigned*)((const char*)(gbase) + (voff)[_i]), (PG8_LAS unsigned*)(lds + (bufoff) + ldsw + _i * 8192), 16, 0, 0); } while (0)
#define PG8_LDA(dst, b, h) do { _Pragma("unroll") for (int m = 0; m < 4; ++m) _Pragma("unroll") for (int k = 0; k < 2; ++k) dst[m][k] = *(const PG8_LAS bf16x8*)(lds + PG8_SA(b, h) + aoff + m * 2048 + k * 1024); } while (0)
#define PG8_LDB(dst, b, h) do { _Pragma("unroll") for (int n = 0; n < 2; ++n) _Pragma("unroll") for (int k = 0; k < 2; ++k) dst[n][k] = *(const PG8_LAS bf16x8*)(lds + PG8_SB(b, h) + boff + n * 2048 + k * 1024); } while (0)
#define PG8_MMA(ai, bj, At, Bt) do { __builtin_amdgcn_s_setprio(1); _Pragma("unroll") for (int m = 0; m < 4; ++m) _Pragma("unroll") for (int n = 0; n < 2; ++n) _Pragma("unroll") for (int k = 0; k < 2; ++k) \
        acc[ai][bj][m][n] = __builtin_amdgcn_mfma_f32_16x16x32_bf16(Bt[n][k], At[m][k], acc[ai][bj][m][n], 0, 0, 0); __builtin_amdgcn_s_setprio(0); } while (0)
#define PG8_WAIT_V(n) asm volatile("s_waitcnt vmcnt(" #n ")" ::: "memory")
#define PG8_WAIT_L(n) asm volatile("s_waitcnt lgkmcnt(" #n ")" ::: "memory")
#define PG8_BAR __builtin_amdgcn_s_barrier()
#define PG8_SCHED __builtin_amdgcn_sched_barrier(0)
    Unit cur, nxt; int ui = 0;
    if (!S.next(0, cur)) return;
    f32x4 acc[2][2][4][2];
#pragma unroll
    for (int a = 0; a < 2; ++a)
#pragma unroll
        for (int b = 0; b < 2; ++b)
#pragma unroll
            for (int m = 0; m < 4; ++m)
#pragma unroll
                for (int n = 0; n < 2; ++n) acc[a][b][m][n] = (f32x4){pg8_zero(), pg8_zero(), pg8_zero(), pg8_zero()};
    bf16x8 At[4][2], B0[2][2], B1[2][2];
    const char* cA = (const char*)g.A + (size_t)cur.pm * tstepA; const char* cB = (const char*)g.Bt + (size_t)cur.pn * tstep;
    S.a_ready(cur);
    if constexpr (SP2) {
        PG8_STAGE(PG8_SB(0, 0), cB, voffB); PG8_STAGE(PG8_SB(0, 1), cB + hstep, voffB); PG8_STAGE(PG8_SA(0, 0), cA, voffA); PG8_STAGE(PG8_SA(0, 1), cA + hstep, voffA);
        if (wr == 1) PG8_BAR;
        PG8_WAIT_V(2); PG8_BAR;
        PG8_STAGE(PG8_SB(1, 0), cB + kstep, voffB); PG8_STAGE(PG8_SA(1, 0), cA + kstep, voffA); PG8_STAGE(PG8_SB(1, 1), cB + hstep + kstep, voffB);
        PG8_WAIT_V(6); PG8_BAR;
    } else {
        PG8_STAGE(PG8_SB(0, 0), cB, voffB); PG8_STAGE(PG8_SA(0, 0), cA, voffA); PG8_STAGE(PG8_SB(0, 1), cB + hstep, voffB); PG8_STAGE(PG8_SA(0, 1), cA + hstep, voffA);
        if (wr == 1) PG8_BAR;
        PG8_WAIT_V(4); PG8_BAR;
        PG8_STAGE(PG8_SB(1, 0), cB + kstep, voffB); PG8_STAGE(PG8_SA(1, 0), cA + kstep, voffA); PG8_STAGE(PG8_SB(1, 1), cB + hstep + kstep, voffB);
        PG8_WAIT_V(6); PG8_BAR;
    }
    for (;;) {
        const bool has_next = S.next(ui + 1, nxt);
        const char* nA = has_next ? (const char*)g.A + (size_t)nxt.pm * tstepA : cA; const char* nB = has_next ? (const char*)g.Bt + (size_t)nxt.pn * tstep : cB;
        for (int t = 0; t < nt; t += 2) {
            const bool last = (t == nt - 2);
            const char* a1 = cA + (size_t)(t + 1) * kstep;
            const char* a2 = last ? nA : cA + (size_t)(t + 2) * kstep; const char* b2 = last ? nB : cB + (size_t)(t + 2) * kstep;
            const char* a3 = a2 + kstep; const char* b3 = b2 + kstep;
            if (last && has_next) S.a_ready(nxt);
            if constexpr (SP2) {
            PG8_LDB(B0, 0, 0); PG8_LDB(B1, 0, 1); PG8_SCHED; PG8_LDA(At, 0, 0); PG8_STAGE(PG8_SA(1, 1), a1 + hstep, voffA);
            PG8_WAIT_V(8); PG8_WAIT_L(0); PG8_BAR; PG8_MMA(0, 0, At, B0); PG8_MMA(0, 1, At, B1); PG8_BAR; PG8_SCHED;
            PG8_LDA(At, 0, 1); PG8_STAGE(PG8_SB(0, 0), b2, voffB); PG8_STAGE(PG8_SB(0, 1), b2 + hstep, voffB); PG8_STAGE(PG8_SA(0, 0), a2, voffA);
            PG8_WAIT_V(8); PG8_WAIT_L(0); PG8_BAR; PG8_MMA(1, 0, At, B0); PG8_MMA(1, 1, At, B1); PG8_BAR; PG8_SCHED;
            PG8_LDB(B0, 1, 0); PG8_LDB(B1, 1, 1); PG8_SCHED; PG8_LDA(At, 1, 0); PG8_STAGE(PG8_SA(0, 1), a2 + hstep, voffA);
            PG8_WAIT_V(8); PG8_WAIT_L(0); PG8_BAR; PG8_MMA(0, 0, At, B0); PG8_MMA(0, 1, At, B1); PG8_BAR; PG8_SCHED;
            PG8_LDA(At, 1, 1); PG8_STAGE(PG8_SB(1, 0), b3, voffB); PG8_STAGE(PG8_SB(1, 1), b3 + hstep, voffB); PG8_STAGE(PG8_SA(1, 0), a3, voffA);
            PG8_WAIT_V(8); PG8_WAIT_L(0); PG8_BAR; PG8_MMA(1, 0, At, B0); PG8_MMA(1, 1, At, B1); PG8_BAR; PG8_SCHED;
            } else {
            PG8_LDB(B0, 0, 0); PG8_SCHED; PG8_LDA(At, 0, 0); PG8_STAGE(PG8_SA(1, 1), a1 + hstep, voffA);
            PG8_WAIT_L(8); PG8_BAR; PG8_WAIT_L(0); PG8_MMA(0, 0, At, B0); PG8_BAR; PG8_SCHED;
            PG8_LDB(B1, 0, 1); PG8_STAGE(PG8_SB(0, 0), b2, voffB);
            PG8_BAR; PG8_WAIT_L(0); PG8_MMA(0, 1, At, B1); PG8_BAR;
            PG8_LDA(At, 0, 1); PG8_STAGE(PG8_SA(0, 0), a2, voffA);
            PG8_BAR; PG8_WAIT_L(0); PG8_MMA(1, 0, At, B0); PG8_BAR; PG8_SCHED;
            PG8_STAGE(PG8_SB(0, 1), b2 + hstep, voffB);
            PG8_WAIT_V(6); PG8_BAR; PG8_MMA(1, 1, At, B1); PG8_BAR;
            PG8_LDB(B0, 1, 0); PG8_SCHED; PG8_LDA(At, 1, 0); PG8_STAGE(PG8_SA(0, 1), a2 + hstep, voffA);
            PG8_WAIT_L(8); PG8_BAR; PG8_WAIT_L(0); PG8_MMA(0, 0, At, B0); PG8_BAR; PG8_SCHED;
            PG8_LDB(B1, 1, 1); PG8_STAGE(PG8_SB(1, 0), b3, voffB);
            PG8_BAR; PG8_WAIT_L(0); PG8_MMA(0, 1, At, B1); PG8_BAR;
            PG8_LDA(At, 1, 1); PG8_STAGE(PG8_SA(1, 0), a3, voffA);
            PG8_BAR; PG8_WAIT_L(0); PG8_MMA(1, 0, At, B0); PG8_BAR; PG8_SCHED;
            PG8_STAGE(PG8_SB(1, 1), b3 + hstep, voffB);
            PG8_WAIT_V(6); PG8_BAR; PG8_MMA(1, 1, At, B1); PG8_BAR;
            }
        }
        if constexpr (ALIGN_EPI) { if (wr == 0) PG8_BAR; }
        if constexpr (!Epi::AFTER_DRAIN) { E(acc, cur, wr, wc, fr, fq); S.done(cur); }
        if (!has_next) break;
#pragma unroll
        for (int a = 0; a < 2; ++a)
#pragma unroll
            for (int b = 0; b < 2; ++b)
#pragma unroll
                for (int m = 0; m < 4; ++m)
#pragma unroll
                    for (int n = 0; n < 2; ++n) acc[a][b][m][n] = (f32x4){pg8_zero(), pg8_zero(), pg8_zero(), pg8_zero()};
        cur = nxt; cA = nA; cB = nB; ++ui;
        if constexpr (ALIGN_EPI) { if (wr == 1) PG8_BAR; }
    }
    PG8_WAIT_V(0);
    if constexpr (!ALIGN_EPI) { if (wr == 0) PG8_BAR; }
    PG8_BAR;
    if constexpr (Epi::AFTER_DRAIN) { E.fused(acc, cur, wr, wc, fr, fq, lds, wid, lane); S.done(cur); }
#undef PG8_SA
#undef PG8_SB
#undef PG8_STAGE
#undef PG8_LDA
#undef PG8_LDB
#undef PG8_MMA
#undef PG8_WAIT_V
#undef PG8_WAIT_L
#undef PG8_BAR
#undef PG8_SCHED
}
}
#define GAS __attribute__((address_space(1)))
#define LAS __attribute__((address_space(3)))
typedef unsigned short bf16;
typedef unsigned v4u __attribute__((ext_vector_type(4)));
typedef float f32x4 __attribute__((ext_vector_type(4)));
typedef short bf16x8 __attribute__((ext_vector_type(8)));
typedef GAS unsigned gu32;
typedef GAS unsigned long long gu64;
#define RLX_AGENT __ATOMIC_RELAXED, __HIP_MEMORY_SCOPE_AGENT
#define LDS_WAIT() asm volatile("s_waitcnt lgkmcnt(0)" ::: "memory")
#define VM_WAIT() asm volatile("s_waitcnt vmcnt(0)" ::: "memory")
__device__ __forceinline__ unsigned long long rt() { return __builtin_amdgcn_s_memrealtime(); }
__device__ __forceinline__ unsigned f2bf(float f) { unsigned u = __builtin_bit_cast(unsigned, f); return (u + 0x7fffu + ((u >> 16) & 1u)) >> 16; }
__device__ __forceinline__ unsigned pk2(float lo, float hi) { return f2bf(lo) | (f2bf(hi) << 16); }
#define XB_TMO      128
#define XB_XCNT(j)  (256  + 64 * (j))
#define XB_XSUB(j)  (1280 + 64 * (j))
#define XB_XGEN(j)  (2304 + 64 * (j))
#define XB_TOP      3328
#define XB_TOPGEN   3392
#define XCD_BAR_WORDS 3456
#define XB_SPIN_CAP (1u << 18)

__device__ __forceinline__ unsigned xb_ld(unsigned* p)              { return __hip_atomic_load(p, __ATOMIC_RELAXED, __HIP_MEMORY_SCOPE_AGENT); }
__device__ __forceinline__ unsigned xb_add(unsigned* p, unsigned v) { return __hip_atomic_fetch_add(p, v, __ATOMIC_RELAXED, __HIP_MEMORY_SCOPE_AGENT); }
__device__ __forceinline__ unsigned xb_xcc_id() { return (unsigned)__builtin_amdgcn_s_getreg((3 << 11) | 20) & 0xFu; }
#define XB_SPIN(cond, bar) do { unsigned _sp = 0; while (cond) { __builtin_amdgcn_s_sleep(1); \
    if ((++_sp & 255u) == 0u) { if (xb_ld(&(bar)[XB_TMO])) break; if (_sp > XB_SPIN_CAP) { atomicAdd(&(bar)[XB_TMO], 1u); break; } } } } while (0)

struct XcdBarrier {
    int tid; unsigned* bar; unsigned x;
    volatile LAS unsigned* st;
};

__device__ __forceinline__ XcdBarrier xcd_barrier_post(unsigned* bar, volatile LAS unsigned* st, int tid) {
    XcdBarrier b; b.bar = bar; b.x = xb_xcc_id(); b.st = st; b.tid = tid;
    if (tid == 0) (void)xb_add(&bar[XB_XCNT(b.x)], 1u);
    return b;
}
__device__ __forceinline__ void xcd_barrier_complete(unsigned* bar, unsigned x, unsigned& nloc, unsigned& nx) {
    const unsigned G = gridDim.x * gridDim.y * gridDim.z;
    unsigned sum, cnt, mine, sp = 0u;
    for (;;) {
        sum = 0u; cnt = 0u; mine = 0u;
#pragma unroll
        for (unsigned j = 0; j < 16; ++j) { const unsigned c = xb_ld(&bar[XB_XCNT(j)]); sum += c; cnt += (c > 0u) ? 1u : 0u; mine = (j == x) ? c : mine; }
        if (sum == G) break;
        __builtin_amdgcn_s_sleep(1);
        if ((++sp & 255u) == 0u) { if (xb_ld(&bar[XB_TMO])) break; if (sp > XB_SPIN_CAP) { atomicAdd(&bar[XB_TMO], 1u); break; } }
    }
    nloc = mine > 0u ? mine : 1u; nx = cnt > 0u ? cnt : 1u;
}

__device__ __forceinline__ void xcd_barrier(const XcdBarrier& b) {
    asm volatile("s_waitcnt vmcnt(0)" ::: "memory");
    __syncthreads();
    if (b.tid == 0) {
        unsigned* bar = b.bar;
        __builtin_amdgcn_s_waitcnt(0);
        unsigned nloc = b.st[0], nx = b.st[1];
        if (nloc == 0u) { xcd_barrier_complete(bar, b.x, nloc, nx); b.st[0] = nloc; b.st[1] = nx; }
        const unsigned old = xb_add(&bar[XB_XSUB(b.x)], 1u);
        const unsigned gen = old / nloc;
        if (old + 1u == (gen + 1u) * nloc) {
            __builtin_amdgcn_fence(__ATOMIC_RELEASE, "agent");
            asm volatile("s_waitcnt vmcnt(0)" ::: "memory");
            const unsigned og = xb_add(&bar[XB_TOP], 1u);
            const unsigned tg = og / nx;
            if (og + 1u == (tg + 1u) * nx) xb_add(&bar[XB_TOPGEN], 1u);
            else XB_SPIN(xb_ld(&bar[XB_TOPGEN]) == tg, bar);
            __builtin_amdgcn_fence(__ATOMIC_ACQUIRE, "agent");
            xb_add(&bar[XB_XGEN(b.x)], 1u);
            asm volatile("s_waitcnt vmcnt(0)" ::: "memory");
        } else {
            XB_SPIN(xb_ld(&bar[XB_XGEN(b.x)]) == gen, bar);
            __builtin_amdgcn_fence(__ATOMIC_ACQUIRE, "agent");
            asm volatile("s_waitcnt vmcnt(0)" ::: "memory");
        }
    }
    __syncthreads();
}

namespace mk {
constexpr int NWAVES = 8, NTHR = 512;
constexpr int D = 1024, NBATCH = 4, SEQ = 4096, CTXL = 256;
constexpr int MLAT = NBATCH * SEQ, MCTX = NBATCH * CTXL, MALL = MLAT + MCTX;
constexpr int INW = 2496, INP = 2560, DFF = 2816, NGU = 2 * DFF;
constexpr int C_R = 0, C_K = 256, C_V = 512, C_GD = 768, C_WD = 832, C_AD = 896, C_DFQ = 960, C_DFK = 1216, C_DFV = 1472, C_GQQ = 1728, C_GQK = 2240, C_GQV = 2368;
constexpr float NORM_EPS = 1e-6f, LOG2E = 1.4426950408889634f;
constexpr float SC_DF = 0.17677669529663687f * LOG2E;
constexpr float SC_GQ = 0.125f * LOG2E;

enum { I_X = 0, I_C, I_CTX, I_CCTX, I_ADAW, I_ADAB, I_NORMG, I_WIN, I_WOUT, I_RWCONV, I_RWW0, I_RWWUP, I_RWA0, I_RWAUP, I_RWGUP, I_RWKK, I_RWKA, I_RWRK, I_RWLNG, I_RWLNB,
       I_DFLAM, I_DFNG, I_GQSINK, I_FFG, I_FFU, I_FFD, I_FFCW, I_FFCB, N_IN };

constexpr size_t MiB = 1u << 20;
constexpr size_t WS_CTL = 0, CTL_ZERO_BYTES = 1 * MiB;
constexpr int CW_BAR = 4096;
constexpr size_t WS_MOD = 1 * MiB;
constexpr size_t WS_TAB = 1 * MiB + 256 * 1024;
constexpr size_t WS_WIN = 2 * MiB, WIN_BYTES = (size_t)INP * D * 2;
constexpr size_t WS_WOUT = 12 * MiB, WOUT_BYTES = (size_t)D * D * 2;
constexpr size_t WS_WGU = 16 * MiB, WGU_BYTES = (size_t)NGU * D * 2;
constexpr size_t WS_WD = 38 * MiB, WD_BYTES = (size_t)D * DFF * 2;
constexpr size_t WS_XSC = 49 * MiB;
constexpr size_t WS_XN = 53 * MiB;
constexpr size_t WS_RP = 87 * MiB;
constexpr size_t WS_RF = 172 * MiB;
constexpr size_t FEAT1 = (size_t)MALL * 256 * 2;
constexpr size_t WS_GAL = WS_RF, WS_GBE = WS_GAL + 2 * FEAT1, WS_GKP = WS_GBE + 2 * FEAT1, WS_GRH = WS_GKP + 2 * FEAT1, WS_FV = WS_GRH + 2 * FEAT1;
constexpr size_t WS_GLT = WS_FV + FEAT1;
constexpr size_t WS_BON = WS_GLT + (size_t)2 * 272 * 256 * 4;
constexpr size_t WS_RF_END = WS_BON + (size_t)MALL * 4 * 4;
constexpr size_t WS_ACT = WS_RP;
constexpr size_t WS_FP = 181 * MiB;
constexpr size_t WS_END = 256 * MiB;
static_assert(WS_RF_END <= WS_END, "feature region");
static_assert(WS_ACT + (size_t)MALL * DFF * 2 <= WS_FP && WS_FP + (size_t)MALL * D * 4 <= WS_END, "ffn buffers");
static_assert(WS_XN + (size_t)MALL * D * 2 <= WS_RP && WS_RP + (size_t)MALL * INP * 2 <= WS_RF, "map");

constexpr int LDS_BYTES = 163840;
constexpr int LDSCTL_OFF = LDS_BYTES - 512, MISC_OFF = LDSCTL_OFF + 320;
constexpr int CW_QUEUE = 2048;

struct Args { const float* in[N_IN]; float* out; unsigned char* ws; int ph_lo, ph_hi; };


typedef const __attribute__((address_space(4))) char* kptr_t;
__device__ __forceinline__ kptr_t karg_base() { kptr_t k = (kptr_t)__builtin_amdgcn_kernarg_segment_ptr(); asm volatile("" : "+s"(k)); return k; }
__device__ __forceinline__ const float* kin(int i) { return *(const float* const __attribute__((address_space(4)))*)(karg_base() + 8 * i); }
__device__ __forceinline__ float* kout() { return *(float* const __attribute__((address_space(4)))*)(karg_base() + 8 * N_IN); }
__device__ __forceinline__ unsigned char* kws() { return *(unsigned char* const __attribute__((address_space(4)))*)(karg_base() + 8 * N_IN + 8); }

struct Frame {
    LAS unsigned char* lds;
    int tid, lane, wave, G, bid;
};

__device__ __forceinline__ float bf2f(bf16 h) { return __uint_as_float(((unsigned)h) << 16); }
template <int CTRL> __device__ __forceinline__ float dpp_mov(float x) { return __int_as_float(__builtin_amdgcn_update_dpp(0, __float_as_int(x), CTRL, 0xF, 0xF, false)); }
template <int CTRL> __device__ __forceinline__ float dpp_add(float x) { return x + dpp_mov<CTRL>(x); }
__device__ __forceinline__ float wave_sum(float v) {
    v = dpp_add<0xB1>(v); v = dpp_add<0x4E>(v); v = dpp_add<0x124>(v); v = dpp_add<0x128>(v);
    auto r = __builtin_amdgcn_permlane16_swap(__float_as_uint(v), __float_as_uint(v), false, false); v = __uint_as_float(r[0]) + __uint_as_float(r[1]);
    r = __builtin_amdgcn_permlane32_swap(__float_as_uint(v), __float_as_uint(v), false, false); return __uint_as_float(r[0]) + __uint_as_float(r[1]);
}
__device__ __forceinline__ float rdlane(float v, int l) { return __int_as_float(__builtin_amdgcn_readlane(__float_as_int(v), l)); }
__device__ __forceinline__ float sigmoidf_(float x) { return 1.0f / (1.0f + __expf(-x)); }
typedef unsigned v2u __attribute__((ext_vector_type(2)));
typedef float f32x2_t __attribute__((ext_vector_type(2))); typedef __bf16 bf16x2_t __attribute__((ext_vector_type(2)));
__device__ __forceinline__ unsigned pk2h(float lo, float hi) { f32x2_t v = {lo, hi}; bf16x2_t b = __builtin_convertvector(v, bf16x2_t); return __builtin_bit_cast(unsigned, b); }
__device__ __forceinline__ float xmax4(float v) {
    auto r = __builtin_amdgcn_permlane16_swap(__float_as_uint(v), __float_as_uint(v), false, false); v = fmaxf(__uint_as_float(r[0]), __uint_as_float(r[1]));
    r = __builtin_amdgcn_permlane32_swap(__float_as_uint(v), __float_as_uint(v), false, false); return fmaxf(__uint_as_float(r[0]), __uint_as_float(r[1]));
}

__device__ __forceinline__ void p0_transpose_item(const float* W, int K, int N, bf16* WT, int row_off, LAS float* scr, int item, int lane) {
    const int nblk = N / 32, kb = item / nblk, nb = item % nblk, k0 = 64 * kb, n0 = 32 * nb;
#pragma unroll 8
    for (int i = 0; i < 32; ++i) { const int kk = 2 * i + (lane >> 5); scr[kk * 33 + (lane & 31)] = W[(size_t)(k0 + kk) * N + n0 + (lane & 31)]; }
    LDS_WAIT(); asm volatile("" ::: "memory");
    const int c = lane & 7;
#pragma unroll
    for (int j = 0; j < 4; ++j) { const int n = (lane >> 3) + 8 * j; const LAS float* s = scr + (8 * c) * 33 + n;
        v4u o; o.x = pk2h(s[0 * 33], s[1 * 33]); o.y = pk2h(s[2 * 33], s[3 * 33]); o.z = pk2h(s[4 * 33], s[5 * 33]); o.w = pk2h(s[6 * 33], s[7 * 33]);
        *(GAS v4u*)(WT + (size_t)(row_off + n0 + n) * K + k0 + 8 * c) = o; }
    LDS_WAIT(); asm volatile("" ::: "memory");
}

__device__ __forceinline__ void p0_prologue(const Args& A, Frame& F) {
    unsigned char* ws = kws();
    {
        LAS float* sc = (LAS float*)F.lds;
        LAS float* red = (LAS float*)(F.lds + 20480);
        float* mod = (float*)(ws + WS_MOD);
        for (int u = F.bid; u < 192; u += F.G) {
            __syncthreads();
            for (int i = F.tid; i < 5 * 1024; i += NTHR) { const int bb = i >> 10, k = i & 1023; const float v = bb < 4 ? kin(I_C)[bb * 1024 + k] : kin(I_CCTX)[k]; sc[i] = v / (1.0f + __expf(-v)); }
            __syncthreads();
            const int l = u / 96, cc = u % 96, col = cc * 64 + (F.tid & 63), ks = F.tid >> 6;
            const float* w = kin(I_ADAW) + (size_t)l * 1024 * 6144 + col;
            float acc[5] = {0.f, 0.f, 0.f, 0.f, 0.f};
            for (int k = ks * 128; k < ks * 128 + 128; ++k) { const float wv = w[(size_t)k * 6144];
#pragma unroll
                for (int bb = 0; bb < 5; ++bb) acc[bb] += sc[bb * 1024 + k] * wv; }
#pragma unroll
            for (int bb = 0; bb < 5; ++bb) red[(ks * 5 + bb) * 64 + (F.tid & 63)] = acc[bb];
            __syncthreads();
            if (F.tid < 320) { const int bb = F.tid >> 6, c = F.tid & 63; float s = kin(I_ADAB)[l * 6144 + cc * 64 + c];
#pragma unroll
                for (int k8 = 0; k8 < 8; ++k8) s += red[(k8 * 5 + bb) * 64 + c];
                mod[(size_t)(l * 5 + bb) * 6144 + cc * 64 + c] = s; }
        }
        __syncthreads();
    }
    {
        LAS float* scr = (LAS float*)(F.lds + F.wave * 16384);
        const int gw = F.bid * NWAVES + F.wave, NGW = F.G * NWAVES;
        constexpr int I_IN = 16 * (INW / 32), I_OUT = 16 * 32, I_G = 16 * (DFF / 32), I_DN = (DFF / 64) * 32, I_LAYER = I_IN + I_OUT + 2 * I_G + I_DN;
        for (int it = gw; it < 2 * I_LAYER; it += NGW) {
            const int l = it / I_LAYER; int r = it % I_LAYER;
            if (r < I_IN) { p0_transpose_item(kin(I_WIN) + (size_t)l * D * INW, D, INW, (bf16*)(ws + WS_WIN + l * WIN_BYTES), 0, scr, r, F.lane); continue; } r -= I_IN;
            if (r < I_OUT) { p0_transpose_item(kin(I_WOUT) + (size_t)l * D * D, D, D, (bf16*)(ws + WS_WOUT + l * WOUT_BYTES), 0, scr, r, F.lane); continue; } r -= I_OUT;
            if (r < I_G) { const int n0 = 32 * (r % (DFF / 32)); p0_transpose_item(kin(I_FFG) + (size_t)l * D * DFF, D, DFF, (bf16*)(ws + WS_WGU + l * WGU_BYTES), 256 * (n0 >> 7) + (n0 & 127) - n0, scr, r, F.lane); continue; } r -= I_G;
            if (r < I_G) { const int n0 = 32 * (r % (DFF / 32)); p0_transpose_item(kin(I_FFU) + (size_t)l * D * DFF, D, DFF, (bf16*)(ws + WS_WGU + l * WGU_BYTES), 256 * (n0 >> 7) + (n0 & 127) - n0 + 128, scr, r, F.lane); continue; } r -= I_G;
            p0_transpose_item(kin(I_FFD) + (size_t)l * DFF * D, DFF, D, (bf16*)(ws + WS_WD + l * WD_BYTES), 0, scr, r, F.lane);
        }
        const int gt = F.bid * NTHR + F.tid, NGT = F.G * NTHR;
        for (int i = gt; i < 2 * 8192; i += NGT) { const int l = i >> 13, j = i & 8191;
            *(GAS v4u*)(ws + WS_WIN + l * WIN_BYTES + (size_t)INW * D * 2 + (size_t)j * 16) = (v4u){0u, 0u, 0u, 0u}; }
    }
    if (F.bid == 0) {
        float* tab = (float*)(ws + WS_TAB);
        for (int i = F.tid; i < 512; i += NTHR) { const int pos = i >> 3, f = i & 7; const float inv = __builtin_amdgcn_exp2f(-(float)f * (13.287712379549449f / 8.0f)), ang = (float)pos * inv; tab[i] = __cosf(ang); tab[512 + i] = __sinf(ang); }
        for (int i = F.tid; i < 1024; i += NTHR) { const int pos = i >> 4, f = i & 15; const float inv = __builtin_amdgcn_exp2f(-(float)f * (13.287712379549449f / 16.0f)), ang = (float)pos * inv; tab[1024 + i] = __cosf(ang); tab[2048 + i] = __sinf(ang); }
        if (F.tid < 2) { const int l = F.tid; const float* lv = kin(I_DFLAM) + l * 128; float s1 = 0.f, s2 = 0.f;
            for (int i = 0; i < 32; ++i) { s1 += lv[i] * lv[32 + i]; s2 += lv[64 + i] * lv[96 + i]; }
            const float lam_init = 0.8f - 0.6f * __expf(-0.3f * (float)l);
            tab[3072 + l] = __expf(s1) - __expf(s2) + lam_init; tab[3074 + l] = lam_init; }
    }
}

__device__ __forceinline__ const float* mod_vec(const Args& A, int l, int bb, int i) { return (const float*)(kws() + WS_MOD) + ((size_t)(l * 5 + bb) * 6 + i) * 1024; }
__device__ __forceinline__ const float* normg_vec(const Args& A, int l, int i) { return kin(I_NORMG) + (size_t)(l * 4 + i) * 1024; }
__device__ __forceinline__ int row_bb(int row) { return row < MLAT ? (row >> 12) : 4; }
__device__ __forceinline__ void seq_pos(int row, int& t, int& T) { if (row < MLAT) { t = row & (SEQ - 1); T = SEQ; } else { t = (row - MLAT) & (CTXL - 1); T = CTXL; } }
__device__ __forceinline__ void ld16(const float* p, int lane, f32x4 (&v)[4]) {
#pragma unroll
    for (int j = 0; j < 4; ++j) v[j] = *(const f32x4*)(p + 4 * lane + 256 * j);
}
__device__ __forceinline__ void st16(float* p, int lane, const f32x4 (&v)[4]) {
#pragma unroll
    for (int j = 0; j < 4; ++j) *(f32x4*)(p + 4 * lane + 256 * j) = v[j];
}
__device__ __forceinline__ float sumsq16(const f32x4 (&v)[4]) {
    float s = 0.f;
#pragma unroll
    for (int j = 0; j < 4; ++j) s += (v[j].x * v[j].x + v[j].y * v[j].y) + (v[j].z * v[j].z + v[j].w * v[j].w);
    return wave_sum(s);
}
__device__ __forceinline__ void norm_mod_store(const f32x4 (&v)[4], float rstd, const float* g, const float* sc, const float* sh, bf16* orow, int lane) {
#pragma unroll
    for (int j = 0; j < 4; ++j) {
        const int c = 4 * lane + 256 * j;
        const f32x4 gg = *(const f32x4*)(g + c), s1 = *(const f32x4*)(sc + c), s0 = *(const f32x4*)(sh + c);
        const f32x4 h = v[j] * rstd * gg * (s1 + 1.0f) + s0;
        v2u o; o.x = pk2h(h.x, h.y); o.y = pk2h(h.z, h.w);
        *(v2u*)(orow + c) = o;
    }
}
__device__ __forceinline__ float* xs_row(const Args& A, int row) { return row < MLAT ? kout() + (size_t)row * D : (float*)(kws() + WS_XSC) + (size_t)(row - MLAT) * D; }
__device__ __forceinline__ const float* xin_row(const Args& A, int row) { return row < MLAT ? kin(I_X) + (size_t)row * D : kin(I_CTX) + (size_t)(row - MLAT) * D; }

__device__ __forceinline__ void phase_prep(const Args& A, Frame& F) {
    const int gw = F.bid * NWAVES + F.wave, NGW = F.G * NWAVES;
    bf16* XN = (bf16*)(kws() + WS_XN);
    for (int row = gw; row < MALL; row += NGW) {
        f32x4 v[4]; ld16(xin_row(A, row), F.lane, v);
        const float rstd = rsqrtf(sumsq16(v) * (1.0f / D) + NORM_EPS);
        const int bb = row_bb(row);
        norm_mod_store(v, rstd, normg_vec(A, 0, 0), mod_vec(A, 0, bb, 1), mod_vec(A, 0, bb, 0), XN + (size_t)row * D, F.lane);
    }
}
__device__ __forceinline__ void phase_e1(const Args& A, Frame& F, int l) {
    const int gw = F.bid * NWAVES + F.wave, NGW = F.G * NWAVES, nrows = l == 0 ? MALL : MLAT;
    bf16* XN = (bf16*)(kws() + WS_XN); const float* YP = (const float*)(kws() + WS_RP);
    for (int row = gw; row < nrows; row += NGW) {
        const int bb = row_bb(row);
        f32x4 y[4], x[4]; ld16(YP + (size_t)row * D, F.lane, y);
        if (l == 0) ld16(xin_row(A, row), F.lane, x); else ld16(xs_row(A, row), F.lane, x);
        const float ry = rsqrtf(sumsq16(y) * (1.0f / D) + NORM_EPS);
        const float* g1 = normg_vec(A, l, 1); const float* ga = mod_vec(A, l, bb, 2);
#pragma unroll
        for (int j = 0; j < 4; ++j) { const int c = 4 * F.lane + 256 * j; x[j] = x[j] + *(const f32x4*)(ga + c) * (y[j] * ry * *(const f32x4*)(g1 + c)); }
        st16(xs_row(A, row), F.lane, x);
        const float rx = rsqrtf(sumsq16(x) * (1.0f / D) + NORM_EPS);
        norm_mod_store(x, rx, normg_vec(A, l, 2), mod_vec(A, l, bb, 4), mod_vec(A, l, bb, 3), XN + (size_t)row * D, F.lane);
    }
}
__device__ __forceinline__ void phase_e2(const Args& A, Frame& F, int l, int r0, int r1) {
    const int gw = F.bid * NWAVES + F.wave, NGW = F.G * NWAVES;
    bf16* XN = (bf16*)(kws() + WS_XN); const float* FP = (const float*)(kws() + WS_FP);
    for (int row = r0 + gw; row < r1; row += NGW) {
        const int bb = row_bb(row);
        f32x4 y[4], x[4]; ld16(FP + (size_t)(row - r0) * D, F.lane, y); ld16(xs_row(A, row), F.lane, x);
        const float ry = rsqrtf(sumsq16(y) * (1.0f / D) + NORM_EPS);
        const float* g3 = normg_vec(A, l, 3); const float* ga = mod_vec(A, l, bb, 5);
#pragma unroll
        for (int j = 0; j < 4; ++j) { const int c = 4 * F.lane + 256 * j; x[j] = x[j] + *(const f32x4*)(ga + c) * (y[j] * ry * *(const f32x4*)(g3 + c)); }
        st16(xs_row(A, row), F.lane, x);
        if (l == 0) {
            const float rx = rsqrtf(sumsq16(x) * (1.0f / D) + NORM_EPS);
            norm_mod_store(x, rx, normg_vec(A, 1, 0), mod_vec(A, 1, bb, 1), mod_vec(A, 1, bb, 0), XN + (size_t)row * D, F.lane);
        }
    }
}
__device__ __forceinline__ void phase_act(const Args& A, Frame& F, int l, int r0, int r1) {
    const bf16* GU = (const bf16*)(kws() + WS_RP); bf16* ACT = (bf16*)(kws() + WS_ACT);
    const float* cw = kin(I_FFCW) + (size_t)l * 3 * DFF; const float* cb = kin(I_FFCB) + (size_t)l * DFF;
    const int nch = DFF / 8, total = (r1 - r0) * nch;
    for (int i = F.bid * NTHR + F.tid; i < total; i += F.G * NTHR) {
        const int rr = i / nch, ch = i % nch, row = r0 + rr, j0 = ch * 8;
        const int t = row < MLAT ? (row & (SEQ - 1)) : ((row - MLAT) & (CTXL - 1)), T = row < MLAT ? SEQ : CTXL;
        const bf16* gp = GU + (size_t)rr * NGU + j0;
        const v4u gc = *(const v4u*)gp, uu = *(const v4u*)(gp + DFF);
        v4u gm = (v4u){0u, 0u, 0u, 0u}, gn = (v4u){0u, 0u, 0u, 0u};
        if (t > 0) gm = *(const v4u*)(gp - NGU);
        if (t < T - 1) gn = *(const v4u*)(gp + NGU);
        unsigned o[4];
#pragma unroll
        for (int q = 0; q < 4; ++q) {
            float r2[2];
#pragma unroll
            for (int e = 0; e < 2; ++e) {
                const int j = j0 + 2 * q + e;
                const float a = __uint_as_float(e ? (gm[q] & 0xffff0000u) : (gm[q] << 16)), b = __uint_as_float(e ? (gc[q] & 0xffff0000u) : (gc[q] << 16)), c = __uint_as_float(e ? (gn[q] & 0xffff0000u) : (gn[q] << 16));
                const float u = __uint_as_float(e ? (uu[q] & 0xffff0000u) : (uu[q] << 16));
                const float z = a * cw[j] + b * cw[DFF + j] + c * cw[2 * DFF + j] + cb[j];
                r2[e] = z / (1.0f + __expf(-z)) * u;
            }
            o[q] = pk2h(r2[0], r2[1]);
        }
        *(v4u*)(ACT + (size_t)rr * DFF + j0) = (v4u){o[0], o[1], o[2], o[3]};
    }
}

struct EpiMulti {
    static constexpr bool PERM = false, AFTER_DRAIN = false;
    int mode;
    bf16* ob; float* of; int ld; const float* tab;
    const float* cw; const float* cb; int nrows; unsigned ldsx;
    __device__ __forceinline__ void operator()(const pg8::f32x4 (&acc)[2][2][4][2], const pg8::Unit& u, int wr, int wc, int fr_, int fq_) const {
        int fr = fr_, fq = fq_; asm volatile("" : "+v"(fr), "+v"(fq));
        if (mode == 1) {
#pragma unroll
            for (int ai = 0; ai < 2; ++ai)
#pragma unroll
                for (int m = 0; m < 4; ++m) { float* rp = of + (size_t)(u.pm * 256 + ai * 128 + wr * 64 + m * 16 + fr) * ld + u.pn * 256 + wc * 32 + 4 * fq;
#pragma unroll
                    for (int bj = 0; bj < 2; ++bj)
#pragma unroll
                        for (int n = 0; n < 2; ++n) *(pg8::f32x4*)(rp + bj * 128 + n * 16) = acc[ai][bj][m][n]; }
        } else if (mode == 3) {
            const unsigned par = (unsigned)(u.pm + u.pn) & 1u;
            const unsigned ex = ldsx + par * 4096u + (unsigned)(wc * 32 + 4 * fq) * 4u;
#pragma unroll
            for (int ai = 0; ai < 2; ++ai)
#pragma unroll
                for (int n = 0; n < 2; ++n) {
                    if (fr == 0) *(LAS pg8::f32x4*)(uintptr_t)(ex + (unsigned)(((ai * 2 + wr) * 2 + 0) * 128 + n * 16) * 4u) = acc[ai][0][0][n];
                    if (fr == 15) *(LAS pg8::f32x4*)(uintptr_t)(ex + (unsigned)(((ai * 2 + wr) * 2 + 1) * 128 + n * 16) * 4u) = acc[ai][0][3][n];
                }
            asm volatile("s_waitcnt lgkmcnt(0)" ::: "memory"); __builtin_amdgcn_s_barrier(); asm volatile("" ::: "memory");
            const int jb = u.pn * 128 + wc * 32 + 4 * fq;
#pragma unroll
            for (int n = 0; n < 2; ++n) {
                const int j = jb + 16 * n;
                const pg8::f32x4 w0 = *(const pg8::f32x4*)(cw + j), w1 = *(const pg8::f32x4*)(cw + DFF + j), w2 = *(const pg8::f32x4*)(cw + 2 * DFF + j), bb = *(const pg8::f32x4*)(cb + j);
#pragma unroll
                for (int ai = 0; ai < 2; ++ai) {
                    const int pblk = (ai * 2 + wr) - 1, nblk = (ai * 2 + wr) + 1;
                    pg8::f32x4 eprev = (pg8::f32x4){0.f, 0.f, 0.f, 0.f}, enext = eprev;
                    if (pblk >= 0) eprev = *(LAS const pg8::f32x4*)(uintptr_t)(ex + (unsigned)((pblk * 2 + 1) * 128 + n * 16) * 4u);
                    if (nblk <= 3) enext = *(LAS const pg8::f32x4*)(uintptr_t)(ex + (unsigned)((nblk * 2 + 0) * 128 + n * 16) * 4u);
#pragma unroll
                    for (int mm = 0; mm < 4; ++mm) {
                        const int trow = ai * 128 + wr * 64 + mm * 16 + fr, grow = u.pm * 254 - 1 + trow;
                        int t, T; seq_pos(grow < 0 ? 0 : grow, t, T);
                        const pg8::f32x4 gc = acc[ai][0][mm][n], uu = acc[ai][1][mm][n];
                        pg8::f32x4 gp, gn;
#pragma unroll
                        for (int i = 0; i < 4; ++i) {
                            const float pold = mm > 0 ? __int_as_float(__builtin_amdgcn_update_dpp(0, __float_as_int(acc[ai][0][mm > 0 ? mm - 1 : 0][n][i]), 0x121, 0xF, 0xF, false)) : eprev[i];
                            gp[i] = __int_as_float(__builtin_amdgcn_update_dpp(__float_as_int(pold), __float_as_int(gc[i]), 0x111, 0xF, 0xF, false));
                            const float nold = mm < 3 ? __int_as_float(__builtin_amdgcn_update_dpp(0, __float_as_int(acc[ai][0][mm < 3 ? mm + 1 : 3][n][i]), 0x12F, 0xF, 0xF, false)) : enext[i];
                            gn[i] = __int_as_float(__builtin_amdgcn_update_dpp(__float_as_int(nold), __float_as_int(gc[i]), 0x101, 0xF, 0xF, false));
                        }
                        if (t == 0) gp = (pg8::f32x4){0.f, 0.f, 0.f, 0.f};
                        if (t == T - 1) gn = (pg8::f32x4){0.f, 0.f, 0.f, 0.f};
                        const pg8::f32x4 z = gp * w0 + gc * w1 + gn * w2 + bb;
                        pg8::f32x4 a;
#pragma unroll
                        for (int i = 0; i < 4; ++i) a[i] = z[i] / (1.0f + __expf(-z[i])) * uu[i];
                        if (trow >= 1 && trow <= 254 && grow < nrows) { v2u o; o.x = pk2h(a[0], a[1]); o.y = pk2h(a[2], a[3]); *(v2u*)(ob + (size_t)grow * DFF + j) = o; }
                    }
                }
            }
        } else if (mode == 2) {
#pragma unroll
            for (int ai = 0; ai < 2; ++ai)
#pragma unroll
                for (int m = 0; m < 4; ++m) { bf16* rp = ob + (size_t)(u.pm * 256 + ai * 128 + wr * 64 + m * 16 + fr) * ld + u.pn * 256 + wc * 32 + 4 * fq;
#pragma unroll
                    for (int bj = 0; bj < 2; ++bj)
#pragma unroll
                        for (int n = 0; n < 2; ++n) { const pg8::f32x4 v = acc[ai][bj][m][n]; v2u o; o.x = pk2h(v[0], v[1]); o.y = pk2h(v[2], v[3]); *(v2u*)(rp + bj * 128 + n * 16) = o; } }
        } else {
            const bool latent = u.pm < (MLAT / 256);
#pragma unroll
            for (int bj = 0; bj < 2; ++bj) {
                const int g32 = u.pn * 8 + bj * 4 + wc;
                if (g32 >= INW / 32) continue;
                const bool isdf = (g32 >= C_DFQ / 32 && g32 < C_DFV / 32), isgq = (g32 >= C_GQQ / 32 && g32 < C_GQV / 32);
                const float qs = (g32 >= C_DFQ / 32 && g32 < C_DFK / 32) ? SC_DF : ((g32 >= C_GQQ / 32 && g32 < C_GQK / 32) ? SC_GQ : 1.0f);
#pragma unroll
                for (int ai = 0; ai < 2; ++ai)
#pragma unroll
                    for (int m = 0; m < 4; ++m) {
                        const int row = u.pm * 256 + ai * 128 + wr * 64 + m * 16 + fr, s = row & (SEQ - 1), prow = s >> 6, pcol = s & 63;
                        pg8::f32x4 v0 = acc[ai][bj][m][0], v1 = acc[ai][bj][m][1];
                        if (isdf) {
                            pg8::f32x4 p0, p1;
#pragma unroll
                            for (int i = 0; i < 4; ++i) { p0[i] = __shfl_xor(v0[i], 32); p1[i] = __shfl_xor(v1[i], 32); }
                            if (latent) {
                                const int f0 = 4 * (fq & 1);
                                const pg8::f32x4 c0 = *(const pg8::f32x4*)(tab + prow * 8 + f0), s0 = *(const pg8::f32x4*)(tab + 512 + prow * 8 + f0);
                                const pg8::f32x4 c1 = *(const pg8::f32x4*)(tab + pcol * 8 + f0), s1 = *(const pg8::f32x4*)(tab + 512 + pcol * 8 + f0);
                                if (fq & 2) { v0 = v0 * c0 + p0 * s0; v1 = v1 * c1 + p1 * s1; } else { v0 = v0 * c0 - p0 * s0; v1 = v1 * c1 - p1 * s1; }
                            }
                        } else if (isgq) {
                            if (latent) {
                                const int pos = (g32 & 1) ? pcol : prow;
                                const pg8::f32x4 cc = *(const pg8::f32x4*)(tab + 1024 + pos * 16 + 4 * fq), ss = *(const pg8::f32x4*)(tab + 2048 + pos * 16 + 4 * fq);
                                const pg8::f32x4 a = v0 * cc - v1 * ss, b = v1 * cc + v0 * ss; v0 = a; v1 = b;
                            }
                        }
                        v0 = v0 * qs; v1 = v1 * qs;
                        bf16* rp = ob + (size_t)row * INP + g32 * 32 + 4 * fq;
                        v2u o; o.x = pk2h(v0[0], v0[1]); o.y = pk2h(v0[2], v0[3]); *(v2u*)rp = o;
                        o.x = pk2h(v1[0], v1[1]); o.y = pk2h(v1[2], v1[3]); *(v2u*)(rp + 16) = o;
                        asm volatile("" ::: "memory");
                    }
            }
        }
    }
};


template <int CTRL, int RM> __device__ __forceinline__ float dpp_mul1(float x) {
    return x * __int_as_float(__builtin_amdgcn_update_dpp(0x3f800000, __float_as_int(x), CTRL, RM, 0xF, false));
}
__device__ __forceinline__ float wave_mulscan(float x) {
    x = dpp_mul1<0x111, 0xF>(x); x = dpp_mul1<0x112, 0xF>(x); x = dpp_mul1<0x114, 0xF>(x); x = dpp_mul1<0x118, 0xF>(x);
    x = dpp_mul1<0x142, 0xA>(x); x = dpp_mul1<0x143, 0xC>(x); return x;
}
__device__ __forceinline__ float wave_shr1_one(float x) { return __int_as_float(__builtin_amdgcn_update_dpp(0x3f800000, __float_as_int(x), 0x138, 0xF, 0xF, false)); }
__device__ __forceinline__ bf16 bf1(float x) { return (bf16)(pk2h(x, 0.f) & 0xffffu); }

constexpr int FT_LD = 65, FT_ARR = 64 * FT_LD * 4;
__device__ __forceinline__ void rwkv_features(const Args& A, Frame& F, int l) {
    const int w = F.wave, n = F.lane;
    const int h = F.bid & 3, c = h * 64 + n;
    const bf16* P = (const bf16*)(kws() + WS_RP);
    bf16* FV = (bf16*)(kws() + WS_FV); float* BON = (float*)(kws() + WS_BON); float* GLT = (float*)(kws() + WS_GLT);
    float wupr[2][32], aupr[2][32], w0r[2], a0r[2], cw[3][3];
#pragma unroll
    for (int d = 0; d < 2; ++d) {
#pragma unroll
        for (int r = 0; r < 32; ++r) { wupr[d][r] = kin(I_RWWUP)[((size_t)(l * 2 + d) * 32 + r) * 256 + c]; aupr[d][r] = kin(I_RWAUP)[((size_t)(l * 2 + d) * 32 + r) * 256 + c]; }
        w0r[d] = kin(I_RWW0)[(l * 2 + d) * 256 + c]; a0r[d] = kin(I_RWA0)[(l * 2 + d) * 256 + c];
    }
#pragma unroll
    for (int tp = 0; tp < 3; ++tp)
#pragma unroll
        for (int j = 0; j < 3; ++j) cw[tp][j] = kin(I_RWCONV)[(size_t)(l * 3 + tp) * 768 + j * 256 + c];
    const float kkc = kin(I_RWKK)[l * 256 + c], kac = kin(I_RWKA)[l * 256 + c], rkc = kin(I_RWRK)[l * 256 + c];
    for (int u = F.bid; u < 4 * (MALL / 64); u += F.G) {
        const int gi = u >> 2;
        __syncthreads();
#pragma unroll 1
        for (int rr = 0; rr < 8; ++rr) {
            const int i = 8 * w + rr, row = 64 * gi + i;
            int t, T; seq_pos(row, t, T);
            const bf16* p0 = P + (size_t)row * INP;
            float xr[3], xk[3], xv[3];
#pragma unroll
            for (int tp = 0; tp < 3; ++tp) {
                const bool ok = (tp == 1) || (tp == 0 ? t > 0 : t < T - 1);
                const bf16* pp = p0 + (ptrdiff_t)(tp - 1) * INP;
                xr[tp] = ok ? bf2f(pp[C_R + c]) : 0.f; xk[tp] = ok ? bf2f(pp[C_K + c]) : 0.f; xv[tp] = ok ? bf2f(pp[C_V + c]) : 0.f;
            }
            const float rq = bf2f(bf1(xr[0] * cw[0][0] + xr[1] * cw[1][0] + xr[2] * cw[2][0])), kq = bf2f(bf1(xk[0] * cw[0][1] + xk[1] * cw[1][1] + xk[2] * cw[2][1]));
            FV[(size_t)row * 256 + c] = bf1(xv[0] * cw[0][2] + xv[1] * cw[1][2] + xv[2] * cw[2][2]);
            const float twd = 1.0f - 2.0f / (1.0f + __expf(2.0f * bf2f(p0[C_WD + n]))), xad = bf2f(p0[C_AD + n]);
            const float kkraw = kq * kkc;
            const float kk = kkraw * (1.0f / fmaxf(sqrtf(wave_sum(kkraw * kkraw)), 1e-12f));
            float bon = 0.f;
            LAS float* L = (LAS float*)F.lds + i * FT_LD + n;
#pragma unroll
            for (int d = 0; d < 2; ++d) {
                float wl = w0r[d], al = a0r[d];
#pragma unroll
                for (int r = 0; r < 32; ++r) { wl = fmaf(rdlane(twd, d * 32 + r), wupr[d][r], wl); al = fmaf(rdlane(xad, d * 32 + r), aupr[d][r], al); }
                const float wv = 1.0f + bf2f(bf1(__expf(-0.6065306597126334f * sigmoidf_(wl)) - 1.0f)), aq = bf2f(bf1(sigmoidf_(al)));
                const float kd = kq * (1.0f + (aq - 1.0f) * kac);
                L[(0 + d) * (FT_ARR / 4)] = wv; L[(3 + d) * (FT_ARR / 4)] = kk * aq; L[(5 + d) * (FT_ARR / 4)] = kd;
                bon += wave_sum(rq * kd * rkc);
            }
            L[2 * (FT_ARR / 4)] = kk; L[7 * (FT_ARR / 4)] = rq;
            if (n == 0) BON[row * 4 + h] = bon;
        }
        __syncthreads();
#pragma unroll
        for (int d = 0; d < 2; ++d) {
            const int i = d ? 63 - n : n;
            const LAS float* L = (const LAS float*)F.lds + i * FT_LD + 8 * w;
            unsigned al8[4], be8[4], kp8[4], rh8[4]; float g63[8];
#pragma unroll
            for (int e2 = 0; e2 < 4; ++e2) {
                float alv[2], bev[2], kpv[2], rhv[2];
#pragma unroll
                for (int q = 0; q < 2; ++q) { const int e = 2 * e2 + q;
                    const float gi_ = wave_mulscan(L[(0 + d) * (FT_ARR / 4) + e]), gim1 = wave_shr1_one(gi_), ig = 1.0f / gi_;
                    g63[e] = rdlane(gi_, 63);
                    alv[q] = gim1 * L[2 * (FT_ARR / 4) + e]; bev[q] = L[(3 + d) * (FT_ARR / 4) + e] * ig; kpv[q] = L[(5 + d) * (FT_ARR / 4) + e] * ig; rhv[q] = gi_ * L[7 * (FT_ARR / 4) + e]; }
                al8[e2] = pk2h(alv[0], alv[1]); be8[e2] = pk2h(bev[0], bev[1]); kp8[e2] = pk2h(kpv[0], kpv[1]); rh8[e2] = pk2h(rhv[0], rhv[1]);
            }
            const size_t o = (size_t)d * MALL * 256 + (size_t)(64 * gi + i) * 256 + h * 64 + 8 * w;
            *(v4u*)((bf16*)(kws() + WS_GAL) + o) = (v4u){al8[0], al8[1], al8[2], al8[3]}; *(v4u*)((bf16*)(kws() + WS_GBE) + o) = (v4u){be8[0], be8[1], be8[2], be8[3]};
            *(v4u*)((bf16*)(kws() + WS_GKP) + o) = (v4u){kp8[0], kp8[1], kp8[2], kp8[3]}; *(v4u*)((bf16*)(kws() + WS_GRH) + o) = (v4u){rh8[0], rh8[1], rh8[2], rh8[3]};
            if (n < 8) { float gl = g63[0];
#pragma unroll
                for (int e = 1; e < 8; ++e) gl = (n == e) ? g63[e] : gl;
                GLT[((size_t)d * 272 + gi) * 256 + h * 64 + 8 * w + n] = gl; }
        }
    }
}

__device__ __forceinline__ int scan_row(int d, int b, int i) { if (i < CTXL) { const int t = d ? CTXL - 1 - i : i; return MLAT + b * CTXL + t; } const int j = i - CTXL, t = d ? SEQ - 1 - j : j; return b * SEQ + t; }

__device__ __forceinline__ void rwkv_readout(const Args& A, Frame& F, int l) {
    const int gw = F.bid * NWAVES + F.wave, NGW = F.G * NWAVES, nrows = l == 0 ? MALL : MLAT;
    const int h = gw & 3, n = F.lane, c = h * 64 + n;
    const bf16* P = (const bf16*)(kws() + WS_RP); const bf16* FV = (const bf16*)(kws() + WS_FV);
    const float* BON = (const float*)(kws() + WS_BON); bf16* Y = (bf16*)(kws() + WS_XN);
    float gupr[64];
#pragma unroll
    for (int j = 0; j < 64; ++j) gupr[j] = kin(I_RWGUP)[((size_t)l * 64 + j) * 256 + c];
    const float lng = kin(I_RWLNG)[l * 256 + c], lnb = kin(I_RWLNB)[l * 256 + c];
    for (int row = gw >> 2; row < nrows; row += NGW >> 2) {
        const size_t o = (size_t)row * 256 + c;
        const float ov = bf2f(P[(size_t)row * INP + c]) + bf2f(P[(size_t)row * INP + 256 + c]);
        const float mu = wave_sum(ov) * (1.0f / 64.0f), dv = ov - mu, var = wave_sum(dv * dv) * (1.0f / 64.0f);
        const float on = dv * rsqrtf(var + 64e-5f) * lng + lnb;
        const float sg = sigmoidf_(bf2f(P[(size_t)row * INP + C_GD + n]));
        float g = 0.f;
#pragma unroll
        for (int j = 0; j < 64; ++j) g = fmaf(rdlane(sg, j), gupr[j], g);
        const float y = (on + BON[row * 4 + h] * bf2f(FV[o])) * g;
        Y[(size_t)row * D + c] = (bf16)f2bf(y);
    }
}


constexpr int CK_LD = 72, CK_MAT = 64 * CK_LD * 2;
enum { M_AL = 0, M_BE, M_KP, M_RH, M_BET, M_KPT, M_VT, M_AOFF, M_BM, M_MB, M_MK, M_SB, M_SB1, M_YZ, M_UT, M_COUNT };
constexpr int CK_TD = M_COUNT * CK_MAT, CK_TD_LD = 40;
constexpr int CK_ADG = CK_TD + 64 * CK_TD_LD * 2;
constexpr int CK_SEG = CK_ADG + 4096;
constexpr int CK_GL = CK_SEG + 2048;
constexpr int CK_END = CK_GL + 256;
static_assert(CK_END <= LDSCTL_OFF, "chunk scan LDS map");
struct CkAddr { unsigned vA, vB, vN, vT, v1, v1t, lds; };
#define CKP(T, addr) ((LAS T*)(uintptr_t)(addr))
template <int KS> __device__ __forceinline__ void mm2(f32x4 (&acc)[2], const CkAddr& K, int mx, int my) {
#pragma unroll
    for (int ks = 0; ks < KS; ++ks) {
        const bf16x8 a = *CKP(const bf16x8, K.vA + mx * CK_MAT + 64 * ks);
#pragma unroll
        for (int t = 0; t < 2; ++t) { const bf16x8 bq = *CKP(const bf16x8, K.vB + my * CK_MAT + t * (16 * CK_LD * 2) + 64 * ks); acc[t] = __builtin_amdgcn_mfma_f32_16x16x32_bf16(a, bq, acc[t], 0, 0, 0); }
    }
}
__device__ __forceinline__ void stN(const CkAddr& K, int mi, int t, const f32x4 v) {
#pragma unroll
    for (int r = 0; r < 4; ++r) *CKP(bf16, K.vN + mi * CK_MAT + r * (CK_LD * 2) + t * 32) = bf1(v[r]);
}
__device__ __forceinline__ void stT(const CkAddr& K, int mi, int t, const f32x4 v) {
    v2u o; o.x = pk2h(v[0], v[1]); o.y = pk2h(v[2], v[3]); *CKP(v2u, K.vT + mi * CK_MAT + t * (16 * CK_LD * 2)) = o;
}
__device__ __forceinline__ void rwkv_chunk_unit(const Args& A, Frame& F, int l, int sc) {
    const bool last = (l == 1);
    const int d = sc >> 4, b = (sc >> 2) & 3, h = sc & 3;
    const int w = F.wave, n = F.lane;
    const bf16* GAL = (const bf16*)(kws() + WS_GAL) + (size_t)d * MALL * 256; const bf16* GBE = (const bf16*)(kws() + WS_GBE) + (size_t)d * MALL * 256;
    const bf16* GKP = (const bf16*)(kws() + WS_GKP) + (size_t)d * MALL * 256; const bf16* GRH = (const bf16*)(kws() + WS_GRH) + (size_t)d * MALL * 256;
    const bf16* FV = (const bf16*)(kws() + WS_FV); const float* GLT = (const float*)(kws() + WS_GLT) + (size_t)d * 272 * 256;
    bf16* O = (bf16*)(kws() + WS_RP) + d * 256;
    v4u ual, ube, ukp, urh, uv; float fgl = 0.f;
    { const int row = scan_row(d, b, n); const size_t o = (size_t)row * 256 + h * 64 + 8 * w;
      ual = *(const v4u*)(GAL + o); ube = *(const v4u*)(GBE + o); ukp = *(const v4u*)(GKP + o); urh = *(const v4u*)(GRH + o); uv = *(const v4u*)(FV + o);
      if (n < 8) fgl = GLT[(size_t)(scan_row(d, b, 0) >> 6) * 256 + h * 64 + 8 * w + n]; }
    __syncthreads();
    for (int i = F.tid; i < CK_END / 16; i += NTHR) *(LAS v4u*)(F.lds + i * 16) = (v4u){0u, 0u, 0u, 0u};
    f32x4 st[2] = {(f32x4){0.f, 0.f, 0.f, 0.f}, (f32x4){0.f, 0.f, 0.f, 0.f}};
    __syncthreads();
    constexpr int NCK = (CTXL + SEQ) / 64;
    for (int c = 0; c < NCK; ++c) {
        const bool skip_o = last && c < CTXL / 64;
        int c15 = n & 15, g = n >> 4; asm volatile("" : "+v"(c15), "+v"(g));
        const int tr = w >> 1, tc0 = (w & 1) * 2;
        CkAddr K; K.lds = (unsigned)(uintptr_t)F.lds;
        K.vA = K.lds + ((16 * tr + c15) * CK_LD + 8 * g) * 2; K.vB = K.lds + ((16 * tc0 + c15) * CK_LD + 8 * g) * 2;
        K.vN = K.lds + ((16 * tr + 4 * g) * CK_LD + 16 * tc0 + c15) * 2; K.vT = K.lds + ((16 * tc0 + c15) * CK_LD + 16 * tr + 4 * g) * 2;
        K.v1 = K.lds + (8 * w * CK_LD + n) * 2; K.v1t = K.lds + (n * CK_LD + 8 * w) * 2;
        asm volatile("" : "+v"(K.vA), "+v"(K.vB), "+v"(K.vN), "+v"(K.vT), "+v"(K.v1), "+v"(K.v1t));
        {
            *CKP(v4u, K.v1t + M_AL * CK_MAT) = ual; *CKP(v4u, K.v1t + M_BE * CK_MAT) = ube; *CKP(v4u, K.v1t + M_KP * CK_MAT) = ukp; *CKP(v4u, K.v1t + M_RH * CK_MAT) = urh;
#pragma unroll
            for (int e = 0; e < 8; ++e) {
                *CKP(bf16, K.v1 + M_BET * CK_MAT + e * (CK_LD * 2)) = (bf16)((e & 1) ? (ube[e >> 1] >> 16) : (ube[e >> 1] & 0xffffu));
                *CKP(bf16, K.v1 + M_KPT * CK_MAT + e * (CK_LD * 2)) = (bf16)((e & 1) ? (ukp[e >> 1] >> 16) : (ukp[e >> 1] & 0xffffu));
                *CKP(bf16, K.v1 + M_VT * CK_MAT + e * (CK_LD * 2)) = (bf16)((e & 1) ? (uv[e >> 1] >> 16) : (uv[e >> 1] & 0xffffu)); }
            if (n < 8) *CKP(float, K.lds + CK_GL + (8 * w + n) * 4) = fgl;
            { const int cn = c + 1 < NCK ? c + 1 : c; const int row = scan_row(d, b, 64 * cn + n); const size_t o = (size_t)row * 256 + h * 64 + 8 * w;
              ual = *(const v4u*)(GAL + o); ube = *(const v4u*)(GBE + o); ukp = *(const v4u*)(GKP + o); urh = *(const v4u*)(GRH + o); uv = *(const v4u*)(FV + o);
              if (n < 8) fgl = GLT[(size_t)(scan_row(d, b, 64 * cn) >> 6) * 256 + h * 64 + 8 * w + n]; }
        }
        __syncthreads();
        if (tc0 <= tr) {
            f32x4 pa[2] = {(f32x4){0.f, 0.f, 0.f, 0.f}, (f32x4){0.f, 0.f, 0.f, 0.f}}, pb[2] = {pa[0], pa[0]}, pm[2] = {pa[0], pa[0]}, pk[2] = {pa[0], pa[0]};
            mm2<2>(pa, K, M_AL, M_BE); mm2<2>(pb, K, M_AL, M_KP); mm2<2>(pm, K, M_RH, M_BE); mm2<2>(pk, K, M_RH, M_KP);
#pragma unroll
            for (int t = 0; t < 2; ++t) { const int tc = tc0 + t; if (tc > tr) continue;
                f32x4 va = pa[t], vb = pb[t], vm = pm[t], vk = pk[t];
                if (tc == tr) {
#pragma unroll
                    for (int r = 0; r < 4; ++r) { const bool strict = c15 < 4 * g + r, incl = c15 <= 4 * g + r;
                        va[r] = strict ? va[r] : 0.f; vb[r] = strict ? vb[r] : 0.f; vm[r] = incl ? vm[r] : 0.f; vk[r] = incl ? vk[r] : 0.f;
                        *CKP(float, K.lds + CK_ADG + ((tr * 16 + 4 * g + r) * 16 + c15) * 4) = va[r]; }
                } else stN(K, M_AOFF, t, va);
                stN(K, M_BM, t, vb); stN(K, M_MB, t, vm); stN(K, M_MK, t, vk);
            }
        }
        __syncthreads();
        f32x4 yb[2] = {(f32x4){0.f, 0.f, 0.f, 0.f}, (f32x4){0.f, 0.f, 0.f, 0.f}}, ob[2] = {yb[0], yb[0]};
        mm2<2>(yb, K, M_BM, M_VT);
        if (!skip_o) mm2<2>(ob, K, M_MK, M_VT);
        if (w == 0) {
            const int bb_ = n >> 4, cc = n & 15; float tcol[16];
            f32x4 arow[16][4];
#pragma unroll
            for (int r = 1; r < 16; ++r)
#pragma unroll
                for (int s4 = 0; s4 * 4 < r; ++s4) arow[r][s4] = *CKP(const f32x4, K.lds + CK_ADG + ((bb_ * 16 + r) * 16 + 4 * s4) * 4);
#pragma unroll
            for (int r = 0; r < 16; ++r) { float acc = (r == cc) ? 1.f : 0.f;
#pragma unroll
                for (int s = 0; s < r; ++s) acc = fmaf(-arow[r][s >> 2][s & 3], tcol[s], acc);
                tcol[r] = acc; *CKP(bf16, K.lds + CK_TD + ((16 * bb_ + r) * CK_TD_LD + cc) * 2) = bf1(acc); }
        }
        __syncthreads();
        const int sbr = (c & 1) ? M_SB1 : M_SB, sbw = (c & 1) ? M_SB : M_SB1;
        mm2<2>(yb, K, M_AL, sbr);
        stT(K, M_YZ, 0, yb[0]); stT(K, M_YZ, 1, yb[1]);
        __syncthreads();
        if (w < 4) {
            const unsigned aX = K.lds + ((c15) * CK_LD + 8 * g) * 2;
            const unsigned bY = K.lds + ((16 * w + c15) * CK_LD + 8 * g) * 2;
            const unsigned cT = K.lds + ((16 * w + c15) * CK_LD + 4 * g) * 2;
#pragma unroll
            for (int blk = 0; blk < 4; ++blk) {
                f32x4 z = (f32x4){0.f, 0.f, 0.f, 0.f};
                if (blk > 0) {
#pragma unroll
                    for (int ks = 0; ks < (blk == 3 ? 2 : 1); ++ks) {
                        const bf16x8 a = *CKP(const bf16x8, aX + M_AOFF * CK_MAT + blk * (16 * CK_LD * 2) + 64 * ks);
                        const bf16x8 u = *CKP(const bf16x8, bY + M_UT * CK_MAT + 64 * ks);
                        z = __builtin_amdgcn_mfma_f32_16x16x32_bf16(a, u, z, 0, 0, 0); }
                }
                { const v2u yv = *CKP(const v2u, cT + M_YZ * CK_MAT + 32 * blk);
                  z[0] += __uint_as_float(yv.x << 16); z[1] += __uint_as_float(yv.x & 0xffff0000u); z[2] += __uint_as_float(yv.y << 16); z[3] += __uint_as_float(yv.y & 0xffff0000u); }
                { v2u zo; zo.x = pk2h(z[0], z[1]); zo.y = pk2h(z[2], z[3]); *CKP(v2u, cT + M_YZ * CK_MAT + 32 * blk) = zo; }
                asm volatile("s_waitcnt lgkmcnt(0)" ::: "memory");
                const bf16x8 ta = *CKP(const bf16x8, K.lds + CK_TD + ((16 * blk + c15) * CK_TD_LD + 8 * g) * 2);
                const bf16x8 zb = *CKP(const bf16x8, bY + M_YZ * CK_MAT + 32 * blk);
                f32x4 u = __builtin_amdgcn_mfma_f32_16x16x32_bf16(ta, zb, (f32x4){0.f, 0.f, 0.f, 0.f}, 0, 0, 0);
                { v2u uo; uo.x = pk2h(-u[0], -u[1]); uo.y = pk2h(-u[2], -u[3]); *CKP(v2u, cT + M_UT * CK_MAT + 32 * blk) = uo; }
                asm volatile("s_waitcnt lgkmcnt(0)" ::: "memory");
            }
        }
        __syncthreads();
        if (!skip_o) {
            mm2<2>(ob, K, M_RH, sbr); mm2<2>(ob, K, M_MB, M_UT);
#pragma unroll
            for (int r = 0; r < 4; ++r) { const int row = scan_row(d, b, 64 * c + 16 * tr + 4 * g + r);
#pragma unroll
                for (int t = 0; t < 2; ++t) O[(size_t)row * INP + h * 64 + 16 * (tc0 + t) + c15] = bf1(ob[t][r]); }
        }
        mm2<2>(st, K, M_UT, M_BET); mm2<2>(st, K, M_VT, M_KPT);
#pragma unroll
        for (int t = 0; t < 2; ++t) { const float gl = *CKP(float, K.lds + CK_GL + (16 * (tc0 + t) + c15) * 4); st[t] = st[t] * gl; stN(K, sbw, t, st[t]); }
        __syncthreads();
    }
}
#undef CKP

struct KeyStream { int ctx_row0, nloc, loc_row0, loc_pos0; };
constexpr int AT_K = 0, AT_V = 4608, AT_BUF = 9728;
typedef float f32x4a __attribute__((ext_vector_type(4)));

template <int NMAP, int DK, int QS, bool MASK>
__device__ __forceinline__ void attn_core(Frame& F, const bf16* P, int kcol, int vcol, const KeyStream ks, const bf16x8 (&qf)[QS][NMAP][DK / 32], int qpos0,
                                          f32x4 (&o)[QS][NMAP][4], float (&m)[QS][NMAP], float (&lsum)[QS][NMAP]) {
    const int c15 = F.lane & 15, g = F.lane >> 4;
    const int sub = F.tid & 255, lkey = sub >> 3, lch = sub & 7; const bool isk = F.tid < 256;
    const int ntiles = 8 + ks.nloc;
#pragma unroll
    for (int qs = 0; qs < QS; ++qs)
#pragma unroll
        for (int mp = 0; mp < NMAP; ++mp) { m[qs][mp] = 0.f; lsum[qs][mp] = 0.f;
#pragma unroll
            for (int dt = 0; dt < 4; ++dt) o[qs][mp][dt] = (f32x4){0.f, 0.f, 0.f, 0.f}; }
    bool anym[QS][NMAP];
#pragma unroll
    for (int qs = 0; qs < QS; ++qs)
#pragma unroll
        for (int mp = 0; mp < NMAP; ++mp) anym[qs][mp] = false;
    v4u stg;
#define AT_LOAD(ti) do { const int rb_ = (ti) < 8 ? ks.ctx_row0 + 32 * (ti) : ks.loc_row0 + 32 * ((ti) - 8); \
        stg = *(const v4u*)(P + (size_t)(rb_ + lkey) * INP + (isk ? kcol : vcol) + 8 * lch); } while (0)
#define AT_WRITE(bi) do { LAS unsigned char* b_ = F.lds + (bi) * AT_BUF; \
        if (isk) *(LAS v4u*)(b_ + AT_K + lkey * 144 + lch * 16) = stg; \
        else { _Pragma("unroll") for (int i_ = 0; i_ < 8; ++i_) { const unsigned w_ = stg[i_ >> 1]; *(LAS bf16*)(b_ + AT_V + (8 * lch + i_) * 80 + lkey * 2) = (bf16)((i_ & 1) ? (w_ >> 16) : (w_ & 0xffffu)); } } } while (0)
    __syncthreads();
    AT_LOAD(0); AT_WRITE(0);
    __syncthreads();
    for (int ti = 0; ti < ntiles; ++ti) {
        { const int tn_ = ti + 1 < ntiles ? ti + 1 : ntiles - 1; AT_LOAD(tn_); }
        LAS unsigned char* bb = F.lds + (ti & 1) * AT_BUF;
        bf16x8 kf[2][NMAP][DK / 32];
#pragma unroll
        for (int kh = 0; kh < 2; ++kh)
#pragma unroll
            for (int mp = 0; mp < NMAP; ++mp)
#pragma unroll
                for (int kx = 0; kx < DK / 32; ++kx) kf[kh][mp][kx] = *(LAS bf16x8*)(bb + AT_K + (c15 + 16 * kh) * 144 + (mp * DK + 32 * kx + 8 * g) * 2);
        bf16x8 vf[4];
#pragma unroll
        for (int dt = 0; dt < 4; ++dt) { const v2u a = *(LAS v2u*)(bb + AT_V + (c15 + 16 * dt) * 80 + (4 * g) * 2), b2 = *(LAS v2u*)(bb + AT_V + (c15 + 16 * dt) * 80 + (16 + 4 * g) * 2);
            const v4u w = (v4u){a.x, a.y, b2.x, b2.y}; vf[dt] = __builtin_bit_cast(bf16x8, w); }
        const int kpos0 = ks.loc_pos0 + 32 * (ti - 8) + 4 * g;
#pragma unroll
        for (int qs = 0; qs < QS; ++qs)
#pragma unroll
            for (int mp = 0; mp < NMAP; ++mp) {
                f32x4 st[2];
                if (anym[qs][mp]) { const float negm = -m[qs][mp];
#pragma unroll
                    for (int kh = 0; kh < 2; ++kh) { st[kh] = (f32x4){negm, negm, negm, negm};
#pragma unroll
                        for (int kx = 0; kx < DK / 32; ++kx) st[kh] = __builtin_amdgcn_mfma_f32_16x16x32_bf16(kf[kh][mp][kx], qf[qs][mp][kx], st[kh], 0, 0, 0); }
                } else {
#pragma unroll
                    for (int kh = 0; kh < 2; ++kh) { st[kh] = (f32x4){0.f, 0.f, 0.f, 0.f};
#pragma unroll
                        for (int kx = 0; kx < DK / 32; ++kx) st[kh] = __builtin_amdgcn_mfma_f32_16x16x32_bf16(kf[kh][mp][kx], qf[qs][mp][kx], st[kh], 0, 0, 0); }
                }
                if (MASK && ti >= 8) {
                    const int kb = ks.loc_pos0 + 32 * (ti - 8), q0 = qpos0 + 16 * qs;
                    if (kb + 31 - q0 > 128 || kb - (q0 + 15) < -128) {
                        const int qp = q0 + c15;
#pragma unroll
                        for (int kh = 0; kh < 2; ++kh)
#pragma unroll
                            for (int r = 0; r < 4; ++r) { const int dd = kpos0 + 16 * kh + r - qp; if (dd > 128 || dd < -128) st[kh][r] = -INFINITY; }
                    }
                }
                float ps = 0.f; float p[8];
#pragma unroll
                for (int kh = 0; kh < 2; ++kh)
#pragma unroll
                    for (int r = 0; r < 4; ++r) { p[kh * 4 + r] = __builtin_amdgcn_exp2f(st[kh][r]); ps += p[kh * 4 + r]; }
                if (__builtin_amdgcn_ballot_w64(!(ps < 1048576.0f)) != 0ull) {
                    float mt = fmaxf(fmaxf(fmaxf(st[0][0], st[0][1]), fmaxf(st[0][2], st[0][3])), fmaxf(fmaxf(st[1][0], st[1][1]), fmaxf(st[1][2], st[1][3])));
                    mt = xmax4(mt);
                    const float delta = fmaxf(mt, 0.f), alpha = __builtin_amdgcn_exp2f(-delta);
                    m[qs][mp] += delta; lsum[qs][mp] *= alpha; anym[qs][mp] = true;
#pragma unroll
                    for (int dt = 0; dt < 4; ++dt) o[qs][mp][dt] = o[qs][mp][dt] * alpha;
                    ps = 0.f;
#pragma unroll
                    for (int kh = 0; kh < 2; ++kh)
#pragma unroll
                        for (int r = 0; r < 4; ++r) { p[kh * 4 + r] = __builtin_amdgcn_exp2f(st[kh][r] - delta); ps += p[kh * 4 + r]; }
                }
                lsum[qs][mp] += ps;
                const v4u pw = (v4u){pk2h(p[0], p[1]), pk2h(p[2], p[3]), pk2h(p[4], p[5]), pk2h(p[6], p[7])};
                const bf16x8 pf = __builtin_bit_cast(bf16x8, pw);
#pragma unroll
                for (int dt = 0; dt < 4; ++dt) o[qs][mp][dt] = __builtin_amdgcn_mfma_f32_16x16x32_bf16(vf[dt], pf, o[qs][mp][dt], 0, 0, 0);
            }
        AT_WRITE((ti + 1) & 1);
        __syncthreads();
    }
#undef AT_LOAD
#undef AT_WRITE
}

__device__ __forceinline__ void diff_unit(const Args& A, Frame& F, int l, int b, int h, int qrow0, int nloc) {
    const bf16* P = (const bf16*)(kws() + WS_RP); bf16* Y = (bf16*)(kws() + WS_XN); const float* tab = (const float*)(kws() + WS_TAB);
    const int c15 = F.lane & 15, g = F.lane >> 4;
    bf16x8 qf[1][2][1];
#pragma unroll
    for (int qs = 0; qs < 1; ++qs)
#pragma unroll
        for (int mp = 0; mp < 2; ++mp) qf[qs][mp][0] = *(const bf16x8*)(P + (size_t)(qrow0 + 16 * F.wave + c15) * INP + C_DFQ + h * 64 + mp * 32 + 8 * g);
    f32x4 o[1][2][4]; float m[1][2], ls[1][2];
    const KeyStream ks{MLAT + b * CTXL, nloc, b * SEQ, 0};
    attn_core<2, 32, 1, false>(F, P, C_DFK + h * 64, C_DFV + h * 64, ks, qf, 0, o, m, ls);
    const float lam = tab[3072 + l], oscale = 1.0f - tab[3074 + l];
    const float* ng = kin(I_DFNG) + l * 64;
#pragma unroll
    for (int qs = 0; qs < 1; ++qs) {
        float inv[2];
#pragma unroll
        for (int mp = 0; mp < 2; ++mp) { float t = ls[qs][mp]; t += __shfl_xor(t, 16); t += __shfl_xor(t, 32); inv[mp] = 1.0f / t; }
        f32x4 ov[4]; float ss = 0.f;
#pragma unroll
        for (int dt = 0; dt < 4; ++dt) { ov[dt] = o[qs][0][dt] * inv[0] - o[qs][1][dt] * (lam * inv[1]); ss += (ov[dt][0] * ov[dt][0] + ov[dt][1] * ov[dt][1]) + (ov[dt][2] * ov[dt][2] + ov[dt][3] * ov[dt][3]); }
        ss += __shfl_xor(ss, 16); ss += __shfl_xor(ss, 32);
        const float r = rsqrtf(ss * (1.0f / 64.0f) + NORM_EPS) * oscale;
        bf16* yp = Y + (size_t)(qrow0 + 16 * F.wave + c15) * D + 256 + h * 64 + 4 * g;
#pragma unroll
        for (int dt = 0; dt < 4; ++dt) { const f32x4 gg = *(const f32x4*)(ng + 16 * dt + 4 * g); const f32x4 v = ov[dt] * r * gg;
            v2u w; w.x = pk2h(v[0], v[1]); w.y = pk2h(v[2], v[3]); *(v2u*)(yp + 16 * dt) = w; }
    }
}
__device__ __forceinline__ void gq_unit(const Args& A, Frame& F, int l, int b, int kv, int qrow0, int qpos_blk  ) {
    const bf16* P = (const bf16*)(kws() + WS_RP); bf16* Y = (bf16*)(kws() + WS_XN);
    const int c15 = F.lane & 15, g = F.lane >> 4;
    const int hq = kv * 4 + (F.wave >> 1), rbase = qrow0 + 64 * (F.wave & 1);
    bf16x8 qf[4][1][2];
#pragma unroll
    for (int qs = 0; qs < 4; ++qs)
#pragma unroll
        for (int kx = 0; kx < 2; ++kx) qf[qs][0][kx] = *(const bf16x8*)(P + (size_t)(rbase + 16 * qs + c15) * INP + C_GQQ + hq * 64 + 32 * kx + 8 * g);
    KeyStream ks{MLAT + b * CTXL, 0, 0, 0}; int qpos0 = 0;
    if (qpos_blk >= 0) { const int lo = qpos_blk > 0 ? (qpos_blk - 1) * 128 : 0, hi = qpos_blk < 31 ? (qpos_blk + 2) * 128 : SEQ;
        ks.nloc = (hi - lo) / 32; ks.loc_row0 = b * SEQ + lo; ks.loc_pos0 = lo; qpos0 = qpos_blk * 128 + 64 * (F.wave & 1); }
    f32x4 o[4][1][4]; float m[4][1], ls[4][1];
    attn_core<1, 64, 4, true>(F, P, C_GQK + kv * 64, C_GQV + kv * 64, ks, qf, qpos0, o, m, ls);
    const float sink2 = kin(I_GQSINK)[l * 8 + hq] * LOG2E;
#pragma unroll
    for (int qs = 0; qs < 4; ++qs) {
        float t = ls[qs][0]; t += __shfl_xor(t, 16); t += __shfl_xor(t, 32);
        const float mf = fmaxf(m[qs][0], sink2), e = __builtin_amdgcn_exp2f(m[qs][0] - mf), den = t * e + __builtin_amdgcn_exp2f(sink2 - mf), scl = e / den;
        bf16* yp = Y + (size_t)(rbase + 16 * qs + c15) * D + 512 + hq * 64 + 4 * g;
#pragma unroll
        for (int dt = 0; dt < 4; ++dt) { const f32x4 v = o[qs][0][dt] * scl; v2u w; w.x = pk2h(v[0], v[1]); w.y = pk2h(v[2], v[3]); *(v2u*)(yp + 16 * dt) = w; }
    }
}
__device__ __forceinline__ void phase_queue(const Args& A, Frame& F, int l) {
    gu32* head = (gu32*)(kws() + WS_CTL) + CW_QUEUE + 64 * l;
    const int total = 32 + 512 + 256 + (l == 0 ? 48 : 0);
    volatile LAS int* slot = (volatile LAS int*)(F.lds + MISC_OFF) + 16;
    for (;;) {
        asm volatile("" : "+v"(F.tid), "+v"(F.lane));
        __syncthreads();
        if (F.tid == 0) *slot = (int)__hip_atomic_fetch_add(head, 1u, __ATOMIC_RELAXED, __HIP_MEMORY_SCOPE_AGENT);
        __syncthreads();
        int u = __builtin_amdgcn_readfirstlane(*slot);
        if (u >= total) break;
        if (u < 32) { rwkv_chunk_unit(A, F, l, u); if ((MK_REPEAT >> 16) & 1) rwkv_chunk_unit(A, F, l, u); continue; }
        u -= 32;
        if (u < 512) { const int b = u >> 7, h = (u >> 5) & 3, qh = u & 31; diff_unit(A, F, l, b, h, b * SEQ + qh * 128, SEQ / 32); if ((MK_REPEAT >> 17) & 1) diff_unit(A, F, l, b, h, b * SEQ + qh * 128, SEQ / 32); continue; }
        u -= 512;
        if (u < 256) { const int b = u >> 6, kv = (u >> 5) & 1, nb = u & 31; gq_unit(A, F, l, b, kv, b * SEQ + nb * 128, nb); continue; }
        u -= 256;
        if (u < 32) { const int b = u >> 3, h = (u >> 1) & 3, hf = u & 1; diff_unit(A, F, l, b, h, MLAT + b * CTXL + hf * 128, 0); }
        else { const int v = u - 32, b = v >> 2, kv = (v >> 1) & 1, hf = v & 1; gq_unit(A, F, l, b, kv, MLAT + b * CTXL + hf * 128, -1); }
    }
}

constexpr int N_PHASES = 21;
}

__global__ void __launch_bounds__(mk::NTHR, 2) mega_fwd(mk::Args A) {
    using namespace mk;
    extern __shared__ __attribute__((aligned(16))) unsigned char lds_raw[];
    Frame F;
    F.lds = (LAS unsigned char*)lds_raw;
    F.tid = threadIdx.x; asm volatile("" : "+v"(F.tid)); F.lane = F.tid & 63; F.wave = __builtin_amdgcn_readfirstlane(F.tid >> 6);
    F.G = gridDim.x; F.bid = blockIdx.x;
    for (int u = F.tid; u < (LDS_BYTES - LDSCTL_OFF) / 4; u += NTHR) ((LAS unsigned*)(F.lds + LDSCTL_OFF))[u] = 0u;
    __syncthreads();
    gu32* ctl = (gu32*)(kws() + WS_CTL);
    XcdBarrier bar; bar.bar = (unsigned*)(ctl + CW_BAR); bar.x = 0; bar.st = nullptr; bar.tid = F.tid;
    const bool multi = (A.ph_hi - A.ph_lo) > 1;
    if (multi) bar = xcd_barrier_post((unsigned*)(ctl + CW_BAR), (volatile LAS unsigned*)(F.lds + MISC_OFF) + 8, F.tid);

    for (int ph = A.ph_lo, rep = 0; ph < A.ph_hi;) {
        { int t_ = F.tid, l_ = F.lane, w_ = F.wave, g_ = F.G, b_ = F.bid; unsigned p_ = (unsigned)(uintptr_t)F.lds;
          w_ = __builtin_amdgcn_readfirstlane(w_); g_ = __builtin_amdgcn_readfirstlane(g_); b_ = __builtin_amdgcn_readfirstlane(b_); p_ = __builtin_amdgcn_readfirstlane(p_);
          asm volatile("" : "+v"(t_), "+v"(l_)); asm volatile("" : "+s"(w_), "+s"(g_), "+s"(b_), "+s"(p_));
          F.tid = t_; F.lane = l_; F.wave = w_; F.G = g_; F.bid = b_; F.lds = (LAS unsigned char*)(uintptr_t)p_; }
        int kind = 0, l = 0, hf = 0;
        if (ph > 0) { const int q = ph - 1; l = q / 10; const int r = q % 10; kind = r < 7 ? 1 + r : (r == 7 ? 8 : (r == 8 ? 10 : 11)); }
        const int nrows = (l == 0) ? MALL : MLAT;
        const int r0 = 0, r1 = nrows; (void)hf;
        const bool is_gemm = (kind == 2 || kind == 6 || kind == 8 || kind == 10);
        if (is_gemm) { if (MK_KINDS & 0x544) {
            pg8::Gemm g; EpiMulti E; E.tab = (const float*)(kws() + WS_TAB); E.ob = nullptr; E.of = nullptr; E.ld = 0; E.mode = 0; E.cw = nullptr; E.cb = nullptr; E.nrows = 0; E.ldsx = 0u;
            if (kind == 2) { g = pg8::Gemm{(const pg8::bf16_t*)(kws() + WS_XN), (const pg8::bf16_t*)(kws() + WS_WIN + l * WIN_BYTES), MALL, INP, D, 256}; E.mode = 0; E.ob = (bf16*)(kws() + WS_RP); E.ld = INP; }
            else if (kind == 6) { g = pg8::Gemm{(const pg8::bf16_t*)(kws() + WS_XN), (const pg8::bf16_t*)(kws() + WS_WOUT + l * WOUT_BYTES), nrows, D, D, 256}; E.mode = 1; E.of = (float*)(kws() + WS_RP); E.ld = D; }
            else if (kind == 8) { const int nmu = (nrows + 253) / 254;
                g = pg8::Gemm{(const pg8::bf16_t*)(kws() + WS_XN) - D, (const pg8::bf16_t*)(kws() + WS_WGU + l * WGU_BYTES), 256 * nmu, NGU, D, 254};
                E.mode = 3; E.ob = (bf16*)(kws() + WS_ACT); E.ld = DFF; E.cw = kin(I_FFCW) + (size_t)l * 3 * DFF; E.cb = kin(I_FFCB) + (size_t)l * DFF; E.nrows = nrows; E.ldsx = (unsigned)(uintptr_t)F.lds + 131072u; }
            else { g = pg8::Gemm{(const pg8::bf16_t*)(kws() + WS_ACT), (const pg8::bf16_t*)(kws() + WS_WD + l * WD_BYTES), nrows, D, DFF, 256}; E.mode = 1; E.of = (float*)(kws() + WS_FP); E.ld = D; }
            pg8::StaticOrder S; S.init(g.M, g.N, F.G, F.bid);
            pg8::gemm_phase<EpiMulti, pg8::StaticOrder, true, true>(F.lds, g, S, E, F.tid);
        } } else {
            switch (kind) {
                case 0: if ((MK_KINDS >> 0) & 1) p0_prologue(A, F); break;
                case 1: if (((MK_KINDS >> 1) & 1) && l == 0) phase_prep(A, F); break;
                case 3: if ((MK_KINDS >> 3) & 1) rwkv_features(A, F, l); break;
                case 4: if ((MK_KINDS >> 4) & 1) phase_queue(A, F, l); break;
                case 5: if ((MK_KINDS >> 5) & 1) rwkv_readout(A, F, l); break;
                case 7: if ((MK_KINDS >> 7) & 1) phase_e1(A, F, l); break;
                case 9: if ((MK_KINDS >> 9) & 1) phase_act(A, F, l, r0, r1); break;
                case 11: if ((MK_KINDS >> 11) & 1) phase_e2(A, F, l, r0, r1); break;
                default: break;
            }
        }
        const bool again = (rep == 0) && ((MK_REPEAT >> kind) & 1);
        if (ph + 1 < A.ph_hi || again) { bar.bar = (unsigned*)((gu32*)(kws() + WS_CTL) + CW_BAR); bar.tid = F.tid; xcd_barrier(bar); }
        if (again) rep = 1; else { rep = 0; ++ph; }
    }
}

extern "C" void kernel_launch(void* const* d_in, const int* in_sizes, int n_in, void* d_out, int out_size, void* d_ws, size_t ws_size, hipStream_t stream) {
    using namespace mk;
    static int grid = 0;
    if (grid == 0) {
        if (n_in != N_IN || out_size != MLAT * D || ws_size < WS_END) { fprintf(stderr, "kernel_launch: unexpected shapes (n_in %d, out %d, ws %zu); nothing launched\n", n_in, out_size, ws_size); grid = -1; return; }
        int dev = 0, cus = 0, per_cu = 0;
        if (hipGetDevice(&dev) != hipSuccess || hipDeviceGetAttribute(&cus, hipDeviceAttributeMultiprocessorCount, dev) != hipSuccess) { grid = -1; return; }
        if (hipFuncSetAttribute((const void*)mega_fwd, hipFuncAttributeMaxDynamicSharedMemorySize, LDS_BYTES) != hipSuccess) { fprintf(stderr, "kernel_launch: hipFuncSetAttribute failed\n"); grid = -1; return; }
        if (hipOccupancyMaxActiveBlocksPerMultiprocessor(&per_cu, (const void*)mega_fwd, NTHR, LDS_BYTES) != hipSuccess || per_cu < 1) { fprintf(stderr, "kernel_launch: occupancy query says %d blocks/CU\n", per_cu); per_cu = 1; }
        (void)hipGetLastError();
        grid = cus;
    }
    if (grid < 0) return;
    (void)hipMemsetAsync((char*)d_ws + WS_CTL, 0, CTL_ZERO_BYTES, stream);
    Args a{};
    for (int i = 0; i < N_IN; ++i) a.in[i] = (const float*)d_in[i];
    a.out = (float*)d_out; a.ws = (unsigned char*)d_ws;
#if MK_PER_PHASE
    for (int ph = 0; ph < N_PHASES; ++ph) { a.ph_lo = ph; a.ph_hi = ph + 1; hipLaunchKernelGGL(mega_fwd, dim3(grid), dim3(NTHR), LDS_BYTES, stream, a); }
#else
    a.ph_lo = 0; a.ph_hi = N_PHASES;
    void* args[] = {&a};
    hipError_t e = hipLaunchCooperativeKernel((const void*)mega_fwd, dim3(grid), dim3(NTHR), args, LDS_BYTES, stream);
    if (e != hipSuccess) fprintf(stderr, "kernel_launch: cooperative launch failed: %s (grid %d)\n", hipGetErrorString(e), grid);
#endif
}
```

```cpp
#include <hip/hip_runtime.h>
#include <hip/hip_cooperative_groups.h>
#include <cstdio>
#include <cstdint>
#ifndef MK_PER_PHASE
#define MK_PER_PHASE 0
#endif
#ifndef MK_KINDS
#define MK_KINDS 0xFFF
#endif
#ifndef MK_REPEAT
#define MK_REPEAT 0
#endif
namespace pg8 {
#define PG8_LAS __attribute__((address_space(3)))
typedef unsigned short bf16_t;
typedef short bf16x8 __attribute__((ext_vector_type(8)));
typedef float f32x4 __attribute__((ext_vector_type(4)));
typedef unsigned u32x4 __attribute__((ext_vector_type(4)));
constexpr int BM = 256, BK = 64, HALF = 128, HTB = HALF * BK * 2  , STAGE_BYTES = 8 * HTB, NXCD = 8, WGM = 8;

__host__ __device__ __forceinline__ int lds_byte(int r, int c) { const int st = (r >> 4) * 2 + (c >> 5), rr = r & 15, cc = c & 31, ob = rr * 64 + cc * 2; return st * 1024 + (ob ^ (((ob >> 9) & 1) << 5)); }
__host__ __device__ __forceinline__ void stage_rc(int b, int& R, int& C) { const int st = b / 1024, sb = b % 1024, swz = sb ^ (((sb >> 9) & 1) << 5); R = (st >> 1) * 16 + swz / 64; C = (st & 1) * 32 + (swz % 64) / 2; }
__host__ __device__ __forceinline__ int perm32(int rho) { const int n = rho >> 4, i = rho & 15; return 8 * (i >> 2) + 4 * n + (i & 3); }

__device__ __forceinline__ float pg8_zero() { float z = 0.f; asm volatile("" : "+v"(z)); return z; }
struct Unit { int pm, pn; };
struct Gemm { const bf16_t* A; const bf16_t* Bt; int M, N, K; int trows; int ld, mt; };

struct StaticOrder {
    int nM, nN, nwg, G, c;
    __host__ __device__ void init(int M, int N, int G_, int c_) { nM = M / BM; nN = N / BM; nwg = nM * nN; G = G_; c = c_; }
    __host__ __device__ bool next(int i, Unit& u) const {
        const long L = (long)i * G + c; if (L >= nwg) return false;
        int wgid = (int)L; { const int q = nwg / NXCD, r = nwg % NXCD, xcd = wgid % NXCD, off = wgid / NXCD; wgid = (xcd < r ? xcd * (q + 1) : r * (q + 1) + (xcd - r) * q) + off; }
        const int nig = WGM * nN, gid = wgid / nig, fm = gid * WGM, gsz = (nM - fm) < WGM ? (nM - fm) : WGM;
        u.pm = fm + ((wgid % nig) % gsz); u.pn = (wgid % nig) / gsz; return true;
    }
    __device__ __forceinline__ void a_ready(const Unit&) const {}
    __device__ __forceinline__ void done(const Unit&) const {}
};

__device__ __forceinline__ unsigned cvt_pk_bf16(float lo, float hi) { unsigned r; asm volatile("v_cvt_pk_bf16_f32 %0, %1, %2" : "=v"(r) : "v"(lo), "v"(hi)); return r; }
typedef float f32x2 __attribute__((ext_vector_type(2)));
__device__ __forceinline__ f32x2 gelu_pk(f32x2 v) {
    const f32x2 av = __builtin_elementwise_abs(v), d = av * 0.2316418882f + 1.0f;
    f32x2 t; t.x = __builtin_amdgcn_rcpf(d.x); t.y = __builtin_amdgcn_rcpf(d.y);
    f32x2 q = t * 0.5307027145f + (-0.7265760135f); q = q * t + 0.7107068705f; q = q * t + (-0.142248368f); q = q * t + 0.127414796f; q = q * t;
    const f32x2 s = (v * v) * (-0.72134752044f);
    f32x2 e; e.x = __builtin_amdgcn_exp2f(s.x); e.y = __builtin_amdgcn_exp2f(s.y);
    const f32x2 m = v * (q * e), r = v - m;
    f32x2 o; o.x = v.x < 0.f ? m.x : r.x; o.y = v.y < 0.f ? m.y : r.y; return o;
}

template <int ACT  > struct EpiBf16 {
    static constexpr bool PERM = true, AFTER_DRAIN = false; static_assert(ACT == 0 || ACT == 1, "EpiBf16: ACT is 0 (none) or 1 (gelu_pk)");
    bf16_t* O; int ldc; const float* bias; int split_cols; size_t split_stride; float scale0;
    __device__ __forceinline__ void operator()(const f32x4 (&acc)[2][2][4][2], const Unit& u, int wr, int wc, int fr, int fq) const {
        const int row0 = u.pm * BM + wr * 64 + fr; int colt = u.pn * BM; bf16_t* base = O;
        float sc = 1.f; if (split_cols) { const int t = colt / split_cols; base += (size_t)t * split_stride; colt -= t * split_cols; if (t == 0) sc = scale0; }
        const int col0 = colt + wc * 32 + 8 * fq, bcol0 = u.pn * BM + wc * 32 + 8 * fq;
        f32x4 bv[2][2];
#pragma unroll
        for (int bj = 0; bj < 2; ++bj)
#pragma unroll
            for (int n = 0; n < 2; ++n) bv[bj][n] = bias ? *(const f32x4*)(bias + bcol0 + bj * HALF + 4 * n) : (f32x4){0.f, 0.f, 0.f, 0.f};
#pragma unroll
        for (int ai = 0; ai < 2; ++ai)
#pragma unroll
            for (int m = 0; m < 4; ++m) { bf16_t* rowp = base + (size_t)(row0 + ai * HALF + m * 16) * ldc + col0;
#pragma unroll
                for (int bj = 0; bj < 2; ++bj) { f32x4 v0 = acc[ai][bj][m][0] + bv[bj][0], v1 = acc[ai][bj][m][1] + bv[bj][1];
                    if (ACT == 1) { f32x2 a = gelu_pk((f32x2){v0[0], v0[1]}), b = gelu_pk((f32x2){v0[2], v0[3]}), c = gelu_pk((f32x2){v1[0], v1[1]}), d = gelu_pk((f32x2){v1[2], v1[3]});
                        v0 = (f32x4){a.x, a.y, b.x, b.y}; v1 = (f32x4){c.x, c.y, d.x, d.y}; }
                    v0 = v0 * sc; v1 = v1 * sc; u32x4 w; w.x = cvt_pk_bf16(v0[0], v0[1]); w.y = cvt_pk_bf16(v0[2], v0[3]); w.z = cvt_pk_bf16(v1[0], v1[1]); w.w = cvt_pk_bf16(v1[2], v1[3]);
                    *(u32x4*)(rowp + bj * HALF) = w; } }
    }
};

template <class Epi, class Sched, bool ALIGN_EPI = false, bool SP2 = false>
__device__ __forceinline__ void gemm_phase(PG8_LAS unsigned char* lds, const Gemm g, const Sched& S, const Epi& E, int tid_in) {
    int tid_ = tid_in; asm volatile("" : "+v"(tid_));
    const int tid = tid_, wid = __builtin_amdgcn_readfirstlane(tid >> 6), lane = tid & 63, wr = wid >> 2, wc = wid & 3, fr = lane & 15, fq = lane >> 4;
    const int K = g.ld, nt = g.K / BK;
    unsigned voffA[2], voffB[2];
#pragma unroll
    for (int i = 0; i < 2; ++i) { int R, C; stage_rc(tid * 16 + i * 8192, R, C); const int Rb = Epi::PERM ? ((R & ~31) + perm32(R & 31)) : R;
        voffA[i] = (unsigned)(R * K + C) * 2u; voffB[i] = (unsigned)(Rb * K + C) * 2u; }
    const size_t kstep = (size_t)(BK * 2);
    const size_t hstep = (size_t)HALF * K * 2;
    const size_t tstep = 2 * hstep;
    const size_t tstepA = (size_t)g.trows * K * 2;
    const unsigned ldsw = (unsigned)wid * 1024u;
    const int aoff = lds_byte(wr * 64 + fr, fq * 8), boff = lds_byte(wc * 32 + fr, fq * 8);
#define PG8_SA(b, h) (((b) * 2 + (h)) * HTB)
#define PG8_SB(b, h) ((4 + (b) * 2 + (h)) * HTB)
#define PG8_STAGE(bufoff, gbase, voff) do { _Pragma("unroll") for (int _i = 0; _i < 2; ++_i) \
        __builtin_amdgcn_global_load_lds((const unsigned*)((const char*)(gbase) + (voff)[_i]), (PG8_LAS unsigned*)(lds + (bufoff) + ldsw + _i * 8192), 16, 0, 0); } while (0)
#define PG8_LDA(dst, b, h) do { _Pragma("unroll") for (int m = 0; m < 4; ++m) _Pragma("unroll") for (int k = 0; k < 2; ++k) dst[m][k] = *(const PG8_LAS bf16x8*)(lds + PG8_SA(b, h) + aoff + m * 2048 + k * 1024); } while (0)
#define PG8_LDB(dst, b, h) do { _Pragma("unroll") for (int n = 0; n < 2; ++n) _Pragma("unroll") for (int k = 0; k < 2; ++k) dst[n][k] = *(const PG8_LAS bf16x8*)(lds + PG8_SB(b, h) + boff + n * 2048 + k * 1024); } while (0)
#define PG8_MMA(ai, bj, At, Bt) do { __builtin_amdgcn_s_setprio(1); _Pragma("unroll") for (int m = 0; m < 4; ++m) _Pragma("unroll") for (int n = 0; n < 2; ++n) _Pragma("unroll") for (int k = 0; k < 2; ++k) \
        acc[ai][bj][m][n] = __builtin_amdgcn_mfma_f32_16x16x32_bf16(Bt[n][k], At[m][k], acc[ai][bj][m][n], 0, 0, 0); __builtin_amdgcn_s_setprio(0); } while (0)
#define PG8_WAIT_V(n) asm volatile("s_waitcnt vmcnt(" #n ")" ::: "memory")
#define PG8_WAIT_L(n) asm volatile("s_waitcnt lgkmcnt(" #n ")" ::: "memory")
#define PG8_BAR __builtin_amdgcn_s_barrier()
#define PG8_SCHED __builtin_amdgcn_sched_barrier(0)
    Unit cur, nxt; int ui = 0;
    if (!S.next(0, cur)) return;
    f32x4 acc[2][2][4][2];
#pragma unroll
    for (int a = 0; a < 2; ++a)
#pragma unroll
        for (int b = 0; b < 2; ++b)
#pragma unroll
            for (int m = 0; m < 4; ++m)
#pragma unroll
                for (int n = 0; n < 2; ++n) acc[a][b][m][n] = (f32x4){pg8_zero(), pg8_zero(), pg8_zero(), pg8_zero()};
    bf16x8 At[4][2], B0[2][2], B1[2][2];
#define PG8_BASEA(un) ((const char*)g.A + (size_t)(g.mt ? (un).pm % g.mt : (un).pm) * tstepA + (g.mt ? (size_t)((un).pm / g.mt) * g.K * 2 : 0))
#define PG8_BASEB(un) ((const char*)g.Bt + (size_t)(un).pn * tstep + (g.mt ? (size_t)((un).pm / g.mt) * g.K * 2 : 0))
    const char* cA = PG8_BASEA(cur); const char* cB = PG8_BASEB(cur);
    S.a_ready(cur);
    if constexpr (SP2) {
        PG8_STAGE(PG8_SB(0, 0), cB, voffB); PG8_STAGE(PG8_SB(0, 1), cB + hstep, voffB); PG8_STAGE(PG8_SA(0, 0), cA, voffA); PG8_STAGE(PG8_SA(0, 1), cA + hstep, voffA);
        if (wr == 1) PG8_BAR;
        PG8_WAIT_V(2); PG8_BAR;
        PG8_STAGE(PG8_SB(1, 0), cB + kstep, voffB); PG8_STAGE(PG8_SA(1, 0), cA + kstep, voffA); PG8_STAGE(PG8_SB(1, 1), cB + hstep + kstep, voffB);
        PG8_WAIT_V(6); PG8_BAR;
    } else {
        PG8_STAGE(PG8_SB(0, 0), cB, voffB); PG8_STAGE(PG8_SA(0, 0), cA, voffA); PG8_STAGE(PG8_SB(0, 1), cB + hstep, voffB); PG8_STAGE(PG8_SA(0, 1), cA + hstep, voffA);
        if (wr == 1) PG8_BAR;
        PG8_WAIT_V(4); PG8_BAR;
        PG8_STAGE(PG8_SB(1, 0), cB + kstep, voffB); PG8_STAGE(PG8_SA(1, 0), cA + kstep, voffA); PG8_STAGE(PG8_SB(1, 1), cB + hstep + kstep, voffB);
        PG8_WAIT_V(6); PG8_BAR;
    }
    for (;;) {
        const bool has_next = S.next(ui + 1, nxt);
        const char* nA = has_next ? PG8_BASEA(nxt) : cA; const char* nB = has_next ? PG8_BASEB(nxt) : cB;
        for (int t = 0; t < nt; t += 2) {
            const bool last = (t == nt - 2);
            const char* a1 = cA + (size_t)(t + 1) * kstep;
            const char* a2 = last ? nA : cA + (size_t)(t + 2) * kstep; const char* b2 = last ? nB : cB + (size_t)(t + 2) * kstep;
            const char* a3 = a2 + kstep; const char* b3 = b2 + kstep;
            if (last && has_next) S.a_ready(nxt);
            if constexpr (SP2) {
            PG8_LDB(B0, 0, 0); PG8_LDB(B1, 0, 1); PG8_SCHED; PG8_LDA(At, 0, 0); PG8_STAGE(PG8_SA(1, 1), a1 + hstep, voffA);
            PG8_WAIT_V(8); PG8_WAIT_L(0); PG8_BAR; PG8_MMA(0, 0, At, B0); PG8_MMA(0, 1, At, B1); PG8_BAR; PG8_SCHED;
            PG8_LDA(At, 0, 1); PG8_STAGE(PG8_SB(0, 0), b2, voffB); PG8_STAGE(PG8_SB(0, 1), b2 + hstep, voffB); PG8_STAGE(PG8_SA(0, 0), a2, voffA);
            PG8_WAIT_V(8); PG8_WAIT_L(0); PG8_BAR; PG8_MMA(1, 0, At, B0); PG8_MMA(1, 1, At, B1); PG8_BAR; PG8_SCHED;
            PG8_LDB(B0, 1, 0); PG8_LDB(B1, 1, 1); PG8_SCHED; PG8_LDA(At, 1, 0); PG8_STAGE(PG8_SA(0, 1), a2 + hstep, voffA);
            PG8_WAIT_V(8); PG8_WAIT_L(0); PG8_BAR; PG8_MMA(0, 0, At, B0); PG8_MMA(0, 1, At, B1); PG8_BAR; PG8_SCHED;
            PG8_LDA(At, 1, 1); PG8_STAGE(PG8_SB(1, 0), b3, voffB); PG8_STAGE(PG8_SB(1, 1), b3 + hstep, voffB); PG8_STAGE(PG8_SA(1, 0), a3, voffA);
            PG8_WAIT_V(8); PG8_WAIT_L(0); PG8_BAR; PG8_MMA(1, 0, At, B0); PG8_MMA(1, 1, At, B1); PG8_BAR; PG8_SCHED;
            } else {
            PG8_LDB(B0, 0, 0); PG8_SCHED; PG8_LDA(At, 0, 0); PG8_STAGE(PG8_SA(1, 1), a1 + hstep, voffA);
            PG8_WAIT_L(8); PG8_BAR; PG8_WAIT_L(0); PG8_MMA(0, 0, At, B0); PG8_BAR; PG8_SCHED;
            PG8_LDB(B1, 0, 1); PG8_STAGE(PG8_SB(0, 0), b2, voffB);
            PG8_BAR; PG8_WAIT_L(0); PG8_MMA(0, 1, At, B1); PG8_BAR;
            PG8_LDA(At, 0, 1); PG8_STAGE(PG8_SA(0, 0), a2, voffA);
            PG8_BAR; PG8_WAIT_L(0); PG8_MMA(1, 0, At, B0); PG8_BAR; PG8_SCHED;
            PG8_STAGE(PG8_SB(0, 1), b2 + hstep, voffB);
            PG8_WAIT_V(6); PG8_BAR; PG8_MMA(1, 1, At, B1); PG8_BAR;
            PG8_LDB(B0, 1, 0); PG8_SCHED; PG8_LDA(At, 1, 0); PG8_STAGE(PG8_SA(0, 1), a2 + hstep, voffA);
            PG8_WAIT_L(8); PG8_BAR; PG8_WAIT_L(0); PG8_MMA(0, 0, At, B0); PG8_BAR; PG8_SCHED;
            PG8_LDB(B1, 1, 1); PG8_STAGE(PG8_SB(1, 0), b3, voffB);
            PG8_BAR; PG8_WAIT_L(0); PG8_MMA(0, 1, At, B1); PG8_BAR;
            PG8_LDA(At, 1, 1); PG8_STAGE(PG8_SA(1, 0), a3, voffA);
            PG8_BAR; PG8_WAIT_L(0); PG8_MMA(1, 0, At, B0); PG8_BAR; PG8_SCHED;
            PG8_STAGE(PG8_SB(1, 1), b3 + hstep, voffB);
            PG8_WAIT_V(6); PG8_BAR; PG8_MMA(1, 1, At, B1); PG8_BAR;
            }
        }
        if constexpr (ALIGN_EPI) { if (wr == 0) PG8_BAR; }
        if constexpr (!Epi::AFTER_DRAIN) { E(acc, cur, wr, wc, fr, fq); S.done(cur); }
        if (!has_next) break;
#pragma unroll
        for (int a = 0; a < 2; ++a)
#pragma unroll
            for (int b = 0; b < 2; ++b)
#pragma unroll
                for (int m = 0; m < 4; ++m)
#pragma unroll
                    for (int n = 0; n < 2; ++n) acc[a][b][m][n] = (f32x4){pg8_zero(), pg8_zero(), pg8_zero(), pg8_zero()};
        cur = nxt; cA = nA; cB = nB; ++ui;
        if constexpr (ALIGN_EPI) { if (wr == 1) PG8_BAR; }
    }
    PG8_WAIT_V(0);
    if constexpr (!ALIGN_EPI) { if (wr == 0) PG8_BAR; }
    PG8_BAR;
    if constexpr (Epi::AFTER_DRAIN) { E.fused(acc, cur, wr, wc, fr, fq, lds, wid, lane); S.done(cur); }
#undef PG8_BASEA
#undef PG8_BASEB
#undef PG8_SA
#undef PG8_SB
#undef PG8_STAGE
#undef PG8_LDA
#undef PG8_LDB
#undef PG8_MMA
#undef PG8_WAIT_V
#undef PG8_WAIT_L
#undef PG8_BAR
#undef PG8_SCHED
}
}
#define GAS __attribute__((address_space(1)))
#define LAS __attribute__((address_space(3)))
typedef unsigned short bf16;
typedef unsigned v4u __attribute__((ext_vector_type(4)));
typedef float f32x4 __attribute__((ext_vector_type(4)));
typedef short bf16x8 __attribute__((ext_vector_type(8)));
typedef GAS unsigned gu32;
typedef GAS unsigned long long gu64;
#define RLX_AGENT __ATOMIC_RELAXED, __HIP_MEMORY_SCOPE_AGENT
#define LDS_WAIT() asm volatile("s_waitcnt lgkmcnt(0)" ::: "memory")
#define VM_WAIT() asm volatile("s_waitcnt vmcnt(0)" ::: "memory")
__device__ __forceinline__ unsigned long long rt() { return __builtin_amdgcn_s_memrealtime(); }
__device__ __forceinline__ unsigned f2bf(float f) { unsigned u = __builtin_bit_cast(unsigned, f); return (u + 0x7fffu + ((u >> 16) & 1u)) >> 16; }
__device__ __forceinline__ unsigned pk2(float lo, float hi) { return f2bf(lo) | (f2bf(hi) << 16); }
#define XB_TMO      128
#define XB_XCNT(j)  (256  + 64 * (j))
#define XB_XSUB(j)  (1280 + 64 * (j))
#define XB_XGEN(j)  (2304 + 64 * (j))
#define XB_TOP      3328
#define XB_TOPGEN   3392
#define XCD_BAR_WORDS 3456
#define XB_SPIN_CAP (1u << 18)

__device__ __forceinline__ unsigned xb_ld(unsigned* p)              { return __hip_atomic_load(p, __ATOMIC_RELAXED, __HIP_MEMORY_SCOPE_AGENT); }
__device__ __forceinline__ unsigned xb_add(unsigned* p, unsigned v) { return __hip_atomic_fetch_add(p, v, __ATOMIC_RELAXED, __HIP_MEMORY_SCOPE_AGENT); }
__device__ __forceinline__ unsigned xb_xcc_id() { return (unsigned)__builtin_amdgcn_s_getreg((3 << 11) | 20) & 0xFu; }
#define XB_SPIN(cond, bar) do { unsigned _sp = 0; while (cond) { __builtin_amdgcn_s_sleep(1); \
    if ((++_sp & 255u) == 0u) { if (xb_ld(&(bar)[XB_TMO])) break; if (_sp > XB_SPIN_CAP) { atomicAdd(&(bar)[XB_TMO], 1u); break; } } } } while (0)

struct XcdBarrier {
    int tid; unsigned* bar; unsigned x;
    volatile LAS unsigned* st;
};

__device__ __forceinline__ XcdBarrier xcd_barrier_post(unsigned* bar, volatile LAS unsigned* st, int tid) {
    XcdBarrier b; b.bar = bar; b.x = xb_xcc_id(); b.st = st; b.tid = tid;
    if (tid == 0) (void)xb_add(&bar[XB_XCNT(b.x)], 1u);
    return b;
}
__device__ __forceinline__ void xcd_barrier_complete(unsigned* bar, unsigned x, unsigned& nloc, unsigned& nx) {
    const unsigned G = gridDim.x * gridDim.y * gridDim.z;
    unsigned sum, cnt, mine, sp = 0u;
    for (;;) {
        sum = 0u; cnt = 0u; mine = 0u;
#pragma unroll
        for (unsigned j = 0; j < 16; ++j) { const unsigned c = xb_ld(&bar[XB_XCNT(j)]); sum += c; cnt += (c > 0u) ? 1u : 0u; mine = (j == x) ? c : mine; }
        if (sum == G) break;
        __builtin_amdgcn_s_sleep(1);
        if ((++sp & 255u) == 0u) { if (xb_ld(&bar[XB_TMO])) break; if (sp > XB_SPIN_CAP) { atomicAdd(&bar[XB_TMO], 1u); break; } }
    }
    nloc = mine > 0u ? mine : 1u; nx = cnt > 0u ? cnt : 1u;
}

__device__ __forceinline__ void xcd_barrier(const XcdBarrier& b) {
    asm volatile("s_waitcnt vmcnt(0)" ::: "memory");
    __syncthreads();
    if (b.tid == 0) {
        unsigned* bar = b.bar;
        __builtin_amdgcn_s_waitcnt(0);
        unsigned nloc = b.st[0], nx = b.st[1];
        if (nloc == 0u) { xcd_barrier_complete(bar, b.x, nloc, nx); b.st[0] = nloc; b.st[1] = nx; }
        const unsigned old = xb_add(&bar[XB_XSUB(b.x)], 1u);
        const unsigned gen = old / nloc;
        if (old + 1u == (gen + 1u) * nloc) {
            __builtin_amdgcn_fence(__ATOMIC_RELEASE, "agent");
            asm volatile("s_waitcnt vmcnt(0)" ::: "memory");
            const unsigned og = xb_add(&bar[XB_TOP], 1u);
            const unsigned tg = og / nx;
            if (og + 1u == (tg + 1u) * nx) xb_add(&bar[XB_TOPGEN], 1u);
            else XB_SPIN(xb_ld(&bar[XB_TOPGEN]) == tg, bar);
            __builtin_amdgcn_fence(__ATOMIC_ACQUIRE, "agent");
            xb_add(&bar[XB_XGEN(b.x)], 1u);
            asm volatile("s_waitcnt vmcnt(0)" ::: "memory");
        } else {
            XB_SPIN(xb_ld(&bar[XB_XGEN(b.x)]) == gen, bar);
            __builtin_amdgcn_fence(__ATOMIC_ACQUIRE, "agent");
            asm volatile("s_waitcnt vmcnt(0)" ::: "memory");
        }
    }
    __syncthreads();
}

namespace mk {
constexpr int NWAVES = 8, NTHR = 512;
constexpr int D = 1024, NBATCH = 4, SEQ = 4096, CTXL = 256;
constexpr int MLAT = NBATCH * SEQ, MCTX = NBATCH * CTXL, MALL = MLAT + MCTX;
constexpr int INW = 2496, INP = 2560, DFF = 2816, NGU = 2 * DFF;
constexpr int C_R = 0, C_K = 256, C_V = 512, C_GD = 768, C_WD = 832, C_AD = 896, C_DFQ = 960, C_DFK = 1216, C_DFV = 1472, C_GQQ = 1728, C_GQK = 2240, C_GQV = 2368;
constexpr float NORM_EPS = 1e-6f, LOG2E = 1.4426950408889634f;
constexpr float SC_DF = 0.17677669529663687f * LOG2E;
constexpr float SC_GQ = 0.125f * LOG2E;

enum { I_X = 0, I_C, I_CTX, I_CCTX, I_ADAW, I_ADAB, I_NORMG, I_WIN, I_WOUT, I_RWCONV, I_RWW0, I_RWWUP, I_RWA0, I_RWAUP, I_RWGUP, I_RWKK, I_RWKA, I_RWRK, I_RWLNG, I_RWLNB,
       I_DFLAM, I_DFNG, I_GQSINK, I_FFG, I_FFU, I_FFD, I_FFCW, I_FFCB, N_IN };

constexpr size_t MiB = 1u << 20;
constexpr size_t WS_CTL = 0, CTL_ZERO_BYTES = 1 * MiB;
constexpr int CW_BAR = 4096;
constexpr size_t WS_MOD = 1 * MiB;
constexpr size_t WS_TAB = 1 * MiB + 256 * 1024;
constexpr size_t WS_WIN = 2 * MiB, WIN_BYTES = (size_t)INP * D * 2;
constexpr size_t WS_WOUT = 12 * MiB, WOUT_BYTES = (size_t)D * D * 2;
constexpr size_t WS_WGU = 16 * MiB, WGU_BYTES = (size_t)NGU * D * 2;
constexpr size_t WS_WD = 38 * MiB, WD_BYTES = (size_t)D * DFF * 2;
constexpr size_t WS_XSC = 49 * MiB;
constexpr size_t WS_XN = 53 * MiB;
constexpr size_t WS_RP = 87 * MiB;
constexpr size_t WS_RF = 172 * MiB;
constexpr size_t FEAT1 = (size_t)MALL * 256 * 2;
constexpr size_t WS_GAL = WS_RF, WS_GBE = WS_GAL + 2 * FEAT1, WS_GKP = WS_GBE + 2 * FEAT1, WS_GRH = WS_GKP + 2 * FEAT1, WS_FV = WS_GRH + 2 * FEAT1;
constexpr size_t WS_GLT = WS_FV + FEAT1;
constexpr size_t WS_BON = WS_GLT + (size_t)2 * 272 * 256 * 4;
constexpr size_t WS_RF_END = WS_BON + (size_t)MALL * 4 * 4;
constexpr size_t WS_ACT = WS_RP;
constexpr size_t WS_FP = 181 * MiB;
constexpr size_t WS_SLO = WS_RF;
constexpr size_t WS_SLD = 215 * MiB;
constexpr size_t WS_END = 256 * MiB;
static_assert(WS_RF_END <= WS_END, "feature region");
static_assert(WS_FP + (size_t)MALL * D * 2 <= WS_SLD && WS_SLD + (size_t)11 * MCTX * D * 2 <= WS_END, "slabs");
static_assert(WS_ACT + (size_t)MALL * DFF * 2 <= WS_FP && WS_FP + (size_t)MALL * D * 4 <= WS_END, "ffn buffers");
static_assert(WS_XN + (size_t)MALL * D * 2 <= WS_RP && WS_RP + (size_t)MALL * INP * 2 <= WS_RF, "map");

constexpr int LDS_BYTES = 163840;
constexpr int LDSCTL_OFF = LDS_BYTES - 512, MISC_OFF = LDSCTL_OFF + 320;
constexpr int CW_QUEUE = 2048;

struct Args { const float* in[N_IN]; float* out; unsigned char* ws; int ph_lo, ph_hi; };


typedef const __attribute__((address_space(4))) char* kptr_t;
__device__ __forceinline__ kptr_t karg_base() { kptr_t k = (kptr_t)__builtin_amdgcn_kernarg_segment_ptr(); asm volatile("" : "+s"(k)); return k; }
__device__ __forceinline__ const float* kin(int i) { return *(const float* const __attribute__((address_space(4)))*)(karg_base() + 8 * i); }
__device__ __forceinline__ float* kout() { return *(float* const __attribute__((address_space(4)))*)(karg_base() + 8 * N_IN); }
__device__ __forceinline__ unsigned char* kws() { return *(unsigned char* const __attribute__((address_space(4)))*)(karg_base() + 8 * N_IN + 8); }

struct Frame {
    LAS unsigned char* lds;
    int tid, lane, wave, G, bid;
};

__device__ __forceinline__ float bf2f(bf16 h) { return __uint_as_float(((unsigned)h) << 16); }
template <int CTRL> __device__ __forceinline__ float dpp_mov(float x) { return __int_as_float(__builtin_amdgcn_update_dpp(0, __float_as_int(x), CTRL, 0xF, 0xF, false)); }
template <int CTRL> __device__ __forceinline__ float dpp_add(float x) { return x + dpp_mov<CTRL>(x); }
__device__ __forceinline__ float wave_sum(float v) {
    v = dpp_add<0xB1>(v); v = dpp_add<0x4E>(v); v = dpp_add<0x124>(v); v = dpp_add<0x128>(v);
    auto r = __builtin_amdgcn_permlane16_swap(__float_as_uint(v), __float_as_uint(v), false, false); v = __uint_as_float(r[0]) + __uint_as_float(r[1]);
    r = __builtin_amdgcn_permlane32_swap(__float_as_uint(v), __float_as_uint(v), false, false); return __uint_as_float(r[0]) + __uint_as_float(r[1]);
}
__device__ __forceinline__ float rdlane(float v, int l) { return __int_as_float(__builtin_amdgcn_readlane(__float_as_int(v), l)); }
__device__ __forceinline__ float sigmoidf_(float x) { return 1.0f / (1.0f + __expf(-x)); }
typedef unsigned v2u __attribute__((ext_vector_type(2)));
typedef float f32x2_t __attribute__((ext_vector_type(2))); typedef __bf16 bf16x2_t __attribute__((ext_vector_type(2)));
__device__ __forceinline__ unsigned pk2h(float lo, float hi) { f32x2_t v = {lo, hi}; bf16x2_t b = __builtin_convertvector(v, bf16x2_t); return __builtin_bit_cast(unsigned, b); }
__device__ __forceinline__ float xmax4(float v) {
    auto r = __builtin_amdgcn_permlane16_swap(__float_as_uint(v), __float_as_uint(v), false, false); v = fmaxf(__uint_as_float(r[0]), __uint_as_float(r[1]));
    r = __builtin_amdgcn_permlane32_swap(__float_as_uint(v), __float_as_uint(v), false, false); return fmaxf(__uint_as_float(r[0]), __uint_as_float(r[1]));
}

__device__ __forceinline__ void p0_transpose_item(const float* W, int K, int N, bf16* WT, int row_off, LAS float* scr, int item, int lane) {
    const int nblk = N / 32, kb = item / nblk, nb = item % nblk, k0 = 64 * kb, n0 = 32 * nb;
#pragma unroll 8
    for (int i = 0; i < 32; ++i) { const int kk = 2 * i + (lane >> 5); scr[kk * 33 + (lane & 31)] = W[(size_t)(k0 + kk) * N + n0 + (lane & 31)]; }
    LDS_WAIT(); asm volatile("" ::: "memory");
    const int c = lane & 7;
#pragma unroll
    for (int j = 0; j < 4; ++j) { const int n = (lane >> 3) + 8 * j; const LAS float* s = scr + (8 * c) * 33 + n;
        v4u o; o.x = pk2h(s[0 * 33], s[1 * 33]); o.y = pk2h(s[2 * 33], s[3 * 33]); o.z = pk2h(s[4 * 33], s[5 * 33]); o.w = pk2h(s[6 * 33], s[7 * 33]);
        *(GAS v4u*)(WT + (size_t)(row_off + n0 + n) * K + k0 + 8 * c) = o; }
    LDS_WAIT(); asm volatile("" ::: "memory");
}

constexpr int WI_IN = 16 * (INW / 32), WI_OUT = 16 * 32, WI_G = 16 * (DFF / 32), WI_DN = (DFF / 64) * 32, WI_LAYER = WI_IN + WI_OUT + 2 * WI_G + WI_DN;
__device__ __forceinline__ void weight_item(int it, LAS float* scr, int lane) {
    unsigned char* ws = kws();
    const int l = it / WI_LAYER; int r = it % WI_LAYER;
    if (r < WI_IN) { p0_transpose_item(kin(I_WIN) + (size_t)l * D * INW, D, INW, (bf16*)(ws + WS_WIN + l * WIN_BYTES), 0, scr, r, lane); return; } r -= WI_IN;
    if (r < WI_OUT) { p0_transpose_item(kin(I_WOUT) + (size_t)l * D * D, D, D, (bf16*)(ws + WS_WOUT + l * WOUT_BYTES), 0, scr, r, lane); return; } r -= WI_OUT;
    if (r < WI_G) { const int n0 = 32 * (r % (DFF / 32)); p0_transpose_item(kin(I_FFG) + (size_t)l * D * DFF, D, DFF, (bf16*)(ws + WS_WGU + l * WGU_BYTES), 256 * (n0 >> 7) + (n0 & 127) - n0, scr, r, lane); return; } r -= WI_G;
    if (r < WI_G) { const int n0 = 32 * (r % (DFF / 32)); p0_transpose_item(kin(I_FFU) + (size_t)l * D * DFF, D, DFF, (bf16*)(ws + WS_WGU + l * WGU_BYTES), 256 * (n0 >> 7) + (n0 & 127) - n0 + 128, scr, r, lane); return; } r -= WI_G;
    p0_transpose_item(kin(I_FFD) + (size_t)l * DFF * D, DFF, D, (bf16*)(ws + WS_WD + l * WD_BYTES), 0, scr, r, lane);
}
constexpr int WI_FILL = (2 * WI_LAYER - WI_IN + 127) / 128;

__device__ __forceinline__ void p0_prologue(const Args& A, Frame& F) {
    unsigned char* ws = kws();
    {
        LAS float* sc = (LAS float*)F.lds;
        LAS float* red = (LAS float*)(F.lds + 20480);
        float* mod = (float*)(ws + WS_MOD);
        for (int u = F.bid; u < 192; u += F.G) {
            __syncthreads();
            for (int i = F.tid; i < 5 * 1024; i += NTHR) { const int bb = i >> 10, k = i & 1023; const float v = bb < 4 ? kin(I_C)[bb * 1024 + k] : kin(I_CCTX)[k]; sc[i] = v / (1.0f + __expf(-v)); }
            __syncthreads();
            const int l = u / 96, cc = u % 96, col = cc * 64 + (F.tid & 63), ks = F.tid >> 6;
            const float* w = kin(I_ADAW) + (size_t)l * 1024 * 6144 + col;
            float acc[5] = {0.f, 0.f, 0.f, 0.f, 0.f};
            for (int k = ks * 128; k < ks * 128 + 128; ++k) { const float wv = w[(size_t)k * 6144];
#pragma unroll
                for (int bb = 0; bb < 5; ++bb) acc[bb] += sc[bb * 1024 + k] * wv; }
#pragma unroll
            for (int bb = 0; bb < 5; ++bb) red[(ks * 5 + bb) * 64 + (F.tid & 63)] = acc[bb];
            __syncthreads();
            if (F.tid < 320) { const int bb = F.tid >> 6, c = F.tid & 63; float s = kin(I_ADAB)[l * 6144 + cc * 64 + c];
#pragma unroll
                for (int k8 = 0; k8 < 8; ++k8) s += red[(k8 * 5 + bb) * 64 + c];
                mod[(size_t)(l * 5 + bb) * 6144 + cc * 64 + c] = s; }
        }
        __syncthreads();
    }
    {
        LAS float* scr = (LAS float*)(F.lds + F.wave * 16384);
        const int gw = F.bid * NWAVES + F.wave, NGW = F.G * NWAVES;
        for (int it = gw; it < WI_IN; it += NGW) weight_item(it, scr, F.lane);
        const int gt = F.bid * NTHR + F.tid, NGT = F.G * NTHR;
        for (int i = gt; i < 2 * 8192; i += NGT) { const int l = i >> 13, j = i & 8191;
            *(GAS v4u*)(ws + WS_WIN + l * WIN_BYTES + (size_t)INW * D * 2 + (size_t)j * 16) = (v4u){0u, 0u, 0u, 0u}; }
    }
    if (F.bid == 0) {
        float* tab = (float*)(ws + WS_TAB);
        for (int i = F.tid; i < 512; i += NTHR) { const int pos = i >> 3, f = i & 7; const float inv = __builtin_amdgcn_exp2f(-(float)f * (13.287712379549449f / 8.0f)), ang = (float)pos * inv; tab[i] = __cosf(ang); tab[512 + i] = __sinf(ang); }
        for (int i = F.tid; i < 1024; i += NTHR) { const int pos = i >> 4, f = i & 15; const float inv = __builtin_amdgcn_exp2f(-(float)f * (13.287712379549449f / 16.0f)), ang = (float)pos * inv; tab[1024 + i] = __cosf(ang); tab[2048 + i] = __sinf(ang); }
        if (F.tid < 2) { const int l = F.tid; const float* lv = kin(I_DFLAM) + l * 128; float s1 = 0.f, s2 = 0.f;
            for (int i = 0; i < 32; ++i) { s1 += lv[i] * lv[32 + i]; s2 += lv[64 + i] * lv[96 + i]; }
            const float lam_init = 0.8f - 0.6f * __expf(-0.3f * (float)l);
            tab[3072 + l] = __expf(s1) - __expf(s2) + lam_init; tab[3074 + l] = lam_init; }
    }
}

__device__ __forceinline__ const float* mod_vec(const Args& A, int l, int bb, int i) { return (const float*)(kws() + WS_MOD) + ((size_t)(l * 5 + bb) * 6 + i) * 1024; }
__device__ __forceinline__ const float* normg_vec(const Args& A, int l, int i) { return kin(I_NORMG) + (size_t)(l * 4 + i) * 1024; }
__device__ __forceinline__ int row_bb(int row) { return row < MLAT ? (row >> 12) : 4; }
__device__ __forceinline__ void seq_pos(int row, int& t, int& T) { if (row < MLAT) { t = row & (SEQ - 1); T = SEQ; } else { t = (row - MLAT) & (CTXL - 1); T = CTXL; } }
__device__ __forceinline__ void ld16(const float* p, int lane, f32x4 (&v)[4]) {
#pragma unroll
    for (int j = 0; j < 4; ++j) v[j] = *(const f32x4*)(p + 4 * lane + 256 * j);
}
__device__ __forceinline__ void ld16b(const bf16* p, int lane, f32x4 (&v)[4]) {
#pragma unroll
    for (int j = 0; j < 4; ++j) { const v2u u = *(const v2u*)(p + 4 * lane + 256 * j);
        v[j] = (f32x4){__uint_as_float(u.x << 16), __uint_as_float(u.x & 0xffff0000u), __uint_as_float(u.y << 16), __uint_as_float(u.y & 0xffff0000u)}; }
}
__device__ __forceinline__ void st16(float* p, int lane, const f32x4 (&v)[4]) {
#pragma unroll
    for (int j = 0; j < 4; ++j) *(f32x4*)(p + 4 * lane + 256 * j) = v[j];
}
__device__ __forceinline__ float sumsq16(const f32x4 (&v)[4]) {
    float s = 0.f;
#pragma unroll
    for (int j = 0; j < 4; ++j) s += (v[j].x * v[j].x + v[j].y * v[j].y) + (v[j].z * v[j].z + v[j].w * v[j].w);
    return wave_sum(s);
}
__device__ __forceinline__ void norm_mod_store(const f32x4 (&v)[4], float rstd, const float* g, const float* sc, const float* sh, bf16* orow, int lane) {
#pragma unroll
    for (int j = 0; j < 4; ++j) {
        const int c = 4 * lane + 256 * j;
        const f32x4 gg = *(const f32x4*)(g + c), s1 = *(const f32x4*)(sc + c), s0 = *(const f32x4*)(sh + c);
        const f32x4 h = v[j] * rstd * gg * (s1 + 1.0f) + s0;
        v2u o; o.x = pk2h(h.x, h.y); o.y = pk2h(h.z, h.w);
        *(v2u*)(orow + c) = o;
    }
}
__device__ __forceinline__ float* xs_row(const Args& A, int row) { return row < MLAT ? kout() + (size_t)row * D : (float*)(kws() + WS_XSC) + (size_t)(row - MLAT) * D; }
__device__ __forceinline__ const float* xin_row(const Args& A, int row) { return row < MLAT ? kin(I_X) + (size_t)row * D : kin(I_CTX) + (size_t)(row - MLAT) * D; }

__device__ __forceinline__ void phase_prep(const Args& A, Frame& F) {
    const int gw = F.bid * NWAVES + F.wave, NGW = F.G * NWAVES;
    bf16* XN = (bf16*)(kws() + WS_XN);
    for (int row = gw; row < MALL; row += NGW) {
        f32x4 v[4]; ld16(xin_row(A, row), F.lane, v);
        const float rstd = rsqrtf(sumsq16(v) * (1.0f / D) + NORM_EPS);
        const int bb = row_bb(row);
        norm_mod_store(v, rstd, normg_vec(A, 0, 0), mod_vec(A, 0, bb, 1), mod_vec(A, 0, bb, 0), XN + (size_t)row * D, F.lane);
    }
}
__device__ __forceinline__ void phase_e1(const Args& A, Frame& F, int l) {
    const int gw = F.bid * NWAVES + F.wave, NGW = F.G * NWAVES, nrows = l == 0 ? MALL : MLAT;
    bf16* XN = (bf16*)(kws() + WS_XN); const bf16* YP = (const bf16*)(kws() + WS_RP);
    for (int row = gw; row < nrows; row += NGW) {
        const int bb = row_bb(row);
        f32x4 y[4], x[4];
        if (l == 0 && row >= MLAT) { const bf16* sl = (const bf16*)(kws() + WS_SLO) + (size_t)(row - MLAT) * D; ld16b(sl, F.lane, y);
            for (int s = 1; s < 4; ++s) { f32x4 t[4]; ld16b(sl + (size_t)s * MCTX * D, F.lane, t);
#pragma unroll
                for (int j = 0; j < 4; ++j) y[j] = y[j] + t[j]; } }
        else ld16b(YP + (size_t)row * D, F.lane, y);
        if (l == 0) ld16(xin_row(A, row), F.lane, x); else ld16(xs_row(A, row), F.lane, x);
        const float ry = rsqrtf(sumsq16(y) * (1.0f / D) + NORM_EPS);
        const float* g1 = normg_vec(A, l, 1); const float* ga = mod_vec(A, l, bb, 2);
#pragma unroll
        for (int j = 0; j < 4; ++j) { const int c = 4 * F.lane + 256 * j; x[j] = x[j] + *(const f32x4*)(ga + c) * (y[j] * ry * *(const f32x4*)(g1 + c)); }
        st16(xs_row(A, row), F.lane, x);
        const float rx = rsqrtf(sumsq16(x) * (1.0f / D) + NORM_EPS);
        norm_mod_store(x, rx, normg_vec(A, l, 2), mod_vec(A, l, bb, 4), mod_vec(A, l, bb, 3), XN + (size_t)row * D, F.lane);
    }
}
__device__ __forceinline__ void phase_e2(const Args& A, Frame& F, int l, int r0, int r1) {
    const int gw = F.bid * NWAVES + F.wave, NGW = F.G * NWAVES;
    bf16* XN = (bf16*)(kws() + WS_XN); const bf16* FP = (const bf16*)(kws() + WS_FP);
    for (int row = r0 + gw; row < r1; row += NGW) {
        const int bb = row_bb(row);
        f32x4 y[4], x[4];
        if (l == 0 && row >= MLAT) { const bf16* sl = (const bf16*)(kws() + WS_SLD) + (size_t)(row - MLAT) * D; ld16b(sl, F.lane, y);
            for (int s = 1; s < 11; ++s) { f32x4 t[4]; ld16b(sl + (size_t)s * MCTX * D, F.lane, t);
#pragma unroll
                for (int j = 0; j < 4; ++j) y[j] = y[j] + t[j]; } }
        else ld16b(FP + (size_t)(row - r0) * D, F.lane, y);
        ld16(xs_row(A, row), F.lane, x);
        const float ry = rsqrtf(sumsq16(y) * (1.0f / D) + NORM_EPS);
        const float* g3 = normg_vec(A, l, 3); const float* ga = mod_vec(A, l, bb, 5);
#pragma unroll
        for (int j = 0; j < 4; ++j) { const int c = 4 * F.lane + 256 * j; x[j] = x[j] + *(const f32x4*)(ga + c) * (y[j] * ry * *(const f32x4*)(g3 + c)); }
        st16(xs_row(A, row), F.lane, x);
        if (l == 0) {
            const float rx = rsqrtf(sumsq16(x) * (1.0f / D) + NORM_EPS);
            norm_mod_store(x, rx, normg_vec(A, 1, 0), mod_vec(A, 1, bb, 1), mod_vec(A, 1, bb, 0), XN + (size_t)row * D, F.lane);
        }
    }
}
__device__ __forceinline__ void phase_act(const Args& A, Frame& F, int l, int r0, int r1) {
    const bf16* GU = (const bf16*)(kws() + WS_RP); bf16* ACT = (bf16*)(kws() + WS_ACT);
    const float* cw = kin(I_FFCW) + (size_t)l * 3 * DFF; const float* cb = kin(I_FFCB) + (size_t)l * DFF;
    const int nch = DFF / 8, total = (r1 - r0) * nch;
    for (int i = F.bid * NTHR + F.tid; i < total; i += F.G * NTHR) {
        const int rr = i / nch, ch = i % nch, row = r0 + rr, j0 = ch * 8;
        const int t = row < MLAT ? (row & (SEQ - 1)) : ((row - MLAT) & (CTXL - 1)), T = row < MLAT ? SEQ : CTXL;
        const bf16* gp = GU + (size_t)rr * NGU + j0;
        const v4u gc = *(const v4u*)gp, uu = *(const v4u*)(gp + DFF);
        v4u gm = (v4u){0u, 0u, 0u, 0u}, gn = (v4u){0u, 0u, 0u, 0u};
        if (t > 0) gm = *(const v4u*)(gp - NGU);
        if (t < T - 1) gn = *(const v4u*)(gp + NGU);
        unsigned o[4];
#pragma unroll
        for (int q = 0; q < 4; ++q) {
            float r2[2];
#pragma unroll
            for (int e = 0; e < 2; ++e) {
                const int j = j0 + 2 * q + e;
                const float a = __uint_as_float(e ? (gm[q] & 0xffff0000u) : (gm[q] << 16)), b = __uint_as_float(e ? (gc[q] & 0xffff0000u) : (gc[q] << 16)), c = __uint_as_float(e ? (gn[q] & 0xffff0000u) : (gn[q] << 16));
                const float u = __uint_as_float(e ? (uu[q] & 0xffff0000u) : (uu[q] << 16));
                const float z = a * cw[j] + b * cw[DFF + j] + c * cw[2 * DFF + j] + cb[j];
                r2[e] = z / (1.0f + __expf(-z)) * u;
            }
            o[q] = pk2h(r2[0], r2[1]);
        }
        *(v4u*)(ACT + (size_t)rr * DFF + j0) = (v4u){o[0], o[1], o[2], o[3]};
    }
}

struct EpiMulti {
    static constexpr bool PERM = false, AFTER_DRAIN = false;
    int mode;
    bf16* ob; float* of; int ld; const float* tab;
    const float* cw; const float* cb; int nrows; unsigned ldsx;
    __device__ __forceinline__ void operator()(const pg8::f32x4 (&acc)[2][2][4][2], const pg8::Unit& u, int wr, int wc, int fr_, int fq_) const {
        int fr = fr_, fq = fq_; asm volatile("" : "+v"(fr), "+v"(fq));
        if (mode == 1) {
#pragma unroll
            for (int ai = 0; ai < 2; ++ai)
#pragma unroll
                for (int m = 0; m < 4; ++m) { float* rp = of + (size_t)(u.pm * 256 + ai * 128 + wr * 64 + m * 16 + fr) * ld + u.pn * 256 + wc * 32 + 4 * fq;
#pragma unroll
                    for (int bj = 0; bj < 2; ++bj)
#pragma unroll
                        for (int n = 0; n < 2; ++n) *(pg8::f32x4*)(rp + bj * 128 + n * 16) = acc[ai][bj][m][n]; }
        } else if (mode == 3) {
            const unsigned par = (unsigned)(u.pm + u.pn) & 1u;
            const unsigned ex = ldsx + par * 4096u + (unsigned)(wc * 32 + 4 * fq) * 4u;
#pragma unroll
            for (int ai = 0; ai < 2; ++ai)
#pragma unroll
                for (int n = 0; n < 2; ++n) {
                    if (fr == 0) *(LAS pg8::f32x4*)(uintptr_t)(ex + (unsigned)(((ai * 2 + wr) * 2 + 0) * 128 + n * 16) * 4u) = acc[ai][0][0][n];
                    if (fr == 15) *(LAS pg8::f32x4*)(uintptr_t)(ex + (unsigned)(((ai * 2 + wr) * 2 + 1) * 128 + n * 16) * 4u) = acc[ai][0][3][n];
                }
            asm volatile("s_waitcnt lgkmcnt(0)" ::: "memory"); __builtin_amdgcn_s_barrier(); asm volatile("" ::: "memory");
            const int jb = u.pn * 128 + wc * 32 + 4 * fq;
#pragma unroll
            for (int n = 0; n < 2; ++n) {
                const int j = jb + 16 * n;
                const pg8::f32x4 w0 = *(const pg8::f32x4*)(cw + j), w1 = *(const pg8::f32x4*)(cw + DFF + j), w2 = *(const pg8::f32x4*)(cw + 2 * DFF + j), bb = *(const pg8::f32x4*)(cb + j);
#pragma unroll
                for (int ai = 0; ai < 2; ++ai) {
                    const int pblk = (ai * 2 + wr) - 1, nblk = (ai * 2 + wr) + 1;
                    pg8::f32x4 eprev = (pg8::f32x4){0.f, 0.f, 0.f, 0.f}, enext = eprev;
                    if (pblk >= 0) eprev = *(LAS const pg8::f32x4*)(uintptr_t)(ex + (unsigned)((pblk * 2 + 1) * 128 + n * 16) * 4u);
                    if (nblk <= 3) enext = *(LAS const pg8::f32x4*)(uintptr_t)(ex + (unsigned)((nblk * 2 + 0) * 128 + n * 16) * 4u);
#pragma unroll
                    for (int mm = 0; mm < 4; ++mm) {
                        const int trow = ai * 128 + wr * 64 + mm * 16 + fr, grow = u.pm * 254 - 1 + trow;
                        int t, T; seq_pos(grow < 0 ? 0 : grow, t, T);
                        const pg8::f32x4 gc = acc[ai][0][mm][n], uu = acc[ai][1][mm][n];
                        pg8::f32x4 gp, gn;
#pragma unroll
                        for (int i = 0; i < 4; ++i) {
                            const float pold = mm > 0 ? __int_as_float(__builtin_amdgcn_update_dpp(0, __float_as_int(acc[ai][0][mm > 0 ? mm - 1 : 0][n][i]), 0x121, 0xF, 0xF, false)) : eprev[i];
                            gp[i] = __int_as_float(__builtin_amdgcn_update_dpp(__float_as_int(pold), __float_as_int(gc[i]), 0x111, 0xF, 0xF, false));
                            const float nold = mm < 3 ? __int_as_float(__builtin_amdgcn_update_dpp(0, __float_as_int(acc[ai][0][mm < 3 ? mm + 1 : 3][n][i]), 0x12F, 0xF, 0xF, false)) : enext[i];
                            gn[i] = __int_as_float(__builtin_amdgcn_update_dpp(__float_as_int(nold), __float_as_int(gc[i]), 0x101, 0xF, 0xF, false));
                        }
                        if (t == 0) gp = (pg8::f32x4){0.f, 0.f, 0.f, 0.f};
                        if (t == T - 1) gn = (pg8::f32x4){0.f, 0.f, 0.f, 0.f};
                        const pg8::f32x4 z = gp * w0 + gc * w1 + gn * w2 + bb;
                        pg8::f32x4 a;
#pragma unroll
                        for (int i = 0; i < 4; ++i) a[i] = z[i] / (1.0f + __expf(-z[i])) * uu[i];
                        if (trow >= 1 && trow <= 254 && grow < nrows) { v2u o; o.x = pk2h(a[0], a[1]); o.y = pk2h(a[2], a[3]); *(v2u*)(ob + (size_t)grow * DFF + j) = o; }
                    }
                }
            }
        } else if (mode == 2) {
#pragma unroll
            for (int ai = 0; ai < 2; ++ai)
#pragma unroll
                for (int m = 0; m < 4; ++m) { bf16* rp = ob + (size_t)(u.pm * 256 + ai * 128 + wr * 64 + m * 16 + fr) * ld + u.pn * 256 + wc * 32 + 4 * fq;
#pragma unroll
                    for (int bj = 0; bj < 2; ++bj)
#pragma unroll
                        for (int n = 0; n < 2; ++n) { const pg8::f32x4 v = acc[ai][bj][m][n]; v2u o; o.x = pk2h(v[0], v[1]); o.y = pk2h(v[2], v[3]); *(v2u*)(rp + bj * 128 + n * 16) = o; } }
        } else {
            const bool latent = u.pm < (MLAT / 256);
#pragma unroll
            for (int bj = 0; bj < 2; ++bj) {
                const int g32 = u.pn * 8 + bj * 4 + wc;
                if (g32 >= INW / 32) continue;
                const bool isdf = (g32 >= C_DFQ / 32 && g32 < C_DFV / 32), isgq = (g32 >= C_GQQ / 32 && g32 < C_GQV / 32);
                const float qs = (g32 >= C_DFQ / 32 && g32 < C_DFK / 32) ? SC_DF : ((g32 >= C_GQQ / 32 && g32 < C_GQK / 32) ? SC_GQ : 1.0f);
#pragma unroll
                for (int ai = 0; ai < 2; ++ai)
#pragma unroll
                    for (int m = 0; m < 4; ++m) {
                        const int row = u.pm * 256 + ai * 128 + wr * 64 + m * 16 + fr, s = row & (SEQ - 1), prow = s >> 6, pcol = s & 63;
                        pg8::f32x4 v0 = acc[ai][bj][m][0], v1 = acc[ai][bj][m][1];
                        if (isdf) {
                            pg8::f32x4 p0, p1;
#pragma unroll
                            for (int i = 0; i < 4; ++i) { p0[i] = __shfl_xor(v0[i], 32); p1[i] = __shfl_xor(v1[i], 32); }
                            if (latent) {
                                const int f0 = 4 * (fq & 1);
                                const pg8::f32x4 c0 = *(const pg8::f32x4*)(tab + prow * 8 + f0), s0 = *(const pg8::f32x4*)(tab + 512 + prow * 8 + f0);
                                const pg8::f32x4 c1 = *(const pg8::f32x4*)(tab + pcol * 8 + f0), s1 = *(const pg8::f32x4*)(tab + 512 + pcol * 8 + f0);
                                if (fq & 2) { v0 = v0 * c0 + p0 * s0; v1 = v1 * c1 + p1 * s1; } else { v0 = v0 * c0 - p0 * s0; v1 = v1 * c1 - p1 * s1; }
                            }
                        } else if (isgq) {
                            if (latent) {
                                const int pos = (g32 & 1) ? pcol : prow;
                                const pg8::f32x4 cc = *(const pg8::f32x4*)(tab + 1024 + pos * 16 + 4 * fq), ss = *(const pg8::f32x4*)(tab + 2048 + pos * 16 + 4 * fq);
                                const pg8::f32x4 a = v0 * cc - v1 * ss, b = v1 * cc + v0 * ss; v0 = a; v1 = b;
                            }
                        }
                        v0 = v0 * qs; v1 = v1 * qs;
                        bf16* rp = ob + (size_t)row * INP + g32 * 32 + 4 * fq;
                        v2u o; o.x = pk2h(v0[0], v0[1]); o.y = pk2h(v0[2], v0[3]); *(v2u*)rp = o;
                        o.x = pk2h(v1[0], v1[1]); o.y = pk2h(v1[2], v1[3]); *(v2u*)(rp + 16) = o;
                        asm volatile("" ::: "memory");
                    }
            }
        }
    }
};


template <int CTRL, int RM> __device__ __forceinline__ float dpp_mul1(float x) {
    return x * __int_as_float(__builtin_amdgcn_update_dpp(0x3f800000, __float_as_int(x), CTRL, RM, 0xF, false));
}
__device__ __forceinline__ float wave_mulscan(float x) {
    x = dpp_mul1<0x111, 0xF>(x); x = dpp_mul1<0x112, 0xF>(x); x = dpp_mul1<0x114, 0xF>(x); x = dpp_mul1<0x118, 0xF>(x);
    x = dpp_mul1<0x142, 0xA>(x); x = dpp_mul1<0x143, 0xC>(x); return x;
}
__device__ __forceinline__ float wave_shr1_one(float x) { return __int_as_float(__builtin_amdgcn_update_dpp(0x3f800000, __float_as_int(x), 0x138, 0xF, 0xF, false)); }
__device__ __forceinline__ bf16 bf1(float x) { return (bf16)(pk2h(x, 0.f) & 0xffffu); }

constexpr int FT_LD = 65, FT_ARR = 64 * FT_LD * 4;
constexpr int FT_BON = 9 * FT_ARR;
constexpr int FT_PR_LD = 200;
static_assert(66 * FT_PR_LD * 2 <= 2 * FT_ARR && FT_BON + 512 <= LDSCTL_OFF, "features LDS map");
__device__ __forceinline__ void rwkv_features(const Args& A, Frame& F, int l) {
    const int w = F.wave, n = F.lane, c15 = n & 15, g = n >> 4, tr = w >> 1, tc0 = (w & 1) * 2;
    const int h = F.bid & 3, c = h * 64 + n;
    const bf16* P = (const bf16*)(kws() + WS_RP);
    bf16* FV = (bf16*)(kws() + WS_FV); float* BON = (float*)(kws() + WS_BON); float* GLT = (float*)(kws() + WS_GLT);
    float cw[3][3];
#pragma unroll
    for (int tp = 0; tp < 3; ++tp)
#pragma unroll
        for (int j = 0; j < 3; ++j) cw[tp][j] = kin(I_RWCONV)[(size_t)(l * 3 + tp) * 768 + j * 256 + c];
    const float kkc = kin(I_RWKK)[l * 256 + c];
    bf16x8 Bw[2][2], Ba[2][2]; float w0c[2][2], a0c[2][2], kac2[2], rkc2[2];
#pragma unroll
    for (int t = 0; t < 2; ++t) { const int cn = h * 64 + 16 * (tc0 + t) + c15;
        kac2[t] = kin(I_RWKA)[l * 256 + cn]; rkc2[t] = kin(I_RWRK)[l * 256 + cn];
#pragma unroll
        for (int d = 0; d < 2; ++d) { w0c[d][t] = kin(I_RWW0)[(l * 2 + d) * 256 + cn]; a0c[d][t] = kin(I_RWA0)[(l * 2 + d) * 256 + cn];
            unsigned pw[4], pa[4];
#pragma unroll
            for (int j = 0; j < 8; j += 2) { const size_t o = ((size_t)(l * 2 + d) * 32 + 8 * g + j) * 256 + cn;
                pw[j >> 1] = pk2h(kin(I_RWWUP)[o], kin(I_RWWUP)[o + 256]); pa[j >> 1] = pk2h(kin(I_RWAUP)[o], kin(I_RWAUP)[o + 256]); }
            Bw[d][t] = __builtin_bit_cast(bf16x8, (v4u){pw[0], pw[1], pw[2], pw[3]}); Ba[d][t] = __builtin_bit_cast(bf16x8, (v4u){pa[0], pa[1], pa[2], pa[3]}); }
    }
    for (int u = F.bid; u < 4 * (MALL / 64); u += F.G) {
        const int gi = u >> 2, row0 = 64 * gi;
        int t0, T; seq_pos(row0, t0, T);
        __syncthreads();
        for (int p = F.tid; p < 66 * 24; p += NTHR) { const int rr = p / 24, q = p % 24, which = q >> 3, ch = q & 7, row = row0 - 1 + rr;
            const bool ok = (rr >= 1 && rr <= 64) || (rr == 0 ? t0 > 0 : t0 + 64 < T);
            v4u v = (v4u){0u, 0u, 0u, 0u};
            if (ok) v = *(const v4u*)(P + (size_t)row * INP + which * 256 + h * 64 + 8 * ch);
            *(LAS v4u*)(F.lds + (rr * FT_PR_LD + which * 64 + 8 * ch) * 2) = v; }
        v4u xwd[2], xad[2];
        { const bf16* pr = P + (size_t)(row0 + 16 * tr + c15) * INP + 8 * g;
#pragma unroll
          for (int d = 0; d < 2; ++d) { xwd[d] = *(const v4u*)(pr + C_WD + 32 * d); xad[d] = *(const v4u*)(pr + C_AD + 32 * d); } }
        __syncthreads();
#pragma unroll
        for (int rr = 0; rr < 8; ++rr) {
            const int i = 8 * w + rr;
            float xr[3], xk[3], xv[3];
#pragma unroll
            for (int tp = 0; tp < 3; ++tp) { const LAS bf16* pp = (const LAS bf16*)F.lds + (i + tp) * FT_PR_LD + n; xr[tp] = bf2f(pp[0]); xk[tp] = bf2f(pp[64]); xv[tp] = bf2f(pp[128]); }
            const float rq = bf2f(bf1(xr[0] * cw[0][0] + xr[1] * cw[1][0] + xr[2] * cw[2][0])), kq = bf2f(bf1(xk[0] * cw[0][1] + xk[1] * cw[1][1] + xk[2] * cw[2][1]));
            FV[(size_t)(row0 + i) * 256 + c] = bf1(xv[0] * cw[0][2] + xv[1] * cw[1][2] + xv[2] * cw[2][2]);
            const float kkraw = kq * kkc;
            const float kk = kkraw * (1.0f / fmaxf(sqrtf(wave_sum(kkraw * kkraw)), 1e-12f));
            LAS float* L = (LAS float*)F.lds + i * FT_LD + n;
            L[2 * (FT_ARR / 4)] = kk; L[7 * (FT_ARR / 4)] = rq; L[8 * (FT_ARR / 4)] = kq;
        }
        __syncthreads();
        {
            bf16x8 aw[2], aa[2];
#pragma unroll
            for (int d = 0; d < 2; ++d) { unsigned pw[4];
#pragma unroll
                for (int q = 0; q < 4; ++q) { const float x0 = __uint_as_float(xwd[d][q] << 16), x1 = __uint_as_float(xwd[d][q] & 0xffff0000u);
                    pw[q] = pk2h(1.0f - 2.0f / (1.0f + __expf(2.0f * x0)), 1.0f - 2.0f / (1.0f + __expf(2.0f * x1))); }
                aw[d] = __builtin_bit_cast(bf16x8, (v4u){pw[0], pw[1], pw[2], pw[3]}); aa[d] = __builtin_bit_cast(bf16x8, xad[d]); }
            float bsum[4] = {0.f, 0.f, 0.f, 0.f};
#pragma unroll
            for (int t = 0; t < 2; ++t) {
                float kkv[4], kqv[4], rqv[4];
#pragma unroll
                for (int r = 0; r < 4; ++r) { const LAS float* L = (const LAS float*)F.lds + (16 * tr + 4 * g + r) * FT_LD + 16 * (tc0 + t) + c15;
                    kkv[r] = L[2 * (FT_ARR / 4)]; rqv[r] = L[7 * (FT_ARR / 4)]; kqv[r] = L[8 * (FT_ARR / 4)]; }
#pragma unroll
                for (int d = 0; d < 2; ++d) {
                    const f32x4 wl = __builtin_amdgcn_mfma_f32_16x16x32_bf16(aw[d], Bw[d][t], (f32x4){0.f, 0.f, 0.f, 0.f}, 0, 0, 0);
                    const f32x4 al = __builtin_amdgcn_mfma_f32_16x16x32_bf16(aa[d], Ba[d][t], (f32x4){0.f, 0.f, 0.f, 0.f}, 0, 0, 0);
#pragma unroll
                    for (int r = 0; r < 4; ++r) {
                        const float wv = 1.0f + bf2f(bf1(__expf(-0.6065306597126334f * sigmoidf_(wl[r] + w0c[d][t])) - 1.0f)), aq = bf2f(bf1(sigmoidf_(al[r] + a0c[d][t])));
                        const float kd = kqv[r] * (1.0f + (aq - 1.0f) * kac2[t]);
                        LAS float* L = (LAS float*)F.lds + (16 * tr + 4 * g + r) * FT_LD + 16 * (tc0 + t) + c15;
                        L[(0 + d) * (FT_ARR / 4)] = wv; L[(3 + d) * (FT_ARR / 4)] = kkv[r] * aq; L[(5 + d) * (FT_ARR / 4)] = kd;
                        bsum[r] += rqv[r] * kd * rkc2[t];
                    }
                }
            }
#pragma unroll
            for (int r = 0; r < 4; ++r) { float s = bsum[r]; s = dpp_add<0xB1>(s); s = dpp_add<0x4E>(s); s = dpp_add<0x124>(s); s = dpp_add<0x128>(s);
                if (c15 == 0) *(LAS float*)(F.lds + FT_BON + ((w & 1) * 64 + 16 * tr + 4 * g + r) * 4) = s; }
        }
        __syncthreads();
        if (F.tid < 64) BON[(row0 + F.tid) * 4 + h] = *(LAS float*)(F.lds + FT_BON + F.tid * 4) + *(LAS float*)(F.lds + FT_BON + (64 + F.tid) * 4);
#pragma unroll
        for (int d = 0; d < 2; ++d) {
            const int i = d ? 63 - n : n;
            const LAS float* L = (const LAS float*)F.lds + i * FT_LD + 8 * w;
            unsigned al8[4], be8[4], kp8[4], rh8[4]; float g63[8];
#pragma unroll
            for (int e2 = 0; e2 < 4; ++e2) {
                float alv[2], bev[2], kpv[2], rhv[2];
#pragma unroll
                for (int q = 0; q < 2; ++q) { const int e = 2 * e2 + q;
                    const float gi_ = wave_mulscan(L[(0 + d) * (FT_ARR / 4) + e]), gim1 = wave_shr1_one(gi_), ig = 1.0f / gi_;
                    g63[e] = rdlane(gi_, 63);
                    alv[q] = gim1 * L[2 * (FT_ARR / 4) + e]; bev[q] = L[(3 + d) * (FT_ARR / 4) + e] * ig; kpv[q] = L[(5 + d) * (FT_ARR / 4) + e] * ig; rhv[q] = gi_ * L[7 * (FT_ARR / 4) + e]; }
                al8[e2] = pk2h(alv[0], alv[1]); be8[e2] = pk2h(bev[0], bev[1]); kp8[e2] = pk2h(kpv[0], kpv[1]); rh8[e2] = pk2h(rhv[0], rhv[1]);
            }
            const size_t o = (size_t)d * MALL * 256 + (size_t)(64 * gi + i) * 256 + h * 64 + 8 * w;
            *(v4u*)((bf16*)(kws() + WS_GAL) + o) = (v4u){al8[0], al8[1], al8[2], al8[3]}; *(v4u*)((bf16*)(kws() + WS_GBE) + o) = (v4u){be8[0], be8[1], be8[2], be8[3]};
            *(v4u*)((bf16*)(kws() + WS_GKP) + o) = (v4u){kp8[0], kp8[1], kp8[2], kp8[3]}; *(v4u*)((bf16*)(kws() + WS_GRH) + o) = (v4u){rh8[0], rh8[1], rh8[2], rh8[3]};
            if (n < 8) { float gl = g63[0];
#pragma unroll
                for (int e = 1; e < 8; ++e) gl = (n == e) ? g63[e] : gl;
                GLT[((size_t)d * 272 + gi) * 256 + h * 64 + 8 * w + n] = gl; }
        }
    }
}

__device__ __forceinline__ int scan_row(int d, int b, int i) { if (i < CTXL) { const int t = d ? CTXL - 1 - i : i; return MLAT + b * CTXL + t; } const int j = i - CTXL, t = d ? SEQ - 1 - j : j; return b * SEQ + t; }

__device__ __forceinline__ void rwkv_readout(const Args& A, Frame& F, int l) {
    const int gw = F.bid * NWAVES + F.wave, NGW = F.G * NWAVES, nrows = l == 0 ? MALL : MLAT;
    const int h = gw & 3, n = F.lane, c = h * 64 + n;
    const bf16* P = (const bf16*)(kws() + WS_RP); const bf16* FV = (const bf16*)(kws() + WS_FV);
    const float* BON = (const float*)(kws() + WS_BON); bf16* Y = (bf16*)(kws() + WS_XN);
    float gupr[64];
#pragma unroll
    for (int j = 0; j < 64; ++j) gupr[j] = kin(I_RWGUP)[((size_t)l * 64 + j) * 256 + c];
    const float lng = kin(I_RWLNG)[l * 256 + c], lnb = kin(I_RWLNB)[l * 256 + c];
    for (int row = gw >> 2; row < nrows; row += NGW >> 2) {
        const size_t o = (size_t)row * 256 + c;
        const float ov = bf2f(P[(size_t)row * INP + c]) + bf2f(P[(size_t)row * INP + 256 + c]);
        const float mu = wave_sum(ov) * (1.0f / 64.0f), dv = ov - mu, var = wave_sum(dv * dv) * (1.0f / 64.0f);
        const float on = dv * rsqrtf(var + 64e-5f) * lng + lnb;
        const float sg = sigmoidf_(bf2f(P[(size_t)row * INP + C_GD + n]));
        float g = 0.f;
#pragma unroll
        for (int j = 0; j < 64; ++j) g = fmaf(rdlane(sg, j), gupr[j], g);
        const float y = (on + BON[row * 4 + h] * bf2f(FV[o])) * g;
        Y[(size_t)row * D + c] = (bf16)f2bf(y);
    }
}


constexpr int CK_LD = 72, CK_MAT = 64 * CK_LD * 2;
enum { M_AL = 0, M_BE, M_KP, M_RH, M_BET, M_KPT, M_VT, M_AOFF, M_BM, M_MB, M_MK, M_SB, M_SB1, M_YZ, M_UT, M_COUNT };
constexpr int CK_TD = M_COUNT * CK_MAT, CK_TD_LD = 40;
constexpr int CK_ADG = CK_TD + 64 * CK_TD_LD * 2;
constexpr int CK_SEG = CK_ADG + 4096;
constexpr int CK_GL = CK_SEG + 2048;
constexpr int CK_END = CK_GL + 256;
static_assert(CK_END <= LDSCTL_OFF, "chunk scan LDS map");
struct CkAddr { unsigned vA, vB, vN, vT, v1, v1t, lds; };
#define CKP(T, addr) ((LAS T*)(uintptr_t)(addr))
template <int KS> __device__ __forceinline__ void mm2(f32x4 (&acc)[2], const CkAddr& K, int mx, int my) {
#pragma unroll
    for (int ks = 0; ks < KS; ++ks) {
        const bf16x8 a = *CKP(const bf16x8, K.vA + mx * CK_MAT + 64 * ks);
#pragma unroll
        for (int t = 0; t < 2; ++t) { const bf16x8 bq = *CKP(const bf16x8, K.vB + my * CK_MAT + t * (16 * CK_LD * 2) + 64 * ks); acc[t] = __builtin_amdgcn_mfma_f32_16x16x32_bf16(a, bq, acc[t], 0, 0, 0); }
    }
}
__device__ __forceinline__ void stN(const CkAddr& K, int mi, int t, const f32x4 v) {
#pragma unroll
    for (int r = 0; r < 4; ++r) *CKP(bf16, K.vN + mi * CK_MAT + r * (CK_LD * 2) + t * 32) = bf1(v[r]);
}
__device__ __forceinline__ void stT(const CkAddr& K, int mi, int t, const f32x4 v) {
    v2u o; o.x = pk2h(v[0], v[1]); o.y = pk2h(v[2], v[3]); *CKP(v2u, K.vT + mi * CK_MAT + t * (16 * CK_LD * 2)) = o;
}
__device__ __forceinline__ void rwkv_chunk_unit(const Args& A, Frame& F, int l, int sc) {
    const bool last = (l == 1);
    const int d = sc >> 4, b = (sc >> 2) & 3, h = sc & 3;
    const int w = F.wave, n = F.lane;
    const bf16* GAL = (const bf16*)(kws() + WS_GAL) + (size_t)d * MALL * 256; const bf16* GBE = (const bf16*)(kws() + WS_GBE) + (size_t)d * MALL * 256;
    const bf16* GKP = (const bf16*)(kws() + WS_GKP) + (size_t)d * MALL * 256; const bf16* GRH = (const bf16*)(kws() + WS_GRH) + (size_t)d * MALL * 256;
    const bf16* FV = (const bf16*)(kws() + WS_FV); const float* GLT = (const float*)(kws() + WS_GLT) + (size_t)d * 272 * 256;
    bf16* O = (bf16*)(kws() + WS_RP) + d * 256;
    v4u ual, ube, ukp, urh, uv; float fgl = 0.f;
    { const int row = scan_row(d, b, n); const size_t o = (size_t)row * 256 + h * 64 + 8 * w;
      ual = *(const v4u*)(GAL + o); ube = *(const v4u*)(GBE + o); ukp = *(const v4u*)(GKP + o); urh = *(const v4u*)(GRH + o); uv = *(const v4u*)(FV + o);
      if (n < 8) fgl = GLT[(size_t)(scan_row(d, b, 0) >> 6) * 256 + h * 64 + 8 * w + n]; }
    __syncthreads();
    for (int i = F.tid; i < CK_END / 16; i += NTHR) *(LAS v4u*)(F.lds + i * 16) = (v4u){0u, 0u, 0u, 0u};
    f32x4 st[2] = {(f32x4){0.f, 0.f, 0.f, 0.f}, (f32x4){0.f, 0.f, 0.f, 0.f}};
    __syncthreads();
    constexpr int NCK = (CTXL + SEQ) / 64;
    for (int c = 0; c < NCK; ++c) {
        const bool skip_o = last && c < CTXL / 64;
        int c15 = n & 15, g = n >> 4; asm volatile("" : "+v"(c15), "+v"(g));
        const int tr = w >> 1, tc0 = (w & 1) * 2;
        CkAddr K; K.lds = (unsigned)(uintptr_t)F.lds;
        K.vA = K.lds + ((16 * tr + c15) * CK_LD + 8 * g) * 2; K.vB = K.lds + ((16 * tc0 + c15) * CK_LD + 8 * g) * 2;
        K.vN = K.lds + ((16 * tr + 4 * g) * CK_LD + 16 * tc0 + c15) * 2; K.vT = K.lds + ((16 * tc0 + c15) * CK_LD + 16 * tr + 4 * g) * 2;
        K.v1 = K.lds + (8 * w * CK_LD + n) * 2; K.v1t = K.lds + (n * CK_LD + 8 * w) * 2;
        asm volatile("" : "+v"(K.vA), "+v"(K.vB), "+v"(K.vN), "+v"(K.vT), "+v"(K.v1), "+v"(K.v1t));
        {
            *CKP(v4u, K.v1t + M_AL * CK_MAT) = ual; *CKP(v4u, K.v1t + M_BE * CK_MAT) = ube; *CKP(v4u, K.v1t + M_KP * CK_MAT) = ukp; *CKP(v4u, K.v1t + M_RH * CK_MAT) = urh;
#pragma unroll
            for (int e = 0; e < 8; ++e) {
                *CKP(bf16, K.v1 + M_BET * CK_MAT + e * (CK_LD * 2)) = (bf16)((e & 1) ? (ube[e >> 1] >> 16) : (ube[e >> 1] & 0xffffu));
                *CKP(bf16, K.v1 + M_KPT * CK_MAT + e * (CK_LD * 2)) = (bf16)((e & 1) ? (ukp[e >> 1] >> 16) : (ukp[e >> 1] & 0xffffu));
                *CKP(bf16, K.v1 + M_VT * CK_MAT + e * (CK_LD * 2)) = (bf16)((e & 1) ? (uv[e >> 1] >> 16) : (uv[e >> 1] & 0xffffu)); }
            if (n < 8) *CKP(float, K.lds + CK_GL + (8 * w + n) * 4) = fgl;
            { const int cn = c + 1 < NCK ? c + 1 : c; const int row = scan_row(d, b, 64 * cn + n); const size_t o = (size_t)row * 256 + h * 64 + 8 * w;
              ual = *(const v4u*)(GAL + o); ube = *(const v4u*)(GBE + o); ukp = *(const v4u*)(GKP + o); urh = *(const v4u*)(GRH + o); uv = *(const v4u*)(FV + o);
              if (n < 8) fgl = GLT[(size_t)(scan_row(d, b, 64 * cn) >> 6) * 256 + h * 64 + 8 * w + n]; }
        }
        __syncthreads();
        if (tc0 <= tr) {
            f32x4 pa[2] = {(f32x4){0.f, 0.f, 0.f, 0.f}, (f32x4){0.f, 0.f, 0.f, 0.f}}, pb[2] = {pa[0], pa[0]}, pm[2] = {pa[0], pa[0]}, pk[2] = {pa[0], pa[0]};
            mm2<2>(pa, K, M_AL, M_BE); mm2<2>(pb, K, M_AL, M_KP); mm2<2>(pm, K, M_RH, M_BE); mm2<2>(pk, K, M_RH, M_KP);
#pragma unroll
            for (int t = 0; t < 2; ++t) { const int tc = tc0 + t; if (tc > tr) continue;
                f32x4 va = pa[t], vb = pb[t], vm = pm[t], vk = pk[t];
                if (tc == tr) {
#pragma unroll
                    for (int r = 0; r < 4; ++r) { const bool strict = c15 < 4 * g + r, incl = c15 <= 4 * g + r;
                        va[r] = strict ? va[r] : 0.f; vb[r] = strict ? vb[r] : 0.f; vm[r] = incl ? vm[r] : 0.f; vk[r] = incl ? vk[r] : 0.f;
                        *CKP(float, K.lds + CK_ADG + ((tr * 16 + 4 * g + r) * 16 + c15) * 4) = va[r]; }
                } else stN(K, M_AOFF, t, va);
                stN(K, M_BM, t, vb); stN(K, M_MB, t, vm); stN(K, M_MK, t, vk);
            }
        }
        __syncthreads();
        f32x4 yb[2] = {(f32x4){0.f, 0.f, 0.f, 0.f}, (f32x4){0.f, 0.f, 0.f, 0.f}}, ob[2] = {yb[0], yb[0]};
        mm2<2>(yb, K, M_BM, M_VT);
        if (!skip_o) mm2<2>(ob, K, M_MK, M_VT);
        if (w == 0) {
            const int bb_ = n >> 4, cc = n & 15; float tcol[16];
            f32x4 arow[16][4];
#pragma unroll
            for (int r = 1; r < 16; ++r)
#pragma unroll
                for (int s4 = 0; s4 * 4 < r; ++s4) arow[r][s4] = *CKP(const f32x4, K.lds + CK_ADG + ((bb_ * 16 + r) * 16 + 4 * s4) * 4);
#pragma unroll
            for (int r = 0; r < 16; ++r) { float acc = (r == cc) ? 1.f : 0.f;
#pragma unroll
                for (int s = 0; s < r; ++s) acc = fmaf(-arow[r][s >> 2][s & 3], tcol[s], acc);
                tcol[r] = acc; *CKP(bf16, K.lds + CK_TD + ((16 * bb_ + r) * CK_TD_LD + cc) * 2) = bf1(acc); }
        }
        __syncthreads();
        const int sbr = (c & 1) ? M_SB1 : M_SB, sbw = (c & 1) ? M_SB : M_SB1;
        mm2<2>(yb, K, M_AL, sbr);
        stT(K, M_YZ, 0, yb[0]); stT(K, M_YZ, 1, yb[1]);
        __syncthreads();
        if (w < 4) {
            const unsigned aX = K.lds + ((c15) * CK_LD + 8 * g) * 2;
            const unsigned bY = K.lds + ((16 * w + c15) * CK_LD + 8 * g) * 2;
            const unsigned cT = K.lds + ((16 * w + c15) * CK_LD + 4 * g) * 2;
#pragma unroll
            for (int blk = 0; blk < 4; ++blk) {
                f32x4 z = (f32x4){0.f, 0.f, 0.f, 0.f};
                if (blk > 0) {
#pragma unroll
                    for (int ks = 0; ks < (blk == 3 ? 2 : 1); ++ks) {
                        const bf16x8 a = *CKP(const bf16x8, aX + M_AOFF * CK_MAT + blk * (16 * CK_LD * 2) + 64 * ks);
                        const bf16x8 u = *CKP(const bf16x8, bY + M_UT * CK_MAT + 64 * ks);
                        z = __builtin_amdgcn_mfma_f32_16x16x32_bf16(a, u, z, 0, 0, 0); }
                }
                { const v2u yv = *CKP(const v2u, cT + M_YZ * CK_MAT + 32 * blk);
                  z[0] += __uint_as_float(yv.x << 16); z[1] += __uint_as_float(yv.x & 0xffff0000u); z[2] += __uint_as_float(yv.y << 16); z[3] += __uint_as_float(yv.y & 0xffff0000u); }
                { v2u zo; zo.x = pk2h(z[0], z[1]); zo.y = pk2h(z[2], z[3]); *CKP(v2u, cT + M_YZ * CK_MAT + 32 * blk) = zo; }
                asm volatile("s_waitcnt lgkmcnt(0)" ::: "memory");
                const bf16x8 ta = *CKP(const bf16x8, K.lds + CK_TD + ((16 * blk + c15) * CK_TD_LD + 8 * g) * 2);
                const bf16x8 zb = *CKP(const bf16x8, bY + M_YZ * CK_MAT + 32 * blk);
                f32x4 u = __builtin_amdgcn_mfma_f32_16x16x32_bf16(ta, zb, (f32x4){0.f, 0.f, 0.f, 0.f}, 0, 0, 0);
                { v2u uo; uo.x = pk2h(-u[0], -u[1]); uo.y = pk2h(-u[2], -u[3]); *CKP(v2u, cT + M_UT * CK_MAT + 32 * blk) = uo; }
                asm volatile("s_waitcnt lgkmcnt(0)" ::: "memory");
            }
        }
        __syncthreads();
        if (!skip_o) {
            mm2<2>(ob, K, M_RH, sbr); mm2<2>(ob, K, M_MB, M_UT);
#pragma unroll
            for (int r = 0; r < 4; ++r) { const int row = scan_row(d, b, 64 * c + 16 * tr + 4 * g + r);
#pragma unroll
                for (int t = 0; t < 2; ++t) O[(size_t)row * INP + h * 64 + 16 * (tc0 + t) + c15] = bf1(ob[t][r]); }
        }
        mm2<2>(st, K, M_UT, M_BET); mm2<2>(st, K, M_VT, M_KPT);
#pragma unroll
        for (int t = 0; t < 2; ++t) { const float gl = *CKP(float, K.lds + CK_GL + (16 * (tc0 + t) + c15) * 4); st[t] = st[t] * gl; stN(K, sbw, t, st[t]); }
        __syncthreads();
    }
}
#undef CKP

struct KeyStream { int ctx_row0, nloc, loc_row0, loc_pos0; };
constexpr int AT_K = 0, AT_V = 4608, AT_BUF = 9728;
typedef float f32x4a __attribute__((ext_vector_type(4)));

template <int NMAP, int DK, int QS, bool MASK>
__device__ __forceinline__ void attn_core(Frame& F, const bf16* P, int kcol, int vcol, const KeyStream ks, const bf16x8 (&qf)[QS][NMAP][DK / 32], int qpos0,
                                          f32x4 (&o)[QS][NMAP][4], float (&m)[QS][NMAP], float (&lsum)[QS][NMAP]) {
    const int c15 = F.lane & 15, g = F.lane >> 4;
    const int sub = F.tid & 255, lkey = sub >> 3, lch = sub & 7; const bool isk = F.tid < 256;
    const int ntiles = 8 + ks.nloc;
#pragma unroll
    for (int qs = 0; qs < QS; ++qs)
#pragma unroll
        for (int mp = 0; mp < NMAP; ++mp) { m[qs][mp] = 0.f; lsum[qs][mp] = 0.f;
#pragma unroll
            for (int dt = 0; dt < 4; ++dt) o[qs][mp][dt] = (f32x4){0.f, 0.f, 0.f, 0.f}; }
    bool anym[QS][NMAP];
#pragma unroll
    for (int qs = 0; qs < QS; ++qs)
#pragma unroll
        for (int mp = 0; mp < NMAP; ++mp) anym[qs][mp] = false;
    v4u stg;
#define AT_LOAD(ti) do { const int rb_ = (ti) < 8 ? ks.ctx_row0 + 32 * (ti) : ks.loc_row0 + 32 * ((ti) - 8); \
        stg = *(const v4u*)(P + (size_t)(rb_ + lkey) * INP + (isk ? kcol : vcol) + 8 * lch); } while (0)
#define AT_WRITE(bi) do { LAS unsigned char* b_ = F.lds + (bi) * AT_BUF; \
        if (isk) *(LAS v4u*)(b_ + AT_K + lkey * 144 + lch * 16) = stg; \
        else { _Pragma("unroll") for (int i_ = 0; i_ < 8; ++i_) { const unsigned w_ = stg[i_ >> 1]; *(LAS bf16*)(b_ + AT_V + (8 * lch + i_) * 80 + lkey * 2) = (bf16)((i_ & 1) ? (w_ >> 16) : (w_ & 0xffffu)); } } } while (0)
    __syncthreads();
    AT_LOAD(0); AT_WRITE(0);
    __syncthreads();
    for (int ti = 0; ti < ntiles; ++ti) {
        { const int tn_ = ti + 1 < ntiles ? ti + 1 : ntiles - 1; AT_LOAD(tn_); }
        LAS unsigned char* bb = F.lds + (ti & 1) * AT_BUF;
        bf16x8 kf[2][NMAP][DK / 32];
#pragma unroll
        for (int kh = 0; kh < 2; ++kh)
#pragma unroll
            for (int mp = 0; mp < NMAP; ++mp)
#pragma unroll
                for (int kx = 0; kx < DK / 32; ++kx) kf[kh][mp][kx] = *(LAS bf16x8*)(bb + AT_K + (c15 + 16 * kh) * 144 + (mp * DK + 32 * kx + 8 * g) * 2);
        bf16x8 vf[4];
#pragma unroll
        for (int dt = 0; dt < 4; ++dt) { const v2u a = *(LAS v2u*)(bb + AT_V + (c15 + 16 * dt) * 80 + (4 * g) * 2), b2 = *(LAS v2u*)(bb + AT_V + (c15 + 16 * dt) * 80 + (16 + 4 * g) * 2);
            const v4u w = (v4u){a.x, a.y, b2.x, b2.y}; vf[dt] = __builtin_bit_cast(bf16x8, w); }
        const int kpos0 = ks.loc_pos0 + 32 * (ti - 8) + 4 * g;
#pragma unroll
        for (int qs = 0; qs < QS; ++qs)
#pragma unroll
            for (int mp = 0; mp < NMAP; ++mp) {
                f32x4 st[2];
                if (anym[qs][mp]) { const float negm = -m[qs][mp];
#pragma unroll
                    for (int kh = 0; kh < 2; ++kh) { st[kh] = (f32x4){negm, negm, negm, negm};
#pragma unroll
                        for (int kx = 0; kx < DK / 32; ++kx) st[kh] = __builtin_amdgcn_mfma_f32_16x16x32_bf16(kf[kh][mp][kx], qf[qs][mp][kx], st[kh], 0, 0, 0); }
                } else {
#pragma unroll
                    for (int kh = 0; kh < 2; ++kh) { st[kh] = (f32x4){0.f, 0.f, 0.f, 0.f};
#pragma unroll
                        for (int kx = 0; kx < DK / 32; ++kx) st[kh] = __builtin_amdgcn_mfma_f32_16x16x32_bf16(kf[kh][mp][kx], qf[qs][mp][kx], st[kh], 0, 0, 0); }
                }
                if (MASK && ti >= 8) {
                    const int kb = ks.loc_pos0 + 32 * (ti - 8), q0 = qpos0 + 16 * qs;
                    if (kb + 31 - q0 > 128 || kb - (q0 + 15) < -128) {
                        const int qp = q0 + c15;
#pragma unroll
                        for (int kh = 0; kh < 2; ++kh)
#pragma unroll
                            for (int r = 0; r < 4; ++r) { const int dd = kpos0 + 16 * kh + r - qp; if (dd > 128 || dd < -128) st[kh][r] = -INFINITY; }
                    }
                }
                float ps = 0.f; float p[8];
#pragma unroll
                for (int kh = 0; kh < 2; ++kh)
#pragma unroll
                    for (int r = 0; r < 4; ++r) { p[kh * 4 + r] = __builtin_amdgcn_exp2f(st[kh][r]); ps += p[kh * 4 + r]; }
                if (__builtin_amdgcn_ballot_w64(!(ps < 1048576.0f)) != 0ull) {
                    float mt = fmaxf(fmaxf(fmaxf(st[0][0], st[0][1]), fmaxf(st[0][2], st[0][3])), fmaxf(fmaxf(st[1][0], st[1][1]), fmaxf(st[1][2], st[1][3])));
                    mt = xmax4(mt);
                    const float delta = fmaxf(mt, 0.f), alpha = __builtin_amdgcn_exp2f(-delta);
                    m[qs][mp] += delta; lsum[qs][mp] *= alpha; anym[qs][mp] = true;
#pragma unroll
                    for (int dt = 0; dt < 4; ++dt) o[qs][mp][dt] = o[qs][mp][dt] * alpha;
                    ps = 0.f;
#pragma unroll
                    for (int kh = 0; kh < 2; ++kh)
#pragma unroll
                        for (int r = 0; r < 4; ++r) { p[kh * 4 + r] = __builtin_amdgcn_exp2f(st[kh][r] - delta); ps += p[kh * 4 + r]; }
                }
                lsum[qs][mp] += ps;
                const v4u pw = (v4u){pk2h(p[0], p[1]), pk2h(p[2], p[3]), pk2h(p[4], p[5]), pk2h(p[6], p[7])};
                const bf16x8 pf = __builtin_bit_cast(bf16x8, pw);
#pragma unroll
                for (int dt = 0; dt < 4; ++dt) o[qs][mp][dt] = __builtin_amdgcn_mfma_f32_16x16x32_bf16(vf[dt], pf, o[qs][mp][dt], 0, 0, 0);
            }
        AT_WRITE((ti + 1) & 1);
        __syncthreads();
    }
#undef AT_LOAD
#undef AT_WRITE
}

__device__ __forceinline__ void diff_unit(const Args& A, Frame& F, int l, int b, int h, int qrow0, int nloc) {
    const bf16* P = (const bf16*)(kws() + WS_RP); bf16* Y = (bf16*)(kws() + WS_XN); const float* tab = (const float*)(kws() + WS_TAB);
    const int c15 = F.lane & 15, g = F.lane >> 4;
    bf16x8 qf[1][2][1];
#pragma unroll
    for (int qs = 0; qs < 1; ++qs)
#pragma unroll
        for (int mp = 0; mp < 2; ++mp) qf[qs][mp][0] = *(const bf16x8*)(P + (size_t)(qrow0 + 16 * F.wave + c15) * INP + C_DFQ + h * 64 + mp * 32 + 8 * g);
    f32x4 o[1][2][4]; float m[1][2], ls[1][2];
    const KeyStream ks{MLAT + b * CTXL, nloc, b * SEQ, 0};
    attn_core<2, 32, 1, false>(F, P, C_DFK + h * 64, C_DFV + h * 64, ks, qf, 0, o, m, ls);
    const float lam = tab[3072 + l], oscale = 1.0f - tab[3074 + l];
    const float* ng = kin(I_DFNG) + l * 64;
#pragma unroll
    for (int qs = 0; qs < 1; ++qs) {
        float inv[2];
#pragma unroll
        for (int mp = 0; mp < 2; ++mp) { float t = ls[qs][mp]; t += __shfl_xor(t, 16); t += __shfl_xor(t, 32); inv[mp] = 1.0f / t; }
        f32x4 ov[4]; float ss = 0.f;
#pragma unroll
        for (int dt = 0; dt < 4; ++dt) { ov[dt] = o[qs][0][dt] * inv[0] - o[qs][1][dt] * (lam * inv[1]); ss += (ov[dt][0] * ov[dt][0] + ov[dt][1] * ov[dt][1]) + (ov[dt][2] * ov[dt][2] + ov[dt][3] * ov[dt][3]); }
        ss += __shfl_xor(ss, 16); ss += __shfl_xor(ss, 32);
        const float r = rsqrtf(ss * (1.0f / 64.0f) + NORM_EPS) * oscale;
        bf16* yp = Y + (size_t)(qrow0 + 16 * F.wave + c15) * D + 256 + h * 64 + 4 * g;
#pragma unroll
        for (int dt = 0; dt < 4; ++dt) { const f32x4 gg = *(const f32x4*)(ng + 16 * dt + 4 * g); const f32x4 v = ov[dt] * r * gg;
            v2u w; w.x = pk2h(v[0], v[1]); w.y = pk2h(v[2], v[3]); *(v2u*)(yp + 16 * dt) = w; }
    }
}
__device__ __forceinline__ void gq_unit(const Args& A, Frame& F, int l, int b, int kv, int qrow0, int qpos_blk  ) {
    const bf16* P = (const bf16*)(kws() + WS_RP); bf16* Y = (bf16*)(kws() + WS_XN);
    const int c15 = F.lane & 15, g = F.lane >> 4;
    const int hq = kv * 4 + (F.wave >> 1), rbase = qrow0 + 64 * (F.wave & 1);
    bf16x8 qf[4][1][2];
#pragma unroll
    for (int qs = 0; qs < 4; ++qs)
#pragma unroll
        for (int kx = 0; kx < 2; ++kx) qf[qs][0][kx] = *(const bf16x8*)(P + (size_t)(rbase + 16 * qs + c15) * INP + C_GQQ + hq * 64 + 32 * kx + 8 * g);
    KeyStream ks{MLAT + b * CTXL, 0, 0, 0}; int qpos0 = 0;
    if (qpos_blk >= 0) { const int lo = qpos_blk > 0 ? (qpos_blk - 1) * 128 : 0, hi = qpos_blk < 31 ? (qpos_blk + 2) * 128 : SEQ;
        ks.nloc = (hi - lo) / 32; ks.loc_row0 = b * SEQ + lo; ks.loc_pos0 = lo; qpos0 = qpos_blk * 128 + 64 * (F.wave & 1); }
    f32x4 o[4][1][4]; float m[4][1], ls[4][1];
    attn_core<1, 64, 4, true>(F, P, C_GQK + kv * 64, C_GQV + kv * 64, ks, qf, qpos0, o, m, ls);
    const float sink2 = kin(I_GQSINK)[l * 8 + hq] * LOG2E;
#pragma unroll
    for (int qs = 0; qs < 4; ++qs) {
        float t = ls[qs][0]; t += __shfl_xor(t, 16); t += __shfl_xor(t, 32);
        const float mf = fmaxf(m[qs][0], sink2), e = __builtin_amdgcn_exp2f(m[qs][0] - mf), den = t * e + __builtin_amdgcn_exp2f(sink2 - mf), scl = e / den;
        bf16* yp = Y + (size_t)(rbase + 16 * qs + c15) * D + 512 + hq * 64 + 4 * g;
#pragma unroll
        for (int dt = 0; dt < 4; ++dt) { const f32x4 v = o[qs][0][dt] * scl; v2u w; w.x = pk2h(v[0], v[1]); w.y = pk2h(v[2], v[3]); *(v2u*)(yp + 16 * dt) = w; }
    }
}
__device__ __forceinline__ void phase_queue(const Args& A, Frame& F, int l) {
    gu32* head = (gu32*)(kws() + WS_CTL) + CW_QUEUE + 64 * l;
    const int total = 32 + 512 + 256 + (l == 0 ? 48 + WI_FILL : 0);
    volatile LAS int* slot = (volatile LAS int*)(F.lds + MISC_OFF) + 16;
    for (;;) {
        asm volatile("" : "+v"(F.tid), "+v"(F.lane));
        __syncthreads();
        if (F.tid == 0) *slot = (int)__hip_atomic_fetch_add(head, 1u, __ATOMIC_RELAXED, __HIP_MEMORY_SCOPE_AGENT);
        __syncthreads();
        int u = __builtin_amdgcn_readfirstlane(*slot);
        if (u >= total) break;
        if (u < 32) { rwkv_chunk_unit(A, F, l, u); if ((MK_REPEAT >> 16) & 1) rwkv_chunk_unit(A, F, l, u); continue; }
        u -= 32;
        if (u < 512) { const int b = u >> 7, h = (u >> 5) & 3, qh = u & 31; diff_unit(A, F, l, b, h, b * SEQ + qh * 128, SEQ / 32); if ((MK_REPEAT >> 17) & 1) diff_unit(A, F, l, b, h, b * SEQ + qh * 128, SEQ / 32); continue; }
        u -= 512;
        if (u < 256) { const int b = u >> 6, kv = (u >> 5) & 1, nb = u & 31; gq_unit(A, F, l, b, kv, b * SEQ + nb * 128, nb); continue; }
        u -= 256;
        if (u < 32) { const int b = u >> 3, h = (u >> 1) & 3, hf = u & 1; diff_unit(A, F, l, b, h, MLAT + b * CTXL + hf * 128, 0); continue; }
        u -= 32;
        if (u < 16) { const int b = u >> 2, kv = (u >> 1) & 1, hf = u & 1; gq_unit(A, F, l, b, kv, MLAT + b * CTXL + hf * 128, -1); continue; }
        u -= 16;
        { LAS float* scr = (LAS float*)(F.lds + F.wave * 16384);
          for (int k = 0; k < 16; ++k) { const int it = WI_IN + u * 128 + F.wave * 16 + k; if (it < 2 * WI_LAYER) weight_item(it, scr, F.lane); } }
    }
}

constexpr int N_PHASES = 20;
}

__global__ void __launch_bounds__(mk::NTHR, 2) mega_fwd(mk::Args A) {
    using namespace mk;
    extern __shared__ __attribute__((aligned(16))) unsigned char lds_raw[];
    Frame F;
    F.lds = (LAS unsigned char*)lds_raw;
    F.tid = threadIdx.x; asm volatile("" : "+v"(F.tid)); F.lane = F.tid & 63; F.wave = __builtin_amdgcn_readfirstlane(F.tid >> 6);
    F.G = gridDim.x; F.bid = blockIdx.x;
    for (int u = F.tid; u < (LDS_BYTES - LDSCTL_OFF) / 4; u += NTHR) ((LAS unsigned*)(F.lds + LDSCTL_OFF))[u] = 0u;
    __syncthreads();
    gu32* ctl = (gu32*)(kws() + WS_CTL);
    XcdBarrier bar; bar.bar = (unsigned*)(ctl + CW_BAR); bar.x = 0; bar.st = nullptr; bar.tid = F.tid;
    const bool multi = (A.ph_hi - A.ph_lo) > 1;
    if (multi) bar = xcd_barrier_post((unsigned*)(ctl + CW_BAR), (volatile LAS unsigned*)(F.lds + MISC_OFF) + 8, F.tid);

    for (int ph = A.ph_lo, rep = 0; ph < A.ph_hi;) {
        { int t_ = F.tid, l_ = F.lane, w_ = F.wave, g_ = F.G, b_ = F.bid; unsigned p_ = (unsigned)(uintptr_t)F.lds;
          w_ = __builtin_amdgcn_readfirstlane(w_); g_ = __builtin_amdgcn_readfirstlane(g_); b_ = __builtin_amdgcn_readfirstlane(b_); p_ = __builtin_amdgcn_readfirstlane(p_);
          asm volatile("" : "+v"(t_), "+v"(l_)); asm volatile("" : "+s"(w_), "+s"(g_), "+s"(b_), "+s"(p_));
          F.tid = t_; F.lane = l_; F.wave = w_; F.G = g_; F.bid = b_; F.lds = (LAS unsigned char*)(uintptr_t)p_; }
        int kind = 0, l = 0, hf = 0;
        if (ph == 1) kind = 1;
        else if (ph > 1) { const int q = ph - 2; l = q / 9; const int r = q % 9; kind = r < 6 ? 2 + r : (r == 6 ? 8 : (r == 7 ? 10 : 11)); }
        const int nrows = (l == 0) ? MALL : MLAT;
        const int r0 = 0, r1 = nrows; (void)hf;
        const bool is_gemm = (kind == 2 || kind == 6 || kind == 8 || kind == 10);
        if (is_gemm) { if (MK_KINDS & 0x544) {
          const int nparts = ((kind == 6 || kind == 10) && l == 0) ? 2 : 1;
          for (int part = 0; part < nparts; ++part) {
            pg8::Gemm g; EpiMulti E; E.tab = (const float*)(kws() + WS_TAB); E.ob = nullptr; E.of = nullptr; E.ld = 0; E.mode = 0; E.cw = nullptr; E.cb = nullptr; E.nrows = 0; E.ldsx = 0u;
            if (kind == 2) { g = pg8::Gemm{(const pg8::bf16_t*)(kws() + WS_XN), (const pg8::bf16_t*)(kws() + WS_WIN + l * WIN_BYTES), MALL, INP, D, 256, D, 0}; E.mode = 0; E.ob = (bf16*)(kws() + WS_RP); E.ld = INP; }
            else if (kind == 6 && part == 0) { g = pg8::Gemm{(const pg8::bf16_t*)(kws() + WS_XN), (const pg8::bf16_t*)(kws() + WS_WOUT + l * WOUT_BYTES), MLAT, D, D, 256, D, 0}; E.mode = 2; E.ob = (bf16*)(kws() + WS_RP); E.ld = D; }
            else if (kind == 6) { g = pg8::Gemm{(const pg8::bf16_t*)(kws() + WS_XN) + (size_t)MLAT * D, (const pg8::bf16_t*)(kws() + WS_WOUT + l * WOUT_BYTES), 256 * 4 * 4, D, 256, 256, D, 4}; E.mode = 2; E.ob = (bf16*)(kws() + WS_SLO); E.ld = D; }
            else if (kind == 8) { const int nmu = (nrows + 253) / 254;
                g = pg8::Gemm{(const pg8::bf16_t*)(kws() + WS_XN) - D, (const pg8::bf16_t*)(kws() + WS_WGU + l * WGU_BYTES), 256 * nmu, NGU, D, 254, D, 0};
                E.mode = 3; E.ob = (bf16*)(kws() + WS_ACT); E.ld = DFF; E.cw = kin(I_FFCW) + (size_t)l * 3 * DFF; E.cb = kin(I_FFCB) + (size_t)l * DFF; E.nrows = nrows; E.ldsx = (unsigned)(uintptr_t)F.lds + 131072u; }
            else if (part == 0) { g = pg8::Gemm{(const pg8::bf16_t*)(kws() + WS_ACT), (const pg8::bf16_t*)(kws() + WS_WD + l * WD_BYTES), MLAT, D, DFF, 256, DFF, 0}; E.mode = 2; E.ob = (bf16*)(kws() + WS_FP); E.ld = D; }
            else { g = pg8::Gemm{(const pg8::bf16_t*)(kws() + WS_ACT) + (size_t)MLAT * DFF, (const pg8::bf16_t*)(kws() + WS_WD + l * WD_BYTES), 256 * 4 * 11, D, 256, 256, DFF, 4}; E.mode = 2; E.ob = (bf16*)(kws() + WS_SLD); E.ld = D; }
            pg8::StaticOrder S; S.init(g.M, g.N, F.G, F.bid);
            pg8::gemm_phase<EpiMulti, pg8::StaticOrder, true, true>(F.lds, g, S, E, F.tid);
          }
        } } else {
            switch (kind) {
                case 0: if ((MK_KINDS >> 0) & 1) { p0_prologue(A, F); } break;
                case 1: if (((MK_KINDS >> 1) & 1) && l == 0) phase_prep(A, F); break;
                case 3: if ((MK_KINDS >> 3) & 1) rwkv_features(A, F, l); break;
                case 4: if ((MK_KINDS >> 4) & 1) phase_queue(A, F, l); break;
                case 5: if ((MK_KINDS >> 5) & 1) rwkv_readout(A, F, l); break;
                case 7: if ((MK_KINDS >> 7) & 1) phase_e1(A, F, l); break;
                case 9: if ((MK_KINDS >> 9) & 1) phase_act(A, F, l, r0, r1); break;
                case 11: if ((MK_KINDS >> 11) & 1) phase_e2(A, F, l, r0, r1); break;
                default: break;
            }
        }
        const bool again = (rep == 0) && ((MK_REPEAT >> kind) & 1);
        if (ph + 1 < A.ph_hi || again) { bar.bar = (unsigned*)((gu32*)(kws() + WS_CTL) + CW_BAR); bar.tid = F.tid; xcd_barrier(bar); }
        if (again) rep = 1; else { rep = 0; ++ph; }
    }
}

extern "C" void kernel_launch(void* const* d_in, const int* in_sizes, int n_in, void* d_out, int out_size, void* d_ws, size_t ws_size, hipStream_t stream) {
    using namespace mk;
    static int grid = 0;
    if (grid == 0) {
        if (n_in != N_IN || out_size != MLAT * D || ws_size < WS_END) { fprintf(stderr, "kernel_launch: unexpected shapes (n_in %d, out %d, ws %zu); nothing launched\n", n_in, out_size, ws_size); grid = -1; return; }
        int dev = 0, cus = 0, per_cu = 0;
        if (hipGetDevice(&dev) != hipSuccess || hipDeviceGetAttribute(&cus, hipDeviceAttributeMultiprocessorCount, dev) != hipSuccess) { grid = -1; return; }
        if (hipFuncSetAttribute((const void*)mega_fwd, hipFuncAttributeMaxDynamicSharedMemorySize, LDS_BYTES) != hipSuccess) { fprintf(stderr, "kernel_launch: hipFuncSetAttribute failed\n"); grid = -1; return; }
        if (hipOccupancyMaxActiveBlocksPerMultiprocessor(&per_cu, (const void*)mega_fwd, NTHR, LDS_BYTES) != hipSuccess || per_cu < 1) { fprintf(stderr, "kernel_launch: occupancy query says %d blocks/CU\n", per_cu); per_cu = 1; }
        (void)hipGetLastError();
        grid = cus;
    }
    if (grid < 0) return;
    (void)hipMemsetAsync((char*)d_ws + WS_CTL, 0, CTL_ZERO_BYTES, stream);
    Args a{};
    for (int i = 0; i < N_IN; ++i) a.in[i] = (const float*)d_in[i];
    a.out = (float*)d_out; a.ws = (unsigned char*)d_ws;
#if MK_PER_PHASE
    for (int ph = 0; ph < N_PHASES; ++ph) { a.ph_lo = ph; a.ph_hi = ph + 1; hipLaunchKernelGGL(mega_fwd, dim3(grid), dim3(NTHR), LDS_BYTES, stream, a); }
#else
    a.ph_lo = 0; a.ph_hi = N_PHASES;
    void* args[] = {&a};
    hipError_t e = hipLaunchCooperativeKernel((const void*)mega_fwd, dim3(grid), dim3(NTHR), args, LDS_BYTES, stream);
    if (e != hipSuccess) fprintf(stderr, "kernel_launch: cooperative launch failed: %s (grid %d)\n", hipGetErrorString(e), grid);
#endif
}
```

```cpp
#include <hip/hip_runtime.h>
#include <hip/hip_cooperative_groups.h>
#include <cstdio>
#include <cstdint>
#ifndef MK_PER_PHASE
#define MK_PER_PHASE 0
#endif
#ifndef MK_KINDS
#define MK_KINDS 0xFFF
#endif
#ifndef MK_REPEAT
#define MK_REPEAT 0
#endif
namespace pg8 {
#define PG8_LAS __attribute__((address_space(3)))
typedef unsigned short bf16_t;
typedef short bf16x8 __attribute__((ext_vector_type(8)));
typedef float f32x4 __attribute__((ext_vector_type(4)));
typedef unsigned u32x4 __attribute__((ext_vector_type(4)));
constexpr int BM = 256, BK = 64, HALF = 128, HTB = HALF * BK * 2  , STAGE_BYTES = 8 * HTB, NXCD = 8, WGM = 8;

__host__ __device__ __forceinline__ int lds_byte(int r, int c) { const int st = (r >> 4) * 2 + (c >> 5), rr = r & 15, cc = c & 31, ob = rr * 64 + cc * 2; return st * 1024 + (ob ^ (((ob >> 9) & 1) << 5)); }
__host__ __device__ __forceinline__ void stage_rc(int b, int& R, int& C) { const int st = b / 1024, sb = b % 1024, swz = sb ^ (((sb >> 9) & 1) << 5); R = (st >> 1) * 16 + swz / 64; C = (st & 1) * 32 + (swz % 64) / 2; }
__host__ __device__ __forceinline__ int perm32(int rho) { const int n = rho >> 4, i = rho & 15; return 8 * (i >> 2) + 4 * n + (i & 3); }

__device__ __forceinline__ float pg8_zero() { float z = 0.f; asm volatile("" : "+v"(z)); return z; }
struct Unit { int pm, pn; };
struct Gemm { const bf16_t* A; const bf16_t* Bt; int M, N, K; int trows; int ld, mt; };

struct StaticOrder {
    int nM, nN, nwg, G, c;
    __host__ __device__ void init(int M, int N, int G_, int c_) { nM = M / BM; nN = N / BM; nwg = nM * nN; G = G_; c = c_; }
    __host__ __device__ bool next(int i, Unit& u) const {
        const long L = (long)i * G + c; if (L >= nwg) return false;
        int wgid = (int)L; { const int q = nwg / NXCD, r = nwg % NXCD, xcd = wgid % NXCD, off = wgid / NXCD; wgid = (xcd < r ? xcd * (q + 1) : r * (q + 1) + (xcd - r) * q) + off; }
        const int nig = WGM * nN, gid = wgid / nig, fm = gid * WGM, gsz = (nM - fm) < WGM ? (nM - fm) : WGM;
        u.pm = fm + ((wgid % nig) % gsz); u.pn = (wgid % nig) / gsz; return true;
    }
    __device__ __forceinline__ void a_ready(const Unit&) const {}
    __device__ __forceinline__ void done(const Unit&) const {}
};

__device__ __forceinline__ unsigned cvt_pk_bf16(float lo, float hi) { unsigned r; asm volatile("v_cvt_pk_bf16_f32 %0, %1, %2" : "=v"(r) : "v"(lo), "v"(hi)); return r; }
typedef float f32x2 __attribute__((ext_vector_type(2)));
__device__ __forceinline__ f32x2 gelu_pk(f32x2 v) {
    const f32x2 av = __builtin_elementwise_abs(v), d = av * 0.2316418882f + 1.0f;
    f32x2 t; t.x = __builtin_amdgcn_rcpf(d.x); t.y = __builtin_amdgcn_rcpf(d.y);
    f32x2 q = t * 0.5307027145f + (-0.7265760135f); q = q * t + 0.7107068705f; q = q * t + (-0.142248368f); q = q * t + 0.127414796f; q = q * t;
    const f32x2 s = (v * v) * (-0.72134752044f);
    f32x2 e; e.x = __builtin_amdgcn_exp2f(s.x); e.y = __builtin_amdgcn_exp2f(s.y);
    const f32x2 m = v * (q * e), r = v - m;
    f32x2 o; o.x = v.x < 0.f ? m.x : r.x; o.y = v.y < 0.f ? m.y : r.y; return o;
}

template <int ACT  > struct EpiBf16 {
    static constexpr bool PERM = true, AFTER_DRAIN = false; static_assert(ACT == 0 || ACT == 1, "EpiBf16: ACT is 0 (none) or 1 (gelu_pk)");
    bf16_t* O; int ldc; const float* bias; int split_cols; size_t split_stride; float scale0;
    __device__ __forceinline__ void operator()(const f32x4 (&acc)[2][2][4][2], const Unit& u, int wr, int wc, int fr, int fq) const {
        const int row0 = u.pm * BM + wr * 64 + fr; int colt = u.pn * BM; bf16_t* base = O;
        float sc = 1.f; if (split_cols) { const int t = colt / split_cols; base += (size_t)t * split_stride; colt -= t * split_cols; if (t == 0) sc = scale0; }
        const int col0 = colt + wc * 32 + 8 * fq, bcol0 = u.pn * BM + wc * 32 + 8 * fq;
        f32x4 bv[2][2];
#pragma unroll
        for (int bj = 0; bj < 2; ++bj)
#pragma unroll
            for (int n = 0; n < 2; ++n) bv[bj][n] = bias ? *(const f32x4*)(bias + bcol0 + bj * HALF + 4 * n) : (f32x4){0.f, 0.f, 0.f, 0.f};
#pragma unroll
        for (int ai = 0; ai < 2; ++ai)
#pragma unroll
            for (int m = 0; m < 4; ++m) { bf16_t* rowp = base + (size_t)(row0 + ai * HALF + m * 16) * ldc + col0;
#pragma unroll
                for (int bj = 0; bj < 2; ++bj) { f32x4 v0 = acc[ai][bj][m][0] + bv[bj][0], v1 = acc[ai][bj][m][1] + bv[bj][1];
                    if (ACT == 1) { f32x2 a = gelu_pk((f32x2){v0[0], v0[1]}), b = gelu_pk((f32x2){v0[2], v0[3]}), c = gelu_pk((f32x2){v1[0], v1[1]}), d = gelu_pk((f32x2){v1[2], v1[3]});
                        v0 = (f32x4){a.x, a.y, b.x, b.y}; v1 = (f32x4){c.x, c.y, d.x, d.y}; }
                    v0 = v0 * sc; v1 = v1 * sc; u32x4 w; w.x = cvt_pk_bf16(v0[0], v0[1]); w.y = cvt_pk_bf16(v0[2], v0[3]); w.z = cvt_pk_bf16(v1[0], v1[1]); w.w = cvt_pk_bf16(v1[2], v1[3]);
                    *(u32x4*)(rowp + bj * HALF) = w; } }
    }
};

template <class Epi, class Sched, bool ALIGN_EPI = false, bool SP2 = false>
__device__ __forceinline__ void gemm_phase(PG8_LAS unsigned char* lds, const Gemm g, const Sched& S, const Epi& E, int tid_in) {
    int tid_ = tid_in; asm volatile("" : "+v"(tid_));
    const int tid = tid_, wid = __builtin_amdgcn_readfirstlane(tid >> 6), lane = tid & 63, wr = wid >> 2, wc = wid & 3, fr = lane & 15, fq = lane >> 4;
    const int K = g.ld, nt = g.K / BK;
    unsigned voffA[2], voffB[2];
#pragma unroll
    for (int i = 0; i < 2; ++i) { int R, C; stage_rc(tid * 16 + i * 8192, R, C); const int Rb = Epi::PERM ? ((R & ~31) + perm32(R & 31)) : R;
        voffA[i] = (unsigned)(R * K + C) * 2u; voffB[i] = (unsigned)(Rb * K + C) * 2u; }
    const size_t kstep = (size_t)(BK * 2);
    const size_t hstep = (size_t)HALF * K * 2;
    const size_t tstep = 2 * hstep;
    const size_t tstepA = (size_t)g.trows * K * 2;
    const unsigned ldsw = (unsigned)wid * 1024u;
    const int aoff = lds_byte(wr * 64 + fr, fq * 8), boff = lds_byte(wc * 32 + fr, fq * 8);
#define PG8_SA(b, h) (((b) * 2 + (h)) * HTB)
#define PG8_SB(b, h) ((4 + (b) * 2 + (h)) * HTB)
#define PG8_STAGE(bufoff, gbase, voff) do { _Pragma("unroll") for (int _i = 0; _i < 2; ++_i) \
        __builtin_amdgcn_global_load_lds((const unsigned*)((const char*)(gbase) + (voff)[_i]), (PG8_LAS unsigned*)(lds + (bufoff) + ldsw + _i * 8192), 16, 0, 0); } while (0)
#define PG8_LDA(dst, b, h) do { _Pragma("unroll") for (int m = 0; m < 4; ++m) _Pragma("unroll") for (int k = 0; k < 2; ++k) dst[m][k] = *(const PG8_LAS bf16x8*)(lds + PG8_SA(b, h) + aoff + m * 2048 + k * 1024); } while (0)
#define PG8_LDB(dst, b, h) do { _Pragma("unroll") for (int n = 0; n < 2; ++n) _Pragma("unroll") for (int k = 0; k < 2; ++k) dst[n][k] = *(const PG8_LAS bf16x8*)(lds + PG8_SB(b, h) + boff + n * 2048 + k * 1024); } while (0)
#define PG8_MMA(ai, bj, At, Bt) do { __builtin_amdgcn_s_setprio(1); _Pragma("unroll") for (int m = 0; m < 4; ++m) _Pragma("unroll") for (int n = 0; n < 2; ++n) _Pragma("unroll") for (int k = 0; k < 2; ++k) \
        acc[ai][bj][m][n] = __builtin_amdgcn_mfma_f32_16x16x32_bf16(Bt[n][k], At[m][k], acc[ai][bj][m][n], 0, 0, 0); __builtin_amdgcn_s_setprio(0); } while (0)
#define PG8_WAIT_V(n) asm volatile("s_waitcnt vmcnt(" #n ")" ::: "memory")
#define PG8_WAIT_L(n) asm volatile("s_waitcnt lgkmcnt(" #n ")" ::: "memory")
#define PG8_BAR __builtin_amdgcn_s_barrier()
#define PG8_SCHED __builtin_amdgcn_sched_barrier(0)
    Unit cur, nxt; int ui = 0;
    if (!S.next(0, cur)) return;
    f32x4 acc[2][2][4][2];
#pragma unroll
    for (int a = 0; a < 2; ++a)
#pragma unroll
        for (int b = 0; b < 2; ++b)
#pragma unroll
            for (int m = 0; m < 4; ++m)
#pragma unroll
                for (int n = 0; n < 2; ++n) acc[a][b][m][n] = (f32x4){pg8_zero(), pg8_zero(), pg8_zero(), pg8_zero()};
    bf16x8 At[4][2], B0[2][2], B1[2][2];
#define PG8_BASEA(un) ((const char*)g.A + (size_t)(g.mt ? (un).pm % g.mt : (un).pm) * tstepA + (g.mt ? (size_t)((un).pm / g.mt) * g.K * 2 : 0))
#define PG8_BASEB(un) ((const char*)g.Bt + (size_t)(un).pn * tstep + (g.mt ? (size_t)((un).pm / g.mt) * g.K * 2 : 0))
    const char* cA = PG8_BASEA(cur); const char* cB = PG8_BASEB(cur);
    S.a_ready(cur);
    if constexpr (SP2) {
        PG8_STAGE(PG8_SB(0, 0), cB, voffB); PG8_STAGE(PG8_SB(0, 1), cB + hstep, voffB); PG8_STAGE(PG8_SA(0, 0), cA, voffA); PG8_STAGE(PG8_SA(0, 1), cA + hstep, voffA);
        if (wr == 1) PG8_BAR;
        PG8_WAIT_V(2); PG8_BAR;
        PG8_STAGE(PG8_SB(1, 0), cB + kstep, voffB); PG8_STAGE(PG8_SA(1, 0), cA + kstep, voffA); PG8_STAGE(PG8_SB(1, 1), cB + hstep + kstep, voffB);
        PG8_WAIT_V(6); PG8_BAR;
    } else {
        PG8_STAGE(PG8_SB(0, 0), cB, voffB); PG8_STAGE(PG8_SA(0, 0), cA, voffA); PG8_STAGE(PG8_SB(0, 1), cB + hstep, voffB); PG8_STAGE(PG8_SA(0, 1), cA + hstep, voffA);
        if (wr == 1) PG8_BAR;
        PG8_WAIT_V(4); PG8_BAR;
        PG8_STAGE(PG8_SB(1, 0), cB + kstep, voffB); PG8_STAGE(PG8_SA(1, 0), cA + kstep, voffA); PG8_STAGE(PG8_SB(1, 1), cB + hstep + kstep, voffB);
        PG8_WAIT_V(6); PG8_BAR;
    }
    for (;;) {
        const bool has_next = S.next(ui + 1, nxt);
        const char* nA = has_next ? PG8_BASEA(nxt) : cA; const char* nB = has_next ? PG8_BASEB(nxt) : cB;
        for (int t = 0; t < nt; t += 2) {
            const bool last = (t == nt - 2);
            const char* a1 = cA + (size_t)(t + 1) * kstep;
            const char* a2 = last ? nA : cA + (size_t)(t + 2) * kstep; const char* b2 = last ? nB : cB + (size_t)(t + 2) * kstep;
            const char* a3 = a2 + kstep; const char* b3 = b2 + kstep;
            if (last && has_next) S.a_ready(nxt);
            if constexpr (SP2) {
            PG8_LDB(B0, 0, 0); PG8_LDB(B1, 0, 1); PG8_SCHED; PG8_LDA(At, 0, 0); PG8_STAGE(PG8_SA(1, 1), a1 + hstep, voffA);
            PG8_WAIT_V(8); PG8_WAIT_L(0); PG8_BAR; PG8_MMA(0, 0, At, B0); PG8_MMA(0, 1, At, B1); PG8_BAR; PG8_SCHED;
            PG8_LDA(At, 0, 1); PG8_STAGE(PG8_SB(0, 0), b2, voffB); PG8_STAGE(PG8_SB(0, 1), b2 + hstep, voffB); PG8_STAGE(PG8_SA(0, 0), a2, voffA);
            PG8_WAIT_V(8); PG8_WAIT_L(0); PG8_BAR; PG8_MMA(1, 0, At, B0); PG8_MMA(1, 1, At, B1); PG8_BAR; PG8_SCHED;
            PG8_LDB(B0, 1, 0); PG8_LDB(B1, 1, 1); PG8_SCHED; PG8_LDA(At, 1, 0); PG8_STAGE(PG8_SA(0, 1), a2 + hstep, voffA);
            PG8_WAIT_V(8); PG8_WAIT_L(0); PG8_BAR; PG8_MMA(0, 0, At, B0); PG8_MMA(0, 1, At, B1); PG8_BAR; PG8_SCHED;
            PG8_LDA(At, 1, 1); PG8_STAGE(PG8_SB(1, 0), b3, voffB); PG8_STAGE(PG8_SB(1, 1), b3 + hstep, voffB); PG8_STAGE(PG8_SA(1, 0), a3, voffA);
            PG8_WAIT_V(8); PG8_WAIT_L(0); PG8_BAR; PG8_MMA(1, 0, At, B0); PG8_MMA(1, 1, At, B1); PG8_BAR; PG8_SCHED;
            } else {
            PG8_LDB(B0, 0, 0); PG8_SCHED; PG8_LDA(At, 0, 0); PG8_STAGE(PG8_SA(1, 1), a1 + hstep, voffA);
            PG8_WAIT_L(8); PG8_BAR; PG8_WAIT_L(0); PG8_MMA(0, 0, At, B0); PG8_BAR; PG8_SCHED;
            PG8_LDB(B1, 0, 1); PG8_STAGE(PG8_SB(0, 0), b2, voffB);
            PG8_BAR; PG8_WAIT_L(0); PG8_MMA(0, 1, At, B1); PG8_BAR;
            PG8_LDA(At, 0, 1); PG8_STAGE(PG8_SA(0, 0), a2, voffA);
            PG8_BAR; PG8_WAIT_L(0); PG8_MMA(1, 0, At, B0); PG8_BAR; PG8_SCHED;
            PG8_STAGE(PG8_SB(0, 1), b2 + hstep, voffB);
            PG8_WAIT_V(6); PG8_BAR; PG8_MMA(1, 1, At, B1); PG8_BAR;
            PG8_LDB(B0, 1, 0); PG8_SCHED; PG8_LDA(At, 1, 0); PG8_STAGE(PG8_SA(0, 1), a2 + hstep, voffA);
            PG8_WAIT_L(8); PG8_BAR; PG8_WAIT_L(0); PG8_MMA(0, 0, At, B0); PG8_BAR; PG8_SCHED;
            PG8_LDB(B1, 1, 1); PG8_STAGE(PG8_SB(1, 0), b3, voffB);
            PG8_BAR; PG8_WAIT_L(0); PG8_MMA(0, 1, At, B1); PG8_BAR;
            PG8_LDA(At, 1, 1); PG8_STAGE(PG8_SA(1, 0), a3, voffA);
            PG8_BAR; PG8_WAIT_L(0); PG8_MMA(1, 0, At, B0); PG8_BAR; PG8_SCHED;
            PG8_STAGE(PG8_SB(1, 1), b3 + hstep, voffB);
            PG8_WAIT_V(6); PG8_BAR; PG8_MMA(1, 1, At, B1); PG8_BAR;
            }
        }
        if constexpr (ALIGN_EPI) { if (wr == 0) PG8_BAR; }
        if constexpr (!Epi::AFTER_DRAIN) { E(acc, cur, wr, wc, fr, fq); S.done(cur); }
        if (!has_next) break;
#pragma unroll
        for (int a = 0; a < 2; ++a)
#pragma unroll
            for (int b = 0; b < 2; ++b)
#pragma unroll
                for (int m = 0; m < 4; ++m)
#pragma unroll
                    for (int n = 0; n < 2; ++n) acc[a][b][m][n] = (f32x4){pg8_zero(), pg8_zero(), pg8_zero(), pg8_zero()};
        cur = nxt; cA = nA; cB = nB; ++ui;
        if constexpr (ALIGN_EPI) { if (wr == 1) PG8_BAR; }
    }
    PG8_WAIT_V(0);
    if constexpr (!ALIGN_EPI) { if (wr == 0) PG8_BAR; }
    PG8_BAR;
    if constexpr (Epi::AFTER_DRAIN) { E.fused(acc, cur, wr, wc, fr, fq, lds, wid, lane); S.done(cur); }
#undef PG8_BASEA
#undef PG8_BASEB
#undef PG8_SA
#undef PG8_SB
#undef PG8_STAGE
#undef PG8_LDA
#undef PG8_LDB
#undef PG8_MMA
#undef PG8_WAIT_V
#undef PG8_WAIT_L
#undef PG8_BAR
#undef PG8_SCHED
}
}
#define GAS __attribute__((address_space(1)))
#define LAS __attribute__((address_space(3)))
typedef unsigned short bf16;
typedef unsigned v4u __attribute__((ext_vector_type(4)));
typedef float f32x4 __attribute__((ext_vector_type(4)));
typedef short bf16x8 __attribute__((ext_vector_type(8)));
typedef GAS unsigned gu32;
typedef GAS unsigned long long gu64;
#define RLX_AGENT __ATOMIC_RELAXED, __HIP_MEMORY_SCOPE_AGENT
#define LDS_WAIT() asm volatile("s_waitcnt lgkmcnt(0)" ::: "memory")
#define VM_WAIT() asm volatile("s_waitcnt vmcnt(0)" ::: "memory")
__device__ __forceinline__ unsigned long long rt() { return __builtin_amdgcn_s_memrealtime(); }
__device__ __forceinline__ unsigned f2bf(float f) { unsigned u = __builtin_bit_cast(unsigned, f); return (u + 0x7fffu + ((u >> 16) & 1u)) >> 16; }
__device__ __forceinline__ unsigned pk2(float lo, float hi) { return f2bf(lo) | (f2bf(hi) << 16); }
#define XB_TMO      128
#define XB_XCNT(j)  (256  + 64 * (j))
#define XB_XSUB(j)  (1280 + 64 * (j))
#define XB_XGEN(j)  (2304 + 64 * (j))
#define XB_TOP      3328
#define XB_TOPGEN   3392
#define XCD_BAR_WORDS 3456
#define XB_SPIN_CAP (1u << 18)

__device__ __forceinline__ unsigned xb_ld(unsigned* p)              { return __hip_atomic_load(p, __ATOMIC_RELAXED, __HIP_MEMORY_SCOPE_AGENT); }
__device__ __forceinline__ unsigned xb_add(unsigned* p, unsigned v) { return __hip_atomic_fetch_add(p, v, __ATOMIC_RELAXED, __HIP_MEMORY_SCOPE_AGENT); }
__device__ __forceinline__ unsigned xb_xcc_id() { return (unsigned)__builtin_amdgcn_s_getreg((3 << 11) | 20) & 0xFu; }
#define XB_SPIN(cond, bar) do { unsigned _sp = 0; while (cond) { __builtin_amdgcn_s_sleep(1); \
    if ((++_sp & 255u) == 0u) { if (xb_ld(&(bar)[XB_TMO])) break; if (_sp > XB_SPIN_CAP) { atomicAdd(&(bar)[XB_TMO], 1u); break; } } } } while (0)

struct XcdBarrier {
    int tid; unsigned* bar; unsigned x;
    volatile LAS unsigned* st;
};

__device__ __forceinline__ XcdBarrier xcd_barrier_post(unsigned* bar, volatile LAS unsigned* st, int tid) {
    XcdBarrier b; b.bar = bar; b.x = xb_xcc_id(); b.st = st; b.tid = tid;
    if (tid == 0) (void)xb_add(&bar[XB_XCNT(b.x)], 1u);
    return b;
}
__device__ __forceinline__ void xcd_barrier_complete(unsigned* bar, unsigned x, unsigned& nloc, unsigned& nx) {
    const unsigned G = gridDim.x * gridDim.y * gridDim.z;
    unsigned sum, cnt, mine, sp = 0u;
    for (;;) {
        sum = 0u; cnt = 0u; mine = 0u;
#pragma unroll
        for (unsigned j = 0; j < 16; ++j) { const unsigned c = xb_ld(&bar[XB_XCNT(j)]); sum += c; cnt += (c > 0u) ? 1u : 0u; mine = (j == x) ? c : mine; }
        if (sum == G) break;
        __builtin_amdgcn_s_sleep(1);
        if ((++sp & 255u) == 0u) { if (xb_ld(&bar[XB_TMO])) break; if (sp > XB_SPIN_CAP) { atomicAdd(&bar[XB_TMO], 1u); break; } }
    }
    nloc = mine > 0u ? mine : 1u; nx = cnt > 0u ? cnt : 1u;
}

__device__ __forceinline__ void xcd_barrier(const XcdBarrier& b) {
    asm volatile("s_waitcnt vmcnt(0)" ::: "memory");
    __syncthreads();
    if (b.tid == 0) {
        unsigned* bar = b.bar;
        __builtin_amdgcn_s_waitcnt(0);
        unsigned nloc = b.st[0], nx = b.st[1];
        if (nloc == 0u) { xcd_barrier_complete(bar, b.x, nloc, nx); b.st[0] = nloc; b.st[1] = nx; }
        const unsigned old = xb_add(&bar[XB_XSUB(b.x)], 1u);
        const unsigned gen = old / nloc;
        if (old + 1u == (gen + 1u) * nloc) {
            __builtin_amdgcn_fence(__ATOMIC_RELEASE, "agent");
            asm volatile("s_waitcnt vmcnt(0)" ::: "memory");
            const unsigned og = xb_add(&bar[XB_TOP], 1u);
            const unsigned tg = og / nx;
            if (og + 1u == (tg + 1u) * nx) xb_add(&bar[XB_TOPGEN], 1u);
            else XB_SPIN(xb_ld(&bar[XB_TOPGEN]) == tg, bar);
            __builtin_amdgcn_fence(__ATOMIC_ACQUIRE, "agent");
            xb_add(&bar[XB_XGEN(b.x)], 1u);
            asm volatile("s_waitcnt vmcnt(0)" ::: "memory");
        } else {
            XB_SPIN(xb_ld(&bar[XB_XGEN(b.x)]) == gen, bar);
            __builtin_amdgcn_fence(__ATOMIC_ACQUIRE, "agent");
            asm volatile("s_waitcnt vmcnt(0)" ::: "memory");
        }
    }
    __syncthreads();
}

namespace mk {
constexpr int NWAVES = 8, NTHR = 512;
constexpr int D = 1024, NBATCH = 4, SEQ = 4096, CTXL = 256;
constexpr int MLAT = NBATCH * SEQ, MCTX = NBATCH * CTXL, MALL = MLAT + MCTX;
constexpr int INW = 2496, INP = 2560, DFF = 2816, NGU = 2 * DFF;
constexpr int C_R = 0, C_K = 256, C_V = 512, C_GD = 768, C_WD = 832, C_AD = 896, C_DFQ = 960, C_DFK = 1216, C_DFV = 1472, C_GQQ = 1728, C_GQK = 2240, C_GQV = 2368;
constexpr float NORM_EPS = 1e-6f, LOG2E = 1.4426950408889634f;
constexpr float SC_DF = 0.17677669529663687f * LOG2E;
constexpr float SC_GQ = 0.125f * LOG2E;

enum { I_X = 0, I_C, I_CTX, I_CCTX, I_ADAW, I_ADAB, I_NORMG, I_WIN, I_WOUT, I_RWCONV, I_RWW0, I_RWWUP, I_RWA0, I_RWAUP, I_RWGUP, I_RWKK, I_RWKA, I_RWRK, I_RWLNG, I_RWLNB,
       I_DFLAM, I_DFNG, I_GQSINK, I_FFG, I_FFU, I_FFD, I_FFCW, I_FFCB, N_IN };

constexpr size_t MiB = 1u << 20;
constexpr size_t WS_CTL = 0, CTL_ZERO_BYTES = 1 * MiB;
constexpr int CW_BAR = 4096;
constexpr size_t WS_MOD = 1 * MiB;
constexpr size_t WS_TAB = 1 * MiB + 256 * 1024;
constexpr size_t WS_WIN = 2 * MiB, WIN_BYTES = (size_t)INP * D * 2;
constexpr size_t WS_WOUT = 12 * MiB, WOUT_BYTES = (size_t)D * D * 2;
constexpr size_t WS_WGU = 16 * MiB, WGU_BYTES = (size_t)NGU * D * 2;
constexpr size_t WS_WD = 38 * MiB, WD_BYTES = (size_t)D * DFF * 2;
constexpr size_t WS_XSC = 49 * MiB;
constexpr size_t WS_XN = 53 * MiB;
constexpr size_t WS_RP = 87 * MiB;
constexpr size_t WS_RF = 172 * MiB;
constexpr size_t FEAT1 = (size_t)MALL * 256 * 2;
constexpr size_t WS_GAL = WS_RF, WS_GBE = WS_GAL + 2 * FEAT1, WS_GKP = WS_GBE + 2 * FEAT1, WS_GRH = WS_GKP + 2 * FEAT1, WS_FV = WS_GRH + 2 * FEAT1;
constexpr size_t WS_GLT = WS_FV + FEAT1;
constexpr size_t WS_BON = WS_GLT + (size_t)2 * 272 * 256 * 4;
constexpr size_t WS_RF_END = WS_BON + (size_t)MALL * 4 * 4;
constexpr size_t WS_ACT = WS_RP;
constexpr size_t WS_FP = 181 * MiB;
constexpr size_t WS_SLO = WS_RF;
constexpr size_t WS_SLD = 215 * MiB;
constexpr size_t WS_END = 256 * MiB;
static_assert(WS_RF_END <= WS_END, "feature region");
static_assert(WS_FP + (size_t)MALL * D * 2 <= WS_SLD && WS_SLD + (size_t)11 * MCTX * D * 2 <= WS_END, "slabs");
static_assert(WS_ACT + (size_t)MALL * DFF * 2 <= WS_FP && WS_FP + (size_t)MALL * D * 4 <= WS_END, "ffn buffers");
static_assert(WS_XN + (size_t)MALL * D * 2 <= WS_RP && WS_RP + (size_t)MALL * INP * 2 <= WS_RF, "map");

constexpr int LDS_BYTES = 163840;
constexpr int LDSCTL_OFF = LDS_BYTES - 512, MISC_OFF = LDSCTL_OFF + 320;
constexpr int CW_QUEUE = 2048;

struct Args { const float* in[N_IN]; float* out; unsigned char* ws; int ph_lo, ph_hi; };


typedef const __attribute__((address_space(4))) char* kptr_t;
__device__ __forceinline__ kptr_t karg_base() { kptr_t k = (kptr_t)__builtin_amdgcn_kernarg_segment_ptr(); asm volatile("" : "+s"(k)); return k; }
__device__ __forceinline__ const float* kin(int i) { return *(const float* const __attribute__((address_space(4)))*)(karg_base() + 8 * i); }
__device__ __forceinline__ float* kout() { return *(float* const __attribute__((address_space(4)))*)(karg_base() + 8 * N_IN); }
__device__ __forceinline__ unsigned char* kws() { return *(unsigned char* const __attribute__((address_space(4)))*)(karg_base() + 8 * N_IN + 8); }

struct Frame {
    LAS unsigned char* lds;
    int tid, lane, wave, G, bid;
};

__device__ __forceinline__ float bf2f(bf16 h) { return __uint_as_float(((unsigned)h) << 16); }
template <int CTRL> __device__ __forceinline__ float dpp_mov(float x) { return __int_as_float(__builtin_amdgcn_update_dpp(0, __float_as_int(x), CTRL, 0xF, 0xF, false)); }
template <int CTRL> __device__ __forceinline__ float dpp_add(float x) { return x + dpp_mov<CTRL>(x); }
__device__ __forceinline__ float wave_sum(float v) {
    v = dpp_add<0xB1>(v); v = dpp_add<0x4E>(v); v = dpp_add<0x124>(v); v = dpp_add<0x128>(v);
    auto r = __builtin_amdgcn_permlane16_swap(__float_as_uint(v), __float_as_uint(v), false, false); v = __uint_as_float(r[0]) + __uint_as_float(r[1]);
    r = __builtin_amdgcn_permlane32_swap(__float_as_uint(v), __float_as_uint(v), false, false); return __uint_as_float(r[0]) + __uint_as_float(r[1]);
}
__device__ __forceinline__ float rdlane(float v, int l) { return __int_as_float(__builtin_amdgcn_readlane(__float_as_int(v), l)); }
__device__ __forceinline__ float sigmoidf_(float x) { return __builtin_amdgcn_rcpf(1.0f + __expf(-x)); }
typedef unsigned v2u __attribute__((ext_vector_type(2)));
typedef float f32x2_t __attribute__((ext_vector_type(2))); typedef __bf16 bf16x2_t __attribute__((ext_vector_type(2)));
__device__ __forceinline__ unsigned pk2h(float lo, float hi) { f32x2_t v = {lo, hi}; bf16x2_t b = __builtin_convertvector(v, bf16x2_t); return __builtin_bit_cast(unsigned, b); }
__device__ __forceinline__ float xmax4(float v) {
    auto r = __builtin_amdgcn_permlane16_swap(__float_as_uint(v), __float_as_uint(v), false, false); v = fmaxf(__uint_as_float(r[0]), __uint_as_float(r[1]));
    r = __builtin_amdgcn_permlane32_swap(__float_as_uint(v), __float_as_uint(v), false, false); return fmaxf(__uint_as_float(r[0]), __uint_as_float(r[1]));
}

__device__ __forceinline__ void p0_transpose_item(const float* W, int K, int N, bf16* WT, int row_off, LAS float* scr, int item, int lane) {
    const int nblk = N / 32, kb = item / nblk, nb = item % nblk, k0 = 64 * kb, n0 = 32 * nb;
#pragma unroll 8
    for (int i = 0; i < 32; ++i) { const int kk = 2 * i + (lane >> 5); scr[kk * 33 + (lane & 31)] = W[(size_t)(k0 + kk) * N + n0 + (lane & 31)]; }
    LDS_WAIT(); asm volatile("" ::: "memory");
    const int c = lane & 7;
#pragma unroll
    for (int j = 0; j < 4; ++j) { const int n = (lane >> 3) + 8 * j; const LAS float* s = scr + (8 * c) * 33 + n;
        v4u o; o.x = pk2h(s[0 * 33], s[1 * 33]); o.y = pk2h(s[2 * 33], s[3 * 33]); o.z = pk2h(s[4 * 33], s[5 * 33]); o.w = pk2h(s[6 * 33], s[7 * 33]);
        *(GAS v4u*)(WT + (size_t)(row_off + n0 + n) * K + k0 + 8 * c) = o; }
    LDS_WAIT(); asm volatile("" ::: "memory");
}

constexpr int WI_IN = 16 * (INW / 32), WI_OUT = 16 * 32, WI_G = 16 * (DFF / 32), WI_DN = (DFF / 64) * 32, WI_LAYER = WI_IN + WI_OUT + 2 * WI_G + WI_DN;
__device__ __forceinline__ void weight_item(int it, LAS float* scr, int lane) {
    unsigned char* ws = kws();
    const int l = it / WI_LAYER; int r = it % WI_LAYER;
    if (r < WI_IN) { p0_transpose_item(kin(I_WIN) + (size_t)l * D * INW, D, INW, (bf16*)(ws + WS_WIN + l * WIN_BYTES), 0, scr, r, lane); return; } r -= WI_IN;
    if (r < WI_OUT) { p0_transpose_item(kin(I_WOUT) + (size_t)l * D * D, D, D, (bf16*)(ws + WS_WOUT + l * WOUT_BYTES), 0, scr, r, lane); return; } r -= WI_OUT;
    if (r < WI_G) { const int n0 = 32 * (r % (DFF / 32)); p0_transpose_item(kin(I_FFG) + (size_t)l * D * DFF, D, DFF, (bf16*)(ws + WS_WGU + l * WGU_BYTES), 256 * (n0 >> 7) + (n0 & 127) - n0, scr, r, lane); return; } r -= WI_G;
    if (r < WI_G) { const int n0 = 32 * (r % (DFF / 32)); p0_transpose_item(kin(I_FFU) + (size_t)l * D * DFF, D, DFF, (bf16*)(ws + WS_WGU + l * WGU_BYTES), 256 * (n0 >> 7) + (n0 & 127) - n0 + 128, scr, r, lane); return; } r -= WI_G;
    p0_transpose_item(kin(I_FFD) + (size_t)l * DFF * D, DFF, D, (bf16*)(ws + WS_WD + l * WD_BYTES), 0, scr, r, lane);
}
constexpr int WI_FILL = (2 * WI_LAYER - WI_IN + 127) / 128;

__device__ __forceinline__ void p0_prologue(const Args& A, Frame& F) {
    unsigned char* ws = kws();
    {
        LAS float* sc = (LAS float*)F.lds;
        LAS float* red = (LAS float*)(F.lds + 20480);
        float* mod = (float*)(ws + WS_MOD);
        for (int u = F.bid; u < 192; u += F.G) {
            __syncthreads();
            for (int i = F.tid; i < 5 * 1024; i += NTHR) { const int bb = i >> 10, k = i & 1023; const float v = bb < 4 ? kin(I_C)[bb * 1024 + k] : kin(I_CCTX)[k]; sc[i] = v / (1.0f + __expf(-v)); }
            __syncthreads();
            const int l = u / 96, cc = u % 96, col = cc * 64 + (F.tid & 63), ks = F.tid >> 6;
            const float* w = kin(I_ADAW) + (size_t)l * 1024 * 6144 + col;
            float acc[5] = {0.f, 0.f, 0.f, 0.f, 0.f};
            for (int k0 = ks * 128; k0 < ks * 128 + 128; k0 += 16) { float wv[16];
#pragma unroll
                for (int q = 0; q < 16; ++q) wv[q] = w[(size_t)(k0 + q) * 6144];
#pragma unroll
                for (int q = 0; q < 16; ++q)
#pragma unroll
                    for (int bb = 0; bb < 5; ++bb) acc[bb] += sc[bb * 1024 + k0 + q] * wv[q]; }
#pragma unroll
            for (int bb = 0; bb < 5; ++bb) red[(ks * 5 + bb) * 64 + (F.tid & 63)] = acc[bb];
            __syncthreads();
            if (F.tid < 320) { const int bb = F.tid >> 6, c = F.tid & 63; float s = kin(I_ADAB)[l * 6144 + cc * 64 + c];
#pragma unroll
                for (int k8 = 0; k8 < 8; ++k8) s += red[(k8 * 5 + bb) * 64 + c];
                mod[(size_t)(l * 5 + bb) * 6144 + cc * 64 + c] = s; }
        }
        __syncthreads();
    }
    {
        LAS float* scr = (LAS float*)(F.lds + F.wave * 16384);
        const int gw = F.bid * NWAVES + F.wave, NGW = F.G * NWAVES;
        for (int it = gw; it < WI_IN; it += NGW) weight_item(it, scr, F.lane);
        const int gt = F.bid * NTHR + F.tid, NGT = F.G * NTHR;
        for (int i = gt; i < 2 * 8192; i += NGT) { const int l = i >> 13, j = i & 8191;
            *(GAS v4u*)(ws + WS_WIN + l * WIN_BYTES + (size_t)INW * D * 2 + (size_t)j * 16) = (v4u){0u, 0u, 0u, 0u}; }
    }
    if (F.bid == 0) {
        float* tab = (float*)(ws + WS_TAB);
        for (int i = F.tid; i < 512; i += NTHR) { const int pos = i >> 3, f = i & 7; const float inv = __builtin_amdgcn_exp2f(-(float)f * (13.287712379549449f / 8.0f)), ang = (float)pos * inv; tab[i] = __cosf(ang); tab[512 + i] = __sinf(ang); }
        for (int i = F.tid; i < 1024; i += NTHR) { const int pos = i >> 4, f = i & 15; const float inv = __builtin_amdgcn_exp2f(-(float)f * (13.287712379549449f / 16.0f)), ang = (float)pos * inv; tab[1024 + i] = __cosf(ang); tab[2048 + i] = __sinf(ang); }
        if (F.tid < 2) { const int l = F.tid; const float* lv = kin(I_DFLAM) + l * 128; float s1 = 0.f, s2 = 0.f;
            for (int i = 0; i < 32; ++i) { s1 += lv[i] * lv[32 + i]; s2 += lv[64 + i] * lv[96 + i]; }
            const float lam_init = 0.8f - 0.6f * __expf(-0.3f * (float)l);
            tab[3072 + l] = __expf(s1) - __expf(s2) + lam_init; tab[3074 + l] = lam_init; }
    }
}

__device__ __forceinline__ const float* mod_vec(const Args& A, int l, int bb, int i) { return (const float*)(kws() + WS_MOD) + ((size_t)(l * 5 + bb) * 6 + i) * 1024; }
__device__ __forceinline__ const float* normg_vec(const Args& A, int l, int i) { return kin(I_NORMG) + (size_t)(l * 4 + i) * 1024; }
__device__ __forceinline__ int row_bb(int row) { return row < MLAT ? (row >> 12) : 4; }
__device__ __forceinline__ void seq_pos(int row, int& t, int& T) { if (row < MLAT) { t = row & (SEQ - 1); T = SEQ; } else { t = (row - MLAT) & (CTXL - 1); T = CTXL; } }
__device__ __forceinline__ void ld16(const float* p, int lane, f32x4 (&v)[4]) {
#pragma unroll
    for (int j = 0; j < 4; ++j) v[j] = *(const f32x4*)(p + 4 * lane + 256 * j);
}
__device__ __forceinline__ void ld16b(const bf16* p, int lane, f32x4 (&v)[4]) {
#pragma unroll
    for (int j = 0; j < 4; ++j) { const v2u u = *(const v2u*)(p + 4 * lane + 256 * j);
        v[j] = (f32x4){__uint_as_float(u.x << 16), __uint_as_float(u.x & 0xffff0000u), __uint_as_float(u.y << 16), __uint_as_float(u.y & 0xffff0000u)}; }
}
__device__ __forceinline__ void st16(float* p, int lane, const f32x4 (&v)[4]) {
#pragma unroll
    for (int j = 0; j < 4; ++j) *(f32x4*)(p + 4 * lane + 256 * j) = v[j];
}
__device__ __forceinline__ float sumsq16(const f32x4 (&v)[4]) {
    float s = 0.f;
#pragma unroll
    for (int j = 0; j < 4; ++j) s += (v[j].x * v[j].x + v[j].y * v[j].y) + (v[j].z * v[j].z + v[j].w * v[j].w);
    return wave_sum(s);
}
__device__ __forceinline__ void norm_mod_store(const f32x4 (&v)[4], float rstd, const float* g, const float* sc, const float* sh, bf16* orow, int lane) {
#pragma unroll
    for (int j = 0; j < 4; ++j) {
        const int c = 4 * lane + 256 * j;
        const f32x4 gg = *(const f32x4*)(g + c), s1 = *(const f32x4*)(sc + c), s0 = *(const f32x4*)(sh + c);
        const f32x4 h = v[j] * rstd * gg * (s1 + 1.0f) + s0;
        v2u o; o.x = pk2h(h.x, h.y); o.y = pk2h(h.z, h.w);
        *(v2u*)(orow + c) = o;
    }
}
__device__ __forceinline__ float* xs_row(const Args& A, int row) { return row < MLAT ? kout() + (size_t)row * D : (float*)(kws() + WS_XSC) + (size_t)(row - MLAT) * D; }
__device__ __forceinline__ const float* xin_row(const Args& A, int row) { return row < MLAT ? kin(I_X) + (size_t)row * D : kin(I_CTX) + (size_t)(row - MLAT) * D; }

__device__ __forceinline__ void phase_prep(const Args& A, Frame& F) {
    const int gw = F.bid * NWAVES + F.wave, NGW = F.G * NWAVES;
    bf16* XN = (bf16*)(kws() + WS_XN);
    f32x4 v[4], vn[4];
    if (gw < MALL) ld16(xin_row(A, gw), F.lane, v);
    for (int row = gw; row < MALL; row += NGW) {
        if (row + NGW < MALL) ld16(xin_row(A, row + NGW), F.lane, vn);
        const float rstd = rsqrtf(sumsq16(v) * (1.0f / D) + NORM_EPS);
        const int bb = row_bb(row);
        norm_mod_store(v, rstd, normg_vec(A, 0, 0), mod_vec(A, 0, bb, 1), mod_vec(A, 0, bb, 0), XN + (size_t)row * D, F.lane);
#pragma unroll
        for (int j = 0; j < 4; ++j) v[j] = vn[j];
    }
}
__device__ __forceinline__ void phase_e1(const Args& A, Frame& F, int l) {
    const int gw = F.bid * NWAVES + F.wave, NGW = F.G * NWAVES, nrows = l == 0 ? MALL : MLAT;
    bf16* XN = (bf16*)(kws() + WS_XN); const bf16* YP = (const bf16*)(kws() + WS_RP);
    for (int row = gw; row < nrows; row += NGW) {
        const int bb = row_bb(row);
        f32x4 y[4], x[4];
        if (l == 0 && row >= MLAT) { const bf16* sl = (const bf16*)(kws() + WS_SLO) + (size_t)(row - MLAT) * D; ld16b(sl, F.lane, y);
            for (int s = 1; s < 4; ++s) { f32x4 t[4]; ld16b(sl + (size_t)s * MCTX * D, F.lane, t);
#pragma unroll
                for (int j = 0; j < 4; ++j) y[j] = y[j] + t[j]; } }
        else ld16b(YP + (size_t)row * D, F.lane, y);
        if (l == 0) ld16(xin_row(A, row), F.lane, x); else ld16(xs_row(A, row), F.lane, x);
        const float ry = rsqrtf(sumsq16(y) * (1.0f / D) + NORM_EPS);
        const float* g1 = normg_vec(A, l, 1); const float* ga = mod_vec(A, l, bb, 2);
#pragma unroll
        for (int j = 0; j < 4; ++j) { const int c = 4 * F.lane + 256 * j; x[j] = x[j] + *(const f32x4*)(ga + c) * (y[j] * ry * *(const f32x4*)(g1 + c)); }
        st16(xs_row(A, row), F.lane, x);
        const float rx = rsqrtf(sumsq16(x) * (1.0f / D) + NORM_EPS);
        norm_mod_store(x, rx, normg_vec(A, l, 2), mod_vec(A, l, bb, 4), mod_vec(A, l, bb, 3), XN + (size_t)row * D, F.lane);
    }
}
__device__ __forceinline__ void phase_e2(const Args& A, Frame& F, int l, int r0, int r1) {
    const int gw = F.bid * NWAVES + F.wave, NGW = F.G * NWAVES;
    bf16* XN = (bf16*)(kws() + WS_XN); const bf16* FP = (const bf16*)(kws() + WS_FP);
    for (int row = r0 + gw; row < r1; row += NGW) {
        const int bb = row_bb(row);
        f32x4 y[4], x[4];
        if (l == 0 && row >= MLAT) { const bf16* sl = (const bf16*)(kws() + WS_SLD) + (size_t)(row - MLAT) * D; ld16b(sl, F.lane, y);
            for (int s = 1; s < 11; ++s) { f32x4 t[4]; ld16b(sl + (size_t)s * MCTX * D, F.lane, t);
#pragma unroll
                for (int j = 0; j < 4; ++j) y[j] = y[j] + t[j]; } }
        else ld16b(FP + (size_t)(row - r0) * D, F.lane, y);
        ld16(xs_row(A, row), F.lane, x);
        const float ry = rsqrtf(sumsq16(y) * (1.0f / D) + NORM_EPS);
        const float* g3 = normg_vec(A, l, 3); const float* ga = mod_vec(A, l, bb, 5);
#pragma unroll
        for (int j = 0; j < 4; ++j) { const int c = 4 * F.lane + 256 * j; x[j] = x[j] + *(const f32x4*)(ga + c) * (y[j] * ry * *(const f32x4*)(g3 + c)); }
        st16(xs_row(A, row), F.lane, x);
        if (l == 0) {
            const float rx = rsqrtf(sumsq16(x) * (1.0f / D) + NORM_EPS);
            norm_mod_store(x, rx, normg_vec(A, 1, 0), mod_vec(A, 1, bb, 1), mod_vec(A, 1, bb, 0), XN + (size_t)row * D, F.lane);
        }
    }
}
__device__ __forceinline__ void phase_act(const Args& A, Frame& F, int l, int r0, int r1) {
    const bf16* GU = (const bf16*)(kws() + WS_RP); bf16* ACT = (bf16*)(kws() + WS_ACT);
    const float* cw = kin(I_FFCW) + (size_t)l * 3 * DFF; const float* cb = kin(I_FFCB) + (size_t)l * DFF;
    const int nch = DFF / 8, total = (r1 - r0) * nch;
    for (int i = F.bid * NTHR + F.tid; i < total; i += F.G * NTHR) {
        const int rr = i / nch, ch = i % nch, row = r0 + rr, j0 = ch * 8;
        const int t = row < MLAT ? (row & (SEQ - 1)) : ((row - MLAT) & (CTXL - 1)), T = row < MLAT ? SEQ : CTXL;
        const bf16* gp = GU + (size_t)rr * NGU + j0;
        const v4u gc = *(const v4u*)gp, uu = *(const v4u*)(gp + DFF);
        v4u gm = (v4u){0u, 0u, 0u, 0u}, gn = (v4u){0u, 0u, 0u, 0u};
        if (t > 0) gm = *(const v4u*)(gp - NGU);
        if (t < T - 1) gn = *(const v4u*)(gp + NGU);
        unsigned o[4];
#pragma unroll
        for (int q = 0; q < 4; ++q) {
            float r2[2];
#pragma unroll
            for (int e = 0; e < 2; ++e) {
                const int j = j0 + 2 * q + e;
                const float a = __uint_as_float(e ? (gm[q] & 0xffff0000u) : (gm[q] << 16)), b = __uint_as_float(e ? (gc[q] & 0xffff0000u) : (gc[q] << 16)), c = __uint_as_float(e ? (gn[q] & 0xffff0000u) : (gn[q] << 16));
                const float u = __uint_as_float(e ? (uu[q] & 0xffff0000u) : (uu[q] << 16));
                const float z = a * cw[j] + b * cw[DFF + j] + c * cw[2 * DFF + j] + cb[j];
                r2[e] = z / (1.0f + __expf(-z)) * u;
            }
            o[q] = pk2h(r2[0], r2[1]);
        }
        *(v4u*)(ACT + (size_t)rr * DFF + j0) = (v4u){o[0], o[1], o[2], o[3]};
    }
}

struct EpiMulti {
    static constexpr bool PERM = false, AFTER_DRAIN = false;
    int mode;
    bf16* ob; float* of; int ld; const float* tab;
    const float* cw; const float* cb; int nrows; unsigned ldsx;
    __device__ __forceinline__ void operator()(const pg8::f32x4 (&acc)[2][2][4][2], const pg8::Unit& u, int wr, int wc, int fr_, int fq_) const {
        int fr = fr_, fq = fq_; asm volatile("" : "+v"(fr), "+v"(fq));
        if (mode == 1) {
#pragma unroll
            for (int ai = 0; ai < 2; ++ai)
#pragma unroll
                for (int m = 0; m < 4; ++m) { float* rp = of + (size_t)(u.pm * 256 + ai * 128 + wr * 64 + m * 16 + fr) * ld + u.pn * 256 + wc * 32 + 4 * fq;
#pragma unroll
                    for (int bj = 0; bj < 2; ++bj)
#pragma unroll
                        for (int n = 0; n < 2; ++n) *(pg8::f32x4*)(rp + bj * 128 + n * 16) = acc[ai][bj][m][n]; }
        } else if (mode == 3) {
            const unsigned par = (unsigned)(u.pm + u.pn) & 1u;
            const unsigned ex = ldsx + par * 4096u + (unsigned)(wc * 32 + 4 * fq) * 4u;
#pragma unroll
            for (int ai = 0; ai < 2; ++ai)
#pragma unroll
                for (int n = 0; n < 2; ++n) {
                    if (fr == 0) *(LAS pg8::f32x4*)(uintptr_t)(ex + (unsigned)(((ai * 2 + wr) * 2 + 0) * 128 + n * 16) * 4u) = acc[ai][0][0][n];
                    if (fr == 15) *(LAS pg8::f32x4*)(uintptr_t)(ex + (unsigned)(((ai * 2 + wr) * 2 + 1) * 128 + n * 16) * 4u) = acc[ai][0][3][n];
                }
            asm volatile("s_waitcnt lgkmcnt(0)" ::: "memory"); __builtin_amdgcn_s_barrier(); asm volatile("" ::: "memory");
            const int jb = u.pn * 128 + wc * 32 + 4 * fq;
#pragma unroll
            for (int n = 0; n < 2; ++n) {
                const int j = jb + 16 * n;
                const pg8::f32x4 w0 = *(const pg8::f32x4*)(cw + j), w1 = *(const pg8::f32x4*)(cw + DFF + j), w2 = *(const pg8::f32x4*)(cw + 2 * DFF + j), bb = *(const pg8::f32x4*)(cb + j);
#pragma unroll
                for (int ai = 0; ai < 2; ++ai) {
                    const int pblk = (ai * 2 + wr) - 1, nblk = (ai * 2 + wr) + 1;
                    pg8::f32x4 eprev = (pg8::f32x4){0.f, 0.f, 0.f, 0.f}, enext = eprev;
                    if (pblk >= 0) eprev = *(LAS const pg8::f32x4*)(uintptr_t)(ex + (unsigned)((pblk * 2 + 1) * 128 + n * 16) * 4u);
                    if (nblk <= 3) enext = *(LAS const pg8::f32x4*)(uintptr_t)(ex + (unsigned)((nblk * 2 + 0) * 128 + n * 16) * 4u);
#pragma unroll
                    for (int mm = 0; mm < 4; ++mm) {
                        const int trow = ai * 128 + wr * 64 + mm * 16 + fr, grow = u.pm * 254 - 1 + trow;
                        int t, T; seq_pos(grow < 0 ? 0 : grow, t, T);
                        const pg8::f32x4 gc = acc[ai][0][mm][n], uu = acc[ai][1][mm][n];
                        pg8::f32x4 gp, gn;
#pragma unroll
                        for (int i = 0; i < 4; ++i) {
                            const float pold = mm > 0 ? __int_as_float(__builtin_amdgcn_update_dpp(0, __float_as_int(acc[ai][0][mm > 0 ? mm - 1 : 0][n][i]), 0x121, 0xF, 0xF, false)) : eprev[i];
                            gp[i] = __int_as_float(__builtin_amdgcn_update_dpp(__float_as_int(pold), __float_as_int(gc[i]), 0x111, 0xF, 0xF, false));
                            const float nold = mm < 3 ? __int_as_float(__builtin_amdgcn_update_dpp(0, __float_as_int(acc[ai][0][mm < 3 ? mm + 1 : 3][n][i]), 0x12F, 0xF, 0xF, false)) : enext[i];
                            gn[i] = __int_as_float(__builtin_amdgcn_update_dpp(__float_as_int(nold), __float_as_int(gc[i]), 0x101, 0xF, 0xF, false));
                        }
                        if (t == 0) gp = (pg8::f32x4){0.f, 0.f, 0.f, 0.f};
                        if (t == T - 1) gn = (pg8::f32x4){0.f, 0.f, 0.f, 0.f};
                        const pg8::f32x4 z = gp * w0 + gc * w1 + gn * w2 + bb;
                        pg8::f32x4 a;
#pragma unroll
                        for (int i = 0; i < 4; ++i) a[i] = z[i] * __builtin_amdgcn_rcpf(1.0f + __expf(-z[i])) * uu[i];
                        if (trow >= 1 && trow <= 254 && grow < nrows) { v2u o; o.x = pk2h(a[0], a[1]); o.y = pk2h(a[2], a[3]); *(v2u*)(ob + (size_t)grow * DFF + j) = o; }
                    }
                }
            }
        } else if (mode == 2) {
#pragma unroll
            for (int ai = 0; ai < 2; ++ai)
#pragma unroll
                for (int m = 0; m < 4; ++m) { bf16* rp = ob + (size_t)(u.pm * 256 + ai * 128 + wr * 64 + m * 16 + fr) * ld + u.pn * 256 + wc * 32 + 4 * fq;
#pragma unroll
                    for (int bj = 0; bj < 2; ++bj)
#pragma unroll
                        for (int n = 0; n < 2; ++n) { const pg8::f32x4 v = acc[ai][bj][m][n]; v2u o; o.x = pk2h(v[0], v[1]); o.y = pk2h(v[2], v[3]); *(v2u*)(rp + bj * 128 + n * 16) = o; } }
        } else {
            const bool latent = u.pm < (MLAT / 256);
#pragma unroll
            for (int bj = 0; bj < 2; ++bj) {
                const int g32 = u.pn * 8 + bj * 4 + wc;
                if (g32 >= INW / 32) continue;
                const bool isdf = (g32 >= C_DFQ / 32 && g32 < C_DFV / 32), isgq = (g32 >= C_GQQ / 32 && g32 < C_GQV / 32);
                const float qs = (g32 >= C_DFQ / 32 && g32 < C_DFK / 32) ? SC_DF : ((g32 >= C_GQQ / 32 && g32 < C_GQK / 32) ? SC_GQ : 1.0f);
#pragma unroll
                for (int ai = 0; ai < 2; ++ai)
#pragma unroll
                    for (int m = 0; m < 4; ++m) {
                        const int row = u.pm * 256 + ai * 128 + wr * 64 + m * 16 + fr, s = row & (SEQ - 1), prow = s >> 6, pcol = s & 63;
                        pg8::f32x4 v0 = acc[ai][bj][m][0], v1 = acc[ai][bj][m][1];
                        if (isdf) {
                            pg8::f32x4 p0, p1;
#pragma unroll
                            for (int i = 0; i < 4; ++i) { p0[i] = __shfl_xor(v0[i], 32); p1[i] = __shfl_xor(v1[i], 32); }
                            if (latent) {
                                const int f0 = 4 * (fq & 1);
                                const pg8::f32x4 c0 = *(const pg8::f32x4*)(tab + prow * 8 + f0), s0 = *(const pg8::f32x4*)(tab + 512 + prow * 8 + f0);
                                const pg8::f32x4 c1 = *(const pg8::f32x4*)(tab + pcol * 8 + f0), s1 = *(const pg8::f32x4*)(tab + 512 + pcol * 8 + f0);
                                if (fq & 2) { v0 = v0 * c0 + p0 * s0; v1 = v1 * c1 + p1 * s1; } else { v0 = v0 * c0 - p0 * s0; v1 = v1 * c1 - p1 * s1; }
                            }
                        } else if (isgq) {
                            if (latent) {
                                const int pos = (g32 & 1) ? pcol : prow;
                                const pg8::f32x4 cc = *(const pg8::f32x4*)(tab + 1024 + pos * 16 + 4 * fq), ss = *(const pg8::f32x4*)(tab + 2048 + pos * 16 + 4 * fq);
                                const pg8::f32x4 a = v0 * cc - v1 * ss, b = v1 * cc + v0 * ss; v0 = a; v1 = b;
                            }
                        }
                        v0 = v0 * qs; v1 = v1 * qs;
                        bf16* rp = ob + (size_t)row * INP + g32 * 32 + 4 * fq;
                        v2u o; o.x = pk2h(v0[0], v0[1]); o.y = pk2h(v0[2], v0[3]); *(v2u*)rp = o;
                        o.x = pk2h(v1[0], v1[1]); o.y = pk2h(v1[2], v1[3]); *(v2u*)(rp + 16) = o;
                        asm volatile("" ::: "memory");
                    }
            }
        }
    }
};


template <int CTRL, int RM> __device__ __forceinline__ float dpp_mul1(float x) {
    return x * __int_as_float(__builtin_amdgcn_update_dpp(0x3f800000, __float_as_int(x), CTRL, RM, 0xF, false));
}
__device__ __forceinline__ float wave_mulscan(float x) {
    x = dpp_mul1<0x111, 0xF>(x); x = dpp_mul1<0x112, 0xF>(x); x = dpp_mul1<0x114, 0xF>(x); x = dpp_mul1<0x118, 0xF>(x);
    x = dpp_mul1<0x142, 0xA>(x); x = dpp_mul1<0x143, 0xC>(x); return x;
}
__device__ __forceinline__ float wave_shr1_one(float x) { return __int_as_float(__builtin_amdgcn_update_dpp(0x3f800000, __float_as_int(x), 0x138, 0xF, 0xF, false)); }
__device__ __forceinline__ bf16 bf1(float x) { return (bf16)(pk2h(x, 0.f) & 0xffffu); }

constexpr int FT_LD = 65, FT_ARR = 64 * FT_LD * 4;
constexpr int FT_BON = 9 * FT_ARR;
constexpr int FT_PR_LD = 200;
static_assert(66 * FT_PR_LD * 2 <= 2 * FT_ARR && FT_BON + 512 <= LDSCTL_OFF, "features LDS map");
__device__ __forceinline__ void rwkv_features(const Args& A, Frame& F, int l) {
    const int w = F.wave, n = F.lane, c15 = n & 15, g = n >> 4, tr = w >> 1, tc0 = (w & 1) * 2;
    const int h = F.bid & 3, c = h * 64 + n;
    const bf16* P = (const bf16*)(kws() + WS_RP);
    bf16* FV = (bf16*)(kws() + WS_FV); float* BON = (float*)(kws() + WS_BON); float* GLT = (float*)(kws() + WS_GLT);
    float cw[3][3];
#pragma unroll
    for (int tp = 0; tp < 3; ++tp)
#pragma unroll
        for (int j = 0; j < 3; ++j) cw[tp][j] = kin(I_RWCONV)[(size_t)(l * 3 + tp) * 768 + j * 256 + c];
    const float kkc = kin(I_RWKK)[l * 256 + c];
    bf16x8 Bw[2][2], Ba[2][2]; float w0c[2][2], a0c[2][2], kac2[2], rkc2[2];
#pragma unroll
    for (int t = 0; t < 2; ++t) { const int cn = h * 64 + 16 * (tc0 + t) + c15;
        kac2[t] = kin(I_RWKA)[l * 256 + cn]; rkc2[t] = kin(I_RWRK)[l * 256 + cn];
#pragma unroll
        for (int d = 0; d < 2; ++d) { w0c[d][t] = kin(I_RWW0)[(l * 2 + d) * 256 + cn]; a0c[d][t] = kin(I_RWA0)[(l * 2 + d) * 256 + cn];
            unsigned pw[4], pa[4];
#pragma unroll
            for (int j = 0; j < 8; j += 2) { const size_t o = ((size_t)(l * 2 + d) * 32 + 8 * g + j) * 256 + cn;
                pw[j >> 1] = pk2h(kin(I_RWWUP)[o], kin(I_RWWUP)[o + 256]); pa[j >> 1] = pk2h(kin(I_RWAUP)[o], kin(I_RWAUP)[o + 256]); }
            Bw[d][t] = __builtin_bit_cast(bf16x8, (v4u){pw[0], pw[1], pw[2], pw[3]}); Ba[d][t] = __builtin_bit_cast(bf16x8, (v4u){pa[0], pa[1], pa[2], pa[3]}); }
    }
    for (int u = F.bid; u < 4 * (MALL / 64); u += F.G) {
        const int gi = u >> 2, row0 = 64 * gi;
        int t0, T; seq_pos(row0, t0, T);
        __syncthreads();
        for (int p = F.tid; p < 66 * 24; p += NTHR) { const int rr = p / 24, q = p % 24, which = q >> 3, ch = q & 7, row = row0 - 1 + rr;
            const bool ok = (rr >= 1 && rr <= 64) || (rr == 0 ? t0 > 0 : t0 + 64 < T);
            v4u v = (v4u){0u, 0u, 0u, 0u};
            if (ok) v = *(const v4u*)(P + (size_t)row * INP + which * 256 + h * 64 + 8 * ch);
            *(LAS v4u*)(F.lds + (rr * FT_PR_LD + which * 64 + 8 * ch) * 2) = v; }
        v4u xwd[2], xad[2];
        { const bf16* pr = P + (size_t)(row0 + 16 * tr + c15) * INP + 8 * g;
#pragma unroll
          for (int d = 0; d < 2; ++d) { xwd[d] = *(const v4u*)(pr + C_WD + 32 * d); xad[d] = *(const v4u*)(pr + C_AD + 32 * d); } }
        __syncthreads();
#pragma unroll
        for (int rr = 0; rr < 8; ++rr) {
            const int i = 8 * w + rr;
            float xr[3], xk[3], xv[3];
#pragma unroll
            for (int tp = 0; tp < 3; ++tp) { const LAS bf16* pp = (const LAS bf16*)F.lds + (i + tp) * FT_PR_LD + n; xr[tp] = bf2f(pp[0]); xk[tp] = bf2f(pp[64]); xv[tp] = bf2f(pp[128]); }
            const float rq = bf2f(bf1(xr[0] * cw[0][0] + xr[1] * cw[1][0] + xr[2] * cw[2][0])), kq = bf2f(bf1(xk[0] * cw[0][1] + xk[1] * cw[1][1] + xk[2] * cw[2][1]));
            FV[(size_t)(row0 + i) * 256 + c] = bf1(xv[0] * cw[0][2] + xv[1] * cw[1][2] + xv[2] * cw[2][2]);
            const float kkraw = kq * kkc;
            const float kk = kkraw * (1.0f / fmaxf(sqrtf(wave_sum(kkraw * kkraw)), 1e-12f));
            LAS float* L = (LAS float*)F.lds + i * FT_LD + n;
            L[2 * (FT_ARR / 4)] = kk; L[7 * (FT_ARR / 4)] = rq; L[8 * (FT_ARR / 4)] = kq;
        }
        __syncthreads();
        {
            bf16x8 aw[2], aa[2];
#pragma unroll
            for (int d = 0; d < 2; ++d) { unsigned pw[4];
#pragma unroll
                for (int q = 0; q < 4; ++q) { const float x0 = __uint_as_float(xwd[d][q] << 16), x1 = __uint_as_float(xwd[d][q] & 0xffff0000u);
                    pw[q] = pk2h(1.0f - 2.0f * __builtin_amdgcn_rcpf(1.0f + __expf(2.0f * x0)), 1.0f - 2.0f * __builtin_amdgcn_rcpf(1.0f + __expf(2.0f * x1))); }
                aw[d] = __builtin_bit_cast(bf16x8, (v4u){pw[0], pw[1], pw[2], pw[3]}); aa[d] = __builtin_bit_cast(bf16x8, xad[d]); }
            float bsum[4] = {0.f, 0.f, 0.f, 0.f};
#pragma unroll
            for (int t = 0; t < 2; ++t) {
                float kkv[4], kqv[4], rqv[4];
#pragma unroll
                for (int r = 0; r < 4; ++r) { const LAS float* L = (const LAS float*)F.lds + (16 * tr + 4 * g + r) * FT_LD + 16 * (tc0 + t) + c15;
                    kkv[r] = L[2 * (FT_ARR / 4)]; rqv[r] = L[7 * (FT_ARR / 4)]; kqv[r] = L[8 * (FT_ARR / 4)]; }
#pragma unroll
                for (int d = 0; d < 2; ++d) {
                    const f32x4 wl = __builtin_amdgcn_mfma_f32_16x16x32_bf16(aw[d], Bw[d][t], (f32x4){0.f, 0.f, 0.f, 0.f}, 0, 0, 0);
                    const f32x4 al = __builtin_amdgcn_mfma_f32_16x16x32_bf16(aa[d], Ba[d][t], (f32x4){0.f, 0.f, 0.f, 0.f}, 0, 0, 0);
#pragma unroll
                    for (int r = 0; r < 4; ++r) {
                        const float wv = 1.0f + bf2f(bf1(__expf(-0.6065306597126334f * sigmoidf_(wl[r] + w0c[d][t])) - 1.0f)), aq = bf2f(bf1(sigmoidf_(al[r] + a0c[d][t])));
                        const float kd = kqv[r] * (1.0f + (aq - 1.0f) * kac2[t]);
                        LAS float* L = (LAS float*)F.lds + (16 * tr + 4 * g + r) * FT_LD + 16 * (tc0 + t) + c15;
                        L[(0 + d) * (FT_ARR / 4)] = wv; L[(3 + d) * (FT_ARR / 4)] = kkv[r] * aq; L[(5 + d) * (FT_ARR / 4)] = kd;
                        bsum[r] += rqv[r] * kd * rkc2[t];
                    }
                }
            }
#pragma unroll
            for (int r = 0; r < 4; ++r) { float s = bsum[r]; s = dpp_add<0xB1>(s); s = dpp_add<0x4E>(s); s = dpp_add<0x124>(s); s = dpp_add<0x128>(s);
                if (c15 == 0) *(LAS float*)(F.lds + FT_BON + ((w & 1) * 64 + 16 * tr + 4 * g + r) * 4) = s; }
        }
        __syncthreads();
        if (F.tid < 64) BON[(row0 + F.tid) * 4 + h] = *(LAS float*)(F.lds + FT_BON + F.tid * 4) + *(LAS float*)(F.lds + FT_BON + (64 + F.tid) * 4);
#pragma unroll
        for (int d = 0; d < 2; ++d) {
            const int i = d ? 63 - n : n;
            const LAS float* L = (const LAS float*)F.lds + i * FT_LD + 8 * w;
            unsigned al8[4], be8[4], kp8[4], rh8[4]; float g63[8];
#pragma unroll
            for (int e2 = 0; e2 < 4; ++e2) {
                float alv[2], bev[2], kpv[2], rhv[2];
#pragma unroll
                for (int q = 0; q < 2; ++q) { const int e = 2 * e2 + q;
                    const float gi_ = wave_mulscan(L[(0 + d) * (FT_ARR / 4) + e]), gim1 = wave_shr1_one(gi_), ig = __builtin_amdgcn_rcpf(gi_);
                    g63[e] = rdlane(gi_, 63);
                    alv[q] = gim1 * L[2 * (FT_ARR / 4) + e]; bev[q] = L[(3 + d) * (FT_ARR / 4) + e] * ig; kpv[q] = L[(5 + d) * (FT_ARR / 4) + e] * ig; rhv[q] = gi_ * L[7 * (FT_ARR / 4) + e]; }
                al8[e2] = pk2h(alv[0], alv[1]); be8[e2] = pk2h(bev[0], bev[1]); kp8[e2] = pk2h(kpv[0], kpv[1]); rh8[e2] = pk2h(rhv[0], rhv[1]);
            }
            const size_t o = (size_t)d * MALL * 256 + (size_t)(64 * gi + i) * 256 + h * 64 + 8 * w;
            *(v4u*)((bf16*)(kws() + WS_GAL) + o) = (v4u){al8[0], al8[1], al8[2], al8[3]}; *(v4u*)((bf16*)(kws() + WS_GBE) + o) = (v4u){be8[0], be8[1], be8[2], be8[3]};
            *(v4u*)((bf16*)(kws() + WS_GKP) + o) = (v4u){kp8[0], kp8[1], kp8[2], kp8[3]}; *(v4u*)((bf16*)(kws() + WS_GRH) + o) = (v4u){rh8[0], rh8[1], rh8[2], rh8[3]};
            if (n < 8) { float gl = g63[0];
#pragma unroll
                for (int e = 1; e < 8; ++e) gl = (n == e) ? g63[e] : gl;
                GLT[((size_t)d * 272 + gi) * 256 + h * 64 + 8 * w + n] = gl; }
        }
    }
}

__device__ __forceinline__ int scan_row(int d, int b, int i) { if (i < CTXL) { const int t = d ? CTXL - 1 - i : i; return MLAT + b * CTXL + t; } const int j = i - CTXL, t = d ? SEQ - 1 - j : j; return b * SEQ + t; }

__device__ __forceinline__ void rwkv_readout(const Args& A, Frame& F, int l) {
    const int gw = F.bid * NWAVES + F.wave, NGW = F.G * NWAVES, nrows = l == 0 ? MALL : MLAT;
    const int h = gw & 3, n = F.lane, c = h * 64 + n;
    const bf16* P = (const bf16*)(kws() + WS_RP); const bf16* FV = (const bf16*)(kws() + WS_FV);
    const float* BON = (const float*)(kws() + WS_BON); bf16* Y = (bf16*)(kws() + WS_XN);
    float gupr[64];
#pragma unroll
    for (int j = 0; j < 64; ++j) gupr[j] = kin(I_RWGUP)[((size_t)l * 64 + j) * 256 + c];
    const float lng = kin(I_RWLNG)[l * 256 + c], lnb = kin(I_RWLNB)[l * 256 + c];
    bf16 q0 = 0, q1 = 0, qg = 0, qv = 0; float qb = 0.f;
#define RO_LOAD(r_) do { q0 = P[(size_t)(r_) * INP + c]; q1 = P[(size_t)(r_) * INP + 256 + c]; qg = P[(size_t)(r_) * INP + C_GD + n]; qv = FV[(size_t)(r_) * 256 + c]; qb = BON[(r_) * 4 + h]; } while (0)
    if ((gw >> 2) < nrows) RO_LOAD(gw >> 2);
    for (int row = gw >> 2; row < nrows; row += NGW >> 2) {
        const float ov = bf2f(q0) + bf2f(q1), gdv = bf2f(qg), vv = bf2f(qv), bon = qb;
        const int nxt = row + (NGW >> 2);
        if (nxt < nrows) RO_LOAD(nxt);
        const float mu = wave_sum(ov) * (1.0f / 64.0f), dv = ov - mu, var = wave_sum(dv * dv) * (1.0f / 64.0f);
        const float on = dv * rsqrtf(var + 64e-5f) * lng + lnb;
        const float sg = sigmoidf_(gdv);
        float g = 0.f;
#pragma unroll
        for (int j = 0; j < 64; ++j) g = fmaf(rdlane(sg, j), gupr[j], g);
        const float y = (on + bon * vv) * g;
        Y[(size_t)row * D + c] = bf1(y);
    }
#undef RO_LOAD
}


constexpr int CK_LD = 72, CK_MAT = 64 * CK_LD * 2;
enum { M_AL = 0, M_BE, M_KP, M_RH, M_BET, M_KPT, M_VT, M_AOFF, M_BM, M_MB, M_MK, M_SB, M_SB1, M_YZ, M_UT, M_COUNT };
constexpr int CK_TD = M_COUNT * CK_MAT, CK_TD_LD = 40;
constexpr int CK_ADG = CK_TD + 64 * CK_TD_LD * 2;
constexpr int CK_SEG = CK_ADG + 4096;
constexpr int CK_GL = CK_SEG + 2048;
constexpr int CK_END = CK_GL + 256;
static_assert(CK_END <= LDSCTL_OFF, "chunk scan LDS map");
struct CkAddr { unsigned vA, vB, vN, vT, v1, v1t, lds; };
#define CKP(T, addr) ((LAS T*)(uintptr_t)(addr))
template <int KS> __device__ __forceinline__ void mm2(f32x4 (&acc)[2], const CkAddr& K, int mx, int my) {
#pragma unroll
    for (int ks = 0; ks < KS; ++ks) {
        const bf16x8 a = *CKP(const bf16x8, K.vA + mx * CK_MAT + 64 * ks);
#pragma unroll
        for (int t = 0; t < 2; ++t) { const bf16x8 bq = *CKP(const bf16x8, K.vB + my * CK_MAT + t * (16 * CK_LD * 2) + 64 * ks); acc[t] = __builtin_amdgcn_mfma_f32_16x16x32_bf16(a, bq, acc[t], 0, 0, 0); }
    }
}
__device__ __forceinline__ void stN(const CkAddr& K, int mi, int t, const f32x4 v) {
#pragma unroll
    for (int r = 0; r < 4; ++r) *CKP(bf16, K.vN + mi * CK_MAT + r * (CK_LD * 2) + t * 32) = bf1(v[r]);
}
__device__ __forceinline__ void stT(const CkAddr& K, int mi, int t, const f32x4 v) {
    v2u o; o.x = pk2h(v[0], v[1]); o.y = pk2h(v[2], v[3]); *CKP(v2u, K.vT + mi * CK_MAT + t * (16 * CK_LD * 2)) = o;
}
__device__ __forceinline__ void rwkv_chunk_unit(const Args& A, Frame& F, int l, int sc) {
    const bool last = (l == 1);
    const int d = sc >> 4, b = (sc >> 2) & 3, h = sc & 3;
    const int w = F.wave, n = F.lane;
    const bf16* GAL = (const bf16*)(kws() + WS_GAL) + (size_t)d * MALL * 256; const bf16* GBE = (const bf16*)(kws() + WS_GBE) + (size_t)d * MALL * 256;
    const bf16* GKP = (const bf16*)(kws() + WS_GKP) + (size_t)d * MALL * 256; const bf16* GRH = (const bf16*)(kws() + WS_GRH) + (size_t)d * MALL * 256;
    const bf16* FV = (const bf16*)(kws() + WS_FV); const float* GLT = (const float*)(kws() + WS_GLT) + (size_t)d * 272 * 256;
    bf16* O = (bf16*)(kws() + WS_RP) + d * 256;
    v4u ual, ube, ukp, urh, uv; float fgl = 0.f;
    { const int row = scan_row(d, b, n); const size_t o = (size_t)row * 256 + h * 64 + 8 * w;
      ual = *(const v4u*)(GAL + o); ube = *(const v4u*)(GBE + o); ukp = *(const v4u*)(GKP + o); urh = *(const v4u*)(GRH + o); uv = *(const v4u*)(FV + o);
      if (n < 8) fgl = GLT[(size_t)(scan_row(d, b, 0) >> 6) * 256 + h * 64 + 8 * w + n]; }
    __syncthreads();
    for (int i = F.tid; i < CK_END / 16; i += NTHR) *(LAS v4u*)(F.lds + i * 16) = (v4u){0u, 0u, 0u, 0u};
    f32x4 st[2] = {(f32x4){0.f, 0.f, 0.f, 0.f}, (f32x4){0.f, 0.f, 0.f, 0.f}};
    __syncthreads();
    constexpr int NCK = (CTXL + SEQ) / 64;
    for (int c = 0; c < NCK; ++c) {
        const bool skip_o = last && c < CTXL / 64;
        int c15 = n & 15, g = n >> 4; asm volatile("" : "+v"(c15), "+v"(g));
        const int tr = w >> 1, tc0 = (w & 1) * 2;
        CkAddr K; K.lds = (unsigned)(uintptr_t)F.lds;
        K.vA = K.lds + ((16 * tr + c15) * CK_LD + 8 * g) * 2; K.vB = K.lds + ((16 * tc0 + c15) * CK_LD + 8 * g) * 2;
        K.vN = K.lds + ((16 * tr + 4 * g) * CK_LD + 16 * tc0 + c15) * 2; K.vT = K.lds + ((16 * tc0 + c15) * CK_LD + 16 * tr + 4 * g) * 2;
        K.v1 = K.lds + (8 * w * CK_LD + n) * 2; K.v1t = K.lds + (n * CK_LD + 8 * w) * 2;
        asm volatile("" : "+v"(K.vA), "+v"(K.vB), "+v"(K.vN), "+v"(K.vT), "+v"(K.v1), "+v"(K.v1t));
        {
            *CKP(v4u, K.v1t + M_AL * CK_MAT) = ual; *CKP(v4u, K.v1t + M_BE * CK_MAT) = ube; *CKP(v4u, K.v1t + M_KP * CK_MAT) = ukp; *CKP(v4u, K.v1t + M_RH * CK_MAT) = urh;
#pragma unroll
            for (int e = 0; e < 8; ++e) {
                *CKP(bf16, K.v1 + M_BET * CK_MAT + e * (CK_LD * 2)) = (bf16)((e & 1) ? (ube[e >> 1] >> 16) : (ube[e >> 1] & 0xffffu));
                *CKP(bf16, K.v1 + M_KPT * CK_MAT + e * (CK_LD * 2)) = (bf16)((e & 1) ? (ukp[e >> 1] >> 16) : (ukp[e >> 1] & 0xffffu));
                *CKP(bf16, K.v1 + M_VT * CK_MAT + e * (CK_LD * 2)) = (bf16)((e & 1) ? (uv[e >> 1] >> 16) : (uv[e >> 1] & 0xffffu)); }
            if (n < 8) *CKP(float, K.lds + CK_GL + (8 * w + n) * 4) = fgl;
            { const int cn = c + 1 < NCK ? c + 1 : c; const int row = scan_row(d, b, 64 * cn + n); const size_t o = (size_t)row * 256 + h * 64 + 8 * w;
              ual = *(const v4u*)(GAL + o); ube = *(const v4u*)(GBE + o); ukp = *(const v4u*)(GKP + o); urh = *(const v4u*)(GRH + o); uv = *(const v4u*)(FV + o);
              if (n < 8) fgl = GLT[(size_t)(scan_row(d, b, 64 * cn) >> 6) * 256 + h * 64 + 8 * w + n]; }
        }
        __syncthreads();
        if (tc0 <= tr) {
            f32x4 pa[2] = {(f32x4){0.f, 0.f, 0.f, 0.f}, (f32x4){0.f, 0.f, 0.f, 0.f}}, pb[2] = {pa[0], pa[0]}, pm[2] = {pa[0], pa[0]}, pk[2] = {pa[0], pa[0]};
            mm2<2>(pa, K, M_AL, M_BE); mm2<2>(pb, K, M_AL, M_KP); mm2<2>(pm, K, M_RH, M_BE); mm2<2>(pk, K, M_RH, M_KP);
#pragma unroll
            for (int t = 0; t < 2; ++t) { const int tc = tc0 + t; if (tc > tr) continue;
                f32x4 va = pa[t], vb = pb[t], vm = pm[t], vk = pk[t];
                if (tc == tr) {
#pragma unroll
                    for (int r = 0; r < 4; ++r) { const bool strict = c15 < 4 * g + r, incl = c15 <= 4 * g + r;
                        va[r] = strict ? va[r] : 0.f; vb[r] = strict ? vb[r] : 0.f; vm[r] = incl ? vm[r] : 0.f; vk[r] = incl ? vk[r] : 0.f;
                        *CKP(float, K.lds + CK_ADG + ((tr * 16 + 4 * g + r) * 16 + c15) * 4) = va[r]; }
                } else stN(K, M_AOFF, t, va);
                stN(K, M_BM, t, vb); stN(K, M_MB, t, vm); stN(K, M_MK, t, vk);
            }
        }
        __syncthreads();
        f32x4 yb[2] = {(f32x4){0.f, 0.f, 0.f, 0.f}, (f32x4){0.f, 0.f, 0.f, 0.f}}, ob[2] = {yb[0], yb[0]};
        mm2<2>(yb, K, M_BM, M_VT);
        if (!skip_o) mm2<2>(ob, K, M_MK, M_VT);
        if (w == 0) {
            const int bb_ = n >> 4, cc = n & 15; float tcol[16];
            f32x4 arow[16][4];
#pragma unroll
            for (int r = 1; r < 16; ++r)
#pragma unroll
                for (int s4 = 0; s4 * 4 < r; ++s4) arow[r][s4] = *CKP(const f32x4, K.lds + CK_ADG + ((bb_ * 16 + r) * 16 + 4 * s4) * 4);
#pragma unroll
            for (int r = 0; r < 16; ++r) { float acc = (r == cc) ? 1.f : 0.f;
#pragma unroll
                for (int s = 0; s < r; ++s) acc = fmaf(-arow[r][s >> 2][s & 3], tcol[s], acc);
                tcol[r] = acc; *CKP(bf16, K.lds + CK_TD + ((16 * bb_ + r) * CK_TD_LD + cc) * 2) = bf1(acc); }
        }
        __syncthreads();
        const int sbr = (c & 1) ? M_SB1 : M_SB, sbw = (c & 1) ? M_SB : M_SB1;
        mm2<2>(yb, K, M_AL, sbr);
        stT(K, M_YZ, 0, yb[0]); stT(K, M_YZ, 1, yb[1]);
        __syncthreads();
        if (w < 4) {
            const unsigned aX = K.lds + ((c15) * CK_LD + 8 * g) * 2;
            const unsigned bY = K.lds + ((16 * w + c15) * CK_LD + 8 * g) * 2;
            const unsigned cT = K.lds + ((16 * w + c15) * CK_LD + 4 * g) * 2;
#pragma unroll
            for (int blk = 0; blk < 4; ++blk) {
                f32x4 z = (f32x4){0.f, 0.f, 0.f, 0.f};
                if (blk > 0) {
#pragma unroll
                    for (int ks = 0; ks < (blk == 3 ? 2 : 1); ++ks) {
                        const bf16x8 a = *CKP(const bf16x8, aX + M_AOFF * CK_MAT + blk * (16 * CK_LD * 2) + 64 * ks);
                        const bf16x8 u = *CKP(const bf16x8, bY + M_UT * CK_MAT + 64 * ks);
                        z = __builtin_amdgcn_mfma_f32_16x16x32_bf16(a, u, z, 0, 0, 0); }
                }
                { const v2u yv = *CKP(const v2u, cT + M_YZ * CK_MAT + 32 * blk);
                  z[0] += __uint_as_float(yv.x << 16); z[1] += __uint_as_float(yv.x & 0xffff0000u); z[2] += __uint_as_float(yv.y << 16); z[3] += __uint_as_float(yv.y & 0xffff0000u); }
                { v2u zo; zo.x = pk2h(z[0], z[1]); zo.y = pk2h(z[2], z[3]); *CKP(v2u, cT + M_YZ * CK_MAT + 32 * blk) = zo; }
                asm volatile("s_waitcnt lgkmcnt(0)" ::: "memory");
                const bf16x8 ta = *CKP(const bf16x8, K.lds + CK_TD + ((16 * blk + c15) * CK_TD_LD + 8 * g) * 2);
                const bf16x8 zb = *CKP(const bf16x8, bY + M_YZ * CK_MAT + 32 * blk);
                f32x4 u = __builtin_amdgcn_mfma_f32_16x16x32_bf16(ta, zb, (f32x4){0.f, 0.f, 0.f, 0.f}, 0, 0, 0);
                { v2u uo; uo.x = pk2h(-u[0], -u[1]); uo.y = pk2h(-u[2], -u[3]); *CKP(v2u, cT + M_UT * CK_MAT + 32 * blk) = uo; }
                asm volatile("s_waitcnt lgkmcnt(0)" ::: "memory");
            }
        }
        __syncthreads();
        if (!skip_o) {
            mm2<2>(ob, K, M_RH, sbr); mm2<2>(ob, K, M_MB, M_UT);
#pragma unroll
            for (int r = 0; r < 4; ++r) { const int row = scan_row(d, b, 64 * c + 16 * tr + 4 * g + r);
#pragma unroll
                for (int t = 0; t < 2; ++t) O[(size_t)row * INP + h * 64 + 16 * (tc0 + t) + c15] = bf1(ob[t][r]); }
        }
        mm2<2>(st, K, M_UT, M_BET); mm2<2>(st, K, M_VT, M_KPT);
#pragma unroll
        for (int t = 0; t < 2; ++t) { const float gl = *CKP(float, K.lds + CK_GL + (16 * (tc0 + t) + c15) * 4); st[t] = st[t] * gl; stN(K, sbw, t, st[t]); }
        __syncthreads();
    }
}
#undef CKP

struct KeyStream { int ctx_row0, nloc, loc_row0, loc_pos0; };
constexpr int AT_K = 0, AT_V = 4608, AT_BUF = 9728;
typedef float f32x4a __attribute__((ext_vector_type(4)));

template <int NMAP, int DK, int QS, bool MASK>
__device__ __forceinline__ void attn_core(Frame& F, const bf16* P, int kcol, int vcol, const KeyStream ks, const bf16x8 (&qf)[QS][NMAP][DK / 32], int qpos0,
                                          f32x4 (&o)[QS][NMAP][4], float (&m)[QS][NMAP], float (&lsum)[QS][NMAP]) {
    const int c15 = F.lane & 15, g = F.lane >> 4;
    const int sub = F.tid & 255, lkey = sub >> 3, lch = sub & 7; const bool isk = F.tid < 256;
    const int ntiles = 8 + ks.nloc;
#pragma unroll
    for (int qs = 0; qs < QS; ++qs)
#pragma unroll
        for (int mp = 0; mp < NMAP; ++mp) { m[qs][mp] = 0.f; lsum[qs][mp] = 0.f;
#pragma unroll
            for (int dt = 0; dt < 4; ++dt) o[qs][mp][dt] = (f32x4){0.f, 0.f, 0.f, 0.f}; }
    bool anym[QS][NMAP];
#pragma unroll
    for (int qs = 0; qs < QS; ++qs)
#pragma unroll
        for (int mp = 0; mp < NMAP; ++mp) anym[qs][mp] = false;
    v4u stg;
#define AT_LOAD(ti) do { const int rb_ = (ti) < 8 ? ks.ctx_row0 + 32 * (ti) : ks.loc_row0 + 32 * ((ti) - 8); \
        stg = *(const v4u*)(P + (size_t)(rb_ + lkey) * INP + (isk ? kcol : vcol) + 8 * lch); } while (0)
#define AT_WRITE(bi) do { LAS unsigned char* b_ = F.lds + (bi) * AT_BUF; \
        if (isk) *(LAS v4u*)(b_ + AT_K + lkey * 144 + lch * 16) = stg; \
        else { _Pragma("unroll") for (int i_ = 0; i_ < 8; ++i_) { const unsigned w_ = stg[i_ >> 1]; *(LAS bf16*)(b_ + AT_V + (8 * lch + i_) * 80 + lkey * 2) = (bf16)((i_ & 1) ? (w_ >> 16) : (w_ & 0xffffu)); } } } while (0)
    __syncthreads();
    AT_LOAD(0); AT_WRITE(0);
    __syncthreads();
    for (int ti = 0; ti < ntiles; ++ti) {
        { const int tn_ = ti + 1 < ntiles ? ti + 1 : ntiles - 1; AT_LOAD(tn_); }
        LAS unsigned char* bb = F.lds + (ti & 1) * AT_BUF;
        bf16x8 kf[2][NMAP][DK / 32];
#pragma unroll
        for (int kh = 0; kh < 2; ++kh)
#pragma unroll
            for (int mp = 0; mp < NMAP; ++mp)
#pragma unroll
                for (int kx = 0; kx < DK / 32; ++kx) kf[kh][mp][kx] = *(LAS bf16x8*)(bb + AT_K + (c15 + 16 * kh) * 144 + (mp * DK + 32 * kx + 8 * g) * 2);
        bf16x8 vf[4];
#pragma unroll
        for (int dt = 0; dt < 4; ++dt) { const v2u a = *(LAS v2u*)(bb + AT_V + (c15 + 16 * dt) * 80 + (4 * g) * 2), b2 = *(LAS v2u*)(bb + AT_V + (c15 + 16 * dt) * 80 + (16 + 4 * g) * 2);
            const v4u w = (v4u){a.x, a.y, b2.x, b2.y}; vf[dt] = __builtin_bit_cast(bf16x8, w); }
        const int kpos0 = ks.loc_pos0 + 32 * (ti - 8) + 4 * g;
#pragma unroll
        for (int qs = 0; qs < QS; ++qs)
#pragma unroll
            for (int mp = 0; mp < NMAP; ++mp) {
                f32x4 st[2];
                if (anym[qs][mp]) { const float negm = -m[qs][mp];
#pragma unroll
                    for (int kh = 0; kh < 2; ++kh) { st[kh] = (f32x4){negm, negm, negm, negm};
#pragma unroll
                        for (int kx = 0; kx < DK / 32; ++kx) st[kh] = __builtin_amdgcn_mfma_f32_16x16x32_bf16(kf[kh][mp][kx], qf[qs][mp][kx], st[kh], 0, 0, 0); }
                } else {
#pragma unroll
                    for (int kh = 0; kh < 2; ++kh) { st[kh] = (f32x4){0.f, 0.f, 0.f, 0.f};
#pragma unroll
                        for (int kx = 0; kx < DK / 32; ++kx) st[kh] = __builtin_amdgcn_mfma_f32_16x16x32_bf16(kf[kh][mp][kx], qf[qs][mp][kx], st[kh], 0, 0, 0); }
                }
                if (MASK && ti >= 8) {
                    const int kb = ks.loc_pos0 + 32 * (ti - 8), q0 = qpos0 + 16 * qs;
                    if (kb + 31 - q0 > 128 || kb - (q0 + 15) < -128) {
                        const int qp = q0 + c15;
#pragma unroll
                        for (int kh = 0; kh < 2; ++kh)
#pragma unroll
                            for (int r = 0; r < 4; ++r) { const int dd = kpos0 + 16 * kh + r - qp; if (dd > 128 || dd < -128) st[kh][r] = -INFINITY; }
                    }
                }
                float ps = 0.f; float p[8];
#pragma unroll
                for (int kh = 0; kh < 2; ++kh)
#pragma unroll
                    for (int r = 0; r < 4; ++r) { p[kh * 4 + r] = __builtin_amdgcn_exp2f(st[kh][r]); ps += p[kh * 4 + r]; }
                if (__builtin_amdgcn_ballot_w64(!(ps < 1048576.0f)) != 0ull) {
                    float mt = fmaxf(fmaxf(fmaxf(st[0][0], st[0][1]), fmaxf(st[0][2], st[0][3])), fmaxf(fmaxf(st[1][0], st[1][1]), fmaxf(st[1][2], st[1][3])));
                    mt = xmax4(mt);
                    const float delta = fmaxf(mt, 0.f), alpha = __builtin_amdgcn_exp2f(-delta);
                    m[qs][mp] += delta; lsum[qs][mp] *= alpha; anym[qs][mp] = true;
#pragma unroll
                    for (int dt = 0; dt < 4; ++dt) o[qs][mp][dt] = o[qs][mp][dt] * alpha;
                    ps = 0.f;
#pragma unroll
                    for (int kh = 0; kh < 2; ++kh)
#pragma unroll
                        for (int r = 0; r < 4; ++r) { p[kh * 4 + r] = __builtin_amdgcn_exp2f(st[kh][r] - delta); ps += p[kh * 4 + r]; }
                }
                lsum[qs][mp] += ps;
                const v4u pw = (v4u){pk2h(p[0], p[1]), pk2h(p[2], p[3]), pk2h(p[4], p[5]), pk2h(p[6], p[7])};
                const bf16x8 pf = __builtin_bit_cast(bf16x8, pw);
#pragma unroll
                for (int dt = 0; dt < 4; ++dt) o[qs][mp][dt] = __builtin_amdgcn_mfma_f32_16x16x32_bf16(vf[dt], pf, o[qs][mp][dt], 0, 0, 0);
            }
        AT_WRITE((ti + 1) & 1);
        __syncthreads();
    }
#undef AT_LOAD
#undef AT_WRITE
}

__device__ __forceinline__ void diff_unit(const Args& A, Frame& F, int l, int b, int h, int qrow0, int nloc) {
    const bf16* P = (const bf16*)(kws() + WS_RP); bf16* Y = (bf16*)(kws() + WS_XN); const float* tab = (const float*)(kws() + WS_TAB);
    const int c15 = F.lane & 15, g = F.lane >> 4;
    bf16x8 qf[1][2][1];
#pragma unroll
    for (int qs = 0; qs < 1; ++qs)
#pragma unroll
        for (int mp = 0; mp < 2; ++mp) qf[qs][mp][0] = *(const bf16x8*)(P + (size_t)(qrow0 + 16 * F.wave + c15) * INP + C_DFQ + h * 64 + mp * 32 + 8 * g);
    f32x4 o[1][2][4]; float m[1][2], ls[1][2];
    const KeyStream ks{MLAT + b * CTXL, nloc, b * SEQ, 0};
    attn_core<2, 32, 1, false>(F, P, C_DFK + h * 64, C_DFV + h * 64, ks, qf, 0, o, m, ls);
    const float lam = tab[3072 + l], oscale = 1.0f - tab[3074 + l];
    const float* ng = kin(I_DFNG) + l * 64;
#pragma unroll
    for (int qs = 0; qs < 1; ++qs) {
        float inv[2];
#pragma unroll
        for (int mp = 0; mp < 2; ++mp) { float t = ls[qs][mp]; t += __shfl_xor(t, 16); t += __shfl_xor(t, 32); inv[mp] = 1.0f / t; }
        f32x4 ov[4]; float ss = 0.f;
#pragma unroll
        for (int dt = 0; dt < 4; ++dt) { ov[dt] = o[qs][0][dt] * inv[0] - o[qs][1][dt] * (lam * inv[1]); ss += (ov[dt][0] * ov[dt][0] + ov[dt][1] * ov[dt][1]) + (ov[dt][2] * ov[dt][2] + ov[dt][3] * ov[dt][3]); }
        ss += __shfl_xor(ss, 16); ss += __shfl_xor(ss, 32);
        const float r = rsqrtf(ss * (1.0f / 64.0f) + NORM_EPS) * oscale;
        bf16* yp = Y + (size_t)(qrow0 + 16 * F.wave + c15) * D + 256 + h * 64 + 4 * g;
#pragma unroll
        for (int dt = 0; dt < 4; ++dt) { const f32x4 gg = *(const f32x4*)(ng + 16 * dt + 4 * g); const f32x4 v = ov[dt] * r * gg;
            v2u w; w.x = pk2h(v[0], v[1]); w.y = pk2h(v[2], v[3]); *(v2u*)(yp + 16 * dt) = w; }
    }
}
__device__ __forceinline__ void gq_unit(const Args& A, Frame& F, int l, int b, int kv, int qrow0, int qpos_blk  ) {
    const bf16* P = (const bf16*)(kws() + WS_RP); bf16* Y = (bf16*)(kws() + WS_XN);
    const int c15 = F.lane & 15, g = F.lane >> 4;
    const int hq = kv * 4 + (F.wave >> 1), rbase = qrow0 + 64 * (F.wave & 1);
    bf16x8 qf[4][1][2];
#pragma unroll
    for (int qs = 0; qs < 4; ++qs)
#pragma unroll
        for (int kx = 0; kx < 2; ++kx) qf[qs][0][kx] = *(const bf16x8*)(P + (size_t)(rbase + 16 * qs + c15) * INP + C_GQQ + hq * 64 + 32 * kx + 8 * g);
    KeyStream ks{MLAT + b * CTXL, 0, 0, 0}; int qpos0 = 0;
    if (qpos_blk >= 0) { const int lo = qpos_blk > 0 ? (qpos_blk - 1) * 128 : 0, hi = qpos_blk < 31 ? (qpos_blk + 2) * 128 : SEQ;
        ks.nloc = (hi - lo) / 32; ks.loc_row0 = b * SEQ + lo; ks.loc_pos0 = lo; qpos0 = qpos_blk * 128 + 64 * (F.wave & 1); }
    f32x4 o[4][1][4]; float m[4][1], ls[4][1];
    attn_core<1, 64, 4, true>(F, P, C_GQK + kv * 64, C_GQV + kv * 64, ks, qf, qpos0, o, m, ls);
    const float sink2 = kin(I_GQSINK)[l * 8 + hq] * LOG2E;
#pragma unroll
    for (int qs = 0; qs < 4; ++qs) {
        float t = ls[qs][0]; t += __shfl_xor(t, 16); t += __shfl_xor(t, 32);
        const float mf = fmaxf(m[qs][0], sink2), e = __builtin_amdgcn_exp2f(m[qs][0] - mf), den = t * e + __builtin_amdgcn_exp2f(sink2 - mf), scl = e / den;
        bf16* yp = Y + (size_t)(rbase + 16 * qs + c15) * D + 512 + hq * 64 + 4 * g;
#pragma unroll
        for (int dt = 0; dt < 4; ++dt) { const f32x4 v = o[qs][0][dt] * scl; v2u w; w.x = pk2h(v[0], v[1]); w.y = pk2h(v[2], v[3]); *(v2u*)(yp + 16 * dt) = w; }
    }
}
__device__ __forceinline__ void phase_queue(const Args& A, Frame& F, int l) {
    gu32* head = (gu32*)(kws() + WS_CTL) + CW_QUEUE + 64 * l;
    const int total = 32 + 512 + 256 + (l == 0 ? 48 + WI_FILL : 0);
    volatile LAS int* slot = (volatile LAS int*)(F.lds + MISC_OFF) + 16;
    for (;;) {
        asm volatile("" : "+v"(F.tid), "+v"(F.lane));
        __syncthreads();
        if (F.tid == 0) *slot = (int)__hip_atomic_fetch_add(head, 1u, __ATOMIC_RELAXED, __HIP_MEMORY_SCOPE_AGENT);
        __syncthreads();
        int u = __builtin_amdgcn_readfirstlane(*slot);
        if (u >= total) break;
        if (u < 32) { rwkv_chunk_unit(A, F, l, u); if ((MK_REPEAT >> 16) & 1) rwkv_chunk_unit(A, F, l, u); continue; }
        u -= 32;
        if (u < 512) { const int b = u >> 7, h = (u >> 5) & 3, qh = u & 31; diff_unit(A, F, l, b, h, b * SEQ + qh * 128, SEQ / 32); if ((MK_REPEAT >> 17) & 1) diff_unit(A, F, l, b, h, b * SEQ + qh * 128, SEQ / 32); continue; }
        u -= 512;
        if (u < 256) { const int b = u >> 6, kv = (u >> 5) & 1, nb = u & 31; gq_unit(A, F, l, b, kv, b * SEQ + nb * 128, nb); continue; }
        u -= 256;
        if (u < 32) { const int b = u >> 3, h = (u >> 1) & 3, hf = u & 1; diff_unit(A, F, l, b, h, MLAT + b * CTXL + hf * 128, 0); continue; }
        u -= 32;
        if (u < 16) { const int b = u >> 2, kv = (u >> 1) & 1, hf = u & 1; gq_unit(A, F, l, b, kv, MLAT + b * CTXL + hf * 128, -1); continue; }
        u -= 16;
        { LAS float* scr = (LAS float*)(F.lds + F.wave * 16384);
          for (int k = 0; k < 16; ++k) { const int it = WI_IN + u * 128 + F.wave * 16 + k; if (it < 2 * WI_LAYER) weight_item(it, scr, F.lane); } }
    }
}

constexpr int N_PHASES = 20;
}

__global__ void __launch_bounds__(mk::NTHR, 2) mega_fwd(mk::Args A) {
    using namespace mk;
    extern __shared__ __attribute__((aligned(16))) unsigned char lds_raw[];
    Frame F;
    F.lds = (LAS unsigned char*)lds_raw;
    F.tid = threadIdx.x; asm volatile("" : "+v"(F.tid)); F.lane = F.tid & 63; F.wave = __builtin_amdgcn_readfirstlane(F.tid >> 6);
    F.G = gridDim.x; F.bid = blockIdx.x;
    for (int u = F.tid; u < (LDS_BYTES - LDSCTL_OFF) / 4; u += NTHR) ((LAS unsigned*)(F.lds + LDSCTL_OFF))[u] = 0u;
    __syncthreads();
    gu32* ctl = (gu32*)(kws() + WS_CTL);
    XcdBarrier bar; bar.bar = (unsigned*)(ctl + CW_BAR); bar.x = 0; bar.st = nullptr; bar.tid = F.tid;
    const bool multi = (A.ph_hi - A.ph_lo) > 1;
    if (multi) bar = xcd_barrier_post((unsigned*)(ctl + CW_BAR), (volatile LAS unsigned*)(F.lds + MISC_OFF) + 8, F.tid);

    for (int ph = A.ph_lo, rep = 0; ph < A.ph_hi;) {
        { int t_ = F.tid, l_ = F.lane, w_ = F.wave, g_ = F.G, b_ = F.bid; unsigned p_ = (unsigned)(uintptr_t)F.lds;
          w_ = __builtin_amdgcn_readfirstlane(w_); g_ = __builtin_amdgcn_readfirstlane(g_); b_ = __builtin_amdgcn_readfirstlane(b_); p_ = __builtin_amdgcn_readfirstlane(p_);
          asm volatile("" : "+v"(t_), "+v"(l_)); asm volatile("" : "+s"(w_), "+s"(g_), "+s"(b_), "+s"(p_));
          F.tid = t_; F.lane = l_; F.wave = w_; F.G = g_; F.bid = b_; F.lds = (LAS unsigned char*)(uintptr_t)p_; }
        int kind = 0, l = 0, hf = 0;
        if (ph == 1) kind = 1;
        else if (ph > 1) { const int q = ph - 2; l = q / 9; const int r = q % 9; kind = r < 6 ? 2 + r : (r == 6 ? 8 : (r == 7 ? 10 : 11)); }
        const int nrows = (l == 0) ? MALL : MLAT;
        const int r0 = 0, r1 = nrows; (void)hf;
        const bool is_gemm = (kind == 2 || kind == 6 || kind == 8 || kind == 10);
        if (is_gemm) { if (MK_KINDS & 0x544) {
          const int nparts = ((kind == 6 || kind == 10) && l == 0) ? 2 : 1;
          for (int part = 0; part < nparts; ++part) {
            pg8::Gemm g; EpiMulti E; E.tab = (const float*)(kws() + WS_TAB); E.ob = nullptr; E.of = nullptr; E.ld = 0; E.mode = 0; E.cw = nullptr; E.cb = nullptr; E.nrows = 0; E.ldsx = 0u;
            if (kind == 2) { g = pg8::Gemm{(const pg8::bf16_t*)(kws() + WS_XN), (const pg8::bf16_t*)(kws() + WS_WIN + l * WIN_BYTES), MALL, INP, D, 256, D, 0}; E.mode = 0; E.ob = (bf16*)(kws() + WS_RP); E.ld = INP; }
            else if (kind == 6 && part == 0) { g = pg8::Gemm{(const pg8::bf16_t*)(kws() + WS_XN), (const pg8::bf16_t*)(kws() + WS_WOUT + l * WOUT_BYTES), MLAT, D, D, 256, D, 0}; E.mode = 2; E.ob = (bf16*)(kws() + WS_RP); E.ld = D; }
            else if (kind == 6) { g = pg8::Gemm{(const pg8::bf16_t*)(kws() + WS_XN) + (size_t)MLAT * D, (const pg8::bf16_t*)(kws() + WS_WOUT + l * WOUT_BYTES), 256 * 4 * 4, D, 256, 256, D, 4}; E.mode = 2; E.ob = (bf16*)(kws() + WS_SLO); E.ld = D; }
            else if (kind == 8) { const int nmu = (nrows + 253) / 254;
                g = pg8::Gemm{(const pg8::bf16_t*)(kws() + WS_XN) - D, (const pg8::bf16_t*)(kws() + WS_WGU + l * WGU_BYTES), 256 * nmu, NGU, D, 254, D, 0};
                E.mode = 3; E.ob = (bf16*)(kws() + WS_ACT); E.ld = DFF; E.cw = kin(I_FFCW) + (size_t)l * 3 * DFF; E.cb = kin(I_FFCB) + (size_t)l * DFF; E.nrows = nrows; E.ldsx = (unsigned)(uintptr_t)F.lds + 131072u; }
            else if (part == 0) { g = pg8::Gemm{(const pg8::bf16_t*)(kws() + WS_ACT), (const pg8::bf16_t*)(kws() + WS_WD + l * WD_BYTES), MLAT, D, DFF, 256, DFF, 0}; E.mode = 2; E.ob = (bf16*)(kws() + WS_FP); E.ld = D; }
            else { g = pg8::Gemm{(const pg8::bf16_t*)(kws() + WS_ACT) + (size_t)MLAT * DFF, (const pg8::bf16_t*)(kws() + WS_WD + l * WD_BYTES), 256 * 4 * 11, D, 256, 256, DFF, 4}; E.mode = 2; E.ob = (bf16*)(kws() + WS_SLD); E.ld = D; }
            pg8::StaticOrder S; S.init(g.M, g.N, F.G, F.bid);
            pg8::gemm_phase<EpiMulti, pg8::StaticOrder, true, true>(F.lds, g, S, E, F.tid);
          }
        } } else {
            switch (kind) {
                case 0: if ((MK_KINDS >> 0) & 1) { p0_prologue(A, F); } break;
                case 1: if (((MK_KINDS >> 1) & 1) && l == 0) phase_prep(A, F); break;
                case 3: if ((MK_KINDS >> 3) & 1) rwkv_features(A, F, l); break;
                case 4: if ((MK_KINDS >> 4) & 1) phase_queue(A, F, l); break;
                case 5: if ((MK_KINDS >> 5) & 1) rwkv_readout(A, F, l); break;
                case 7: if ((MK_KINDS >> 7) & 1) phase_e1(A, F, l); break;
                case 9: if ((MK_KINDS >> 9) & 1) phase_act(A, F, l, r0, r1); break;
                case 11: if ((MK_KINDS >> 11) & 1) phase_e2(A, F, l, r0, r1); break;
                default: break;
            }
        }
        const bool again = (rep == 0) && ((MK_REPEAT >> kind) & 1);
        if (ph + 1 < A.ph_hi || again) { bar.bar = (unsigned*)((gu32*)(kws() + WS_CTL) + CW_BAR); bar.tid = F.tid; xcd_barrier(bar); }
        if (again) rep = 1; else { rep = 0; ++ph; }
    }
}

extern "C" void kernel_launch(void* const* d_in, const int* in_sizes, int n_in, void* d_out, int out_size, void* d_ws, size_t ws_size, hipStream_t stream) {
    using namespace mk;
    static int grid = 0;
    if (grid == 0) {
        if (n_in != N_IN || out_size != MLAT * D || ws_size < WS_END) { fprintf(stderr, "kernel_launch: unexpected shapes (n_in %d, out %d, ws %zu); nothing launched\n", n_in, out_size, ws_size); grid = -1; return; }
        int dev = 0, cus = 0, per_cu = 0;
        if (hipGetDevice(&dev) != hipSuccess || hipDeviceGetAttribute(&cus, hipDeviceAttributeMultiprocessorCount, dev) != hipSuccess) { grid = -1; return; }
        if (hipFuncSetAttribute((const void*)mega_fwd, hipFuncAttributeMaxDynamicSharedMemorySize, LDS_BYTES) != hipSuccess) { fprintf(stderr, "kernel_launch: hipFuncSetAttribute failed\n"); grid = -1; return; }
        if (hipOccupancyMaxActiveBlocksPerMultiprocessor(&per_cu, (const void*)mega_fwd, NTHR, LDS_BYTES) != hipSuccess || per_cu < 1) { fprintf(stderr, "kernel_launch: occupancy query says %d blocks/CU\n", per_cu); per_cu = 1; }
        (void)hipGetLastError();
        grid = cus;
    }
    if (grid < 0) return;
    (void)hipMemsetAsync((char*)d_ws + WS_CTL, 0, CTL_ZERO_BYTES, stream);
    Args a{};
    for (int i = 0; i < N_IN; ++i) a.in[i] = (const float*)d_in[i];
    a.out = (float*)d_out; a.ws = (unsigned char*)d_ws;
#if MK_PER_PHASE
    for (int ph = 0; ph < N_PHASES; ++ph) { a.ph_lo = ph; a.ph_hi = ph + 1; hipLaunchKernelGGL(mega_fwd, dim3(grid), dim3(NTHR), LDS_BYTES, stream, a); }
#else
    a.ph_lo = 0; a.ph_hi = N_PHASES;
    void* args[] = {&a};
    hipError_t e = hipLaunchCooperativeKernel((const void*)mega_fwd, dim3(grid), dim3(NTHR), args, LDS_BYTES, stream);
    if (e != hipSuccess) fprintf(stderr, "kernel_launch: cooperative launch failed: %s (grid %d)\n", hipGetErrorString(e), grid);
#endif
}
```

```cpp
#include <hip/hip_runtime.h>
#include <hip/hip_cooperative_groups.h>
#include <cstdio>
#include <cstdint>
#ifndef MK_PER_PHASE
#define MK_PER_PHASE 0
#endif
#ifndef MK_KINDS
#define MK_KINDS 0xFFF
#endif
#ifndef MK_REPEAT
#define MK_REPEAT 0
#endif
#ifndef MK_RWDUP
#define MK_RWDUP 0
#endif
#ifndef MK_FUSE
#define MK_FUSE 3
#endif
#ifdef MK_DBGDRAIN
#define MK_DBGD 1
#else
#define MK_DBGD 0
#endif
namespace pg8 {
#define PG8_LAS __attribute__((address_space(3)))
typedef unsigned short bf16_t;
typedef short bf16x8 __attribute__((ext_vector_type(8)));
typedef float f32x4 __attribute__((ext_vector_type(4)));
typedef unsigned u32x4 __attribute__((ext_vector_type(4)));
constexpr int BM = 256, BK = 64, HALF = 128, HTB = HALF * BK * 2  , STAGE_BYTES = 8 * HTB, NXCD = 8, WGM = 8;

__host__ __device__ __forceinline__ int lds_byte(int r, int c) { const int st = (r >> 4) * 2 + (c >> 5), rr = r & 15, cc = c & 31, ob = rr * 64 + cc * 2; return st * 1024 + (ob ^ (((ob >> 9) & 1) << 5)); }
__host__ __device__ __forceinline__ void stage_rc(int b, int& R, int& C) { const int st = b / 1024, sb = b % 1024, swz = sb ^ (((sb >> 9) & 1) << 5); R = (st >> 1) * 16 + swz / 64; C = (st & 1) * 32 + (swz % 64) / 2; }
__host__ __device__ __forceinline__ int perm32(int rho) { const int n = rho >> 4, i = rho & 15; return 8 * (i >> 2) + 4 * n + (i & 3); }

__device__ __forceinline__ float pg8_zero() { float z = 0.f; asm volatile("" : "+v"(z)); return z; }
struct Unit { int pm, pn; };
struct Gemm { const bf16_t* A; const bf16_t* Bt; int M, N, K; int trows; int ld, mt; };

struct StaticOrder {
    int nM, nN, nwg, G, c;
    __host__ __device__ void init(int M, int N, int G_, int c_) { nM = M / BM; nN = N / BM; nwg = nM * nN; G = G_; c = c_; }
    __host__ __device__ bool next(int i, Unit& u) const {
        const long L = (long)i * G + c; if (L >= nwg) return false;
        int wgid = (int)L; { const int q = nwg / NXCD, r = nwg % NXCD, xcd = wgid % NXCD, off = wgid / NXCD; wgid = (xcd < r ? xcd * (q + 1) : r * (q + 1) + (xcd - r) * q) + off; }
        const int nig = WGM * nN, gid = wgid / nig, fm = gid * WGM, gsz = (nM - fm) < WGM ? (nM - fm) : WGM;
        u.pm = fm + ((wgid % nig) % gsz); u.pn = (wgid % nig) / gsz; return true;
    }
    __device__ __forceinline__ void a_ready(const Unit&) const {}
    __device__ __forceinline__ void done(const Unit&) const {}
};

__device__ __forceinline__ unsigned cvt_pk_bf16(float lo, float hi) { unsigned r; asm volatile("v_cvt_pk_bf16_f32 %0, %1, %2" : "=v"(r) : "v"(lo), "v"(hi)); return r; }
typedef float f32x2 __attribute__((ext_vector_type(2)));
__device__ __forceinline__ f32x2 gelu_pk(f32x2 v) {
    const f32x2 av = __builtin_elementwise_abs(v), d = av * 0.2316418882f + 1.0f;
    f32x2 t; t.x = __builtin_amdgcn_rcpf(d.x); t.y = __builtin_amdgcn_rcpf(d.y);
    f32x2 q = t * 0.5307027145f + (-0.7265760135f); q = q * t + 0.7107068705f; q = q * t + (-0.142248368f); q = q * t + 0.127414796f; q = q * t;
    const f32x2 s = (v * v) * (-0.72134752044f);
    f32x2 e; e.x = __builtin_amdgcn_exp2f(s.x); e.y = __builtin_amdgcn_exp2f(s.y);
    const f32x2 m = v * (q * e), r = v - m;
    f32x2 o; o.x = v.x < 0.f ? m.x : r.x; o.y = v.y < 0.f ? m.y : r.y; return o;
}

template <int ACT  > struct EpiBf16 {
    static constexpr bool PERM = true, AFTER_DRAIN = false; static_assert(ACT == 0 || ACT == 1, "EpiBf16: ACT is 0 (none) or 1 (gelu_pk)");
    bf16_t* O; int ldc; const float* bias; int split_cols; size_t split_stride; float scale0;
    __device__ __forceinline__ void operator()(const f32x4 (&acc)[2][2][4][2], const Unit& u, int wr, int wc, int fr, int fq) const {
        const int row0 = u.pm * BM + wr * 64 + fr; int colt = u.pn * BM; bf16_t* base = O;
        float sc = 1.f; if (split_cols) { const int t = colt / split_cols; base += (size_t)t * split_stride; colt -= t * split_cols; if (t == 0) sc = scale0; }
        const int col0 = colt + wc * 32 + 8 * fq, bcol0 = u.pn * BM + wc * 32 + 8 * fq;
        f32x4 bv[2][2];
#pragma unroll
        for (int bj = 0; bj < 2; ++bj)
#pragma unroll
            for (int n = 0; n < 2; ++n) bv[bj][n] = bias ? *(const f32x4*)(bias + bcol0 + bj * HALF + 4 * n) : (f32x4){0.f, 0.f, 0.f, 0.f};
#pragma unroll
        for (int ai = 0; ai < 2; ++ai)
#pragma unroll
            for (int m = 0; m < 4; ++m) { bf16_t* rowp = base + (size_t)(row0 + ai * HALF + m * 16) * ldc + col0;
#pragma unroll
                for (int bj = 0; bj < 2; ++bj) { f32x4 v0 = acc[ai][bj][m][0] + bv[bj][0], v1 = acc[ai][bj][m][1] + bv[bj][1];
                    if (ACT == 1) { f32x2 a = gelu_pk((f32x2){v0[0], v0[1]}), b = gelu_pk((f32x2){v0[2], v0[3]}), c = gelu_pk((f32x2){v1[0], v1[1]}), d = gelu_pk((f32x2){v1[2], v1[3]});
                        v0 = (f32x4){a.x, a.y, b.x, b.y}; v1 = (f32x4){c.x, c.y, d.x, d.y}; }
                    v0 = v0 * sc; v1 = v1 * sc; u32x4 w; w.x = cvt_pk_bf16(v0[0], v0[1]); w.y = cvt_pk_bf16(v0[2], v0[3]); w.z = cvt_pk_bf16(v1[0], v1[1]); w.w = cvt_pk_bf16(v1[2], v1[3]);
                    *(u32x4*)(rowp + bj * HALF) = w; } }
    }
};

template <class Epi, class Sched, bool ALIGN_EPI = false, bool SP2 = false>
__device__ __forceinline__ void gemm_phase(PG8_LAS unsigned char* lds, const Gemm g, const Sched& S, const Epi& E, int tid_in) {
    int tid_ = tid_in; asm volatile("" : "+v"(tid_));
    const int tid = tid_, wid = __builtin_amdgcn_readfirstlane(tid >> 6), lane = tid & 63, wr = wid >> 2, wc = wid & 3, fr = lane & 15, fq = lane >> 4;
    const int K = g.ld, nt = g.K / BK;
    unsigned voffA[2], voffB[2];
#pragma unroll
    for (int i = 0; i < 2; ++i) { int R, C; stage_rc(tid * 16 + i * 8192, R, C); const int Rb = Epi::PERM ? ((R & ~31) + perm32(R & 31)) : R;
        voffA[i] = (unsigned)(R * K + C) * 2u; voffB[i] = (unsigned)(Rb * K + C) * 2u; }
    const size_t kstep = (size_t)(BK * 2);
    const size_t hstep = (size_t)HALF * K * 2;
    const size_t tstep = 2 * hstep;
    const size_t tstepA = (size_t)g.trows * K * 2;
    const unsigned ldsw = (unsigned)wid * 1024u;
    const int aoff = lds_byte(wr * 64 + fr, fq * 8), boff = lds_byte(wc * 32 + fr, fq * 8);
#define PG8_SA(b, h) (((b) * 2 + (h)) * HTB)
#define PG8_SB(b, h) ((4 + (b) * 2 + (h)) * HTB)
#define PG8_STAGE(bufoff, gbase, voff) do { _Pragma("unroll") for (int _i = 0; _i < 2; ++_i) \
        __builtin_amdgcn_global_load_lds((const unsigned*)((const char*)(gbase) + (voff)[_i]), (PG8_LAS unsigned*)(lds + (bufoff) + ldsw + _i * 8192), 16, 0, 0); } while (0)
#define PG8_LDA(dst, b, h) do { _Pragma("unroll") for (int m = 0; m < 4; ++m) _Pragma("unroll") for (int k = 0; k < 2; ++k) dst[m][k] = *(const PG8_LAS bf16x8*)(lds + PG8_SA(b, h) + aoff + m * 2048 + k * 1024); } while (0)
#define PG8_LDB(dst, b, h) do { _Pragma("unroll") for (int n = 0; n < 2; ++n) _Pragma("unroll") for (int k = 0; k < 2; ++k) dst[n][k] = *(const PG8_LAS bf16x8*)(lds + PG8_SB(b, h) + boff + n * 2048 + k * 1024); } while (0)
#define PG8_MMA(ai, bj, At, Bt) do { __builtin_amdgcn_s_setprio(1); _Pragma("unroll") for (int m = 0; m < 4; ++m) _Pragma("unroll") for (int n = 0; n < 2; ++n) _Pragma("unroll") for (int k = 0; k < 2; ++k) \
        acc[ai][bj][m][n] = __builtin_amdgcn_mfma_f32_16x16x32_bf16(Bt[n][k], At[m][k], acc[ai][bj][m][n], 0, 0, 0); __builtin_amdgcn_s_setprio(0); } while (0)
#define PG8_WAIT_V(n) asm volatile("s_waitcnt vmcnt(" #n ")" ::: "memory")
#define PG8_WAIT_L(n) asm volatile("s_waitcnt lgkmcnt(" #n ")" ::: "memory")
#define PG8_BAR __builtin_amdgcn_s_barrier()
#define PG8_SCHED __builtin_amdgcn_sched_barrier(0)
    Unit cur, nxt; int ui = 0;
    if (!S.next(0, cur)) return;
    f32x4 acc[2][2][4][2];
#pragma unroll
    for (int a = 0; a < 2; ++a)
#pragma unroll
        for (int b = 0; b < 2; ++b)
#pragma unroll
            for (int m = 0; m < 4; ++m)
#pragma unroll
                for (int n = 0; n < 2; ++n) acc[a][b][m][n] = (f32x4){pg8_zero(), pg8_zero(), pg8_zero(), pg8_zero()};
    bf16x8 At[4][2], B0[2][2], B1[2][2];
#define PG8_BASEA(un) ((const char*)g.A + (size_t)(g.mt ? (un).pm % g.mt : (un).pm) * tstepA + (g.mt ? (size_t)((un).pm / g.mt) * g.K * 2 : 0))
#define PG8_BASEB(un) ((const char*)g.Bt + (size_t)(un).pn * tstep + (g.mt ? (size_t)((un).pm / g.mt) * g.K * 2 : 0))
    const char* cA = PG8_BASEA(cur); const char* cB = PG8_BASEB(cur);
    S.a_ready(cur);
    if constexpr (SP2) {
        PG8_STAGE(PG8_SB(0, 0), cB, voffB); PG8_STAGE(PG8_SB(0, 1), cB + hstep, voffB); PG8_STAGE(PG8_SA(0, 0), cA, voffA); PG8_STAGE(PG8_SA(0, 1), cA + hstep, voffA);
        if (wr == 1) PG8_BAR;
        PG8_WAIT_V(2); PG8_BAR;
        PG8_STAGE(PG8_SB(1, 0), cB + kstep, voffB); PG8_STAGE(PG8_SA(1, 0), cA + kstep, voffA); PG8_STAGE(PG8_SB(1, 1), cB + hstep + kstep, voffB);
        PG8_WAIT_V(6); PG8_BAR;
    } else {
        PG8_STAGE(PG8_SB(0, 0), cB, voffB); PG8_STAGE(PG8_SA(0, 0), cA, voffA); PG8_STAGE(PG8_SB(0, 1), cB + hstep, voffB); PG8_STAGE(PG8_SA(0, 1), cA + hstep, voffA);
        if (wr == 1) PG8_BAR;
        PG8_WAIT_V(4); PG8_BAR;
        PG8_STAGE(PG8_SB(1, 0), cB + kstep, voffB); PG8_STAGE(PG8_SA(1, 0), cA + kstep, voffA); PG8_STAGE(PG8_SB(1, 1), cB + hstep + kstep, voffB);
        PG8_WAIT_V(6); PG8_BAR;
    }
    for (;;) {
        const bool has_next = S.next(ui + 1, nxt);
        const char* nA = has_next ? PG8_BASEA(nxt) : cA; const char* nB = has_next ? PG8_BASEB(nxt) : cB;
        for (int t = 0; t < nt; t += 2) {
            const bool last = (t == nt - 2);
            const char* a1 = cA + (size_t)(t + 1) * kstep;
            const char* a2 = last ? nA : cA + (size_t)(t + 2) * kstep; const char* b2 = last ? nB : cB + (size_t)(t + 2) * kstep;
            const char* a3 = a2 + kstep; const char* b3 = b2 + kstep;
            if (last && has_next) S.a_ready(nxt);
            if constexpr (SP2) {
            PG8_LDB(B0, 0, 0); PG8_LDB(B1, 0, 1); PG8_SCHED; PG8_LDA(At, 0, 0); PG8_STAGE(PG8_SA(1, 1), a1 + hstep, voffA);
            PG8_WAIT_V(8); PG8_WAIT_L(0); PG8_BAR; PG8_MMA(0, 0, At, B0); PG8_MMA(0, 1, At, B1); PG8_BAR; PG8_SCHED;
            PG8_LDA(At, 0, 1); PG8_STAGE(PG8_SB(0, 0), b2, voffB); PG8_STAGE(PG8_SB(0, 1), b2 + hstep, voffB); PG8_STAGE(PG8_SA(0, 0), a2, voffA);
            PG8_WAIT_V(8); PG8_WAIT_L(0); PG8_BAR; PG8_MMA(1, 0, At, B0); PG8_MMA(1, 1, At, B1); PG8_BAR; PG8_SCHED;
            PG8_LDB(B0, 1, 0); PG8_LDB(B1, 1, 1); PG8_SCHED; PG8_LDA(At, 1, 0); PG8_STAGE(PG8_SA(0, 1), a2 + hstep, voffA);
            PG8_WAIT_V(8); PG8_WAIT_L(0); PG8_BAR; PG8_MMA(0, 0, At, B0); PG8_MMA(0, 1, At, B1); PG8_BAR; PG8_SCHED;
            PG8_LDA(At, 1, 1); PG8_STAGE(PG8_SB(1, 0), b3, voffB); PG8_STAGE(PG8_SB(1, 1), b3 + hstep, voffB); PG8_STAGE(PG8_SA(1, 0), a3, voffA);
            PG8_WAIT_V(8); PG8_WAIT_L(0); PG8_BAR; PG8_MMA(1, 0, At, B0); PG8_MMA(1, 1, At, B1); PG8_BAR; PG8_SCHED;
            } else {
            PG8_LDB(B0, 0, 0); PG8_SCHED; PG8_LDA(At, 0, 0); PG8_STAGE(PG8_SA(1, 1), a1 + hstep, voffA);
            PG8_WAIT_L(8); PG8_BAR; PG8_WAIT_L(0); PG8_MMA(0, 0, At, B0); PG8_BAR; PG8_SCHED;
            PG8_LDB(B1, 0, 1); PG8_STAGE(PG8_SB(0, 0), b2, voffB);
            PG8_BAR; PG8_WAIT_L(0); PG8_MMA(0, 1, At, B1); PG8_BAR;
            PG8_LDA(At, 0, 1); PG8_STAGE(PG8_SA(0, 0), a2, voffA);
            PG8_BAR; PG8_WAIT_L(0); PG8_MMA(1, 0, At, B0); PG8_BAR; PG8_SCHED;
            PG8_STAGE(PG8_SB(0, 1), b2 + hstep, voffB);
            PG8_WAIT_V(6); PG8_BAR; PG8_MMA(1, 1, At, B1); PG8_BAR;
            PG8_LDB(B0, 1, 0); PG8_SCHED; PG8_LDA(At, 1, 0); PG8_STAGE(PG8_SA(0, 1), a2 + hstep, voffA);
            PG8_WAIT_L(8); PG8_BAR; PG8_WAIT_L(0); PG8_MMA(0, 0, At, B0); PG8_BAR; PG8_SCHED;
            PG8_LDB(B1, 1, 1); PG8_STAGE(PG8_SB(1, 0), b3, voffB);
            PG8_BAR; PG8_WAIT_L(0); PG8_MMA(0, 1, At, B1); PG8_BAR;
            PG8_LDA(At, 1, 1); PG8_STAGE(PG8_SA(1, 0), a3, voffA);
            PG8_BAR; PG8_WAIT_L(0); PG8_MMA(1, 0, At, B0); PG8_BAR; PG8_SCHED;
            PG8_STAGE(PG8_SB(1, 1), b3 + hstep, voffB);
            PG8_WAIT_V(6); PG8_BAR; PG8_MMA(1, 1, At, B1); PG8_BAR;
            }
        }
        if constexpr (ALIGN_EPI) { if (wr == 0) PG8_BAR; }
        if (!E.drain()) { E(acc, cur, wr, wc, fr, fq); S.done(cur); }
        if (!has_next) break;
#pragma unroll
        for (int a = 0; a < 2; ++a)
#pragma unroll
            for (int b = 0; b < 2; ++b)
#pragma unroll
                for (int m = 0; m < 4; ++m)
#pragma unroll
                    for (int n = 0; n < 2; ++n) acc[a][b][m][n] = (f32x4){pg8_zero(), pg8_zero(), pg8_zero(), pg8_zero()};
        cur = nxt; cA = nA; cB = nB; ++ui;
        if constexpr (ALIGN_EPI) { if (wr == 1) PG8_BAR; }
    }
    PG8_WAIT_V(0);
    if constexpr (!ALIGN_EPI) { if (wr == 0) PG8_BAR; }
    PG8_BAR;
    if (E.drain()) { E.fused(acc, cur, wr, wc, fr, fq, lds, wid, lane); S.done(cur); }
#undef PG8_BASEA
#undef PG8_BASEB
#undef PG8_SA
#undef PG8_SB
#undef PG8_STAGE
#undef PG8_LDA
#undef PG8_LDB
#undef PG8_MMA
#undef PG8_WAIT_V
#undef PG8_WAIT_L
#undef PG8_BAR
#undef PG8_SCHED
}
}
#define GAS __attribute__((address_space(1)))
#define LAS __attribute__((address_space(3)))
typedef unsigned short bf16;
typedef unsigned v4u __attribute__((ext_vector_type(4)));
typedef float f32x4 __attribute__((ext_vector_type(4)));
typedef short bf16x8 __attribute__((ext_vector_type(8)));
typedef GAS unsigned gu32;
typedef GAS unsigned long long gu64;
#define RLX_AGENT __ATOMIC_RELAXED, __HIP_MEMORY_SCOPE_AGENT
#define LDS_WAIT() asm volatile("s_waitcnt lgkmcnt(0)" ::: "memory")
#define VM_WAIT() asm volatile("s_waitcnt vmcnt(0)" ::: "memory")
__device__ __forceinline__ unsigned long long rt() { return __builtin_amdgcn_s_memrealtime(); }
__device__ __forceinline__ unsigned f2bf(float f) { unsigned u = __builtin_bit_cast(unsigned, f); return (u + 0x7fffu + ((u >> 16) & 1u)) >> 16; }
__device__ __forceinline__ unsigned pk2(float lo, float hi) { return f2bf(lo) | (f2bf(hi) << 16); }
#define XB_TMO      128
#define XB_XCNT(j)  (256  + 64 * (j))
#define XB_XSUB(j)  (1280 + 64 * (j))
#define XB_XGEN(j)  (2304 + 64 * (j))
#define XB_TOP      3328
#define XB_TOPGEN   3392
#define XCD_BAR_WORDS 3456
#define XB_SPIN_CAP (1u << 18)

__device__ __forceinline__ unsigned xb_ld(unsigned* p)              { return __hip_atomic_load(p, __ATOMIC_RELAXED, __HIP_MEMORY_SCOPE_AGENT); }
__device__ __forceinline__ unsigned xb_add(unsigned* p, unsigned v) { return __hip_atomic_fetch_add(p, v, __ATOMIC_RELAXED, __HIP_MEMORY_SCOPE_AGENT); }
__device__ __forceinline__ unsigned xb_xcc_id() { return (unsigned)__builtin_amdgcn_s_getreg((3 << 11) | 20) & 0xFu; }
#define XB_SPIN(cond, bar) do { unsigned _sp = 0; while (cond) { __builtin_amdgcn_s_sleep(1); \
    if ((++_sp & 255u) == 0u) { if (xb_ld(&(bar)[XB_TMO])) break; if (_sp > XB_SPIN_CAP) { atomicAdd(&(bar)[XB_TMO], 1u); break; } } } } while (0)

struct XcdBarrier {
    int tid; unsigned* bar; unsigned x;
    volatile LAS unsigned* st;
};

__device__ __forceinline__ XcdBarrier xcd_barrier_post(unsigned* bar, volatile LAS unsigned* st, int tid) {
    XcdBarrier b; b.bar = bar; b.x = xb_xcc_id(); b.st = st; b.tid = tid;
    if (tid == 0) (void)xb_add(&bar[XB_XCNT(b.x)], 1u);
    return b;
}
__device__ __forceinline__ void xcd_barrier_complete(unsigned* bar, unsigned x, unsigned& nloc, unsigned& nx) {
    const unsigned G = gridDim.x * gridDim.y * gridDim.z;
    unsigned sum, cnt, mine, sp = 0u;
    for (;;) {
        sum = 0u; cnt = 0u; mine = 0u;
#pragma unroll
        for (unsigned j = 0; j < 16; ++j) { const unsigned c = xb_ld(&bar[XB_XCNT(j)]); sum += c; cnt += (c > 0u) ? 1u : 0u; mine = (j == x) ? c : mine; }
        if (sum == G) break;
        __builtin_amdgcn_s_sleep(1);
        if ((++sp & 255u) == 0u) { if (xb_ld(&bar[XB_TMO])) break; if (sp > XB_SPIN_CAP) { atomicAdd(&bar[XB_TMO], 1u); break; } }
    }
    nloc = mine > 0u ? mine : 1u; nx = cnt > 0u ? cnt : 1u;
}

__device__ __forceinline__ void xcd_barrier(const XcdBarrier& b) {
    asm volatile("s_waitcnt vmcnt(0)" ::: "memory");
    __syncthreads();
    if (b.tid == 0) {
        unsigned* bar = b.bar;
        __builtin_amdgcn_s_waitcnt(0);
        unsigned nloc = b.st[0], nx = b.st[1];
        if (nloc == 0u) { xcd_barrier_complete(bar, b.x, nloc, nx); b.st[0] = nloc; b.st[1] = nx; }
        const unsigned old = xb_add(&bar[XB_XSUB(b.x)], 1u);
        const unsigned gen = old / nloc;
        if (old + 1u == (gen + 1u) * nloc) {
            __builtin_amdgcn_fence(__ATOMIC_RELEASE, "agent");
            asm volatile("s_waitcnt vmcnt(0)" ::: "memory");
            const unsigned og = xb_add(&bar[XB_TOP], 1u);
            const unsigned tg = og / nx;
            if (og + 1u == (tg + 1u) * nx) xb_add(&bar[XB_TOPGEN], 1u);
            else XB_SPIN(xb_ld(&bar[XB_TOPGEN]) == tg, bar);
            __builtin_amdgcn_fence(__ATOMIC_ACQUIRE, "agent");
            xb_add(&bar[XB_XGEN(b.x)], 1u);
            asm volatile("s_waitcnt vmcnt(0)" ::: "memory");
        } else {
            XB_SPIN(xb_ld(&bar[XB_XGEN(b.x)]) == gen, bar);
            __builtin_amdgcn_fence(__ATOMIC_ACQUIRE, "agent");
            asm volatile("s_waitcnt vmcnt(0)" ::: "memory");
        }
    }
    __syncthreads();
}

namespace mk {
constexpr int NWAVES = 8, NTHR = 512;
constexpr int D = 1024, NBATCH = 4, SEQ = 4096, CTXL = 256;
constexpr int MLAT = NBATCH * SEQ, MCTX = NBATCH * CTXL, MALL = MLAT + MCTX;
constexpr int INW = 2496, INP = 2560, DFF = 2816, NGU = 2 * DFF;
constexpr int C_R = 0, C_K = 256, C_V = 512, C_GD = 768, C_WD = 832, C_AD = 896, C_DFQ = 960, C_DFK = 1216, C_DFV = 1472, C_GQQ = 1728, C_GQK = 2240, C_GQV = 2368;
constexpr float NORM_EPS = 1e-6f, LOG2E = 1.4426950408889634f;
constexpr float SC_DF = 0.17677669529663687f * LOG2E;
constexpr float SC_GQ = 0.125f * LOG2E;

enum { I_X = 0, I_C, I_CTX, I_CCTX, I_ADAW, I_ADAB, I_NORMG, I_WIN, I_WOUT, I_RWCONV, I_RWW0, I_RWWUP, I_RWA0, I_RWAUP, I_RWGUP, I_RWKK, I_RWKA, I_RWRK, I_RWLNG, I_RWLNB,
       I_DFLAM, I_DFNG, I_GQSINK, I_FFG, I_FFU, I_FFD, I_FFCW, I_FFCB, N_IN };

constexpr size_t MiB = 1u << 20;
constexpr size_t WS_CTL = 0, CTL_ZERO_BYTES = 1 * MiB;
constexpr int CW_BAR = 4096;
constexpr size_t WS_MOD = 1 * MiB;
constexpr size_t WS_TAB = 1 * MiB + 256 * 1024;
constexpr size_t WS_WIN = 2 * MiB, WIN_BYTES = (size_t)INP * D * 2;
constexpr size_t WS_WOUT = 12 * MiB, WOUT_BYTES = (size_t)D * D * 2;
constexpr size_t WS_WGU = 16 * MiB, WGU_BYTES = (size_t)NGU * D * 2;
constexpr size_t WS_WD = 38 * MiB, WD_BYTES = (size_t)D * DFF * 2;
constexpr size_t WS_XSC = 49 * MiB;
constexpr size_t WS_XN = 53 * MiB;
constexpr size_t WS_RP = 87 * MiB;
constexpr size_t WS_RF = 172 * MiB;
constexpr size_t FEAT1 = (size_t)MALL * 256 * 2;
constexpr size_t WS_GAL = WS_RF, WS_GBE = WS_GAL + 2 * FEAT1, WS_GKP = WS_GBE + 2 * FEAT1, WS_GRH = WS_GKP + 2 * FEAT1, WS_FV = WS_GRH + 2 * FEAT1;
constexpr size_t WS_GLT = WS_FV + FEAT1;
constexpr size_t WS_BON = WS_GLT + (size_t)2 * 272 * 256 * 4;
constexpr size_t WS_RF_END = WS_BON + (size_t)MALL * 4 * 4;
constexpr size_t WS_ACT = WS_RP;
constexpr size_t WS_FP = 181 * MiB;
constexpr size_t WS_SLO = WS_RF;
constexpr size_t WS_SLD = 215 * MiB;
constexpr size_t WS_XB = 240 * MiB;
constexpr size_t WS_END = 256 * MiB;
static_assert(WS_RF_END <= WS_END, "feature region");
static_assert(WS_SLD + (size_t)11 * MCTX * D * 2 <= WS_XB && WS_XB + (size_t)8 * MLAT * 4 * 4 <= WS_END, "exchange slots");
static_assert(WS_FP + (size_t)MALL * D * 2 <= WS_SLD && WS_SLD + (size_t)11 * MCTX * D * 2 <= WS_END, "slabs");
static_assert(WS_ACT + (size_t)MALL * DFF * 2 <= WS_FP && WS_FP + (size_t)MALL * D * 4 <= WS_END, "ffn buffers");
static_assert(WS_XN + (size_t)MALL * D * 2 <= WS_RP && WS_RP + (size_t)MALL * INP * 2 <= WS_RF, "map");

constexpr int LDS_BYTES = 163840;
constexpr int LDSCTL_OFF = LDS_BYTES - 512, MISC_OFF = LDSCTL_OFF + 320;
constexpr int CW_QUEUE = 2048, CW_PST = 32768;

struct Args { const float* in[N_IN]; float* out; unsigned char* ws; int ph_lo, ph_hi; };


typedef const __attribute__((address_space(4))) char* kptr_t;
__device__ __forceinline__ kptr_t karg_base() { kptr_t k = (kptr_t)__builtin_amdgcn_kernarg_segment_ptr(); asm volatile("" : "+s"(k)); return k; }
__device__ __forceinline__ const float* kin(int i) { return *(const float* const __attribute__((address_space(4)))*)(karg_base() + 8 * i); }
__device__ __forceinline__ float* kout() { return *(float* const __attribute__((address_space(4)))*)(karg_base() + 8 * N_IN); }
__device__ __forceinline__ unsigned char* kws() { return *(unsigned char* const __attribute__((address_space(4)))*)(karg_base() + 8 * N_IN + 8); }

struct Frame {
    LAS unsigned char* lds;
    int tid, lane, wave, G, bid;
};

__device__ __forceinline__ float bf2f(bf16 h) { return __uint_as_float(((unsigned)h) << 16); }
template <int CTRL> __device__ __forceinline__ float dpp_mov(float x) { return __int_as_float(__builtin_amdgcn_update_dpp(0, __float_as_int(x), CTRL, 0xF, 0xF, false)); }
template <int CTRL> __device__ __forceinline__ float dpp_add(float x) { return x + dpp_mov<CTRL>(x); }
__device__ __forceinline__ float wave_sum(float v) {
    v = dpp_add<0xB1>(v); v = dpp_add<0x4E>(v); v = dpp_add<0x124>(v); v = dpp_add<0x128>(v);
    auto r = __builtin_amdgcn_permlane16_swap(__float_as_uint(v), __float_as_uint(v), false, false); v = __uint_as_float(r[0]) + __uint_as_float(r[1]);
    r = __builtin_amdgcn_permlane32_swap(__float_as_uint(v), __float_as_uint(v), false, false); return __uint_as_float(r[0]) + __uint_as_float(r[1]);
}
__device__ __forceinline__ float rdlane(float v, int l) { return __int_as_float(__builtin_amdgcn_readlane(__float_as_int(v), l)); }
__device__ __forceinline__ float sigmoidf_(float x) { return __builtin_amdgcn_rcpf(1.0f + __expf(-x)); }
typedef unsigned v2u __attribute__((ext_vector_type(2)));
typedef float f32x2_t __attribute__((ext_vector_type(2))); typedef __bf16 bf16x2_t __attribute__((ext_vector_type(2)));
__device__ __forceinline__ unsigned pk2h(float lo, float hi) { f32x2_t v = {lo, hi}; bf16x2_t b = __builtin_convertvector(v, bf16x2_t); return __builtin_bit_cast(unsigned, b); }
__device__ __forceinline__ float xmax4(float v) {
    auto r = __builtin_amdgcn_permlane16_swap(__float_as_uint(v), __float_as_uint(v), false, false); v = fmaxf(__uint_as_float(r[0]), __uint_as_float(r[1]));
    r = __builtin_amdgcn_permlane32_swap(__float_as_uint(v), __float_as_uint(v), false, false); return fmaxf(__uint_as_float(r[0]), __uint_as_float(r[1]));
}

__device__ __forceinline__ void p0_transpose_item(const float* W, int K, int N, bf16* WT, int row_off, LAS float* scr, int item, int lane) {
    const int nblk = N / 32, kb = item / nblk, nb = item % nblk, k0 = 64 * kb, n0 = 32 * nb;
#pragma unroll 8
    for (int i = 0; i < 32; ++i) { const int kk = 2 * i + (lane >> 5); scr[kk * 33 + (lane & 31)] = W[(size_t)(k0 + kk) * N + n0 + (lane & 31)]; }
    LDS_WAIT(); asm volatile("" ::: "memory");
    const int c = lane & 7;
#pragma unroll
    for (int j = 0; j < 4; ++j) { const int n = (lane >> 3) + 8 * j; const LAS float* s = scr + (8 * c) * 33 + n;
        v4u o; o.x = pk2h(s[0 * 33], s[1 * 33]); o.y = pk2h(s[2 * 33], s[3 * 33]); o.z = pk2h(s[4 * 33], s[5 * 33]); o.w = pk2h(s[6 * 33], s[7 * 33]);
        *(GAS v4u*)(WT + (size_t)(row_off + n0 + n) * K + k0 + 8 * c) = o; }
    LDS_WAIT(); asm volatile("" ::: "memory");
}

constexpr int WI_IN = 16 * (INW / 32), WI_OUT = 16 * 32, WI_G = 16 * (DFF / 32), WI_DN = (DFF / 64) * 32, WI_LAYER = WI_IN + WI_OUT + 2 * WI_G + WI_DN;
__device__ __forceinline__ void weight_item(int it, LAS float* scr, int lane) {
    unsigned char* ws = kws();
    const int l = it / WI_LAYER; int r = it % WI_LAYER;
    if (r < WI_IN) { p0_transpose_item(kin(I_WIN) + (size_t)l * D * INW, D, INW, (bf16*)(ws + WS_WIN + l * WIN_BYTES), 0, scr, r, lane); return; } r -= WI_IN;
    if (r < WI_OUT) { p0_transpose_item(kin(I_WOUT) + (size_t)l * D * D, D, D, (bf16*)(ws + WS_WOUT + l * WOUT_BYTES), 0, scr, r, lane); return; } r -= WI_OUT;
    if (r < WI_G) { const int n0 = 32 * (r % (DFF / 32)); p0_transpose_item(kin(I_FFG) + (size_t)l * D * DFF, D, DFF, (bf16*)(ws + WS_WGU + l * WGU_BYTES), 256 * (n0 >> 7) + (n0 & 127) - n0, scr, r, lane); return; } r -= WI_G;
    if (r < WI_G) { const int n0 = 32 * (r % (DFF / 32)); p0_transpose_item(kin(I_FFU) + (size_t)l * D * DFF, D, DFF, (bf16*)(ws + WS_WGU + l * WGU_BYTES), 256 * (n0 >> 7) + (n0 & 127) - n0 + 128, scr, r, lane); return; } r -= WI_G;
    p0_transpose_item(kin(I_FFD) + (size_t)l * DFF * D, DFF, D, (bf16*)(ws + WS_WD + l * WD_BYTES), 0, scr, r, lane);
}
constexpr int WI_FILL = (2 * WI_LAYER - WI_IN + 127) / 128;

__device__ __forceinline__ void p0_prologue(const Args& A, Frame& F) {
    unsigned char* ws = kws();
    {
        LAS float* sc = (LAS float*)F.lds;
        LAS float* red = (LAS float*)(F.lds + 20480);
        float* mod = (float*)(ws + WS_MOD);
        for (int u = F.bid; u < 192; u += F.G) {
            __syncthreads();
            for (int i = F.tid; i < 5 * 1024; i += NTHR) { const int bb = i >> 10, k = i & 1023; const float v = bb < 4 ? kin(I_C)[bb * 1024 + k] : kin(I_CCTX)[k]; sc[i] = v / (1.0f + __expf(-v)); }
            __syncthreads();
            const int l = u / 96, cc = u % 96, col = cc * 64 + (F.tid & 63), ks = F.tid >> 6;
            const float* w = kin(I_ADAW) + (size_t)l * 1024 * 6144 + col;
            float acc[5] = {0.f, 0.f, 0.f, 0.f, 0.f};
            for (int k0 = ks * 128; k0 < ks * 128 + 128; k0 += 16) { float wv[16];
#pragma unroll
                for (int q = 0; q < 16; ++q) wv[q] = w[(size_t)(k0 + q) * 6144];
#pragma unroll
                for (int q = 0; q < 16; ++q)
#pragma unroll
                    for (int bb = 0; bb < 5; ++bb) acc[bb] += sc[bb * 1024 + k0 + q] * wv[q]; }
#pragma unroll
            for (int bb = 0; bb < 5; ++bb) red[(ks * 5 + bb) * 64 + (F.tid & 63)] = acc[bb];
            __syncthreads();
            if (F.tid < 320) { const int bb = F.tid >> 6, c = F.tid & 63; float s = kin(I_ADAB)[l * 6144 + cc * 64 + c];
#pragma unroll
                for (int k8 = 0; k8 < 8; ++k8) s += red[(k8 * 5 + bb) * 64 + c];
                mod[(size_t)(l * 5 + bb) * 6144 + cc * 64 + c] = s; }
        }
        __syncthreads();
    }
    {
        LAS float* scr = (LAS float*)(F.lds + F.wave * 16384);
        const int gw = F.bid * NWAVES + F.wave, NGW = F.G * NWAVES;
        for (int it = gw; it < WI_IN; it += NGW) weight_item(it, scr, F.lane);
        const int gt = F.bid * NTHR + F.tid, NGT = F.G * NTHR;
        for (int i = gt; i < 2 * 8192; i += NGT) { const int l = i >> 13, j = i & 8191;
            *(GAS v4u*)(ws + WS_WIN + l * WIN_BYTES + (size_t)INW * D * 2 + (size_t)j * 16) = (v4u){0u, 0u, 0u, 0u}; }
    }
    if (F.bid == 0) {
        float* tab = (float*)(ws + WS_TAB);
        for (int i = F.tid; i < 512; i += NTHR) { const int pos = i >> 3, f = i & 7; const float inv = __builtin_amdgcn_exp2f(-(float)f * (13.287712379549449f / 8.0f)), ang = (float)pos * inv; tab[i] = __cosf(ang); tab[512 + i] = __sinf(ang); }
        for (int i = F.tid; i < 1024; i += NTHR) { const int pos = i >> 4, f = i & 15; const float inv = __builtin_amdgcn_exp2f(-(float)f * (13.287712379549449f / 16.0f)), ang = (float)pos * inv; tab[1024 + i] = __cosf(ang); tab[2048 + i] = __sinf(ang); }
        if (F.tid < 2) { const int l = F.tid; const float* lv = kin(I_DFLAM) + l * 128; float s1 = 0.f, s2 = 0.f;
            for (int i = 0; i < 32; ++i) { s1 += lv[i] * lv[32 + i]; s2 += lv[64 + i] * lv[96 + i]; }
            const float lam_init = 0.8f - 0.6f * __expf(-0.3f * (float)l);
            tab[3072 + l] = __expf(s1) - __expf(s2) + lam_init; tab[3074 + l] = lam_init; }
    }
}

__device__ __forceinline__ const float* mod_vec(const Args& A, int l, int bb, int i) { return (const float*)(kws() + WS_MOD) + ((size_t)(l * 5 + bb) * 6 + i) * 1024; }
__device__ __forceinline__ const float* normg_vec(const Args& A, int l, int i) { return kin(I_NORMG) + (size_t)(l * 4 + i) * 1024; }
__device__ __forceinline__ int row_bb(int row) { return row < MLAT ? (row >> 12) : 4; }
__device__ __forceinline__ void seq_pos(int row, int& t, int& T) { if (row < MLAT) { t = row & (SEQ - 1); T = SEQ; } else { t = (row - MLAT) & (CTXL - 1); T = CTXL; } }
__device__ __forceinline__ void ld16(const float* p, int lane, f32x4 (&v)[4]) {
#pragma unroll
    for (int j = 0; j < 4; ++j) v[j] = *(const f32x4*)(p + 4 * lane + 256 * j);
}
__device__ __forceinline__ void ld16b(const bf16* p, int lane, f32x4 (&v)[4]) {
#pragma unroll
    for (int j = 0; j < 4; ++j) { const v2u u = *(const v2u*)(p + 4 * lane + 256 * j);
        v[j] = (f32x4){__uint_as_float(u.x << 16), __uint_as_float(u.x & 0xffff0000u), __uint_as_float(u.y << 16), __uint_as_float(u.y & 0xffff0000u)}; }
}
__device__ __forceinline__ void st16(float* p, int lane, const f32x4 (&v)[4]) {
#pragma unroll
    for (int j = 0; j < 4; ++j) *(f32x4*)(p + 4 * lane + 256 * j) = v[j];
}
__device__ __forceinline__ float sumsq16(const f32x4 (&v)[4]) {
    float s = 0.f;
#pragma unroll
    for (int j = 0; j < 4; ++j) s += (v[j].x * v[j].x + v[j].y * v[j].y) + (v[j].z * v[j].z + v[j].w * v[j].w);
    return wave_sum(s);
}
__device__ __forceinline__ void norm_mod_store(const f32x4 (&v)[4], float rstd, const float* g, const float* sc, const float* sh, bf16* orow, int lane) {
#pragma unroll
    for (int j = 0; j < 4; ++j) {
        const int c = 4 * lane + 256 * j;
        const f32x4 gg = *(const f32x4*)(g + c), s1 = *(const f32x4*)(sc + c), s0 = *(const f32x4*)(sh + c);
        const f32x4 h = v[j] * rstd * gg * (s1 + 1.0f) + s0;
        v2u o; o.x = pk2h(h.x, h.y); o.y = pk2h(h.z, h.w);
        *(v2u*)(orow + c) = o;
    }
}
__device__ __forceinline__ float* xs_row(const Args& A, int row) { return row < MLAT ? kout() + (size_t)row * D : (float*)(kws() + WS_XSC) + (size_t)(row - MLAT) * D; }
__device__ __forceinline__ const float* xin_row(const Args& A, int row) { return row < MLAT ? kin(I_X) + (size_t)row * D : kin(I_CTX) + (size_t)(row - MLAT) * D; }

__device__ __forceinline__ void phase_prep(const Args& A, Frame& F) {
    const int gw = F.bid * NWAVES + F.wave, NGW = F.G * NWAVES;
    bf16* XN = (bf16*)(kws() + WS_XN);
    f32x4 v[4], vn[4];
    if (gw < MALL) ld16(xin_row(A, gw), F.lane, v);
    for (int row = gw; row < MALL; row += NGW) {
        if (row + NGW < MALL) ld16(xin_row(A, row + NGW), F.lane, vn);
        const float rstd = rsqrtf(sumsq16(v) * (1.0f / D) + NORM_EPS);
        const int bb = row_bb(row);
        norm_mod_store(v, rstd, normg_vec(A, 0, 0), mod_vec(A, 0, bb, 1), mod_vec(A, 0, bb, 0), XN + (size_t)row * D, F.lane);
#pragma unroll
        for (int j = 0; j < 4; ++j) v[j] = vn[j];
    }
}
__device__ __forceinline__ void phase_e1(const Args& A, Frame& F, int l) {
    const int gw = F.bid * NWAVES + F.wave, NGW = F.G * NWAVES, nrows = l == 0 ? MALL : MLAT;
    bf16* XN = (bf16*)(kws() + WS_XN); const bf16* YP = (const bf16*)(kws() + WS_RP);
    for (int row = ((MK_FUSE & 1) && !MK_DBGD ? MLAT : 0) + gw; row < nrows; row += NGW) {
        const int bb = row_bb(row);
        f32x4 y[4], x[4];
        if (l == 0 && row >= MLAT) { const bf16* sl = (const bf16*)(kws() + WS_SLO) + (size_t)(row - MLAT) * D; ld16b(sl, F.lane, y);
            for (int s = 1; s < 4; ++s) { f32x4 t[4]; ld16b(sl + (size_t)s * MCTX * D, F.lane, t);
#pragma unroll
                for (int j = 0; j < 4; ++j) y[j] = y[j] + t[j]; } }
        else ld16b(YP + (size_t)row * D, F.lane, y);
        if (l == 0) ld16(xin_row(A, row), F.lane, x); else ld16(xs_row(A, row), F.lane, x);
        const float ry = rsqrtf(sumsq16(y) * (1.0f / D) + NORM_EPS);
        const float* g1 = normg_vec(A, l, 1); const float* ga = mod_vec(A, l, bb, 2);
#pragma unroll
        for (int j = 0; j < 4; ++j) { const int c = 4 * F.lane + 256 * j; x[j] = x[j] + *(const f32x4*)(ga + c) * (y[j] * ry * *(const f32x4*)(g1 + c)); }
        st16(xs_row(A, row), F.lane, x);
        const float rx = rsqrtf(sumsq16(x) * (1.0f / D) + NORM_EPS);
        norm_mod_store(x, rx, normg_vec(A, l, 2), mod_vec(A, l, bb, 4), mod_vec(A, l, bb, 3), XN + (size_t)row * D, F.lane);
    }
}
__device__ __forceinline__ void phase_e2(const Args& A, Frame& F, int l, int r0, int r1) {
    const int gw = F.bid * NWAVES + F.wave, NGW = F.G * NWAVES;
    bf16* XN = (bf16*)(kws() + WS_XN); const bf16* FP = (const bf16*)(kws() + WS_FP);
    for (int row = ((MK_FUSE & 2) && !MK_DBGD ? (r0 < MLAT ? MLAT : r0) : r0) + gw; row < r1; row += NGW) {
        const int bb = row_bb(row);
        f32x4 y[4], x[4];
        if (l == 0 && row >= MLAT) { const bf16* sl = (const bf16*)(kws() + WS_SLD) + (size_t)(row - MLAT) * D; ld16b(sl, F.lane, y);
            for (int s = 1; s < 11; ++s) { f32x4 t[4]; ld16b(sl + (size_t)s * MCTX * D, F.lane, t);
#pragma unroll
                for (int j = 0; j < 4; ++j) y[j] = y[j] + t[j]; } }
        else ld16b(FP + (size_t)(row - r0) * D, F.lane, y);
        ld16(xs_row(A, row), F.lane, x);
        const float ry = rsqrtf(sumsq16(y) * (1.0f / D) + NORM_EPS);
        const float* g3 = normg_vec(A, l, 3); const float* ga = mod_vec(A, l, bb, 5);
#pragma unroll
        for (int j = 0; j < 4; ++j) { const int c = 4 * F.lane + 256 * j; x[j] = x[j] + *(const f32x4*)(ga + c) * (y[j] * ry * *(const f32x4*)(g3 + c)); }
        st16(xs_row(A, row), F.lane, x);
        if (l == 0) {
            const float rx = rsqrtf(sumsq16(x) * (1.0f / D) + NORM_EPS);
            norm_mod_store(x, rx, normg_vec(A, 1, 0), mod_vec(A, 1, bb, 1), mod_vec(A, 1, bb, 0), XN + (size_t)row * D, F.lane);
        }
    }
}
__device__ __forceinline__ void phase_act(const Args& A, Frame& F, int l, int r0, int r1) {
    const bf16* GU = (const bf16*)(kws() + WS_RP); bf16* ACT = (bf16*)(kws() + WS_ACT);
    const float* cw = kin(I_FFCW) + (size_t)l * 3 * DFF; const float* cb = kin(I_FFCB) + (size_t)l * DFF;
    const int nch = DFF / 8, total = (r1 - r0) * nch;
    for (int i = F.bid * NTHR + F.tid; i < total; i += F.G * NTHR) {
        const int rr = i / nch, ch = i % nch, row = r0 + rr, j0 = ch * 8;
        const int t = row < MLAT ? (row & (SEQ - 1)) : ((row - MLAT) & (CTXL - 1)), T = row < MLAT ? SEQ : CTXL;
        const bf16* gp = GU + (size_t)rr * NGU + j0;
        const v4u gc = *(const v4u*)gp, uu = *(const v4u*)(gp + DFF);
        v4u gm = (v4u){0u, 0u, 0u, 0u}, gn = (v4u){0u, 0u, 0u, 0u};
        if (t > 0) gm = *(const v4u*)(gp - NGU);
        if (t < T - 1) gn = *(const v4u*)(gp + NGU);
        unsigned o[4];
#pragma unroll
        for (int q = 0; q < 4; ++q) {
            float r2[2];
#pragma unroll
            for (int e = 0; e < 2; ++e) {
                const int j = j0 + 2 * q + e;
                const float a = __uint_as_float(e ? (gm[q] & 0xffff0000u) : (gm[q] << 16)), b = __uint_as_float(e ? (gc[q] & 0xffff0000u) : (gc[q] << 16)), c = __uint_as_float(e ? (gn[q] & 0xffff0000u) : (gn[q] << 16));
                const float u = __uint_as_float(e ? (uu[q] & 0xffff0000u) : (uu[q] << 16));
                const float z = a * cw[j] + b * cw[DFF + j] + c * cw[2 * DFF + j] + cb[j];
                r2[e] = z / (1.0f + __expf(-z)) * u;
            }
            o[q] = pk2h(r2[0], r2[1]);
        }
        *(v4u*)(ACT + (size_t)rr * DFF + j0) = (v4u){o[0], o[1], o[2], o[3]};
    }
}

struct EpiMulti {
    static constexpr bool PERM = false, AFTER_DRAIN = false;
    int mode;
    bf16* ob; float* of; int ld; const float* tab;
    const float* cw; const float* cb; int nrows; unsigned ldsx;
    const float* xin; float* xout; bf16* xn; const float *gA, *gaA, *gB, *scB, *shB; float* xb0; float* xb1; gu32* cnt0; gu32* cnt1; int two;
    __device__ __forceinline__ bool drain() const { return mode >= 5; }
    __device__ __forceinline__ void row_stats(const pg8::f32x4 (&v)[2][2][4][2], const pg8::Unit& u, int wr, int wc, int fr, int fq, LAS unsigned char* lds, int wid, int lane, float* xb, gu32* cnt) const {
        LAS float* Pp = (LAS float*)lds; LAS float* Ss = (LAS float*)(lds + 8192); LAS unsigned* flag = (LAS unsigned*)(lds + 8192 + 1024);
#pragma unroll
        for (int ai = 0; ai < 2; ++ai)
#pragma unroll
            for (int mm = 0; mm < 4; ++mm) { float s = 0.f;
#pragma unroll
                for (int bj = 0; bj < 2; ++bj)
#pragma unroll
                    for (int n = 0; n < 2; ++n) { const pg8::f32x4 x = v[ai][bj][mm][n]; s += (x[0] * x[0] + x[1] * x[1]) + (x[2] * x[2] + x[3] * x[3]); }
                s += __shfl_xor(s, 16); s += __shfl_xor(s, 32);
                if (fq == 0) Pp[(ai * 128 + wr * 64 + mm * 16 + fr) * 4 + wc] = s; }
        asm volatile("s_waitcnt lgkmcnt(0)" ::: "memory"); __builtin_amdgcn_s_barrier(); asm volatile("" ::: "memory");
        const int row = wid * 32 + (lane & 31);
        if (lane < 32) { const float s = (Pp[row * 4 + 0] + Pp[row * 4 + 1]) + (Pp[row * 4 + 2] + Pp[row * 4 + 3]);
            __hip_atomic_store((gu32*)(xb + ((size_t)u.pn * MLAT + u.pm * 256 + row)), __float_as_uint(s), __ATOMIC_RELAXED, __HIP_MEMORY_SCOPE_AGENT); }
        asm volatile("s_waitcnt vmcnt(0)" ::: "memory");
        if (lane == 0) __hip_atomic_fetch_add(cnt + 64 * u.pm, 1u, __ATOMIC_RELAXED, __HIP_MEMORY_SCOPE_AGENT);
        if (wid == 0) {
            unsigned sp = 0;
            while ((unsigned)__builtin_amdgcn_readfirstlane(__hip_atomic_load(cnt + 64 * u.pm, __ATOMIC_RELAXED, __HIP_MEMORY_SCOPE_AGENT)) < 32u) { __builtin_amdgcn_s_sleep(2); if (++sp > (1u << 22)) break; }
            __builtin_amdgcn_fence(__ATOMIC_ACQUIRE, "agent");
            if (lane == 0) flag[0] = 1u;
        }
        asm volatile("s_waitcnt vmcnt(0) lgkmcnt(0)" ::: "memory"); __builtin_amdgcn_s_barrier(); asm volatile("" ::: "memory");
        if (lane < 32) { float t = 0.f;
#pragma unroll
            for (int q = 0; q < 4; ++q) t += __uint_as_float(__hip_atomic_load((gu32*)(xb + ((size_t)q * MLAT + u.pm * 256 + row)), __ATOMIC_RELAXED, __HIP_MEMORY_SCOPE_AGENT));
            Ss[row] = rsqrtf(t * (1.0f / D) + NORM_EPS); }
        asm volatile("s_waitcnt vmcnt(0) lgkmcnt(0)" ::: "memory"); __builtin_amdgcn_s_barrier(); asm volatile("" ::: "memory");
    }
    __device__ __forceinline__ void fused(pg8::f32x4 (&acc)[2][2][4][2], const pg8::Unit& u, int wr, int wc, int fr_, int fq_, PG8_LAS unsigned char* lds, int wid, int lane) const {
        int fr = fr_, fq = fq_; asm volatile("" : "+v"(fr), "+v"(fq));
#if defined(MK_DBGDRAIN)
        { bf16* obd = mode == 5 ? (bf16*)(kws() + WS_RP) : (bf16*)(kws() + WS_FP);
#pragma unroll
          for (int ai = 0; ai < 2; ++ai)
#pragma unroll
            for (int mm = 0; mm < 4; ++mm) { bf16* rp = obd + (size_t)(u.pm * 256 + ai * 128 + wr * 64 + mm * 16 + fr) * D + u.pn * 256 + wc * 32 + 4 * fq;
#pragma unroll
                for (int bj = 0; bj < 2; ++bj)
#pragma unroll
                    for (int n = 0; n < 2; ++n) { const pg8::f32x4 v = acc[ai][bj][mm][n]; v2u o; o.x = pk2h(v[0], v[1]); o.y = pk2h(v[2], v[3]); *(v2u*)(rp + bj * 128 + n * 16) = o; } }
          return; }
#endif
        const LAS float* Ss = (const LAS float*)((LAS unsigned char*)lds + 8192);
        const int col0 = u.pn * 256 + wc * 32 + 4 * fq, bofs = (u.pm >> 4) * 6144;
        row_stats(acc, u, wr, wc, fr, fq, (LAS unsigned char*)lds, wid, lane, xb0, cnt0);
        pg8::f32x4 cA_[2][2];
#pragma unroll
        for (int bj = 0; bj < 2; ++bj)
#pragma unroll
            for (int n = 0; n < 2; ++n) cA_[bj][n] = *(const pg8::f32x4*)(gA + col0 + 128 * bj + 16 * n) * *(const pg8::f32x4*)(gaA + bofs + col0 + 128 * bj + 16 * n);
#pragma unroll
        for (int ai = 0; ai < 2; ++ai)
#pragma unroll
            for (int mm = 0; mm < 4; ++mm) { const int r = ai * 128 + wr * 64 + mm * 16 + fr; const float rs = Ss[r]; const size_t off = (size_t)(u.pm * 256 + r) * D + col0;
#pragma unroll
                for (int bj = 0; bj < 2; ++bj)
#pragma unroll
                    for (int n = 0; n < 2; ++n) { const pg8::f32x4 xi = *(const pg8::f32x4*)(xin + off + 128 * bj + 16 * n); acc[ai][bj][mm][n] = xi + cA_[bj][n] * (acc[ai][bj][mm][n] * rs); }
                asm volatile("" : "+v"(acc[ai][0][mm][0]), "+v"(acc[ai][0][mm][1]), "+v"(acc[ai][1][mm][0]), "+v"(acc[ai][1][mm][1]));
                if (mm & 1) asm volatile("" ::: "memory"); }
        if (two) {
            asm volatile("s_waitcnt lgkmcnt(0)" ::: "memory"); __builtin_amdgcn_s_barrier(); asm volatile("" ::: "memory");
            row_stats(acc, u, wr, wc, fr, fq, (LAS unsigned char*)lds, wid, lane, xb1, cnt1);
        }
        pg8::f32x4 cB_[2][2], cS_[2][2];
        if (two) {
#pragma unroll
            for (int bj = 0; bj < 2; ++bj)
#pragma unroll
                for (int n = 0; n < 2; ++n) { cB_[bj][n] = *(const pg8::f32x4*)(gB + col0 + 128 * bj + 16 * n) * (*(const pg8::f32x4*)(scB + bofs + col0 + 128 * bj + 16 * n) + 1.0f); cS_[bj][n] = *(const pg8::f32x4*)(shB + bofs + col0 + 128 * bj + 16 * n); }
        }
#pragma unroll
        for (int ai = 0; ai < 2; ++ai)
#pragma unroll
            for (int mm = 0; mm < 4; ++mm) { const int r = ai * 128 + wr * 64 + mm * 16 + fr; const size_t off = (size_t)(u.pm * 256 + r) * D + col0; const float rs = two ? Ss[r] : 0.f;
#pragma unroll
                for (int bj = 0; bj < 2; ++bj)
#pragma unroll
                    for (int n = 0; n < 2; ++n) { const pg8::f32x4 x1 = acc[ai][bj][mm][n]; *(pg8::f32x4*)(xout + off + 128 * bj + 16 * n) = x1;
                        if (two) { const pg8::f32x4 hh = x1 * rs * cB_[bj][n] + cS_[bj][n]; v2u o; o.x = pk2h(hh[0], hh[1]); o.y = pk2h(hh[2], hh[3]); *(v2u*)(xn + off + 128 * bj + 16 * n) = o; } }
                asm volatile("" ::: "memory"); }
        asm volatile("s_waitcnt lgkmcnt(0)" ::: "memory"); __builtin_amdgcn_s_barrier(); asm volatile("" ::: "memory");
    }
    __device__ __forceinline__ void operator()(const pg8::f32x4 (&acc)[2][2][4][2], const pg8::Unit& u, int wr, int wc, int fr_, int fq_) const {
        int fr = fr_, fq = fq_; asm volatile("" : "+v"(fr), "+v"(fq));
        if (mode == 1) {
#pragma unroll
            for (int ai = 0; ai < 2; ++ai)
#pragma unroll
                for (int m = 0; m < 4; ++m) { float* rp = of + (size_t)(u.pm * 256 + ai * 128 + wr * 64 + m * 16 + fr) * ld + u.pn * 256 + wc * 32 + 4 * fq;
#pragma unroll
                    for (int bj = 0; bj < 2; ++bj)
#pragma unroll
                        for (int n = 0; n < 2; ++n) *(pg8::f32x4*)(rp + bj * 128 + n * 16) = acc[ai][bj][m][n]; }
        } else if (mode == 3) {
            const unsigned par = (unsigned)(u.pm + u.pn) & 1u;
            const unsigned ex = ldsx + par * 4096u + (unsigned)(wc * 32 + 4 * fq) * 4u;
#pragma unroll
            for (int ai = 0; ai < 2; ++ai)
#pragma unroll
                for (int n = 0; n < 2; ++n) {
                    if (fr == 0) *(LAS pg8::f32x4*)(uintptr_t)(ex + (unsigned)(((ai * 2 + wr) * 2 + 0) * 128 + n * 16) * 4u) = acc[ai][0][0][n];
                    if (fr == 15) *(LAS pg8::f32x4*)(uintptr_t)(ex + (unsigned)(((ai * 2 + wr) * 2 + 1) * 128 + n * 16) * 4u) = acc[ai][0][3][n];
                }
            asm volatile("s_waitcnt lgkmcnt(0)" ::: "memory"); __builtin_amdgcn_s_barrier(); asm volatile("" ::: "memory");
            const int jb = u.pn * 128 + wc * 32 + 4 * fq;
#pragma unroll
            for (int n = 0; n < 2; ++n) {
                const int j = jb + 16 * n;
                const pg8::f32x4 w0 = *(const pg8::f32x4*)(cw + j), w1 = *(const pg8::f32x4*)(cw + DFF + j), w2 = *(const pg8::f32x4*)(cw + 2 * DFF + j), bb = *(const pg8::f32x4*)(cb + j);
#pragma unroll
                for (int ai = 0; ai < 2; ++ai) {
                    const int pblk = (ai * 2 + wr) - 1, nblk = (ai * 2 + wr) + 1;
                    pg8::f32x4 eprev = (pg8::f32x4){0.f, 0.f, 0.f, 0.f}, enext = eprev;
                    if (pblk >= 0) eprev = *(LAS const pg8::f32x4*)(uintptr_t)(ex + (unsigned)((pblk * 2 + 1) * 128 + n * 16) * 4u);
                    if (nblk <= 3) enext = *(LAS const pg8::f32x4*)(uintptr_t)(ex + (unsigned)((nblk * 2 + 0) * 128 + n * 16) * 4u);
#pragma unroll
                    for (int mm = 0; mm < 4; ++mm) {
                        const int trow = ai * 128 + wr * 64 + mm * 16 + fr, grow = u.pm * 254 - 1 + trow;
                        int t, T; seq_pos(grow < 0 ? 0 : grow, t, T);
                        const pg8::f32x4 gc = acc[ai][0][mm][n], uu = acc[ai][1][mm][n];
                        pg8::f32x4 gp, gn;
#pragma unroll
                        for (int i = 0; i < 4; ++i) {
                            const float pold = mm > 0 ? __int_as_float(__builtin_amdgcn_update_dpp(0, __float_as_int(acc[ai][0][mm > 0 ? mm - 1 : 0][n][i]), 0x121, 0xF, 0xF, false)) : eprev[i];
                            gp[i] = __int_as_float(__builtin_amdgcn_update_dpp(__float_as_int(pold), __float_as_int(gc[i]), 0x111, 0xF, 0xF, false));
                            const float nold = mm < 3 ? __int_as_float(__builtin_amdgcn_update_dpp(0, __float_as_int(acc[ai][0][mm < 3 ? mm + 1 : 3][n][i]), 0x12F, 0xF, 0xF, false)) : enext[i];
                            gn[i] = __int_as_float(__builtin_amdgcn_update_dpp(__float_as_int(nold), __float_as_int(gc[i]), 0x101, 0xF, 0xF, false));
                        }
                        if (t == 0) gp = (pg8::f32x4){0.f, 0.f, 0.f, 0.f};
                        if (t == T - 1) gn = (pg8::f32x4){0.f, 0.f, 0.f, 0.f};
                        const pg8::f32x4 z = gp * w0 + gc * w1 + gn * w2 + bb;
                        pg8::f32x4 a;
#pragma unroll
                        for (int i = 0; i < 4; ++i) a[i] = z[i] * __builtin_amdgcn_rcpf(1.0f + __expf(-z[i])) * uu[i];
                        if (trow >= 1 && trow <= 254 && grow < nrows) { v2u o; o.x = pk2h(a[0], a[1]); o.y = pk2h(a[2], a[3]); *(v2u*)(ob + (size_t)grow * DFF + j) = o; }
                    }
                }
            }
        } else if (mode == 2) {
#pragma unroll
            for (int ai = 0; ai < 2; ++ai)
#pragma unroll
                for (int m = 0; m < 4; ++m) { bf16* rp = ob + (size_t)(u.pm * 256 + ai * 128 + wr * 64 + m * 16 + fr) * ld + u.pn * 256 + wc * 32 + 4 * fq;
#pragma unroll
                    for (int bj = 0; bj < 2; ++bj)
#pragma unroll
                        for (int n = 0; n < 2; ++n) { const pg8::f32x4 v = acc[ai][bj][m][n]; v2u o; o.x = pk2h(v[0], v[1]); o.y = pk2h(v[2], v[3]); *(v2u*)(rp + bj * 128 + n * 16) = o; } }
        } else {
            const bool latent = u.pm < (MLAT / 256);
#pragma unroll
            for (int bj = 0; bj < 2; ++bj) {
                const int g32 = u.pn * 8 + bj * 4 + wc;
                if (g32 >= INW / 32) continue;
                const bool isdf = (g32 >= C_DFQ / 32 && g32 < C_DFV / 32), isgq = (g32 >= C_GQQ / 32 && g32 < C_GQV / 32);
                const float qs = (g32 >= C_DFQ / 32 && g32 < C_DFK / 32) ? SC_DF : ((g32 >= C_GQQ / 32 && g32 < C_GQK / 32) ? SC_GQ : 1.0f);
#pragma unroll
                for (int ai = 0; ai < 2; ++ai)
#pragma unroll
                    for (int m = 0; m < 4; ++m) {
                        const int row = u.pm * 256 + ai * 128 + wr * 64 + m * 16 + fr, s = row & (SEQ - 1), prow = s >> 6, pcol = s & 63;
                        pg8::f32x4 v0 = acc[ai][bj][m][0], v1 = acc[ai][bj][m][1];
                        if (isdf) {
                            pg8::f32x4 p0, p1;
#pragma unroll
                            for (int i = 0; i < 4; ++i) { p0[i] = __shfl_xor(v0[i], 32); p1[i] = __shfl_xor(v1[i], 32); }
                            if (latent) {
                                const int f0 = 4 * (fq & 1);
                                const pg8::f32x4 c0 = *(const pg8::f32x4*)(tab + prow * 8 + f0), s0 = *(const pg8::f32x4*)(tab + 512 + prow * 8 + f0);
                                const pg8::f32x4 c1 = *(const pg8::f32x4*)(tab + pcol * 8 + f0), s1 = *(const pg8::f32x4*)(tab + 512 + pcol * 8 + f0);
                                if (fq & 2) { v0 = v0 * c0 + p0 * s0; v1 = v1 * c1 + p1 * s1; } else { v0 = v0 * c0 - p0 * s0; v1 = v1 * c1 - p1 * s1; }
                            }
                        } else if (isgq) {
                            if (latent) {
                                const int pos = (g32 & 1) ? pcol : prow;
                                const pg8::f32x4 cc = *(const pg8::f32x4*)(tab + 1024 + pos * 16 + 4 * fq), ss = *(const pg8::f32x4*)(tab + 2048 + pos * 16 + 4 * fq);
                                const pg8::f32x4 a = v0 * cc - v1 * ss, b = v1 * cc + v0 * ss; v0 = a; v1 = b;
                            }
                        }
                        v0 = v0 * qs; v1 = v1 * qs;
                        bf16* rp = ob + (size_t)row * INP + g32 * 32 + 4 * fq;
                        v2u o; o.x = pk2h(v0[0], v0[1]); o.y = pk2h(v0[2], v0[3]); *(v2u*)rp = o;
                        o.x = pk2h(v1[0], v1[1]); o.y = pk2h(v1[2], v1[3]); *(v2u*)(rp + 16) = o;
                        asm volatile("" ::: "memory");
                    }
            }
        }
    }
};


template <int CTRL, int RM> __device__ __forceinline__ float dpp_mul1(float x) {
    return x * __int_as_float(__builtin_amdgcn_update_dpp(0x3f800000, __float_as_int(x), CTRL, RM, 0xF, false));
}
__device__ __forceinline__ float wave_mulscan(float x) {
    x = dpp_mul1<0x111, 0xF>(x); x = dpp_mul1<0x112, 0xF>(x); x = dpp_mul1<0x114, 0xF>(x); x = dpp_mul1<0x118, 0xF>(x);
    x = dpp_mul1<0x142, 0xA>(x); x = dpp_mul1<0x143, 0xC>(x); return x;
}
__device__ __forceinline__ float wave_shr1_one(float x) { return __int_as_float(__builtin_amdgcn_update_dpp(0x3f800000, __float_as_int(x), 0x138, 0xF, 0xF, false)); }
__device__ __forceinline__ bf16 bf1(float x) { return (bf16)(pk2h(x, 0.f) & 0xffffu); }

constexpr int FT_LD = 65, FT_ARR = 64 * FT_LD * 4;
constexpr int FT_BON = 9 * FT_ARR;
constexpr int FT_PR_LD = 200;
static_assert(66 * FT_PR_LD * 2 <= 2 * FT_ARR && FT_BON + 512 <= LDSCTL_OFF, "features LDS map");
__device__ __forceinline__ void rwkv_features(const Args& A, Frame& F, int l) {
    const int w = F.wave, n = F.lane, c15 = n & 15, g = n >> 4, tr = w >> 1, tc0 = (w & 1) * 2;
    const int h = F.bid & 3, c = h * 64 + n;
    const bf16* P = (const bf16*)(kws() + WS_RP);
    bf16* FV = (bf16*)(kws() + WS_FV); float* BON = (float*)(kws() + WS_BON); float* GLT = (float*)(kws() + WS_GLT);
    float cw[3][3];
#pragma unroll
    for (int tp = 0; tp < 3; ++tp)
#pragma unroll
        for (int j = 0; j < 3; ++j) cw[tp][j] = kin(I_RWCONV)[(size_t)(l * 3 + tp) * 768 + j * 256 + c];
    const float kkc = kin(I_RWKK)[l * 256 + c];
    bf16x8 Bw[2][2], Ba[2][2]; float w0c[2][2], a0c[2][2], kac2[2], rkc2[2];
#pragma unroll
    for (int t = 0; t < 2; ++t) { const int cn = h * 64 + 16 * (tc0 + t) + c15;
        kac2[t] = kin(I_RWKA)[l * 256 + cn]; rkc2[t] = kin(I_RWRK)[l * 256 + cn];
#pragma unroll
        for (int d = 0; d < 2; ++d) { w0c[d][t] = kin(I_RWW0)[(l * 2 + d) * 256 + cn]; a0c[d][t] = kin(I_RWA0)[(l * 2 + d) * 256 + cn];
            unsigned pw[4], pa[4];
#pragma unroll
            for (int j = 0; j < 8; j += 2) { const size_t o = ((size_t)(l * 2 + d) * 32 + 8 * g + j) * 256 + cn;
                pw[j >> 1] = pk2h(kin(I_RWWUP)[o], kin(I_RWWUP)[o + 256]); pa[j >> 1] = pk2h(kin(I_RWAUP)[o], kin(I_RWAUP)[o + 256]); }
            Bw[d][t] = __builtin_bit_cast(bf16x8, (v4u){pw[0], pw[1], pw[2], pw[3]}); Ba[d][t] = __builtin_bit_cast(bf16x8, (v4u){pa[0], pa[1], pa[2], pa[3]}); }
    }
    for (int u = F.bid; u < 4 * (MALL / 64); u += F.G) {
        const int gi = u >> 2, row0 = 64 * gi;
        int t0, T; seq_pos(row0, t0, T);
        __syncthreads();
        for (int p = F.tid; p < 66 * 24; p += NTHR) { const int rr = p / 24, q = p % 24, which = q >> 3, ch = q & 7, row = row0 - 1 + rr;
            const bool ok = (rr >= 1 && rr <= 64) || (rr == 0 ? t0 > 0 : t0 + 64 < T);
            v4u v = (v4u){0u, 0u, 0u, 0u};
            if (ok) v = *(const v4u*)(P + (size_t)row * INP + which * 256 + h * 64 + 8 * ch);
            *(LAS v4u*)(F.lds + (rr * FT_PR_LD + which * 64 + 8 * ch) * 2) = v; }
        v4u xwd[2], xad[2];
        { const bf16* pr = P + (size_t)(row0 + 16 * tr + c15) * INP + 8 * g;
#pragma unroll
          for (int d = 0; d < 2; ++d) { xwd[d] = *(const v4u*)(pr + C_WD + 32 * d); xad[d] = *(const v4u*)(pr + C_AD + 32 * d); } }
        __syncthreads();
#pragma unroll
        for (int rr = 0; rr < 8; ++rr) {
            const int i = 8 * w + rr;
            float xr[3], xk[3], xv[3];
#pragma unroll
            for (int tp = 0; tp < 3; ++tp) { const LAS bf16* pp = (const LAS bf16*)F.lds + (i + tp) * FT_PR_LD + n; xr[tp] = bf2f(pp[0]); xk[tp] = bf2f(pp[64]); xv[tp] = bf2f(pp[128]); }
            const float rq = bf2f(bf1(xr[0] * cw[0][0] + xr[1] * cw[1][0] + xr[2] * cw[2][0])), kq = bf2f(bf1(xk[0] * cw[0][1] + xk[1] * cw[1][1] + xk[2] * cw[2][1]));
            FV[(size_t)(row0 + i) * 256 + c] = bf1(xv[0] * cw[0][2] + xv[1] * cw[1][2] + xv[2] * cw[2][2]);
            const float kkraw = kq * kkc;
            const float kk = kkraw * (1.0f / fmaxf(sqrtf(wave_sum(kkraw * kkraw)), 1e-12f));
            LAS float* L = (LAS float*)F.lds + i * FT_LD + n;
            L[2 * (FT_ARR / 4)] = kk; L[7 * (FT_ARR / 4)] = rq; L[8 * (FT_ARR / 4)] = kq;
        }
        __syncthreads();
        {
            bf16x8 aw[2], aa[2];
#pragma unroll
            for (int d = 0; d < 2; ++d) { unsigned pw[4];
#pragma unroll
                for (int q = 0; q < 4; ++q) { const float x0 = __uint_as_float(xwd[d][q] << 16), x1 = __uint_as_float(xwd[d][q] & 0xffff0000u);
                    pw[q] = pk2h(1.0f - 2.0f * __builtin_amdgcn_rcpf(1.0f + __expf(2.0f * x0)), 1.0f - 2.0f * __builtin_amdgcn_rcpf(1.0f + __expf(2.0f * x1))); }
                aw[d] = __builtin_bit_cast(bf16x8, (v4u){pw[0], pw[1], pw[2], pw[3]}); aa[d] = __builtin_bit_cast(bf16x8, xad[d]); }
            float bsum[4] = {0.f, 0.f, 0.f, 0.f};
#pragma unroll
            for (int t = 0; t < 2; ++t) {
                float kkv[4], kqv[4], rqv[4];
#pragma unroll
                for (int r = 0; r < 4; ++r) { const LAS float* L = (const LAS float*)F.lds + (16 * tr + 4 * g + r) * FT_LD + 16 * (tc0 + t) + c15;
                    kkv[r] = L[2 * (FT_ARR / 4)]; rqv[r] = L[7 * (FT_ARR / 4)]; kqv[r] = L[8 * (FT_ARR / 4)]; }
#pragma unroll
                for (int d = 0; d < 2; ++d) {
                    const f32x4 wl = __builtin_amdgcn_mfma_f32_16x16x32_bf16(aw[d], Bw[d][t], (f32x4){0.f, 0.f, 0.f, 0.f}, 0, 0, 0);
                    const f32x4 al = __builtin_amdgcn_mfma_f32_16x16x32_bf16(aa[d], Ba[d][t], (f32x4){0.f, 0.f, 0.f, 0.f}, 0, 0, 0);
#pragma unroll
                    for (int r = 0; r < 4; ++r) {
                        const float wv = 1.0f + bf2f(bf1(__expf(-0.6065306597126334f * sigmoidf_(wl[r] + w0c[d][t])) - 1.0f)), aq = bf2f(bf1(sigmoidf_(al[r] + a0c[d][t])));
                        const float kd = kqv[r] * (1.0f + (aq - 1.0f) * kac2[t]);
                        LAS float* L = (LAS float*)F.lds + (16 * tr + 4 * g + r) * FT_LD + 16 * (tc0 + t) + c15;
                        L[(0 + d) * (FT_ARR / 4)] = wv; L[(3 + d) * (FT_ARR / 4)] = kkv[r] * aq; L[(5 + d) * (FT_ARR / 4)] = kd;
                        bsum[r] += rqv[r] * kd * rkc2[t];
                    }
                }
            }
#pragma unroll
            for (int r = 0; r < 4; ++r) { float s = bsum[r]; s = dpp_add<0xB1>(s); s = dpp_add<0x4E>(s); s = dpp_add<0x124>(s); s = dpp_add<0x128>(s);
                if (c15 == 0) *(LAS float*)(F.lds + FT_BON + ((w & 1) * 64 + 16 * tr + 4 * g + r) * 4) = s; }
        }
        __syncthreads();
        if (F.tid < 64) BON[(row0 + F.tid) * 4 + h] = *(LAS float*)(F.lds + FT_BON + F.tid * 4) + *(LAS float*)(F.lds + FT_BON + (64 + F.tid) * 4);
#pragma unroll
        for (int d = 0; d < 2; ++d) {
            const int i = d ? 63 - n : n;
            const LAS float* L = (const LAS float*)F.lds + i * FT_LD + 8 * w;
            unsigned al8[4], be8[4], kp8[4], rh8[4]; float g63[8];
#pragma unroll
            for (int e2 = 0; e2 < 4; ++e2) {
                float alv[2], bev[2], kpv[2], rhv[2];
#pragma unroll
                for (int q = 0; q < 2; ++q) { const int e = 2 * e2 + q;
                    const float gi_ = wave_mulscan(L[(0 + d) * (FT_ARR / 4) + e]), gim1 = wave_shr1_one(gi_), ig = __builtin_amdgcn_rcpf(gi_);
                    g63[e] = rdlane(gi_, 63);
                    alv[q] = gim1 * L[2 * (FT_ARR / 4) + e]; bev[q] = L[(3 + d) * (FT_ARR / 4) + e] * ig; kpv[q] = L[(5 + d) * (FT_ARR / 4) + e] * ig; rhv[q] = gi_ * L[7 * (FT_ARR / 4) + e]; }
                al8[e2] = pk2h(alv[0], alv[1]); be8[e2] = pk2h(bev[0], bev[1]); kp8[e2] = pk2h(kpv[0], kpv[1]); rh8[e2] = pk2h(rhv[0], rhv[1]);
            }
            const size_t o = (size_t)d * MALL * 256 + (size_t)(64 * gi + i) * 256 + h * 64 + 8 * w;
            *(v4u*)((bf16*)(kws() + WS_GAL) + o) = (v4u){al8[0], al8[1], al8[2], al8[3]}; *(v4u*)((bf16*)(kws() + WS_GBE) + o) = (v4u){be8[0], be8[1], be8[2], be8[3]};
            *(v4u*)((bf16*)(kws() + WS_GKP) + o) = (v4u){kp8[0], kp8[1], kp8[2], kp8[3]}; *(v4u*)((bf16*)(kws() + WS_GRH) + o) = (v4u){rh8[0], rh8[1], rh8[2], rh8[3]};
            if (n < 8) { float gl = g63[0];
#pragma unroll
                for (int e = 1; e < 8; ++e) gl = (n == e) ? g63[e] : gl;
                GLT[((size_t)d * 272 + gi) * 256 + h * 64 + 8 * w + n] = gl; }
        }
    }
}

__device__ __forceinline__ int scan_row(int d, int b, int i) { if (i < CTXL) { const int t = d ? CTXL - 1 - i : i; return MLAT + b * CTXL + t; } const int j = i - CTXL, t = d ? SEQ - 1 - j : j; return b * SEQ + t; }

__device__ __forceinline__ void rwkv_readout(const Args& A, Frame& F, int l) {
    const int gw = F.bid * NWAVES + F.wave, NGW = F.G * NWAVES, nrows = l == 0 ? MALL : MLAT;
    const int h = gw & 3, n = F.lane, c = h * 64 + n;
    const bf16* P = (const bf16*)(kws() + WS_RP); const bf16* FV = (const bf16*)(kws() + WS_FV);
    const float* BON = (const float*)(kws() + WS_BON); bf16* Y = (bf16*)(kws() + WS_XN);
    float gupr[64];
#pragma unroll
    for (int j = 0; j < 64; ++j) gupr[j] = kin(I_RWGUP)[((size_t)l * 64 + j) * 256 + c];
    const float lng = kin(I_RWLNG)[l * 256 + c], lnb = kin(I_RWLNB)[l * 256 + c];
    bf16 q0 = 0, q1 = 0, qg = 0, qv = 0; float qb = 0.f;
#define RO_LOAD(r_) do { q0 = P[(size_t)(r_) * INP + c]; q1 = P[(size_t)(r_) * INP + 256 + c]; qg = P[(size_t)(r_) * INP + C_GD + n]; qv = FV[(size_t)(r_) * 256 + c]; qb = BON[(r_) * 4 + h]; } while (0)
    if ((gw >> 2) < nrows) RO_LOAD(gw >> 2);
    for (int row = gw >> 2; row < nrows; row += NGW >> 2) {
        const float ov = bf2f(q0) + bf2f(q1), gdv = bf2f(qg), vv = bf2f(qv), bon = qb;
        const int nxt = row + (NGW >> 2);
        if (nxt < nrows) RO_LOAD(nxt);
        const float mu = wave_sum(ov) * (1.0f / 64.0f), dv = ov - mu, var = wave_sum(dv * dv) * (1.0f / 64.0f);
        const float on = dv * rsqrtf(var + 64e-5f) * lng + lnb;
        const float sg = sigmoidf_(gdv);
        float g = 0.f;
#pragma unroll
        for (int j = 0; j < 64; ++j) g = fmaf(rdlane(sg, j), gupr[j], g);
        const float y = (on + bon * vv) * g;
        Y[(size_t)row * D + c] = bf1(y);
    }
#undef RO_LOAD
}


constexpr int CK_LD = 72, CK_MAT = 64 * CK_LD * 2 + 256;
enum { M_AL = 0, M_BE, M_KP, M_RH, M_BET, M_KPT, M_VT, M_AOFF, M_BM, M_MB, M_MK, M_SB, M_SB1, M_YZ, M_UT, M_COUNT };
constexpr int CK_TD = M_COUNT * CK_MAT, CK_TD_LD = 40;
constexpr int CK_ADG = CK_TD + 64 * CK_TD_LD * 2;
constexpr int CK_SEG = CK_ADG + 4096;
constexpr int CK_GL = CK_SEG + 2048;
constexpr int CK_END = CK_GL + 256;
static_assert(CK_END <= LDSCTL_OFF, "chunk scan LDS map");
struct CkAddr { unsigned vA, vB, vN, vT, v1, v1t, lds, vAs, vBs; };
#define CKP(T, addr) ((LAS T*)(uintptr_t)(addr))
template <int KS, bool SKX = false, bool SKY = false> __device__ __forceinline__ void mm2(f32x4 (&acc)[2], const CkAddr& K, int mx, int my) {
#pragma unroll
    for (int ks = 0; ks < KS; ++ks) {
        const bf16x8 a = *CKP(const bf16x8, (SKX ? K.vAs : K.vA) + mx * CK_MAT + 64 * ks);
#pragma unroll
        for (int t = 0; t < 2; ++t) { const bf16x8 bq = *CKP(const bf16x8, (SKY ? K.vBs + t * 32 : K.vB) + my * CK_MAT + t * (16 * CK_LD * 2) + 64 * ks); acc[t] = __builtin_amdgcn_mfma_f32_16x16x32_bf16(a, bq, acc[t], 0, 0, 0); }
    }
}
__device__ __forceinline__ void stN(const CkAddr& K, int mi, int t, const f32x4 v) {
#pragma unroll
    for (int r = 0; r < 4; ++r) *CKP(bf16, K.vN + mi * CK_MAT + r * (CK_LD * 2) + t * 32) = bf1(v[r]);
}
__device__ __forceinline__ void stT(const CkAddr& K, int mi, int t, const f32x4 v) {
    v2u o; o.x = pk2h(v[0], v[1]); o.y = pk2h(v[2], v[3]); *CKP(v2u, K.vT + mi * CK_MAT + t * (16 * CK_LD * 2)) = o;
}
__device__ __forceinline__ void rwkv_chunk_unit(const Args& A, Frame& F, int l, int sc) {
    const bool last = (l == 1);
    const int d = sc >> 4, b = (sc >> 2) & 3, h = sc & 3;
    const int w = F.wave, n = F.lane;
    const bf16* GAL = (const bf16*)(kws() + WS_GAL) + (size_t)d * MALL * 256; const bf16* GBE = (const bf16*)(kws() + WS_GBE) + (size_t)d * MALL * 256;
    const bf16* GKP = (const bf16*)(kws() + WS_GKP) + (size_t)d * MALL * 256; const bf16* GRH = (const bf16*)(kws() + WS_GRH) + (size_t)d * MALL * 256;
    const bf16* FV = (const bf16*)(kws() + WS_FV); const float* GLT = (const float*)(kws() + WS_GLT) + (size_t)d * 272 * 256;
    bf16* O = (bf16*)(kws() + WS_RP) + d * 256;
    v4u ual, ube, ukp, urh, uv; float fgl = 0.f;
    { const int row = scan_row(d, b, 8 * w + (n >> 3)); const size_t o = (size_t)row * 256 + h * 64 + 8 * (n & 7);
      ual = *(const v4u*)(GAL + o); ube = *(const v4u*)(GBE + o); ukp = *(const v4u*)(GKP + o); urh = *(const v4u*)(GRH + o); uv = *(const v4u*)(FV + o);
      if (w == 0) fgl = GLT[(size_t)(scan_row(d, b, 0) >> 6) * 256 + h * 64 + n]; }
    __syncthreads();
    for (int i = F.tid; i < CK_END / 16; i += NTHR) *(LAS v4u*)(F.lds + i * 16) = (v4u){0u, 0u, 0u, 0u};
    f32x4 st[2] = {(f32x4){0.f, 0.f, 0.f, 0.f}, (f32x4){0.f, 0.f, 0.f, 0.f}};
    __syncthreads();
    constexpr int NCK = (CTXL + SEQ) / 64;
    for (int c = 0; c < NCK; ++c) {
        const bool skip_o = last && c < CTXL / 64;
        int c15 = n & 15, g = n >> 4; asm volatile("" : "+v"(c15), "+v"(g));
        const int tr = w >> 1, tc0 = (w & 1) * 2;
        CkAddr K; K.lds = (unsigned)(uintptr_t)F.lds;
        K.vA = K.lds + ((16 * tr + c15) * CK_LD + 8 * g) * 2; K.vB = K.lds + ((16 * tc0 + c15) * CK_LD + 8 * g) * 2;
        K.vN = K.lds + ((16 * tr + 4 * g) * CK_LD + 16 * tc0 + c15) * 2; K.vT = K.lds + ((16 * tc0 + c15) * CK_LD + 16 * tr + 4 * g) * 2;
        K.v1 = K.lds + (8 * (n & 7) * CK_LD + 8 * w + (n >> 3)) * 2 + 16 * (n & 7); K.v1t = K.lds + ((8 * w + (n >> 3)) * CK_LD + 8 * (n & 7)) * 2;
        K.vAs = K.vA + 32 * tr + 16 * (c15 >> 3); K.vBs = K.vB + 32 * tc0 + 16 * (c15 >> 3);
        asm volatile("" : "+v"(K.vA), "+v"(K.vB), "+v"(K.vN), "+v"(K.vT), "+v"(K.v1), "+v"(K.v1t), "+v"(K.vAs), "+v"(K.vBs));
        {
            for (int rp_ = 0; rp_ < 1 + ((MK_RWDUP >> 1) & 1); ++rp_) {
            *CKP(v4u, K.v1t + M_AL * CK_MAT) = ual; *CKP(v4u, K.v1t + M_BE * CK_MAT) = ube; *CKP(v4u, K.v1t + M_KP * CK_MAT) = ukp; *CKP(v4u, K.v1t + M_RH * CK_MAT) = urh;
#pragma unroll
            for (int e = 0; e < 8; ++e) {
                *CKP(bf16, K.v1 + M_BET * CK_MAT + e * (CK_LD * 2)) = (bf16)((e & 1) ? (ube[e >> 1] >> 16) : (ube[e >> 1] & 0xffffu));
                *CKP(bf16, K.v1 + M_KPT * CK_MAT + e * (CK_LD * 2)) = (bf16)((e & 1) ? (ukp[e >> 1] >> 16) : (ukp[e >> 1] & 0xffffu));
                *CKP(bf16, K.v1 + M_VT * CK_MAT + e * (CK_LD * 2)) = (bf16)((e & 1) ? (uv[e >> 1] >> 16) : (uv[e >> 1] & 0xffffu)); }
            if (w == 0) *CKP(float, K.lds + CK_GL + n * 4) = fgl;
            asm volatile("" ::: "memory"); }
            { const int cn = c + 1 < NCK ? c + 1 : c; const int row = scan_row(d, b, 64 * cn + 8 * w + (n >> 3)); const size_t o = (size_t)row * 256 + h * 64 + 8 * (n & 7);
              ual = *(const v4u*)(GAL + o); ube = *(const v4u*)(GBE + o); ukp = *(const v4u*)(GKP + o); urh = *(const v4u*)(GRH + o); uv = *(const v4u*)(FV + o);
              if (w == 0) fgl = GLT[(size_t)(scan_row(d, b, 64 * cn) >> 6) * 256 + h * 64 + n]; }
        }
        __syncthreads();
        for (int rp_ = 0; rp_ < 1 + ((MK_RWDUP >> 2) & 1); ++rp_) {
        if (tc0 <= tr) {
            f32x4 pa[2] = {(f32x4){0.f, 0.f, 0.f, 0.f}, (f32x4){0.f, 0.f, 0.f, 0.f}}, pb[2] = {pa[0], pa[0]}, pm[2] = {pa[0], pa[0]}, pk[2] = {pa[0], pa[0]};
            mm2<2>(pa, K, M_AL, M_BE); mm2<2>(pb, K, M_AL, M_KP); mm2<2>(pm, K, M_RH, M_BE); mm2<2>(pk, K, M_RH, M_KP);
#pragma unroll
            for (int t = 0; t < 2; ++t) { const int tc = tc0 + t; if (tc > tr) continue;
                f32x4 va = pa[t], vb = pb[t], vm = pm[t], vk = pk[t];
                if (tc == tr) {
#pragma unroll
                    for (int r = 0; r < 4; ++r) { const bool strict = c15 < 4 * g + r, incl = c15 <= 4 * g + r;
                        va[r] = strict ? va[r] : 0.f; vb[r] = strict ? vb[r] : 0.f; vm[r] = incl ? vm[r] : 0.f; vk[r] = incl ? vk[r] : 0.f;
                        *CKP(float, K.lds + CK_ADG + ((tr * 16 + 4 * g + r) * 16 + c15) * 4) = va[r]; }
                } else stN(K, M_AOFF, t, va);
                stN(K, M_BM, t, vb); stN(K, M_MB, t, vm); stN(K, M_MK, t, vk);
            }
        }
        __syncthreads();
        }
        f32x4 yb[2], ob[2];
        for (int rp_ = 0; rp_ < 1 + ((MK_RWDUP >> 3) & 1); ++rp_) {
        yb[0] = (f32x4){0.f, 0.f, 0.f, 0.f}; yb[1] = yb[0]; ob[0] = yb[0]; ob[1] = yb[0];
        mm2<2, false, true>(yb, K, M_BM, M_VT);
        if (!skip_o) mm2<2, false, true>(ob, K, M_MK, M_VT);
        if (w == 0) {
            const int bb_ = n >> 4, cc = n & 15; float tcol[16];
            f32x4 arow[16][4];
#pragma unroll
            for (int r = 1; r < 16; ++r)
#pragma unroll
                for (int s4 = 0; s4 * 4 < r; ++s4) arow[r][s4] = *CKP(const f32x4, K.lds + CK_ADG + ((bb_ * 16 + r) * 16 + 4 * s4) * 4);
#pragma unroll
            for (int r = 0; r < 16; ++r) { float acc = (r == cc) ? 1.f : 0.f;
#pragma unroll
                for (int s = 0; s < r; ++s) acc = fmaf(-arow[r][s >> 2][s & 3], tcol[s], acc);
                tcol[r] = acc; *CKP(bf16, K.lds + CK_TD + ((16 * bb_ + r) * CK_TD_LD + cc) * 2) = bf1(acc); }
        }
        if ((MK_RWDUP >> 3) & 1) __syncthreads();
        }
        const int sbr = (c & 1) ? M_SB1 : M_SB, sbw = (c & 1) ? M_SB : M_SB1;
        const f32x4 ybs0 = yb[0], ybs1 = yb[1];
        for (int rp_ = 0; rp_ < 1 + ((MK_RWDUP >> 4) & 1); ++rp_) {
        yb[0] = ybs0; yb[1] = ybs1;
        mm2<2>(yb, K, M_AL, sbr);
        stT(K, M_YZ, 0, yb[0]); stT(K, M_YZ, 1, yb[1]);
        __syncthreads();
        if (w < 4) {
            const unsigned aX = K.lds + ((c15) * CK_LD + 8 * g) * 2;
            const unsigned bY = K.lds + ((16 * w + c15) * CK_LD + 8 * g) * 2;
            const unsigned cT = K.lds + ((16 * w + c15) * CK_LD + 4 * g) * 2;
#pragma unroll
            for (int blk = 0; blk < 4; ++blk) {
                f32x4 z = (f32x4){0.f, 0.f, 0.f, 0.f};
                if (blk > 0) {
#pragma unroll
                    for (int ks = 0; ks < (blk == 3 ? 2 : 1); ++ks) {
                        const bf16x8 a = *CKP(const bf16x8, aX + M_AOFF * CK_MAT + blk * (16 * CK_LD * 2) + 64 * ks);
                        const bf16x8 u = *CKP(const bf16x8, bY + M_UT * CK_MAT + 64 * ks);
                        z = __builtin_amdgcn_mfma_f32_16x16x32_bf16(a, u, z, 0, 0, 0); }
                }
                { const v2u yv = *CKP(const v2u, cT + M_YZ * CK_MAT + 32 * blk);
                  z[0] += __uint_as_float(yv.x << 16); z[1] += __uint_as_float(yv.x & 0xffff0000u); z[2] += __uint_as_float(yv.y << 16); z[3] += __uint_as_float(yv.y & 0xffff0000u); }
                { v2u zo; zo.x = pk2h(z[0], z[1]); zo.y = pk2h(z[2], z[3]); *CKP(v2u, cT + M_YZ * CK_MAT + 32 * blk) = zo; }
                asm volatile("s_waitcnt lgkmcnt(0)" ::: "memory");
                const bf16x8 ta = *CKP(const bf16x8, K.lds + CK_TD + ((16 * blk + c15) * CK_TD_LD + 8 * g) * 2);
                const bf16x8 zb = *CKP(const bf16x8, bY + M_YZ * CK_MAT + 32 * blk);
                f32x4 u = __builtin_amdgcn_mfma_f32_16x16x32_bf16(ta, zb, (f32x4){0.f, 0.f, 0.f, 0.f}, 0, 0, 0);
                { v2u uo; uo.x = pk2h(-u[0], -u[1]); uo.y = pk2h(-u[2], -u[3]); *CKP(v2u, cT + M_UT * CK_MAT + 32 * blk) = uo; }
                asm volatile("s_waitcnt lgkmcnt(0)" ::: "memory");
            }
        }
        __syncthreads();
        }
        const f32x4 obs0 = ob[0], obs1 = ob[1];
        for (int rp_ = 0; rp_ < 1 + ((MK_RWDUP >> 5) & 1); ++rp_) if (!skip_o) {
            ob[0] = obs0; ob[1] = obs1;
            mm2<2>(ob, K, M_RH, sbr); mm2<2>(ob, K, M_MB, M_UT);
#pragma unroll
            for (int r = 0; r < 4; ++r) { const int row = scan_row(d, b, 64 * c + 16 * tr + 4 * g + r);
#pragma unroll
                for (int t = 0; t < 2; ++t) O[(size_t)row * INP + h * 64 + 16 * (tc0 + t) + c15] = bf1(ob[t][r]); }
        }
        const f32x4 sts0 = st[0], sts1 = st[1];
        for (int rp_ = 0; rp_ < 1 + ((MK_RWDUP >> 6) & 1); ++rp_) {
        st[0] = sts0; st[1] = sts1;
        mm2<2, false, true>(st, K, M_UT, M_BET); mm2<2, true, true>(st, K, M_VT, M_KPT);
#pragma unroll
        for (int t = 0; t < 2; ++t) { const float gl = *CKP(float, K.lds + CK_GL + (16 * (tc0 + t) + c15) * 4); st[t] = st[t] * gl; stN(K, sbw, t, st[t]); }
        }
        __syncthreads();
    }
}
#undef CKP

struct KeyStream { int ctx_row0, nloc, loc_row0, loc_pos0; };
constexpr int AT_K = 0, AT_V = 9216, AT_BUF = 18688;
typedef float f32x4a __attribute__((ext_vector_type(4)));

template <int NMAP, int DK, int QS, bool MASK>
__device__ __forceinline__ void attn_core(Frame& F, const bf16* P, int kcol, int vcol, const KeyStream ks, const bf16x8 (&qf)[QS][NMAP][DK / 32], int qpos0,
                                          f32x4 (&o)[QS][NMAP][4], float (&m)[QS][NMAP], float (&lsum)[QS][NMAP]) {
    const int c15 = F.lane & 15, g = F.lane >> 4;
    const int lkey = F.tid >> 3, lch = F.tid & 7;
    const int ntiles = 4 + ks.nloc;
#pragma unroll
    for (int qs = 0; qs < QS; ++qs)
#pragma unroll
        for (int mp = 0; mp < NMAP; ++mp) { m[qs][mp] = 0.f; lsum[qs][mp] = 0.f;
#pragma unroll
            for (int dt = 0; dt < 4; ++dt) o[qs][mp][dt] = (f32x4){0.f, 0.f, 0.f, 0.f}; }
    bool anym[QS][NMAP];
#pragma unroll
    for (int qs = 0; qs < QS; ++qs)
#pragma unroll
        for (int mp = 0; mp < NMAP; ++mp) anym[qs][mp] = false;
    v4u stgk, stgv;
#define AT_LOAD(ti) do { const int rb_ = (ti) < 4 ? ks.ctx_row0 + 64 * (ti) : ks.loc_row0 + 64 * ((ti) - 4); \
        const bf16* p_ = P + (size_t)(rb_ + lkey) * INP + 8 * lch; stgk = *(const v4u*)(p_ + kcol); stgv = *(const v4u*)(p_ + vcol); } while (0)
#define AT_WRITE(bi) do { LAS unsigned char* b_ = F.lds + (bi) * AT_BUF; \
        *(LAS v4u*)(b_ + AT_K + lkey * 144 + lch * 16) = stgk; \
        _Pragma("unroll") for (int i_ = 0; i_ < 8; ++i_) { const unsigned w_ = stgv[i_ >> 1]; *(LAS bf16*)(b_ + AT_V + (8 * lch + i_) * 144 + 16 * lch + lkey * 2) = (bf16)((i_ & 1) ? (w_ >> 16) : (w_ & 0xffffu)); } } while (0)
    __syncthreads();
    AT_LOAD(0); AT_WRITE(0);
    __syncthreads();
    for (int ti = 0; ti < ntiles; ++ti) {
        { const int tn_ = ti + 1 < ntiles ? ti + 1 : ntiles - 1; AT_LOAD(tn_); }
        LAS unsigned char* bb = F.lds + (ti & 1) * AT_BUF;
#pragma unroll
        for (int sx = 0; sx < 2; ++sx) {
        bf16x8 kf[2][NMAP][DK / 32];
#pragma unroll
        for (int kh = 0; kh < 2; ++kh)
#pragma unroll
            for (int mp = 0; mp < NMAP; ++mp)
#pragma unroll
                for (int kx = 0; kx < DK / 32; ++kx) kf[kh][mp][kx] = *(LAS bf16x8*)(bb + AT_K + (32 * sx + 16 * kh + c15) * 144 + (mp * DK + 32 * kx + 8 * g) * 2);
        bf16x8 vf[4];
#pragma unroll
        for (int dt = 0; dt < 4; ++dt) { const v2u a = *(LAS v2u*)(bb + AT_V + (c15 + 16 * dt) * 144 + 16 * (2 * dt + (c15 >> 3)) + (32 * sx + 4 * g) * 2), b2 = *(LAS v2u*)(bb + AT_V + (c15 + 16 * dt) * 144 + 16 * (2 * dt + (c15 >> 3)) + (32 * sx + 16 + 4 * g) * 2);
            const v4u w = (v4u){a.x, a.y, b2.x, b2.y}; vf[dt] = __builtin_bit_cast(bf16x8, w); }
        const int kpos0 = ks.loc_pos0 + 64 * (ti - 4) + 32 * sx + 4 * g;
#pragma unroll
        for (int qs = 0; qs < QS; ++qs)
#pragma unroll
            for (int mp = 0; mp < NMAP; ++mp) {
                f32x4 st[2];
                if (anym[qs][mp]) { const float negm = -m[qs][mp];
#pragma unroll
                    for (int kh = 0; kh < 2; ++kh) { st[kh] = (f32x4){negm, negm, negm, negm};
#pragma unroll
                        for (int kx = 0; kx < DK / 32; ++kx) st[kh] = __builtin_amdgcn_mfma_f32_16x16x32_bf16(kf[kh][mp][kx], qf[qs][mp][kx], st[kh], 0, 0, 0); }
                } else {
#pragma unroll
                    for (int kh = 0; kh < 2; ++kh) { st[kh] = (f32x4){0.f, 0.f, 0.f, 0.f};
#pragma unroll
                        for (int kx = 0; kx < DK / 32; ++kx) st[kh] = __builtin_amdgcn_mfma_f32_16x16x32_bf16(kf[kh][mp][kx], qf[qs][mp][kx], st[kh], 0, 0, 0); }
                }
                if (MASK && ti >= 4) {
                    const int kb = ks.loc_pos0 + 64 * (ti - 4) + 32 * sx, q0 = qpos0 + 16 * qs;
                    if (kb + 31 - q0 > 128 || kb - (q0 + 15) < -128) {
                        const int qp = q0 + c15;
#pragma unroll
                        for (int kh = 0; kh < 2; ++kh)
#pragma unroll
                            for (int r = 0; r < 4; ++r) { const int dd = kpos0 + 16 * kh + r - qp; if (dd > 128 || dd < -128) st[kh][r] = -INFINITY; }
                    }
                }
                float ps = 0.f; float p[8];
#pragma unroll
                for (int kh = 0; kh < 2; ++kh)
#pragma unroll
                    for (int r = 0; r < 4; ++r) { p[kh * 4 + r] = __builtin_amdgcn_exp2f(st[kh][r]); ps += p[kh * 4 + r]; }
                if (__builtin_amdgcn_ballot_w64(!(ps < 1048576.0f)) != 0ull) {
                    float mt = fmaxf(fmaxf(fmaxf(st[0][0], st[0][1]), fmaxf(st[0][2], st[0][3])), fmaxf(fmaxf(st[1][0], st[1][1]), fmaxf(st[1][2], st[1][3])));
                    mt = xmax4(mt);
                    const float delta = fmaxf(mt, 0.f), alpha = __builtin_amdgcn_exp2f(-delta);
                    m[qs][mp] += delta; lsum[qs][mp] *= alpha; anym[qs][mp] = true;
#pragma unroll
                    for (int dt = 0; dt < 4; ++dt) o[qs][mp][dt] = o[qs][mp][dt] * alpha;
                    ps = 0.f;
#pragma unroll
                    for (int kh = 0; kh < 2; ++kh)
#pragma unroll
                        for (int r = 0; r < 4; ++r) { p[kh * 4 + r] = __builtin_amdgcn_exp2f(st[kh][r] - delta); ps += p[kh * 4 + r]; }
                }
                lsum[qs][mp] += ps;
                const v4u pw = (v4u){pk2h(p[0], p[1]), pk2h(p[2], p[3]), pk2h(p[4], p[5]), pk2h(p[6], p[7])};
                const bf16x8 pf = __builtin_bit_cast(bf16x8, pw);
#pragma unroll
                for (int dt = 0; dt < 4; ++dt) o[qs][mp][dt] = __builtin_amdgcn_mfma_f32_16x16x32_bf16(vf[dt], pf, o[qs][mp][dt], 0, 0, 0);
            }
        }
        AT_WRITE((ti + 1) & 1);
        __syncthreads();
    }
#undef AT_LOAD
#undef AT_WRITE
}

template <int QS>
__device__ __forceinline__ void diff_unit(const Args& A, Frame& F, int l, int b, int h, int qrow0, int nloc) {
    const bf16* P = (const bf16*)(kws() + WS_RP); bf16* Y = (bf16*)(kws() + WS_XN); const float* tab = (const float*)(kws() + WS_TAB);
    const int c15 = F.lane & 15, g = F.lane >> 4;
    bf16x8 qf[QS][2][1];
#pragma unroll
    for (int qs = 0; qs < QS; ++qs)
#pragma unroll
        for (int mp = 0; mp < 2; ++mp) qf[qs][mp][0] = *(const bf16x8*)(P + (size_t)(qrow0 + 16 * QS * F.wave + 16 * qs + c15) * INP + C_DFQ + h * 64 + mp * 32 + 8 * g);
    f32x4 o[QS][2][4]; float m[QS][2], ls[QS][2];
    const KeyStream ks{MLAT + b * CTXL, nloc, b * SEQ, 0};
    attn_core<2, 32, QS, false>(F, P, C_DFK + h * 64, C_DFV + h * 64, ks, qf, 0, o, m, ls);
    const float lam = tab[3072 + l], oscale = 1.0f - tab[3074 + l];
    const float* ng = kin(I_DFNG) + l * 64;
#pragma unroll
    for (int qs = 0; qs < QS; ++qs) {
        float inv[2];
#pragma unroll
        for (int mp = 0; mp < 2; ++mp) { float t = ls[qs][mp]; t += __shfl_xor(t, 16); t += __shfl_xor(t, 32); inv[mp] = 1.0f / t; }
        f32x4 ov[4]; float ss = 0.f;
#pragma unroll
        for (int dt = 0; dt < 4; ++dt) { ov[dt] = o[qs][0][dt] * inv[0] - o[qs][1][dt] * (lam * inv[1]); ss += (ov[dt][0] * ov[dt][0] + ov[dt][1] * ov[dt][1]) + (ov[dt][2] * ov[dt][2] + ov[dt][3] * ov[dt][3]); }
        ss += __shfl_xor(ss, 16); ss += __shfl_xor(ss, 32);
        const float r = rsqrtf(ss * (1.0f / 64.0f) + NORM_EPS) * oscale;
        bf16* yp = Y + (size_t)(qrow0 + 16 * QS * F.wave + 16 * qs + c15) * D + 256 + h * 64 + 4 * g;
#pragma unroll
        for (int dt = 0; dt < 4; ++dt) { const f32x4 gg = *(const f32x4*)(ng + 16 * dt + 4 * g); const f32x4 v = ov[dt] * r * gg;
            v2u w; w.x = pk2h(v[0], v[1]); w.y = pk2h(v[2], v[3]); *(v2u*)(yp + 16 * dt) = w; }
    }
}
__device__ __forceinline__ void gq_unit(const Args& A, Frame& F, int l, int b, int kv, int qrow0, int qpos_blk  ) {
    const bf16* P = (const bf16*)(kws() + WS_RP); bf16* Y = (bf16*)(kws() + WS_XN);
    const int c15 = F.lane & 15, g = F.lane >> 4;
    const int hq = kv * 4 + (F.wave >> 1), rbase = qrow0 + 64 * (F.wave & 1);
    bf16x8 qf[4][1][2];
#pragma unroll
    for (int qs = 0; qs < 4; ++qs)
#pragma unroll
        for (int kx = 0; kx < 2; ++kx) qf[qs][0][kx] = *(const bf16x8*)(P + (size_t)(rbase + 16 * qs + c15) * INP + C_GQQ + hq * 64 + 32 * kx + 8 * g);
    KeyStream ks{MLAT + b * CTXL, 0, 0, 0}; int qpos0 = 0;
    if (qpos_blk >= 0) { const int lo = qpos_blk > 0 ? (qpos_blk - 1) * 128 : 0, hi = qpos_blk < 31 ? (qpos_blk + 2) * 128 : SEQ;
        ks.nloc = (hi - lo) / 64; ks.loc_row0 = b * SEQ + lo; ks.loc_pos0 = lo; qpos0 = qpos_blk * 128 + 64 * (F.wave & 1); }
    f32x4 o[4][1][4]; float m[4][1], ls[4][1];
    attn_core<1, 64, 4, true>(F, P, C_GQK + kv * 64, C_GQV + kv * 64, ks, qf, qpos0, o, m, ls);
    const float sink2 = kin(I_GQSINK)[l * 8 + hq] * LOG2E;
#pragma unroll
    for (int qs = 0; qs < 4; ++qs) {
        float t = ls[qs][0]; t += __shfl_xor(t, 16); t += __shfl_xor(t, 32);
        const float mf = fmaxf(m[qs][0], sink2), e = __builtin_amdgcn_exp2f(m[qs][0] - mf), den = t * e + __builtin_amdgcn_exp2f(sink2 - mf), scl = e / den;
        bf16* yp = Y + (size_t)(rbase + 16 * qs + c15) * D + 512 + hq * 64 + 4 * g;
#pragma unroll
        for (int dt = 0; dt < 4; ++dt) { const f32x4 v = o[qs][0][dt] * scl; v2u w; w.x = pk2h(v[0], v[1]); w.y = pk2h(v[2], v[3]); *(v2u*)(yp + 16 * dt) = w; }
    }
}
__device__ __forceinline__ void phase_queue(const Args& A, Frame& F, int l) {
    gu32* head = (gu32*)(kws() + WS_CTL) + CW_QUEUE + 64 * l;
    constexpr int DF_BIG = 208;
    const int total = 32 + DF_BIG + 2 * (256 - DF_BIG) + 256 + (l == 0 ? 48 + WI_FILL : 0);
    volatile LAS int* slot = (volatile LAS int*)(F.lds + MISC_OFF) + 16;
    for (;;) {
        asm volatile("" : "+v"(F.tid), "+v"(F.lane));
        __syncthreads();
        if (F.tid == 0) *slot = (int)__hip_atomic_fetch_add(head, 1u, __ATOMIC_RELAXED, __HIP_MEMORY_SCOPE_AGENT);
        __syncthreads();
        int u = __builtin_amdgcn_readfirstlane(*slot);
        if (u >= total) break;
        if (u < 32) { rwkv_chunk_unit(A, F, l, u); if ((MK_REPEAT >> 16) & 1) rwkv_chunk_unit(A, F, l, u); continue; }
        u -= 32;
        if (u < DF_BIG) { const int b = u >> 6, h = (u >> 4) & 3, qb = u & 15; diff_unit<2>(A, F, l, b, h, b * SEQ + qb * 256, SEQ / 64); continue; }
        if (u < DF_BIG + 2 * (256 - DF_BIG)) { const int v = 2 * DF_BIG + (u - DF_BIG), b = v >> 7, h = (v >> 5) & 3, qh = v & 31; diff_unit<1>(A, F, l, b, h, b * SEQ + qh * 128, SEQ / 64); continue; }
        u -= DF_BIG + 2 * (256 - DF_BIG) - 512;
        u -= 512;
        if (u < 256) { const int b = u >> 6, kv = (u >> 5) & 1, nb = u & 31; gq_unit(A, F, l, b, kv, b * SEQ + nb * 128, nb); continue; }
        u -= 256;
        if (u < 32) { const int b = u >> 3, h = (u >> 1) & 3, hf = u & 1; diff_unit<1>(A, F, l, b, h, MLAT + b * CTXL + hf * 128, 0); continue; }
        u -= 32;
        if (u < 16) { const int b = u >> 2, kv = (u >> 1) & 1, hf = u & 1; gq_unit(A, F, l, b, kv, MLAT + b * CTXL + hf * 128, -1); continue; }
        u -= 16;
        { LAS float* scr = (LAS float*)(F.lds + F.wave * 16384);
          for (int k = 0; k < 16; ++k) { const int it = WI_IN + u * 128 + F.wave * 16 + k; if (it < 2 * WI_LAYER) weight_item(it, scr, F.lane); } }
    }
}

constexpr int N_PHASES = (MK_FUSE == 3) ? 18 : 20;
}

__global__ void __launch_bounds__(mk::NTHR, 2) mega_fwd(mk::Args A) {
    using namespace mk;
    extern __shared__ __attribute__((aligned(16))) unsigned char lds_raw[];
    Frame F;
    F.lds = (LAS unsigned char*)lds_raw;
    F.tid = threadIdx.x; asm volatile("" : "+v"(F.tid)); F.lane = F.tid & 63; F.wave = __builtin_amdgcn_readfirstlane(F.tid >> 6);
    F.G = gridDim.x; F.bid = blockIdx.x;
    for (int u = F.tid; u < (LDS_BYTES - LDSCTL_OFF) / 4; u += NTHR) ((LAS unsigned*)(F.lds + LDSCTL_OFF))[u] = 0u;
    __syncthreads();
    gu32* ctl = (gu32*)(kws() + WS_CTL);
    XcdBarrier bar; bar.bar = (unsigned*)(ctl + CW_BAR); bar.x = 0; bar.st = nullptr; bar.tid = F.tid;
    const bool multi = (A.ph_hi - A.ph_lo) > 1;
    if (multi) bar = xcd_barrier_post((unsigned*)(ctl + CW_BAR), (volatile LAS unsigned*)(F.lds + MISC_OFF) + 8, F.tid);

    for (int ph = A.ph_lo, rep = 0; ph < A.ph_hi;) {
        { int t_ = F.tid, l_ = F.lane, w_ = F.wave, g_ = F.G, b_ = F.bid; unsigned p_ = (unsigned)(uintptr_t)F.lds;
          w_ = __builtin_amdgcn_readfirstlane(w_); g_ = __builtin_amdgcn_readfirstlane(g_); b_ = __builtin_amdgcn_readfirstlane(b_); p_ = __builtin_amdgcn_readfirstlane(p_);
          asm volatile("" : "+v"(t_), "+v"(l_)); asm volatile("" : "+s"(w_), "+s"(g_), "+s"(b_), "+s"(p_));
          F.tid = t_; F.lane = l_; F.wave = w_; F.G = g_; F.bid = b_; F.lds = (LAS unsigned char*)(uintptr_t)p_; }
        int kind = 0, l = 0, hf = 0;
        if (ph == 1) kind = 1;
        else if (ph > 1 && ph < 11) { l = 0; const int r = ph - 2; kind = r < 6 ? 2 + r : (r == 6 ? 8 : (r == 7 ? 10 : 11)); }
        else if (ph >= 11) { l = 1; const int r = ph - 11; kind = r < 5 ? 2 + r : (r == 5 ? 8 : 10); }
        const int nrows = (l == 0) ? MALL : MLAT;
        const int r0 = 0, r1 = nrows; (void)hf;
        const bool is_gemm = (kind == 2 || kind == 6 || kind == 8 || kind == 10);
        if (is_gemm) { if (MK_KINDS & 0x544) {
          const int nparts = ((kind == 6 || kind == 10) && l == 0) ? 2 : 1;
          for (int part = 0; part < nparts; ++part) {
            pg8::Gemm g; EpiMulti E; E.tab = (const float*)(kws() + WS_TAB); E.ob = nullptr; E.of = nullptr; E.ld = 0; E.mode = 0; E.cw = nullptr; E.cb = nullptr; E.nrows = 0; E.ldsx = 0u; E.xin = nullptr; E.xout = nullptr; E.xn = nullptr; E.gA = E.gaA = E.gB = E.scB = E.shB = nullptr; E.xb0 = E.xb1 = nullptr; E.cnt0 = E.cnt1 = nullptr; E.two = 0;
            if (kind == 2) { g = pg8::Gemm{(const pg8::bf16_t*)(kws() + WS_XN), (const pg8::bf16_t*)(kws() + WS_WIN + l * WIN_BYTES), MALL, INP, D, 256, D, 0}; E.mode = 0; E.ob = (bf16*)(kws() + WS_RP); E.ld = INP; }
            else if (kind == 6 && part == 0 && !(MK_FUSE & 1)) { g = pg8::Gemm{(const pg8::bf16_t*)(kws() + WS_XN), (const pg8::bf16_t*)(kws() + WS_WOUT + l * WOUT_BYTES), MLAT, D, D, 256, D, 0}; E.mode = 2; E.ob = (bf16*)(kws() + WS_RP); E.ld = D; }
            else if (kind == 6 && part == 0) { g = pg8::Gemm{(const pg8::bf16_t*)(kws() + WS_XN), (const pg8::bf16_t*)(kws() + WS_WOUT + l * WOUT_BYTES), MLAT, D, D, 256, D, 0};
                E.mode = 5; E.xin = l == 0 ? kin(I_X) : kout(); E.xout = kout(); E.xn = (bf16*)(kws() + WS_XN); E.gA = normg_vec(A, l, 1); E.gaA = mod_vec(A, l, 0, 2); E.two = 1; E.gB = normg_vec(A, l, 2); E.scB = mod_vec(A, l, 0, 4); E.shB = mod_vec(A, l, 0, 3);
                E.xb0 = (float*)(kws() + WS_XB) + (size_t)((l * 2 + 0) * 2 + 0) * MLAT * 4; E.xb1 = (float*)(kws() + WS_XB) + (size_t)((l * 2 + 0) * 2 + 1) * MLAT * 4;
                E.cnt0 = (gu32*)(kws() + WS_CTL) + CW_PST + ((l * 2 + 0) * 2 + 0) * 4096; E.cnt1 = (gu32*)(kws() + WS_CTL) + CW_PST + ((l * 2 + 0) * 2 + 1) * 4096; }
            else if (kind == 6) { g = pg8::Gemm{(const pg8::bf16_t*)(kws() + WS_XN) + (size_t)MLAT * D, (const pg8::bf16_t*)(kws() + WS_WOUT + l * WOUT_BYTES), 256 * 4 * 4, D, 256, 256, D, 4}; E.mode = 2; E.ob = (bf16*)(kws() + WS_SLO); E.ld = D; }
            else if (kind == 8) { const int nmu = (nrows + 253) / 254;
                g = pg8::Gemm{(const pg8::bf16_t*)(kws() + WS_XN) - D, (const pg8::bf16_t*)(kws() + WS_WGU + l * WGU_BYTES), 256 * nmu, NGU, D, 254, D, 0};
                E.mode = 3; E.ob = (bf16*)(kws() + WS_ACT); E.ld = DFF; E.cw = kin(I_FFCW) + (size_t)l * 3 * DFF; E.cb = kin(I_FFCB) + (size_t)l * DFF; E.nrows = nrows; E.ldsx = (unsigned)(uintptr_t)F.lds + 131072u; }
            else if (part == 0 && !(MK_FUSE & 2)) { g = pg8::Gemm{(const pg8::bf16_t*)(kws() + WS_ACT), (const pg8::bf16_t*)(kws() + WS_WD + l * WD_BYTES), MLAT, D, DFF, 256, DFF, 0}; E.mode = 2; E.ob = (bf16*)(kws() + WS_FP); E.ld = D; }
            else if (part == 0) { g = pg8::Gemm{(const pg8::bf16_t*)(kws() + WS_ACT), (const pg8::bf16_t*)(kws() + WS_WD + l * WD_BYTES), MLAT, D, DFF, 256, DFF, 0};
                E.mode = 6; E.xin = kout(); E.xout = kout(); E.xn = (bf16*)(kws() + WS_XN); E.gA = normg_vec(A, l, 3); E.gaA = mod_vec(A, l, 0, 5); E.two = l == 0; E.gB = normg_vec(A, 1, 0); E.scB = mod_vec(A, 1, 0, 1); E.shB = mod_vec(A, 1, 0, 0);
                E.xb0 = (float*)(kws() + WS_XB) + (size_t)((l * 2 + 1) * 2 + 0) * MLAT * 4; E.xb1 = (float*)(kws() + WS_XB) + (size_t)((l * 2 + 1) * 2 + 1) * MLAT * 4;
                E.cnt0 = (gu32*)(kws() + WS_CTL) + CW_PST + ((l * 2 + 1) * 2 + 0) * 4096; E.cnt1 = (gu32*)(kws() + WS_CTL) + CW_PST + ((l * 2 + 1) * 2 + 1) * 4096; }
            else { g = pg8::Gemm{(const pg8::bf16_t*)(kws() + WS_ACT) + (size_t)MLAT * DFF, (const pg8::bf16_t*)(kws() + WS_WD + l * WD_BYTES), 256 * 4 * 11, D, 256, 256, DFF, 4}; E.mode = 2; E.ob = (bf16*)(kws() + WS_SLD); E.ld = D; }
            pg8::StaticOrder S; S.init(g.M, g.N, F.G, F.bid);
            pg8::gemm_phase<EpiMulti, pg8::StaticOrder, true, true>(F.lds, g, S, E, F.tid);
          }
        } } else {
            switch (kind) {
                case 0: if ((MK_KINDS >> 0) & 1) { p0_prologue(A, F); } break;
                case 1: if (((MK_KINDS >> 1) & 1) && l == 0) phase_prep(A, F); break;
                case 3: if ((MK_KINDS >> 3) & 1) rwkv_features(A, F, l); break;
                case 4: if ((MK_KINDS >> 4) & 1) phase_queue(A, F, l); break;
                case 5: if ((MK_KINDS >> 5) & 1) rwkv_readout(A, F, l); break;
                case 7: if ((MK_KINDS >> 7) & 1) phase_e1(A, F, l); break;
                case 9: if ((MK_KINDS >> 9) & 1) phase_act(A, F, l, r0, r1); break;
                case 11: if ((MK_KINDS >> 11) & 1) phase_e2(A, F, l, r0, r1); break;
                default: break;
            }
        }
        const bool again = (rep == 0) && ((MK_REPEAT >> kind) & 1);
        if (ph + 1 < A.ph_hi || again) { bar.bar = (unsigned*)((gu32*)(kws() + WS_CTL) + CW_BAR); bar.tid = F.tid; xcd_barrier(bar); }
        if (again) rep = 1; else { rep = 0; ++ph; }
    }
}

extern "C" void kernel_launch(void* const* d_in, const int* in_sizes, int n_in, void* d_out, int out_size, void* d_ws, size_t ws_size, hipStream_t stream) {
    using namespace mk;
    static int grid = 0;
    if (grid == 0) {
        if (n_in != N_IN || out_size != MLAT * D || ws_size < WS_END) { fprintf(stderr, "kernel_launch: unexpected shapes (n_in %d, out %d, ws %zu); nothing launched\n", n_in, out_size, ws_size); grid = -1; return; }
        int dev = 0, cus = 0, per_cu = 0;
        if (hipGetDevice(&dev) != hipSuccess || hipDeviceGetAttribute(&cus, hipDeviceAttributeMultiprocessorCount, dev) != hipSuccess) { grid = -1; return; }
        if (hipFuncSetAttribute((const void*)mega_fwd, hipFuncAttributeMaxDynamicSharedMemorySize, LDS_BYTES) != hipSuccess) { fprintf(stderr, "kernel_launch: hipFuncSetAttribute failed\n"); grid = -1; return; }
        if (hipOccupancyMaxActiveBlocksPerMultiprocessor(&per_cu, (const void*)mega_fwd, NTHR, LDS_BYTES) != hipSuccess || per_cu < 1) { fprintf(stderr, "kernel_launch: occupancy query says %d blocks/CU\n", per_cu); per_cu = 1; }
        (void)hipGetLastError();
        grid = cus;
    }
    if (grid < 0) return;
    (void)hipMemsetAsync((char*)d_ws + WS_CTL, 0, CTL_ZERO_BYTES, stream);
    Args a{};
    for (int i = 0; i < N_IN; ++i) a.in[i] = (const float*)d_in[i];
    a.out = (float*)d_out; a.ws = (unsigned char*)d_ws;
#if MK_PER_PHASE
    for (int ph = 0; ph < N_PHASES; ++ph) { a.ph_lo = ph; a.ph_hi = ph + 1; hipLaunchKernelGGL(mega_fwd, dim3(grid), dim3(NTHR), LDS_BYTES, stream, a); }
#else
    a.ph_lo = 0; a.ph_hi = N_PHASES;
    void* args[] = {&a};
    hipError_t e = hipLaunchCooperativeKernel((const void*)mega_fwd, dim3(grid), dim3(NTHR), args, LDS_BYTES, stream);
    if (e != hipSuccess) fprintf(stderr, "kernel_launch: cooperative launch failed: %s (grid %d)\n", hipGetErrorString(e), grid);
#endif
}
```

```cpp
#include <hip/hip_runtime.h>
#include <hip/hip_cooperative_groups.h>
#include <cstdio>
#include <cstdint>
#ifndef MK_PER_PHASE
#define MK_PER_PHASE 0
#endif
#ifndef MK_KINDS
#define MK_KINDS 0xFFF
#endif
#ifndef MK_REPEAT
#define MK_REPEAT 0
#endif
#ifndef MK_RWDUP
#define MK_RWDUP 0
#endif
#ifndef MK_FUSE
#define MK_FUSE 3
#endif
#ifdef MK_DBGDRAIN
#define MK_DBGD 1
#else
#define MK_DBGD 0
#endif
namespace pg8 {
#define PG8_LAS __attribute__((address_space(3)))
typedef unsigned short bf16_t;
typedef short bf16x8 __attribute__((ext_vector_type(8)));
typedef float f32x4 __attribute__((ext_vector_type(4)));
typedef unsigned u32x4 __attribute__((ext_vector_type(4)));
constexpr int BM = 256, BK = 64, HALF = 128, HTB = HALF * BK * 2  , STAGE_BYTES = 8 * HTB, NXCD = 8, WGM = 8;

__host__ __device__ __forceinline__ int lds_byte(int r, int c) { const int st = (r >> 4) * 2 + (c >> 5), rr = r & 15, cc = c & 31, ob = rr * 64 + cc * 2; return st * 1024 + (ob ^ (((ob >> 9) & 1) << 5)); }
__host__ __device__ __forceinline__ void stage_rc(int b, int& R, int& C) { const int st = b / 1024, sb = b % 1024, swz = sb ^ (((sb >> 9) & 1) << 5); R = (st >> 1) * 16 + swz / 64; C = (st & 1) * 32 + (swz % 64) / 2; }
__host__ __device__ __forceinline__ int perm32(int rho) { const int n = rho >> 4, i = rho & 15; return 8 * (i >> 2) + 4 * n + (i & 3); }

__device__ __forceinline__ float pg8_zero() { float z = 0.f; asm volatile("" : "+v"(z)); return z; }
struct Unit { int pm, pn; };
struct Gemm { const bf16_t* A; const bf16_t* Bt; int M, N, K; int trows; int ld, mt; };

struct StaticOrder {
    int nM, nN, nwg, G, c;
    __host__ __device__ void init(int M, int N, int G_, int c_) { nM = M / BM; nN = N / BM; nwg = nM * nN; G = G_; c = c_; }
    __host__ __device__ bool next(int i, Unit& u) const {
        const long L = (long)i * G + c; if (L >= nwg) return false;
        int wgid = (int)L; { const int q = nwg / NXCD, r = nwg % NXCD, xcd = wgid % NXCD, off = wgid / NXCD; wgid = (xcd < r ? xcd * (q + 1) : r * (q + 1) + (xcd - r) * q) + off; }
        const int nig = WGM * nN, gid = wgid / nig, fm = gid * WGM, gsz = (nM - fm) < WGM ? (nM - fm) : WGM;
        u.pm = fm + ((wgid % nig) % gsz); u.pn = (wgid % nig) / gsz; return true;
    }
    __device__ __forceinline__ void a_ready(const Unit&) const {}
    __device__ __forceinline__ void done(const Unit&) const {}
};

__device__ __forceinline__ unsigned cvt_pk_bf16(float lo, float hi) { unsigned r; asm volatile("v_cvt_pk_bf16_f32 %0, %1, %2" : "=v"(r) : "v"(lo), "v"(hi)); return r; }
typedef float f32x2 __attribute__((ext_vector_type(2)));
__device__ __forceinline__ f32x2 gelu_pk(f32x2 v) {
    const f32x2 av = __builtin_elementwise_abs(v), d = av * 0.2316418882f + 1.0f;
    f32x2 t; t.x = __builtin_amdgcn_rcpf(d.x); t.y = __builtin_amdgcn_rcpf(d.y);
    f32x2 q = t * 0.5307027145f + (-0.7265760135f); q = q * t + 0.7107068705f; q = q * t + (-0.142248368f); q = q * t + 0.127414796f; q = q * t;
    const f32x2 s = (v * v) * (-0.72134752044f);
    f32x2 e; e.x = __builtin_amdgcn_exp2f(s.x); e.y = __builtin_amdgcn_exp2f(s.y);
    const f32x2 m = v * (q * e), r = v - m;
    f32x2 o; o.x = v.x < 0.f ? m.x : r.x; o.y = v.y < 0.f ? m.y : r.y; return o;
}

template <int ACT  > struct EpiBf16 {
    static constexpr bool PERM = true, AFTER_DRAIN = false; static_assert(ACT == 0 || ACT == 1, "EpiBf16: ACT is 0 (none) or 1 (gelu_pk)");
    bf16_t* O; int ldc; const float* bias; int split_cols; size_t split_stride; float scale0;
    __device__ __forceinline__ void operator()(const f32x4 (&acc)[2][2][4][2], const Unit& u, int wr, int wc, int fr, int fq) const {
        const int row0 = u.pm * BM + wr * 64 + fr; int colt = u.pn * BM; bf16_t* base = O;
        float sc = 1.f; if (split_cols) { const int t = colt / split_cols; base += (size_t)t * split_stride; colt -= t * split_cols; if (t == 0) sc = scale0; }
        const int col0 = colt + wc * 32 + 8 * fq, bcol0 = u.pn * BM + wc * 32 + 8 * fq;
        f32x4 bv[2][2];
#pragma unroll
        for (int bj = 0; bj < 2; ++bj)
#pragma unroll
            for (int n = 0; n < 2; ++n) bv[bj][n] = bias ? *(const f32x4*)(bias + bcol0 + bj * HALF + 4 * n) : (f32x4){0.f, 0.f, 0.f, 0.f};
#pragma unroll
        for (int ai = 0; ai < 2; ++ai)
#pragma unroll
            for (int m = 0; m < 4; ++m) { bf16_t* rowp = base + (size_t)(row0 + ai * HALF + m * 16) * ldc + col0;
#pragma unroll
                for (int bj = 0; bj < 2; ++bj) { f32x4 v0 = acc[ai][bj][m][0] + bv[bj][0], v1 = acc[ai][bj][m][1] + bv[bj][1];
                    if (ACT == 1) { f32x2 a = gelu_pk((f32x2){v0[0], v0[1]}), b = gelu_pk((f32x2){v0[2], v0[3]}), c = gelu_pk((f32x2){v1[0], v1[1]}), d = gelu_pk((f32x2){v1[2], v1[3]});
                        v0 = (f32x4){a.x, a.y, b.x, b.y}; v1 = (f32x4){c.x, c.y, d.x, d.y}; }
                    v0 = v0 * sc; v1 = v1 * sc; u32x4 w; w.x = cvt_pk_bf16(v0[0], v0[1]); w.y = cvt_pk_bf16(v0[2], v0[3]); w.z = cvt_pk_bf16(v1[0], v1[1]); w.w = cvt_pk_bf16(v1[2], v1[3]);
                    *(u32x4*)(rowp + bj * HALF) = w; } }
    }
};

template <class Epi, class Sched, bool ALIGN_EPI = false, bool SP2 = false>
__device__ __forceinline__ void gemm_phase(PG8_LAS unsigned char* lds, const Gemm g, const Sched& S, const Epi& E, int tid_in) {
    int tid_ = tid_in; asm volatile("" : "+v"(tid_));
    const int tid = tid_, wid = __builtin_amdgcn_readfirstlane(tid >> 6), lane = tid & 63, wr = wid >> 2, wc = wid & 3, fr = lane & 15, fq = lane >> 4;
    const int K = g.ld, nt = g.K / BK;
    unsigned voffA[2], voffB[2];
#pragma unroll
    for (int i = 0; i < 2; ++i) { int R, C; stage_rc(tid * 16 + i * 8192, R, C); const int Rb = Epi::PERM ? ((R & ~31) + perm32(R & 31)) : R;
        voffA[i] = (unsigned)(R * K + C) * 2u; voffB[i] = (unsigned)(Rb * K + C) * 2u; }
    const size_t kstep = (size_t)(BK * 2);
    const size_t hstep = (size_t)HALF * K * 2;
    const size_t tstep = 2 * hstep;
    const size_t tstepA = (size_t)g.trows * K * 2;
    const unsigned ldsw = (unsigned)wid * 1024u;
    const int aoff = lds_byte(wr * 64 + fr, fq * 8), boff = lds_byte(wc * 32 + fr, fq * 8);
#define PG8_SA(b, h) (((b) * 2 + (h)) * HTB)
#define PG8_SB(b, h) ((4 + (b) * 2 + (h)) * HTB)
#define PG8_STAGE(bufoff, gbase, voff) do { _Pragma("unroll") for (int _i = 0; _i < 2; ++_i) \
        __builtin_amdgcn_global_load_lds((const unsigned*)((const char*)(gbase) + (voff)[_i]), (PG8_LAS unsigned*)(lds + (bufoff) + ldsw + _i * 8192), 16, 0, 0); } while (0)
#define PG8_LDA(dst, b, h) do { _Pragma("unroll") for (int m = 0; m < 4; ++m) _Pragma("unroll") for (int k = 0; k < 2; ++k) dst[m][k] = *(const PG8_LAS bf16x8*)(lds + PG8_SA(b, h) + aoff + m * 2048 + k * 1024); } while (0)
#define PG8_LDB(dst, b, h) do { _Pragma("unroll") for (int n = 0; n < 2; ++n) _Pragma("unroll") for (int k = 0; k < 2; ++k) dst[n][k] = *(const PG8_LAS bf16x8*)(lds + PG8_SB(b, h) + boff + n * 2048 + k * 1024); } while (0)
#define PG8_MMA(ai, bj, At, Bt) do { __builtin_amdgcn_s_setprio(1); _Pragma("unroll") for (int m = 0; m < 4; ++m) _Pragma("unroll") for (int n = 0; n < 2; ++n) _Pragma("unroll") for (int k = 0; k < 2; ++k) \
        acc[ai][bj][m][n] = __builtin_amdgcn_mfma_f32_16x16x32_bf16(Bt[n][k], At[m][k], acc[ai][bj][m][n], 0, 0, 0); __builtin_amdgcn_s_setprio(0); } while (0)
#define PG8_WAIT_V(n) asm volatile("s_waitcnt vmcnt(" #n ")" ::: "memory")
#define PG8_WAIT_L(n) asm volatile("s_waitcnt lgkmcnt(" #n ")" ::: "memory")
#define PG8_BAR __builtin_amdgcn_s_barrier()
#define PG8_SCHED __builtin_amdgcn_sched_barrier(0)
    Unit cur, nxt; int ui = 0;
    if (!S.next(0, cur)) return;
    f32x4 acc[2][2][4][2];
#pragma unroll
    for (int a = 0; a < 2; ++a)
#pragma unroll
        for (int b = 0; b < 2; ++b)
#pragma unroll
            for (int m = 0; m < 4; ++m)
#pragma unroll
                for (int n = 0; n < 2; ++n) acc[a][b][m][n] = (f32x4){pg8_zero(), pg8_zero(), pg8_zero(), pg8_zero()};
    bf16x8 At[4][2], B0[2][2], B1[2][2];
#define PG8_BASEA(un) ((const char*)g.A + (size_t)(g.mt ? (un).pm % g.mt : (un).pm) * tstepA + (g.mt ? (size_t)((un).pm / g.mt) * g.K * 2 : 0))
#define PG8_BASEB(un) ((const char*)g.Bt + (size_t)(un).pn * tstep + (g.mt ? (size_t)((un).pm / g.mt) * g.K * 2 : 0))
    const char* cA = PG8_BASEA(cur); const char* cB = PG8_BASEB(cur);
    S.a_ready(cur);
    if constexpr (SP2) {
        PG8_STAGE(PG8_SB(0, 0), cB, voffB); PG8_STAGE(PG8_SB(0, 1), cB + hstep, voffB); PG8_STAGE(PG8_SA(0, 0), cA, voffA); PG8_STAGE(PG8_SA(0, 1), cA + hstep, voffA);
        if (wr == 1) PG8_BAR;
        PG8_WAIT_V(2); PG8_BAR;
        PG8_STAGE(PG8_SB(1, 0), cB + kstep, voffB); PG8_STAGE(PG8_SA(1, 0), cA + kstep, voffA); PG8_STAGE(PG8_SB(1, 1), cB + hstep + kstep, voffB);
        PG8_WAIT_V(6); PG8_BAR;
    } else {
        PG8_STAGE(PG8_SB(0, 0), cB, voffB); PG8_STAGE(PG8_SA(0, 0), cA, voffA); PG8_STAGE(PG8_SB(0, 1), cB + hstep, voffB); PG8_STAGE(PG8_SA(0, 1), cA + hstep, voffA);
        if (wr == 1) PG8_BAR;
        PG8_WAIT_V(4); PG8_BAR;
        PG8_STAGE(PG8_SB(1, 0), cB + kstep, voffB); PG8_STAGE(PG8_SA(1, 0), cA + kstep, voffA); PG8_STAGE(PG8_SB(1, 1), cB + hstep + kstep, voffB);
        PG8_WAIT_V(6); PG8_BAR;
    }
    for (;;) {
        const bool has_next = S.next(ui + 1, nxt);
        const char* nA = has_next ? PG8_BASEA(nxt) : cA; const char* nB = has_next ? PG8_BASEB(nxt) : cB;
        for (int t = 0; t < nt; t += 2) {
            const bool last = (t == nt - 2);
            const char* a1 = cA + (size_t)(t + 1) * kstep;
            const char* a2 = last ? nA : cA + (size_t)(t + 2) * kstep; const char* b2 = last ? nB : cB + (size_t)(t + 2) * kstep;
            const char* a3 = a2 + kstep; const char* b3 = b2 + kstep;
            if (last && has_next) S.a_ready(nxt);
            if constexpr (SP2) {
            PG8_LDB(B0, 0, 0); PG8_LDB(B1, 0, 1); PG8_SCHED; PG8_LDA(At, 0, 0); PG8_STAGE(PG8_SA(1, 1), a1 + hstep, voffA);
            PG8_WAIT_V(8); PG8_WAIT_L(0); PG8_BAR; PG8_MMA(0, 0, At, B0); PG8_MMA(0, 1, At, B1); PG8_BAR; PG8_SCHED;
            PG8_LDA(At, 0, 1); PG8_STAGE(PG8_SB(0, 0), b2, voffB); PG8_STAGE(PG8_SB(0, 1), b2 + hstep, voffB); PG8_STAGE(PG8_SA(0, 0), a2, voffA);
            PG8_WAIT_V(8); PG8_WAIT_L(0); PG8_BAR; PG8_MMA(1, 0, At, B0); PG8_MMA(1, 1, At, B1); PG8_BAR; PG8_SCHED;
            PG8_LDB(B0, 1, 0); PG8_LDB(B1, 1, 1); PG8_SCHED; PG8_LDA(At, 1, 0); PG8_STAGE(PG8_SA(0, 1), a2 + hstep, voffA);
            PG8_WAIT_V(8); PG8_WAIT_L(0); PG8_BAR; PG8_MMA(0, 0, At, B0); PG8_MMA(0, 1, At, B1); PG8_BAR; PG8_SCHED;
            PG8_LDA(At, 1, 1); PG8_STAGE(PG8_SB(1, 0), b3, voffB); PG8_STAGE(PG8_SB(1, 1), b3 + hstep, voffB); PG8_STAGE(PG8_SA(1, 0), a3, voffA);
            PG8_WAIT_V(8); PG8_WAIT_L(0); PG8_BAR; PG8_MMA(1, 0, At, B0); PG8_MMA(1, 1, At, B1); PG8_BAR; PG8_SCHED;
            } else {
            PG8_LDB(B0, 0, 0); PG8_SCHED; PG8_LDA(At, 0, 0); PG8_STAGE(PG8_SA(1, 1), a1 + hstep, voffA);
            PG8_WAIT_L(8); PG8_BAR; PG8_WAIT_L(0); PG8_MMA(0, 0, At, B0); PG8_BAR; PG8_SCHED;
            PG8_LDB(B1, 0, 1); PG8_STAGE(PG8_SB(0, 0), b2, voffB);
            PG8_BAR; PG8_WAIT_L(0); PG8_MMA(0, 1, At, B1); PG8_BAR;
            PG8_LDA(At, 0, 1); PG8_STAGE(PG8_SA(0, 0), a2, voffA);
            PG8_BAR; PG8_WAIT_L(0); PG8_MMA(1, 0, At, B0); PG8_BAR; PG8_SCHED;
            PG8_STAGE(PG8_SB(0, 1), b2 + hstep, voffB);
            PG8_WAIT_V(6); PG8_BAR; PG8_MMA(1, 1, At, B1); PG8_BAR;
            PG8_LDB(B0, 1, 0); PG8_SCHED; PG8_LDA(At, 1, 0); PG8_STAGE(PG8_SA(0, 1), a2 + hstep, voffA);
            PG8_WAIT_L(8); PG8_BAR; PG8_WAIT_L(0); PG8_MMA(0, 0, At, B0); PG8_BAR; PG8_SCHED;
            PG8_LDB(B1, 1, 1); PG8_STAGE(PG8_SB(1, 0), b3, voffB);
            PG8_BAR; PG8_WAIT_L(0); PG8_MMA(0, 1, At, B1); PG8_BAR;
            PG8_LDA(At, 1, 1); PG8_STAGE(PG8_SA(1, 0), a3, voffA);
            PG8_BAR; PG8_WAIT_L(0); PG8_MMA(1, 0, At, B0); PG8_BAR; PG8_SCHED;
            PG8_STAGE(PG8_SB(1, 1), b3 + hstep, voffB);
            PG8_WAIT_V(6); PG8_BAR; PG8_MMA(1, 1, At, B1); PG8_BAR;
            }
        }
        if constexpr (ALIGN_EPI) { if (wr == 0) PG8_BAR; }
        if (!E.drain()) { E(acc, cur, wr, wc, fr, fq); S.done(cur); }
        if (!has_next) break;
#pragma unroll
        for (int a = 0; a < 2; ++a)
#pragma unroll
            for (int b = 0; b < 2; ++b)
#pragma unroll
                for (int m = 0; m < 4; ++m)
#pragma unroll
                    for (int n = 0; n < 2; ++n) acc[a][b][m][n] = (f32x4){pg8_zero(), pg8_zero(), pg8_zero(), pg8_zero()};
        cur = nxt; cA = nA; cB = nB; ++ui;
        if constexpr (ALIGN_EPI) { if (wr == 1) PG8_BAR; }
    }
    PG8_WAIT_V(0);
    if constexpr (!ALIGN_EPI) { if (wr == 0) PG8_BAR; }
    PG8_BAR;
    if (E.drain()) { E.fused(acc, cur, wr, wc, fr, fq, lds, wid, lane); S.done(cur); }
#undef PG8_BASEA
#undef PG8_BASEB
#undef PG8_SA
#undef PG8_SB
#undef PG8_STAGE
#undef PG8_LDA
#undef PG8_LDB
#undef PG8_MMA
#undef PG8_WAIT_V
#undef PG8_WAIT_L
#undef PG8_BAR
#undef PG8_SCHED
}
}
#define GAS __attribute__((address_space(1)))
#define LAS __attribute__((address_space(3)))
typedef unsigned short bf16;
typedef unsigned v4u __attribute__((ext_vector_type(4)));
typedef float f32x4 __attribute__((ext_vector_type(4)));
typedef short bf16x8 __attribute__((ext_vector_type(8)));
typedef GAS unsigned gu32;
typedef GAS unsigned long long gu64;
#define RLX_AGENT __ATOMIC_RELAXED, __HIP_MEMORY_SCOPE_AGENT
#define LDS_WAIT() asm volatile("s_waitcnt lgkmcnt(0)" ::: "memory")
#define VM_WAIT() asm volatile("s_waitcnt vmcnt(0)" ::: "memory")
__device__ __forceinline__ unsigned long long rt() { return __builtin_amdgcn_s_memrealtime(); }
__device__ __forceinline__ unsigned f2bf(float f) { unsigned u = __builtin_bit_cast(unsigned, f); return (u + 0x7fffu + ((u >> 16) & 1u)) >> 16; }
__device__ __forceinline__ unsigned pk2(float lo, float hi) { return f2bf(lo) | (f2bf(hi) << 16); }
#define XB_TMO      128
#define XB_XCNT(j)  (256  + 64 * (j))
#define XB_XSUB(j)  (1280 + 64 * (j))
#define XB_XGEN(j)  (2304 + 64 * (j))
#define XB_TOP      3328
#define XB_TOPGEN   3392
#define XCD_BAR_WORDS 3456
#define XB_SPIN_CAP (1u << 18)

__device__ __forceinline__ unsigned xb_ld(unsigned* p)              { return __hip_atomic_load(p, __ATOMIC_RELAXED, __HIP_MEMORY_SCOPE_AGENT); }
__device__ __forceinline__ unsigned xb_add(unsigned* p, unsigned v) { return __hip_atomic_fetch_add(p, v, __ATOMIC_RELAXED, __HIP_MEMORY_SCOPE_AGENT); }
__device__ __forceinline__ unsigned xb_xcc_id() { return (unsigned)__builtin_amdgcn_s_getreg((3 << 11) | 20) & 0xFu; }
#define XB_SPIN(cond, bar) do { unsigned _sp = 0; while (cond) { __builtin_amdgcn_s_sleep(1); \
    if ((++_sp & 255u) == 0u) { if (xb_ld(&(bar)[XB_TMO])) break; if (_sp > XB_SPIN_CAP) { atomicAdd(&(bar)[XB_TMO], 1u); break; } } } } while (0)

struct XcdBarrier {
    int tid; unsigned* bar; unsigned x;
    volatile LAS unsigned* st;
};

__device__ __forceinline__ XcdBarrier xcd_barrier_post(unsigned* bar, volatile LAS unsigned* st, int tid) {
    XcdBarrier b; b.bar = bar; b.x = xb_xcc_id(); b.st = st; b.tid = tid;
    if (tid == 0) (void)xb_add(&bar[XB_XCNT(b.x)], 1u);
    return b;
}
__device__ __forceinline__ void xcd_barrier_complete(unsigned* bar, unsigned x, unsigned& nloc, unsigned& nx) {
    const unsigned G = gridDim.x * gridDim.y * gridDim.z;
    unsigned sum, cnt, mine, sp = 0u;
    for (;;) {
        sum = 0u; cnt = 0u; mine = 0u;
#pragma unroll
        for (unsigned j = 0; j < 16; ++j) { const unsigned c = xb_ld(&bar[XB_XCNT(j)]); sum += c; cnt += (c > 0u) ? 1u : 0u; mine = (j == x) ? c : mine; }
        if (sum == G) break;
        __builtin_amdgcn_s_sleep(1);
        if ((++sp & 255u) == 0u) { if (xb_ld(&bar[XB_TMO])) break; if (sp > XB_SPIN_CAP) { atomicAdd(&bar[XB_TMO], 1u); break; } }
    }
    nloc = mine > 0u ? mine : 1u; nx = cnt > 0u ? cnt : 1u;
}

__device__ __forceinline__ void xcd_barrier(const XcdBarrier& b) {
    asm volatile("s_waitcnt vmcnt(0)" ::: "memory");
    __syncthreads();
    if (b.tid == 0) {
        unsigned* bar = b.bar;
        __builtin_amdgcn_s_waitcnt(0);
        unsigned nloc = b.st[0], nx = b.st[1];
        if (nloc == 0u) { xcd_barrier_complete(bar, b.x, nloc, nx); b.st[0] = nloc; b.st[1] = nx; }
        const unsigned old = xb_add(&bar[XB_XSUB(b.x)], 1u);
        const unsigned gen = old / nloc;
        if (old + 1u == (gen + 1u) * nloc) {
            __builtin_amdgcn_fence(__ATOMIC_RELEASE, "agent");
            asm volatile("s_waitcnt vmcnt(0)" ::: "memory");
            const unsigned og = xb_add(&bar[XB_TOP], 1u);
            const unsigned tg = og / nx;
            if (og + 1u == (tg + 1u) * nx) xb_add(&bar[XB_TOPGEN], 1u);
            else XB_SPIN(xb_ld(&bar[XB_TOPGEN]) == tg, bar);
            __builtin_amdgcn_fence(__ATOMIC_ACQUIRE, "agent");
            xb_add(&bar[XB_XGEN(b.x)], 1u);
            asm volatile("s_waitcnt vmcnt(0)" ::: "memory");
        } else {
            XB_SPIN(xb_ld(&bar[XB_XGEN(b.x)]) == gen, bar);
            __builtin_amdgcn_fence(__ATOMIC_ACQUIRE, "agent");
            asm volatile("s_waitcnt vmcnt(0)" ::: "memory");
        }
    }
    __syncthreads();
}

namespace mk {
constexpr int NWAVES = 8, NTHR = 512;
constexpr int D = 1024, NBATCH = 4, SEQ = 4096, CTXL = 256;
constexpr int MLAT = NBATCH * SEQ, MCTX = NBATCH * CTXL, MALL = MLAT + MCTX;
constexpr int INW = 2496, INP = 2560, DFF = 2816, NGU = 2 * DFF;
constexpr int C_R = 0, C_K = 256, C_V = 512, C_GD = 768, C_WD = 832, C_AD = 896, C_DFQ = 960, C_DFK = 1216, C_DFV = 1472, C_GQQ = 1728, C_GQK = 2240, C_GQV = 2368;
constexpr float NORM_EPS = 1e-6f, LOG2E = 1.4426950408889634f;
constexpr float SC_DF = 0.17677669529663687f * LOG2E;
constexpr float SC_GQ = 0.125f * LOG2E;

enum { I_X = 0, I_C, I_CTX, I_CCTX, I_ADAW, I_ADAB, I_NORMG, I_WIN, I_WOUT, I_RWCONV, I_RWW0, I_RWWUP, I_RWA0, I_RWAUP, I_RWGUP, I_RWKK, I_RWKA, I_RWRK, I_RWLNG, I_RWLNB,
       I_DFLAM, I_DFNG, I_GQSINK, I_FFG, I_FFU, I_FFD, I_FFCW, I_FFCB, N_IN };

constexpr size_t MiB = 1u << 20;
constexpr size_t WS_CTL = 0, CTL_ZERO_BYTES = 1 * MiB;
constexpr int CW_BAR = 4096;
constexpr size_t WS_MOD = 1 * MiB;
constexpr size_t WS_TAB = 1 * MiB + 256 * 1024;
constexpr size_t WS_WIN = 2 * MiB, WIN_BYTES = (size_t)INP * D * 2;
constexpr size_t WS_WOUT = 12 * MiB, WOUT_BYTES = (size_t)D * D * 2;
constexpr size_t WS_WGU = 16 * MiB, WGU_BYTES = (size_t)NGU * D * 2;
constexpr size_t WS_WD = 38 * MiB, WD_BYTES = (size_t)D * DFF * 2;
constexpr size_t WS_XSC = 49 * MiB;
constexpr size_t WS_XN = 53 * MiB;
constexpr size_t WS_RP = 87 * MiB;
constexpr size_t WS_RF = 172 * MiB;
constexpr size_t FEAT1 = (size_t)MALL * 256 * 2;
constexpr size_t WS_GAL = WS_RF, WS_GBE = WS_GAL + 2 * FEAT1, WS_GKP = WS_GBE + 2 * FEAT1, WS_GRH = WS_GKP + 2 * FEAT1, WS_FV = WS_GRH + 2 * FEAT1;
constexpr size_t WS_GLT = WS_FV + FEAT1;
constexpr size_t WS_BON = WS_GLT + (size_t)2 * 272 * 256 * 4;
constexpr size_t WS_RF_END = WS_BON + (size_t)MALL * 4 * 4;
constexpr size_t WS_ACT = WS_RP;
constexpr size_t WS_FP = 181 * MiB;
constexpr size_t WS_SLO = WS_RF;
constexpr size_t WS_SLD = 215 * MiB;
constexpr size_t WS_XB = 240 * MiB;
constexpr size_t WS_END = 256 * MiB;
static_assert(WS_RF_END <= WS_END, "feature region");
static_assert(WS_SLD + (size_t)11 * MCTX * D * 2 <= WS_XB && WS_XB + (size_t)8 * MLAT * 4 * 4 <= WS_END, "exchange slots");
static_assert(WS_FP + (size_t)MALL * D * 2 <= WS_SLD && WS_SLD + (size_t)11 * MCTX * D * 2 <= WS_END, "slabs");
static_assert(WS_ACT + (size_t)MALL * DFF * 2 <= WS_FP && WS_FP + (size_t)MALL * D * 4 <= WS_END, "ffn buffers");
static_assert(WS_XN + (size_t)MALL * D * 2 <= WS_RP && WS_RP + (size_t)MALL * INP * 2 <= WS_RF, "map");

constexpr int LDS_BYTES = 163840;
constexpr int LDSCTL_OFF = LDS_BYTES - 512, MISC_OFF = LDSCTL_OFF + 320;
constexpr int CW_QUEUE = 2048, CW_PST = 32768;

struct Args { const float* in[N_IN]; float* out; unsigned char* ws; int ph_lo, ph_hi; };


typedef const __attribute__((address_space(4))) char* kptr_t;
__device__ __forceinline__ kptr_t karg_base() { kptr_t k = (kptr_t)__builtin_amdgcn_kernarg_segment_ptr(); asm volatile("" : "+s"(k)); return k; }
__device__ __forceinline__ const float* kin(int i) { return *(const float* const __attribute__((address_space(4)))*)(karg_base() + 8 * i); }
__device__ __forceinline__ float* kout() { return *(float* const __attribute__((address_space(4)))*)(karg_base() + 8 * N_IN); }
__device__ __forceinline__ unsigned char* kws() { return *(unsigned char* const __attribute__((address_space(4)))*)(karg_base() + 8 * N_IN + 8); }

struct Frame {
    LAS unsigned char* lds;
    int tid, lane, wave, G, bid;
};

__device__ __forceinline__ float bf2f(bf16 h) { return __uint_as_float(((unsigned)h) << 16); }
template <int CTRL> __device__ __forceinline__ float dpp_mov(float x) { return __int_as_float(__builtin_amdgcn_update_dpp(0, __float_as_int(x), CTRL, 0xF, 0xF, false)); }
template <int CTRL> __device__ __forceinline__ float dpp_add(float x) { return x + dpp_mov<CTRL>(x); }
__device__ __forceinline__ float wave_sum(float v) {
    v = dpp_add<0xB1>(v); v = dpp_add<0x4E>(v); v = dpp_add<0x124>(v); v = dpp_add<0x128>(v);
    auto r = __builtin_amdgcn_permlane16_swap(__float_as_uint(v), __float_as_uint(v), false, false); v = __uint_as_float(r[0]) + __uint_as_float(r[1]);
    r = __builtin_amdgcn_permlane32_swap(__float_as_uint(v), __float_as_uint(v), false, false); return __uint_as_float(r[0]) + __uint_as_float(r[1]);
}
__device__ __forceinline__ float rdlane(float v, int l) { return __int_as_float(__builtin_amdgcn_readlane(__float_as_int(v), l)); }
__device__ __forceinline__ float sigmoidf_(float x) { return __builtin_amdgcn_rcpf(1.0f + __expf(-x)); }
typedef unsigned v2u __attribute__((ext_vector_type(2)));
typedef float f32x2_t __attribute__((ext_vector_type(2))); typedef __bf16 bf16x2_t __attribute__((ext_vector_type(2)));
__device__ __forceinline__ unsigned pk2h(float lo, float hi) { f32x2_t v = {lo, hi}; bf16x2_t b = __builtin_convertvector(v, bf16x2_t); return __builtin_bit_cast(unsigned, b); }
__device__ __forceinline__ float xmax4(float v) {
    auto r = __builtin_amdgcn_permlane16_swap(__float_as_uint(v), __float_as_uint(v), false, false); v = fmaxf(__uint_as_float(r[0]), __uint_as_float(r[1]));
    r = __builtin_amdgcn_permlane32_swap(__float_as_uint(v), __float_as_uint(v), false, false); return fmaxf(__uint_as_float(r[0]), __uint_as_float(r[1]));
}

__device__ __forceinline__ void p0_transpose_item(const float* W, int K, int N, bf16* WT, int row_off, LAS float* scr, int item, int lane) {
    const int nblk = N / 32, kb = item / nblk, nb = item % nblk, k0 = 64 * kb, n0 = 32 * nb;
#pragma unroll 8
    for (int i = 0; i < 32; ++i) { const int kk = 2 * i + (lane >> 5); scr[kk * 33 + (lane & 31)] = W[(size_t)(k0 + kk) * N + n0 + (lane & 31)]; }
    LDS_WAIT(); asm volatile("" ::: "memory");
    const int c = lane & 7;
#pragma unroll
    for (int j = 0; j < 4; ++j) { const int n = (lane >> 3) + 8 * j; const LAS float* s = scr + (8 * c) * 33 + n;
        v4u o; o.x = pk2h(s[0 * 33], s[1 * 33]); o.y = pk2h(s[2 * 33], s[3 * 33]); o.z = pk2h(s[4 * 33], s[5 * 33]); o.w = pk2h(s[6 * 33], s[7 * 33]);
        *(GAS v4u*)(WT + (size_t)(row_off + n0 + n) * K + k0 + 8 * c) = o; }
    LDS_WAIT(); asm volatile("" ::: "memory");
}

constexpr int WI_IN = 16 * (INW / 32), WI_OUT = 16 * 32, WI_G = 16 * (DFF / 32), WI_DN = (DFF / 64) * 32, WI_LAYER = WI_IN + WI_OUT + 2 * WI_G + WI_DN;
__device__ __forceinline__ void weight_item(int it, LAS float* scr, int lane) {
    unsigned char* ws = kws();
    const int l = it / WI_LAYER; int r = it % WI_LAYER;
    if (r < WI_IN) { p0_transpose_item(kin(I_WIN) + (size_t)l * D * INW, D, INW, (bf16*)(ws + WS_WIN + l * WIN_BYTES), 0, scr, r, lane); return; } r -= WI_IN;
    if (r < WI_OUT) { p0_transpose_item(kin(I_WOUT) + (size_t)l * D * D, D, D, (bf16*)(ws + WS_WOUT + l * WOUT_BYTES), 0, scr, r, lane); return; } r -= WI_OUT;
    if (r < WI_G) { const int n0 = 32 * (r % (DFF / 32)); p0_transpose_item(kin(I_FFG) + (size_t)l * D * DFF, D, DFF, (bf16*)(ws + WS_WGU + l * WGU_BYTES), 256 * (n0 >> 7) + (n0 & 127) - n0, scr, r, lane); return; } r -= WI_G;
    if (r < WI_G) { const int n0 = 32 * (r % (DFF / 32)); p0_transpose_item(kin(I_FFU) + (size_t)l * D * DFF, D, DFF, (bf16*)(ws + WS_WGU + l * WGU_BYTES), 256 * (n0 >> 7) + (n0 & 127) - n0 + 128, scr, r, lane); return; } r -= WI_G;
    p0_transpose_item(kin(I_FFD) + (size_t)l * DFF * D, DFF, D, (bf16*)(ws + WS_WD + l * WD_BYTES), 0, scr, r, lane);
}
constexpr int WI_FILL = (2 * WI_LAYER - WI_IN + 127) / 128;

__device__ __forceinline__ void p0_prologue(const Args& A, Frame& F) {
    unsigned char* ws = kws();
    {
        LAS float* sc = (LAS float*)F.lds;
        LAS float* red = (LAS float*)(F.lds + 20480);
        float* mod = (float*)(ws + WS_MOD);
        for (int u = F.bid; u < 192; u += F.G) {
            __syncthreads();
            for (int i = F.tid; i < 5 * 1024; i += NTHR) { const int bb = i >> 10, k = i & 1023; const float v = bb < 4 ? kin(I_C)[bb * 1024 + k] : kin(I_CCTX)[k]; sc[i] = v / (1.0f + __expf(-v)); }
            __syncthreads();
            const int l = u / 96, cc = u % 96, col = cc * 64 + (F.tid & 63), ks = F.tid >> 6;
            const float* w = kin(I_ADAW) + (size_t)l * 1024 * 6144 + col;
            float acc[5] = {0.f, 0.f, 0.f, 0.f, 0.f};
            for (int k0 = ks * 128; k0 < ks * 128 + 128; k0 += 16) { float wv[16];
#pragma unroll
                for (int q = 0; q < 16; ++q) wv[q] = w[(size_t)(k0 + q) * 6144];
#pragma unroll
                for (int q = 0; q < 16; ++q)
#pragma unroll
                    for (int bb = 0; bb < 5; ++bb) acc[bb] += sc[bb * 1024 + k0 + q] * wv[q]; }
#pragma unroll
            for (int bb = 0; bb < 5; ++bb) red[(ks * 5 + bb) * 64 + (F.tid & 63)] = acc[bb];
            __syncthreads();
            if (F.tid < 320) { const int bb = F.tid >> 6, c = F.tid & 63; float s = kin(I_ADAB)[l * 6144 + cc * 64 + c];
#pragma unroll
                for (int k8 = 0; k8 < 8; ++k8) s += red[(k8 * 5 + bb) * 64 + c];
                mod[(size_t)(l * 5 + bb) * 6144 + cc * 64 + c] = s; }
        }
        __syncthreads();
    }
    {
        LAS float* scr = (LAS float*)(F.lds + F.wave * 16384);
        const int gw = F.bid * NWAVES + F.wave, NGW = F.G * NWAVES;
        for (int it = gw; it < WI_IN; it += NGW) weight_item(it, scr, F.lane);
        const int gt = F.bid * NTHR + F.tid, NGT = F.G * NTHR;
        for (int i = gt; i < 2 * 8192; i += NGT) { const int l = i >> 13, j = i & 8191;
            *(GAS v4u*)(ws + WS_WIN + l * WIN_BYTES + (size_t)INW * D * 2 + (size_t)j * 16) = (v4u){0u, 0u, 0u, 0u}; }
    }
    if (F.bid == 0) {
        float* tab = (float*)(ws + WS_TAB);
        for (int i = F.tid; i < 512; i += NTHR) { const int pos = i >> 3, f = i & 7; const float inv = __builtin_amdgcn_exp2f(-(float)f * (13.287712379549449f / 8.0f)), ang = (float)pos * inv; tab[i] = __cosf(ang); tab[512 + i] = __sinf(ang); }
        for (int i = F.tid; i < 1024; i += NTHR) { const int pos = i >> 4, f = i & 15; const float inv = __builtin_amdgcn_exp2f(-(float)f * (13.287712379549449f / 16.0f)), ang = (float)pos * inv; tab[1024 + i] = __cosf(ang); tab[2048 + i] = __sinf(ang); }
        if (F.tid < 2) { const int l = F.tid; const float* lv = kin(I_DFLAM) + l * 128; float s1 = 0.f, s2 = 0.f;
            for (int i = 0; i < 32; ++i) { s1 += lv[i] * lv[32 + i]; s2 += lv[64 + i] * lv[96 + i]; }
            const float lam_init = 0.8f - 0.6f * __expf(-0.3f * (float)l);
            tab[3072 + l] = __expf(s1) - __expf(s2) + lam_init; tab[3074 + l] = lam_init; }
    }
}

__device__ __forceinline__ const float* mod_vec(const Args& A, int l, int bb, int i) { return (const float*)(kws() + WS_MOD) + ((size_t)(l * 5 + bb) * 6 + i) * 1024; }
__device__ __forceinline__ const float* normg_vec(const Args& A, int l, int i) { return kin(I_NORMG) + (size_t)(l * 4 + i) * 1024; }
__device__ __forceinline__ int row_bb(int row) { return row < MLAT ? (row >> 12) : 4; }
__device__ __forceinline__ void seq_pos(int row, int& t, int& T) { if (row < MLAT) { t = row & (SEQ - 1); T = SEQ; } else { t = (row - MLAT) & (CTXL - 1); T = CTXL; } }
__device__ __forceinline__ void ld16(const float* p, int lane, f32x4 (&v)[4]) {
#pragma unroll
    for (int j = 0; j < 4; ++j) v[j] = *(const f32x4*)(p + 4 * lane + 256 * j);
}
__device__ __forceinline__ void ld16b(const bf16* p, int lane, f32x4 (&v)[4]) {
#pragma unroll
    for (int j = 0; j < 4; ++j) { const v2u u = *(const v2u*)(p + 4 * lane + 256 * j);
        v[j] = (f32x4){__uint_as_float(u.x << 16), __uint_as_float(u.x & 0xffff0000u), __uint_as_float(u.y << 16), __uint_as_float(u.y & 0xffff0000u)}; }
}
__device__ __forceinline__ void st16(float* p, int lane, const f32x4 (&v)[4]) {
#pragma unroll
    for (int j = 0; j < 4; ++j) *(f32x4*)(p + 4 * lane + 256 * j) = v[j];
}
__device__ __forceinline__ float sumsq16(const f32x4 (&v)[4]) {
    float s = 0.f;
#pragma unroll
    for (int j = 0; j < 4; ++j) s += (v[j].x * v[j].x + v[j].y * v[j].y) + (v[j].z * v[j].z + v[j].w * v[j].w);
    return wave_sum(s);
}
__device__ __forceinline__ void norm_mod_store(const f32x4 (&v)[4], float rstd, const float* g, const float* sc, const float* sh, bf16* orow, int lane) {
#pragma unroll
    for (int j = 0; j < 4; ++j) {
        const int c = 4 * lane + 256 * j;
        const f32x4 gg = *(const f32x4*)(g + c), s1 = *(const f32x4*)(sc + c), s0 = *(const f32x4*)(sh + c);
        const f32x4 h = v[j] * rstd * gg * (s1 + 1.0f) + s0;
        v2u o; o.x = pk2h(h.x, h.y); o.y = pk2h(h.z, h.w);
        *(v2u*)(orow + c) = o;
    }
}
__device__ __forceinline__ float* xs_row(const Args& A, int row) { return row < MLAT ? kout() + (size_t)row * D : (float*)(kws() + WS_XSC) + (size_t)(row - MLAT) * D; }
__device__ __forceinline__ const float* xin_row(const Args& A, int row) { return row < MLAT ? kin(I_X) + (size_t)row * D : kin(I_CTX) + (size_t)(row - MLAT) * D; }

__device__ __forceinline__ void phase_prep(const Args& A, Frame& F) {
    const int gw = F.bid * NWAVES + F.wave, NGW = F.G * NWAVES;
    bf16* XN = (bf16*)(kws() + WS_XN);
    f32x4 v[4], vn[4];
    if (gw < MALL) ld16(xin_row(A, gw), F.lane, v);
    for (int row = gw; row < MALL; row += NGW) {
        if (row + NGW < MALL) ld16(xin_row(A, row + NGW), F.lane, vn);
        const float rstd = rsqrtf(sumsq16(v) * (1.0f / D) + NORM_EPS);
        const int bb = row_bb(row);
        norm_mod_store(v, rstd, normg_vec(A, 0, 0), mod_vec(A, 0, bb, 1), mod_vec(A, 0, bb, 0), XN + (size_t)row * D, F.lane);
#pragma unroll
        for (int j = 0; j < 4; ++j) v[j] = vn[j];
    }
}
__device__ __forceinline__ void phase_e1(const Args& A, Frame& F, int l) {
    const int gw = F.bid * NWAVES + F.wave, NGW = F.G * NWAVES, nrows = l == 0 ? MALL : MLAT;
    bf16* XN = (bf16*)(kws() + WS_XN); const bf16* YP = (const bf16*)(kws() + WS_RP);
    for (int row = ((MK_FUSE & 1) && !MK_DBGD ? MLAT : 0) + gw; row < nrows; row += NGW) {
        const int bb = row_bb(row);
        f32x4 y[4], x[4];
        if (l == 0 && row >= MLAT) { const bf16* sl = (const bf16*)(kws() + WS_SLO) + (size_t)(row - MLAT) * D; ld16b(sl, F.lane, y);
            for (int s = 1; s < 4; ++s) { f32x4 t[4]; ld16b(sl + (size_t)s * MCTX * D, F.lane, t);
#pragma unroll
                for (int j = 0; j < 4; ++j) y[j] = y[j] + t[j]; } }
        else ld16b(YP + (size_t)row * D, F.lane, y);
        if (l == 0) ld16(xin_row(A, row), F.lane, x); else ld16(xs_row(A, row), F.lane, x);
        const float ry = rsqrtf(sumsq16(y) * (1.0f / D) + NORM_EPS);
        const float* g1 = normg_vec(A, l, 1); const float* ga = mod_vec(A, l, bb, 2);
#pragma unroll
        for (int j = 0; j < 4; ++j) { const int c = 4 * F.lane + 256 * j; x[j] = x[j] + *(const f32x4*)(ga + c) * (y[j] * ry * *(const f32x4*)(g1 + c)); }
        st16(xs_row(A, row), F.lane, x);
        const float rx = rsqrtf(sumsq16(x) * (1.0f / D) + NORM_EPS);
        norm_mod_store(x, rx, normg_vec(A, l, 2), mod_vec(A, l, bb, 4), mod_vec(A, l, bb, 3), XN + (size_t)row * D, F.lane);
    }
}
__device__ __forceinline__ void phase_e2(const Args& A, Frame& F, int l, int r0, int r1) {
    const int gw = F.bid * NWAVES + F.wave, NGW = F.G * NWAVES;
    bf16* XN = (bf16*)(kws() + WS_XN); const bf16* FP = (const bf16*)(kws() + WS_FP);
    for (int row = ((MK_FUSE & 2) && !MK_DBGD ? (r0 < MLAT ? MLAT : r0) : r0) + gw; row < r1; row += NGW) {
        const int bb = row_bb(row);
        f32x4 y[4], x[4];
        if (l == 0 && row >= MLAT) { const bf16* sl = (const bf16*)(kws() + WS_SLD) + (size_t)(row - MLAT) * D; ld16b(sl, F.lane, y);
            for (int s = 1; s < 11; ++s) { f32x4 t[4]; ld16b(sl + (size_t)s * MCTX * D, F.lane, t);
#pragma unroll
                for (int j = 0; j < 4; ++j) y[j] = y[j] + t[j]; } }
        else ld16b(FP + (size_t)(row - r0) * D, F.lane, y);
        ld16(xs_row(A, row), F.lane, x);
        const float ry = rsqrtf(sumsq16(y) * (1.0f / D) + NORM_EPS);
        const float* g3 = normg_vec(A, l, 3); const float* ga = mod_vec(A, l, bb, 5);
#pragma unroll
        for (int j = 0; j < 4; ++j) { const int c = 4 * F.lane + 256 * j; x[j] = x[j] + *(const f32x4*)(ga + c) * (y[j] * ry * *(const f32x4*)(g3 + c)); }
        st16(xs_row(A, row), F.lane, x);
        if (l == 0) {
            const float rx = rsqrtf(sumsq16(x) * (1.0f / D) + NORM_EPS);
            norm_mod_store(x, rx, normg_vec(A, 1, 0), mod_vec(A, 1, bb, 1), mod_vec(A, 1, bb, 0), XN + (size_t)row * D, F.lane);
        }
    }
}
__device__ __forceinline__ void phase_act(const Args& A, Frame& F, int l, int r0, int r1) {
    const bf16* GU = (const bf16*)(kws() + WS_RP); bf16* ACT = (bf16*)(kws() + WS_ACT);
    const float* cw = kin(I_FFCW) + (size_t)l * 3 * DFF; const float* cb = kin(I_FFCB) + (size_t)l * DFF;
    const int nch = DFF / 8, total = (r1 - r0) * nch;
    for (int i = F.bid * NTHR + F.tid; i < total; i += F.G * NTHR) {
        const int rr = i / nch, ch = i % nch, row = r0 + rr, j0 = ch * 8;
        const int t = row < MLAT ? (row & (SEQ - 1)) : ((row - MLAT) & (CTXL - 1)), T = row < MLAT ? SEQ : CTXL;
        const bf16* gp = GU + (size_t)rr * NGU + j0;
        const v4u gc = *(const v4u*)gp, uu = *(const v4u*)(gp + DFF);
        v4u gm = (v4u){0u, 0u, 0u, 0u}, gn = (v4u){0u, 0u, 0u, 0u};
        if (t > 0) gm = *(const v4u*)(gp - NGU);
        if (t < T - 1) gn = *(const v4u*)(gp + NGU);
        unsigned o[4];
#pragma unroll
        for (int q = 0; q < 4; ++q) {
            float r2[2];
#pragma unroll
            for (int e = 0; e < 2; ++e) {
                const int j = j0 + 2 * q + e;
                const float a = __uint_as_float(e ? (gm[q] & 0xffff0000u) : (gm[q] << 16)), b = __uint_as_float(e ? (gc[q] & 0xffff0000u) : (gc[q] << 16)), c = __uint_as_float(e ? (gn[q] & 0xffff0000u) : (gn[q] << 16));
                const float u = __uint_as_float(e ? (uu[q] & 0xffff0000u) : (uu[q] << 16));
                const float z = a * cw[j] + b * cw[DFF + j] + c * cw[2 * DFF + j] + cb[j];
                r2[e] = z / (1.0f + __expf(-z)) * u;
            }
            o[q] = pk2h(r2[0], r2[1]);
        }
        *(v4u*)(ACT + (size_t)rr * DFF + j0) = (v4u){o[0], o[1], o[2], o[3]};
    }
}

struct EpiMulti {
    static constexpr bool PERM = false, AFTER_DRAIN = false;
    int mode;
    bf16* ob; float* of; int ld; const float* tab;
    const float* cw; const float* cb; int nrows; unsigned ldsx;
    const float* xin; float* xout; bf16* xn; const float *gA, *gaA, *gB, *scB, *shB; float* xb0; float* xb1; gu32* cnt0; gu32* cnt1; int two;
    __device__ __forceinline__ bool drain() const { return mode >= 5; }
    __device__ __forceinline__ void row_stats(const pg8::f32x4 (&v)[2][2][4][2], const pg8::Unit& u, int wr, int wc, int fr, int fq, LAS unsigned char* lds, int wid, int lane, float* xb, gu32* cnt) const {
        LAS float* Pp = (LAS float*)lds; LAS float* Ss = (LAS float*)(lds + 8192); LAS unsigned* flag = (LAS unsigned*)(lds + 8192 + 1024);
#pragma unroll
        for (int ai = 0; ai < 2; ++ai)
#pragma unroll
            for (int mm = 0; mm < 4; ++mm) { float s = 0.f;
#pragma unroll
                for (int bj = 0; bj < 2; ++bj)
#pragma unroll
                    for (int n = 0; n < 2; ++n) { const pg8::f32x4 x = v[ai][bj][mm][n]; s += (x[0] * x[0] + x[1] * x[1]) + (x[2] * x[2] + x[3] * x[3]); }
                s += __shfl_xor(s, 16); s += __shfl_xor(s, 32);
                if (fq == 0) Pp[(ai * 128 + wr * 64 + mm * 16 + fr) * 4 + wc] = s; }
        asm volatile("s_waitcnt lgkmcnt(0)" ::: "memory"); __builtin_amdgcn_s_barrier(); asm volatile("" ::: "memory");
        const int row = wid * 32 + (lane & 31);
        if (lane < 32) { const float s = (Pp[row * 4 + 0] + Pp[row * 4 + 1]) + (Pp[row * 4 + 2] + Pp[row * 4 + 3]);
            __hip_atomic_store((gu32*)(xb + ((size_t)u.pn * MLAT + u.pm * 256 + row)), __float_as_uint(s), __ATOMIC_RELAXED, __HIP_MEMORY_SCOPE_AGENT); }
        asm volatile("s_waitcnt vmcnt(0)" ::: "memory");
        if (lane == 0) __hip_atomic_fetch_add(cnt + 64 * u.pm, 1u, __ATOMIC_RELAXED, __HIP_MEMORY_SCOPE_AGENT);
        if (wid == 0) {
            unsigned sp = 0;
            while ((unsigned)__builtin_amdgcn_readfirstlane(__hip_atomic_load(cnt + 64 * u.pm, __ATOMIC_RELAXED, __HIP_MEMORY_SCOPE_AGENT)) < 32u) { __builtin_amdgcn_s_sleep(2); if (++sp > (1u << 22)) break; }
            __builtin_amdgcn_fence(__ATOMIC_ACQUIRE, "agent");
            if (lane == 0) flag[0] = 1u;
        }
        asm volatile("s_waitcnt vmcnt(0) lgkmcnt(0)" ::: "memory"); __builtin_amdgcn_s_barrier(); asm volatile("" ::: "memory");
        if (lane < 32) { float t = 0.f;
#pragma unroll
            for (int q = 0; q < 4; ++q) t += __uint_as_float(__hip_atomic_load((gu32*)(xb + ((size_t)q * MLAT + u.pm * 256 + row)), __ATOMIC_RELAXED, __HIP_MEMORY_SCOPE_AGENT));
            Ss[row] = rsqrtf(t * (1.0f / D) + NORM_EPS); }
        asm volatile("s_waitcnt vmcnt(0) lgkmcnt(0)" ::: "memory"); __builtin_amdgcn_s_barrier(); asm volatile("" ::: "memory");
    }
    __device__ __forceinline__ void fused(pg8::f32x4 (&acc)[2][2][4][2], const pg8::Unit& u, int wr, int wc, int fr_, int fq_, PG8_LAS unsigned char* lds, int wid, int lane) const {
        int fr = fr_, fq = fq_; asm volatile("" : "+v"(fr), "+v"(fq));
#if defined(MK_DBGDRAIN)
        { bf16* obd = mode == 5 ? (bf16*)(kws() + WS_RP) : (bf16*)(kws() + WS_FP);
#pragma unroll
          for (int ai = 0; ai < 2; ++ai)
#pragma unroll
            for (int mm = 0; mm < 4; ++mm) { bf16* rp = obd + (size_t)(u.pm * 256 + ai * 128 + wr * 64 + mm * 16 + fr) * D + u.pn * 256 + wc * 32 + 4 * fq;
#pragma unroll
                for (int bj = 0; bj < 2; ++bj)
#pragma unroll
                    for (int n = 0; n < 2; ++n) { const pg8::f32x4 v = acc[ai][bj][mm][n]; v2u o; o.x = pk2h(v[0], v[1]); o.y = pk2h(v[2], v[3]); *(v2u*)(rp + bj * 128 + n * 16) = o; } }
          return; }
#endif
        const LAS float* Ss = (const LAS float*)((LAS unsigned char*)lds + 8192);
        const int col0 = u.pn * 256 + wc * 32 + 4 * fq, bofs = (u.pm >> 4) * 6144;
        row_stats(acc, u, wr, wc, fr, fq, (LAS unsigned char*)lds, wid, lane, xb0, cnt0);
        pg8::f32x4 cA_[2][2];
#pragma unroll
        for (int bj = 0; bj < 2; ++bj)
#pragma unroll
            for (int n = 0; n < 2; ++n) cA_[bj][n] = *(const pg8::f32x4*)(gA + col0 + 128 * bj + 16 * n) * *(const pg8::f32x4*)(gaA + bofs + col0 + 128 * bj + 16 * n);
#pragma unroll
        for (int ai = 0; ai < 2; ++ai)
#pragma unroll
            for (int mm = 0; mm < 4; ++mm) { const int r = ai * 128 + wr * 64 + mm * 16 + fr; const float rs = Ss[r]; const size_t off = (size_t)(u.pm * 256 + r) * D + col0;
#pragma unroll
                for (int bj = 0; bj < 2; ++bj)
#pragma unroll
                    for (int n = 0; n < 2; ++n) { const pg8::f32x4 xi = *(const pg8::f32x4*)(xin + off + 128 * bj + 16 * n); acc[ai][bj][mm][n] = xi + cA_[bj][n] * (acc[ai][bj][mm][n] * rs); }
                asm volatile("" : "+v"(acc[ai][0][mm][0]), "+v"(acc[ai][0][mm][1]), "+v"(acc[ai][1][mm][0]), "+v"(acc[ai][1][mm][1]));
                if (mm & 1) asm volatile("" ::: "memory"); }
        if (two) {
            asm volatile("s_waitcnt lgkmcnt(0)" ::: "memory"); __builtin_amdgcn_s_barrier(); asm volatile("" ::: "memory");
            row_stats(acc, u, wr, wc, fr, fq, (LAS unsigned char*)lds, wid, lane, xb1, cnt1);
        }
        pg8::f32x4 cB_[2][2], cS_[2][2];
        if (two) {
#pragma unroll
            for (int bj = 0; bj < 2; ++bj)
#pragma unroll
                for (int n = 0; n < 2; ++n) { cB_[bj][n] = *(const pg8::f32x4*)(gB + col0 + 128 * bj + 16 * n) * (*(const pg8::f32x4*)(scB + bofs + col0 + 128 * bj + 16 * n) + 1.0f); cS_[bj][n] = *(const pg8::f32x4*)(shB + bofs + col0 + 128 * bj + 16 * n); }
        }
#pragma unroll
        for (int ai = 0; ai < 2; ++ai)
#pragma unroll
            for (int mm = 0; mm < 4; ++mm) { const int r = ai * 128 + wr * 64 + mm * 16 + fr; const size_t off = (size_t)(u.pm * 256 + r) * D + col0; const float rs = two ? Ss[r] : 0.f;
#pragma unroll
                for (int bj = 0; bj < 2; ++bj)
#pragma unroll
                    for (int n = 0; n < 2; ++n) { const pg8::f32x4 x1 = acc[ai][bj][mm][n]; *(pg8::f32x4*)(xout + off + 128 * bj + 16 * n) = x1;
                        if (two) { const pg8::f32x4 hh = x1 * rs * cB_[bj][n] + cS_[bj][n]; v2u o; o.x = pk2h(hh[0], hh[1]); o.y = pk2h(hh[2], hh[3]); *(v2u*)(xn + off + 128 * bj + 16 * n) = o; } }
                asm volatile("" ::: "memory"); }
        asm volatile("s_waitcnt lgkmcnt(0)" ::: "memory"); __builtin_amdgcn_s_barrier(); asm volatile("" ::: "memory");
    }
    __device__ __forceinline__ void operator()(const pg8::f32x4 (&acc)[2][2][4][2], const pg8::Unit& u, int wr, int wc, int fr_, int fq_) const {
        int fr = fr_, fq = fq_; asm volatile("" : "+v"(fr), "+v"(fq));
        if (mode == 1) {
#pragma unroll
            for (int ai = 0; ai < 2; ++ai)
#pragma unroll
                for (int m = 0; m < 4; ++m) { float* rp = of + (size_t)(u.pm * 256 + ai * 128 + wr * 64 + m * 16 + fr) * ld + u.pn * 256 + wc * 32 + 4 * fq;
#pragma unroll
                    for (int bj = 0; bj < 2; ++bj)
#pragma unroll
                        for (int n = 0; n < 2; ++n) *(pg8::f32x4*)(rp + bj * 128 + n * 16) = acc[ai][bj][m][n]; }
        } else if (mode == 3) {
            const unsigned par = (unsigned)(u.pm + u.pn) & 1u;
            const unsigned ex = ldsx + par * 4096u + (unsigned)(wc * 32 + 4 * fq) * 4u;
#pragma unroll
            for (int ai = 0; ai < 2; ++ai)
#pragma unroll
                for (int n = 0; n < 2; ++n) {
                    if (fr == 0) *(LAS pg8::f32x4*)(uintptr_t)(ex + (unsigned)(((ai * 2 + wr) * 2 + 0) * 128 + n * 16) * 4u) = acc[ai][0][0][n];
                    if (fr == 15) *(LAS pg8::f32x4*)(uintptr_t)(ex + (unsigned)(((ai * 2 + wr) * 2 + 1) * 128 + n * 16) * 4u) = acc[ai][0][3][n];
                }
            asm volatile("s_waitcnt lgkmcnt(0)" ::: "memory"); __builtin_amdgcn_s_barrier(); asm volatile("" ::: "memory");
            const int jb = u.pn * 128 + wc * 32 + 4 * fq;
#pragma unroll
            for (int n = 0; n < 2; ++n) {
                const int j = jb + 16 * n;
                const pg8::f32x4 w0 = *(const pg8::f32x4*)(cw + j), w1 = *(const pg8::f32x4*)(cw + DFF + j), w2 = *(const pg8::f32x4*)(cw + 2 * DFF + j), bb = *(const pg8::f32x4*)(cb + j);
#pragma unroll
                for (int ai = 0; ai < 2; ++ai) {
                    const int pblk = (ai * 2 + wr) - 1, nblk = (ai * 2 + wr) + 1;
                    pg8::f32x4 eprev = (pg8::f32x4){0.f, 0.f, 0.f, 0.f}, enext = eprev;
                    if (pblk >= 0) eprev = *(LAS const pg8::f32x4*)(uintptr_t)(ex + (unsigned)((pblk * 2 + 1) * 128 + n * 16) * 4u);
                    if (nblk <= 3) enext = *(LAS const pg8::f32x4*)(uintptr_t)(ex + (unsigned)((nblk * 2 + 0) * 128 + n * 16) * 4u);
#pragma unroll
                    for (int mm = 0; mm < 4; ++mm) {
                        const int trow = ai * 128 + wr * 64 + mm * 16 + fr, grow = u.pm * 254 - 1 + trow;
                        int t, T; seq_pos(grow < 0 ? 0 : grow, t, T);
                        const pg8::f32x4 gc = acc[ai][0][mm][n], uu = acc[ai][1][mm][n];
                        pg8::f32x4 gp, gn;
#pragma unroll
                        for (int i = 0; i < 4; ++i) {
                            const float pold = mm > 0 ? __int_as_float(__builtin_amdgcn_update_dpp(0, __float_as_int(acc[ai][0][mm > 0 ? mm - 1 : 0][n][i]), 0x121, 0xF, 0xF, false)) : eprev[i];
                            gp[i] = __int_as_float(__builtin_amdgcn_update_dpp(__float_as_int(pold), __float_as_int(gc[i]), 0x111, 0xF, 0xF, false));
                            const float nold = mm < 3 ? __int_as_float(__builtin_amdgcn_update_dpp(0, __float_as_int(acc[ai][0][mm < 3 ? mm + 1 : 3][n][i]), 0x12F, 0xF, 0xF, false)) : enext[i];
                            gn[i] = __int_as_float(__builtin_amdgcn_update_dpp(__float_as_int(nold), __float_as_int(gc[i]), 0x101, 0xF, 0xF, false));
                        }
                        if (t == 0) gp = (pg8::f32x4){0.f, 0.f, 0.f, 0.f};
                        if (t == T - 1) gn = (pg8::f32x4){0.f, 0.f, 0.f, 0.f};
                        const pg8::f32x4 z = gp * w0 + gc * w1 + gn * w2 + bb;
                        pg8::f32x4 a;
#pragma unroll
                        for (int i = 0; i < 4; ++i) a[i] = z[i] * __builtin_amdgcn_rcpf(1.0f + __expf(-z[i])) * uu[i];
                        if (trow >= 1 && trow <= 254 && grow < nrows) { v2u o; o.x = pk2h(a[0], a[1]); o.y = pk2h(a[2], a[3]); *(v2u*)(ob + (size_t)grow * DFF + j) = o; }
                    }
                }
            }
        } else if (mode == 2) {
#pragma unroll
            for (int ai = 0; ai < 2; ++ai)
#pragma unroll
                for (int m = 0; m < 4; ++m) { bf16* rp = ob + (size_t)(u.pm * 256 + ai * 128 + wr * 64 + m * 16 + fr) * ld + u.pn * 256 + wc * 32 + 4 * fq;
#pragma unroll
                    for (int bj = 0; bj < 2; ++bj)
#pragma unroll
                        for (int n = 0; n < 2; ++n) { const pg8::f32x4 v = acc[ai][bj][m][n]; v2u o; o.x = pk2h(v[0], v[1]); o.y = pk2h(v[2], v[3]); *(v2u*)(rp + bj * 128 + n * 16) = o; } }
        } else {
            const bool latent = u.pm < (MLAT / 256);
#pragma unroll
            for (int bj = 0; bj < 2; ++bj) {
                const int g32 = u.pn * 8 + bj * 4 + wc;
                if (g32 >= INW / 32) continue;
                const bool isdf = (g32 >= C_DFQ / 32 && g32 < C_DFV / 32), isgq = (g32 >= C_GQQ / 32 && g32 < C_GQV / 32);
                const float qs = (g32 >= C_DFQ / 32 && g32 < C_DFK / 32) ? SC_DF : ((g32 >= C_GQQ / 32 && g32 < C_GQK / 32) ? SC_GQ : 1.0f);
#pragma unroll
                for (int ai = 0; ai < 2; ++ai)
#pragma unroll
                    for (int m = 0; m < 4; ++m) {
                        const int row = u.pm * 256 + ai * 128 + wr * 64 + m * 16 + fr, s = row & (SEQ - 1), prow = s >> 6, pcol = s & 63;
                        pg8::f32x4 v0 = acc[ai][bj][m][0], v1 = acc[ai][bj][m][1];
                        if (isdf) {
                            pg8::f32x4 p0, p1;
#pragma unroll
                            for (int i = 0; i < 4; ++i) { p0[i] = __shfl_xor(v0[i], 32); p1[i] = __shfl_xor(v1[i], 32); }
                            if (latent) {
                                const int f0 = 4 * (fq & 1);
                                const pg8::f32x4 c0 = *(const pg8::f32x4*)(tab + prow * 8 + f0), s0 = *(const pg8::f32x4*)(tab + 512 + prow * 8 + f0);
                                const pg8::f32x4 c1 = *(const pg8::f32x4*)(tab + pcol * 8 + f0), s1 = *(const pg8::f32x4*)(tab + 512 + pcol * 8 + f0);
                                if (fq & 2) { v0 = v0 * c0 + p0 * s0; v1 = v1 * c1 + p1 * s1; } else { v0 = v0 * c0 - p0 * s0; v1 = v1 * c1 - p1 * s1; }
                            }
                        } else if (isgq) {
                            if (latent) {
                                const int pos = (g32 & 1) ? pcol : prow;
                                const pg8::f32x4 cc = *(const pg8::f32x4*)(tab + 1024 + pos * 16 + 4 * fq), ss = *(const pg8::f32x4*)(tab + 2048 + pos * 16 + 4 * fq);
                                const pg8::f32x4 a = v0 * cc - v1 * ss, b = v1 * cc + v0 * ss; v0 = a; v1 = b;
                            }
                        }
                        v0 = v0 * qs; v1 = v1 * qs;
                        bf16* rp = ob + (size_t)row * INP + g32 * 32 + 4 * fq;
                        v2u o; o.x = pk2h(v0[0], v0[1]); o.y = pk2h(v0[2], v0[3]); *(v2u*)rp = o;
                        o.x = pk2h(v1[0], v1[1]); o.y = pk2h(v1[2], v1[3]); *(v2u*)(rp + 16) = o;
                        asm volatile("" ::: "memory");
                    }
            }
        }
    }
};


template <int CTRL, int RM> __device__ __forceinline__ float dpp_mul1(float x) {
    return x * __int_as_float(__builtin_amdgcn_update_dpp(0x3f800000, __float_as_int(x), CTRL, RM, 0xF, false));
}
__device__ __forceinline__ float wave_mulscan(float x) {
    x = dpp_mul1<0x111, 0xF>(x); x = dpp_mul1<0x112, 0xF>(x); x = dpp_mul1<0x114, 0xF>(x); x = dpp_mul1<0x118, 0xF>(x);
    x = dpp_mul1<0x142, 0xA>(x); x = dpp_mul1<0x143, 0xC>(x); return x;
}
__device__ __forceinline__ float wave_shr1_one(float x) { return __int_as_float(__builtin_amdgcn_update_dpp(0x3f800000, __float_as_int(x), 0x138, 0xF, 0xF, false)); }
__device__ __forceinline__ bf16 bf1(float x) { return (bf16)(pk2h(x, 0.f) & 0xffffu); }

constexpr int FT_LD = 65, FT_ARR = 64 * FT_LD * 4;
constexpr int FT_BON = 9 * FT_ARR;
constexpr int FT_PR_LD = 200;
static_assert(66 * FT_PR_LD * 2 <= 2 * FT_ARR && FT_BON + 512 <= LDSCTL_OFF, "features LDS map");
__device__ __forceinline__ void rwkv_features(const Args& A, Frame& F, int l) {
    const int w = F.wave, n = F.lane, c15 = n & 15, g = n >> 4, tr = w >> 1, tc0 = (w & 1) * 2;
    const int h = F.bid & 3, c = h * 64 + n;
    const bf16* P = (const bf16*)(kws() + WS_RP);
    bf16* FV = (bf16*)(kws() + WS_FV); float* BON = (float*)(kws() + WS_BON); float* GLT = (float*)(kws() + WS_GLT);
    float cw[3][3];
#pragma unroll
    for (int tp = 0; tp < 3; ++tp)
#pragma unroll
        for (int j = 0; j < 3; ++j) cw[tp][j] = kin(I_RWCONV)[(size_t)(l * 3 + tp) * 768 + j * 256 + c];
    const float kkc = kin(I_RWKK)[l * 256 + c];
    bf16x8 Bw[2][2], Ba[2][2]; float w0c[2][2], a0c[2][2], kac2[2], rkc2[2];
#pragma unroll
    for (int t = 0; t < 2; ++t) { const int cn = h * 64 + 16 * (tc0 + t) + c15;
        kac2[t] = kin(I_RWKA)[l * 256 + cn]; rkc2[t] = kin(I_RWRK)[l * 256 + cn];
#pragma unroll
        for (int d = 0; d < 2; ++d) { w0c[d][t] = kin(I_RWW0)[(l * 2 + d) * 256 + cn]; a0c[d][t] = kin(I_RWA0)[(l * 2 + d) * 256 + cn];
            unsigned pw[4], pa[4];
#pragma unroll
            for (int j = 0; j < 8; j += 2) { const size_t o = ((size_t)(l * 2 + d) * 32 + 8 * g + j) * 256 + cn;
                pw[j >> 1] = pk2h(kin(I_RWWUP)[o], kin(I_RWWUP)[o + 256]); pa[j >> 1] = pk2h(kin(I_RWAUP)[o], kin(I_RWAUP)[o + 256]); }
            Bw[d][t] = __builtin_bit_cast(bf16x8, (v4u){pw[0], pw[1], pw[2], pw[3]}); Ba[d][t] = __builtin_bit_cast(bf16x8, (v4u){pa[0], pa[1], pa[2], pa[3]}); }
    }
    for (int u = F.bid; u < 4 * (MALL / 64); u += F.G) {
        const int gi = u >> 2, row0 = 64 * gi;
        int t0, T; seq_pos(row0, t0, T);
        __syncthreads();
        for (int p = F.tid; p < 66 * 24; p += NTHR) { const int rr = p / 24, q = p % 24, which = q >> 3, ch = q & 7, row = row0 - 1 + rr;
            const bool ok = (rr >= 1 && rr <= 64) || (rr == 0 ? t0 > 0 : t0 + 64 < T);
            v4u v = (v4u){0u, 0u, 0u, 0u};
            if (ok) v = *(const v4u*)(P + (size_t)row * INP + which * 256 + h * 64 + 8 * ch);
            *(LAS v4u*)(F.lds + (rr * FT_PR_LD + which * 64 + 8 * ch) * 2) = v; }
        v4u xwd[2], xad[2];
        { const bf16* pr = P + (size_t)(row0 + 16 * tr + c15) * INP + 8 * g;
#pragma unroll
          for (int d = 0; d < 2; ++d) { xwd[d] = *(const v4u*)(pr + C_WD + 32 * d); xad[d] = *(const v4u*)(pr + C_AD + 32 * d); } }
        __syncthreads();
#pragma unroll
        for (int rr = 0; rr < 8; ++rr) {
            const int i = 8 * w + rr;
            float xr[3], xk[3], xv[3];
#pragma unroll
            for (int tp = 0; tp < 3; ++tp) { const LAS bf16* pp = (const LAS bf16*)F.lds + (i + tp) * FT_PR_LD + n; xr[tp] = bf2f(pp[0]); xk[tp] = bf2f(pp[64]); xv[tp] = bf2f(pp[128]); }
            const float rq = bf2f(bf1(xr[0] * cw[0][0] + xr[1] * cw[1][0] + xr[2] * cw[2][0])), kq = bf2f(bf1(xk[0] * cw[0][1] + xk[1] * cw[1][1] + xk[2] * cw[2][1]));
            FV[(size_t)(row0 + i) * 256 + c] = bf1(xv[0] * cw[0][2] + xv[1] * cw[1][2] + xv[2] * cw[2][2]);
            const float kkraw = kq * kkc;
            const float kk = kkraw * (1.0f / fmaxf(sqrtf(wave_sum(kkraw * kkraw)), 1e-12f));
            LAS float* L = (LAS float*)F.lds + i * FT_LD + n;
            L[2 * (FT_ARR / 4)] = kk; L[7 * (FT_ARR / 4)] = rq; L[8 * (FT_ARR / 4)] = kq;
        }
        __syncthreads();
        {
            bf16x8 aw[2], aa[2];
#pragma unroll
            for (int d = 0; d < 2; ++d) { unsigned pw[4];
#pragma unroll
                for (int q = 0; q < 4; ++q) { const float x0 = __uint_as_float(xwd[d][q] << 16), x1 = __uint_as_float(xwd[d][q] & 0xffff0000u);
                    pw[q] = pk2h(1.0f - 2.0f * __builtin_amdgcn_rcpf(1.0f + __expf(2.0f * x0)), 1.0f - 2.0f * __builtin_amdgcn_rcpf(1.0f + __expf(2.0f * x1))); }
                aw[d] = __builtin_bit_cast(bf16x8, (v4u){pw[0], pw[1], pw[2], pw[3]}); aa[d] = __builtin_bit_cast(bf16x8, xad[d]); }
            float bsum[4] = {0.f, 0.f, 0.f, 0.f};
#pragma unroll
            for (int t = 0; t < 2; ++t) {
                float kkv[4], kqv[4], rqv[4];
#pragma unroll
                for (int r = 0; r < 4; ++r) { const LAS float* L = (const LAS float*)F.lds + (16 * tr + 4 * g + r) * FT_LD + 16 * (tc0 + t) + c15;
                    kkv[r] = L[2 * (FT_ARR / 4)]; rqv[r] = L[7 * (FT_ARR / 4)]; kqv[r] = L[8 * (FT_ARR / 4)]; }
#pragma unroll
                for (int d = 0; d < 2; ++d) {
                    const f32x4 wl = __builtin_amdgcn_mfma_f32_16x16x32_bf16(aw[d], Bw[d][t], (f32x4){0.f, 0.f, 0.f, 0.f}, 0, 0, 0);
                    const f32x4 al = __builtin_amdgcn_mfma_f32_16x16x32_bf16(aa[d], Ba[d][t], (f32x4){0.f, 0.f, 0.f, 0.f}, 0, 0, 0);
#pragma unroll
                    for (int r = 0; r < 4; ++r) {
                        const float wv = 1.0f + bf2f(bf1(__expf(-0.6065306597126334f * sigmoidf_(wl[r] + w0c[d][t])) - 1.0f)), aq = bf2f(bf1(sigmoidf_(al[r] + a0c[d][t])));
                        const float kd = kqv[r] * (1.0f + (aq - 1.0f) * kac2[t]);
                        LAS float* L = (LAS float*)F.lds + (16 * tr + 4 * g + r) * FT_LD + 16 * (tc0 + t) + c15;
                        L[(0 + d) * (FT_ARR / 4)] = wv; L[(3 + d) * (FT_ARR / 4)] = kkv[r] * aq; L[(5 + d) * (FT_ARR / 4)] = kd;
                        bsum[r] += rqv[r] * kd * rkc2[t];
                    }
                }
            }
#pragma unroll
            for (int r = 0; r < 4; ++r) { float s = bsum[r]; s = dpp_add<0xB1>(s); s = dpp_add<0x4E>(s); s = dpp_add<0x124>(s); s = dpp_add<0x128>(s);
                if (c15 == 0) *(LAS float*)(F.lds + FT_BON + ((w & 1) * 64 + 16 * tr + 4 * g + r) * 4) = s; }
        }
        __syncthreads();
        if (F.tid < 64) BON[(row0 + F.tid) * 4 + h] = *(LAS float*)(F.lds + FT_BON + F.tid * 4) + *(LAS float*)(F.lds + FT_BON + (64 + F.tid) * 4);
#pragma unroll
        for (int d = 0; d < 2; ++d) {
            const int i = d ? 63 - n : n;
            const LAS float* L = (const LAS float*)F.lds + i * FT_LD + 8 * w;
            unsigned al8[4], be8[4], kp8[4], rh8[4]; float g63[8];
#pragma unroll
            for (int e2 = 0; e2 < 4; ++e2) {
                float alv[2], bev[2], kpv[2], rhv[2];
#pragma unroll
                for (int q = 0; q < 2; ++q) { const int e = 2 * e2 + q;
                    const float gi_ = wave_mulscan(L[(0 + d) * (FT_ARR / 4) + e]), gim1 = wave_shr1_one(gi_), ig = __builtin_amdgcn_rcpf(gi_);
                    g63[e] = rdlane(gi_, 63);
                    alv[q] = gim1 * L[2 * (FT_ARR / 4) + e]; bev[q] = L[(3 + d) * (FT_ARR / 4) + e] * ig; kpv[q] = L[(5 + d) * (FT_ARR / 4) + e] * ig; rhv[q] = gi_ * L[7 * (FT_ARR / 4) + e]; }
                al8[e2] = pk2h(alv[0], alv[1]); be8[e2] = pk2h(bev[0], bev[1]); kp8[e2] = pk2h(kpv[0], kpv[1]); rh8[e2] = pk2h(rhv[0], rhv[1]);
            }
            const size_t o = (size_t)d * MALL * 256 + (size_t)(64 * gi + i) * 256 + h * 64 + 8 * w;
            *(v4u*)((bf16*)(kws() + WS_GAL) + o) = (v4u){al8[0], al8[1], al8[2], al8[3]}; *(v4u*)((bf16*)(kws() + WS_GBE) + o) = (v4u){be8[0], be8[1], be8[2], be8[3]};
            *(v4u*)((bf16*)(kws() + WS_GKP) + o) = (v4u){kp8[0], kp8[1], kp8[2], kp8[3]}; *(v4u*)((bf16*)(kws() + WS_GRH) + o) = (v4u){rh8[0], rh8[1], rh8[2], rh8[3]};
            if (n < 8) { float gl = g63[0];
#pragma unroll
                for (int e = 1; e < 8; ++e) gl = (n == e) ? g63[e] : gl;
                GLT[((size_t)d * 272 + gi) * 256 + h * 64 + 8 * w + n] = gl; }
        }
    }
}

__device__ __forceinline__ int scan_row(int d, int b, int i) { if (i < CTXL) { const int t = d ? CTXL - 1 - i : i; return MLAT + b * CTXL + t; } const int j = i - CTXL, t = d ? SEQ - 1 - j : j; return b * SEQ + t; }

__device__ __forceinline__ void rwkv_readout(const Args& A, Frame& F, int l) {
    const int gw = F.bid * NWAVES + F.wave, NGW = F.G * NWAVES, nrows = l == 0 ? MALL : MLAT;
    const int h = gw & 3, n = F.lane, c = h * 64 + n;
    const bf16* P = (const bf16*)(kws() + WS_RP); const bf16* FV = (const bf16*)(kws() + WS_FV);
    const float* BON = (const float*)(kws() + WS_BON); bf16* Y = (bf16*)(kws() + WS_XN);
    float gupr[64];
#pragma unroll
    for (int j = 0; j < 64; ++j) gupr[j] = kin(I_RWGUP)[((size_t)l * 64 + j) * 256 + c];
    const float lng = kin(I_RWLNG)[l * 256 + c], lnb = kin(I_RWLNB)[l * 256 + c];
    bf16 q0 = 0, q1 = 0, qg = 0, qv = 0; float qb = 0.f;
#define RO_LOAD(r_) do { q0 = P[(size_t)(r_) * INP + c]; q1 = P[(size_t)(r_) * INP + 256 + c]; qg = P[(size_t)(r_) * INP + C_GD + n]; qv = FV[(size_t)(r_) * 256 + c]; qb = BON[(r_) * 4 + h]; } while (0)
    if ((gw >> 2) < nrows) RO_LOAD(gw >> 2);
    for (int row = gw >> 2; row < nrows; row += NGW >> 2) {
        const float ov = bf2f(q0) + bf2f(q1), gdv = bf2f(qg), vv = bf2f(qv), bon = qb;
        const int nxt = row + (NGW >> 2);
        if (nxt < nrows) RO_LOAD(nxt);
        const float mu = wave_sum(ov) * (1.0f / 64.0f), dv = ov - mu, var = wave_sum(dv * dv) * (1.0f / 64.0f);
        const float on = dv * rsqrtf(var + 64e-5f) * lng + lnb;
        const float sg = sigmoidf_(gdv);
        float g = 0.f;
#pragma unroll
        for (int j = 0; j < 64; ++j) g = fmaf(rdlane(sg, j), gupr[j], g);
        const float y = (on + bon * vv) * g;
        Y[(size_t)row * D + c] = bf1(y);
    }
#undef RO_LOAD
}


constexpr int CK_LD = 72, CK_MAT = 64 * CK_LD * 2 + 256;
enum { M_AL = 0, M_BE, M_KP, M_RH, M_BET, M_KPT, M_VT, M_AOFF, M_BM, M_MB, M_MK, M_SB, M_SB1, M_YZ, M_UT, M_COUNT };
constexpr int CK_TD = M_COUNT * CK_MAT, CK_TD_LD = 40;
constexpr int CK_ADG = CK_TD + 64 * CK_TD_LD * 2;
constexpr int CK_SEG = CK_ADG + 4096;
constexpr int CK_GL = CK_SEG + 2048;
constexpr int CK_END = CK_GL + 256;
static_assert(CK_END <= LDSCTL_OFF, "chunk scan LDS map");
struct CkAddr { unsigned vA, vB, vN, vT, v1, v1t, lds, vAs, vBs, vX0, vN0, vT0; };
#define CKP(T, addr) ((LAS T*)(uintptr_t)(addr))
template <int KS, bool SKX = false, bool SKY = false> __device__ __forceinline__ void mm2(f32x4 (&acc)[2], const CkAddr& K, int mx, int my) {
#pragma unroll
    for (int ks = 0; ks < KS; ++ks) {
        const bf16x8 a = *CKP(const bf16x8, (SKX ? K.vAs : K.vA) + mx * CK_MAT + 64 * ks);
#pragma unroll
        for (int t = 0; t < 2; ++t) { const bf16x8 bq = *CKP(const bf16x8, (SKY ? K.vBs + t * 32 : K.vB) + my * CK_MAT + t * (16 * CK_LD * 2) + 64 * ks); acc[t] = __builtin_amdgcn_mfma_f32_16x16x32_bf16(a, bq, acc[t], 0, 0, 0); }
    }
}
template <int KS, bool SKX, bool SKY> __device__ __forceinline__ void mm1(f32x4& acc, const CkAddr& K, int mx, int my, int xt, int yt) {
    const unsigned ax = K.vX0 + (SKX ? 16 * (((K.vX0 - K.lds) / (CK_LD * 2)) >> 3) : 0) + mx * CK_MAT + xt * (16 * CK_LD * 2 + (SKX ? 32 : 0));
    const unsigned ay = K.vX0 + (SKY ? 16 * (((K.vX0 - K.lds) / (CK_LD * 2)) >> 3) : 0) + my * CK_MAT + yt * (16 * CK_LD * 2 + (SKY ? 32 : 0));
#pragma unroll
    for (int ks = 0; ks < KS; ++ks) acc = __builtin_amdgcn_mfma_f32_16x16x32_bf16(*CKP(const bf16x8, ax + 64 * ks), *CKP(const bf16x8, ay + 64 * ks), acc, 0, 0, 0);
}
__device__ __forceinline__ void stN1(const CkAddr& K, int mi, int rt, int ct, const f32x4 v) {
#pragma unroll
    for (int r = 0; r < 4; ++r) *CKP(bf16, K.vN0 + mi * CK_MAT + rt * (16 * CK_LD * 2) + r * (CK_LD * 2) + ct * 32) = bf1(v[r]);
}
__device__ __forceinline__ void stT1(const CkAddr& K, int mi, int rt, int ct, const f32x4 v) {
    v2u o; o.x = pk2h(v[0], v[1]); o.y = pk2h(v[2], v[3]); *CKP(v2u, K.vT0 + mi * CK_MAT + ct * (16 * CK_LD * 2) + rt * 32) = o;
}
__device__ __forceinline__ void stN(const CkAddr& K, int mi, int t, const f32x4 v) {
#pragma unroll
    for (int r = 0; r < 4; ++r) *CKP(bf16, K.vN + mi * CK_MAT + r * (CK_LD * 2) + t * 32) = bf1(v[r]);
}
__device__ __forceinline__ void stT(const CkAddr& K, int mi, int t, const f32x4 v) {
    v2u o; o.x = pk2h(v[0], v[1]); o.y = pk2h(v[2], v[3]); *CKP(v2u, K.vT + mi * CK_MAT + t * (16 * CK_LD * 2)) = o;
}
__device__ __forceinline__ void rwkv_chunk_unit(const Args& A, Frame& F, int l, int sc, int vh) {
    const bool last = (l == 1);
    const int d = sc >> 4, b = (sc >> 2) & 3, h = sc & 3;
    const int w = F.wave, n = F.lane;
    const bf16* GAL = (const bf16*)(kws() + WS_GAL) + (size_t)d * MALL * 256; const bf16* GBE = (const bf16*)(kws() + WS_GBE) + (size_t)d * MALL * 256;
    const bf16* GKP = (const bf16*)(kws() + WS_GKP) + (size_t)d * MALL * 256; const bf16* GRH = (const bf16*)(kws() + WS_GRH) + (size_t)d * MALL * 256;
    const bf16* FV = (const bf16*)(kws() + WS_FV); const float* GLT = (const float*)(kws() + WS_GLT) + (size_t)d * 272 * 256;
    bf16* O = (bf16*)(kws() + WS_RP) + d * 256;
    v4u ual, ube, ukp, urh, uv; float fgl = 0.f;
    { const int row = scan_row(d, b, 8 * w + (n >> 3)); const size_t o = (size_t)row * 256 + h * 64 + 8 * (n & 7);
      ual = *(const v4u*)(GAL + o); ube = *(const v4u*)(GBE + o); ukp = *(const v4u*)(GKP + o); urh = *(const v4u*)(GRH + o); uv = *(const v4u*)(FV + o);
      if (w == 0) fgl = GLT[(size_t)(scan_row(d, b, 0) >> 6) * 256 + h * 64 + n]; }
    __syncthreads();
    for (int i = F.tid; i < CK_END / 16; i += NTHR) *(LAS v4u*)(F.lds + i * 16) = (v4u){0u, 0u, 0u, 0u};
    f32x4 st = (f32x4){0.f, 0.f, 0.f, 0.f};
    __syncthreads();
    constexpr int NCK = (CTXL + SEQ) / 64;
    for (int c = 0; c < NCK; ++c) {
        const bool skip_o = last && c < CTXL / 64;
        int c15 = n & 15, g = n >> 4; asm volatile("" : "+v"(c15), "+v"(g));
        const int tr = w >> 1, tc0 = (w & 1) * 2;
        CkAddr K; K.lds = (unsigned)(uintptr_t)F.lds;
        K.vA = K.lds + ((16 * tr + c15) * CK_LD + 8 * g) * 2; K.vB = K.lds + ((16 * tc0 + c15) * CK_LD + 8 * g) * 2;
        K.vN = K.lds + ((16 * tr + 4 * g) * CK_LD + 16 * tc0 + c15) * 2; K.vT = K.lds + ((16 * tc0 + c15) * CK_LD + 16 * tr + 4 * g) * 2;
        K.v1 = K.lds + (8 * (n & 7) * CK_LD + 8 * w + (n >> 3)) * 2 + 16 * (n & 7); K.v1t = K.lds + ((8 * w + (n >> 3)) * CK_LD + 8 * (n & 7)) * 2;
        K.vAs = K.vA + 32 * tr + 16 * (c15 >> 3); K.vBs = K.vB + 32 * tc0 + 16 * (c15 >> 3);
        const int ti = w >> 1, tv = w & 1, tv2 = w >> 2, tk = w & 3;
        K.vX0 = K.lds + (c15 * CK_LD + 8 * g) * 2; K.vN0 = K.lds + (4 * g * CK_LD + c15) * 2; K.vT0 = K.lds + (c15 * CK_LD + 4 * g) * 2;
                asm volatile("" : "+v"(K.vA), "+v"(K.vB), "+v"(K.vN), "+v"(K.vT), "+v"(K.v1), "+v"(K.v1t), "+v"(K.vAs), "+v"(K.vBs), "+v"(K.vX0), "+v"(K.vN0), "+v"(K.vT0));
        {
            for (int rp_ = 0; rp_ < 1 + ((MK_RWDUP >> 1) & 1); ++rp_) {
            *CKP(v4u, K.v1t + M_AL * CK_MAT) = ual; *CKP(v4u, K.v1t + M_BE * CK_MAT) = ube; *CKP(v4u, K.v1t + M_KP * CK_MAT) = ukp; *CKP(v4u, K.v1t + M_RH * CK_MAT) = urh;
#pragma unroll
            for (int e = 0; e < 8; ++e) {
                *CKP(bf16, K.v1 + M_BET * CK_MAT + e * (CK_LD * 2)) = (bf16)((e & 1) ? (ube[e >> 1] >> 16) : (ube[e >> 1] & 0xffffu));
                *CKP(bf16, K.v1 + M_KPT * CK_MAT + e * (CK_LD * 2)) = (bf16)((e & 1) ? (ukp[e >> 1] >> 16) : (ukp[e >> 1] & 0xffffu));
                *CKP(bf16, K.v1 + M_VT * CK_MAT + e * (CK_LD * 2)) = (bf16)((e & 1) ? (uv[e >> 1] >> 16) : (uv[e >> 1] & 0xffffu)); }
            if (w == 0) *CKP(float, K.lds + CK_GL + n * 4) = fgl;
            asm volatile("" ::: "memory"); }
            { const int cn = c + 1 < NCK ? c + 1 : c; const int row = scan_row(d, b, 64 * cn + 8 * w + (n >> 3)); const size_t o = (size_t)row * 256 + h * 64 + 8 * (n & 7);
              ual = *(const v4u*)(GAL + o); ube = *(const v4u*)(GBE + o); ukp = *(const v4u*)(GKP + o); urh = *(const v4u*)(GRH + o); uv = *(const v4u*)(FV + o);
              if (w == 0) fgl = GLT[(size_t)(scan_row(d, b, 64 * cn) >> 6) * 256 + h * 64 + n]; }
        }
        __syncthreads();
        for (int rp_ = 0; rp_ < 1 + ((MK_RWDUP >> 2) & 1); ++rp_) {
        if (tc0 <= tr) {
            f32x4 pa[2] = {(f32x4){0.f, 0.f, 0.f, 0.f}, (f32x4){0.f, 0.f, 0.f, 0.f}}, pb[2] = {pa[0], pa[0]}, pm[2] = {pa[0], pa[0]}, pk[2] = {pa[0], pa[0]};
            mm2<2>(pa, K, M_AL, M_BE); mm2<2>(pb, K, M_AL, M_KP); mm2<2>(pm, K, M_RH, M_BE); mm2<2>(pk, K, M_RH, M_KP);
#pragma unroll
            for (int t = 0; t < 2; ++t) { const int tc = tc0 + t; if (tc > tr) continue;
                f32x4 va = pa[t], vb = pb[t], vm = pm[t], vk = pk[t];
                if (tc == tr) {
#pragma unroll
                    for (int r = 0; r < 4; ++r) { const bool strict = c15 < 4 * g + r, incl = c15 <= 4 * g + r;
                        va[r] = strict ? va[r] : 0.f; vb[r] = strict ? vb[r] : 0.f; vm[r] = incl ? vm[r] : 0.f; vk[r] = incl ? vk[r] : 0.f;
                        *CKP(float, K.lds + CK_ADG + ((tr * 16 + 4 * g + r) * 16 + c15) * 4) = va[r]; }
                } else stN(K, M_AOFF, t, va);
                stN(K, M_BM, t, vb); stN(K, M_MB, t, vm); stN(K, M_MK, t, vk);
            }
        }
        __syncthreads();
        }
        f32x4 yb, ob;
        for (int rp_ = 0; rp_ < 1 + ((MK_RWDUP >> 3) & 1); ++rp_) {
        yb = (f32x4){0.f, 0.f, 0.f, 0.f}; ob = yb;
        mm1<2, false, true>(yb, K, M_BM, M_VT, ti, 2 * vh + tv);
        if (!skip_o) mm1<2, false, true>(ob, K, M_MK, M_VT, ti, 2 * vh + tv);
        if (w == 0) {
            const int bb_ = n >> 4, cc = n & 15; float tcol[16];
            f32x4 arow[16][4];
#pragma unroll
            for (int r = 1; r < 16; ++r)
#pragma unroll
                for (int s4 = 0; s4 * 4 < r; ++s4) arow[r][s4] = *CKP(const f32x4, K.lds + CK_ADG + ((bb_ * 16 + r) * 16 + 4 * s4) * 4);
#pragma unroll
            for (int r = 0; r < 16; ++r) { float acc = (r == cc) ? 1.f : 0.f;
#pragma unroll
                for (int s = 0; s < r; ++s) acc = fmaf(-arow[r][s >> 2][s & 3], tcol[s], acc);
                tcol[r] = acc; *CKP(bf16, K.lds + CK_TD + ((16 * bb_ + r) * CK_TD_LD + cc) * 2) = bf1(acc); }
        }
        if ((MK_RWDUP >> 3) & 1) __syncthreads();
        }
        const int sbr = (c & 1) ? M_SB1 : M_SB, sbw = (c & 1) ? M_SB : M_SB1;
        const f32x4 ybs0 = yb;
        for (int rp_ = 0; rp_ < 1 + ((MK_RWDUP >> 4) & 1); ++rp_) {
        yb = ybs0;
        mm1<2, false, false>(yb, K, M_AL, sbr, ti, tv);
        stT1(K, M_YZ, ti, tv, yb);
        __syncthreads();
        if (w < 2) {
            const unsigned aX = K.lds + ((c15) * CK_LD + 8 * g) * 2;
            const unsigned bY = K.lds + ((16 * w + c15) * CK_LD + 8 * g) * 2;
            const unsigned cT = K.lds + ((16 * w + c15) * CK_LD + 4 * g) * 2;
#pragma unroll
            for (int blk = 0; blk < 4; ++blk) {
                f32x4 z = (f32x4){0.f, 0.f, 0.f, 0.f};
                if (blk > 0) {
#pragma unroll
                    for (int ks = 0; ks < (blk == 3 ? 2 : 1); ++ks) {
                        const bf16x8 a = *CKP(const bf16x8, aX + M_AOFF * CK_MAT + blk * (16 * CK_LD * 2) + 64 * ks);
                        const bf16x8 u = *CKP(const bf16x8, bY + M_UT * CK_MAT + 64 * ks);
                        z = __builtin_amdgcn_mfma_f32_16x16x32_bf16(a, u, z, 0, 0, 0); }
                }
                { const v2u yv = *CKP(const v2u, cT + M_YZ * CK_MAT + 32 * blk);
                  z[0] += __uint_as_float(yv.x << 16); z[1] += __uint_as_float(yv.x & 0xffff0000u); z[2] += __uint_as_float(yv.y << 16); z[3] += __uint_as_float(yv.y & 0xffff0000u); }
                { v2u zo; zo.x = pk2h(z[0], z[1]); zo.y = pk2h(z[2], z[3]); *CKP(v2u, cT + M_YZ * CK_MAT + 32 * blk) = zo; }
                asm volatile("s_waitcnt lgkmcnt(0)" ::: "memory");
                const bf16x8 ta = *CKP(const bf16x8, K.lds + CK_TD + ((16 * blk + c15) * CK_TD_LD + 8 * g) * 2);
                const bf16x8 zb = *CKP(const bf16x8, bY + M_YZ * CK_MAT + 32 * blk);
                f32x4 u = __builtin_amdgcn_mfma_f32_16x16x32_bf16(ta, zb, (f32x4){0.f, 0.f, 0.f, 0.f}, 0, 0, 0);
                { v2u uo; uo.x = pk2h(-u[0], -u[1]); uo.y = pk2h(-u[2], -u[3]); *CKP(v2u, cT + M_UT * CK_MAT + 32 * blk) = uo; }
                asm volatile("s_waitcnt lgkmcnt(0)" ::: "memory");
            }
        }
        __syncthreads();
        }
        const f32x4 obs0 = ob;
        for (int rp_ = 0; rp_ < 1 + ((MK_RWDUP >> 5) & 1); ++rp_) if (!skip_o) {
            ob = obs0;
            mm1<2, false, false>(ob, K, M_RH, sbr, ti, tv); mm1<2, false, false>(ob, K, M_MB, M_UT, ti, tv);
#pragma unroll
            for (int r = 0; r < 4; ++r) { const int row = scan_row(d, b, 64 * c + 16 * ti + 4 * g + r); O[(size_t)row * INP + h * 64 + 32 * vh + 16 * tv + c15] = bf1(ob[r]); }
        }
        const f32x4 sts0 = st;
        for (int rp_ = 0; rp_ < 1 + ((MK_RWDUP >> 6) & 1); ++rp_) {
        st = sts0;
        mm1<2, false, true>(st, K, M_UT, M_BET, tv2, tk); mm1<2, true, true>(st, K, M_VT, M_KPT, 2 * vh + tv2, tk);
        { const float gl = *CKP(float, K.lds + CK_GL + (16 * tk + c15) * 4); st = st * gl; stN1(K, sbw, tv2, tk, st); }
        }
        __syncthreads();
    }
}
#undef CKP

struct KeyStream { int ctx_row0, nloc, loc_row0, loc_pos0; };
constexpr int AT_K = 0, AT_V = 9216, AT_BUF = 18688;
typedef float f32x4a __attribute__((ext_vector_type(4)));

template <int NMAP, int DK, int QS, bool MASK>
__device__ __forceinline__ void attn_core(Frame& F, const bf16* P, int kcol, int vcol, const KeyStream ks, const bf16x8 (&qf)[QS][NMAP][DK / 32], int qpos0,
                                          f32x4 (&o)[QS][NMAP][4], float (&m)[QS][NMAP], float (&lsum)[QS][NMAP]) {
    const int c15 = F.lane & 15, g = F.lane >> 4;
    const int lkey = F.tid >> 3, lch = F.tid & 7;
    const int ntiles = 4 + ks.nloc;
#pragma unroll
    for (int qs = 0; qs < QS; ++qs)
#pragma unroll
        for (int mp = 0; mp < NMAP; ++mp) { m[qs][mp] = 0.f; lsum[qs][mp] = 0.f;
#pragma unroll
            for (int dt = 0; dt < 4; ++dt) o[qs][mp][dt] = (f32x4){0.f, 0.f, 0.f, 0.f}; }
    bool anym[QS][NMAP];
#pragma unroll
    for (int qs = 0; qs < QS; ++qs)
#pragma unroll
        for (int mp = 0; mp < NMAP; ++mp) anym[qs][mp] = false;
    v4u stgk, stgv;
#define AT_LOAD(ti) do { const int rb_ = (ti) < 4 ? ks.ctx_row0 + 64 * (ti) : ks.loc_row0 + 64 * ((ti) - 4); \
        const bf16* p_ = P + (size_t)(rb_ + lkey) * INP + 8 * lch; stgk = *(const v4u*)(p_ + kcol); stgv = *(const v4u*)(p_ + vcol); } while (0)
#define AT_WRITE(bi) do { LAS unsigned char* b_ = F.lds + (bi) * AT_BUF; \
        *(LAS v4u*)(b_ + AT_K + lkey * 144 + lch * 16) = stgk; \
        _Pragma("unroll") for (int i_ = 0; i_ < 8; ++i_) { const unsigned w_ = stgv[i_ >> 1]; *(LAS bf16*)(b_ + AT_V + (8 * lch + i_) * 144 + 16 * lch + lkey * 2) = (bf16)((i_ & 1) ? (w_ >> 16) : (w_ & 0xffffu)); } } while (0)
    __syncthreads();
    AT_LOAD(0); AT_WRITE(0);
    __syncthreads();
    for (int ti = 0; ti < ntiles; ++ti) {
        { const int tn_ = ti + 1 < ntiles ? ti + 1 : ntiles - 1; AT_LOAD(tn_); }
        LAS unsigned char* bb = F.lds + (ti & 1) * AT_BUF;
#pragma unroll
        for (int sx = 0; sx < 2; ++sx) {
        bf16x8 kf[2][NMAP][DK / 32];
#pragma unroll
        for (int kh = 0; kh < 2; ++kh)
#pragma unroll
            for (int mp = 0; mp < NMAP; ++mp)
#pragma unroll
                for (int kx = 0; kx < DK / 32; ++kx) kf[kh][mp][kx] = *(LAS bf16x8*)(bb + AT_K + (32 * sx + 16 * kh + c15) * 144 + (mp * DK + 32 * kx + 8 * g) * 2);
        bf16x8 vf[4];
#pragma unroll
        for (int dt = 0; dt < 4; ++dt) { const v2u a = *(LAS v2u*)(bb + AT_V + (c15 + 16 * dt) * 144 + 16 * (2 * dt + (c15 >> 3)) + (32 * sx + 4 * g) * 2), b2 = *(LAS v2u*)(bb + AT_V + (c15 + 16 * dt) * 144 + 16 * (2 * dt + (c15 >> 3)) + (32 * sx + 16 + 4 * g) * 2);
            const v4u w = (v4u){a.x, a.y, b2.x, b2.y}; vf[dt] = __builtin_bit_cast(bf16x8, w); }
        const int kpos0 = ks.loc_pos0 + 64 * (ti - 4) + 32 * sx + 4 * g;
        f32x4 st[QS][NMAP][2]; float p[QS][NMAP][8], ps[QS][NMAP];
        bool anyref = false;
#pragma unroll
        for (int qs = 0; qs < QS; ++qs)
#pragma unroll
            for (int mp = 0; mp < NMAP; ++mp) anyref |= anym[qs][mp];
        if (!anyref) {
#pragma unroll
            for (int qs = 0; qs < QS; ++qs)
#pragma unroll
                for (int mp = 0; mp < NMAP; ++mp)
#pragma unroll
                    for (int kh = 0; kh < 2; ++kh) { st[qs][mp][kh] = (f32x4){0.f, 0.f, 0.f, 0.f};
#pragma unroll
                        for (int kx = 0; kx < DK / 32; ++kx) st[qs][mp][kh] = __builtin_amdgcn_mfma_f32_16x16x32_bf16(kf[kh][mp][kx], qf[qs][mp][kx], st[qs][mp][kh], 0, 0, 0); }
        } else {
#pragma unroll
            for (int qs = 0; qs < QS; ++qs)
#pragma unroll
                for (int mp = 0; mp < NMAP; ++mp) { const float negm = -m[qs][mp];
#pragma unroll
                    for (int kh = 0; kh < 2; ++kh) { st[qs][mp][kh] = (f32x4){negm, negm, negm, negm};
#pragma unroll
                        for (int kx = 0; kx < DK / 32; ++kx) st[qs][mp][kh] = __builtin_amdgcn_mfma_f32_16x16x32_bf16(kf[kh][mp][kx], qf[qs][mp][kx], st[qs][mp][kh], 0, 0, 0); } }
        }
        if (MASK && ti >= 4) {
            const int kb = ks.loc_pos0 + 64 * (ti - 4) + 32 * sx;
            if (kb + 31 - qpos0 > 128 || kb - (qpos0 + 16 * QS - 1) < -128) {
#pragma unroll
                for (int qs = 0; qs < QS; ++qs) { const int qp = qpos0 + 16 * qs + c15;
#pragma unroll
                    for (int mp = 0; mp < NMAP; ++mp)
#pragma unroll
                        for (int kh = 0; kh < 2; ++kh)
#pragma unroll
                            for (int r = 0; r < 4; ++r) { const int dd = kpos0 + 16 * kh + r - qp; st[qs][mp][kh][r] = (dd > 128 || dd < -128) ? -INFINITY : st[qs][mp][kh][r]; } }
            }
        }
        float big = 0.f;
#pragma unroll
        for (int qs = 0; qs < QS; ++qs)
#pragma unroll
            for (int mp = 0; mp < NMAP; ++mp) { float s_ = 0.f;
#pragma unroll
                for (int kh = 0; kh < 2; ++kh)
#pragma unroll
                    for (int r = 0; r < 4; ++r) { p[qs][mp][kh * 4 + r] = __builtin_amdgcn_exp2f(st[qs][mp][kh][r]); s_ += p[qs][mp][kh * 4 + r]; }
                ps[qs][mp] = s_; big = fmaxf(big, s_); }
        if (__builtin_amdgcn_ballot_w64(!(big < 1048576.0f)) != 0ull) {
#pragma unroll
            for (int qs = 0; qs < QS; ++qs)
#pragma unroll
                for (int mp = 0; mp < NMAP; ++mp) {
                    float mt = fmaxf(fmaxf(fmaxf(st[qs][mp][0][0], st[qs][mp][0][1]), fmaxf(st[qs][mp][0][2], st[qs][mp][0][3])), fmaxf(fmaxf(st[qs][mp][1][0], st[qs][mp][1][1]), fmaxf(st[qs][mp][1][2], st[qs][mp][1][3])));
                    mt = xmax4(mt);
                    const float delta = mt > 8.0f ? mt : 0.f, alpha = __builtin_amdgcn_exp2f(-delta);
                    m[qs][mp] += delta; lsum[qs][mp] *= alpha; anym[qs][mp] = true;
#pragma unroll
                    for (int dt = 0; dt < 4; ++dt) o[qs][mp][dt] = o[qs][mp][dt] * alpha;
                    float s_ = 0.f;
#pragma unroll
                    for (int kh = 0; kh < 2; ++kh)
#pragma unroll
                        for (int r = 0; r < 4; ++r) { p[qs][mp][kh * 4 + r] = __builtin_amdgcn_exp2f(st[qs][mp][kh][r] - delta); s_ += p[qs][mp][kh * 4 + r]; }
                    ps[qs][mp] = s_;
                }
        }
#pragma unroll
        for (int qs = 0; qs < QS; ++qs)
#pragma unroll
            for (int mp = 0; mp < NMAP; ++mp) {
                lsum[qs][mp] += ps[qs][mp];
                const v4u pw = (v4u){pk2h(p[qs][mp][0], p[qs][mp][1]), pk2h(p[qs][mp][2], p[qs][mp][3]), pk2h(p[qs][mp][4], p[qs][mp][5]), pk2h(p[qs][mp][6], p[qs][mp][7])};
                const bf16x8 pf = __builtin_bit_cast(bf16x8, pw);
#pragma unroll
                for (int dt = 0; dt < 4; ++dt) o[qs][mp][dt] = __builtin_amdgcn_mfma_f32_16x16x32_bf16(vf[dt], pf, o[qs][mp][dt], 0, 0, 0);
            }
        }
        AT_WRITE((ti + 1) & 1);
        __syncthreads();
    }
#undef AT_LOAD
#undef AT_WRITE
}

template <int QS>
__device__ __forceinline__ void diff_unit(const Args& A, Frame& F, int l, int b, int h, int qrow0, int nloc) {
    const bf16* P = (const bf16*)(kws() + WS_RP); bf16* Y = (bf16*)(kws() + WS_XN); const float* tab = (const float*)(kws() + WS_TAB);
    const int c15 = F.lane & 15, g = F.lane >> 4;
    bf16x8 qf[QS][2][1];
#pragma unroll
    for (int qs = 0; qs < QS; ++qs)
#pragma unroll
        for (int mp = 0; mp < 2; ++mp) qf[qs][mp][0] = *(const bf16x8*)(P + (size_t)(qrow0 + 16 * QS * F.wave + 16 * qs + c15) * INP + C_DFQ + h * 64 + mp * 32 + 8 * g);
    f32x4 o[QS][2][4]; float m[QS][2], ls[QS][2];
    const KeyStream ks{MLAT + b * CTXL, nloc, b * SEQ, 0};
    attn_core<2, 32, QS, false>(F, P, C_DFK + h * 64, C_DFV + h * 64, ks, qf, 0, o, m, ls);
    const float lam = tab[3072 + l], oscale = 1.0f - tab[3074 + l];
    const float* ng = kin(I_DFNG) + l * 64;
#pragma unroll
    for (int qs = 0; qs < QS; ++qs) {
        float inv[2];
#pragma unroll
        for (int mp = 0; mp < 2; ++mp) { float t = ls[qs][mp]; t += __shfl_xor(t, 16); t += __shfl_xor(t, 32); inv[mp] = 1.0f / t; }
        f32x4 ov[4]; float ss = 0.f;
#pragma unroll
        for (int dt = 0; dt < 4; ++dt) { ov[dt] = o[qs][0][dt] * inv[0] - o[qs][1][dt] * (lam * inv[1]); ss += (ov[dt][0] * ov[dt][0] + ov[dt][1] * ov[dt][1]) + (ov[dt][2] * ov[dt][2] + ov[dt][3] * ov[dt][3]); }
        ss += __shfl_xor(ss, 16); ss += __shfl_xor(ss, 32);
        const float r = rsqrtf(ss * (1.0f / 64.0f) + NORM_EPS) * oscale;
        bf16* yp = Y + (size_t)(qrow0 + 16 * QS * F.wave + 16 * qs + c15) * D + 256 + h * 64 + 4 * g;
#pragma unroll
        for (int dt = 0; dt < 4; ++dt) { const f32x4 gg = *(const f32x4*)(ng + 16 * dt + 4 * g); const f32x4 v = ov[dt] * r * gg;
            v2u w; w.x = pk2h(v[0], v[1]); w.y = pk2h(v[2], v[3]); *(v2u*)(yp + 16 * dt) = w; }
    }
}
__device__ __forceinline__ void gq_unit(const Args& A, Frame& F, int l, int b, int kv, int qrow0, int qpos_blk  ) {
    const bf16* P = (const bf16*)(kws() + WS_RP); bf16* Y = (bf16*)(kws() + WS_XN);
    const int c15 = F.lane & 15, g = F.lane >> 4;
    const int hq = kv * 4 + (F.wave >> 1), rbase = qrow0 + 64 * (F.wave & 1);
    bf16x8 qf[4][1][2];
#pragma unroll
    for (int qs = 0; qs < 4; ++qs)
#pragma unroll
        for (int kx = 0; kx < 2; ++kx) qf[qs][0][kx] = *(const bf16x8*)(P + (size_t)(rbase + 16 * qs + c15) * INP + C_GQQ + hq * 64 + 32 * kx + 8 * g);
    KeyStream ks{MLAT + b * CTXL, 0, 0, 0}; int qpos0 = 0;
    if (qpos_blk >= 0) { const int lo = qpos_blk > 0 ? (qpos_blk - 1) * 128 : 0, hi = qpos_blk < 31 ? (qpos_blk + 2) * 128 : SEQ;
        ks.nloc = (hi - lo) / 64; ks.loc_row0 = b * SEQ + lo; ks.loc_pos0 = lo; qpos0 = qpos_blk * 128 + 64 * (F.wave & 1); }
    f32x4 o[4][1][4]; float m[4][1], ls[4][1];
    attn_core<1, 64, 4, true>(F, P, C_GQK + kv * 64, C_GQV + kv * 64, ks, qf, qpos0, o, m, ls);
    const float sink2 = kin(I_GQSINK)[l * 8 + hq] * LOG2E;
#pragma unroll
    for (int qs = 0; qs < 4; ++qs) {
        float t = ls[qs][0]; t += __shfl_xor(t, 16); t += __shfl_xor(t, 32);
        const float mf = fmaxf(m[qs][0], sink2), e = __builtin_amdgcn_exp2f(m[qs][0] - mf), den = t * e + __builtin_amdgcn_exp2f(sink2 - mf), scl = e / den;
        bf16* yp = Y + (size_t)(rbase + 16 * qs + c15) * D + 512 + hq * 64 + 4 * g;
#pragma unroll
        for (int dt = 0; dt < 4; ++dt) { const f32x4 v = o[qs][0][dt] * scl; v2u w; w.x = pk2h(v[0], v[1]); w.y = pk2h(v[2], v[3]); *(v2u*)(yp + 16 * dt) = w; }
    }
}
__device__ __forceinline__ void phase_queue(const Args& A, Frame& F, int l) {
    gu32* head = (gu32*)(kws() + WS_CTL) + CW_QUEUE + 64 * l;
    constexpr int DF_BIG = 208;
    const int total = 64 + DF_BIG + 2 * (256 - DF_BIG) + 256 + (l == 0 ? 48 + WI_FILL : 0);
    volatile LAS int* slot = (volatile LAS int*)(F.lds + MISC_OFF) + 16;
    for (;;) {
        asm volatile("" : "+v"(F.tid), "+v"(F.lane));
        __syncthreads();
        if (F.tid == 0) *slot = (int)__hip_atomic_fetch_add(head, 1u, __ATOMIC_RELAXED, __HIP_MEMORY_SCOPE_AGENT);
        __syncthreads();
        int u = __builtin_amdgcn_readfirstlane(*slot);
        if (u >= total) break;
        if (u < 64) { rwkv_chunk_unit(A, F, l, u >> 1, u & 1); continue; }
        u -= 64;
        if (u < DF_BIG) { const int b = u >> 6, h = (u >> 4) & 3, qb = u & 15; diff_unit<2>(A, F, l, b, h, b * SEQ + qb * 256, SEQ / 64); continue; }
        if (u < DF_BIG + 2 * (256 - DF_BIG)) { const int v = 2 * DF_BIG + (u - DF_BIG), b = v >> 7, h = (v >> 5) & 3, qh = v & 31; diff_unit<1>(A, F, l, b, h, b * SEQ + qh * 128, SEQ / 64); continue; }
        u -= DF_BIG + 2 * (256 - DF_BIG) - 512;
        u -= 512;
        if (u < 256) { const int b = u >> 6, kv = (u >> 5) & 1, nb = u & 31; gq_unit(A, F, l, b, kv, b * SEQ + nb * 128, nb); continue; }
        u -= 256;
        if (u < 32) { const int b = u >> 3, h = (u >> 1) & 3, hf = u & 1; diff_unit<1>(A, F, l, b, h, MLAT + b * CTXL + hf * 128, 0); continue; }
        u -= 32;
        if (u < 16) { const int b = u >> 2, kv = (u >> 1) & 1, hf = u & 1; gq_unit(A, F, l, b, kv, MLAT + b * CTXL + hf * 128, -1); continue; }
        u -= 16;
        { LAS float* scr = (LAS float*)(F.lds + F.wave * 16384);
          for (int k = 0; k < 16; ++k) { const int it = WI_IN + u * 128 + F.wave * 16 + k; if (it < 2 * WI_LAYER) weight_item(it, scr, F.lane); } }
    }
}

constexpr int N_PHASES = (MK_FUSE == 3) ? 18 : 20;
}

__global__ void __launch_bounds__(mk::NTHR, 2) mega_fwd(mk::Args A) {
    using namespace mk;
    extern __shared__ __attribute__((aligned(16))) unsigned char lds_raw[];
    Frame F;
    F.lds = (LAS unsigned char*)lds_raw;
    F.tid = threadIdx.x; asm volatile("" : "+v"(F.tid)); F.lane = F.tid & 63; F.wave = __builtin_amdgcn_readfirstlane(F.tid >> 6);
    F.G = gridDim.x; F.bid = blockIdx.x;
    for (int u = F.tid; u < (LDS_BYTES - LDSCTL_OFF) / 4; u += NTHR) ((LAS unsigned*)(F.lds + LDSCTL_OFF))[u] = 0u;
    __syncthreads();
    gu32* ctl = (gu32*)(kws() + WS_CTL);
    XcdBarrier bar; bar.bar = (unsigned*)(ctl + CW_BAR); bar.x = 0; bar.st = nullptr; bar.tid = F.tid;
    const bool multi = (A.ph_hi - A.ph_lo) > 1;
    if (multi) bar = xcd_barrier_post((unsigned*)(ctl + CW_BAR), (volatile LAS unsigned*)(F.lds + MISC_OFF) + 8, F.tid);

    for (int ph = A.ph_lo, rep = 0; ph < A.ph_hi;) {
        { int t_ = F.tid, l_ = F.lane, w_ = F.wave, g_ = F.G, b_ = F.bid; unsigned p_ = (unsigned)(uintptr_t)F.lds;
          w_ = __builtin_amdgcn_readfirstlane(w_); g_ = __builtin_amdgcn_readfirstlane(g_); b_ = __builtin_amdgcn_readfirstlane(b_); p_ = __builtin_amdgcn_readfirstlane(p_);
          asm volatile("" : "+v"(t_), "+v"(l_)); asm volatile("" : "+s"(w_), "+s"(g_), "+s"(b_), "+s"(p_));
          F.tid = t_; F.lane = l_; F.wave = w_; F.G = g_; F.bid = b_; F.lds = (LAS unsigned char*)(uintptr_t)p_; }
        int kind = 0, l = 0, hf = 0;
        if (ph == 1) kind = 1;
        else if (ph > 1 && ph < 11) { l = 0; const int r = ph - 2; kind = r < 6 ? 2 + r : (r == 6 ? 8 : (r == 7 ? 10 : 11)); }
        else if (ph >= 11) { l = 1; const int r = ph - 11; kind = r < 5 ? 2 + r : (r == 5 ? 8 : 10); }
        const int nrows = (l == 0) ? MALL : MLAT;
        const int r0 = 0, r1 = nrows; (void)hf;
        const bool is_gemm = (kind == 2 || kind == 6 || kind == 8 || kind == 10);
        if (is_gemm) { if (MK_KINDS & 0x544) {
          const int nparts = ((kind == 6 || kind == 10) && l == 0) ? 2 : 1;
          for (int part = 0; part < nparts; ++part) {
            pg8::Gemm g; EpiMulti E; E.tab = (const float*)(kws() + WS_TAB); E.ob = nullptr; E.of = nullptr; E.ld = 0; E.mode = 0; E.cw = nullptr; E.cb = nullptr; E.nrows = 0; E.ldsx = 0u; E.xin = nullptr; E.xout = nullptr; E.xn = nullptr; E.gA = E.gaA = E.gB = E.scB = E.shB = nullptr; E.xb0 = E.xb1 = nullptr; E.cnt0 = E.cnt1 = nullptr; E.two = 0;
            if (kind == 2) { g = pg8::Gemm{(const pg8::bf16_t*)(kws() + WS_XN), (const pg8::bf16_t*)(kws() + WS_WIN + l * WIN_BYTES), MALL, INP, D, 256, D, 0}; E.mode = 0; E.ob = (bf16*)(kws() + WS_RP); E.ld = INP; }
            else if (kind == 6 && part == 0 && !(MK_FUSE & 1)) { g = pg8::Gemm{(const pg8::bf16_t*)(kws() + WS_XN), (const pg8::bf16_t*)(kws() + WS_WOUT + l * WOUT_BYTES), MLAT, D, D, 256, D, 0}; E.mode = 2; E.ob = (bf16*)(kws() + WS_RP); E.ld = D; }
            else if (kind == 6 && part == 0) { g = pg8::Gemm{(const pg8::bf16_t*)(kws() + WS_XN), (const pg8::bf16_t*)(kws() + WS_WOUT + l * WOUT_BYTES), MLAT, D, D, 256, D, 0};
                E.mode = 5; E.xin = l == 0 ? kin(I_X) : kout(); E.xout = kout(); E.xn = (bf16*)(kws() + WS_XN); E.gA = normg_vec(A, l, 1); E.gaA = mod_vec(A, l, 0, 2); E.two = 1; E.gB = normg_vec(A, l, 2); E.scB = mod_vec(A, l, 0, 4); E.shB = mod_vec(A, l, 0, 3);
                E.xb0 = (float*)(kws() + WS_XB) + (size_t)((l * 2 + 0) * 2 + 0) * MLAT * 4; E.xb1 = (float*)(kws() + WS_XB) + (size_t)((l * 2 + 0) * 2 + 1) * MLAT * 4;
                E.cnt0 = (gu32*)(kws() + WS_CTL) + CW_PST + ((l * 2 + 0) * 2 + 0) * 4096; E.cnt1 = (gu32*)(kws() + WS_CTL) + CW_PST + ((l * 2 + 0) * 2 + 1) * 4096; }
            else if (kind == 6) { g = pg8::Gemm{(const pg8::bf16_t*)(kws() + WS_XN) + (size_t)MLAT * D, (const pg8::bf16_t*)(kws() + WS_WOUT + l * WOUT_BYTES), 256 * 4 * 4, D, 256, 256, D, 4}; E.mode = 2; E.ob = (bf16*)(kws() + WS_SLO); E.ld = D; }
            else if (kind == 8) { const int nmu = (nrows + 253) / 254;
                g = pg8::Gemm{(const pg8::bf16_t*)(kws() + WS_XN) - D, (const pg8::bf16_t*)(kws() + WS_WGU + l * WGU_BYTES), 256 * nmu, NGU, D, 254, D, 0};
                E.mode = 3; E.ob = (bf16*)(kws() + WS_ACT); E.ld = DFF; E.cw = kin(I_FFCW) + (size_t)l * 3 * DFF; E.cb = kin(I_FFCB) + (size_t)l * DFF; E.nrows = nrows; E.ldsx = (unsigned)(uintptr_t)F.lds + 131072u; }
            else if (part == 0 && !(MK_FUSE & 2)) { g = pg8::Gemm{(const pg8::bf16_t*)(kws() + WS_ACT), (const pg8::bf16_t*)(kws() + WS_WD + l * WD_BYTES), MLAT, D, DFF, 256, DFF, 0}; E.mode = 2; E.ob = (bf16*)(kws() + WS_FP); E.ld = D; }
            else if (part == 0) { g = pg8::Gemm{(const pg8::bf16_t*)(kws() + WS_ACT), (const pg8::bf16_t*)(kws() + WS_WD + l * WD_BYTES), MLAT, D, DFF, 256, DFF, 0};
                E.mode = 6; E.xin = kout(); E.xout = kout(); E.xn = (bf16*)(kws() + WS_XN); E.gA = normg_vec(A, l, 3); E.gaA = mod_vec(A, l, 0, 5); E.two = l == 0; E.gB = normg_vec(A, 1, 0); E.scB = mod_vec(A, 1, 0, 1); E.shB = mod_vec(A, 1, 0, 0);
                E.xb0 = (float*)(kws() + WS_XB) + (size_t)((l * 2 + 1) * 2 + 0) * MLAT * 4; E.xb1 = (float*)(kws() + WS_XB) + (size_t)((l * 2 + 1) * 2 + 1) * MLAT * 4;
                E.cnt0 = (gu32*)(kws() + WS_CTL) + CW_PST + ((l * 2 + 1) * 2 + 0) * 4096; E.cnt1 = (gu32*)(kws() + WS_CTL) + CW_PST + ((l * 2 + 1) * 2 + 1) * 4096; }
            else { g = pg8::Gemm{(const pg8::bf16_t*)(kws() + WS_ACT) + (size_t)MLAT * DFF, (const pg8::bf16_t*)(kws() + WS_WD + l * WD_BYTES), 256 * 4 * 11, D, 256, 256, DFF, 4}; E.mode = 2; E.ob = (bf16*)(kws() + WS_SLD); E.ld = D; }
            pg8::StaticOrder S; S.init(g.M, g.N, F.G, F.bid);
            pg8::gemm_phase<EpiMulti, pg8::StaticOrder, true, true>(F.lds, g, S, E, F.tid);
          }
        } } else {
            switch (kind) {
                case 0: if ((MK_KINDS >> 0) & 1) { p0_prologue(A, F); } break;
                case 1: if (((MK_KINDS >> 1) & 1) && l == 0) phase_prep(A, F); break;
                case 3: if ((MK_KINDS >> 3) & 1) rwkv_features(A, F, l); break;
                case 4: if ((MK_KINDS >> 4) & 1) phase_queue(A, F, l); break;
                case 5: if ((MK_KINDS >> 5) & 1) rwkv_readout(A, F, l); break;
                case 7: if ((MK_KINDS >> 7) & 1) phase_e1(A, F, l); break;
                case 9: if ((MK_KINDS >> 9) & 1) phase_act(A, F, l, r0, r1); break;
                case 11: if ((MK_KINDS >> 11) & 1) phase_e2(A, F, l, r0, r1); break;
                default: break;
            }
        }
        const bool again = (rep == 0) && ((MK_REPEAT >> kind) & 1);
        if (ph + 1 < A.ph_hi || again) { bar.bar = (unsigned*)((gu32*)(kws() + WS_CTL) + CW_BAR); bar.tid = F.tid; xcd_barrier(bar); }
        if (again) rep = 1; else { rep = 0; ++ph; }
    }
}

extern "C" void kernel_launch(void* const* d_in, const int* in_sizes, int n_in, void* d_out, int out_size, void* d_ws, size_t ws_size, hipStream_t stream) {
    using namespace mk;
    static int grid = 0;
    if (grid == 0) {
        if (n_in != N_IN || out_size != MLAT * D || ws_size < WS_END) { fprintf(stderr, "kernel_launch: unexpected shapes (n_in %d, out %d, ws %zu); nothing launched\n", n_in, out_size, ws_size); grid = -1; return; }
        int dev = 0, cus = 0, per_cu = 0;
        if (hipGetDevice(&dev) != hipSuccess || hipDeviceGetAttribute(&cus, hipDeviceAttributeMultiprocessorCount, dev) != hipSuccess) { grid = -1; return; }
        if (hipFuncSetAttribute((const void*)mega_fwd, hipFuncAttributeMaxDynamicSharedMemorySize, LDS_BYTES) != hipSuccess) { fprintf(stderr, "kernel_launch: hipFuncSetAttribute failed\n"); grid = -1; return; }
        if (hipOccupancyMaxActiveBlocksPerMultiprocessor(&per_cu, (const void*)mega_fwd, NTHR, LDS_BYTES) != hipSuccess || per_cu < 1) { fprintf(stderr, "kernel_launch: occupancy query says %d blocks/CU\n", per_cu); per_cu = 1; }
        (void)hipGetLastError();
        grid = cus;
    }
    if (grid < 0) return;
    (void)hipMemsetAsync((char*)d_ws + WS_CTL, 0, CTL_ZERO_BYTES, stream);
    Args a{};
    for (int i = 0; i < N_IN; ++i) a.in[i] = (const float*)d_in[i];
    a.out = (float*)d_out; a.ws = (unsigned char*)d_ws;
#if MK_PER_PHASE
    for (int ph = 0; ph < N_PHASES; ++ph) { a.ph_lo = ph; a.ph_hi = ph + 1; hipLaunchKernelGGL(mega_fwd, dim3(grid), dim3(NTHR), LDS_BYTES, stream, a); }
#else
    a.ph_lo = 0; a.ph_hi = N_PHASES;
    void* args[] = {&a};
    hipError_t e = hipLaunchCooperativeKernel((const void*)mega_fwd, dim3(grid), dim3(NTHR), args, LDS_BYTES, stream);
    if (e != hipSuccess) fprintf(stderr, "kernel_launch: cooperative launch failed: %s (grid %d)\n", hipGetErrorString(e), grid);
#endif
}
```

```cpp
#include <hip/hip_runtime.h>
#include <hip/hip_cooperative_groups.h>
#include <cstdio>
#include <cstdint>
#ifndef MK_PER_PHASE
#define MK_PER_PHASE 0
#endif
#ifndef MK_KINDS
#define MK_KINDS 0xFFF
#endif
#ifndef MK_REPEAT
#define MK_REPEAT 0
#endif
#ifndef MK_RWDUP
#define MK_RWDUP 0
#endif
#ifndef MK_AMP
#define MK_AMP 0
#endif
#ifndef MK_FUSE
#define MK_FUSE 3
#endif
#ifdef MK_DBGDRAIN
#define MK_DBGD 1
#else
#define MK_DBGD 0
#endif
namespace pg8 {
#define PG8_LAS __attribute__((address_space(3)))
typedef unsigned short bf16_t;
typedef short bf16x8 __attribute__((ext_vector_type(8)));
typedef float f32x4 __attribute__((ext_vector_type(4)));
typedef unsigned u32x4 __attribute__((ext_vector_type(4)));
constexpr int BM = 256, BK = 64, HALF = 128, HTB = HALF * BK * 2  , STAGE_BYTES = 8 * HTB, NXCD = 8, WGM = 8;

__host__ __device__ __forceinline__ int lds_byte(int r, int c) { const int st = (r >> 4) * 2 + (c >> 5), rr = r & 15, cc = c & 31, ob = rr * 64 + cc * 2; return st * 1024 + (ob ^ (((ob >> 9) & 1) << 5)); }
__host__ __device__ __forceinline__ void stage_rc(int b, int& R, int& C) { const int st = b / 1024, sb = b % 1024, swz = sb ^ (((sb >> 9) & 1) << 5); R = (st >> 1) * 16 + swz / 64; C = (st & 1) * 32 + (swz % 64) / 2; }
__host__ __device__ __forceinline__ int perm32(int rho) { const int n = rho >> 4, i = rho & 15; return 8 * (i >> 2) + 4 * n + (i & 3); }

__device__ __forceinline__ float pg8_zero() { float z = 0.f; asm volatile("" : "+v"(z)); return z; }
struct Unit { int pm, pn; };
struct Gemm { const bf16_t* A; const bf16_t* Bt; int M, N, K; int trows; int ld, mt; };

struct StaticOrder {
    int nM, nN, nwg, G, c;
    __host__ __device__ void init(int M, int N, int G_, int c_) { nM = M / BM; nN = N / BM; nwg = nM * nN; G = G_; c = c_; }
    __host__ __device__ bool next(int i, Unit& u) const {
        const long L = (long)i * G + c; if (L >= nwg) return false;
        int wgid = (int)L; { const int q = nwg / NXCD, r = nwg % NXCD, xcd = wgid % NXCD, off = wgid / NXCD; wgid = (xcd < r ? xcd * (q + 1) : r * (q + 1) + (xcd - r) * q) + off; }
        const int nig = WGM * nN, gid = wgid / nig, fm = gid * WGM, gsz = (nM - fm) < WGM ? (nM - fm) : WGM;
        u.pm = fm + ((wgid % nig) % gsz); u.pn = (wgid % nig) / gsz; return true;
    }
    __device__ __forceinline__ void a_ready(const Unit&) const {}
    __device__ __forceinline__ void done(const Unit&) const {}
};

__device__ __forceinline__ unsigned cvt_pk_bf16(float lo, float hi) { unsigned r; asm volatile("v_cvt_pk_bf16_f32 %0, %1, %2" : "=v"(r) : "v"(lo), "v"(hi)); return r; }
typedef float f32x2 __attribute__((ext_vector_type(2)));
__device__ __forceinline__ f32x2 gelu_pk(f32x2 v) {
    const f32x2 av = __builtin_elementwise_abs(v), d = av * 0.2316418882f + 1.0f;
    f32x2 t; t.x = __builtin_amdgcn_rcpf(d.x); t.y = __builtin_amdgcn_rcpf(d.y);
    f32x2 q = t * 0.5307027145f + (-0.7265760135f); q = q * t + 0.7107068705f; q = q * t + (-0.142248368f); q = q * t + 0.127414796f; q = q * t;
    const f32x2 s = (v * v) * (-0.72134752044f);
    f32x2 e; e.x = __builtin_amdgcn_exp2f(s.x); e.y = __builtin_amdgcn_exp2f(s.y);
    const f32x2 m = v * (q * e), r = v - m;
    f32x2 o; o.x = v.x < 0.f ? m.x : r.x; o.y = v.y < 0.f ? m.y : r.y; return o;
}

template <int ACT  > struct EpiBf16 {
    static constexpr bool PERM = true, AFTER_DRAIN = false; static_assert(ACT == 0 || ACT == 1, "EpiBf16: ACT is 0 (none) or 1 (gelu_pk)");
    bf16_t* O; int ldc; const float* bias; int split_cols; size_t split_stride; float scale0;
    __device__ __forceinline__ void operator()(const f32x4 (&acc)[2][2][4][2], const Unit& u, int wr, int wc, int fr, int fq) const {
        const int row0 = u.pm * BM + wr * 64 + fr; int colt = u.pn * BM; bf16_t* base = O;
        float sc = 1.f; if (split_cols) { const int t = colt / split_cols; base += (size_t)t * split_stride; colt -= t * split_cols; if (t == 0) sc = scale0; }
        const int col0 = colt + wc * 32 + 8 * fq, bcol0 = u.pn * BM + wc * 32 + 8 * fq;
        f32x4 bv[2][2];
#pragma unroll
        for (int bj = 0; bj < 2; ++bj)
#pragma unroll
            for (int n = 0; n < 2; ++n) bv[bj][n] = bias ? *(const f32x4*)(bias + bcol0 + bj * HALF + 4 * n) : (f32x4){0.f, 0.f, 0.f, 0.f};
#pragma unroll
        for (int ai = 0; ai < 2; ++ai)
#pragma unroll
            for (int m = 0; m < 4; ++m) { bf16_t* rowp = base + (size_t)(row0 + ai * HALF + m * 16) * ldc + col0;
#pragma unroll
                for (int bj = 0; bj < 2; ++bj) { f32x4 v0 = acc[ai][bj][m][0] + bv[bj][0], v1 = acc[ai][bj][m][1] + bv[bj][1];
                    if (ACT == 1) { f32x2 a = gelu_pk((f32x2){v0[0], v0[1]}), b = gelu_pk((f32x2){v0[2], v0[3]}), c = gelu_pk((f32x2){v1[0], v1[1]}), d = gelu_pk((f32x2){v1[2], v1[3]});
                        v0 = (f32x4){a.x, a.y, b.x, b.y}; v1 = (f32x4){c.x, c.y, d.x, d.y}; }
                    v0 = v0 * sc; v1 = v1 * sc; u32x4 w; w.x = cvt_pk_bf16(v0[0], v0[1]); w.y = cvt_pk_bf16(v0[2], v0[3]); w.z = cvt_pk_bf16(v1[0], v1[1]); w.w = cvt_pk_bf16(v1[2], v1[3]);
                    *(u32x4*)(rowp + bj * HALF) = w; } }
    }
};

template <class Epi, class Sched, bool ALIGN_EPI = false, bool SP2 = false>
__device__ __forceinline__ void gemm_phase(PG8_LAS unsigned char* lds, const Gemm g, const Sched& S, const Epi& E, int tid_in) {
    int tid_ = tid_in; asm volatile("" : "+v"(tid_));
    const int tid = tid_, wid = __builtin_amdgcn_readfirstlane(tid >> 6), lane = tid & 63, wr = wid >> 2, wc = wid & 3, fr = lane & 15, fq = lane >> 4;
    const int K = g.ld, nt = g.K / BK;
    unsigned voffA[2], voffB[2];
#pragma unroll
    for (int i = 0; i < 2; ++i) { int R, C; stage_rc(tid * 16 + i * 8192, R, C); const int Rb = Epi::PERM ? ((R & ~31) + perm32(R & 31)) : R;
        voffA[i] = (unsigned)(R * K + C) * 2u; voffB[i] = (unsigned)(Rb * K + C) * 2u; }
    const size_t kstep = (size_t)(BK * 2);
    const size_t hstep = (size_t)HALF * K * 2;
    const size_t tstep = 2 * hstep;
    const size_t tstepA = (size_t)g.trows * K * 2;
    const unsigned ldsw = (unsigned)wid * 1024u;
    const int aoff = lds_byte(wr * 64 + fr, fq * 8), boff = lds_byte(wc * 32 + fr, fq * 8);
#define PG8_SA(b, h) (((b) * 2 + (h)) * HTB)
#define PG8_SB(b, h) ((4 + (b) * 2 + (h)) * HTB)
#define PG8_STAGE(bufoff, gbase, voff) do { _Pragma("unroll") for (int _i = 0; _i < 2; ++_i) \
        __builtin_amdgcn_global_load_lds((const unsigned*)((const char*)(gbase) + (voff)[_i]), (PG8_LAS unsigned*)(lds + (bufoff) + ldsw + _i * 8192), 16, 0, 0); } while (0)
#define PG8_LDA(dst, b, h) do { _Pragma("unroll") for (int m = 0; m < 4; ++m) _Pragma("unroll") for (int k = 0; k < 2; ++k) dst[m][k] = *(const PG8_LAS bf16x8*)(lds + PG8_SA(b, h) + aoff + m * 2048 + k * 1024); } while (0)
#define PG8_LDB(dst, b, h) do { _Pragma("unroll") for (int n = 0; n < 2; ++n) _Pragma("unroll") for (int k = 0; k < 2; ++k) dst[n][k] = *(const PG8_LAS bf16x8*)(lds + PG8_SB(b, h) + boff + n * 2048 + k * 1024); } while (0)
#define PG8_MMA(ai, bj, At, Bt) do { __builtin_amdgcn_s_setprio(1); _Pragma("unroll") for (int m = 0; m < 4; ++m) _Pragma("unroll") for (int n = 0; n < 2; ++n) _Pragma("unroll") for (int k = 0; k < 2; ++k) \
        acc[ai][bj][m][n] = __builtin_amdgcn_mfma_f32_16x16x32_bf16(Bt[n][k], At[m][k], acc[ai][bj][m][n], 0, 0, 0); __builtin_amdgcn_s_setprio(0); } while (0)
#define PG8_WAIT_V(n) asm volatile("s_waitcnt vmcnt(" #n ")" ::: "memory")
#define PG8_WAIT_L(n) asm volatile("s_waitcnt lgkmcnt(" #n ")" ::: "memory")
#define PG8_BAR __builtin_amdgcn_s_barrier()
#define PG8_SCHED __builtin_amdgcn_sched_barrier(0)
    Unit cur, nxt; int ui = 0;
    if (!S.next(0, cur)) return;
    f32x4 acc[2][2][4][2];
#pragma unroll
    for (int a = 0; a < 2; ++a)
#pragma unroll
        for (int b = 0; b < 2; ++b)
#pragma unroll
            for (int m = 0; m < 4; ++m)
#pragma unroll
                for (int n = 0; n < 2; ++n) acc[a][b][m][n] = (f32x4){pg8_zero(), pg8_zero(), pg8_zero(), pg8_zero()};
    bf16x8 At[4][2], B0[2][2], B1[2][2];
#define PG8_BASEA(un) ((const char*)g.A + (size_t)(g.mt ? (un).pm % g.mt : (un).pm) * tstepA + (g.mt ? (size_t)((un).pm / g.mt) * g.K * 2 : 0))
#define PG8_BASEB(un) ((const char*)g.Bt + (size_t)(un).pn * tstep + (g.mt ? (size_t)((un).pm / g.mt) * g.K * 2 : 0))
    const char* cA = PG8_BASEA(cur); const char* cB = PG8_BASEB(cur);
    S.a_ready(cur);
    if constexpr (SP2) {
        PG8_STAGE(PG8_SB(0, 0), cB, voffB); PG8_STAGE(PG8_SB(0, 1), cB + hstep, voffB); PG8_STAGE(PG8_SA(0, 0), cA, voffA); PG8_STAGE(PG8_SA(0, 1), cA + hstep, voffA);
        if (wr == 1) PG8_BAR;
        PG8_WAIT_V(2); PG8_BAR;
        PG8_STAGE(PG8_SB(1, 0), cB + kstep, voffB); PG8_STAGE(PG8_SA(1, 0), cA + kstep, voffA); PG8_STAGE(PG8_SB(1, 1), cB + hstep + kstep, voffB);
        PG8_WAIT_V(6); PG8_BAR;
    } else {
        PG8_STAGE(PG8_SB(0, 0), cB, voffB); PG8_STAGE(PG8_SA(0, 0), cA, voffA); PG8_STAGE(PG8_SB(0, 1), cB + hstep, voffB); PG8_STAGE(PG8_SA(0, 1), cA + hstep, voffA);
        if (wr == 1) PG8_BAR;
        PG8_WAIT_V(4); PG8_BAR;
        PG8_STAGE(PG8_SB(1, 0), cB + kstep, voffB); PG8_STAGE(PG8_SA(1, 0), cA + kstep, voffA); PG8_STAGE(PG8_SB(1, 1), cB + hstep + kstep, voffB);
        PG8_WAIT_V(6); PG8_BAR;
    }
    for (;;) {
        const bool has_next = S.next(ui + 1, nxt);
        const char* nA = has_next ? PG8_BASEA(nxt) : cA; const char* nB = has_next ? PG8_BASEB(nxt) : cB;
        for (int t = 0; t < nt; t += 2) {
            const bool last = (t == nt - 2);
            const char* a1 = cA + (size_t)(t + 1) * kstep;
            const char* a2 = last ? nA : cA + (size_t)(t + 2) * kstep; const char* b2 = last ? nB : cB + (size_t)(t + 2) * kstep;
            const char* a3 = a2 + kstep; const char* b3 = b2 + kstep;
            if (last && has_next) S.a_ready(nxt);
            if constexpr (SP2) {
            PG8_LDB(B0, 0, 0); PG8_LDB(B1, 0, 1); PG8_SCHED; PG8_LDA(At, 0, 0); PG8_STAGE(PG8_SA(1, 1), a1 + hstep, voffA);
            PG8_WAIT_V(8); PG8_WAIT_L(0); PG8_BAR; PG8_MMA(0, 0, At, B0); PG8_MMA(0, 1, At, B1); PG8_BAR; PG8_SCHED;
            PG8_LDA(At, 0, 1); PG8_STAGE(PG8_SB(0, 0), b2, voffB); PG8_STAGE(PG8_SB(0, 1), b2 + hstep, voffB); PG8_STAGE(PG8_SA(0, 0), a2, voffA);
            PG8_WAIT_V(8); PG8_WAIT_L(0); PG8_BAR; PG8_MMA(1, 0, At, B0); PG8_MMA(1, 1, At, B1); PG8_BAR; PG8_SCHED;
            PG8_LDB(B0, 1, 0); PG8_LDB(B1, 1, 1); PG8_SCHED; PG8_LDA(At, 1, 0); PG8_STAGE(PG8_SA(0, 1), a2 + hstep, voffA);
            PG8_WAIT_V(8); PG8_WAIT_L(0); PG8_BAR; PG8_MMA(0, 0, At, B0); PG8_MMA(0, 1, At, B1); PG8_BAR; PG8_SCHED;
            PG8_LDA(At, 1, 1); PG8_STAGE(PG8_SB(1, 0), b3, voffB); PG8_STAGE(PG8_SB(1, 1), b3 + hstep, voffB); PG8_STAGE(PG8_SA(1, 0), a3, voffA);
            PG8_WAIT_V(8); PG8_WAIT_L(0); PG8_BAR; PG8_MMA(1, 0, At, B0); PG8_MMA(1, 1, At, B1); PG8_BAR; PG8_SCHED;
            } else {
            PG8_LDB(B0, 0, 0); PG8_SCHED; PG8_LDA(At, 0, 0); PG8_STAGE(PG8_SA(1, 1), a1 + hstep, voffA);
            PG8_WAIT_L(8); PG8_BAR; PG8_WAIT_L(0); PG8_MMA(0, 0, At, B0); PG8_BAR; PG8_SCHED;
            PG8_LDB(B1, 0, 1); PG8_STAGE(PG8_SB(0, 0), b2, voffB);
            PG8_BAR; PG8_WAIT_L(0); PG8_MMA(0, 1, At, B1); PG8_BAR;
            PG8_LDA(At, 0, 1); PG8_STAGE(PG8_SA(0, 0), a2, voffA);
            PG8_BAR; PG8_WAIT_L(0); PG8_MMA(1, 0, At, B0); PG8_BAR; PG8_SCHED;
            PG8_STAGE(PG8_SB(0, 1), b2 + hstep, voffB);
            PG8_WAIT_V(6); PG8_BAR; PG8_MMA(1, 1, At, B1); PG8_BAR;
            PG8_LDB(B0, 1, 0); PG8_SCHED; PG8_LDA(At, 1, 0); PG8_STAGE(PG8_SA(0, 1), a2 + hstep, voffA);
            PG8_WAIT_L(8); PG8_BAR; PG8_WAIT_L(0); PG8_MMA(0, 0, At, B0); PG8_BAR; PG8_SCHED;
            PG8_LDB(B1, 1, 1); PG8_STAGE(PG8_SB(1, 0), b3, voffB);
            PG8_BAR; PG8_WAIT_L(0); PG8_MMA(0, 1, At, B1); PG8_BAR;
            PG8_LDA(At, 1, 1); PG8_STAGE(PG8_SA(1, 0), a3, voffA);
            PG8_BAR; PG8_WAIT_L(0); PG8_MMA(1, 0, At, B0); PG8_BAR; PG8_SCHED;
            PG8_STAGE(PG8_SB(1, 1), b3 + hstep, voffB);
            PG8_WAIT_V(6); PG8_BAR; PG8_MMA(1, 1, At, B1); PG8_BAR;
            }
        }
        if constexpr (ALIGN_EPI) { if (wr == 0) PG8_BAR; }
        if (!E.drain()) { E(acc, cur, wr, wc, fr, fq); S.done(cur); }
        if (!has_next) break;
#pragma unroll
        for (int a = 0; a < 2; ++a)
#pragma unroll
            for (int b = 0; b < 2; ++b)
#pragma unroll
                for (int m = 0; m < 4; ++m)
#pragma unroll
                    for (int n = 0; n < 2; ++n) acc[a][b][m][n] = (f32x4){pg8_zero(), pg8_zero(), pg8_zero(), pg8_zero()};
        cur = nxt; cA = nA; cB = nB; ++ui;
        if constexpr (ALIGN_EPI) { if (wr == 1) PG8_BAR; }
    }
    PG8_WAIT_V(0);
    if constexpr (!ALIGN_EPI) { if (wr == 0) PG8_BAR; }
    PG8_BAR;
    if (E.drain()) { E.fused(acc, cur, wr, wc, fr, fq, lds, wid, lane); S.done(cur); }
#undef PG8_BASEA
#undef PG8_BASEB
#undef PG8_SA
#undef PG8_SB
#undef PG8_STAGE
#undef PG8_LDA
#undef PG8_LDB
#undef PG8_MMA
#undef PG8_WAIT_V
#undef PG8_WAIT_L
#undef PG8_BAR
#undef PG8_SCHED
}
}
#define GAS __attribute__((address_space(1)))
#define LAS __attribute__((address_space(3)))
typedef unsigned short bf16;
typedef unsigned v4u __attribute__((ext_vector_type(4)));
typedef float f32x4 __attribute__((ext_vector_type(4)));
typedef short bf16x8 __attribute__((ext_vector_type(8)));
typedef GAS unsigned gu32;
typedef GAS unsigned long long gu64;
#define RLX_AGENT __ATOMIC_RELAXED, __HIP_MEMORY_SCOPE_AGENT
#define LDS_WAIT() asm volatile("s_waitcnt lgkmcnt(0)" ::: "memory")
#define VM_WAIT() asm volatile("s_waitcnt vmcnt(0)" ::: "memory")
__device__ __forceinline__ unsigned long long rt() { return __builtin_amdgcn_s_memrealtime(); }
__device__ __forceinline__ unsigned f2bf(float f) { unsigned u = __builtin_bit_cast(unsigned, f); return (u + 0x7fffu + ((u >> 16) & 1u)) >> 16; }
__device__ __forceinline__ unsigned pk2(float lo, float hi) { return f2bf(lo) | (f2bf(hi) << 16); }
#define XB_TMO      128
#define XB_XCNT(j)  (256  + 64 * (j))
#define XB_XSUB(j)  (1280 + 64 * (j))
#define XB_XGEN(j)  (2304 + 64 * (j))
#define XB_TOP      3328
#define XB_TOPGEN   3392
#define XCD_BAR_WORDS 3456
#define XB_SPIN_CAP (1u << 18)

__device__ __forceinline__ unsigned xb_ld(unsigned* p)              { return __hip_atomic_load(p, __ATOMIC_RELAXED, __HIP_MEMORY_SCOPE_AGENT); }
__device__ __forceinline__ unsigned xb_add(unsigned* p, unsigned v) { return __hip_atomic_fetch_add(p, v, __ATOMIC_RELAXED, __HIP_MEMORY_SCOPE_AGENT); }
__device__ __forceinline__ unsigned xb_xcc_id() { return (unsigned)__builtin_amdgcn_s_getreg((3 << 11) | 20) & 0xFu; }
#define XB_SPIN(cond, bar) do { unsigned _sp = 0; while (cond) { __builtin_amdgcn_s_sleep(1); \
    if ((++_sp & 255u) == 0u) { if (xb_ld(&(bar)[XB_TMO])) break; if (_sp > XB_SPIN_CAP) { atomicAdd(&(bar)[XB_TMO], 1u); break; } } } } while (0)

struct XcdBarrier {
    int tid; unsigned* bar; unsigned x;
    volatile LAS unsigned* st;
};

__device__ __forceinline__ XcdBarrier xcd_barrier_post(unsigned* bar, volatile LAS unsigned* st, int tid) {
    XcdBarrier b; b.bar = bar; b.x = xb_xcc_id(); b.st = st; b.tid = tid;
    if (tid == 0) (void)xb_add(&bar[XB_XCNT(b.x)], 1u);
    return b;
}
__device__ __forceinline__ void xcd_barrier_complete(unsigned* bar, unsigned x, unsigned& nloc, unsigned& nx) {
    const unsigned G = gridDim.x * gridDim.y * gridDim.z;
    unsigned sum, cnt, mine, sp = 0u;
    for (;;) {
        sum = 0u; cnt = 0u; mine = 0u;
#pragma unroll
        for (unsigned j = 0; j < 16; ++j) { const unsigned c = xb_ld(&bar[XB_XCNT(j)]); sum += c; cnt += (c > 0u) ? 1u : 0u; mine = (j == x) ? c : mine; }
        if (sum == G) break;
        __builtin_amdgcn_s_sleep(1);
        if ((++sp & 255u) == 0u) { if (xb_ld(&bar[XB_TMO])) break; if (sp > XB_SPIN_CAP) { atomicAdd(&bar[XB_TMO], 1u); break; } }
    }
    nloc = mine > 0u ? mine : 1u; nx = cnt > 0u ? cnt : 1u;
}

__device__ __forceinline__ void xcd_barrier(const XcdBarrier& b) {
    asm volatile("s_waitcnt vmcnt(0)" ::: "memory");
    __syncthreads();
    if (b.tid == 0) {
        unsigned* bar = b.bar;
        __builtin_amdgcn_s_waitcnt(0);
        unsigned nloc = b.st[0], nx = b.st[1];
        if (nloc == 0u) { xcd_barrier_complete(bar, b.x, nloc, nx); b.st[0] = nloc; b.st[1] = nx; }
        const unsigned old = xb_add(&bar[XB_XSUB(b.x)], 1u);
        const unsigned gen = old / nloc;
        if (old + 1u == (gen + 1u) * nloc) {
            __builtin_amdgcn_fence(__ATOMIC_RELEASE, "agent");
            asm volatile("s_waitcnt vmcnt(0)" ::: "memory");
            const unsigned og = xb_add(&bar[XB_TOP], 1u);
            const unsigned tg = og / nx;
            if (og + 1u == (tg + 1u) * nx) xb_add(&bar[XB_TOPGEN], 1u);
            else XB_SPIN(xb_ld(&bar[XB_TOPGEN]) == tg, bar);
            __builtin_amdgcn_fence(__ATOMIC_ACQUIRE, "agent");
            xb_add(&bar[XB_XGEN(b.x)], 1u);
            asm volatile("s_waitcnt vmcnt(0)" ::: "memory");
        } else {
            XB_SPIN(xb_ld(&bar[XB_XGEN(b.x)]) == gen, bar);
            __builtin_amdgcn_fence(__ATOMIC_ACQUIRE, "agent");
            asm volatile("s_waitcnt vmcnt(0)" ::: "memory");
        }
    }
    __syncthreads();
}

namespace mk {
constexpr int NWAVES = 8, NTHR = 512;
constexpr int D = 1024, NBATCH = 4, SEQ = 4096, CTXL = 256;
constexpr int MLAT = NBATCH * SEQ, MCTX = NBATCH * CTXL, MALL = MLAT + MCTX;
constexpr int INW = 2496, INP = 2560, DFF = 2816, NGU = 2 * DFF;
constexpr int C_R = 0, C_K = 256, C_V = 512, C_GD = 768, C_WD = 832, C_AD = 896, C_DFQ = 960, C_DFK = 1216, C_DFV = 1472, C_GQQ = 1728, C_GQK = 2240, C_GQV = 2368;
constexpr float NORM_EPS = 1e-6f, LOG2E = 1.4426950408889634f;
constexpr float SC_DF = 0.17677669529663687f * LOG2E;
constexpr float SC_GQ = 0.125f * LOG2E;

enum { I_X = 0, I_C, I_CTX, I_CCTX, I_ADAW, I_ADAB, I_NORMG, I_WIN, I_WOUT, I_RWCONV, I_RWW0, I_RWWUP, I_RWA0, I_RWAUP, I_RWGUP, I_RWKK, I_RWKA, I_RWRK, I_RWLNG, I_RWLNB,
       I_DFLAM, I_DFNG, I_GQSINK, I_FFG, I_FFU, I_FFD, I_FFCW, I_FFCB, N_IN };

constexpr size_t MiB = 1u << 20;
constexpr size_t WS_CTL = 0, CTL_ZERO_BYTES = 1 * MiB;
constexpr int CW_BAR = 4096;
constexpr size_t WS_MOD = 1 * MiB;
constexpr size_t WS_TAB = 1 * MiB + 256 * 1024;
constexpr size_t WS_WIN = 2 * MiB, WIN_BYTES = (size_t)INP * D * 2;
constexpr size_t WS_WOUT = 12 * MiB, WOUT_BYTES = (size_t)D * D * 2;
constexpr size_t WS_WGU = 16 * MiB, WGU_BYTES = (size_t)NGU * D * 2;
constexpr size_t WS_WD = 38 * MiB, WD_BYTES = (size_t)D * DFF * 2;
constexpr size_t WS_XSC = 49 * MiB;
constexpr size_t WS_XN = 53 * MiB;
constexpr size_t WS_RP = 87 * MiB;
constexpr size_t WS_RF = 172 * MiB;
constexpr size_t FEAT1 = (size_t)MALL * 256 * 2;
constexpr size_t WS_GAL = WS_RF, WS_GBE = WS_GAL + 2 * FEAT1, WS_GKP = WS_GBE + 2 * FEAT1, WS_GRH = WS_GKP + 2 * FEAT1, WS_FV = WS_GRH + 2 * FEAT1;
constexpr size_t WS_GLT = WS_FV + FEAT1;
constexpr size_t WS_BON = WS_GLT + (size_t)2 * 272 * 256 * 4;
constexpr size_t WS_RF_END = WS_BON + (size_t)MALL * 4 * 4;
constexpr size_t WS_ACT = WS_RP;
constexpr size_t WS_FP = 181 * MiB;
constexpr size_t WS_SLO = WS_RF;
constexpr size_t WS_SLD = 215 * MiB;
constexpr size_t WS_XB = 240 * MiB;
constexpr size_t WS_END = 256 * MiB;
static_assert(WS_RF_END <= WS_END, "feature region");
static_assert(WS_SLD + (size_t)11 * MCTX * D * 2 <= WS_XB && WS_XB + (size_t)8 * MLAT * 4 * 4 <= WS_END, "exchange slots");
static_assert(WS_FP + (size_t)MALL * D * 2 <= WS_SLD && WS_SLD + (size_t)11 * MCTX * D * 2 <= WS_END, "slabs");
static_assert(WS_ACT + (size_t)MALL * DFF * 2 <= WS_FP && WS_FP + (size_t)MALL * D * 4 <= WS_END, "ffn buffers");
static_assert(WS_XN + (size_t)MALL * D * 2 <= WS_RP && WS_RP + (size_t)MALL * INP * 2 <= WS_RF, "map");

constexpr int LDS_BYTES = 163840;
constexpr int LDSCTL_OFF = LDS_BYTES - 512, MISC_OFF = LDSCTL_OFF + 320;
constexpr int CW_QUEUE = 2048, CW_PST = 32768;

struct Args { const float* in[N_IN]; float* out; unsigned char* ws; int ph_lo, ph_hi; };


typedef const __attribute__((address_space(4))) char* kptr_t;
__device__ __forceinline__ kptr_t karg_base() { kptr_t k = (kptr_t)__builtin_amdgcn_kernarg_segment_ptr(); asm volatile("" : "+s"(k)); return k; }
__device__ __forceinline__ const float* kin(int i) { return *(const float* const __attribute__((address_space(4)))*)(karg_base() + 8 * i); }
__device__ __forceinline__ float* kout() { return *(float* const __attribute__((address_space(4)))*)(karg_base() + 8 * N_IN); }
__device__ __forceinline__ unsigned char* kws() { return *(unsigned char* const __attribute__((address_space(4)))*)(karg_base() + 8 * N_IN + 8); }

struct Frame {
    LAS unsigned char* lds;
    int tid, lane, wave, G, bid;
};

__device__ __forceinline__ float bf2f(bf16 h) { return __uint_as_float(((unsigned)h) << 16); }
template <int CTRL> __device__ __forceinline__ float dpp_mov(float x) { return __int_as_float(__builtin_amdgcn_update_dpp(0, __float_as_int(x), CTRL, 0xF, 0xF, false)); }
template <int CTRL> __device__ __forceinline__ float dpp_add(float x) { return x + dpp_mov<CTRL>(x); }
__device__ __forceinline__ float wave_sum(float v) {
    v = dpp_add<0xB1>(v); v = dpp_add<0x4E>(v); v = dpp_add<0x124>(v); v = dpp_add<0x128>(v);
    auto r = __builtin_amdgcn_permlane16_swap(__float_as_uint(v), __float_as_uint(v), false, false); v = __uint_as_float(r[0]) + __uint_as_float(r[1]);
    r = __builtin_amdgcn_permlane32_swap(__float_as_uint(v), __float_as_uint(v), false, false); return __uint_as_float(r[0]) + __uint_as_float(r[1]);
}
__device__ __forceinline__ float rdlane(float v, int l) { return __int_as_float(__builtin_amdgcn_readlane(__float_as_int(v), l)); }
__device__ __forceinline__ float sigmoidf_(float x) { return __builtin_amdgcn_rcpf(1.0f + __expf(-x)); }
typedef unsigned v2u __attribute__((ext_vector_type(2)));
typedef float f32x2_t __attribute__((ext_vector_type(2))); typedef __bf16 bf16x2_t __attribute__((ext_vector_type(2)));
__device__ __forceinline__ unsigned pk2h(float lo, float hi) { f32x2_t v = {lo, hi}; bf16x2_t b = __builtin_convertvector(v, bf16x2_t); return __builtin_bit_cast(unsigned, b); }
__device__ __forceinline__ float xmax4(float v) {
    auto r = __builtin_amdgcn_permlane16_swap(__float_as_uint(v), __float_as_uint(v), false, false); v = fmaxf(__uint_as_float(r[0]), __uint_as_float(r[1]));
    r = __builtin_amdgcn_permlane32_swap(__float_as_uint(v), __float_as_uint(v), false, false); return fmaxf(__uint_as_float(r[0]), __uint_as_float(r[1]));
}

__device__ __forceinline__ void p0_transpose_item(const float* W, int K, int N, bf16* WT, int row_off, LAS float* scr, int item, int lane) {
    const int nblk = N / 32, kb = item / nblk, nb = item % nblk, k0 = 64 * kb, n0 = 32 * nb;
#pragma unroll 8
    for (int i = 0; i < 32; ++i) { const int kk = 2 * i + (lane >> 5); scr[kk * 33 + (lane & 31)] = W[(size_t)(k0 + kk) * N + n0 + (lane & 31)]; }
    LDS_WAIT(); asm volatile("" ::: "memory");
    const int c = lane & 7;
#pragma unroll
    for (int j = 0; j < 4; ++j) { const int n = (lane >> 3) + 8 * j; const LAS float* s = scr + (8 * c) * 33 + n;
        v4u o; o.x = pk2h(s[0 * 33], s[1 * 33]); o.y = pk2h(s[2 * 33], s[3 * 33]); o.z = pk2h(s[4 * 33], s[5 * 33]); o.w = pk2h(s[6 * 33], s[7 * 33]);
        *(GAS v4u*)(WT + (size_t)(row_off + n0 + n) * K + k0 + 8 * c) = o; }
    LDS_WAIT(); asm volatile("" ::: "memory");
}

constexpr int WI_IN = 16 * (INW / 32), WI_OUT = 16 * 32, WI_G = 16 * (DFF / 32), WI_DN = (DFF / 64) * 32, WI_LAYER = WI_IN + WI_OUT + 2 * WI_G + WI_DN;
__device__ __forceinline__ void weight_item(int it, LAS float* scr, int lane) {
    unsigned char* ws = kws();
    const int l = it / WI_LAYER; int r = it % WI_LAYER;
    if (r < WI_IN) { p0_transpose_item(kin(I_WIN) + (size_t)l * D * INW, D, INW, (bf16*)(ws + WS_WIN + l * WIN_BYTES), 0, scr, r, lane); return; } r -= WI_IN;
    if (r < WI_OUT) { p0_transpose_item(kin(I_WOUT) + (size_t)l * D * D, D, D, (bf16*)(ws + WS_WOUT + l * WOUT_BYTES), 0, scr, r, lane); return; } r -= WI_OUT;
    if (r < WI_G) { const int n0 = 32 * (r % (DFF / 32)); p0_transpose_item(kin(I_FFG) + (size_t)l * D * DFF, D, DFF, (bf16*)(ws + WS_WGU + l * WGU_BYTES), 256 * (n0 >> 7) + (n0 & 127) - n0, scr, r, lane); return; } r -= WI_G;
    if (r < WI_G) { const int n0 = 32 * (r % (DFF / 32)); p0_transpose_item(kin(I_FFU) + (size_t)l * D * DFF, D, DFF, (bf16*)(ws + WS_WGU + l * WGU_BYTES), 256 * (n0 >> 7) + (n0 & 127) - n0 + 128, scr, r, lane); return; } r -= WI_G;
    p0_transpose_item(kin(I_FFD) + (size_t)l * DFF * D, DFF, D, (bf16*)(ws + WS_WD + l * WD_BYTES), 0, scr, r, lane);
}
constexpr int WI_FILL = (2 * WI_LAYER - WI_IN + 127) / 128;

__device__ __forceinline__ void p0_prologue(const Args& A, Frame& F) {
    unsigned char* ws = kws();
    {
        LAS float* sc = (LAS float*)F.lds;
        LAS float* red = (LAS float*)(F.lds + 20480);
        float* mod = (float*)(ws + WS_MOD);
        for (int u = F.bid; u < 192; u += F.G) {
            __syncthreads();
            for (int i = F.tid; i < 5 * 1024; i += NTHR) { const int bb = i >> 10, k = i & 1023; const float v = bb < 4 ? kin(I_C)[bb * 1024 + k] : kin(I_CCTX)[k]; sc[i] = v / (1.0f + __expf(-v)); }
            __syncthreads();
            const int l = u / 96, cc = u % 96, col = cc * 64 + (F.tid & 63), ks = F.tid >> 6;
            const float* w = kin(I_ADAW) + (size_t)l * 1024 * 6144 + col;
            float acc[5] = {0.f, 0.f, 0.f, 0.f, 0.f};
            for (int k0 = ks * 128; k0 < ks * 128 + 128; k0 += 16) { float wv[16];
#pragma unroll
                for (int q = 0; q < 16; ++q) wv[q] = w[(size_t)(k0 + q) * 6144];
#pragma unroll
                for (int q = 0; q < 16; ++q)
#pragma unroll
                    for (int bb = 0; bb < 5; ++bb) acc[bb] += sc[bb * 1024 + k0 + q] * wv[q]; }
#pragma unroll
            for (int bb = 0; bb < 5; ++bb) red[(ks * 5 + bb) * 64 + (F.tid & 63)] = acc[bb];
            __syncthreads();
            if (F.tid < 320) { const int bb = F.tid >> 6, c = F.tid & 63; float s = kin(I_ADAB)[l * 6144 + cc * 64 + c];
#pragma unroll
                for (int k8 = 0; k8 < 8; ++k8) s += red[(k8 * 5 + bb) * 64 + c];
                mod[(size_t)(l * 5 + bb) * 6144 + cc * 64 + c] = s; }
        }
        __syncthreads();
    }
    {
        LAS float* scr = (LAS float*)(F.lds + F.wave * 16384);
        const int gw = F.bid * NWAVES + F.wave, NGW = F.G * NWAVES;
        for (int it = gw; it < WI_IN; it += NGW) weight_item(it, scr, F.lane);
        const int gt = F.bid * NTHR + F.tid, NGT = F.G * NTHR;
        for (int i = gt; i < 2 * 8192; i += NGT) { const int l = i >> 13, j = i & 8191;
            unsigned z_ = 0u; asm volatile("" : "+v"(z_)); *(GAS v4u*)(ws + WS_WIN + l * WIN_BYTES + (size_t)INW * D * 2 + (size_t)j * 16) = (v4u){z_, z_, z_, z_}; }
    }
    if (F.bid == 0) {
        float* tab = (float*)(ws + WS_TAB);
        for (int i = F.tid; i < 512; i += NTHR) { const int pos = i >> 3, f = i & 7; const float inv = __builtin_amdgcn_exp2f(-(float)f * (13.287712379549449f / 8.0f)), ang = (float)pos * inv; tab[i] = __cosf(ang); tab[512 + i] = __sinf(ang); }
        for (int i = F.tid; i < 1024; i += NTHR) { const int pos = i >> 4, f = i & 15; const float inv = __builtin_amdgcn_exp2f(-(float)f * (13.287712379549449f / 16.0f)), ang = (float)pos * inv; tab[1024 + i] = __cosf(ang); tab[2048 + i] = __sinf(ang); }
        if (F.tid < 2) { const int l = F.tid; const float* lv = kin(I_DFLAM) + l * 128; float s1 = 0.f, s2 = 0.f;
            for (int i = 0; i < 32; ++i) { s1 += lv[i] * lv[32 + i]; s2 += lv[64 + i] * lv[96 + i]; }
            const float lam_init = 0.8f - 0.6f * __expf(-0.3f * (float)l);
            tab[3072 + l] = __expf(s1) - __expf(s2) + lam_init; tab[3074 + l] = lam_init; }
    }
}

__device__ __forceinline__ const float* mod_vec(const Args& A, int l, int bb, int i) { return (const float*)(kws() + WS_MOD) + ((size_t)(l * 5 + bb) * 6 + i) * 1024; }
__device__ __forceinline__ const float* normg_vec(const Args& A, int l, int i) { return kin(I_NORMG) + (size_t)(l * 4 + i) * 1024; }
__device__ __forceinline__ int row_bb(int row) { return row < MLAT ? (row >> 12) : 4; }
__device__ __forceinline__ void seq_pos(int row, int& t, int& T) { if (row < MLAT) { t = row & (SEQ - 1); T = SEQ; } else { t = (row - MLAT) & (CTXL - 1); T = CTXL; } }
__device__ __forceinline__ void ld16(const float* p, int lane, f32x4 (&v)[4]) {
#pragma unroll
    for (int j = 0; j < 4; ++j) v[j] = *(const f32x4*)(p + 4 * lane + 256 * j);
}
__device__ __forceinline__ void ld16b(const bf16* p, int lane, f32x4 (&v)[4]) {
#pragma unroll
    for (int j = 0; j < 4; ++j) { const v2u u = *(const v2u*)(p + 4 * lane + 256 * j);
        v[j] = (f32x4){__uint_as_float(u.x << 16), __uint_as_float(u.x & 0xffff0000u), __uint_as_float(u.y << 16), __uint_as_float(u.y & 0xffff0000u)}; }
}
__device__ __forceinline__ void st16(float* p, int lane, const f32x4 (&v)[4]) {
#pragma unroll
    for (int j = 0; j < 4; ++j) *(f32x4*)(p + 4 * lane + 256 * j) = v[j];
}
__device__ __forceinline__ float sumsq16(const f32x4 (&v)[4]) {
    float s = 0.f;
#pragma unroll
    for (int j = 0; j < 4; ++j) s += (v[j].x * v[j].x + v[j].y * v[j].y) + (v[j].z * v[j].z + v[j].w * v[j].w);
    return wave_sum(s);
}
__device__ __forceinline__ void norm_mod_store(const f32x4 (&v)[4], float rstd, const float* g, const float* sc, const float* sh, bf16* orow, int lane) {
#pragma unroll
    for (int j = 0; j < 4; ++j) {
        const int c = 4 * lane + 256 * j;
        const f32x4 gg = *(const f32x4*)(g + c), s1 = *(const f32x4*)(sc + c), s0 = *(const f32x4*)(sh + c);
        const f32x4 h = v[j] * rstd * gg * (s1 + 1.0f) + s0;
        v2u o; o.x = pk2h(h.x, h.y); o.y = pk2h(h.z, h.w);
        *(v2u*)(orow + c) = o;
    }
}
__device__ __forceinline__ float* xs_row(const Args& A, int row) { return row < MLAT ? kout() + (size_t)row * D : (float*)(kws() + WS_XSC) + (size_t)(row - MLAT) * D; }
__device__ __forceinline__ const float* xin_row(const Args& A, int row) { return row < MLAT ? kin(I_X) + (size_t)row * D : kin(I_CTX) + (size_t)(row - MLAT) * D; }

__device__ __forceinline__ void phase_prep(const Args& A, Frame& F) {
    const int gw = F.bid * NWAVES + F.wave, NGW = F.G * NWAVES;
    bf16* XN = (bf16*)(kws() + WS_XN);
    f32x4 v[4], vn[4];
    if (gw < MALL) ld16(xin_row(A, gw), F.lane, v);
    for (int row = gw; row < MALL; row += NGW) {
        if (row + NGW < MALL) ld16(xin_row(A, row + NGW), F.lane, vn);
        const float rstd = rsqrtf(sumsq16(v) * (1.0f / D) + NORM_EPS);
        const int bb = row_bb(row);
        norm_mod_store(v, rstd, normg_vec(A, 0, 0), mod_vec(A, 0, bb, 1), mod_vec(A, 0, bb, 0), XN + (size_t)row * D, F.lane);
#pragma unroll
        for (int j = 0; j < 4; ++j) v[j] = vn[j];
    }
}
__device__ __forceinline__ void phase_e1(const Args& A, Frame& F, int l) {
    const int gw = F.bid * NWAVES + F.wave, NGW = F.G * NWAVES, nrows = l == 0 ? MALL : MLAT;
    bf16* XN = (bf16*)(kws() + WS_XN); const bf16* YP = (const bf16*)(kws() + WS_RP);
    for (int row = ((MK_FUSE & 1) && !MK_DBGD ? MLAT : 0) + gw; row < nrows; row += NGW) {
        const int bb = row_bb(row);
        f32x4 y[4], x[4];
        if (l == 0 && row >= MLAT) { const bf16* sl = (const bf16*)(kws() + WS_SLO) + (size_t)(row - MLAT) * D; ld16b(sl, F.lane, y);
            for (int s = 1; s < 4; ++s) { f32x4 t[4]; ld16b(sl + (size_t)s * MCTX * D, F.lane, t);
#pragma unroll
                for (int j = 0; j < 4; ++j) y[j] = y[j] + t[j]; } }
        else ld16b(YP + (size_t)row * D, F.lane, y);
        if (l == 0) ld16(xin_row(A, row), F.lane, x); else ld16(xs_row(A, row), F.lane, x);
        const float ry = rsqrtf(sumsq16(y) * (1.0f / D) + NORM_EPS);
        const float* g1 = normg_vec(A, l, 1); const float* ga = mod_vec(A, l, bb, 2);
#pragma unroll
        for (int j = 0; j < 4; ++j) { const int c = 4 * F.lane + 256 * j; x[j] = x[j] + *(const f32x4*)(ga + c) * (y[j] * ry * *(const f32x4*)(g1 + c)); }
        st16(xs_row(A, row), F.lane, x);
        const float rx = rsqrtf(sumsq16(x) * (1.0f / D) + NORM_EPS);
        norm_mod_store(x, rx, normg_vec(A, l, 2), mod_vec(A, l, bb, 4), mod_vec(A, l, bb, 3), XN + (size_t)row * D, F.lane);
    }
}
__device__ __forceinline__ void phase_e2(const Args& A, Frame& F, int l, int r0, int r1) {
    const int gw = F.bid * NWAVES + F.wave, NGW = F.G * NWAVES;
    bf16* XN = (bf16*)(kws() + WS_XN); const bf16* FP = (const bf16*)(kws() + WS_FP);
    for (int row = ((MK_FUSE & 2) && !MK_DBGD ? (r0 < MLAT ? MLAT : r0) : r0) + gw; row < r1; row += NGW) {
        const int bb = row_bb(row);
        f32x4 y[4], x[4];
        if (l == 0 && row >= MLAT) { const bf16* sl = (const bf16*)(kws() + WS_SLD) + (size_t)(row - MLAT) * D; ld16b(sl, F.lane, y);
            for (int s = 1; s < 11; ++s) { f32x4 t[4]; ld16b(sl + (size_t)s * MCTX * D, F.lane, t);
#pragma unroll
                for (int j = 0; j < 4; ++j) y[j] = y[j] + t[j]; } }
        else ld16b(FP + (size_t)(row - r0) * D, F.lane, y);
        ld16(xs_row(A, row), F.lane, x);
        const float ry = rsqrtf(sumsq16(y) * (1.0f / D) + NORM_EPS);
        const float* g3 = normg_vec(A, l, 3); const float* ga = mod_vec(A, l, bb, 5);
#pragma unroll
        for (int j = 0; j < 4; ++j) { const int c = 4 * F.lane + 256 * j; x[j] = x[j] + *(const f32x4*)(ga + c) * (y[j] * ry * *(const f32x4*)(g3 + c)); }
        st16(xs_row(A, row), F.lane, x);
        if (l == 0) {
            const float rx = rsqrtf(sumsq16(x) * (1.0f / D) + NORM_EPS);
            norm_mod_store(x, rx, normg_vec(A, 1, 0), mod_vec(A, 1, bb, 1), mod_vec(A, 1, bb, 0), XN + (size_t)row * D, F.lane);
        }
    }
}
__device__ __forceinline__ void phase_act(const Args& A, Frame& F, int l, int r0, int r1) {
    const bf16* GU = (const bf16*)(kws() + WS_RP); bf16* ACT = (bf16*)(kws() + WS_ACT);
    const float* cw = kin(I_FFCW) + (size_t)l * 3 * DFF; const float* cb = kin(I_FFCB) + (size_t)l * DFF;
    const int nch = DFF / 8, total = (r1 - r0) * nch;
    for (int i = F.bid * NTHR + F.tid; i < total; i += F.G * NTHR) {
        const int rr = i / nch, ch = i % nch, row = r0 + rr, j0 = ch * 8;
        const int t = row < MLAT ? (row & (SEQ - 1)) : ((row - MLAT) & (CTXL - 1)), T = row < MLAT ? SEQ : CTXL;
        const bf16* gp = GU + (size_t)rr * NGU + j0;
        const v4u gc = *(const v4u*)gp, uu = *(const v4u*)(gp + DFF);
        v4u gm = (v4u){0u, 0u, 0u, 0u}, gn = (v4u){0u, 0u, 0u, 0u};
        if (t > 0) gm = *(const v4u*)(gp - NGU);
        if (t < T - 1) gn = *(const v4u*)(gp + NGU);
        unsigned o[4];
#pragma unroll
        for (int q = 0; q < 4; ++q) {
            float r2[2];
#pragma unroll
            for (int e = 0; e < 2; ++e) {
                const int j = j0 + 2 * q + e;
                const float a = __uint_as_float(e ? (gm[q] & 0xffff0000u) : (gm[q] << 16)), b = __uint_as_float(e ? (gc[q] & 0xffff0000u) : (gc[q] << 16)), c = __uint_as_float(e ? (gn[q] & 0xffff0000u) : (gn[q] << 16));
                const float u = __uint_as_float(e ? (uu[q] & 0xffff0000u) : (uu[q] << 16));
                const float z = a * cw[j] + b * cw[DFF + j] + c * cw[2 * DFF + j] + cb[j];
                r2[e] = z / (1.0f + __expf(-z)) * u;
            }
            o[q] = pk2h(r2[0], r2[1]);
        }
        *(v4u*)(ACT + (size_t)rr * DFF + j0) = (v4u){o[0], o[1], o[2], o[3]};
    }
}

struct EpiMulti {
    static constexpr bool PERM = false, AFTER_DRAIN = false;
    int mode;
    bf16* ob; float* of; int ld; const float* tab;
    const float* cw; const float* cb; int nrows; unsigned ldsx;
    const float* xin; float* xout; bf16* xn; const float *gA, *gaA, *gB, *scB, *shB; float* xb0; float* xb1; gu32* cnt0; gu32* cnt1; int two;
    __device__ __forceinline__ bool drain() const { return mode >= 5; }
    __device__ __forceinline__ void row_stats(const pg8::f32x4 (&v)[2][2][4][2], const pg8::Unit& u, int wr, int wc, int fr, int fq, LAS unsigned char* lds, int wid, int lane, float* xb, gu32* cnt) const {
        LAS float* Pp = (LAS float*)lds; LAS float* Ss = (LAS float*)(lds + 8192); LAS unsigned* flag = (LAS unsigned*)(lds + 8192 + 1024);
#pragma unroll
        for (int ai = 0; ai < 2; ++ai)
#pragma unroll
            for (int mm = 0; mm < 4; ++mm) { float s = 0.f;
#pragma unroll
                for (int bj = 0; bj < 2; ++bj)
#pragma unroll
                    for (int n = 0; n < 2; ++n) { const pg8::f32x4 x = v[ai][bj][mm][n]; s += (x[0] * x[0] + x[1] * x[1]) + (x[2] * x[2] + x[3] * x[3]); }
                s += __shfl_xor(s, 16); s += __shfl_xor(s, 32);
                if (fq == 0) Pp[(ai * 128 + wr * 64 + mm * 16 + fr) * 4 + wc] = s; }
        asm volatile("s_waitcnt lgkmcnt(0)" ::: "memory"); __builtin_amdgcn_s_barrier(); asm volatile("" ::: "memory");
        const int row = wid * 32 + (lane & 31);
        if (lane < 32) { const float s = (Pp[row * 4 + 0] + Pp[row * 4 + 1]) + (Pp[row * 4 + 2] + Pp[row * 4 + 3]);
            __hip_atomic_store((gu32*)(xb + ((size_t)u.pn * MLAT + u.pm * 256 + row)), __float_as_uint(s), __ATOMIC_RELAXED, __HIP_MEMORY_SCOPE_AGENT); }
        asm volatile("s_waitcnt vmcnt(0)" ::: "memory");
        if (lane == 0) __hip_atomic_fetch_add(cnt + 64 * u.pm, 1u, __ATOMIC_RELAXED, __HIP_MEMORY_SCOPE_AGENT);
        if (wid == 0) {
            unsigned sp = 0;
            while ((unsigned)__builtin_amdgcn_readfirstlane(__hip_atomic_load(cnt + 64 * u.pm, __ATOMIC_RELAXED, __HIP_MEMORY_SCOPE_AGENT)) < 32u) { __builtin_amdgcn_s_sleep(2); if (++sp > (1u << 22)) break; }
            __builtin_amdgcn_fence(__ATOMIC_ACQUIRE, "agent");
            if (lane == 0) flag[0] = 1u;
        }
        asm volatile("s_waitcnt vmcnt(0) lgkmcnt(0)" ::: "memory"); __builtin_amdgcn_s_barrier(); asm volatile("" ::: "memory");
        if (lane < 32) { float t = 0.f;
#pragma unroll
            for (int q = 0; q < 4; ++q) t += __uint_as_float(__hip_atomic_load((gu32*)(xb + ((size_t)q * MLAT + u.pm * 256 + row)), __ATOMIC_RELAXED, __HIP_MEMORY_SCOPE_AGENT));
            Ss[row] = rsqrtf(t * (1.0f / D) + NORM_EPS); }
        asm volatile("s_waitcnt vmcnt(0) lgkmcnt(0)" ::: "memory"); __builtin_amdgcn_s_barrier(); asm volatile("" ::: "memory");
    }
    __device__ __forceinline__ void fused(pg8::f32x4 (&acc)[2][2][4][2], const pg8::Unit& u, int wr, int wc, int fr_, int fq_, PG8_LAS unsigned char* lds, int wid, int lane) const {
        int fr = fr_, fq = fq_; asm volatile("" : "+v"(fr), "+v"(fq));
#if defined(MK_DBGDRAIN)
        { bf16* obd = mode == 5 ? (bf16*)(kws() + WS_RP) : (bf16*)(kws() + WS_FP);
#pragma unroll
          for (int ai = 0; ai < 2; ++ai)
#pragma unroll
            for (int mm = 0; mm < 4; ++mm) { bf16* rp = obd + (size_t)(u.pm * 256 + ai * 128 + wr * 64 + mm * 16 + fr) * D + u.pn * 256 + wc * 32 + 4 * fq;
#pragma unroll
                for (int bj = 0; bj < 2; ++bj)
#pragma unroll
                    for (int n = 0; n < 2; ++n) { const pg8::f32x4 v = acc[ai][bj][mm][n]; v2u o; o.x = pk2h(v[0], v[1]); o.y = pk2h(v[2], v[3]); *(v2u*)(rp + bj * 128 + n * 16) = o; } }
          return; }
#endif
        const LAS float* Ss = (const LAS float*)((LAS unsigned char*)lds + 8192);
        const int col0 = u.pn * 256 + wc * 32 + 4 * fq, bofs = (u.pm >> 4) * 6144;
        row_stats(acc, u, wr, wc, fr, fq, (LAS unsigned char*)lds, wid, lane, xb0, cnt0);
        pg8::f32x4 cA_[2][2];
#pragma unroll
        for (int bj = 0; bj < 2; ++bj)
#pragma unroll
            for (int n = 0; n < 2; ++n) cA_[bj][n] = *(const pg8::f32x4*)(gA + col0 + 128 * bj + 16 * n) * *(const pg8::f32x4*)(gaA + bofs + col0 + 128 * bj + 16 * n);
#pragma unroll
        for (int ai = 0; ai < 2; ++ai)
#pragma unroll
            for (int mm = 0; mm < 4; ++mm) { const int r = ai * 128 + wr * 64 + mm * 16 + fr; const float rs = Ss[r]; const size_t off = (size_t)(u.pm * 256 + r) * D + col0;
#pragma unroll
                for (int bj = 0; bj < 2; ++bj)
#pragma unroll
                    for (int n = 0; n < 2; ++n) { const pg8::f32x4 xi = *(const pg8::f32x4*)(xin + off + 128 * bj + 16 * n); acc[ai][bj][mm][n] = xi + cA_[bj][n] * (acc[ai][bj][mm][n] * rs); }
                asm volatile("" : "+v"(acc[ai][0][mm][0]), "+v"(acc[ai][0][mm][1]), "+v"(acc[ai][1][mm][0]), "+v"(acc[ai][1][mm][1]));
                if (mm & 1) asm volatile("" ::: "memory"); }
        if (two) {
            asm volatile("s_waitcnt lgkmcnt(0)" ::: "memory"); __builtin_amdgcn_s_barrier(); asm volatile("" ::: "memory");
            row_stats(acc, u, wr, wc, fr, fq, (LAS unsigned char*)lds, wid, lane, xb1, cnt1);
        }
        pg8::f32x4 cB_[2][2], cS_[2][2];
        if (two) {
#pragma unroll
            for (int bj = 0; bj < 2; ++bj)
#pragma unroll
                for (int n = 0; n < 2; ++n) { cB_[bj][n] = *(const pg8::f32x4*)(gB + col0 + 128 * bj + 16 * n) * (*(const pg8::f32x4*)(scB + bofs + col0 + 128 * bj + 16 * n) + 1.0f); cS_[bj][n] = *(const pg8::f32x4*)(shB + bofs + col0 + 128 * bj + 16 * n); }
        }
#pragma unroll
        for (int ai = 0; ai < 2; ++ai)
#pragma unroll
            for (int mm = 0; mm < 4; ++mm) { const int r = ai * 128 + wr * 64 + mm * 16 + fr; const size_t off = (size_t)(u.pm * 256 + r) * D + col0; const float rs = two ? Ss[r] : 0.f;
#pragma unroll
                for (int bj = 0; bj < 2; ++bj)
#pragma unroll
                    for (int n = 0; n < 2; ++n) { const pg8::f32x4 x1 = acc[ai][bj][mm][n]; *(pg8::f32x4*)(xout + off + 128 * bj + 16 * n) = x1;
                        if (two) { const pg8::f32x4 hh = x1 * rs * cB_[bj][n] + cS_[bj][n]; v2u o; o.x = pk2h(hh[0], hh[1]); o.y = pk2h(hh[2], hh[3]); *(v2u*)(xn + off + 128 * bj + 16 * n) = o; } }
                asm volatile("" ::: "memory"); }
        asm volatile("s_waitcnt lgkmcnt(0)" ::: "memory"); __builtin_amdgcn_s_barrier(); asm volatile("" ::: "memory");
    }
    __device__ __forceinline__ void operator()(const pg8::f32x4 (&acc)[2][2][4][2], const pg8::Unit& u, int wr, int wc, int fr_, int fq_) const {
        int fr = fr_, fq = fq_; asm volatile("" : "+v"(fr), "+v"(fq));
        if (mode == 1) {
#pragma unroll
            for (int ai = 0; ai < 2; ++ai)
#pragma unroll
                for (int m = 0; m < 4; ++m) { float* rp = of + (size_t)(u.pm * 256 + ai * 128 + wr * 64 + m * 16 + fr) * ld + u.pn * 256 + wc * 32 + 4 * fq;
#pragma unroll
                    for (int bj = 0; bj < 2; ++bj)
#pragma unroll
                        for (int n = 0; n < 2; ++n) *(pg8::f32x4*)(rp + bj * 128 + n * 16) = acc[ai][bj][m][n]; }
        } else if (mode == 3) {
            const unsigned par = (unsigned)(u.pm + u.pn) & 1u;
            const unsigned ex = ldsx + par * 4096u + (unsigned)(wc * 32 + 4 * fq) * 4u;
#pragma unroll
            for (int ai = 0; ai < 2; ++ai)
#pragma unroll
                for (int n = 0; n < 2; ++n) {
                    if (fr == 0) *(LAS pg8::f32x4*)(uintptr_t)(ex + (unsigned)(((ai * 2 + wr) * 2 + 0) * 128 + n * 16) * 4u) = acc[ai][0][0][n];
                    if (fr == 15) *(LAS pg8::f32x4*)(uintptr_t)(ex + (unsigned)(((ai * 2 + wr) * 2 + 1) * 128 + n * 16) * 4u) = acc[ai][0][3][n];
                }
            asm volatile("s_waitcnt lgkmcnt(0)" ::: "memory"); __builtin_amdgcn_s_barrier(); asm volatile("" ::: "memory");
            const int jb = u.pn * 128 + wc * 32 + 4 * fq;
#pragma unroll
            for (int n = 0; n < 2; ++n) {
                const int j = jb + 16 * n;
                const pg8::f32x4 w0 = *(const pg8::f32x4*)(cw + j), w1 = *(const pg8::f32x4*)(cw + DFF + j), w2 = *(const pg8::f32x4*)(cw + 2 * DFF + j), bb = *(const pg8::f32x4*)(cb + j);
#pragma unroll
                for (int ai = 0; ai < 2; ++ai) {
                    const int pblk = (ai * 2 + wr) - 1, nblk = (ai * 2 + wr) + 1;
                    pg8::f32x4 eprev = (pg8::f32x4){0.f, 0.f, 0.f, 0.f}, enext = eprev;
                    if (pblk >= 0) eprev = *(LAS const pg8::f32x4*)(uintptr_t)(ex + (unsigned)((pblk * 2 + 1) * 128 + n * 16) * 4u);
                    if (nblk <= 3) enext = *(LAS const pg8::f32x4*)(uintptr_t)(ex + (unsigned)((nblk * 2 + 0) * 128 + n * 16) * 4u);
#pragma unroll
                    for (int mm = 0; mm < 4; ++mm) {
                        const int trow = ai * 128 + wr * 64 + mm * 16 + fr, grow = u.pm * 254 - 1 + trow;
                        int t, T; seq_pos(grow < 0 ? 0 : grow, t, T);
                        const pg8::f32x4 gc = acc[ai][0][mm][n], uu = acc[ai][1][mm][n];
                        pg8::f32x4 gp, gn;
#pragma unroll
                        for (int i = 0; i < 4; ++i) {
                            const float pold = mm > 0 ? __int_as_float(__builtin_amdgcn_update_dpp(0, __float_as_int(acc[ai][0][mm > 0 ? mm - 1 : 0][n][i]), 0x121, 0xF, 0xF, false)) : eprev[i];
                            gp[i] = __int_as_float(__builtin_amdgcn_update_dpp(__float_as_int(pold), __float_as_int(gc[i]), 0x111, 0xF, 0xF, false));
                            const float nold = mm < 3 ? __int_as_float(__builtin_amdgcn_update_dpp(0, __float_as_int(acc[ai][0][mm < 3 ? mm + 1 : 3][n][i]), 0x12F, 0xF, 0xF, false)) : enext[i];
                            gn[i] = __int_as_float(__builtin_amdgcn_update_dpp(__float_as_int(nold), __float_as_int(gc[i]), 0x101, 0xF, 0xF, false));
                        }
                        if (t == 0) gp = (pg8::f32x4){0.f, 0.f, 0.f, 0.f};
                        if (t == T - 1) gn = (pg8::f32x4){0.f, 0.f, 0.f, 0.f};
                        const pg8::f32x4 z = gp * w0 + gc * w1 + gn * w2 + bb;
                        pg8::f32x4 a;
#pragma unroll
                        for (int i = 0; i < 4; ++i) a[i] = z[i] * __builtin_amdgcn_rcpf(1.0f + __expf(-z[i])) * uu[i];
                        if (trow >= 1 && trow <= 254 && grow < nrows) { v2u o; o.x = pk2h(a[0], a[1]); o.y = pk2h(a[2], a[3]); *(v2u*)(ob + (size_t)grow * DFF + j) = o; }
                    }
                }
            }
        } else if (mode == 2) {
#pragma unroll
            for (int ai = 0; ai < 2; ++ai)
#pragma unroll
                for (int m = 0; m < 4; ++m) { bf16* rp = ob + (size_t)(u.pm * 256 + ai * 128 + wr * 64 + m * 16 + fr) * ld + u.pn * 256 + wc * 32 + 4 * fq;
#pragma unroll
                    for (int bj = 0; bj < 2; ++bj)
#pragma unroll
                        for (int n = 0; n < 2; ++n) { const pg8::f32x4 v = acc[ai][bj][m][n]; v2u o; o.x = pk2h(v[0], v[1]); o.y = pk2h(v[2], v[3]); *(v2u*)(rp + bj * 128 + n * 16) = o; } }
        } else {
            const bool latent = u.pm < (MLAT / 256);
#pragma unroll
            for (int bj = 0; bj < 2; ++bj) {
                const int g32 = u.pn * 8 + bj * 4 + wc;
                if (g32 >= INW / 32) continue;
                const bool isdf = (g32 >= C_DFQ / 32 && g32 < C_DFV / 32), isgq = (g32 >= C_GQQ / 32 && g32 < C_GQV / 32);
                const float qs = (g32 >= C_DFQ / 32 && g32 < C_DFK / 32) ? SC_DF : ((g32 >= C_GQQ / 32 && g32 < C_GQK / 32) ? SC_GQ : 1.0f);
#pragma unroll
                for (int ai = 0; ai < 2; ++ai)
#pragma unroll
                    for (int m = 0; m < 4; ++m) {
                        const int row = u.pm * 256 + ai * 128 + wr * 64 + m * 16 + fr, s = row & (SEQ - 1), prow = s >> 6, pcol = s & 63;
                        pg8::f32x4 v0 = acc[ai][bj][m][0], v1 = acc[ai][bj][m][1];
                        if (isdf) {
                            pg8::f32x4 p0, p1;
#pragma unroll
                            for (int i = 0; i < 4; ++i) { p0[i] = __shfl_xor(v0[i], 32); p1[i] = __shfl_xor(v1[i], 32); }
                            if (latent) {
                                const int f0 = 4 * (fq & 1);
                                const pg8::f32x4 c0 = *(const pg8::f32x4*)(tab + prow * 8 + f0), s0 = *(const pg8::f32x4*)(tab + 512 + prow * 8 + f0);
                                const pg8::f32x4 c1 = *(const pg8::f32x4*)(tab + pcol * 8 + f0), s1 = *(const pg8::f32x4*)(tab + 512 + pcol * 8 + f0);
                                if (fq & 2) { v0 = v0 * c0 + p0 * s0; v1 = v1 * c1 + p1 * s1; } else { v0 = v0 * c0 - p0 * s0; v1 = v1 * c1 - p1 * s1; }
                            }
                        } else if (isgq) {
                            if (latent) {
                                const int pos = (g32 & 1) ? pcol : prow;
                                const pg8::f32x4 cc = *(const pg8::f32x4*)(tab + 1024 + pos * 16 + 4 * fq), ss = *(const pg8::f32x4*)(tab + 2048 + pos * 16 + 4 * fq);
                                const pg8::f32x4 a = v0 * cc - v1 * ss, b = v1 * cc + v0 * ss; v0 = a; v1 = b;
                            }
                        }
                        v0 = v0 * qs; v1 = v1 * qs;
                        bf16* rp = ob + (size_t)row * INP + g32 * 32 + 4 * fq;
                        v2u o; o.x = pk2h(v0[0], v0[1]); o.y = pk2h(v0[2], v0[3]); *(v2u*)rp = o;
                        o.x = pk2h(v1[0], v1[1]); o.y = pk2h(v1[2], v1[3]); *(v2u*)(rp + 16) = o;
                        asm volatile("" ::: "memory");
                    }
            }
        }
    }
};


template <int CTRL, int RM> __device__ __forceinline__ float dpp_mul1(float x) {
    return x * __int_as_float(__builtin_amdgcn_update_dpp(0x3f800000, __float_as_int(x), CTRL, RM, 0xF, false));
}
__device__ __forceinline__ float wave_mulscan(float x) {
    x = dpp_mul1<0x111, 0xF>(x); x = dpp_mul1<0x112, 0xF>(x); x = dpp_mul1<0x114, 0xF>(x); x = dpp_mul1<0x118, 0xF>(x);
    x = dpp_mul1<0x142, 0xA>(x); x = dpp_mul1<0x143, 0xC>(x); return x;
}
__device__ __forceinline__ float wave_shr1_one(float x) { return __int_as_float(__builtin_amdgcn_update_dpp(0x3f800000, __float_as_int(x), 0x138, 0xF, 0xF, false)); }
__device__ __forceinline__ bf16 bf1(float x) { return (bf16)(pk2h(x, 0.f) & 0xffffu); }

constexpr int FT_LD = 65, FT_ARR = 64 * FT_LD * 4;
constexpr int FT_BON = 9 * FT_ARR;
constexpr int FT_PR_LD = 200;
static_assert(66 * FT_PR_LD * 2 <= 2 * FT_ARR && FT_BON + 512 <= LDSCTL_OFF, "features LDS map");
__device__ __forceinline__ void rwkv_features(const Args& A, Frame& F, int l) {
    const int w = F.wave, n = F.lane, c15 = n & 15, g = n >> 4, tr = w >> 1, tc0 = (w & 1) * 2;
    const int h = F.bid & 3, c = h * 64 + n;
    const bf16* P = (const bf16*)(kws() + WS_RP);
    bf16* FV = (bf16*)(kws() + WS_FV); float* BON = (float*)(kws() + WS_BON); float* GLT = (float*)(kws() + WS_GLT);
    float cw[3][3];
#pragma unroll
    for (int tp = 0; tp < 3; ++tp)
#pragma unroll
        for (int j = 0; j < 3; ++j) cw[tp][j] = kin(I_RWCONV)[(size_t)(l * 3 + tp) * 768 + j * 256 + c];
    const float kkc = kin(I_RWKK)[l * 256 + c];
    bf16x8 Bw[2][2], Ba[2][2]; float w0c[2][2], a0c[2][2], kac2[2], rkc2[2];
#pragma unroll
    for (int t = 0; t < 2; ++t) { const int cn = h * 64 + 16 * (tc0 + t) + c15;
        kac2[t] = kin(I_RWKA)[l * 256 + cn]; rkc2[t] = kin(I_RWRK)[l * 256 + cn];
#pragma unroll
        for (int d = 0; d < 2; ++d) { w0c[d][t] = kin(I_RWW0)[(l * 2 + d) * 256 + cn]; a0c[d][t] = kin(I_RWA0)[(l * 2 + d) * 256 + cn];
            unsigned pw[4], pa[4];
#pragma unroll
            for (int j = 0; j < 8; j += 2) { const size_t o = ((size_t)(l * 2 + d) * 32 + 8 * g + j) * 256 + cn;
                pw[j >> 1] = pk2h(kin(I_RWWUP)[o], kin(I_RWWUP)[o + 256]); pa[j >> 1] = pk2h(kin(I_RWAUP)[o], kin(I_RWAUP)[o + 256]); }
            Bw[d][t] = __builtin_bit_cast(bf16x8, (v4u){pw[0], pw[1], pw[2], pw[3]}); Ba[d][t] = __builtin_bit_cast(bf16x8, (v4u){pa[0], pa[1], pa[2], pa[3]}); }
    }
    for (int u = F.bid; u < 4 * (MALL / 64); u += F.G) {
        const int gi = u >> 2, row0 = 64 * gi;
        int t0, T; seq_pos(row0, t0, T);
        __syncthreads();
        for (int p = F.tid; p < 66 * 24; p += NTHR) { const int rr = p / 24, q = p % 24, which = q >> 3, ch = q & 7, row = row0 - 1 + rr;
            const bool ok = (rr >= 1 && rr <= 64) || (rr == 0 ? t0 > 0 : t0 + 64 < T);
            unsigned z_ = 0u; asm volatile("" : "+v"(z_)); v4u v = (v4u){z_, z_, z_, z_};
            if (ok) v = *(const v4u*)(P + (size_t)row * INP + which * 256 + h * 64 + 8 * ch);
            *(LAS v4u*)(F.lds + (rr * FT_PR_LD + which * 64 + 8 * ch) * 2) = v; }
        v4u xwd[2], xad[2];
        { const bf16* pr = P + (size_t)(row0 + 16 * tr + c15) * INP + 8 * g;
#pragma unroll
          for (int d = 0; d < 2; ++d) { xwd[d] = *(const v4u*)(pr + C_WD + 32 * d); xad[d] = *(const v4u*)(pr + C_AD + 32 * d); } }
        __syncthreads();
#pragma unroll
        for (int rr = 0; rr < 8; ++rr) {
            const int i = 8 * w + rr;
            float xr[3], xk[3], xv[3];
#pragma unroll
            for (int tp = 0; tp < 3; ++tp) { const LAS bf16* pp = (const LAS bf16*)F.lds + (i + tp) * FT_PR_LD + n; xr[tp] = bf2f(pp[0]); xk[tp] = bf2f(pp[64]); xv[tp] = bf2f(pp[128]); }
            const float rq = bf2f(bf1(xr[0] * cw[0][0] + xr[1] * cw[1][0] + xr[2] * cw[2][0])), kq = bf2f(bf1(xk[0] * cw[0][1] + xk[1] * cw[1][1] + xk[2] * cw[2][1]));
            FV[(size_t)(row0 + i) * 256 + c] = bf1(xv[0] * cw[0][2] + xv[1] * cw[1][2] + xv[2] * cw[2][2]);
            const float kkraw = kq * kkc;
            const float kk = kkraw * (1.0f / fmaxf(sqrtf(wave_sum(kkraw * kkraw)), 1e-12f));
            LAS float* L = (LAS float*)F.lds + i * FT_LD + n;
            L[2 * (FT_ARR / 4)] = kk; L[7 * (FT_ARR / 4)] = rq; L[8 * (FT_ARR / 4)] = kq;
        }
        __syncthreads();
        {
            bf16x8 aw[2], aa[2];
#pragma unroll
            for (int d = 0; d < 2; ++d) { unsigned pw[4];
#pragma unroll
                for (int q = 0; q < 4; ++q) { const float x0 = __uint_as_float(xwd[d][q] << 16), x1 = __uint_as_float(xwd[d][q] & 0xffff0000u);
                    pw[q] = pk2h(1.0f - 2.0f * __builtin_amdgcn_rcpf(1.0f + __expf(2.0f * x0)), 1.0f - 2.0f * __builtin_amdgcn_rcpf(1.0f + __expf(2.0f * x1))); }
                aw[d] = __builtin_bit_cast(bf16x8, (v4u){pw[0], pw[1], pw[2], pw[3]}); aa[d] = __builtin_bit_cast(bf16x8, xad[d]); }
            float bsum[4] = {0.f, 0.f, 0.f, 0.f};
#pragma unroll
            for (int t = 0; t < 2; ++t) {
                float kkv[4], kqv[4], rqv[4];
#pragma unroll
                for (int r = 0; r < 4; ++r) { const LAS float* L = (const LAS float*)F.lds + (16 * tr + 4 * g + r) * FT_LD + 16 * (tc0 + t) + c15;
                    kkv[r] = L[2 * (FT_ARR / 4)]; rqv[r] = L[7 * (FT_ARR / 4)]; kqv[r] = L[8 * (FT_ARR / 4)]; }
#pragma unroll
                for (int d = 0; d < 2; ++d) {
                    const f32x4 wl = __builtin_amdgcn_mfma_f32_16x16x32_bf16(aw[d], Bw[d][t], (f32x4){0.f, 0.f, 0.f, 0.f}, 0, 0, 0);
                    const f32x4 al = __builtin_amdgcn_mfma_f32_16x16x32_bf16(aa[d], Ba[d][t], (f32x4){0.f, 0.f, 0.f, 0.f}, 0, 0, 0);
#pragma unroll
                    for (int r = 0; r < 4; ++r) {
                        const float wv = 1.0f + bf2f(bf1(__expf(-0.6065306597126334f * sigmoidf_(wl[r] + w0c[d][t])) - 1.0f)), aq = bf2f(bf1(sigmoidf_(al[r] + a0c[d][t])));
                        const float kd = kqv[r] * (1.0f + (aq - 1.0f) * kac2[t]);
                        LAS float* L = (LAS float*)F.lds + (16 * tr + 4 * g + r) * FT_LD + 16 * (tc0 + t) + c15;
                        L[(0 + d) * (FT_ARR / 4)] = wv; L[(3 + d) * (FT_ARR / 4)] = kkv[r] * aq; L[(5 + d) * (FT_ARR / 4)] = kd;
                        bsum[r] += rqv[r] * kd * rkc2[t];
                    }
                }
            }
#pragma unroll
            for (int r = 0; r < 4; ++r) { float s = bsum[r]; s = dpp_add<0xB1>(s); s = dpp_add<0x4E>(s); s = dpp_add<0x124>(s); s = dpp_add<0x128>(s);
                if (c15 == 0) *(LAS float*)(F.lds + FT_BON + ((w & 1) * 64 + 16 * tr + 4 * g + r) * 4) = s; }
        }
        __syncthreads();
        if (F.tid < 64) BON[(row0 + F.tid) * 4 + h] = *(LAS float*)(F.lds + FT_BON + F.tid * 4) + *(LAS float*)(F.lds + FT_BON + (64 + F.tid) * 4);
#pragma unroll
        for (int d = 0; d < 2; ++d) {
            const int i = d ? 63 - n : n;
            const LAS float* L = (const LAS float*)F.lds + i * FT_LD + 8 * w;
            unsigned al8[4], be8[4], kp8[4], rh8[4]; float g63[8];
#pragma unroll
            for (int e2 = 0; e2 < 4; ++e2) {
                float alv[2], bev[2], kpv[2], rhv[2];
#pragma unroll
                for (int q = 0; q < 2; ++q) { const int e = 2 * e2 + q;
                    const float gi_ = wave_mulscan(L[(0 + d) * (FT_ARR / 4) + e]), gim1 = wave_shr1_one(gi_), ig = __builtin_amdgcn_rcpf(gi_);
                    g63[e] = rdlane(gi_, 63);
                    alv[q] = gim1 * L[2 * (FT_ARR / 4) + e]; bev[q] = L[(3 + d) * (FT_ARR / 4) + e] * ig; kpv[q] = L[(5 + d) * (FT_ARR / 4) + e] * ig; rhv[q] = gi_ * L[7 * (FT_ARR / 4) + e]; }
                al8[e2] = pk2h(alv[0], alv[1]); be8[e2] = pk2h(bev[0], bev[1]); kp8[e2] = pk2h(kpv[0], kpv[1]); rh8[e2] = pk2h(rhv[0], rhv[1]);
            }
            const size_t o = (size_t)d * MALL * 256 + (size_t)(64 * gi + i) * 256 + h * 64 + 8 * w;
            *(v4u*)((bf16*)(kws() + WS_GAL) + o) = (v4u){al8[0], al8[1], al8[2], al8[3]}; *(v4u*)((bf16*)(kws() + WS_GBE) + o) = (v4u){be8[0], be8[1], be8[2], be8[3]};
            *(v4u*)((bf16*)(kws() + WS_GKP) + o) = (v4u){kp8[0], kp8[1], kp8[2], kp8[3]}; *(v4u*)((bf16*)(kws() + WS_GRH) + o) = (v4u){rh8[0], rh8[1], rh8[2], rh8[3]};
            if (n < 8) { float gl = g63[0];
#pragma unroll
                for (int e = 1; e < 8; ++e) gl = (n == e) ? g63[e] : gl;
                GLT[((size_t)d * 272 + gi) * 256 + h * 64 + 8 * w + n] = gl; }
        }
    }
}

__device__ __forceinline__ int scan_row(int d, int b, int i) { if (i < CTXL) { const int t = d ? CTXL - 1 - i : i; return MLAT + b * CTXL + t; } const int j = i - CTXL, t = d ? SEQ - 1 - j : j; return b * SEQ + t; }

__device__ __forceinline__ void rwkv_readout(const Args& A, Frame& F, int l) {
    const int gw = F.bid * NWAVES + F.wave, NGW = F.G * NWAVES, nrows = l == 0 ? MALL : MLAT;
    const int h = gw & 3, n = F.lane, c = h * 64 + n;
    const bf16* P = (const bf16*)(kws() + WS_RP); const bf16* FV = (const bf16*)(kws() + WS_FV);
    const float* BON = (const float*)(kws() + WS_BON); bf16* Y = (bf16*)(kws() + WS_XN);
    float gupr[64];
#pragma unroll
    for (int j = 0; j < 64; ++j) gupr[j] = kin(I_RWGUP)[((size_t)l * 64 + j) * 256 + c];
    const float lng = kin(I_RWLNG)[l * 256 + c], lnb = kin(I_RWLNB)[l * 256 + c];
    bf16 q0 = 0, q1 = 0, qg = 0, qv = 0; float qb = 0.f;
#define RO_LOAD(r_) do { q0 = P[(size_t)(r_) * INP + c]; q1 = P[(size_t)(r_) * INP + 256 + c]; qg = P[(size_t)(r_) * INP + C_GD + n]; qv = FV[(size_t)(r_) * 256 + c]; qb = BON[(r_) * 4 + h]; } while (0)
    if ((gw >> 2) < nrows) RO_LOAD(gw >> 2);
    for (int row = gw >> 2; row < nrows; row += NGW >> 2) {
        const float ov = bf2f(q0) + bf2f(q1), gdv = bf2f(qg), vv = bf2f(qv), bon = qb;
        const int nxt = row + (NGW >> 2);
        if (nxt < nrows) RO_LOAD(nxt);
        const float mu = wave_sum(ov) * (1.0f / 64.0f), dv = ov - mu, var = wave_sum(dv * dv) * (1.0f / 64.0f);
        const float on = dv * rsqrtf(var + 64e-5f) * lng + lnb;
        const float sg = sigmoidf_(gdv);
        float g = 0.f;
#pragma unroll
        for (int j = 0; j < 64; ++j) g = fmaf(rdlane(sg, j), gupr[j], g);
        const float y = (on + bon * vv) * g;
        Y[(size_t)row * D + c] = bf1(y);
    }
#undef RO_LOAD
}


constexpr int CK_LD = 72, CK_MAT = 64 * CK_LD * 2, CK_HALF = 32 * CK_LD * 2;
constexpr int O_AL = 0, O_BE = 2 * CK_MAT, O_RH = 4 * CK_MAT, O_KP = 6 * CK_MAT, O_V = 7 * CK_MAT, O_AOFF = 8 * CK_MAT, O_MB = 10 * CK_MAT, O_BM = 12 * CK_MAT, O_MK = 13 * CK_MAT;
constexpr int O_SB = 14 * CK_MAT, O_YZ = O_SB + 2 * CK_HALF, O_UT = O_YZ + CK_HALF;
constexpr int CK_TD_LD = 40, CK_TDSZ = 64 * CK_TD_LD * 2;
constexpr int CK_TD = O_UT + CK_HALF;
constexpr int CK_ADG = CK_TD + 2 * CK_TDSZ;
constexpr int CK_GL = CK_ADG + 4096;
constexpr int CK_END = CK_GL + 512;
static_assert(CK_END <= LDSCTL_OFF, "chunk scan LDS map");
struct CkAddr { unsigned v1t, lds, vX0, vT0, vR0; };
typedef short v4s16 __attribute__((ext_vector_type(4)));
#define CKP(T, addr) ((LAS T*)(uintptr_t)(addr))
__device__ __forceinline__ bf16x8 ldtr(unsigned addr) {
    const v4s16 lo = __builtin_amdgcn_ds_read_tr16_b64_v4i16((LAS v4s16*)(uintptr_t)addr), hi = __builtin_amdgcn_ds_read_tr16_b64_v4i16((LAS v4s16*)(uintptr_t)(addr + 4 * CK_LD * 2));
    return __builtin_bit_cast(bf16x8, __builtin_shufflevector(lo, hi, 0, 1, 2, 3, 4, 5, 6, 7));
}
template <int KS, bool TRX, bool TRY> __device__ __forceinline__ void mm1(f32x4& acc, const CkAddr& K, unsigned ox, unsigned oy, int xt, int yt) {
    const unsigned ax = (TRX ? K.vR0 + xt * 32 : K.vX0 + xt * (16 * CK_LD * 2)) + ox;
    const unsigned ay = (TRY ? K.vR0 + yt * 32 : K.vX0 + yt * (16 * CK_LD * 2)) + oy;
#pragma unroll
    for (int ks = 0; ks < KS; ++ks) {
        const bf16x8 a = TRX ? ldtr(ax + ks * (32 * CK_LD * 2)) : *CKP(const bf16x8, ax + 64 * ks);
        const bf16x8 bq = TRY ? ldtr(ay + ks * (32 * CK_LD * 2)) : *CKP(const bf16x8, ay + 64 * ks);
        acc = __builtin_amdgcn_mfma_f32_16x16x32_bf16(a, bq, acc, 0, 0, 0); }
}
__device__ __forceinline__ void stT1(const CkAddr& K, unsigned o, int rt, int ct, const f32x4 v) {
    v2u q; q.x = pk2h(v[0], v[1]); q.y = pk2h(v[2], v[3]); *CKP(v2u, K.vT0 + o + ct * (16 * CK_LD * 2) + rt * 32) = q;
}
__device__ __forceinline__ void ck_tile4(const CkAddr& K, int xt, int yt, unsigned oAL, unsigned oBE, unsigned oRH, f32x4& pa, f32x4& pb, f32x4& pm, f32x4& pk) {
    pa = (f32x4){0.f, 0.f, 0.f, 0.f}; pb = pa; pm = pa; pk = pa;
    mm1<2, false, false>(pa, K, oBE, oAL, xt, yt); mm1<2, false, false>(pb, K, O_KP, oAL, xt, yt); mm1<2, false, false>(pm, K, oBE, oRH, xt, yt); mm1<2, false, false>(pk, K, O_KP, oRH, xt, yt);
}
__device__ __forceinline__ void rwkv_chunk_unit(const Args& A, Frame& F, int l, int sc, int vh) {
    const bool last = (l == 1);
    const int d = sc >> 4, b = (sc >> 2) & 3, h = sc & 3;
    const int w = F.wave, n = F.lane;
    const bf16* GAL = (const bf16*)(kws() + WS_GAL) + (size_t)d * MALL * 256; const bf16* GBE = (const bf16*)(kws() + WS_GBE) + (size_t)d * MALL * 256;
    const bf16* GKP = (const bf16*)(kws() + WS_GKP) + (size_t)d * MALL * 256; const bf16* GRH = (const bf16*)(kws() + WS_GRH) + (size_t)d * MALL * 256;
    const bf16* FV = (const bf16*)(kws() + WS_FV); const float* GLT = (const float*)(kws() + WS_GLT) + (size_t)d * 272 * 256;
    bf16* O = (bf16*)(kws() + WS_RP) + d * 256;
    constexpr int NCK = (CTXL + SEQ) / 64;
    v4u ual, ube, ukp, urh, uv; float fgl = 0.f;
#define CK_FETCH(cc_) do { const int cq_ = (cc_) < NCK ? (cc_) : NCK - 1; const int row_ = scan_row(d, b, 64 * cq_ + 8 * w + (n >> 3)); const size_t o_ = (size_t)row_ * 256 + h * 64 + 8 * (n & 7); \
        ual = *(const v4u*)(GAL + o_); ube = *(const v4u*)(GBE + o_); ukp = *(const v4u*)(GKP + o_); urh = *(const v4u*)(GRH + o_); uv = *(const v4u*)(FV + o_); \
        if (w == 0) fgl = GLT[(size_t)(scan_row(d, b, 64 * cq_) >> 6) * 256 + h * 64 + n]; } while (0)
    CK_FETCH(0);
    __syncthreads();
    { unsigned z_ = 0u; asm volatile("" : "+v"(z_));
      for (int i = F.tid; i < CK_END / 16; i += NTHR) *(LAS v4u*)(F.lds + i * 16) = (v4u){z_, z_, z_, z_}; }
    f32x4 st = (f32x4){0.f, 0.f, 0.f, 0.f};
    f32x4 st0 = st, yb0 = st, ob0 = st;
    __syncthreads();
    for (int c = -1; c < NCK; ++c) {
        int c15 = n & 15, g = n >> 4; asm volatile("" : "+v"(c15), "+v"(g));
        CkAddr K; K.lds = (unsigned)(uintptr_t)F.lds;
        K.v1t = K.lds + ((8 * w + (n >> 3)) * CK_LD + 8 * (n & 7)) * 2;
        K.vR0 = K.lds + ((8 * g + (c15 >> 2)) * CK_LD + 4 * (c15 & 3)) * 2;
        K.vX0 = K.lds + (c15 * CK_LD + 8 * g) * 2; K.vT0 = K.lds + (c15 * CK_LD + 4 * g) * 2;
        asm volatile("" : "+v"(K.v1t), "+v"(K.vX0), "+v"(K.vT0), "+v"(K.vR0));
        const int ti = w >> 1, tv = w & 1, tv2 = w >> 2, tk = w & 3;
        const unsigned pc = (unsigned)(c & 1), pn = pc ^ 1u;
        const unsigned oAL = O_AL + pc * CK_MAT, oBE = O_BE + pc * CK_MAT, oRH = O_RH + pc * CK_MAT, oAOFF = O_AOFF + pc * CK_MAT, oMB = O_MB + pc * CK_MAT, oSB = O_SB + pc * CK_HALF, oTD = CK_TD + pc * CK_TDSZ, oGL = CK_GL + pc * 256;
        const unsigned nAL = O_AL + pn * CK_MAT, nBE = O_BE + pn * CK_MAT, nRH = O_RH + pn * CK_MAT, nAOFF = O_AOFF + pn * CK_MAT, nMB = O_MB + pn * CK_MAT, nSB = O_SB + pn * CK_HALF, nTD = CK_TD + pn * CK_TDSZ, nGL = CK_GL + pn * 256;
        const bool skip_o = c < 0 || (last && c < CTXL / 64), skip_on = last && c + 1 < CTXL / 64;
        *CKP(v4u, K.v1t + nAL) = ual; *CKP(v4u, K.v1t + nBE) = ube; *CKP(v4u, K.v1t + O_KP) = ukp; *CKP(v4u, K.v1t + nRH) = urh; *CKP(v4u, K.v1t + O_V) = uv;
        if (w == 0) *CKP(float, K.lds + nGL + n * 4) = fgl;
        asm volatile("" ::: "memory");
        CK_FETCH(c + 2);
        { f32x4 yb = yb0; mm1<2, false, false>(yb, K, oAL, oSB, ti, tv); stT1(K, O_YZ, ti, tv, yb); }
        __syncthreads();
        if (w < 2) {
            const unsigned aX = K.lds + ((c15) * CK_LD + 8 * g) * 2;
            const unsigned bY = K.lds + ((16 * w + c15) * CK_LD + 8 * g) * 2;
            const unsigned cT = K.lds + ((16 * w + c15) * CK_LD + 4 * g) * 2;
#pragma unroll
            for (int blk = 0; blk < 4; ++blk) {
                f32x4 z = (f32x4){0.f, 0.f, 0.f, 0.f};
                if (blk > 0) {
#pragma unroll
                    for (int ks = 0; ks < (blk == 3 ? 2 : 1); ++ks) {
                        const bf16x8 a = *CKP(const bf16x8, aX + oAOFF + blk * (16 * CK_LD * 2) + 64 * ks);
                        const bf16x8 u = *CKP(const bf16x8, bY + O_UT + 64 * ks);
                        z = __builtin_amdgcn_mfma_f32_16x16x32_bf16(a, u, z, 0, 0, 0); }
                }
                { const v2u yv = *CKP(const v2u, cT + O_YZ + 32 * blk);
                  z[0] += __uint_as_float(yv.x << 16); z[1] += __uint_as_float(yv.x & 0xffff0000u); z[2] += __uint_as_float(yv.y << 16); z[3] += __uint_as_float(yv.y & 0xffff0000u); }
                { v2u zo; zo.x = pk2h(z[0], z[1]); zo.y = pk2h(z[2], z[3]); *CKP(v2u, cT + O_YZ + 32 * blk) = zo; }
                asm volatile("s_waitcnt lgkmcnt(0)" ::: "memory");
                const bf16x8 ta = *CKP(const bf16x8, K.lds + oTD + ((16 * blk + c15) * CK_TD_LD + 8 * g) * 2);
                const bf16x8 zb = *CKP(const bf16x8, bY + O_YZ + 32 * blk);
                f32x4 u = __builtin_amdgcn_mfma_f32_16x16x32_bf16(ta, zb, (f32x4){0.f, 0.f, 0.f, 0.f}, 0, 0, 0);
                { v2u uo; uo.x = pk2h(-u[0], -u[1]); uo.y = pk2h(-u[2], -u[3]); *CKP(v2u, cT + O_UT + 32 * blk) = uo; }
                asm volatile("s_waitcnt lgkmcnt(0)" ::: "memory");
            }
        } else if (w < 6) {
            const int bb = w - 2;
            f32x4 pa, pb, pm, pk; ck_tile4(K, bb, bb, nAL, nBE, nRH, pa, pb, pm, pk);
#pragma unroll
            for (int r = 0; r < 4; ++r) { const bool strict = 4 * g + r < c15, incl = 4 * g + r <= c15;
                pa[r] = strict ? pa[r] : 0.f; pb[r] = strict ? pb[r] : 0.f; pm[r] = incl ? pm[r] : 0.f; pk[r] = incl ? pk[r] : 0.f; }
            *CKP(f32x4, K.lds + CK_ADG + ((bb * 16 + c15) * 16 + 4 * g) * 4) = pa;
            stT1(K, O_BM, bb, bb, pb); stT1(K, nMB, bb, bb, pm); stT1(K, O_MK, bb, bb, pk);
            asm volatile("s_waitcnt lgkmcnt(0)" ::: "memory");
            if (n < 16) { float tcol[16];
                f32x4 arow[16][4];
#pragma unroll
                for (int r = 1; r < 16; ++r)
#pragma unroll
                    for (int s4 = 0; s4 * 4 < r; ++s4) arow[r][s4] = *CKP(const f32x4, K.lds + CK_ADG + ((bb * 16 + r) * 16 + 4 * s4) * 4);
#pragma unroll
                for (int r = 0; r < 16; ++r) { float acc = (r == n) ? 1.f : 0.f;
#pragma unroll
                    for (int s = 0; s < r; ++s) acc = fmaf(-arow[r][s >> 2][s & 3], tcol[s], acc);
                    tcol[r] = acc; *CKP(bf16, K.lds + nTD + ((16 * bb + r) * CK_TD_LD + n) * 2) = bf1(acc); }
            }
        } else {
#pragma unroll
            for (int q = 0; q < 3; ++q) {
                const int xt = (w & 1) ? (q == 0 ? 1 : 0) : (q == 0 ? 0 : q == 1 ? 2 : 1), yt = (w & 1) ? (q == 2 ? 3 : 2) : (q == 0 ? 1 : 3);
                f32x4 pa, pb, pm, pk; ck_tile4(K, xt, yt, nAL, nBE, nRH, pa, pb, pm, pk);
                stT1(K, nAOFF, xt, yt, pa); stT1(K, O_BM, xt, yt, pb); stT1(K, nMB, xt, yt, pm); stT1(K, O_MK, xt, yt, pk);
            }
        }
        __syncthreads();
        if (!skip_o) {
            f32x4 ob = ob0;
            mm1<2, false, false>(ob, K, oSB, oRH, tv, ti); mm1<2, false, false>(ob, K, O_UT, oMB, tv, ti);
            const int row = scan_row(d, b, 64 * c + 16 * ti + c15); v2u oo; oo.x = pk2h(ob[0], ob[1]); oo.y = pk2h(ob[2], ob[3]);
            *(v2u*)(O + (size_t)row * INP + h * 64 + 32 * vh + 16 * tv + 4 * g) = oo;
        }
        { mm1<2, true, false>(st, K, oBE, O_UT, tk, tv2);
          const f32x4 gl = *CKP(const f32x4, K.lds + oGL + (16 * tk + 4 * g) * 4); st = (st + st0) * gl; stT1(K, nSB, tk, tv2, st); }
        yb0 = (f32x4){0.f, 0.f, 0.f, 0.f}; ob0 = yb0; st0 = yb0;
        mm1<2, false, true>(yb0, K, O_BM, O_V, ti, 2 * vh + tv);
        if (!skip_on) mm1<2, true, false>(ob0, K, O_V, O_MK, 2 * vh + tv, ti);
        mm1<2, true, true>(st0, K, O_KP, O_V, tk, 2 * vh + tv2);
        __syncthreads();
    }
#undef CK_FETCH
}
#undef CKP

struct KeyStream { int ctx_row0, nloc, loc_row0, loc_pos0; };
constexpr int AT_K = 0, AT_V = 9216, AT_BUF = 18688;
typedef float f32x4a __attribute__((ext_vector_type(4)));

template <int NMAP, int DK, int QS, bool MASK>
__device__ __forceinline__ void attn_core(Frame& F, const bf16* P, int kcol, int vcol, const KeyStream ks, const bf16x8 (&qf)[QS][NMAP][DK / 32], int qpos0,
                                          f32x4 (&o)[QS][NMAP][4], float (&m)[QS][NMAP], float (&lsum)[QS][NMAP]) {
    const int c15 = F.lane & 15, g = F.lane >> 4;
    const int lkey = F.tid >> 3, lch = F.tid & 7;
    const int ntiles = 4 + ks.nloc;
#pragma unroll
    for (int qs = 0; qs < QS; ++qs)
#pragma unroll
        for (int mp = 0; mp < NMAP; ++mp) { m[qs][mp] = 0.f; lsum[qs][mp] = 0.f;
#pragma unroll
            for (int dt = 0; dt < 4; ++dt) o[qs][mp][dt] = (f32x4){0.f, 0.f, 0.f, 0.f}; }
    v4u stgk, stgv;
#define AT_LOAD(ti) do { const int rb_ = (ti) < 4 ? ks.ctx_row0 + 64 * (ti) : ks.loc_row0 + 64 * ((ti) - 4); \
        const bf16* p_ = P + (size_t)(rb_ + lkey) * INP + 8 * lch; stgk = *(const v4u*)(p_ + kcol); stgv = *(const v4u*)(p_ + vcol); } while (0)
#define AT_WRITE(bi) do { LAS unsigned char* b_ = F.lds + (bi) * AT_BUF; \
        *(LAS v4u*)(b_ + AT_K + lkey * 144 + lch * 16) = stgk; \
        _Pragma("unroll") for (int i_ = 0; i_ < 8; ++i_) { const unsigned w_ = stgv[i_ >> 1]; *(LAS bf16*)(b_ + AT_V + (8 * lch + i_) * 144 + 16 * lch + lkey * 2) = (bf16)((i_ & 1) ? (w_ >> 16) : (w_ & 0xffffu)); } } while (0)
    __syncthreads();
    AT_LOAD(0); AT_WRITE(0);
    __syncthreads();
#define AT_QK(dst, sx_) do { bf16x8 kf_[2][NMAP][DK / 32]; \
        _Pragma("unroll") for (int kh = 0; kh < 2; ++kh) _Pragma("unroll") for (int mp = 0; mp < NMAP; ++mp) _Pragma("unroll") for (int kx = 0; kx < DK / 32; ++kx) \
            kf_[kh][mp][kx] = *(LAS bf16x8*)(bb + AT_K + (32 * (sx_) + 16 * kh + c15) * 144 + (mp * DK + 32 * kx + 8 * g) * 2); \
        _Pragma("unroll") for (int qs = 0; qs < QS; ++qs) _Pragma("unroll") for (int mp = 0; mp < NMAP; ++mp) { const float negm = -m[qs][mp]; \
            _Pragma("unroll") for (int kh = 0; kh < 2; ++kh) { dst[qs][mp][kh] = (f32x4){negm, negm, negm, negm}; \
                _Pragma("unroll") for (int kx = 0; kx < DK / 32; ++kx) dst[qs][mp][kh] = __builtin_amdgcn_mfma_f32_16x16x32_bf16(kf_[kh][mp][kx], qf[qs][mp][kx], dst[qs][mp][kh], 0, 0, 0); } } } while (0)
#define AT_MASK(dst, sx_) do { if (MASK && ti >= 4) { const int kb_ = ks.loc_pos0 + 64 * (ti - 4) + 32 * (sx_); \
        if (kb_ + 31 - qpos0 > 128 || kb_ - (qpos0 + 16 * QS - 1) < -128) {       \
            _Pragma("unroll") for (int qs = 0; qs < QS; ++qs) { const int qp_ = qpos0 + 16 * qs + c15; \
                _Pragma("unroll") for (int mp = 0; mp < NMAP; ++mp) _Pragma("unroll") for (int kh = 0; kh < 2; ++kh) _Pragma("unroll") for (int r = 0; r < 4; ++r) { \
                    const int dd_ = kb_ + 4 * g + 16 * kh + r - qp_; dst[qs][mp][kh][r] = (dd_ > 128 || dd_ < -128) ? -INFINITY : dst[qs][mp][kh][r]; } } } } } while (0)
    for (int ti = 0; ti < ntiles; ++ti) {
        LAS unsigned char* bb = F.lds + (ti & 1) * AT_BUF;
        f32x4 st[QS][NMAP][2], sn[QS][NMAP][2];
        AT_QK(st, 0);
#pragma unroll
        for (int sx = 0; sx < 2; ++sx) {
        if (sx == 1) { const int tn_ = ti + 1 < ntiles ? ti + 1 : ntiles - 1; AT_LOAD(tn_); }
        bf16x8 vf[4];
#pragma unroll
        for (int dt = 0; dt < 4; ++dt) { const v2u a = *(LAS v2u*)(bb + AT_V + (c15 + 16 * dt) * 144 + 16 * (2 * dt + (c15 >> 3)) + (32 * sx + 4 * g) * 2), b2 = *(LAS v2u*)(bb + AT_V + (c15 + 16 * dt) * 144 + 16 * (2 * dt + (c15 >> 3)) + (32 * sx + 16 + 4 * g) * 2);
            const v4u w = (v4u){a.x, a.y, b2.x, b2.y}; vf[dt] = __builtin_bit_cast(bf16x8, w); }
        if (sx == 0) { AT_QK(sn, 1); __builtin_amdgcn_sched_barrier(0); }
        float p[QS][NMAP][8], ps[QS][NMAP];
        AT_MASK(st, sx);
        float big = 0.f;
#pragma unroll
        for (int qs = 0; qs < QS; ++qs)
#pragma unroll
            for (int mp = 0; mp < NMAP; ++mp) { float s_ = 0.f;
#pragma unroll
                for (int kh = 0; kh < 2; ++kh)
#pragma unroll
                    for (int r = 0; r < 4; ++r) { p[qs][mp][kh * 4 + r] = __builtin_amdgcn_exp2f(st[qs][mp][kh][r]); s_ += p[qs][mp][kh * 4 + r]; }
                ps[qs][mp] = s_; big = fmaxf(big, s_); }
        if (__builtin_amdgcn_ballot_w64(!(big < 1048576.0f)) != 0ull) {
            f32x4 sr[QS][NMAP][2];
            AT_QK(sr, sx); AT_MASK(sr, sx);
#pragma unroll
            for (int qs = 0; qs < QS; ++qs)
#pragma unroll
                for (int mp = 0; mp < NMAP; ++mp) {
                    float mt = fmaxf(fmaxf(fmaxf(sr[qs][mp][0][0], sr[qs][mp][0][1]), fmaxf(sr[qs][mp][0][2], sr[qs][mp][0][3])), fmaxf(fmaxf(sr[qs][mp][1][0], sr[qs][mp][1][1]), fmaxf(sr[qs][mp][1][2], sr[qs][mp][1][3])));
                    mt = xmax4(mt);
                    const float delta = mt > 8.0f ? mt : 0.f, alpha = __builtin_amdgcn_exp2f(-delta);
                    m[qs][mp] += delta; lsum[qs][mp] *= alpha;
#pragma unroll
                    for (int dt = 0; dt < 4; ++dt) o[qs][mp][dt] = o[qs][mp][dt] * alpha;
                    if (sx == 0) {
#pragma unroll
                        for (int kh = 0; kh < 2; ++kh) sn[qs][mp][kh] = sn[qs][mp][kh] - delta; }
                    float s_ = 0.f;
#pragma unroll
                    for (int kh = 0; kh < 2; ++kh)
#pragma unroll
                        for (int r = 0; r < 4; ++r) { p[qs][mp][kh * 4 + r] = __builtin_amdgcn_exp2f(sr[qs][mp][kh][r] - delta); s_ += p[qs][mp][kh * 4 + r]; }
                    ps[qs][mp] = s_;
                }
        }
#pragma unroll
        for (int qs = 0; qs < QS; ++qs)
#pragma unroll
            for (int mp = 0; mp < NMAP; ++mp) {
                lsum[qs][mp] += ps[qs][mp];
                const v4u pw = (v4u){pk2h(p[qs][mp][0], p[qs][mp][1]), pk2h(p[qs][mp][2], p[qs][mp][3]), pk2h(p[qs][mp][4], p[qs][mp][5]), pk2h(p[qs][mp][6], p[qs][mp][7])};
                const bf16x8 pf = __builtin_bit_cast(bf16x8, pw);
#pragma unroll
                for (int dt = 0; dt < 4; ++dt) o[qs][mp][dt] = __builtin_amdgcn_mfma_f32_16x16x32_bf16(vf[dt], pf, o[qs][mp][dt], 0, 0, 0);
            }
        if (sx == 0) {
#pragma unroll
            for (int qs = 0; qs < QS; ++qs)
#pragma unroll
                for (int mp = 0; mp < NMAP; ++mp) { st[qs][mp][0] = sn[qs][mp][0]; st[qs][mp][1] = sn[qs][mp][1]; } }
        }
        AT_WRITE((ti + 1) & 1);
        __syncthreads();
    }
#undef AT_QK
#undef AT_MASK
#undef AT_LOAD
#undef AT_WRITE
}

template <int QS>
__device__ __forceinline__ void diff_unit(const Args& A, Frame& F, int l, int b, int h, int qrow0, int nloc) {
    const bf16* P = (const bf16*)(kws() + WS_RP); bf16* Y = (bf16*)(kws() + WS_XN); const float* tab = (const float*)(kws() + WS_TAB);
    const int c15 = F.lane & 15, g = F.lane >> 4;
    bf16x8 qf[QS][2][1];
#pragma unroll
    for (int qs = 0; qs < QS; ++qs)
#pragma unroll
        for (int mp = 0; mp < 2; ++mp) qf[qs][mp][0] = *(const bf16x8*)(P + (size_t)(qrow0 + 16 * QS * F.wave + 16 * qs + c15) * INP + C_DFQ + h * 64 + mp * 32 + 8 * g);
    f32x4 o[QS][2][4]; float m[QS][2], ls[QS][2];
    const KeyStream ks{MLAT + b * CTXL, nloc, b * SEQ, 0};
    attn_core<2, 32, QS, false>(F, P, C_DFK + h * 64, C_DFV + h * 64, ks, qf, 0, o, m, ls);
    const float lam = tab[3072 + l], oscale = 1.0f - tab[3074 + l];
    const float* ng = kin(I_DFNG) + l * 64;
#pragma unroll
    for (int qs = 0; qs < QS; ++qs) {
        float inv[2];
#pragma unroll
        for (int mp = 0; mp < 2; ++mp) { float t = ls[qs][mp]; t += __shfl_xor(t, 16); t += __shfl_xor(t, 32); inv[mp] = 1.0f / t; }
        f32x4 ov[4]; float ss = 0.f;
#pragma unroll
        for (int dt = 0; dt < 4; ++dt) { ov[dt] = o[qs][0][dt] * inv[0] - o[qs][1][dt] * (lam * inv[1]); ss += (ov[dt][0] * ov[dt][0] + ov[dt][1] * ov[dt][1]) + (ov[dt][2] * ov[dt][2] + ov[dt][3] * ov[dt][3]); }
        ss += __shfl_xor(ss, 16); ss += __shfl_xor(ss, 32);
        const float r = rsqrtf(ss * (1.0f / 64.0f) + NORM_EPS) * oscale;
        bf16* yp = Y + (size_t)(qrow0 + 16 * QS * F.wave + 16 * qs + c15) * D + 256 + h * 64 + 4 * g;
#pragma unroll
        for (int dt = 0; dt < 4; ++dt) { const f32x4 gg = *(const f32x4*)(ng + 16 * dt + 4 * g); const f32x4 v = ov[dt] * r * gg;
            v2u w; w.x = pk2h(v[0], v[1]); w.y = pk2h(v[2], v[3]); *(v2u*)(yp + 16 * dt) = w; }
    }
}
__device__ __forceinline__ void gq_unit(const Args& A, Frame& F, int l, int b, int kv, int qrow0, int qpos_blk  ) {
    const bf16* P = (const bf16*)(kws() + WS_RP); bf16* Y = (bf16*)(kws() + WS_XN);
    const int c15 = F.lane & 15, g = F.lane >> 4;
    const int hq = kv * 4 + (F.wave >> 1), rbase = qrow0 + 64 * (F.wave & 1);
    bf16x8 qf[4][1][2];
#pragma unroll
    for (int qs = 0; qs < 4; ++qs)
#pragma unroll
        for (int kx = 0; kx < 2; ++kx) qf[qs][0][kx] = *(const bf16x8*)(P + (size_t)(rbase + 16 * qs + c15) * INP + C_GQQ + hq * 64 + 32 * kx + 8 * g);
    KeyStream ks{MLAT + b * CTXL, 0, 0, 0}; int qpos0 = 0;
    if (qpos_blk >= 0) { const int lo = qpos_blk > 0 ? (qpos_blk - 1) * 128 : 0, hi = qpos_blk < 31 ? (qpos_blk + 2) * 128 : SEQ;
        ks.nloc = (hi - lo) / 64; ks.loc_row0 = b * SEQ + lo; ks.loc_pos0 = lo; qpos0 = qpos_blk * 128 + 64 * (F.wave & 1); }
    f32x4 o[4][1][4]; float m[4][1], ls[4][1];
    attn_core<1, 64, 4, true>(F, P, C_GQK + kv * 64, C_GQV + kv * 64, ks, qf, qpos0, o, m, ls);
    const float sink2 = kin(I_GQSINK)[l * 8 + hq] * LOG2E;
#pragma unroll
    for (int qs = 0; qs < 4; ++qs) {
        float t = ls[qs][0]; t += __shfl_xor(t, 16); t += __shfl_xor(t, 32);
        const float mf = fmaxf(m[qs][0], sink2), e = __builtin_amdgcn_exp2f(m[qs][0] - mf), den = t * e + __builtin_amdgcn_exp2f(sink2 - mf), scl = e / den;
        bf16* yp = Y + (size_t)(rbase + 16 * qs + c15) * D + 512 + hq * 64 + 4 * g;
#pragma unroll
        for (int dt = 0; dt < 4; ++dt) { const f32x4 v = o[qs][0][dt] * scl; v2u w; w.x = pk2h(v[0], v[1]); w.y = pk2h(v[2], v[3]); *(v2u*)(yp + 16 * dt) = w; }
    }
}
__device__ __forceinline__ void phase_queue(const Args& A, Frame& F, int l, int rep) {
    gu32* head = (gu32*)(kws() + WS_CTL) + CW_QUEUE + 64 * l + 16 * rep;
    constexpr int DF_BIG = 256;
    const int total = 64 + DF_BIG + 2 * (256 - DF_BIG) + 256 + (l == 0 ? 48 + WI_FILL : 0);
    volatile LAS int* slot = (volatile LAS int*)(F.lds + MISC_OFF) + 16;
    for (;;) {
        asm volatile("" : "+v"(F.tid), "+v"(F.lane));
        __syncthreads();
        if (F.tid == 0) *slot = (int)__hip_atomic_fetch_add(head, 1u, __ATOMIC_RELAXED, __HIP_MEMORY_SCOPE_AGENT);
        __syncthreads();
        int u = __builtin_amdgcn_readfirstlane(*slot);
        if (u >= total) break;
#if MK_AMP & 1
        if (u < 64) { const unsigned long long t0_ = __builtin_amdgcn_s_memrealtime(); rwkv_chunk_unit(A, F, l, u >> 1, u & 1); const unsigned long long t1_ = __builtin_amdgcn_s_memrealtime();
            while (__builtin_amdgcn_s_memrealtime() - t1_ < t1_ - t0_) __builtin_amdgcn_s_sleep(8); continue; }
#endif
        if (u < 64) { rwkv_chunk_unit(A, F, l, u >> 1, u & 1); continue; }
        u -= 64;
#if MK_AMP & 2
        if (u < DF_BIG) { const unsigned long long t0_ = __builtin_amdgcn_s_memrealtime(); { const int b = u >> 6, h = (u >> 4) & 3, qb = u & 15; diff_unit<2>(A, F, l, b, h, b * SEQ + qb * 256, SEQ / 64); } const unsigned long long t1_ = __builtin_amdgcn_s_memrealtime();
            while (__builtin_amdgcn_s_memrealtime() - t1_ < t1_ - t0_) __builtin_amdgcn_s_sleep(8); continue; }
#endif
        if (u < DF_BIG) { const int b = u >> 6, h = (u >> 4) & 3, qb = u & 15; diff_unit<2>(A, F, l, b, h, b * SEQ + qb * 256, SEQ / 64); continue; }
        if (u < DF_BIG + 2 * (256 - DF_BIG)) { const int v = 2 * DF_BIG + (u - DF_BIG), b = v >> 7, h = (v >> 5) & 3, qh = v & 31; diff_unit<1>(A, F, l, b, h, b * SEQ + qh * 128, SEQ / 64); continue; }
        u -= DF_BIG + 2 * (256 - DF_BIG) - 512;
        u -= 512;
        if (u < 256) { const int b = u >> 6, kv = (u >> 5) & 1, nb = u & 31; gq_unit(A, F, l, b, kv, b * SEQ + nb * 128, nb); continue; }
        u -= 256;
        if (u < 32) { const int b = u >> 3, h = (u >> 1) & 3, hf = u & 1; diff_unit<1>(A, F, l, b, h, MLAT + b * CTXL + hf * 128, 0); continue; }
        u -= 32;
        if (u < 16) { const int b = u >> 2, kv = (u >> 1) & 1, hf = u & 1; gq_unit(A, F, l, b, kv, MLAT + b * CTXL + hf * 128, -1); continue; }
        u -= 16;
        { LAS float* scr = (LAS float*)(F.lds + F.wave * 16384);
          for (int k = 0; k < 16; ++k) { const int it = WI_IN + u * 128 + F.wave * 16 + k; if (it < 2 * WI_LAYER) weight_item(it, scr, F.lane); } }
    }
}

constexpr int N_PHASES = (MK_FUSE == 3) ? 18 : 20;
}

__global__ void __launch_bounds__(mk::NTHR, 2) mega_fwd(mk::Args A) {
    using namespace mk;
    extern __shared__ __attribute__((aligned(16))) unsigned char lds_raw[];
    Frame F;
    F.lds = (LAS unsigned char*)lds_raw;
    F.tid = threadIdx.x; asm volatile("" : "+v"(F.tid)); F.lane = F.tid & 63; F.wave = __builtin_amdgcn_readfirstlane(F.tid >> 6);
    F.G = gridDim.x; F.bid = blockIdx.x;
    for (int u = F.tid; u < (LDS_BYTES - LDSCTL_OFF) / 4; u += NTHR) ((LAS unsigned*)(F.lds + LDSCTL_OFF))[u] = 0u;
    __syncthreads();
    gu32* ctl = (gu32*)(kws() + WS_CTL);
    XcdBarrier bar; bar.bar = (unsigned*)(ctl + CW_BAR); bar.x = 0; bar.st = nullptr; bar.tid = F.tid;
    const bool multi = (A.ph_hi - A.ph_lo) > 1;
    if (multi) bar = xcd_barrier_post((unsigned*)(ctl + CW_BAR), (volatile LAS unsigned*)(F.lds + MISC_OFF) + 8, F.tid);

    for (int ph = A.ph_lo, rep = 0; ph < A.ph_hi;) {
        { int t_ = F.tid, l_ = F.lane, w_ = F.wave, g_ = F.G, b_ = F.bid; unsigned p_ = (unsigned)(uintptr_t)F.lds;
          w_ = __builtin_amdgcn_readfirstlane(w_); g_ = __builtin_amdgcn_readfirstlane(g_); b_ = __builtin_amdgcn_readfirstlane(b_); p_ = __builtin_amdgcn_readfirstlane(p_);
          asm volatile("" : "+v"(t_), "+v"(l_)); asm volatile("" : "+s"(w_), "+s"(g_), "+s"(b_), "+s"(p_));
          F.tid = t_; F.lane = l_; F.wave = w_; F.G = g_; F.bid = b_; F.lds = (LAS unsigned char*)(uintptr_t)p_; }
        int kind = 0, l = 0, hf = 0;
        if (ph == 1) kind = 1;
        else if (ph > 1 && ph < 11) { l = 0; const int r = ph - 2; kind = r < 6 ? 2 + r : (r == 6 ? 8 : (r == 7 ? 10 : 11)); }
        else if (ph >= 11) { l = 1; const int r = ph - 11; kind = r < 5 ? 2 + r : (r == 5 ? 8 : 10); }
        const int nrows = (l == 0) ? MALL : MLAT;
        const int r0 = 0, r1 = nrows; (void)hf;
        const bool is_gemm = (kind == 2 || kind == 6 || kind == 8 || kind == 10);
        if (is_gemm) { if (MK_KINDS & 0x544) {
          const int nparts = ((kind == 6 || kind == 10) && l == 0) ? 2 : 1;
          for (int part = 0; part < nparts; ++part) {
            pg8::Gemm g; EpiMulti E; E.tab = (const float*)(kws() + WS_TAB); E.ob = nullptr; E.of = nullptr; E.ld = 0; E.mode = 0; E.cw = nullptr; E.cb = nullptr; E.nrows = 0; E.ldsx = 0u; E.xin = nullptr; E.xout = nullptr; E.xn = nullptr; E.gA = E.gaA = E.gB = E.scB = E.shB = nullptr; E.xb0 = E.xb1 = nullptr; E.cnt0 = E.cnt1 = nullptr; E.two = 0;
            if (kind == 2) { g = pg8::Gemm{(const pg8::bf16_t*)(kws() + WS_XN), (const pg8::bf16_t*)(kws() + WS_WIN + l * WIN_BYTES), MALL, INP, D, 256, D, 0}; E.mode = 0; E.ob = (bf16*)(kws() + WS_RP); E.ld = INP; }
            else if (kind == 6 && part == 0 && !(MK_FUSE & 1)) { g = pg8::Gemm{(const pg8::bf16_t*)(kws() + WS_XN), (const pg8::bf16_t*)(kws() + WS_WOUT + l * WOUT_BYTES), MLAT, D, D, 256, D, 0}; E.mode = 2; E.ob = (bf16*)(kws() + WS_RP); E.ld = D; }
            else if (kind == 6 && part == 0) { g = pg8::Gemm{(const pg8::bf16_t*)(kws() + WS_XN), (const pg8::bf16_t*)(kws() + WS_WOUT + l * WOUT_BYTES), MLAT, D, D, 256, D, 0};
                E.mode = 5; E.xin = l == 0 ? kin(I_X) : kout(); E.xout = kout(); E.xn = (bf16*)(kws() + WS_XN); E.gA = normg_vec(A, l, 1); E.gaA = mod_vec(A, l, 0, 2); E.two = 1; E.gB = normg_vec(A, l, 2); E.scB = mod_vec(A, l, 0, 4); E.shB = mod_vec(A, l, 0, 3);
                E.xb0 = (float*)(kws() + WS_XB) + (size_t)((l * 2 + 0) * 2 + 0) * MLAT * 4; E.xb1 = (float*)(kws() + WS_XB) + (size_t)((l * 2 + 0) * 2 + 1) * MLAT * 4;
                E.cnt0 = (gu32*)(kws() + WS_CTL) + CW_PST + ((l * 2 + 0) * 2 + 0) * 4096; E.cnt1 = (gu32*)(kws() + WS_CTL) + CW_PST + ((l * 2 + 0) * 2 + 1) * 4096; }
            else if (kind == 6) { g = pg8::Gemm{(const pg8::bf16_t*)(kws() + WS_XN) + (size_t)MLAT * D, (const pg8::bf16_t*)(kws() + WS_WOUT + l * WOUT_BYTES), 256 * 4 * 4, D, 256, 256, D, 4}; E.mode = 2; E.ob = (bf16*)(kws() + WS_SLO); E.ld = D; }
            else if (kind == 8) { const int nmu = (nrows + 253) / 254;
                g = pg8::Gemm{(const pg8::bf16_t*)(kws() + WS_XN) - D, (const pg8::bf16_t*)(kws() + WS_WGU + l * WGU_BYTES), 256 * nmu, NGU, D, 254, D, 0};
                E.mode = 3; E.ob = (bf16*)(kws() + WS_ACT); E.ld = DFF; E.cw = kin(I_FFCW) + (size_t)l * 3 * DFF; E.cb = kin(I_FFCB) + (size_t)l * DFF; E.nrows = nrows; E.ldsx = (unsigned)(uintptr_t)F.lds + 131072u; }
            else if (part == 0 && !(MK_FUSE & 2)) { g = pg8::Gemm{(const pg8::bf16_t*)(kws() + WS_ACT), (const pg8::bf16_t*)(kws() + WS_WD + l * WD_BYTES), MLAT, D, DFF, 256, DFF, 0}; E.mode = 2; E.ob = (bf16*)(kws() + WS_FP); E.ld = D; }
            else if (part == 0) { g = pg8::Gemm{(const pg8::bf16_t*)(kws() + WS_ACT), (const pg8::bf16_t*)(kws() + WS_WD + l * WD_BYTES), MLAT, D, DFF, 256, DFF, 0};
                E.mode = 6; E.xin = kout(); E.xout = kout(); E.xn = (bf16*)(kws() + WS_XN); E.gA = normg_vec(A, l, 3); E.gaA = mod_vec(A, l, 0, 5); E.two = l == 0; E.gB = normg_vec(A, 1, 0); E.scB = mod_vec(A, 1, 0, 1); E.shB = mod_vec(A, 1, 0, 0);
                E.xb0 = (float*)(kws() + WS_XB) + (size_t)((l * 2 + 1) * 2 + 0) * MLAT * 4; E.xb1 = (float*)(kws() + WS_XB) + (size_t)((l * 2 + 1) * 2 + 1) * MLAT * 4;
                E.cnt0 = (gu32*)(kws() + WS_CTL) + CW_PST + ((l * 2 + 1) * 2 + 0) * 4096; E.cnt1 = (gu32*)(kws() + WS_CTL) + CW_PST + ((l * 2 + 1) * 2 + 1) * 4096; }
            else { g = pg8::Gemm{(const pg8::bf16_t*)(kws() + WS_ACT) + (size_t)MLAT * DFF, (const pg8::bf16_t*)(kws() + WS_WD + l * WD_BYTES), 256 * 4 * 11, D, 256, 256, DFF, 4}; E.mode = 2; E.ob = (bf16*)(kws() + WS_SLD); E.ld = D; }
            pg8::StaticOrder S; S.init(g.M, g.N, F.G, F.bid);
            pg8::gemm_phase<EpiMulti, pg8::StaticOrder, true, true>(F.lds, g, S, E, F.tid);
          }
        } } else {
            switch (kind) {
                case 0: if ((MK_KINDS >> 0) & 1) { p0_prologue(A, F); } break;
                case 1: if (((MK_KINDS >> 1) & 1) && l == 0) phase_prep(A, F); break;
                case 3: if ((MK_KINDS >> 3) & 1) rwkv_features(A, F, l); break;
                case 4: if ((MK_KINDS >> 4) & 1) phase_queue(A, F, l, rep); break;
                case 5: if ((MK_KINDS >> 5) & 1) rwkv_readout(A, F, l); break;
                case 7: if ((MK_KINDS >> 7) & 1) phase_e1(A, F, l); break;
                case 9: if ((MK_KINDS >> 9) & 1) phase_act(A, F, l, r0, r1); break;
                case 11: if ((MK_KINDS >> 11) & 1) phase_e2(A, F, l, r0, r1); break;
                default: break;
            }
        }
        const bool again = (rep == 0) && ((MK_REPEAT >> kind) & 1);
        if (ph + 1 < A.ph_hi || again) { bar.bar = (unsigned*)((gu32*)(kws() + WS_CTL) + CW_BAR); bar.tid = F.tid; xcd_barrier(bar); }
        if (again) rep = 1; else { rep = 0; ++ph; }
    }
}

extern "C" void kernel_launch(void* const* d_in, const int* in_sizes, int n_in, void* d_out, int out_size, void* d_ws, size_t ws_size, hipStream_t stream) {
    using namespace mk;
    static int grid = 0;
    if (grid == 0) {
        if (n_in != N_IN || out_size != MLAT * D || ws_size < WS_END) { fprintf(stderr, "kernel_launch: unexpected shapes (n_in %d, out %d, ws %zu); nothing launched\n", n_in, out_size, ws_size); grid = -1; return; }
        int dev = 0, cus = 0, per_cu = 0;
        if (hipGetDevice(&dev) != hipSuccess || hipDeviceGetAttribute(&cus, hipDeviceAttributeMultiprocessorCount, dev) != hipSuccess) { grid = -1; return; }
        if (hipFuncSetAttribute((const void*)mega_fwd, hipFuncAttributeMaxDynamicSharedMemorySize, LDS_BYTES) != hipSuccess) { fprintf(stderr, "kernel_launch: hipFuncSetAttribute failed\n"); grid = -1; return; }
        if (hipOccupancyMaxActiveBlocksPerMultiprocessor(&per_cu, (const void*)mega_fwd, NTHR, LDS_BYTES) != hipSuccess || per_cu < 1) { fprintf(stderr, "kernel_launch: occupancy query says %d blocks/CU\n", per_cu); per_cu = 1; }
        (void)hipGetLastError();
        grid = cus;
    }
    if (grid < 0) return;
    (void)hipMemsetAsync((char*)d_ws + WS_CTL, 0, CTL_ZERO_BYTES, stream);
    Args a{};
    for (int i = 0; i < N_IN; ++i) a.in[i] = (const float*)d_in[i];
    a.out = (float*)d_out; a.ws = (unsigned char*)d_ws;
#if MK_PER_PHASE
    for (int ph = 0; ph < N_PHASES; ++ph) { a.ph_lo = ph; a.ph_hi = ph + 1; hipLaunchKernelGGL(mega_fwd, dim3(grid), dim3(NTHR), LDS_BYTES, stream, a); }
#else
    a.ph_lo = 0; a.ph_hi = N_PHASES;
    void* args[] = {&a};
    hipError_t e = hipLaunchCooperativeKernel((const void*)mega_fwd, dim3(grid), dim3(NTHR), args, LDS_BYTES, stream);
    if (e != hipSuccess) fprintf(stderr, "kernel_launch: cooperative launch failed: %s (grid %d)\n", hipGetErrorString(e), grid);
#endif
}
```

```cpp
#include <hip/hip_runtime.h>
#include <hip/hip_cooperative_groups.h>
#include <cstdio>
#include <cstdint>
#ifndef MK_PER_PHASE
#define MK_PER_PHASE 0
#endif
#ifndef MK_KINDS
#define MK_KINDS 0xFFF
#endif
#ifndef MK_REPEAT
#define MK_REPEAT 0
#endif
#ifndef MK_RWDUP
#define MK_RWDUP 0
#endif
#ifndef MK_AMP
#define MK_AMP 0
#endif
#ifndef MK_FUSE
#define MK_FUSE 3
#endif
#ifdef MK_DBGDRAIN
#define MK_DBGD 1
#else
#define MK_DBGD 0
#endif
namespace pg8 {
#define PG8_LAS __attribute__((address_space(3)))
typedef unsigned short bf16_t;
typedef short bf16x8 __attribute__((ext_vector_type(8)));
typedef float f32x4 __attribute__((ext_vector_type(4)));
typedef unsigned u32x4 __attribute__((ext_vector_type(4)));
constexpr int BM = 256, BK = 64, HALF = 128, HTB = HALF * BK * 2  , STAGE_BYTES = 8 * HTB, NXCD = 8, WGM = 8;

__host__ __device__ __forceinline__ int lds_byte(int r, int c) { const int st = (r >> 4) * 2 + (c >> 5), rr = r & 15, cc = c & 31, ob = rr * 64 + cc * 2; return st * 1024 + (ob ^ (((ob >> 9) & 1) << 5)); }
__host__ __device__ __forceinline__ void stage_rc(int b, int& R, int& C) { const int st = b / 1024, sb = b % 1024, swz = sb ^ (((sb >> 9) & 1) << 5); R = (st >> 1) * 16 + swz / 64; C = (st & 1) * 32 + (swz % 64) / 2; }
__host__ __device__ __forceinline__ int perm32(int rho) { const int n = rho >> 4, i = rho & 15; return 8 * (i >> 2) + 4 * n + (i & 3); }

__device__ __forceinline__ float pg8_zero() { float z = 0.f; asm volatile("" : "+v"(z)); return z; }
struct Unit { int pm, pn; };
struct Gemm { const bf16_t* A; const bf16_t* Bt; int M, N, K; int trows; int ld, mt; };

struct StaticOrder {
    int nM, nN, nwg, G, c;
    __host__ __device__ void init(int M, int N, int G_, int c_) { nM = M / BM; nN = N / BM; nwg = nM * nN; G = G_; c = c_; }
    __host__ __device__ bool next(int i, Unit& u) const {
        const long L = (long)i * G + c; if (L >= nwg) return false;
        int wgid = (int)L; { const int q = nwg / NXCD, r = nwg % NXCD, xcd = wgid % NXCD, off = wgid / NXCD; wgid = (xcd < r ? xcd * (q + 1) : r * (q + 1) + (xcd - r) * q) + off; }
        const int nig = WGM * nN, gid = wgid / nig, fm = gid * WGM, gsz = (nM - fm) < WGM ? (nM - fm) : WGM;
        u.pm = fm + ((wgid % nig) % gsz); u.pn = (wgid % nig) / gsz; return true;
    }
    __device__ __forceinline__ void a_ready(const Unit&) const {}
    __device__ __forceinline__ void done(const Unit&) const {}
};

__device__ __forceinline__ unsigned cvt_pk_bf16(float lo, float hi) { unsigned r; asm volatile("v_cvt_pk_bf16_f32 %0, %1, %2" : "=v"(r) : "v"(lo), "v"(hi)); return r; }
typedef float f32x2 __attribute__((ext_vector_type(2)));
__device__ __forceinline__ f32x2 gelu_pk(f32x2 v) {
    const f32x2 av = __builtin_elementwise_abs(v), d = av * 0.2316418882f + 1.0f;
    f32x2 t; t.x = __builtin_amdgcn_rcpf(d.x); t.y = __builtin_amdgcn_rcpf(d.y);
    f32x2 q = t * 0.5307027145f + (-0.7265760135f); q = q * t + 0.7107068705f; q = q * t + (-0.142248368f); q = q * t + 0.127414796f; q = q * t;
    const f32x2 s = (v * v) * (-0.72134752044f);
    f32x2 e; e.x = __builtin_amdgcn_exp2f(s.x); e.y = __builtin_amdgcn_exp2f(s.y);
    const f32x2 m = v * (q * e), r = v - m;
    f32x2 o; o.x = v.x < 0.f ? m.x : r.x; o.y = v.y < 0.f ? m.y : r.y; return o;
}

template <int ACT  > struct EpiBf16 {
    static constexpr bool PERM = true, AFTER_DRAIN = false; static_assert(ACT == 0 || ACT == 1, "EpiBf16: ACT is 0 (none) or 1 (gelu_pk)");
    bf16_t* O; int ldc; const float* bias; int split_cols; size_t split_stride; float scale0;
    __device__ __forceinline__ void operator()(const f32x4 (&acc)[2][2][4][2], const Unit& u, int wr, int wc, int fr, int fq) const {
        const int row0 = u.pm * BM + wr * 64 + fr; int colt = u.pn * BM; bf16_t* base = O;
        float sc = 1.f; if (split_cols) { const int t = colt / split_cols; base += (size_t)t * split_stride; colt -= t * split_cols; if (t == 0) sc = scale0; }
        const int col0 = colt + wc * 32 + 8 * fq, bcol0 = u.pn * BM + wc * 32 + 8 * fq;
        f32x4 bv[2][2];
#pragma unroll
        for (int bj = 0; bj < 2; ++bj)
#pragma unroll
            for (int n = 0; n < 2; ++n) bv[bj][n] = bias ? *(const f32x4*)(bias + bcol0 + bj * HALF + 4 * n) : (f32x4){0.f, 0.f, 0.f, 0.f};
#pragma unroll
        for (int ai = 0; ai < 2; ++ai)
#pragma unroll
            for (int m = 0; m < 4; ++m) { bf16_t* rowp = base + (size_t)(row0 + ai * HALF + m * 16) * ldc + col0;
#pragma unroll
                for (int bj = 0; bj < 2; ++bj) { f32x4 v0 = acc[ai][bj][m][0] + bv[bj][0], v1 = acc[ai][bj][m][1] + bv[bj][1];
                    if (ACT == 1) { f32x2 a = gelu_pk((f32x2){v0[0], v0[1]}), b = gelu_pk((f32x2){v0[2], v0[3]}), c = gelu_pk((f32x2){v1[0], v1[1]}), d = gelu_pk((f32x2){v1[2], v1[3]});
                        v0 = (f32x4){a.x, a.y, b.x, b.y}; v1 = (f32x4){c.x, c.y, d.x, d.y}; }
                    v0 = v0 * sc; v1 = v1 * sc; u32x4 w; w.x = cvt_pk_bf16(v0[0], v0[1]); w.y = cvt_pk_bf16(v0[2], v0[3]); w.z = cvt_pk_bf16(v1[0], v1[1]); w.w = cvt_pk_bf16(v1[2], v1[3]);
                    *(u32x4*)(rowp + bj * HALF) = w; } }
    }
};

template <class Epi, class Sched, bool ALIGN_EPI = false, bool SP2 = false>
__device__ __forceinline__ void gemm_phase(PG8_LAS unsigned char* lds, const Gemm g, const Sched& S, const Epi& E, int tid_in) {
    int tid_ = tid_in; asm volatile("" : "+v"(tid_));
    const int tid = tid_, wid = __builtin_amdgcn_readfirstlane(tid >> 6), lane = tid & 63, wr = wid >> 2, wc = wid & 3, fr = lane & 15, fq = lane >> 4;
    const int K = g.ld, nt = g.K / BK;
    unsigned voffA[2], voffB[2];
#pragma unroll
    for (int i = 0; i < 2; ++i) { int R, C; stage_rc(tid * 16 + i * 8192, R, C); const int Rb = Epi::PERM ? ((R & ~31) + perm32(R & 31)) : R;
        voffA[i] = (unsigned)(R * K + C) * 2u; voffB[i] = (unsigned)(Rb * K + C) * 2u; }
    const size_t kstep = (size_t)(BK * 2);
    const size_t hstep = (size_t)HALF * K * 2;
    const size_t tstep = 2 * hstep;
    const size_t tstepA = (size_t)g.trows * K * 2;
    const unsigned ldsw = (unsigned)wid * 1024u;
    const int aoff = lds_byte(wr * 64 + fr, fq * 8), boff = lds_byte(wc * 32 + fr, fq * 8);
#define PG8_SA(b, h) (((b) * 2 + (h)) * HTB)
#define PG8_SB(b, h) ((4 + (b) * 2 + (h)) * HTB)
#define PG8_STAGE(bufoff, gbase, voff) do { _Pragma("unroll") for (int _i = 0; _i < 2; ++_i) \
        __builtin_amdgcn_global_load_lds((const unsigned*)((const char*)(gbase) + (voff)[_i]), (PG8_LAS unsigned*)(lds + (bufoff) + ldsw + _i * 8192), 16, 0, 0); } while (0)
#define PG8_LDA(dst, b, h) do { _Pragma("unroll") for (int m = 0; m < 4; ++m) _Pragma("unroll") for (int k = 0; k < 2; ++k) dst[m][k] = *(const PG8_LAS bf16x8*)(lds + PG8_SA(b, h) + aoff + m * 2048 + k * 1024); } while (0)
#define PG8_LDB(dst, b, h) do { _Pragma("unroll") for (int n = 0; n < 2; ++n) _Pragma("unroll") for (int k = 0; k < 2; ++k) dst[n][k] = *(const PG8_LAS bf16x8*)(lds + PG8_SB(b, h) + boff + n * 2048 + k * 1024); } while (0)
#define PG8_MMA(ai, bj, At, Bt) do { __builtin_amdgcn_s_setprio(1); _Pragma("unroll") for (int m = 0; m < 4; ++m) _Pragma("unroll") for (int n = 0; n < 2; ++n) _Pragma("unroll") for (int k = 0; k < 2; ++k) \
        acc[ai][bj][m][n] = __builtin_amdgcn_mfma_f32_16x16x32_bf16(Bt[n][k], At[m][k], acc[ai][bj][m][n], 0, 0, 0); __builtin_amdgcn_s_setprio(0); } while (0)
#define PG8_WAIT_V(n) asm volatile("s_waitcnt vmcnt(" #n ")" ::: "memory")
#define PG8_WAIT_L(n) asm volatile("s_waitcnt lgkmcnt(" #n ")" ::: "memory")
#define PG8_BAR __builtin_amdgcn_s_barrier()
#define PG8_SCHED __builtin_amdgcn_sched_barrier(0)
    Unit cur, nxt; int ui = 0;
    if (!S.next(0, cur)) return;
    f32x4 acc[2][2][4][2];
#pragma unroll
    for (int a = 0; a < 2; ++a)
#pragma unroll
        for (int b = 0; b < 2; ++b)
#pragma unroll
            for (int m = 0; m < 4; ++m)
#pragma unroll
                for (int n = 0; n < 2; ++n) acc[a][b][m][n] = (f32x4){pg8_zero(), pg8_zero(), pg8_zero(), pg8_zero()};
    bf16x8 At[4][2], B0[2][2], B1[2][2];
#define PG8_BASEA(un) ((const char*)g.A + (size_t)(g.mt ? (un).pm % g.mt : (un).pm) * tstepA + (g.mt ? (size_t)((un).pm / g.mt) * g.K * 2 : 0))
#define PG8_BASEB(un) ((const char*)g.Bt + (size_t)(un).pn * tstep + (g.mt ? (size_t)((un).pm / g.mt) * g.K * 2 : 0))
    const char* cA = PG8_BASEA(cur); const char* cB = PG8_BASEB(cur);
    S.a_ready(cur);
    if constexpr (SP2) {
        PG8_STAGE(PG8_SB(0, 0), cB, voffB); PG8_STAGE(PG8_SB(0, 1), cB + hstep, voffB); PG8_STAGE(PG8_SA(0, 0), cA, voffA); PG8_STAGE(PG8_SA(0, 1), cA + hstep, voffA);
        if (wr == 1) PG8_BAR;
        PG8_WAIT_V(2); PG8_BAR;
        PG8_STAGE(PG8_SB(1, 0), cB + kstep, voffB); PG8_STAGE(PG8_SA(1, 0), cA + kstep, voffA); PG8_STAGE(PG8_SB(1, 1), cB + hstep + kstep, voffB);
        PG8_WAIT_V(6); PG8_BAR;
    } else {
        PG8_STAGE(PG8_SB(0, 0), cB, voffB); PG8_STAGE(PG8_SA(0, 0), cA, voffA); PG8_STAGE(PG8_SB(0, 1), cB + hstep, voffB); PG8_STAGE(PG8_SA(0, 1), cA + hstep, voffA);
        if (wr == 1) PG8_BAR;
        PG8_WAIT_V(4); PG8_BAR;
        PG8_STAGE(PG8_SB(1, 0), cB + kstep, voffB); PG8_STAGE(PG8_SA(1, 0), cA + kstep, voffA); PG8_STAGE(PG8_SB(1, 1), cB + hstep + kstep, voffB);
        PG8_WAIT_V(6); PG8_BAR;
    }
    for (;;) {
        const bool has_next = S.next(ui + 1, nxt);
        const char* nA = has_next ? PG8_BASEA(nxt) : cA; const char* nB = has_next ? PG8_BASEB(nxt) : cB;
        for (int t = 0; t < nt; t += 2) {
            const bool last = (t == nt - 2);
            const char* a1 = cA + (size_t)(t + 1) * kstep;
            const char* a2 = last ? nA : cA + (size_t)(t + 2) * kstep; const char* b2 = last ? nB : cB + (size_t)(t + 2) * kstep;
            const char* a3 = a2 + kstep; const char* b3 = b2 + kstep;
            if (last && has_next) S.a_ready(nxt);
            if constexpr (SP2) {
            PG8_LDB(B0, 0, 0); PG8_LDB(B1, 0, 1); PG8_SCHED; PG8_LDA(At, 0, 0); PG8_STAGE(PG8_SA(1, 1), a1 + hstep, voffA);
            PG8_WAIT_V(8); PG8_WAIT_L(0); PG8_BAR; PG8_MMA(0, 0, At, B0); PG8_MMA(0, 1, At, B1); PG8_BAR; PG8_SCHED;
            PG8_LDA(At, 0, 1); PG8_STAGE(PG8_SB(0, 0), b2, voffB); PG8_STAGE(PG8_SB(0, 1), b2 + hstep, voffB); PG8_STAGE(PG8_SA(0, 0), a2, voffA);
            PG8_WAIT_V(8); PG8_WAIT_L(0); PG8_BAR; PG8_MMA(1, 0, At, B0); PG8_MMA(1, 1, At, B1); PG8_BAR; PG8_SCHED;
            PG8_LDB(B0, 1, 0); PG8_LDB(B1, 1, 1); PG8_SCHED; PG8_LDA(At, 1, 0); PG8_STAGE(PG8_SA(0, 1), a2 + hstep, voffA);
            PG8_WAIT_V(8); PG8_WAIT_L(0); PG8_BAR; PG8_MMA(0, 0, At, B0); PG8_MMA(0, 1, At, B1); PG8_BAR; PG8_SCHED;
            PG8_LDA(At, 1, 1); PG8_STAGE(PG8_SB(1, 0), b3, voffB); PG8_STAGE(PG8_SB(1, 1), b3 + hstep, voffB); PG8_STAGE(PG8_SA(1, 0), a3, voffA);
            PG8_WAIT_V(8); PG8_WAIT_L(0); PG8_BAR; PG8_MMA(1, 0, At, B0); PG8_MMA(1, 1, At, B1); PG8_BAR; PG8_SCHED;
            } else {
            PG8_LDB(B0, 0, 0); PG8_SCHED; PG8_LDA(At, 0, 0); PG8_STAGE(PG8_SA(1, 1), a1 + hstep, voffA);
            PG8_WAIT_L(8); PG8_BAR; PG8_WAIT_L(0); PG8_MMA(0, 0, At, B0); PG8_BAR; PG8_SCHED;
            PG8_LDB(B1, 0, 1); PG8_STAGE(PG8_SB(0, 0), b2, voffB);
            PG8_BAR; PG8_WAIT_L(0); PG8_MMA(0, 1, At, B1); PG8_BAR;
            PG8_LDA(At, 0, 1); PG8_STAGE(PG8_SA(0, 0), a2, voffA);
            PG8_BAR; PG8_WAIT_L(0); PG8_MMA(1, 0, At, B0); PG8_BAR; PG8_SCHED;
            PG8_STAGE(PG8_SB(0, 1), b2 + hstep, voffB);
            PG8_WAIT_V(6); PG8_BAR; PG8_MMA(1, 1, At, B1); PG8_BAR;
            PG8_LDB(B0, 1, 0); PG8_SCHED; PG8_LDA(At, 1, 0); PG8_STAGE(PG8_SA(0, 1), a2 + hstep, voffA);
            PG8_WAIT_L(8); PG8_BAR; PG8_WAIT_L(0); PG8_MMA(0, 0, At, B0); PG8_BAR; PG8_SCHED;
            PG8_LDB(B1, 1, 1); PG8_STAGE(PG8_SB(1, 0), b3, voffB);
            PG8_BAR; PG8_WAIT_L(0); PG8_MMA(0, 1, At, B1); PG8_BAR;
            PG8_LDA(At, 1, 1); PG8_STAGE(PG8_SA(1, 0), a3, voffA);
            PG8_BAR; PG8_WAIT_L(0); PG8_MMA(1, 0, At, B0); PG8_BAR; PG8_SCHED;
            PG8_STAGE(PG8_SB(1, 1), b3 + hstep, voffB);
            PG8_WAIT_V(6); PG8_BAR; PG8_MMA(1, 1, At, B1); PG8_BAR;
            }
        }
        if constexpr (ALIGN_EPI) { if (wr == 0) PG8_BAR; }
        if (!E.drain()) { E(acc, cur, wr, wc, fr, fq); S.done(cur); }
        if (!has_next) break;
#pragma unroll
        for (int a = 0; a < 2; ++a)
#pragma unroll
            for (int b = 0; b < 2; ++b)
#pragma unroll
                for (int m = 0; m < 4; ++m)
#pragma unroll
                    for (int n = 0; n < 2; ++n) acc[a][b][m][n] = (f32x4){pg8_zero(), pg8_zero(), pg8_zero(), pg8_zero()};
        cur = nxt; cA = nA; cB = nB; ++ui;
        if constexpr (ALIGN_EPI) { if (wr == 1) PG8_BAR; }
    }
    PG8_WAIT_V(0);
    if constexpr (!ALIGN_EPI) { if (wr == 0) PG8_BAR; }
    PG8_BAR;
    if (E.drain()) { E.fused(acc, cur, wr, wc, fr, fq, lds, wid, lane); S.done(cur); }
#undef PG8_BASEA
#undef PG8_BASEB
#undef PG8_SA
#undef PG8_SB
#undef PG8_STAGE
#undef PG8_LDA
#undef PG8_LDB
#undef PG8_MMA
#undef PG8_WAIT_V
#undef PG8_WAIT_L
#undef PG8_BAR
#undef PG8_SCHED
}
}
#define GAS __attribute__((address_space(1)))
#define LAS __attribute__((address_space(3)))
typedef unsigned short bf16;
typedef unsigned v4u __attribute__((ext_vector_type(4)));
typedef float f32x4 __attribute__((ext_vector_type(4)));
typedef short bf16x8 __attribute__((ext_vector_type(8)));
typedef GAS unsigned gu32;
typedef GAS unsigned long long gu64;
#define RLX_AGENT __ATOMIC_RELAXED, __HIP_MEMORY_SCOPE_AGENT
#define LDS_WAIT() asm volatile("s_waitcnt lgkmcnt(0)" ::: "memory")
#define VM_WAIT() asm volatile("s_waitcnt vmcnt(0)" ::: "memory")
__device__ __forceinline__ unsigned long long rt() { return __builtin_amdgcn_s_memrealtime(); }
__device__ __forceinline__ unsigned f2bf(float f) { unsigned u = __builtin_bit_cast(unsigned, f); return (u + 0x7fffu + ((u >> 16) & 1u)) >> 16; }
__device__ __forceinline__ unsigned pk2(float lo, float hi) { return f2bf(lo) | (f2bf(hi) << 16); }
#define XB_TMO      128
#define XB_XCNT(j)  (256  + 64 * (j))
#define XB_XSUB(j)  (1280 + 64 * (j))
#define XB_XGEN(j)  (2304 + 64 * (j))
#define XB_TOP      3328
#define XB_TOPGEN   3392
#define XCD_BAR_WORDS 3456
#define XB_SPIN_CAP (1u << 18)

__device__ __forceinline__ unsigned xb_ld(unsigned* p)              { return __hip_atomic_load(p, __ATOMIC_RELAXED, __HIP_MEMORY_SCOPE_AGENT); }
__device__ __forceinline__ unsigned xb_add(unsigned* p, unsigned v) { return __hip_atomic_fetch_add(p, v, __ATOMIC_RELAXED, __HIP_MEMORY_SCOPE_AGENT); }
__device__ __forceinline__ unsigned xb_xcc_id() { return (unsigned)__builtin_amdgcn_s_getreg((3 << 11) | 20) & 0xFu; }
#define XB_SPIN(cond, bar) do { unsigned _sp = 0; while (cond) { __builtin_amdgcn_s_sleep(1); \
    if ((++_sp & 255u) == 0u) { if (xb_ld(&(bar)[XB_TMO])) break; if (_sp > XB_SPIN_CAP) { atomicAdd(&(bar)[XB_TMO], 1u); break; } } } } while (0)

struct XcdBarrier {
    int tid; unsigned* bar; unsigned x;
    volatile LAS unsigned* st;
};

__device__ __forceinline__ XcdBarrier xcd_barrier_post(unsigned* bar, volatile LAS unsigned* st, int tid) {
    XcdBarrier b; b.bar = bar; b.x = xb_xcc_id(); b.st = st; b.tid = tid;
    if (tid == 0) (void)xb_add(&bar[XB_XCNT(b.x)], 1u);
    return b;
}
__device__ __forceinline__ void xcd_barrier_complete(unsigned* bar, unsigned x, unsigned& nloc, unsigned& nx) {
    const unsigned G = gridDim.x * gridDim.y * gridDim.z;
    unsigned sum, cnt, mine, sp = 0u;
    for (;;) {
        sum = 0u; cnt = 0u; mine = 0u;
#pragma unroll
        for (unsigned j = 0; j < 16; ++j) { const unsigned c = xb_ld(&bar[XB_XCNT(j)]); sum += c; cnt += (c > 0u) ? 1u : 0u; mine = (j == x) ? c : mine; }
        if (sum == G) break;
        __builtin_amdgcn_s_sleep(1);
        if ((++sp & 255u) == 0u) { if (xb_ld(&bar[XB_TMO])) break; if (sp > XB_SPIN_CAP) { atomicAdd(&bar[XB_TMO], 1u); break; } }
    }
    nloc = mine > 0u ? mine : 1u; nx = cnt > 0u ? cnt : 1u;
}

__device__ __forceinline__ void xcd_barrier(const XcdBarrier& b) {
    asm volatile("s_waitcnt vmcnt(0)" ::: "memory");
    __syncthreads();
    if (b.tid == 0) {
        unsigned* bar = b.bar;
        __builtin_amdgcn_s_waitcnt(0);
        unsigned nloc = b.st[0], nx = b.st[1];
        if (nloc == 0u) { xcd_barrier_complete(bar, b.x, nloc, nx); b.st[0] = nloc; b.st[1] = nx; }
        const unsigned old = xb_add(&bar[XB_XSUB(b.x)], 1u);
        const unsigned gen = old / nloc;
        if (old + 1u == (gen + 1u) * nloc) {
            __builtin_amdgcn_fence(__ATOMIC_RELEASE, "agent");
            asm volatile("s_waitcnt vmcnt(0)" ::: "memory");
            const unsigned og = xb_add(&bar[XB_TOP], 1u);
            const unsigned tg = og / nx;
            if (og + 1u == (tg + 1u) * nx) xb_add(&bar[XB_TOPGEN], 1u);
            else XB_SPIN(xb_ld(&bar[XB_TOPGEN]) == tg, bar);
            __builtin_amdgcn_fence(__ATOMIC_ACQUIRE, "agent");
            xb_add(&bar[XB_XGEN(b.x)], 1u);
            asm volatile("s_waitcnt vmcnt(0)" ::: "memory");
        } else {
            XB_SPIN(xb_ld(&bar[XB_XGEN(b.x)]) == gen, bar);
            __builtin_amdgcn_fence(__ATOMIC_ACQUIRE, "agent");
            asm volatile("s_waitcnt vmcnt(0)" ::: "memory");
        }
    }
    __syncthreads();
}

namespace mk {
constexpr int NWAVES = 8, NTHR = 512;
constexpr int D = 1024, NBATCH = 4, SEQ = 4096, CTXL = 256;
constexpr int MLAT = NBATCH * SEQ, MCTX = NBATCH * CTXL, MALL = MLAT + MCTX;
constexpr int INW = 2496, INP = 2560, DFF = 2816, NGU = 2 * DFF;
constexpr int C_R = 0, C_K = 256, C_V = 512, C_GD = 768, C_WD = 832, C_AD = 896, C_DFQ = 960, C_DFK = 1216, C_DFV = 1472, C_GQQ = 1728, C_GQK = 2240, C_GQV = 2368;
constexpr float NORM_EPS = 1e-6f, LOG2E = 1.4426950408889634f;
constexpr float SC_DF = 0.17677669529663687f * LOG2E;
constexpr float SC_GQ = 0.125f * LOG2E;

enum { I_X = 0, I_C, I_CTX, I_CCTX, I_ADAW, I_ADAB, I_NORMG, I_WIN, I_WOUT, I_RWCONV, I_RWW0, I_RWWUP, I_RWA0, I_RWAUP, I_RWGUP, I_RWKK, I_RWKA, I_RWRK, I_RWLNG, I_RWLNB,
       I_DFLAM, I_DFNG, I_GQSINK, I_FFG, I_FFU, I_FFD, I_FFCW, I_FFCB, N_IN };

constexpr size_t MiB = 1u << 20;
constexpr size_t WS_CTL = 0, CTL_ZERO_BYTES = 1 * MiB;
constexpr int CW_BAR = 4096;
constexpr size_t WS_MOD = 1 * MiB;
constexpr size_t WS_TAB = 1 * MiB + 256 * 1024;
constexpr size_t WS_WIN = 2 * MiB, WIN_BYTES = (size_t)INP * D * 2;
constexpr size_t WS_WOUT = 12 * MiB, WOUT_BYTES = (size_t)D * D * 2;
constexpr size_t WS_WGU = 16 * MiB, WGU_BYTES = (size_t)NGU * D * 2;
constexpr size_t WS_WD = 38 * MiB, WD_BYTES = (size_t)D * DFF * 2;
constexpr size_t WS_XSC = 49 * MiB;
constexpr size_t WS_XN = 53 * MiB;
constexpr size_t WS_RP = 87 * MiB;
constexpr size_t WS_RF = 172 * MiB;
constexpr size_t FEAT1 = (size_t)MALL * 256 * 2;
constexpr size_t WS_GAL = WS_RF, WS_GBE = WS_GAL + 2 * FEAT1, WS_GKP = WS_GBE + 2 * FEAT1, WS_GRH = WS_GKP + 2 * FEAT1, WS_FV = WS_GRH + 2 * FEAT1;
constexpr size_t WS_GLT = WS_FV + FEAT1;
constexpr size_t WS_BON = WS_GLT + (size_t)2 * 272 * 256 * 4;
constexpr size_t WS_RF_END = WS_BON + (size_t)MALL * 4 * 4;
constexpr size_t WS_ACT = WS_RP;
constexpr size_t WS_FP = 181 * MiB;
constexpr size_t WS_SLO = WS_RF;
constexpr size_t WS_SLD = 215 * MiB;
constexpr size_t WS_XB = 240 * MiB;
constexpr size_t WS_END = 256 * MiB;
static_assert(WS_RF_END <= WS_END, "feature region");
static_assert(WS_SLD + (size_t)11 * MCTX * D * 2 <= WS_XB && WS_XB + (size_t)8 * MLAT * 4 * 4 <= WS_END, "exchange slots");
static_assert(WS_FP + (size_t)MALL * D * 2 <= WS_SLD && WS_SLD + (size_t)11 * MCTX * D * 2 <= WS_END, "slabs");
static_assert(WS_ACT + (size_t)MALL * DFF * 2 <= WS_FP && WS_FP + (size_t)MALL * D * 4 <= WS_END, "ffn buffers");
static_assert(WS_XN + (size_t)MALL * D * 2 <= WS_RP && WS_RP + (size_t)MALL * INP * 2 <= WS_RF, "map");

constexpr int LDS_BYTES = 163840;
constexpr int LDSCTL_OFF = LDS_BYTES - 512, MISC_OFF = LDSCTL_OFF + 320;
constexpr int CW_QUEUE = 2048, CW_PST = 32768;

struct Args { const float* in[N_IN]; float* out; unsigned char* ws; int ph_lo, ph_hi; };


typedef const __attribute__((address_space(4))) char* kptr_t;
__device__ __forceinline__ kptr_t karg_base() { kptr_t k = (kptr_t)__builtin_amdgcn_kernarg_segment_ptr(); asm volatile("" : "+s"(k)); return k; }
__device__ __forceinline__ const float* kin(int i) { return *(const float* const __attribute__((address_space(4)))*)(karg_base() + 8 * i); }
__device__ __forceinline__ float* kout() { return *(float* const __attribute__((address_space(4)))*)(karg_base() + 8 * N_IN); }
__device__ __forceinline__ unsigned char* kws() { return *(unsigned char* const __attribute__((address_space(4)))*)(karg_base() + 8 * N_IN + 8); }

struct Frame {
    LAS unsigned char* lds;
    int tid, lane, wave, G, bid;
};

__device__ __forceinline__ float bf2f(bf16 h) { return __uint_as_float(((unsigned)h) << 16); }
template <int CTRL> __device__ __forceinline__ float dpp_mov(float x) { return __int_as_float(__builtin_amdgcn_update_dpp(0, __float_as_int(x), CTRL, 0xF, 0xF, false)); }
template <int CTRL> __device__ __forceinline__ float dpp_add(float x) { return x + dpp_mov<CTRL>(x); }
__device__ __forceinline__ float wave_sum(float v) {
    v = dpp_add<0xB1>(v); v = dpp_add<0x4E>(v); v = dpp_add<0x124>(v); v = dpp_add<0x128>(v);
    auto r = __builtin_amdgcn_permlane16_swap(__float_as_uint(v), __float_as_uint(v), false, false); v = __uint_as_float(r[0]) + __uint_as_float(r[1]);
    r = __builtin_amdgcn_permlane32_swap(__float_as_uint(v), __float_as_uint(v), false, false); return __uint_as_float(r[0]) + __uint_as_float(r[1]);
}
__device__ __forceinline__ float rdlane(float v, int l) { return __int_as_float(__builtin_amdgcn_readlane(__float_as_int(v), l)); }
__device__ __forceinline__ float sigmoidf_(float x) { return __builtin_amdgcn_rcpf(1.0f + __expf(-x)); }
typedef unsigned v2u __attribute__((ext_vector_type(2)));
typedef float f32x2_t __attribute__((ext_vector_type(2))); typedef __bf16 bf16x2_t __attribute__((ext_vector_type(2)));
__device__ __forceinline__ unsigned pk2h(float lo, float hi) { f32x2_t v = {lo, hi}; bf16x2_t b = __builtin_convertvector(v, bf16x2_t); return __builtin_bit_cast(unsigned, b); }
__device__ __forceinline__ float xmax4(float v) {
    auto r = __builtin_amdgcn_permlane16_swap(__float_as_uint(v), __float_as_uint(v), false, false); v = fmaxf(__uint_as_float(r[0]), __uint_as_float(r[1]));
    r = __builtin_amdgcn_permlane32_swap(__float_as_uint(v), __float_as_uint(v), false, false); return fmaxf(__uint_as_float(r[0]), __uint_as_float(r[1]));
}

__device__ __forceinline__ void p0_transpose_item(const float* W, int K, int N, bf16* WT, int row_off, LAS float* scr, int item, int lane) {
    const int nblk = N / 32, kb = item / nblk, nb = item % nblk, k0 = 64 * kb, n0 = 32 * nb;
#pragma unroll 8
    for (int i = 0; i < 32; ++i) { const int kk = 2 * i + (lane >> 5); scr[kk * 33 + (lane & 31)] = W[(size_t)(k0 + kk) * N + n0 + (lane & 31)]; }
    LDS_WAIT(); asm volatile("" ::: "memory");
    const int c = lane & 7;
#pragma unroll
    for (int j = 0; j < 4; ++j) { const int n = (lane >> 3) + 8 * j; const LAS float* s = scr + (8 * c) * 33 + n;
        v4u o; o.x = pk2h(s[0 * 33], s[1 * 33]); o.y = pk2h(s[2 * 33], s[3 * 33]); o.z = pk2h(s[4 * 33], s[5 * 33]); o.w = pk2h(s[6 * 33], s[7 * 33]);
        *(GAS v4u*)(WT + (size_t)(row_off + n0 + n) * K + k0 + 8 * c) = o; }
    LDS_WAIT(); asm volatile("" ::: "memory");
}

constexpr int WI_IN = 16 * (INW / 32), WI_OUT = 16 * 32, WI_G = 16 * (DFF / 32), WI_DN = (DFF / 64) * 32, WI_LAYER = WI_IN + WI_OUT + 2 * WI_G + WI_DN;
__device__ __forceinline__ void weight_item(int it, LAS float* scr, int lane) {
    unsigned char* ws = kws();
    const int l = it / WI_LAYER; int r = it % WI_LAYER;
    if (r < WI_IN) { p0_transpose_item(kin(I_WIN) + (size_t)l * D * INW, D, INW, (bf16*)(ws + WS_WIN + l * WIN_BYTES), 0, scr, r, lane); return; } r -= WI_IN;
    if (r < WI_OUT) { p0_transpose_item(kin(I_WOUT) + (size_t)l * D * D, D, D, (bf16*)(ws + WS_WOUT + l * WOUT_BYTES), 0, scr, r, lane); return; } r -= WI_OUT;
    if (r < WI_G) { const int n0 = 32 * (r % (DFF / 32)); p0_transpose_item(kin(I_FFG) + (size_t)l * D * DFF, D, DFF, (bf16*)(ws + WS_WGU + l * WGU_BYTES), 256 * (n0 >> 7) + (n0 & 127) - n0, scr, r, lane); return; } r -= WI_G;
    if (r < WI_G) { const int n0 = 32 * (r % (DFF / 32)); p0_transpose_item(kin(I_FFU) + (size_t)l * D * DFF, D, DFF, (bf16*)(ws + WS_WGU + l * WGU_BYTES), 256 * (n0 >> 7) + (n0 & 127) - n0 + 128, scr, r, lane); return; } r -= WI_G;
    p0_transpose_item(kin(I_FFD) + (size_t)l * DFF * D, DFF, D, (bf16*)(ws + WS_WD + l * WD_BYTES), 0, scr, r, lane);
}
constexpr int WI_FILL = (2 * WI_LAYER - WI_IN + 127) / 128;

__device__ __forceinline__ void p0_prologue(const Args& A, Frame& F) {
    unsigned char* ws = kws();
    {
        LAS float* sc = (LAS float*)F.lds;
        LAS float* red = (LAS float*)(F.lds + 20480);
        float* mod = (float*)(ws + WS_MOD);
        for (int u = F.bid; u < 192; u += F.G) {
            __syncthreads();
            for (int i = F.tid; i < 5 * 1024; i += NTHR) { const int bb = i >> 10, k = i & 1023; const float v = bb < 4 ? kin(I_C)[bb * 1024 + k] : kin(I_CCTX)[k]; sc[i] = v / (1.0f + __expf(-v)); }
            __syncthreads();
            const int l = u / 96, cc = u % 96, col = cc * 64 + (F.tid & 63), ks = F.tid >> 6;
            const float* w = kin(I_ADAW) + (size_t)l * 1024 * 6144 + col;
            float acc[5] = {0.f, 0.f, 0.f, 0.f, 0.f};
            for (int k0 = ks * 128; k0 < ks * 128 + 128; k0 += 16) { float wv[16];
#pragma unroll
                for (int q = 0; q < 16; ++q) wv[q] = w[(size_t)(k0 + q) * 6144];
#pragma unroll
                for (int q = 0; q < 16; ++q)
#pragma unroll
                    for (int bb = 0; bb < 5; ++bb) acc[bb] += sc[bb * 1024 + k0 + q] * wv[q]; }
#pragma unroll
            for (int bb = 0; bb < 5; ++bb) red[(ks * 5 + bb) * 64 + (F.tid & 63)] = acc[bb];
            __syncthreads();
            if (F.tid < 320) { const int bb = F.tid >> 6, c = F.tid & 63; float s = kin(I_ADAB)[l * 6144 + cc * 64 + c];
#pragma unroll
                for (int k8 = 0; k8 < 8; ++k8) s += red[(k8 * 5 + bb) * 64 + c];
                mod[(size_t)(l * 5 + bb) * 6144 + cc * 64 + c] = s; }
        }
        __syncthreads();
    }
    {
        LAS float* scr = (LAS float*)(F.lds + F.wave * 16384);
        const int gw = F.bid * NWAVES + F.wave, NGW = F.G * NWAVES;
        for (int it = gw; it < WI_IN; it += NGW) weight_item(it, scr, F.lane);
        const int gt = F.bid * NTHR + F.tid, NGT = F.G * NTHR;
        for (int i = gt; i < 2 * 8192; i += NGT) { const int l = i >> 13, j = i & 8191;
            unsigned z_ = 0u; asm volatile("" : "+v"(z_)); *(GAS v4u*)(ws + WS_WIN + l * WIN_BYTES + (size_t)INW * D * 2 + (size_t)j * 16) = (v4u){z_, z_, z_, z_}; }
    }
    if (F.bid == 0) {
        float* tab = (float*)(ws + WS_TAB);
        for (int i = F.tid; i < 512; i += NTHR) { const int pos = i >> 3, f = i & 7; const float inv = __builtin_amdgcn_exp2f(-(float)f * (13.287712379549449f / 8.0f)), ang = (float)pos * inv; tab[i] = __cosf(ang); tab[512 + i] = __sinf(ang); }
        for (int i = F.tid; i < 1024; i += NTHR) { const int pos = i >> 4, f = i & 15; const float inv = __builtin_amdgcn_exp2f(-(float)f * (13.287712379549449f / 16.0f)), ang = (float)pos * inv; tab[1024 + i] = __cosf(ang); tab[2048 + i] = __sinf(ang); }
        if (F.tid < 2) { const int l = F.tid; const float* lv = kin(I_DFLAM) + l * 128; float s1 = 0.f, s2 = 0.f;
            for (int i = 0; i < 32; ++i) { s1 += lv[i] * lv[32 + i]; s2 += lv[64 + i] * lv[96 + i]; }
            const float lam_init = 0.8f - 0.6f * __expf(-0.3f * (float)l);
            tab[3072 + l] = __expf(s1) - __expf(s2) + lam_init; tab[3074 + l] = lam_init; }
    }
}

__device__ __forceinline__ const float* mod_vec(const Args& A, int l, int bb, int i) { return (const float*)(kws() + WS_MOD) + ((size_t)(l * 5 + bb) * 6 + i) * 1024; }
__device__ __forceinline__ const float* normg_vec(const Args& A, int l, int i) { return kin(I_NORMG) + (size_t)(l * 4 + i) * 1024; }
__device__ __forceinline__ int row_bb(int row) { return row < MLAT ? (row >> 12) : 4; }
__device__ __forceinline__ void seq_pos(int row, int& t, int& T) { if (row < MLAT) { t = row & (SEQ - 1); T = SEQ; } else { t = (row - MLAT) & (CTXL - 1); T = CTXL; } }
__device__ __forceinline__ void ld16(const float* p, int lane, f32x4 (&v)[4]) {
#pragma unroll
    for (int j = 0; j < 4; ++j) v[j] = *(const f32x4*)(p + 4 * lane + 256 * j);
}
__device__ __forceinline__ void ld16b(const bf16* p, int lane, f32x4 (&v)[4]) {
#pragma unroll
    for (int j = 0; j < 4; ++j) { const v2u u = *(const v2u*)(p + 4 * lane + 256 * j);
        v[j] = (f32x4){__uint_as_float(u.x << 16), __uint_as_float(u.x & 0xffff0000u), __uint_as_float(u.y << 16), __uint_as_float(u.y & 0xffff0000u)}; }
}
__device__ __forceinline__ void st16(float* p, int lane, const f32x4 (&v)[4]) {
#pragma unroll
    for (int j = 0; j < 4; ++j) *(f32x4*)(p + 4 * lane + 256 * j) = v[j];
}
__device__ __forceinline__ float sumsq16(const f32x4 (&v)[4]) {
    float s = 0.f;
#pragma unroll
    for (int j = 0; j < 4; ++j) s += (v[j].x * v[j].x + v[j].y * v[j].y) + (v[j].z * v[j].z + v[j].w * v[j].w);
    return wave_sum(s);
}
__device__ __forceinline__ void norm_mod_store(const f32x4 (&v)[4], float rstd, const float* g, const float* sc, const float* sh, bf16* orow, int lane) {
#pragma unroll
    for (int j = 0; j < 4; ++j) {
        const int c = 4 * lane + 256 * j;
        const f32x4 gg = *(const f32x4*)(g + c), s1 = *(const f32x4*)(sc + c), s0 = *(const f32x4*)(sh + c);
        const f32x4 h = v[j] * rstd * gg * (s1 + 1.0f) + s0;
        v2u o; o.x = pk2h(h.x, h.y); o.y = pk2h(h.z, h.w);
        *(v2u*)(orow + c) = o;
    }
}
__device__ __forceinline__ float* xs_row(const Args& A, int row) { return row < MLAT ? kout() + (size_t)row * D : (float*)(kws() + WS_XSC) + (size_t)(row - MLAT) * D; }
__device__ __forceinline__ const float* xin_row(const Args& A, int row) { return row < MLAT ? kin(I_X) + (size_t)row * D : kin(I_CTX) + (size_t)(row - MLAT) * D; }

__device__ __forceinline__ void phase_prep(const Args& A, Frame& F) {
    const int gw = F.bid * NWAVES + F.wave, NGW = F.G * NWAVES;
    bf16* XN = (bf16*)(kws() + WS_XN);
    f32x4 v[4], vn[4];
    if (gw < MALL) ld16(xin_row(A, gw), F.lane, v);
    for (int row = gw; row < MALL; row += NGW) {
        if (row + NGW < MALL) ld16(xin_row(A, row + NGW), F.lane, vn);
        const float rstd = rsqrtf(sumsq16(v) * (1.0f / D) + NORM_EPS);
        const int bb = row_bb(row);
        norm_mod_store(v, rstd, normg_vec(A, 0, 0), mod_vec(A, 0, bb, 1), mod_vec(A, 0, bb, 0), XN + (size_t)row * D, F.lane);
#pragma unroll
        for (int j = 0; j < 4; ++j) v[j] = vn[j];
    }
}
__device__ __forceinline__ void phase_e1(const Args& A, Frame& F, int l) {
    const int gw = F.bid * NWAVES + F.wave, NGW = F.G * NWAVES, nrows = l == 0 ? MALL : MLAT;
    bf16* XN = (bf16*)(kws() + WS_XN); const bf16* YP = (const bf16*)(kws() + WS_RP);
    for (int row = ((MK_FUSE & 1) && !MK_DBGD ? MLAT : 0) + gw; row < nrows; row += NGW) {
        const int bb = row_bb(row);
        f32x4 y[4], x[4];
        if (l == 0 && row >= MLAT) { const bf16* sl = (const bf16*)(kws() + WS_SLO) + (size_t)(row - MLAT) * D; ld16b(sl, F.lane, y);
            for (int s = 1; s < 4; ++s) { f32x4 t[4]; ld16b(sl + (size_t)s * MCTX * D, F.lane, t);
#pragma unroll
                for (int j = 0; j < 4; ++j) y[j] = y[j] + t[j]; } }
        else ld16b(YP + (size_t)row * D, F.lane, y);
        if (l == 0) ld16(xin_row(A, row), F.lane, x); else ld16(xs_row(A, row), F.lane, x);
        const float ry = rsqrtf(sumsq16(y) * (1.0f / D) + NORM_EPS);
        const float* g1 = normg_vec(A, l, 1); const float* ga = mod_vec(A, l, bb, 2);
#pragma unroll
        for (int j = 0; j < 4; ++j) { const int c = 4 * F.lane + 256 * j; x[j] = x[j] + *(const f32x4*)(ga + c) * (y[j] * ry * *(const f32x4*)(g1 + c)); }
        st16(xs_row(A, row), F.lane, x);
        const float rx = rsqrtf(sumsq16(x) * (1.0f / D) + NORM_EPS);
        norm_mod_store(x, rx, normg_vec(A, l, 2), mod_vec(A, l, bb, 4), mod_vec(A, l, bb, 3), XN + (size_t)row * D, F.lane);
    }
}
__device__ __forceinline__ void phase_e2(const Args& A, Frame& F, int l, int r0, int r1) {
    const int gw = F.bid * NWAVES + F.wave, NGW = F.G * NWAVES;
    bf16* XN = (bf16*)(kws() + WS_XN); const bf16* FP = (const bf16*)(kws() + WS_FP);
    for (int row = ((MK_FUSE & 2) && !MK_DBGD ? (r0 < MLAT ? MLAT : r0) : r0) + gw; row < r1; row += NGW) {
        const int bb = row_bb(row);
        f32x4 y[4], x[4];
        if (l == 0 && row >= MLAT) { const bf16* sl = (const bf16*)(kws() + WS_SLD) + (size_t)(row - MLAT) * D; ld16b(sl, F.lane, y);
            for (int s = 1; s < 11; ++s) { f32x4 t[4]; ld16b(sl + (size_t)s * MCTX * D, F.lane, t);
#pragma unroll
                for (int j = 0; j < 4; ++j) y[j] = y[j] + t[j]; } }
        else ld16b(FP + (size_t)(row - r0) * D, F.lane, y);
        ld16(xs_row(A, row), F.lane, x);
        const float ry = rsqrtf(sumsq16(y) * (1.0f / D) + NORM_EPS);
        const float* g3 = normg_vec(A, l, 3); const float* ga = mod_vec(A, l, bb, 5);
#pragma unroll
        for (int j = 0; j < 4; ++j) { const int c = 4 * F.lane + 256 * j; x[j] = x[j] + *(const f32x4*)(ga + c) * (y[j] * ry * *(const f32x4*)(g3 + c)); }
        st16(xs_row(A, row), F.lane, x);
        if (l == 0) {
            const float rx = rsqrtf(sumsq16(x) * (1.0f / D) + NORM_EPS);
            norm_mod_store(x, rx, normg_vec(A, 1, 0), mod_vec(A, 1, bb, 1), mod_vec(A, 1, bb, 0), XN + (size_t)row * D, F.lane);
        }
    }
}
__device__ __forceinline__ void phase_act(const Args& A, Frame& F, int l, int r0, int r1) {
    const bf16* GU = (const bf16*)(kws() + WS_RP); bf16* ACT = (bf16*)(kws() + WS_ACT);
    const float* cw = kin(I_FFCW) + (size_t)l * 3 * DFF; const float* cb = kin(I_FFCB) + (size_t)l * DFF;
    const int nch = DFF / 8, total = (r1 - r0) * nch;
    for (int i = F.bid * NTHR + F.tid; i < total; i += F.G * NTHR) {
        const int rr = i / nch, ch = i % nch, row = r0 + rr, j0 = ch * 8;
        const int t = row < MLAT ? (row & (SEQ - 1)) : ((row - MLAT) & (CTXL - 1)), T = row < MLAT ? SEQ : CTXL;
        const bf16* gp = GU + (size_t)rr * NGU + j0;
        const v4u gc = *(const v4u*)gp, uu = *(const v4u*)(gp + DFF);
        v4u gm = (v4u){0u, 0u, 0u, 0u}, gn = (v4u){0u, 0u, 0u, 0u};
        if (t > 0) gm = *(const v4u*)(gp - NGU);
        if (t < T - 1) gn = *(const v4u*)(gp + NGU);
        unsigned o[4];
#pragma unroll
        for (int q = 0; q < 4; ++q) {
            float r2[2];
#pragma unroll
            for (int e = 0; e < 2; ++e) {
                const int j = j0 + 2 * q + e;
                const float a = __uint_as_float(e ? (gm[q] & 0xffff0000u) : (gm[q] << 16)), b = __uint_as_float(e ? (gc[q] & 0xffff0000u) : (gc[q] << 16)), c = __uint_as_float(e ? (gn[q] & 0xffff0000u) : (gn[q] << 16));
                const float u = __uint_as_float(e ? (uu[q] & 0xffff0000u) : (uu[q] << 16));
                const float z = a * cw[j] + b * cw[DFF + j] + c * cw[2 * DFF + j] + cb[j];
                r2[e] = z / (1.0f + __expf(-z)) * u;
            }
            o[q] = pk2h(r2[0], r2[1]);
        }
        *(v4u*)(ACT + (size_t)rr * DFF + j0) = (v4u){o[0], o[1], o[2], o[3]};
    }
}

struct EpiMulti {
    static constexpr bool PERM = false, AFTER_DRAIN = false;
    int mode;
    bf16* ob; float* of; int ld; const float* tab;
    const float* cw; const float* cb; int nrows; unsigned ldsx;
    const float* xin; float* xout; bf16* xn; const float *gA, *gaA, *gB, *scB, *shB; float* xb0; float* xb1; gu32* cnt0; gu32* cnt1; int two;
    __device__ __forceinline__ bool drain() const { return mode >= 5; }
    __device__ __forceinline__ void row_stats(const pg8::f32x4 (&v)[2][2][4][2], const pg8::Unit& u, int wr, int wc, int fr, int fq, LAS unsigned char* lds, int wid, int lane, float* xb, gu32* cnt) const {
        LAS float* Pp = (LAS float*)lds; LAS float* Ss = (LAS float*)(lds + 8192); LAS unsigned* flag = (LAS unsigned*)(lds + 8192 + 1024);
#pragma unroll
        for (int ai = 0; ai < 2; ++ai)
#pragma unroll
            for (int mm = 0; mm < 4; ++mm) { float s = 0.f;
#pragma unroll
                for (int bj = 0; bj < 2; ++bj)
#pragma unroll
                    for (int n = 0; n < 2; ++n) { const pg8::f32x4 x = v[ai][bj][mm][n]; s += (x[0] * x[0] + x[1] * x[1]) + (x[2] * x[2] + x[3] * x[3]); }
                s += __shfl_xor(s, 16); s += __shfl_xor(s, 32);
                if (fq == 0) Pp[(ai * 128 + wr * 64 + mm * 16 + fr) * 4 + wc] = s; }
        asm volatile("s_waitcnt lgkmcnt(0)" ::: "memory"); __builtin_amdgcn_s_barrier(); asm volatile("" ::: "memory");
        const int row = wid * 32 + (lane & 31);
        if (lane < 32) { const float s = (Pp[row * 4 + 0] + Pp[row * 4 + 1]) + (Pp[row * 4 + 2] + Pp[row * 4 + 3]);
            __hip_atomic_store((gu32*)(xb + ((size_t)u.pn * MLAT + u.pm * 256 + row)), __float_as_uint(s), __ATOMIC_RELAXED, __HIP_MEMORY_SCOPE_AGENT); }
        asm volatile("s_waitcnt vmcnt(0)" ::: "memory");
        if (lane == 0) __hip_atomic_fetch_add(cnt + 64 * u.pm, 1u, __ATOMIC_RELAXED, __HIP_MEMORY_SCOPE_AGENT);
        if (wid == 0) {
            unsigned sp = 0;
            while ((unsigned)__builtin_amdgcn_readfirstlane(__hip_atomic_load(cnt + 64 * u.pm, __ATOMIC_RELAXED, __HIP_MEMORY_SCOPE_AGENT)) < 32u) { __builtin_amdgcn_s_sleep(2); if (++sp > (1u << 22)) break; }
            __builtin_amdgcn_fence(__ATOMIC_ACQUIRE, "agent");
            if (lane == 0) flag[0] = 1u;
        }
        asm volatile("s_waitcnt vmcnt(0) lgkmcnt(0)" ::: "memory"); __builtin_amdgcn_s_barrier(); asm volatile("" ::: "memory");
        if (lane < 32) { float t = 0.f;
#pragma unroll
            for (int q = 0; q < 4; ++q) t += __uint_as_float(__hip_atomic_load((gu32*)(xb + ((size_t)q * MLAT + u.pm * 256 + row)), __ATOMIC_RELAXED, __HIP_MEMORY_SCOPE_AGENT));
            Ss[row] = rsqrtf(t * (1.0f / D) + NORM_EPS); }
        asm volatile("s_waitcnt vmcnt(0) lgkmcnt(0)" ::: "memory"); __builtin_amdgcn_s_barrier(); asm volatile("" ::: "memory");
    }
    __device__ __forceinline__ void fused(pg8::f32x4 (&acc)[2][2][4][2], const pg8::Unit& u, int wr, int wc, int fr_, int fq_, PG8_LAS unsigned char* lds, int wid, int lane) const {
        int fr = fr_, fq = fq_; asm volatile("" : "+v"(fr), "+v"(fq));
#if defined(MK_DBGDRAIN)
        { bf16* obd = mode == 5 ? (bf16*)(kws() + WS_RP) : (bf16*)(kws() + WS_FP);
#pragma unroll
          for (int ai = 0; ai < 2; ++ai)
#pragma unroll
            for (int mm = 0; mm < 4; ++mm) { bf16* rp = obd + (size_t)(u.pm * 256 + ai * 128 + wr * 64 + mm * 16 + fr) * D + u.pn * 256 + wc * 32 + 4 * fq;
#pragma unroll
                for (int bj = 0; bj < 2; ++bj)
#pragma unroll
                    for (int n = 0; n < 2; ++n) { const pg8::f32x4 v = acc[ai][bj][mm][n]; v2u o; o.x = pk2h(v[0], v[1]); o.y = pk2h(v[2], v[3]); *(v2u*)(rp + bj * 128 + n * 16) = o; } }
          return; }
#endif
        const LAS float* Ss = (const LAS float*)((LAS unsigned char*)lds + 8192);
        const int col0 = u.pn * 256 + wc * 32 + 4 * fq, bofs = (u.pm >> 4) * 6144;
        row_stats(acc, u, wr, wc, fr, fq, (LAS unsigned char*)lds, wid, lane, xb0, cnt0);
        pg8::f32x4 cA_[2][2];
#pragma unroll
        for (int bj = 0; bj < 2; ++bj)
#pragma unroll
            for (int n = 0; n < 2; ++n) cA_[bj][n] = *(const pg8::f32x4*)(gA + col0 + 128 * bj + 16 * n) * *(const pg8::f32x4*)(gaA + bofs + col0 + 128 * bj + 16 * n);
#pragma unroll
        for (int ai = 0; ai < 2; ++ai)
#pragma unroll
            for (int mm = 0; mm < 4; ++mm) { const int r = ai * 128 + wr * 64 + mm * 16 + fr; const float rs = Ss[r]; const size_t off = (size_t)(u.pm * 256 + r) * D + col0;
#pragma unroll
                for (int bj = 0; bj < 2; ++bj)
#pragma unroll
                    for (int n = 0; n < 2; ++n) { const pg8::f32x4 xi = *(const pg8::f32x4*)(xin + off + 128 * bj + 16 * n); acc[ai][bj][mm][n] = xi + cA_[bj][n] * (acc[ai][bj][mm][n] * rs); }
                asm volatile("" : "+v"(acc[ai][0][mm][0]), "+v"(acc[ai][0][mm][1]), "+v"(acc[ai][1][mm][0]), "+v"(acc[ai][1][mm][1]));
                if (mm & 1) asm volatile("" ::: "memory"); }
        if (two) {
            asm volatile("s_waitcnt lgkmcnt(0)" ::: "memory"); __builtin_amdgcn_s_barrier(); asm volatile("" ::: "memory");
            row_stats(acc, u, wr, wc, fr, fq, (LAS unsigned char*)lds, wid, lane, xb1, cnt1);
        }
        pg8::f32x4 cB_[2][2], cS_[2][2];
        if (two) {
#pragma unroll
            for (int bj = 0; bj < 2; ++bj)
#pragma unroll
                for (int n = 0; n < 2; ++n) { cB_[bj][n] = *(const pg8::f32x4*)(gB + col0 + 128 * bj + 16 * n) * (*(const pg8::f32x4*)(scB + bofs + col0 + 128 * bj + 16 * n) + 1.0f); cS_[bj][n] = *(const pg8::f32x4*)(shB + bofs + col0 + 128 * bj + 16 * n); }
        }
#pragma unroll
        for (int ai = 0; ai < 2; ++ai)
#pragma unroll
            for (int mm = 0; mm < 4; ++mm) { const int r = ai * 128 + wr * 64 + mm * 16 + fr; const size_t off = (size_t)(u.pm * 256 + r) * D + col0; const float rs = two ? Ss[r] : 0.f;
#pragma unroll
                for (int bj = 0; bj < 2; ++bj)
#pragma unroll
                    for (int n = 0; n < 2; ++n) { const pg8::f32x4 x1 = acc[ai][bj][mm][n]; *(pg8::f32x4*)(xout + off + 128 * bj + 16 * n) = x1;
                        if (two) { const pg8::f32x4 hh = x1 * rs * cB_[bj][n] + cS_[bj][n]; v2u o; o.x = pk2h(hh[0], hh[1]); o.y = pk2h(hh[2], hh[3]); *(v2u*)(xn + off + 128 * bj + 16 * n) = o; } }
                asm volatile("" ::: "memory"); }
        asm volatile("s_waitcnt lgkmcnt(0)" ::: "memory"); __builtin_amdgcn_s_barrier(); asm volatile("" ::: "memory");
    }
    __device__ __forceinline__ void operator()(const pg8::f32x4 (&acc)[2][2][4][2], const pg8::Unit& u, int wr, int wc, int fr_, int fq_) const {
        int fr = fr_, fq = fq_; asm volatile("" : "+v"(fr), "+v"(fq));
        if (mode == 1) {
#pragma unroll
            for (int ai = 0; ai < 2; ++ai)
#pragma unroll
                for (int m = 0; m < 4; ++m) { float* rp = of + (size_t)(u.pm * 256 + ai * 128 + wr * 64 + m * 16 + fr) * ld + u.pn * 256 + wc * 32 + 4 * fq;
#pragma unroll
                    for (int bj = 0; bj < 2; ++bj)
#pragma unroll
                        for (int n = 0; n < 2; ++n) *(pg8::f32x4*)(rp + bj * 128 + n * 16) = acc[ai][bj][m][n]; }
        } else if (mode == 3) {
            const unsigned par = (unsigned)(u.pm + u.pn) & 1u;
            const unsigned ex = ldsx + par * 4096u + (unsigned)(wc * 32 + 4 * fq) * 4u;
#pragma unroll
            for (int ai = 0; ai < 2; ++ai)
#pragma unroll
                for (int n = 0; n < 2; ++n) {
                    if (fr == 0) *(LAS pg8::f32x4*)(uintptr_t)(ex + (unsigned)(((ai * 2 + wr) * 2 + 0) * 128 + n * 16) * 4u) = acc[ai][0][0][n];
                    if (fr == 15) *(LAS pg8::f32x4*)(uintptr_t)(ex + (unsigned)(((ai * 2 + wr) * 2 + 1) * 128 + n * 16) * 4u) = acc[ai][0][3][n];
                }
            asm volatile("s_waitcnt lgkmcnt(0)" ::: "memory"); __builtin_amdgcn_s_barrier(); asm volatile("" ::: "memory");
            const int jb = u.pn * 128 + wc * 32 + 4 * fq;
#pragma unroll
            for (int n = 0; n < 2; ++n) {
                const int j = jb + 16 * n;
                const pg8::f32x4 w0 = *(const pg8::f32x4*)(cw + j), w1 = *(const pg8::f32x4*)(cw + DFF + j), w2 = *(const pg8::f32x4*)(cw + 2 * DFF + j), bb = *(const pg8::f32x4*)(cb + j);
#pragma unroll
                for (int ai = 0; ai < 2; ++ai) {
                    const int pblk = (ai * 2 + wr) - 1, nblk = (ai * 2 + wr) + 1;
                    pg8::f32x4 eprev = (pg8::f32x4){0.f, 0.f, 0.f, 0.f}, enext = eprev;
                    if (pblk >= 0) eprev = *(LAS const pg8::f32x4*)(uintptr_t)(ex + (unsigned)((pblk * 2 + 1) * 128 + n * 16) * 4u);
                    if (nblk <= 3) enext = *(LAS const pg8::f32x4*)(uintptr_t)(ex + (unsigned)((nblk * 2 + 0) * 128 + n * 16) * 4u);
#pragma unroll
                    for (int mm = 0; mm < 4; ++mm) {
                        const int trow = ai * 128 + wr * 64 + mm * 16 + fr, grow = u.pm * 254 - 1 + trow;
                        int t, T; seq_pos(grow < 0 ? 0 : grow, t, T);
                        const pg8::f32x4 gc = acc[ai][0][mm][n], uu = acc[ai][1][mm][n];
                        pg8::f32x4 gp, gn;
#pragma unroll
                        for (int i = 0; i < 4; ++i) {
                            const float pold = mm > 0 ? __int_as_float(__builtin_amdgcn_update_dpp(0, __float_as_int(acc[ai][0][mm > 0 ? mm - 1 : 0][n][i]), 0x121, 0xF, 0xF, false)) : eprev[i];
                            gp[i] = __int_as_float(__builtin_amdgcn_update_dpp(__float_as_int(pold), __float_as_int(gc[i]), 0x111, 0xF, 0xF, false));
                            const float nold = mm < 3 ? __int_as_float(__builtin_amdgcn_update_dpp(0, __float_as_int(acc[ai][0][mm < 3 ? mm + 1 : 3][n][i]), 0x12F, 0xF, 0xF, false)) : enext[i];
                            gn[i] = __int_as_float(__builtin_amdgcn_update_dpp(__float_as_int(nold), __float_as_int(gc[i]), 0x101, 0xF, 0xF, false));
                        }
                        if (t == 0) gp = (pg8::f32x4){0.f, 0.f, 0.f, 0.f};
                        if (t == T - 1) gn = (pg8::f32x4){0.f, 0.f, 0.f, 0.f};
                        const pg8::f32x4 z = gp * w0 + gc * w1 + gn * w2 + bb;
                        pg8::f32x4 a;
#pragma unroll
                        for (int i = 0; i < 4; ++i) a[i] = z[i] * __builtin_amdgcn_rcpf(1.0f + __expf(-z[i])) * uu[i];
                        if (trow >= 1 && trow <= 254 && grow < nrows) { v2u o; o.x = pk2h(a[0], a[1]); o.y = pk2h(a[2], a[3]); *(v2u*)(ob + (size_t)grow * DFF + j) = o; }
                    }
                }
            }
        } else if (mode == 2) {
#pragma unroll
            for (int ai = 0; ai < 2; ++ai)
#pragma unroll
                for (int m = 0; m < 4; ++m) { bf16* rp = ob + (size_t)(u.pm * 256 + ai * 128 + wr * 64 + m * 16 + fr) * ld + u.pn * 256 + wc * 32 + 4 * fq;
#pragma unroll
                    for (int bj = 0; bj < 2; ++bj)
#pragma unroll
                        for (int n = 0; n < 2; ++n) { const pg8::f32x4 v = acc[ai][bj][m][n]; v2u o; o.x = pk2h(v[0], v[1]); o.y = pk2h(v[2], v[3]); *(v2u*)(rp + bj * 128 + n * 16) = o; } }
        } else {
            const bool latent = u.pm < (MLAT / 256);
#pragma unroll
            for (int bj = 0; bj < 2; ++bj) {
                const int g32 = u.pn * 8 + bj * 4 + wc;
                if (g32 >= INW / 32) continue;
                const bool isdf = (g32 >= C_DFQ / 32 && g32 < C_DFV / 32), isgq = (g32 >= C_GQQ / 32 && g32 < C_GQV / 32);
                const float qs = (g32 >= C_DFQ / 32 && g32 < C_DFK / 32) ? SC_DF : ((g32 >= C_GQQ / 32 && g32 < C_GQK / 32) ? SC_GQ : 1.0f);
#pragma unroll
                for (int ai = 0; ai < 2; ++ai)
#pragma unroll
                    for (int m = 0; m < 4; ++m) {
                        const int row = u.pm * 256 + ai * 128 + wr * 64 + m * 16 + fr, s = row & (SEQ - 1), prow = s >> 6, pcol = s & 63;
                        pg8::f32x4 v0 = acc[ai][bj][m][0], v1 = acc[ai][bj][m][1];
                        if (isdf) {
                            pg8::f32x4 p0, p1;
#pragma unroll
                            for (int i = 0; i < 4; ++i) { p0[i] = __shfl_xor(v0[i], 32); p1[i] = __shfl_xor(v1[i], 32); }
                            if (latent) {
                                const int f0 = 4 * (fq & 1);
                                const pg8::f32x4 c0 = *(const pg8::f32x4*)(tab + prow * 8 + f0), s0 = *(const pg8::f32x4*)(tab + 512 + prow * 8 + f0);
                                const pg8::f32x4 c1 = *(const pg8::f32x4*)(tab + pcol * 8 + f0), s1 = *(const pg8::f32x4*)(tab + 512 + pcol * 8 + f0);
                                if (fq & 2) { v0 = v0 * c0 + p0 * s0; v1 = v1 * c1 + p1 * s1; } else { v0 = v0 * c0 - p0 * s0; v1 = v1 * c1 - p1 * s1; }
                            }
                        } else if (isgq) {
                            if (latent) {
                                const int pos = (g32 & 1) ? pcol : prow;
                                const pg8::f32x4 cc = *(const pg8::f32x4*)(tab + 1024 + pos * 16 + 4 * fq), ss = *(const pg8::f32x4*)(tab + 2048 + pos * 16 + 4 * fq);
                                const pg8::f32x4 a = v0 * cc - v1 * ss, b = v1 * cc + v0 * ss; v0 = a; v1 = b;
                            }
                        }
                        v0 = v0 * qs; v1 = v1 * qs;
                        bf16* rp = ob + (size_t)row * INP + g32 * 32 + 4 * fq;
                        v2u o; o.x = pk2h(v0[0], v0[1]); o.y = pk2h(v0[2], v0[3]); *(v2u*)rp = o;
                        o.x = pk2h(v1[0], v1[1]); o.y = pk2h(v1[2], v1[3]); *(v2u*)(rp + 16) = o;
                        asm volatile("" ::: "memory");
                    }
            }
        }
    }
};


template <int CTRL, int RM> __device__ __forceinline__ float dpp_mul1(float x) {
    return x * __int_as_float(__builtin_amdgcn_update_dpp(0x3f800000, __float_as_int(x), CTRL, RM, 0xF, false));
}
__device__ __forceinline__ float wave_mulscan(float x) {
    x = dpp_mul1<0x111, 0xF>(x); x = dpp_mul1<0x112, 0xF>(x); x = dpp_mul1<0x114, 0xF>(x); x = dpp_mul1<0x118, 0xF>(x);
    x = dpp_mul1<0x142, 0xA>(x); x = dpp_mul1<0x143, 0xC>(x); return x;
}
__device__ __forceinline__ float wave_shr1_one(float x) { return __int_as_float(__builtin_amdgcn_update_dpp(0x3f800000, __float_as_int(x), 0x138, 0xF, 0xF, false)); }
__device__ __forceinline__ bf16 bf1(float x) { return (bf16)(pk2h(x, 0.f) & 0xffffu); }

constexpr int FT_LD = 65, FT_ARR = 64 * FT_LD * 4;
constexpr int FT_BON = 9 * FT_ARR;
constexpr int FT_PR_LD = 200;
static_assert(66 * FT_PR_LD * 2 <= 2 * FT_ARR && FT_BON + 512 <= LDSCTL_OFF, "features LDS map");
__device__ __forceinline__ void rwkv_features(const Args& A, Frame& F, int l) {
    const int w = F.wave, n = F.lane, c15 = n & 15, g = n >> 4, tr = w >> 1, tc0 = (w & 1) * 2;
    const int h = F.bid & 3, c = h * 64 + n;
    const bf16* P = (const bf16*)(kws() + WS_RP);
    bf16* FV = (bf16*)(kws() + WS_FV); float* BON = (float*)(kws() + WS_BON); float* GLT = (float*)(kws() + WS_GLT);
    float cw[3][3];
#pragma unroll
    for (int tp = 0; tp < 3; ++tp)
#pragma unroll
        for (int j = 0; j < 3; ++j) cw[tp][j] = kin(I_RWCONV)[(size_t)(l * 3 + tp) * 768 + j * 256 + c];
    const float kkc = kin(I_RWKK)[l * 256 + c];
    bf16x8 Bw[2][2], Ba[2][2]; float w0c[2][2], a0c[2][2], kac2[2], rkc2[2];
#pragma unroll
    for (int t = 0; t < 2; ++t) { const int cn = h * 64 + 16 * (tc0 + t) + c15;
        kac2[t] = kin(I_RWKA)[l * 256 + cn]; rkc2[t] = kin(I_RWRK)[l * 256 + cn];
#pragma unroll
        for (int d = 0; d < 2; ++d) { w0c[d][t] = kin(I_RWW0)[(l * 2 + d) * 256 + cn]; a0c[d][t] = kin(I_RWA0)[(l * 2 + d) * 256 + cn];
            unsigned pw[4], pa[4];
#pragma unroll
            for (int j = 0; j < 8; j += 2) { const size_t o = ((size_t)(l * 2 + d) * 32 + 8 * g + j) * 256 + cn;
                pw[j >> 1] = pk2h(kin(I_RWWUP)[o], kin(I_RWWUP)[o + 256]); pa[j >> 1] = pk2h(kin(I_RWAUP)[o], kin(I_RWAUP)[o + 256]); }
            Bw[d][t] = __builtin_bit_cast(bf16x8, (v4u){pw[0], pw[1], pw[2], pw[3]}); Ba[d][t] = __builtin_bit_cast(bf16x8, (v4u){pa[0], pa[1], pa[2], pa[3]}); }
    }
    for (int u = F.bid; u < 4 * (MALL / 64); u += F.G) {
        const int gi = u >> 2, row0 = 64 * gi;
        int t0, T; seq_pos(row0, t0, T);
        __syncthreads();
        for (int p = F.tid; p < 66 * 24; p += NTHR) { const int rr = p / 24, q = p % 24, which = q >> 3, ch = q & 7, row = row0 - 1 + rr;
            const bool ok = (rr >= 1 && rr <= 64) || (rr == 0 ? t0 > 0 : t0 + 64 < T);
            unsigned z_ = 0u; asm volatile("" : "+v"(z_)); v4u v = (v4u){z_, z_, z_, z_};
            if (ok) v = *(const v4u*)(P + (size_t)row * INP + which * 256 + h * 64 + 8 * ch);
            *(LAS v4u*)(F.lds + (rr * FT_PR_LD + which * 64 + 8 * ch) * 2) = v; }
        v4u xwd[2], xad[2];
        { const bf16* pr = P + (size_t)(row0 + 16 * tr + c15) * INP + 8 * g;
#pragma unroll
          for (int d = 0; d < 2; ++d) { xwd[d] = *(const v4u*)(pr + C_WD + 32 * d); xad[d] = *(const v4u*)(pr + C_AD + 32 * d); } }
        __syncthreads();
#pragma unroll
        for (int rr = 0; rr < 8; ++rr) {
            const int i = 8 * w + rr;
            float xr[3], xk[3], xv[3];
#pragma unroll
            for (int tp = 0; tp < 3; ++tp) { const LAS bf16* pp = (const LAS bf16*)F.lds + (i + tp) * FT_PR_LD + n; xr[tp] = bf2f(pp[0]); xk[tp] = bf2f(pp[64]); xv[tp] = bf2f(pp[128]); }
            const float rq = bf2f(bf1(xr[0] * cw[0][0] + xr[1] * cw[1][0] + xr[2] * cw[2][0])), kq = bf2f(bf1(xk[0] * cw[0][1] + xk[1] * cw[1][1] + xk[2] * cw[2][1]));
            FV[(size_t)(row0 + i) * 256 + c] = bf1(xv[0] * cw[0][2] + xv[1] * cw[1][2] + xv[2] * cw[2][2]);
            const float kkraw = kq * kkc;
            const float kk = kkraw * (1.0f / fmaxf(sqrtf(wave_sum(kkraw * kkraw)), 1e-12f));
            LAS float* L = (LAS float*)F.lds + i * FT_LD + n;
            L[2 * (FT_ARR / 4)] = kk; L[7 * (FT_ARR / 4)] = rq; L[8 * (FT_ARR / 4)] = kq;
        }
        __syncthreads();
        {
            bf16x8 aw[2], aa[2];
#pragma unroll
            for (int d = 0; d < 2; ++d) { unsigned pw[4];
#pragma unroll
                for (int q = 0; q < 4; ++q) { const float x0 = __uint_as_float(xwd[d][q] << 16), x1 = __uint_as_float(xwd[d][q] & 0xffff0000u);
                    pw[q] = pk2h(1.0f - 2.0f * __builtin_amdgcn_rcpf(1.0f + __expf(2.0f * x0)), 1.0f - 2.0f * __builtin_amdgcn_rcpf(1.0f + __expf(2.0f * x1))); }
                aw[d] = __builtin_bit_cast(bf16x8, (v4u){pw[0], pw[1], pw[2], pw[3]}); aa[d] = __builtin_bit_cast(bf16x8, xad[d]); }
            float bsum[4] = {0.f, 0.f, 0.f, 0.f};
#pragma unroll
            for (int t = 0; t < 2; ++t) {
                float kkv[4], kqv[4], rqv[4];
#pragma unroll
                for (int r = 0; r < 4; ++r) { const LAS float* L = (const LAS float*)F.lds + (16 * tr + 4 * g + r) * FT_LD + 16 * (tc0 + t) + c15;
                    kkv[r] = L[2 * (FT_ARR / 4)]; rqv[r] = L[7 * (FT_ARR / 4)]; kqv[r] = L[8 * (FT_ARR / 4)]; }
#pragma unroll
                for (int d = 0; d < 2; ++d) {
                    const f32x4 wl = __builtin_amdgcn_mfma_f32_16x16x32_bf16(aw[d], Bw[d][t], (f32x4){0.f, 0.f, 0.f, 0.f}, 0, 0, 0);
                    const f32x4 al = __builtin_amdgcn_mfma_f32_16x16x32_bf16(aa[d], Ba[d][t], (f32x4){0.f, 0.f, 0.f, 0.f}, 0, 0, 0);
#pragma unroll
                    for (int r = 0; r < 4; ++r) {
                        const float wv = 1.0f + bf2f(bf1(__expf(-0.6065306597126334f * sigmoidf_(wl[r] + w0c[d][t])) - 1.0f)), aq = bf2f(bf1(sigmoidf_(al[r] + a0c[d][t])));
                        const float kd = kqv[r] * (1.0f + (aq - 1.0f) * kac2[t]);
                        LAS float* L = (LAS float*)F.lds + (16 * tr + 4 * g + r) * FT_LD + 16 * (tc0 + t) + c15;
                        L[(0 + d) * (FT_ARR / 4)] = wv; L[(3 + d) * (FT_ARR / 4)] = kkv[r] * aq; L[(5 + d) * (FT_ARR / 4)] = kd;
                        bsum[r] += rqv[r] * kd * rkc2[t];
                    }
                }
            }
#pragma unroll
            for (int r = 0; r < 4; ++r) { float s = bsum[r]; s = dpp_add<0xB1>(s); s = dpp_add<0x4E>(s); s = dpp_add<0x124>(s); s = dpp_add<0x128>(s);
                if (c15 == 0) *(LAS float*)(F.lds + FT_BON + ((w & 1) * 64 + 16 * tr + 4 * g + r) * 4) = s; }
        }
        __syncthreads();
        if (F.tid < 64) BON[(row0 + F.tid) * 4 + h] = *(LAS float*)(F.lds + FT_BON + F.tid * 4) + *(LAS float*)(F.lds + FT_BON + (64 + F.tid) * 4);
#pragma unroll
        for (int d = 0; d < 2; ++d) {
            const int i = d ? 63 - n : n;
            const LAS float* L = (const LAS float*)F.lds + i * FT_LD + 8 * w;
            unsigned al8[4], be8[4], kp8[4], rh8[4]; float g63[8];
#pragma unroll
            for (int e2 = 0; e2 < 4; ++e2) {
                float alv[2], bev[2], kpv[2], rhv[2];
#pragma unroll
                for (int q = 0; q < 2; ++q) { const int e = 2 * e2 + q;
                    const float gi_ = wave_mulscan(L[(0 + d) * (FT_ARR / 4) + e]), gim1 = wave_shr1_one(gi_), ig = __builtin_amdgcn_rcpf(gi_);
                    g63[e] = rdlane(gi_, 63);
                    alv[q] = gim1 * L[2 * (FT_ARR / 4) + e]; bev[q] = L[(3 + d) * (FT_ARR / 4) + e] * ig; kpv[q] = L[(5 + d) * (FT_ARR / 4) + e] * ig; rhv[q] = gi_ * L[7 * (FT_ARR / 4) + e]; }
                al8[e2] = pk2h(alv[0], alv[1]); be8[e2] = pk2h(bev[0], bev[1]); kp8[e2] = pk2h(kpv[0], kpv[1]); rh8[e2] = pk2h(rhv[0], rhv[1]);
            }
            const size_t o = (size_t)d * MALL * 256 + (size_t)(64 * gi + i) * 256 + h * 64 + 8 * w;
            *(v4u*)((bf16*)(kws() + WS_GAL) + o) = (v4u){al8[0], al8[1], al8[2], al8[3]}; *(v4u*)((bf16*)(kws() + WS_GBE) + o) = (v4u){be8[0], be8[1], be8[2], be8[3]};
            *(v4u*)((bf16*)(kws() + WS_GKP) + o) = (v4u){kp8[0], kp8[1], kp8[2], kp8[3]}; *(v4u*)((bf16*)(kws() + WS_GRH) + o) = (v4u){rh8[0], rh8[1], rh8[2], rh8[3]};
            if (n < 8) { float gl = g63[0];
#pragma unroll
                for (int e = 1; e < 8; ++e) gl = (n == e) ? g63[e] : gl;
                GLT[((size_t)d * 272 + gi) * 256 + h * 64 + 8 * w + n] = gl; }
        }
    }
}

__device__ __forceinline__ int scan_row(int d, int b, int i) { if (i < CTXL) { const int t = d ? CTXL - 1 - i : i; return MLAT + b * CTXL + t; } const int j = i - CTXL, t = d ? SEQ - 1 - j : j; return b * SEQ + t; }

__device__ __forceinline__ void rwkv_readout(const Args& A, Frame& F, int l) {
    const int gw = F.bid * NWAVES + F.wave, NGW = F.G * NWAVES, nrows = l == 0 ? MALL : MLAT;
    const int h = gw & 3, n = F.lane, c = h * 64 + n;
    const bf16* P = (const bf16*)(kws() + WS_RP); const bf16* FV = (const bf16*)(kws() + WS_FV);
    const float* BON = (const float*)(kws() + WS_BON); bf16* Y = (bf16*)(kws() + WS_XN);
    float gupr[64];
#pragma unroll
    for (int j = 0; j < 64; ++j) gupr[j] = kin(I_RWGUP)[((size_t)l * 64 + j) * 256 + c];
    const float lng = kin(I_RWLNG)[l * 256 + c], lnb = kin(I_RWLNB)[l * 256 + c];
    bf16 q0 = 0, q1 = 0, qg = 0, qv = 0; float qb = 0.f;
#define RO_LOAD(r_) do { q0 = P[(size_t)(r_) * INP + c]; q1 = P[(size_t)(r_) * INP + 256 + c]; qg = P[(size_t)(r_) * INP + C_GD + n]; qv = FV[(size_t)(r_) * 256 + c]; qb = BON[(r_) * 4 + h]; } while (0)
    if ((gw >> 2) < nrows) RO_LOAD(gw >> 2);
    for (int row = gw >> 2; row < nrows; row += NGW >> 2) {
        const float ov = bf2f(q0) + bf2f(q1), gdv = bf2f(qg), vv = bf2f(qv), bon = qb;
        const int nxt = row + (NGW >> 2);
        if (nxt < nrows) RO_LOAD(nxt);
        const float mu = wave_sum(ov) * (1.0f / 64.0f), dv = ov - mu, var = wave_sum(dv * dv) * (1.0f / 64.0f);
        const float on = dv * rsqrtf(var + 64e-5f) * lng + lnb;
        const float sg = sigmoidf_(gdv);
        float g = 0.f;
#pragma unroll
        for (int j = 0; j < 64; ++j) g = fmaf(rdlane(sg, j), gupr[j], g);
        const float y = (on + bon * vv) * g;
        Y[(size_t)row * D + c] = bf1(y);
    }
#undef RO_LOAD
}


constexpr int CK_LD = 72, CK_MAT = 64 * CK_LD * 2, CK_HALF = 32 * CK_LD * 2;
constexpr int O_AL = 0, O_BE = 2 * CK_MAT, O_RH = 4 * CK_MAT, O_KP = 6 * CK_MAT, O_V = 7 * CK_MAT, O_AOFF = 8 * CK_MAT, O_MB = 10 * CK_MAT, O_BM = 12 * CK_MAT, O_MK = 13 * CK_MAT;
constexpr int O_SB = 14 * CK_MAT, O_YZ = O_SB + 2 * CK_HALF, O_UT = O_YZ + CK_HALF;
constexpr int CK_TD_LD = 40, CK_TDSZ = 64 * CK_TD_LD * 2;
constexpr int CK_TD = O_UT + CK_HALF;
constexpr int CK_ADG = CK_TD + 2 * CK_TDSZ;
constexpr int CK_GL = CK_ADG + 4096;
constexpr int CK_END = CK_GL + 512;
static_assert(CK_END <= LDSCTL_OFF, "chunk scan LDS map");
struct CkAddr { unsigned v1t, lds, vX0, vT0, vR0; };
typedef short v4s16 __attribute__((ext_vector_type(4)));
#define CKP(T, addr) ((LAS T*)(uintptr_t)(addr))
__device__ __forceinline__ bf16x8 ldtr(unsigned addr) {
    const v4s16 lo = __builtin_amdgcn_ds_read_tr16_b64_v4i16((LAS v4s16*)(uintptr_t)addr), hi = __builtin_amdgcn_ds_read_tr16_b64_v4i16((LAS v4s16*)(uintptr_t)(addr + 4 * CK_LD * 2));
    return __builtin_bit_cast(bf16x8, __builtin_shufflevector(lo, hi, 0, 1, 2, 3, 4, 5, 6, 7));
}
template <int KS, bool TRX, bool TRY> __device__ __forceinline__ void mm1(f32x4& acc, const CkAddr& K, unsigned ox, unsigned oy, int xt, int yt) {
    const unsigned ax = (TRX ? K.vR0 + xt * 32 : K.vX0 + xt * (16 * CK_LD * 2)) + ox;
    const unsigned ay = (TRY ? K.vR0 + yt * 32 : K.vX0 + yt * (16 * CK_LD * 2)) + oy;
#pragma unroll
    for (int ks = 0; ks < KS; ++ks) {
        const bf16x8 a = TRX ? ldtr(ax + ks * (32 * CK_LD * 2)) : *CKP(const bf16x8, ax + 64 * ks);
        const bf16x8 bq = TRY ? ldtr(ay + ks * (32 * CK_LD * 2)) : *CKP(const bf16x8, ay + 64 * ks);
        acc = __builtin_amdgcn_mfma_f32_16x16x32_bf16(a, bq, acc, 0, 0, 0); }
}
__device__ __forceinline__ void stT1(const CkAddr& K, unsigned o, int rt, int ct, const f32x4 v) {
    v2u q; q.x = pk2h(v[0], v[1]); q.y = pk2h(v[2], v[3]); *CKP(v2u, K.vT0 + o + ct * (16 * CK_LD * 2) + rt * 32) = q;
}
__device__ __forceinline__ void ck_tile4(const CkAddr& K, int xt, int yt, unsigned oAL, unsigned oBE, unsigned oRH, f32x4& pa, f32x4& pb, f32x4& pm, f32x4& pk) {
    pa = (f32x4){0.f, 0.f, 0.f, 0.f}; pb = pa; pm = pa; pk = pa;
    mm1<2, false, false>(pa, K, oBE, oAL, xt, yt); mm1<2, false, false>(pb, K, O_KP, oAL, xt, yt); mm1<2, false, false>(pm, K, oBE, oRH, xt, yt); mm1<2, false, false>(pk, K, O_KP, oRH, xt, yt);
}
__device__ __forceinline__ void rwkv_chunk_unit(const Args& A, Frame& F, int l, int sc, int vh) {
    const bool last = (l == 1);
    const int d = sc >> 4, b = (sc >> 2) & 3, h = sc & 3;
    const int w = F.wave, n = F.lane;
    const bf16* GAL = (const bf16*)(kws() + WS_GAL) + (size_t)d * MALL * 256; const bf16* GBE = (const bf16*)(kws() + WS_GBE) + (size_t)d * MALL * 256;
    const bf16* GKP = (const bf16*)(kws() + WS_GKP) + (size_t)d * MALL * 256; const bf16* GRH = (const bf16*)(kws() + WS_GRH) + (size_t)d * MALL * 256;
    const bf16* FV = (const bf16*)(kws() + WS_FV); const float* GLT = (const float*)(kws() + WS_GLT) + (size_t)d * 272 * 256;
    bf16* O = (bf16*)(kws() + WS_RP) + d * 256;
    constexpr int NCK = (CTXL + SEQ) / 64;
    v4u ual, ube, ukp, urh, uv; float fgl = 0.f;
#define CK_FETCH(cc_) do { const int cq_ = (cc_) < NCK ? (cc_) : NCK - 1; const int row_ = scan_row(d, b, 64 * cq_ + 8 * w + (n >> 3)); const size_t o_ = (size_t)row_ * 256 + h * 64 + 8 * (n & 7); \
        ual = *(const v4u*)(GAL + o_); ube = *(const v4u*)(GBE + o_); ukp = *(const v4u*)(GKP + o_); urh = *(const v4u*)(GRH + o_); uv = *(const v4u*)(FV + o_); \
        if (w == 0) fgl = GLT[(size_t)(scan_row(d, b, 64 * cq_) >> 6) * 256 + h * 64 + n]; } while (0)
    CK_FETCH(0);
    __syncthreads();
    { unsigned z_ = 0u; asm volatile("" : "+v"(z_));
      for (int i = F.tid; i < CK_END / 16; i += NTHR) *(LAS v4u*)(F.lds + i * 16) = (v4u){z_, z_, z_, z_}; }
    f32x4 st = (f32x4){0.f, 0.f, 0.f, 0.f};
    f32x4 st0 = st, yb0 = st, ob0 = st;
    __syncthreads();
    for (int c = -1; c < NCK; ++c) {
        int c15 = n & 15, g = n >> 4; asm volatile("" : "+v"(c15), "+v"(g));
        CkAddr K; K.lds = (unsigned)(uintptr_t)F.lds;
        K.v1t = K.lds + ((8 * w + (n >> 3)) * CK_LD + 8 * (n & 7)) * 2;
        K.vR0 = K.lds + ((8 * g + (c15 >> 2)) * CK_LD + 4 * (c15 & 3)) * 2;
        K.vX0 = K.lds + (c15 * CK_LD + 8 * g) * 2; K.vT0 = K.lds + (c15 * CK_LD + 4 * g) * 2;
        asm volatile("" : "+v"(K.v1t), "+v"(K.vX0), "+v"(K.vT0), "+v"(K.vR0));
        const int ti = w >> 1, tv = w & 1, tv2 = w >> 2, tk = w & 3;
        const unsigned pc = (unsigned)(c & 1), pn = pc ^ 1u;
        const unsigned oAL = O_AL + pc * CK_MAT, oBE = O_BE + pc * CK_MAT, oRH = O_RH + pc * CK_MAT, oAOFF = O_AOFF + pc * CK_MAT, oMB = O_MB + pc * CK_MAT, oSB = O_SB + pc * CK_HALF, oTD = CK_TD + pc * CK_TDSZ, oGL = CK_GL + pc * 256;
        const unsigned nAL = O_AL + pn * CK_MAT, nBE = O_BE + pn * CK_MAT, nRH = O_RH + pn * CK_MAT, nAOFF = O_AOFF + pn * CK_MAT, nMB = O_MB + pn * CK_MAT, nSB = O_SB + pn * CK_HALF, nTD = CK_TD + pn * CK_TDSZ, nGL = CK_GL + pn * 256;
        const bool skip_o = c < 0 || (last && c < CTXL / 64), skip_on = last && c + 1 < CTXL / 64;
        *CKP(v4u, K.v1t + nAL) = ual; *CKP(v4u, K.v1t + nBE) = ube; *CKP(v4u, K.v1t + O_KP) = ukp; *CKP(v4u, K.v1t + nRH) = urh; *CKP(v4u, K.v1t + O_V) = uv;
        if (w == 0) *CKP(float, K.lds + nGL + n * 4) = fgl;
        asm volatile("" ::: "memory");
        CK_FETCH(c + 2);
        { f32x4 yb = yb0; mm1<2, false, false>(yb, K, oAL, oSB, ti, tv); stT1(K, O_YZ, ti, tv, yb); }
        __syncthreads();
        if (w < 2) {
            const unsigned aX = K.lds + ((c15) * CK_LD + 8 * g) * 2;
            const unsigned bY = K.lds + ((16 * w + c15) * CK_LD + 8 * g) * 2;
            const unsigned cT = K.lds + ((16 * w + c15) * CK_LD + 4 * g) * 2;
#pragma unroll
            for (int blk = 0; blk < 4; ++blk) {
                f32x4 z = (f32x4){0.f, 0.f, 0.f, 0.f};
                if (blk > 0) {
#pragma unroll
                    for (int ks = 0; ks < (blk == 3 ? 2 : 1); ++ks) {
                        const bf16x8 a = *CKP(const bf16x8, aX + oAOFF + blk * (16 * CK_LD * 2) + 64 * ks);
                        const bf16x8 u = *CKP(const bf16x8, bY + O_UT + 64 * ks);
                        z = __builtin_amdgcn_mfma_f32_16x16x32_bf16(a, u, z, 0, 0, 0); }
                }
                { const v2u yv = *CKP(const v2u, cT + O_YZ + 32 * blk);
                  z[0] += __uint_as_float(yv.x << 16); z[1] += __uint_as_float(yv.x & 0xffff0000u); z[2] += __uint_as_float(yv.y << 16); z[3] += __uint_as_float(yv.y & 0xffff0000u); }
                { v2u zo; zo.x = pk2h(z[0], z[1]); zo.y = pk2h(z[2], z[3]); *CKP(v2u, cT + O_YZ + 32 * blk) = zo; }
                asm volatile("s_waitcnt lgkmcnt(0)" ::: "memory");
                const bf16x8 ta = *CKP(const bf16x8, K.lds + oTD + ((16 * blk + c15) * CK_TD_LD + 8 * g) * 2);
                const bf16x8 zb = *CKP(const bf16x8, bY + O_YZ + 32 * blk);
                f32x4 u = __builtin_amdgcn_mfma_f32_16x16x32_bf16(ta, zb, (f32x4){0.f, 0.f, 0.f, 0.f}, 0, 0, 0);
                { v2u uo; uo.x = pk2h(-u[0], -u[1]); uo.y = pk2h(-u[2], -u[3]); *CKP(v2u, cT + O_UT + 32 * blk) = uo; }
                asm volatile("s_waitcnt lgkmcnt(0)" ::: "memory");
            }
        } else if (w < 6) {
            const int bb = w - 2;
            f32x4 pa, pb, pm, pk; ck_tile4(K, bb, bb, nAL, nBE, nRH, pa, pb, pm, pk);
#pragma unroll
            for (int r = 0; r < 4; ++r) { const bool strict = 4 * g + r < c15, incl = 4 * g + r <= c15;
                pa[r] = strict ? pa[r] : 0.f; pb[r] = strict ? pb[r] : 0.f; pm[r] = incl ? pm[r] : 0.f; pk[r] = incl ? pk[r] : 0.f; }
            *CKP(f32x4, K.lds + CK_ADG + ((bb * 16 + c15) * 16 + 4 * g) * 4) = pa;
            stT1(K, O_BM, bb, bb, pb); stT1(K, nMB, bb, bb, pm); stT1(K, O_MK, bb, bb, pk);
            asm volatile("s_waitcnt lgkmcnt(0)" ::: "memory");
            if (n < 16) { float tcol[16];
                f32x4 arow[16][4];
#pragma unroll
                for (int r = 1; r < 16; ++r)
#pragma unroll
                    for (int s4 = 0; s4 * 4 < r; ++s4) arow[r][s4] = *CKP(const f32x4, K.lds + CK_ADG + ((bb * 16 + r) * 16 + 4 * s4) * 4);
#pragma unroll
                for (int r = 0; r < 16; ++r) { float acc = (r == n) ? 1.f : 0.f;
#pragma unroll
                    for (int s = 0; s < r; ++s) acc = fmaf(-arow[r][s >> 2][s & 3], tcol[s], acc);
                    tcol[r] = acc; *CKP(bf16, K.lds + nTD + ((16 * bb + r) * CK_TD_LD + n) * 2) = bf1(acc); }
            }
        } else {
#pragma unroll
            for (int q = 0; q < 3; ++q) {
                const int xt = (w & 1) ? (q == 0 ? 1 : 0) : (q == 0 ? 0 : q == 1 ? 2 : 1), yt = (w & 1) ? (q == 2 ? 3 : 2) : (q == 0 ? 1 : 3);
                f32x4 pa, pb, pm, pk; ck_tile4(K, xt, yt, nAL, nBE, nRH, pa, pb, pm, pk);
                stT1(K, nAOFF, xt, yt, pa); stT1(K, O_BM, xt, yt, pb); stT1(K, nMB, xt, yt, pm); stT1(K, O_MK, xt, yt, pk);
            }
        }
        __syncthreads();
        if (!skip_o) {
            f32x4 ob = ob0;
            mm1<2, false, false>(ob, K, oSB, oRH, tv, ti); mm1<2, false, false>(ob, K, O_UT, oMB, tv, ti);
            const int row = scan_row(d, b, 64 * c + 16 * ti + c15); v2u oo; oo.x = pk2h(ob[0], ob[1]); oo.y = pk2h(ob[2], ob[3]);
            *(v2u*)(O + (size_t)row * INP + h * 64 + 32 * vh + 16 * tv + 4 * g) = oo;
        }
        { mm1<2, true, false>(st, K, oBE, O_UT, tk, tv2);
          const f32x4 gl = *CKP(const f32x4, K.lds + oGL + (16 * tk + 4 * g) * 4); st = (st + st0) * gl; stT1(K, nSB, tk, tv2, st); }
        yb0 = (f32x4){0.f, 0.f, 0.f, 0.f}; ob0 = yb0; st0 = yb0;
        mm1<2, false, true>(yb0, K, O_BM, O_V, ti, 2 * vh + tv);
        if (!skip_on) mm1<2, true, false>(ob0, K, O_V, O_MK, 2 * vh + tv, ti);
        mm1<2, true, true>(st0, K, O_KP, O_V, tk, 2 * vh + tv2);
        __syncthreads();
    }
#undef CK_FETCH
}
#undef CKP

struct KeyStream { int ctx_row0, nloc, loc_row0, loc_pos0; };
constexpr int AT_KSZ = 9216, AT_VSZ = 9472, AT_KB = 0, AT_VB = 3 * AT_KSZ;
typedef float f32x4a __attribute__((ext_vector_type(4)));

typedef __bf16 bf16v2 __attribute__((ext_vector_type(2)));
__device__ __forceinline__ float dot2_ones(unsigned pair, float acc) { return __builtin_amdgcn_fdot2_f32_bf16(__builtin_bit_cast(bf16v2, pair), __builtin_bit_cast(bf16v2, 0x3f803f80u), acc, false); }
template <int NMAP, int DK, int QS, bool MASK, bool XT>
__device__ __forceinline__ void attn_core(Frame& F, const bf16* P, int kcol, int vcol, const KeyStream ks, const bf16x8 (&qf)[QS][NMAP][DK / 32], int qpos0,
                                          f32x4 (&o)[QS][NMAP][4], float (&m)[QS][NMAP], float (&lsum)[QS][NMAP]) {
    const int c15 = F.lane & 15, g = F.lane >> 4;
    const int lkey = F.tid >> 3, lch = F.tid & 7;
    const int ntiles = 4 + ks.nloc;
#pragma unroll
    for (int qs = 0; qs < QS; ++qs)
#pragma unroll
        for (int mp = 0; mp < NMAP; ++mp) { m[qs][mp] = 0.f; lsum[qs][mp] = 0.f;
#pragma unroll
            for (int dt = 0; dt < 4; ++dt) o[qs][mp][dt] = (f32x4){0.f, 0.f, 0.f, 0.f}; }
    v4u stgk, stgv; const unsigned lofs = (unsigned)(lkey * INP + 8 * lch) * 2u;
#define AT_ROW(ti) ((ti) < 4 ? ks.ctx_row0 + 64 * (ti) : ks.loc_row0 + 64 * ((ti) - 4))
#define AT_LOADK(ti) do { const int t_ = (ti) < ntiles ? (ti) : ntiles - 1; unsigned long long pb_ = (unsigned long long)(uintptr_t)(P + (size_t)AT_ROW(t_) * INP + kcol); asm volatile("" : "+s"(pb_)); stgk = *(const GAS v4u*)(uintptr_t)(pb_ + lofs); } while (0)
#define AT_LOADV(ti) do { const int t_ = (ti) < ntiles ? (ti) : ntiles - 1; unsigned long long pb_ = (unsigned long long)(uintptr_t)(P + (size_t)AT_ROW(t_) * INP + vcol); asm volatile("" : "+s"(pb_)); stgv = *(const GAS v4u*)(uintptr_t)(pb_ + lofs); } while (0)
#define AT_WRITEK(kb_) do { *(LAS v4u*)(F.lds + (kb_) + lkey * 144 + lch * 16) = stgk; } while (0)
#define AT_WRITEV(vb_) do { _Pragma("unroll") for (int i_ = 0; i_ < 8; ++i_) { const unsigned w_ = stgv[i_ >> 1]; \
        *(LAS bf16*)(F.lds + (vb_) + (8 * lch + i_) * 144 + 16 * lch + lkey * 2) = (bf16)((i_ & 1) ? (w_ >> 16) : (w_ & 0xffffu)); } } while (0)
#define AT_QK(dst, kb_, sx_) do { bf16x8 kf_[2][NMAP][DK / 32]; \
        _Pragma("unroll") for (int kh = 0; kh < 2; ++kh) _Pragma("unroll") for (int mp = 0; mp < NMAP; ++mp) _Pragma("unroll") for (int kx = 0; kx < DK / 32; ++kx) \
            kf_[kh][mp][kx] = *(LAS bf16x8*)(F.lds + (kb_) + (32 * (sx_) + 16 * kh + c15) * 144 + (mp * DK + 32 * kx + 8 * g) * 2); \
        _Pragma("unroll") for (int qs = 0; qs < QS; ++qs) _Pragma("unroll") for (int mp = 0; mp < NMAP; ++mp) { const float negm = -m[qs][mp]; \
            _Pragma("unroll") for (int kh = 0; kh < 2; ++kh) { dst[qs][mp][kh] = (f32x4){negm, negm, negm, negm}; \
                _Pragma("unroll") for (int kx = 0; kx < DK / 32; ++kx) dst[qs][mp][kh] = __builtin_amdgcn_mfma_f32_16x16x32_bf16(kf_[kh][mp][kx], qf[qs][mp][kx], dst[qs][mp][kh], 0, 0, 0); } } } while (0)
#define AT_MASK(dst, ti_, sx_) do { if (MASK && (ti_) >= 4) { const int kb_ = ks.loc_pos0 + 64 * ((ti_) - 4) + 32 * (sx_); \
        if (kb_ + 31 - qpos0 > 128 || kb_ - (qpos0 + 16 * QS - 1) < -128) {       \
            _Pragma("unroll") for (int qs = 0; qs < QS; ++qs) { const int qp_ = qpos0 + 16 * qs + c15; \
                _Pragma("unroll") for (int mp = 0; mp < NMAP; ++mp) _Pragma("unroll") for (int kh = 0; kh < 2; ++kh) _Pragma("unroll") for (int r = 0; r < 4; ++r) { \
                    const int dd_ = kb_ + 4 * g + 16 * kh + r - qp_; dst[qs][mp][kh][r] = (dd_ > 128 || dd_ < -128) ? -INFINITY : dst[qs][mp][kh][r]; } } } } } while (0)
    __syncthreads();
    AT_LOADK(0); AT_WRITEK(AT_KB); AT_LOADV(0); AT_WRITEV(AT_VB); AT_LOADK(1); AT_WRITEK(AT_KB + AT_KSZ); AT_LOADV(1);
    __syncthreads();
    f32x4 st[QS][NMAP][2], sn[QS][NMAP][2];
    if (XT) AT_QK(st, AT_KB, 0);
    unsigned kcur = AT_KB, knxt = AT_KB + AT_KSZ, kfar = AT_KB + 2 * AT_KSZ;
    for (int ti = 0; ti < ntiles; ++ti) {
        const unsigned vcur = AT_VB + (ti & 1) * AT_VSZ, vnxt = AT_VB + ((ti + 1) & 1) * AT_VSZ;
        if (!XT) AT_QK(st, kcur, 0);
#pragma unroll
        for (int sx = 0; sx < 2; ++sx) {
        if (sx == 0) AT_QK(sn, kcur, 1); else if (XT) AT_QK(sn, knxt, 0);
        if (sx == 0) AT_LOADK(ti + 2); else AT_LOADV(ti + 2);
        bf16x8 vf[4];
#pragma unroll
        for (int dt = 0; dt < 4; ++dt) { const v2u a = *(LAS v2u*)(F.lds + vcur + (c15 + 16 * dt) * 144 + 16 * (2 * dt + (c15 >> 3)) + (32 * sx + 4 * g) * 2), b2 = *(LAS v2u*)(F.lds + vcur + (c15 + 16 * dt) * 144 + 16 * (2 * dt + (c15 >> 3)) + (32 * sx + 16 + 4 * g) * 2);
            const v4u w = (v4u){a.x, a.y, b2.x, b2.y}; vf[dt] = __builtin_bit_cast(bf16x8, w); }
        v4u pw[QS][NMAP]; float ps[QS][NMAP];
        AT_MASK(st, ti, sx);
        float big = 0.f;
#pragma unroll
        for (int qs = 0; qs < QS; ++qs)
#pragma unroll
            for (int mp = 0; mp < NMAP; ++mp) { float e[8];
#pragma unroll
                for (int kh = 0; kh < 2; ++kh)
#pragma unroll
                    for (int r = 0; r < 4; ++r) e[kh * 4 + r] = __builtin_amdgcn_exp2f(st[qs][mp][kh][r]);
                pw[qs][mp] = (v4u){pk2h(e[0], e[1]), pk2h(e[2], e[3]), pk2h(e[4], e[5]), pk2h(e[6], e[7])};
                const float s_ = dot2_ones(pw[qs][mp].w, dot2_ones(pw[qs][mp].z, dot2_ones(pw[qs][mp].y, dot2_ones(pw[qs][mp].x, 0.f))));
                ps[qs][mp] = s_; big = fmaxf(big, s_); }
        if (__builtin_amdgcn_ballot_w64(!(big < 1048576.0f)) != 0ull) {
            f32x4 sr[QS][NMAP][2];
            AT_QK(sr, kcur, sx); AT_MASK(sr, ti, sx);
#pragma unroll
            for (int qs = 0; qs < QS; ++qs)
#pragma unroll
                for (int mp = 0; mp < NMAP; ++mp) {
                    float mt = fmaxf(fmaxf(fmaxf(sr[qs][mp][0][0], sr[qs][mp][0][1]), fmaxf(sr[qs][mp][0][2], sr[qs][mp][0][3])), fmaxf(fmaxf(sr[qs][mp][1][0], sr[qs][mp][1][1]), fmaxf(sr[qs][mp][1][2], sr[qs][mp][1][3])));
                    mt = xmax4(mt);
                    const float delta = mt > 8.0f ? mt : 0.f, alpha = __builtin_amdgcn_exp2f(-delta);
                    m[qs][mp] += delta; lsum[qs][mp] *= alpha;
#pragma unroll
                    for (int dt = 0; dt < 4; ++dt) o[qs][mp][dt] = o[qs][mp][dt] * alpha;
                    if (sx == 0 || XT) {
#pragma unroll
                        for (int kh = 0; kh < 2; ++kh) sn[qs][mp][kh] = sn[qs][mp][kh] - delta; }
                    float e[8];
#pragma unroll
                    for (int kh = 0; kh < 2; ++kh)
#pragma unroll
                        for (int r = 0; r < 4; ++r) e[kh * 4 + r] = __builtin_amdgcn_exp2f(sr[qs][mp][kh][r] - delta);
                    pw[qs][mp] = (v4u){pk2h(e[0], e[1]), pk2h(e[2], e[3]), pk2h(e[4], e[5]), pk2h(e[6], e[7])};
                    ps[qs][mp] = dot2_ones(pw[qs][mp].w, dot2_ones(pw[qs][mp].z, dot2_ones(pw[qs][mp].y, dot2_ones(pw[qs][mp].x, 0.f))));
                }
        }
#pragma unroll
        for (int qs = 0; qs < QS; ++qs)
#pragma unroll
            for (int mp = 0; mp < NMAP; ++mp) {
                lsum[qs][mp] += ps[qs][mp];
                const bf16x8 pf = __builtin_bit_cast(bf16x8, pw[qs][mp]);
#pragma unroll
                for (int dt = 0; dt < 4; ++dt) o[qs][mp][dt] = __builtin_amdgcn_mfma_f32_16x16x32_bf16(vf[dt], pf, o[qs][mp][dt], 0, 0, 0);
            }
        if (sx == 0 || XT) {
#pragma unroll
            for (int qs = 0; qs < QS; ++qs)
#pragma unroll
                for (int mp = 0; mp < NMAP; ++mp) { st[qs][mp][0] = sn[qs][mp][0]; st[qs][mp][1] = sn[qs][mp][1]; } }
        if (sx == 0) AT_WRITEV(vnxt); else AT_WRITEK(kfar);
        }
        { const unsigned t_ = kcur; kcur = knxt; knxt = kfar; kfar = t_; }
        __syncthreads();
    }
#undef AT_QK
#undef AT_MASK
#undef AT_ROW
#undef AT_LOADK
#undef AT_LOADV
#undef AT_WRITEK
#undef AT_WRITEV
}

template <int QS>
__device__ __forceinline__ void diff_unit(const Args& A, Frame& F, int l, int b, int h, int qrow0, int nloc) {
    const bf16* P = (const bf16*)(kws() + WS_RP); bf16* Y = (bf16*)(kws() + WS_XN); const float* tab = (const float*)(kws() + WS_TAB);
    const int c15 = F.lane & 15, g = F.lane >> 4;
    bf16x8 qf[QS][2][1];
#pragma unroll
    for (int qs = 0; qs < QS; ++qs)
#pragma unroll
        for (int mp = 0; mp < 2; ++mp) qf[qs][mp][0] = *(const bf16x8*)(P + (size_t)(qrow0 + 16 * QS * F.wave + 16 * qs + c15) * INP + C_DFQ + h * 64 + mp * 32 + 8 * g);
    f32x4 o[QS][2][4]; float m[QS][2], ls[QS][2];
    const KeyStream ks{MLAT + b * CTXL, nloc, b * SEQ, 0};
    attn_core<2, 32, QS, false, true>(F, P, C_DFK + h * 64, C_DFV + h * 64, ks, qf, 0, o, m, ls);
    const float lam = tab[3072 + l], oscale = 1.0f - tab[3074 + l];
    const float* ng = kin(I_DFNG) + l * 64;
#pragma unroll
    for (int qs = 0; qs < QS; ++qs) {
        float inv[2];
#pragma unroll
        for (int mp = 0; mp < 2; ++mp) { float t = ls[qs][mp]; t += __shfl_xor(t, 16); t += __shfl_xor(t, 32); inv[mp] = 1.0f / t; }
        f32x4 ov[4]; float ss = 0.f;
#pragma unroll
        for (int dt = 0; dt < 4; ++dt) { ov[dt] = o[qs][0][dt] * inv[0] - o[qs][1][dt] * (lam * inv[1]); ss += (ov[dt][0] * ov[dt][0] + ov[dt][1] * ov[dt][1]) + (ov[dt][2] * ov[dt][2] + ov[dt][3] * ov[dt][3]); }
        ss += __shfl_xor(ss, 16); ss += __shfl_xor(ss, 32);
        const float r = rsqrtf(ss * (1.0f / 64.0f) + NORM_EPS) * oscale;
        bf16* yp = Y + (size_t)(qrow0 + 16 * QS * F.wave + 16 * qs + c15) * D + 256 + h * 64 + 4 * g;
#pragma unroll
        for (int dt = 0; dt < 4; ++dt) { const f32x4 gg = *(const f32x4*)(ng + 16 * dt + 4 * g); const f32x4 v = ov[dt] * r * gg;
            v2u w; w.x = pk2h(v[0], v[1]); w.y = pk2h(v[2], v[3]); *(v2u*)(yp + 16 * dt) = w; }
    }
}
__device__ __forceinline__ void gq_unit(const Args& A, Frame& F, int l, int b, int kv, int qrow0, int qpos_blk  ) {
    const bf16* P = (const bf16*)(kws() + WS_RP); bf16* Y = (bf16*)(kws() + WS_XN);
    const int c15 = F.lane & 15, g = F.lane >> 4;
    const int hq = kv * 4 + (F.wave >> 1), rbase = qrow0 + 64 * (F.wave & 1);
    bf16x8 qf[4][1][2];
#pragma unroll
    for (int qs = 0; qs < 4; ++qs)
#pragma unroll
        for (int kx = 0; kx < 2; ++kx) qf[qs][0][kx] = *(const bf16x8*)(P + (size_t)(rbase + 16 * qs + c15) * INP + C_GQQ + hq * 64 + 32 * kx + 8 * g);
    KeyStream ks{MLAT + b * CTXL, 0, 0, 0}; int qpos0 = 0;
    if (qpos_blk >= 0) { const int lo = qpos_blk > 0 ? (qpos_blk - 1) * 128 : 0, hi = qpos_blk < 31 ? (qpos_blk + 2) * 128 : SEQ;
        ks.nloc = (hi - lo) / 64; ks.loc_row0 = b * SEQ + lo; ks.loc_pos0 = lo; qpos0 = qpos_blk * 128 + 64 * (F.wave & 1); }
    f32x4 o[4][1][4]; float m[4][1], ls[4][1];
    attn_core<1, 64, 4, true, false>(F, P, C_GQK + kv * 64, C_GQV + kv * 64, ks, qf, qpos0, o, m, ls);
    const float sink2 = kin(I_GQSINK)[l * 8 + hq] * LOG2E;
#pragma unroll
    for (int qs = 0; qs < 4; ++qs) {
        float t = ls[qs][0]; t += __shfl_xor(t, 16); t += __shfl_xor(t, 32);
        const float mf = fmaxf(m[qs][0], sink2), e = __builtin_amdgcn_exp2f(m[qs][0] - mf), den = t * e + __builtin_amdgcn_exp2f(sink2 - mf), scl = e / den;
        bf16* yp = Y + (size_t)(rbase + 16 * qs + c15) * D + 512 + hq * 64 + 4 * g;
#pragma unroll
        for (int dt = 0; dt < 4; ++dt) { const f32x4 v = o[qs][0][dt] * scl; v2u w; w.x = pk2h(v[0], v[1]); w.y = pk2h(v[2], v[3]); *(v2u*)(yp + 16 * dt) = w; }
    }
}
__device__ __forceinline__ void phase_queue(const Args& A, Frame& F, int l, int rep) {
    gu32* head = (gu32*)(kws() + WS_CTL) + CW_QUEUE + 64 * l + 16 * rep;
    constexpr int DF_BIG = 256;
    const int total = 64 + DF_BIG + 2 * (256 - DF_BIG) + 256 + (l == 0 ? 48 + WI_FILL : 0);
    volatile LAS int* slot = (volatile LAS int*)(F.lds + MISC_OFF) + 16;
    for (;;) {
        asm volatile("" : "+v"(F.tid), "+v"(F.lane));
        __syncthreads();
        if (F.tid == 0) *slot = (int)__hip_atomic_fetch_add(head, 1u, __ATOMIC_RELAXED, __HIP_MEMORY_SCOPE_AGENT);
        __syncthreads();
        int u = __builtin_amdgcn_readfirstlane(*slot);
        if (u >= total) break;
#if MK_AMP & 1
        if (u < 64) { const unsigned long long t0_ = __builtin_amdgcn_s_memrealtime(); rwkv_chunk_unit(A, F, l, u >> 1, u & 1); const unsigned long long t1_ = __builtin_amdgcn_s_memrealtime();
            while (__builtin_amdgcn_s_memrealtime() - t1_ < t1_ - t0_) __builtin_amdgcn_s_sleep(8); continue; }
#endif
        if (u < 64) { rwkv_chunk_unit(A, F, l, u >> 1, u & 1); continue; }
        u -= 64;
#if MK_AMP & 2
        if (u < DF_BIG) { const unsigned long long t0_ = __builtin_amdgcn_s_memrealtime(); { const int b = u >> 6, h = (u >> 4) & 3, qb = u & 15; diff_unit<2>(A, F, l, b, h, b * SEQ + qb * 256, SEQ / 64); } const unsigned long long t1_ = __builtin_amdgcn_s_memrealtime();
            while (__builtin_amdgcn_s_memrealtime() - t1_ < t1_ - t0_) __builtin_amdgcn_s_sleep(8); continue; }
#endif
        if (u < DF_BIG) { const int b = u >> 6, h = (u >> 4) & 3, qb = u & 15; diff_unit<2>(A, F, l, b, h, b * SEQ + qb * 256, SEQ / 64); continue; }
        if (u < DF_BIG + 2 * (256 - DF_BIG)) { const int v = 2 * DF_BIG + (u - DF_BIG), b = v >> 7, h = (v >> 5) & 3, qh = v & 31; diff_unit<1>(A, F, l, b, h, b * SEQ + qh * 128, SEQ / 64); continue; }
        u -= DF_BIG + 2 * (256 - DF_BIG) - 512;
        u -= 512;
        if (u < 256) { const int b = u >> 6, kv = (u >> 5) & 1, nb = u & 31; gq_unit(A, F, l, b, kv, b * SEQ + nb * 128, nb); continue; }
        u -= 256;
        if (u < 32) { const int b = u >> 3, h = (u >> 1) & 3, hf = u & 1; diff_unit<1>(A, F, l, b, h, MLAT + b * CTXL + hf * 128, 0); continue; }
        u -= 32;
        if (u < 16) { const int b = u >> 2, kv = (u >> 1) & 1, hf = u & 1; gq_unit(A, F, l, b, kv, MLAT + b * CTXL + hf * 128, -1); continue; }
        u -= 16;
        { LAS float* scr = (LAS float*)(F.lds + F.wave * 16384);
          for (int k = 0; k < 16; ++k) { const int it = WI_IN + u * 128 + F.wave * 16 + k; if (it < 2 * WI_LAYER) weight_item(it, scr, F.lane); } }
    }
}

constexpr int N_PHASES = (MK_FUSE == 3) ? 18 : 20;
}

__global__ void __launch_bounds__(mk::NTHR, 2) mega_fwd(mk::Args A) {
    using namespace mk;
    extern __shared__ __attribute__((aligned(16))) unsigned char lds_raw[];
    Frame F;
    F.lds = (LAS unsigned char*)lds_raw;
    F.tid = threadIdx.x; asm volatile("" : "+v"(F.tid)); F.lane = F.tid & 63; F.wave = __builtin_amdgcn_readfirstlane(F.tid >> 6);
    F.G = gridDim.x; F.bid = blockIdx.x;
    for (int u = F.tid; u < (LDS_BYTES - LDSCTL_OFF) / 4; u += NTHR) ((LAS unsigned*)(F.lds + LDSCTL_OFF))[u] = 0u;
    __syncthreads();
    gu32* ctl = (gu32*)(kws() + WS_CTL);
    XcdBarrier bar; bar.bar = (unsigned*)(ctl + CW_BAR); bar.x = 0; bar.st = nullptr; bar.tid = F.tid;
    const bool multi = (A.ph_hi - A.ph_lo) > 1;
    if (multi) bar = xcd_barrier_post((unsigned*)(ctl + CW_BAR), (volatile LAS unsigned*)(F.lds + MISC_OFF) + 8, F.tid);

    for (int ph = A.ph_lo, rep = 0; ph < A.ph_hi;) {
        { int t_ = F.tid, l_ = F.lane, w_ = F.wave, g_ = F.G, b_ = F.bid; unsigned p_ = (unsigned)(uintptr_t)F.lds;
          w_ = __builtin_amdgcn_readfirstlane(w_); g_ = __builtin_amdgcn_readfirstlane(g_); b_ = __builtin_amdgcn_readfirstlane(b_); p_ = __builtin_amdgcn_readfirstlane(p_);
          asm volatile("" : "+v"(t_), "+v"(l_)); asm volatile("" : "+s"(w_), "+s"(g_), "+s"(b_), "+s"(p_));
          F.tid = t_; F.lane = l_; F.wave = w_; F.G = g_; F.bid = b_; F.lds = (LAS unsigned char*)(uintptr_t)p_; }
        int kind = 0, l = 0, hf = 0;
        if (ph == 1) kind = 1;
        else if (ph > 1 && ph < 11) { l = 0; const int r = ph - 2; kind = r < 6 ? 2 + r : (r == 6 ? 8 : (r == 7 ? 10 : 11)); }
        else if (ph >= 11) { l = 1; const int r = ph - 11; kind = r < 5 ? 2 + r : (r == 5 ? 8 : 10); }
        const int nrows = (l == 0) ? MALL : MLAT;
        const int r0 = 0, r1 = nrows; (void)hf;
        const bool is_gemm = (kind == 2 || kind == 6 || kind == 8 || kind == 10);
        if (is_gemm) { if (MK_KINDS & 0x544) {
          const int nparts = ((kind == 6 || kind == 10) && l == 0) ? 2 : 1;
          for (int part = 0; part < nparts; ++part) {
            pg8::Gemm g; EpiMulti E; E.tab = (const float*)(kws() + WS_TAB); E.ob = nullptr; E.of = nullptr; E.ld = 0; E.mode = 0; E.cw = nullptr; E.cb = nullptr; E.nrows = 0; E.ldsx = 0u; E.xin = nullptr; E.xout = nullptr; E.xn = nullptr; E.gA = E.gaA = E.gB = E.scB = E.shB = nullptr; E.xb0 = E.xb1 = nullptr; E.cnt0 = E.cnt1 = nullptr; E.two = 0;
            if (kind == 2) { g = pg8::Gemm{(const pg8::bf16_t*)(kws() + WS_XN), (const pg8::bf16_t*)(kws() + WS_WIN + l * WIN_BYTES), MALL, INP, D, 256, D, 0}; E.mode = 0; E.ob = (bf16*)(kws() + WS_RP); E.ld = INP; }
            else if (kind == 6 && part == 0 && !(MK_FUSE & 1)) { g = pg8::Gemm{(const pg8::bf16_t*)(kws() + WS_XN), (const pg8::bf16_t*)(kws() + WS_WOUT + l * WOUT_BYTES), MLAT, D, D, 256, D, 0}; E.mode = 2; E.ob = (bf16*)(kws() + WS_RP); E.ld = D; }
            else if (kind == 6 && part == 0) { g = pg8::Gemm{(const pg8::bf16_t*)(kws() + WS_XN), (const pg8::bf16_t*)(kws() + WS_WOUT + l * WOUT_BYTES), MLAT, D, D, 256, D, 0};
                E.mode = 5; E.xin = l == 0 ? kin(I_X) : kout(); E.xout = kout(); E.xn = (bf16*)(kws() + WS_XN); E.gA = normg_vec(A, l, 1); E.gaA = mod_vec(A, l, 0, 2); E.two = 1; E.gB = normg_vec(A, l, 2); E.scB = mod_vec(A, l, 0, 4); E.shB = mod_vec(A, l, 0, 3);
                E.xb0 = (float*)(kws() + WS_XB) + (size_t)((l * 2 + 0) * 2 + 0) * MLAT * 4; E.xb1 = (float*)(kws() + WS_XB) + (size_t)((l * 2 + 0) * 2 + 1) * MLAT * 4;
                E.cnt0 = (gu32*)(kws() + WS_CTL) + CW_PST + ((l * 2 + 0) * 2 + 0) * 4096; E.cnt1 = (gu32*)(kws() + WS_CTL) + CW_PST + ((l * 2 + 0) * 2 + 1) * 4096; }
            else if (kind == 6) { g = pg8::Gemm{(const pg8::bf16_t*)(kws() + WS_XN) + (size_t)MLAT * D, (const pg8::bf16_t*)(kws() + WS_WOUT + l * WOUT_BYTES), 256 * 4 * 4, D, 256, 256, D, 4}; E.mode = 2; E.ob = (bf16*)(kws() + WS_SLO); E.ld = D; }
            else if (kind == 8) { const int nmu = (nrows + 253) / 254;
                g = pg8::Gemm{(const pg8::bf16_t*)(kws() + WS_XN) - D, (const pg8::bf16_t*)(kws() + WS_WGU + l * WGU_BYTES), 256 * nmu, NGU, D, 254, D, 0};
                E.mode = 3; E.ob = (bf16*)(kws() + WS_ACT); E.ld = DFF; E.cw = kin(I_FFCW) + (size_t)l * 3 * DFF; E.cb = kin(I_FFCB) + (size_t)l * DFF; E.nrows = nrows; E.ldsx = (unsigned)(uintptr_t)F.lds + 131072u; }
            else if (part == 0 && !(MK_FUSE & 2)) { g = pg8::Gemm{(const pg8::bf16_t*)(kws() + WS_ACT), (const pg8::bf16_t*)(kws() + WS_WD + l * WD_BYTES), MLAT, D, DFF, 256, DFF, 0}; E.mode = 2; E.ob = (bf16*)(kws() + WS_FP); E.ld = D; }
            else if (part == 0) { g = pg8::Gemm{(const pg8::bf16_t*)(kws() + WS_ACT), (const pg8::bf16_t*)(kws() + WS_WD + l * WD_BYTES), MLAT, D, DFF, 256, DFF, 0};
                E.mode = 6; E.xin = kout(); E.xout = kout(); E.xn = (bf16*)(kws() + WS_XN); E.gA = normg_vec(A, l, 3); E.gaA = mod_vec(A, l, 0, 5); E.two = l == 0; E.gB = normg_vec(A, 1, 0); E.scB = mod_vec(A, 1, 0, 1); E.shB = mod_vec(A, 1, 0, 0);
                E.xb0 = (float*)(kws() + WS_XB) + (size_t)((l * 2 + 1) * 2 + 0) * MLAT * 4; E.xb1 = (float*)(kws() + WS_XB) + (size_t)((l * 2 + 1) * 2 + 1) * MLAT * 4;
                E.cnt0 = (gu32*)(kws() + WS_CTL) + CW_PST + ((l * 2 + 1) * 2 + 0) * 4096; E.cnt1 = (gu32*)(kws() + WS_CTL) + CW_PST + ((l * 2 + 1) * 2 + 1) * 4096; }
            else { g = pg8::Gemm{(const pg8::bf16_t*)(kws() + WS_ACT) + (size_t)MLAT * DFF, (const pg8::bf16_t*)(kws() + WS_WD + l * WD_BYTES), 256 * 4 * 11, D, 256, 256, DFF, 4}; E.mode = 2; E.ob = (bf16*)(kws() + WS_SLD); E.ld = D; }
            pg8::StaticOrder S; S.init(g.M, g.N, F.G, F.bid);
            pg8::gemm_phase<EpiMulti, pg8::StaticOrder, true, true>(F.lds, g, S, E, F.tid);
          }
        } } else {
            switch (kind) {
                case 0: if ((MK_KINDS >> 0) & 1) { p0_prologue(A, F); } break;
                case 1: if (((MK_KINDS >> 1) & 1) && l == 0) phase_prep(A, F); break;
                case 3: if ((MK_KINDS >> 3) & 1) rwkv_features(A, F, l); break;
                case 4: if ((MK_KINDS >> 4) & 1) phase_queue(A, F, l, rep); break;
                case 5: if ((MK_KINDS >> 5) & 1) rwkv_readout(A, F, l); break;
                case 7: if ((MK_KINDS >> 7) & 1) phase_e1(A, F, l); break;
                case 9: if ((MK_KINDS >> 9) & 1) phase_act(A, F, l, r0, r1); break;
                case 11: if ((MK_KINDS >> 11) & 1) phase_e2(A, F, l, r0, r1); break;
                default: break;
            }
        }
        const bool again = (rep == 0) && ((MK_REPEAT >> kind) & 1);
        if (ph + 1 < A.ph_hi || again) { bar.bar = (unsigned*)((gu32*)(kws() + WS_CTL) + CW_BAR); bar.tid = F.tid; xcd_barrier(bar); }
        if (again) rep = 1; else { rep = 0; ++ph; }
    }
}

extern "C" void kernel_launch(void* const* d_in, const int* in_sizes, int n_in, void* d_out, int out_size, void* d_ws, size_t ws_size, hipStream_t stream) {
    using namespace mk;
    static int grid = 0;
    if (grid == 0) {
        if (n_in != N_IN || out_size != MLAT * D || ws_size < WS_END) { fprintf(stderr, "kernel_launch: unexpected shapes (n_in %d, out %d, ws %zu); nothing launched\n", n_in, out_size, ws_size); grid = -1; return; }
        int dev = 0, cus = 0, per_cu = 0;
        if (hipGetDevice(&dev) != hipSuccess || hipDeviceGetAttribute(&cus, hipDeviceAttributeMultiprocessorCount, dev) != hipSuccess) { grid = -1; return; }
        if (hipFuncSetAttribute((const void*)mega_fwd, hipFuncAttributeMaxDynamicSharedMemorySize, LDS_BYTES) != hipSuccess) { fprintf(stderr, "kernel_launch: hipFuncSetAttribute failed\n"); grid = -1; return; }
        if (hipOccupancyMaxActiveBlocksPerMultiprocessor(&per_cu, (const void*)mega_fwd, NTHR, LDS_BYTES) != hipSuccess || per_cu < 1) { fprintf(stderr, "kernel_launch: occupancy query says %d blocks/CU\n", per_cu); per_cu = 1; }
        (void)hipGetLastError();
        grid = cus;
    }
    if (grid < 0) return;
    (void)hipMemsetAsync((char*)d_ws + WS_CTL, 0, CTL_ZERO_BYTES, stream);
    Args a{};
    for (int i = 0; i < N_IN; ++i) a.in[i] = (const float*)d_in[i];
    a.out = (float*)d_out; a.ws = (unsigned char*)d_ws;
#if MK_PER_PHASE
    for (int ph = 0; ph < N_PHASES; ++ph) { a.ph_lo = ph; a.ph_hi = ph + 1; hipLaunchKernelGGL(mega_fwd, dim3(grid), dim3(NTHR), LDS_BYTES, stream, a); }
#else
    a.ph_lo = 0; a.ph_hi = N_PHASES;
    void* args[] = {&a};
    hipError_t e = hipLaunchCooperativeKernel((const void*)mega_fwd, dim3(grid), dim3(NTHR), args, LDS_BYTES, stream);
    if (e != hipSuccess) fprintf(stderr, "kernel_launch: cooperative launch failed: %s (grid %d)\n", hipGetErrorString(e), grid);
#endif
}
```

```cpp
#include <hip/hip_runtime.h>
#include <hip/hip_cooperative_groups.h>
#include <cstdio>
#include <cstdint>
#ifndef MK_PER_PHASE
#define MK_PER_PHASE 0
#endif
#ifndef MK_KINDS
#define MK_KINDS 0xFFF
#endif
#ifndef MK_REPEAT
#define MK_REPEAT 0
#endif
#ifndef MK_RWDUP
#define MK_RWDUP 0
#endif
#ifndef MK_AMP
#define MK_AMP 0
#endif
#ifndef MK_FUSE
#define MK_FUSE 3
#endif
#ifdef MK_DBGDRAIN
#define MK_DBGD 1
#else
#define MK_DBGD 0
#endif
namespace pg8 {
#define PG8_LAS __attribute__((address_space(3)))
typedef unsigned short bf16_t;
typedef short bf16x8 __attribute__((ext_vector_type(8)));
typedef float f32x4 __attribute__((ext_vector_type(4)));
typedef unsigned u32x4 __attribute__((ext_vector_type(4)));
constexpr int BM = 256, BK = 64, HALF = 128, HTB = HALF * BK * 2  , STAGE_BYTES = 8 * HTB, NXCD = 8, WGM = 8;

__host__ __device__ __forceinline__ int lds_byte(int r, int c) { const int st = (r >> 4) * 2 + (c >> 5), rr = r & 15, cc = c & 31, ob = rr * 64 + cc * 2; return st * 1024 + (ob ^ (((ob >> 9) & 1) << 5)); }
__host__ __device__ __forceinline__ void stage_rc(int b, int& R, int& C) { const int st = b / 1024, sb = b % 1024, swz = sb ^ (((sb >> 9) & 1) << 5); R = (st >> 1) * 16 + swz / 64; C = (st & 1) * 32 + (swz % 64) / 2; }
__host__ __device__ __forceinline__ int perm32(int rho) { const int n = rho >> 4, i = rho & 15; return 8 * (i >> 2) + 4 * n + (i & 3); }

__device__ __forceinline__ float pg8_zero() { float z = 0.f; asm volatile("" : "+v"(z)); return z; }
struct Unit { int pm, pn; };
struct Gemm { const bf16_t* A; const bf16_t* Bt; int M, N, K; int trows; int ld, mt; };

struct StaticOrder {
    int nM, nN, nwg, G, c;
    __host__ __device__ void init(int M, int N, int G_, int c_) { nM = M / BM; nN = N / BM; nwg = nM * nN; G = G_; c = c_; }
    __host__ __device__ bool next(int i, Unit& u) const {
        const long L = (long)i * G + c; if (L >= nwg) return false;
        int wgid = (int)L; { const int q = nwg / NXCD, r = nwg % NXCD, xcd = wgid % NXCD, off = wgid / NXCD; wgid = (xcd < r ? xcd * (q + 1) : r * (q + 1) + (xcd - r) * q) + off; }
        const int nig = WGM * nN, gid = wgid / nig, fm = gid * WGM, gsz = (nM - fm) < WGM ? (nM - fm) : WGM;
        u.pm = fm + ((wgid % nig) % gsz); u.pn = (wgid % nig) / gsz; return true;
    }
    __device__ __forceinline__ void a_ready(const Unit&) const {}
    __device__ __forceinline__ void done(const Unit&) const {}
};

__device__ __forceinline__ unsigned cvt_pk_bf16(float lo, float hi) { unsigned r; asm volatile("v_cvt_pk_bf16_f32 %0, %1, %2" : "=v"(r) : "v"(lo), "v"(hi)); return r; }
typedef float f32x2 __attribute__((ext_vector_type(2)));
__device__ __forceinline__ f32x2 gelu_pk(f32x2 v) {
    const f32x2 av = __builtin_elementwise_abs(v), d = av * 0.2316418882f + 1.0f;
    f32x2 t; t.x = __builtin_amdgcn_rcpf(d.x); t.y = __builtin_amdgcn_rcpf(d.y);
    f32x2 q = t * 0.5307027145f + (-0.7265760135f); q = q * t + 0.7107068705f; q = q * t + (-0.142248368f); q = q * t + 0.127414796f; q = q * t;
    const f32x2 s = (v * v) * (-0.72134752044f);
    f32x2 e; e.x = __builtin_amdgcn_exp2f(s.x); e.y = __builtin_amdgcn_exp2f(s.y);
    const f32x2 m = v * (q * e), r = v - m;
    f32x2 o; o.x = v.x < 0.f ? m.x : r.x; o.y = v.y < 0.f ? m.y : r.y; return o;
}

template <int ACT  > struct EpiBf16 {
    static constexpr bool PERM = true, AFTER_DRAIN = false; static_assert(ACT == 0 || ACT == 1, "EpiBf16: ACT is 0 (none) or 1 (gelu_pk)");
    bf16_t* O; int ldc; const float* bias; int split_cols; size_t split_stride; float scale0;
    __device__ __forceinline__ void operator()(const f32x4 (&acc)[2][2][4][2], const Unit& u, int wr, int wc, int fr, int fq) const {
        const int row0 = u.pm * BM + wr * 64 + fr; int colt = u.pn * BM; bf16_t* base = O;
        float sc = 1.f; if (split_cols) { const int t = colt / split_cols; base += (size_t)t * split_stride; colt -= t * split_cols; if (t == 0) sc = scale0; }
        const int col0 = colt + wc * 32 + 8 * fq, bcol0 = u.pn * BM + wc * 32 + 8 * fq;
        f32x4 bv[2][2];
#pragma unroll
        for (int bj = 0; bj < 2; ++bj)
#pragma unroll
            for (int n = 0; n < 2; ++n) bv[bj][n] = bias ? *(const f32x4*)(bias + bcol0 + bj * HALF + 4 * n) : (f32x4){0.f, 0.f, 0.f, 0.f};
#pragma unroll
        for (int ai = 0; ai < 2; ++ai)
#pragma unroll
            for (int m = 0; m < 4; ++m) { bf16_t* rowp = base + (size_t)(row0 + ai * HALF + m * 16) * ldc + col0;
#pragma unroll
                for (int bj = 0; bj < 2; ++bj) { f32x4 v0 = acc[ai][bj][m][0] + bv[bj][0], v1 = acc[ai][bj][m][1] + bv[bj][1];
                    if (ACT == 1) { f32x2 a = gelu_pk((f32x2){v0[0], v0[1]}), b = gelu_pk((f32x2){v0[2], v0[3]}), c = gelu_pk((f32x2){v1[0], v1[1]}), d = gelu_pk((f32x2){v1[2], v1[3]});
                        v0 = (f32x4){a.x, a.y, b.x, b.y}; v1 = (f32x4){c.x, c.y, d.x, d.y}; }
                    v0 = v0 * sc; v1 = v1 * sc; u32x4 w; w.x = cvt_pk_bf16(v0[0], v0[1]); w.y = cvt_pk_bf16(v0[2], v0[3]); w.z = cvt_pk_bf16(v1[0], v1[1]); w.w = cvt_pk_bf16(v1[2], v1[3]);
                    *(u32x4*)(rowp + bj * HALF) = w; } }
    }
};

template <class Epi, class Sched, bool ALIGN_EPI = false, bool SP2 = false>
__device__ __forceinline__ void gemm_phase(PG8_LAS unsigned char* lds, const Gemm g, const Sched& S, const Epi& E, int tid_in) {
    int tid_ = tid_in; asm volatile("" : "+v"(tid_));
    const int tid = tid_, wid = __builtin_amdgcn_readfirstlane(tid >> 6), lane = tid & 63, wr = wid >> 2, wc = wid & 3, fr = lane & 15, fq = lane >> 4;
    const int K = g.ld, nt = g.K / BK;
    unsigned voffA[2], voffB[2];
#pragma unroll
    for (int i = 0; i < 2; ++i) { int R, C; stage_rc(tid * 16 + i * 8192, R, C); const int Rb = Epi::PERM ? ((R & ~31) + perm32(R & 31)) : R;
        voffA[i] = (unsigned)(R * K + C) * 2u; voffB[i] = (unsigned)(Rb * K + C) * 2u; }
    const size_t kstep = (size_t)(BK * 2);
    const size_t hstep = (size_t)HALF * K * 2;
    const size_t tstep = 2 * hstep;
    const size_t tstepA = (size_t)g.trows * K * 2;
    const unsigned ldsw = (unsigned)wid * 1024u;
    const int aoff = lds_byte(wr * 64 + fr, fq * 8), boff = lds_byte(wc * 32 + fr, fq * 8);
#define PG8_SA(b, h) (((b) * 2 + (h)) * HTB)
#define PG8_SB(b, h) ((4 + (b) * 2 + (h)) * HTB)
#define PG8_STAGE(bufoff, gbase, voff) do { _Pragma("unroll") for (int _i = 0; _i < 2; ++_i) \
        __builtin_amdgcn_global_load_lds((const unsigned*)((const char*)(gbase) + (voff)[_i]), (PG8_LAS unsigned*)(lds + (bufoff) + ldsw + _i * 8192), 16, 0, 0); } while (0)
#define PG8_LDA(dst, b, h) do { _Pragma("unroll") for (int m = 0; m < 4; ++m) _Pragma("unroll") for (int k = 0; k < 2; ++k) dst[m][k] = *(const PG8_LAS bf16x8*)(lds + PG8_SA(b, h) + aoff + m * 2048 + k * 1024); } while (0)
#define PG8_LDB(dst, b, h) do { _Pragma("unroll") for (int n = 0; n < 2; ++n) _Pragma("unroll") for (int k = 0; k < 2; ++k) dst[n][k] = *(const PG8_LAS bf16x8*)(lds + PG8_SB(b, h) + boff + n * 2048 + k * 1024); } while (0)
#define PG8_MMA(ai, bj, At, Bt) do { __builtin_amdgcn_s_setprio(1); _Pragma("unroll") for (int m = 0; m < 4; ++m) _Pragma("unroll") for (int n = 0; n < 2; ++n) _Pragma("unroll") for (int k = 0; k < 2; ++k) \
        acc[ai][bj][m][n] = __builtin_amdgcn_mfma_f32_16x16x32_bf16(Bt[n][k], At[m][k], acc[ai][bj][m][n], 0, 0, 0); __builtin_amdgcn_s_setprio(0); } while (0)
#define PG8_WAIT_V(n) asm volatile("s_waitcnt vmcnt(" #n ")" ::: "memory")
#define PG8_WAIT_L(n) asm volatile("s_waitcnt lgkmcnt(" #n ")" ::: "memory")
#define PG8_BAR __builtin_amdgcn_s_barrier()
#define PG8_SCHED __builtin_amdgcn_sched_barrier(0)
    Unit cur, nxt; int ui = 0;
    if (!S.next(0, cur)) return;
    f32x4 acc[2][2][4][2];
#pragma unroll
    for (int a = 0; a < 2; ++a)
#pragma unroll
        for (int b = 0; b < 2; ++b)
#pragma unroll
            for (int m = 0; m < 4; ++m)
#pragma unroll
                for (int n = 0; n < 2; ++n) acc[a][b][m][n] = (f32x4){pg8_zero(), pg8_zero(), pg8_zero(), pg8_zero()};
    bf16x8 At[4][2], B0[2][2], B1[2][2];
#define PG8_BASEA(un) ((const char*)g.A + (size_t)(g.mt ? (un).pm % g.mt : (un).pm) * tstepA + (g.mt ? (size_t)((un).pm / g.mt) * g.K * 2 : 0))
#define PG8_BASEB(un) ((const char*)g.Bt + (size_t)(un).pn * tstep + (g.mt ? (size_t)((un).pm / g.mt) * g.K * 2 : 0))
    const char* cA = PG8_BASEA(cur); const char* cB = PG8_BASEB(cur);
    S.a_ready(cur);
    if constexpr (SP2) {
        PG8_STAGE(PG8_SB(0, 0), cB, voffB); PG8_STAGE(PG8_SB(0, 1), cB + hstep, voffB); PG8_STAGE(PG8_SA(0, 0), cA, voffA); PG8_STAGE(PG8_SA(0, 1), cA + hstep, voffA);
        if (wr == 1) PG8_BAR;
        PG8_WAIT_V(2); PG8_BAR;
        PG8_STAGE(PG8_SB(1, 0), cB + kstep, voffB); PG8_STAGE(PG8_SA(1, 0), cA + kstep, voffA); PG8_STAGE(PG8_SB(1, 1), cB + hstep + kstep, voffB);
        PG8_WAIT_V(6); PG8_BAR;
    } else {
        PG8_STAGE(PG8_SB(0, 0), cB, voffB); PG8_STAGE(PG8_SA(0, 0), cA, voffA); PG8_STAGE(PG8_SB(0, 1), cB + hstep, voffB); PG8_STAGE(PG8_SA(0, 1), cA + hstep, voffA);
        if (wr == 1) PG8_BAR;
        PG8_WAIT_V(4); PG8_BAR;
        PG8_STAGE(PG8_SB(1, 0), cB + kstep, voffB); PG8_STAGE(PG8_SA(1, 0), cA + kstep, voffA); PG8_STAGE(PG8_SB(1, 1), cB + hstep + kstep, voffB);
        PG8_WAIT_V(6); PG8_BAR;
    }
    for (;;) {
        const bool has_next = S.next(ui + 1, nxt);
        const char* nA = has_next ? PG8_BASEA(nxt) : cA; const char* nB = has_next ? PG8_BASEB(nxt) : cB;
        for (int t = 0; t < nt; t += 2) {
            const bool last = (t == nt - 2);
            const char* a1 = cA + (size_t)(t + 1) * kstep;
            const char* a2 = last ? nA : cA + (size_t)(t + 2) * kstep; const char* b2 = last ? nB : cB + (size_t)(t + 2) * kstep;
            const char* a3 = a2 + kstep; const char* b3 = b2 + kstep;
            if (last && has_next) S.a_ready(nxt);
            if constexpr (SP2) {
            PG8_LDB(B0, 0, 0); PG8_LDB(B1, 0, 1); PG8_SCHED; PG8_LDA(At, 0, 0); PG8_STAGE(PG8_SA(1, 1), a1 + hstep, voffA);
            PG8_WAIT_V(8); PG8_WAIT_L(0); PG8_BAR; PG8_MMA(0, 0, At, B0); PG8_MMA(0, 1, At, B1); PG8_BAR; PG8_SCHED;
            PG8_LDA(At, 0, 1); PG8_STAGE(PG8_SB(0, 0), b2, voffB); PG8_STAGE(PG8_SB(0, 1), b2 + hstep, voffB); PG8_STAGE(PG8_SA(0, 0), a2, voffA);
            PG8_WAIT_V(8); PG8_WAIT_L(0); PG8_BAR; PG8_MMA(1, 0, At, B0); PG8_MMA(1, 1, At, B1); PG8_BAR; PG8_SCHED;
            PG8_LDB(B0, 1, 0); PG8_LDB(B1, 1, 1); PG8_SCHED; PG8_LDA(At, 1, 0); PG8_STAGE(PG8_SA(0, 1), a2 + hstep, voffA);
            PG8_WAIT_V(8); PG8_WAIT_L(0); PG8_BAR; PG8_MMA(0, 0, At, B0); PG8_MMA(0, 1, At, B1); PG8_BAR; PG8_SCHED;
            PG8_LDA(At, 1, 1); PG8_STAGE(PG8_SB(1, 0), b3, voffB); PG8_STAGE(PG8_SB(1, 1), b3 + hstep, voffB); PG8_STAGE(PG8_SA(1, 0), a3, voffA);
            PG8_WAIT_V(8); PG8_WAIT_L(0); PG8_BAR; PG8_MMA(1, 0, At, B0); PG8_MMA(1, 1, At, B1); PG8_BAR; PG8_SCHED;
            } else {
            PG8_LDB(B0, 0, 0); PG8_SCHED; PG8_LDA(At, 0, 0); PG8_STAGE(PG8_SA(1, 1), a1 + hstep, voffA);
            PG8_WAIT_L(8); PG8_BAR; PG8_WAIT_L(0); PG8_MMA(0, 0, At, B0); PG8_BAR; PG8_SCHED;
            PG8_LDB(B1, 0, 1); PG8_STAGE(PG8_SB(0, 0), b2, voffB);
            PG8_BAR; PG8_WAIT_L(0); PG8_MMA(0, 1, At, B1); PG8_BAR;
            PG8_LDA(At, 0, 1); PG8_STAGE(PG8_SA(0, 0), a2, voffA);
            PG8_BAR; PG8_WAIT_L(0); PG8_MMA(1, 0, At, B0); PG8_BAR; PG8_SCHED;
            PG8_STAGE(PG8_SB(0, 1), b2 + hstep, voffB);
            PG8_WAIT_V(6); PG8_BAR; PG8_MMA(1, 1, At, B1); PG8_BAR;
            PG8_LDB(B0, 1, 0); PG8_SCHED; PG8_LDA(At, 1, 0); PG8_STAGE(PG8_SA(0, 1), a2 + hstep, voffA);
            PG8_WAIT_L(8); PG8_BAR; PG8_WAIT_L(0); PG8_MMA(0, 0, At, B0); PG8_BAR; PG8_SCHED;
            PG8_LDB(B1, 1, 1); PG8_STAGE(PG8_SB(1, 0), b3, voffB);
            PG8_BAR; PG8_WAIT_L(0); PG8_MMA(0, 1, At, B1); PG8_BAR;
            PG8_LDA(At, 1, 1); PG8_STAGE(PG8_SA(1, 0), a3, voffA);
            PG8_BAR; PG8_WAIT_L(0); PG8_MMA(1, 0, At, B0); PG8_BAR; PG8_SCHED;
            PG8_STAGE(PG8_SB(1, 1), b3 + hstep, voffB);
            PG8_WAIT_V(6); PG8_BAR; PG8_MMA(1, 1, At, B1); PG8_BAR;
            }
        }
        if constexpr (ALIGN_EPI) { if (wr == 0) PG8_BAR; }
        if (!E.drain()) { E(acc, cur, wr, wc, fr, fq); S.done(cur); }
        if (!has_next) break;
#pragma unroll
        for (int a = 0; a < 2; ++a)
#pragma unroll
            for (int b = 0; b < 2; ++b)
#pragma unroll
                for (int m = 0; m < 4; ++m)
#pragma unroll
                    for (int n = 0; n < 2; ++n) acc[a][b][m][n] = (f32x4){pg8_zero(), pg8_zero(), pg8_zero(), pg8_zero()};
        cur = nxt; cA = nA; cB = nB; ++ui;
        if constexpr (ALIGN_EPI) { if (wr == 1) PG8_BAR; }
    }
    PG8_WAIT_V(0);
    if constexpr (!ALIGN_EPI) { if (wr == 0) PG8_BAR; }
    PG8_BAR;
    if (E.drain()) { E.fused(acc, cur, wr, wc, fr, fq, lds, wid, lane); S.done(cur); }
#undef PG8_BASEA
#undef PG8_BASEB
#undef PG8_SA
#undef PG8_SB
#undef PG8_STAGE
#undef PG8_LDA
#undef PG8_LDB
#undef PG8_MMA
#undef PG8_WAIT_V
#undef PG8_WAIT_L
#undef PG8_BAR
#undef PG8_SCHED
}
}
#define GAS __attribute__((address_space(1)))
#define LAS __attribute__((address_space(3)))
typedef unsigned short bf16;
typedef unsigned v4u __attribute__((ext_vector_type(4)));
typedef float f32x4 __attribute__((ext_vector_type(4)));
typedef short bf16x8 __attribute__((ext_vector_type(8)));
typedef GAS unsigned gu32;
typedef GAS unsigned long long gu64;
#define RLX_AGENT __ATOMIC_RELAXED, __HIP_MEMORY_SCOPE_AGENT
#define LDS_WAIT() asm volatile("s_waitcnt lgkmcnt(0)" ::: "memory")
#define VM_WAIT() asm volatile("s_waitcnt vmcnt(0)" ::: "memory")
__device__ __forceinline__ unsigned long long rt() { return __builtin_amdgcn_s_memrealtime(); }
__device__ __forceinline__ unsigned f2bf(float f) { unsigned u = __builtin_bit_cast(unsigned, f); return (u + 0x7fffu + ((u >> 16) & 1u)) >> 16; }
__device__ __forceinline__ unsigned pk2(float lo, float hi) { return f2bf(lo) | (f2bf(hi) << 16); }
#define XB_TMO      128
#define XB_XCNT(j)  (256  + 64 * (j))
#define XB_XSUB(j)  (1280 + 64 * (j))
#define XB_XGEN(j)  (2304 + 64 * (j))
#define XB_TOP      3328
#define XB_TOPGEN   3392
#define XCD_BAR_WORDS 3456
#define XB_SPIN_CAP (1u << 18)

__device__ __forceinline__ unsigned xb_ld(unsigned* p)              { return __hip_atomic_load(p, __ATOMIC_RELAXED, __HIP_MEMORY_SCOPE_AGENT); }
__device__ __forceinline__ unsigned xb_add(unsigned* p, unsigned v) { return __hip_atomic_fetch_add(p, v, __ATOMIC_RELAXED, __HIP_MEMORY_SCOPE_AGENT); }
__device__ __forceinline__ unsigned xb_xcc_id() { return (unsigned)__builtin_amdgcn_s_getreg((3 << 11) | 20) & 0xFu; }
#define XB_SPIN(cond, bar) do { unsigned _sp = 0; while (cond) { __builtin_amdgcn_s_sleep(1); \
    if ((++_sp & 255u) == 0u) { if (xb_ld(&(bar)[XB_TMO])) break; if (_sp > XB_SPIN_CAP) { atomicAdd(&(bar)[XB_TMO], 1u); break; } } } } while (0)

struct XcdBarrier {
    int tid; unsigned* bar; unsigned x;
    volatile LAS unsigned* st;
};

__device__ __forceinline__ XcdBarrier xcd_barrier_post(unsigned* bar, volatile LAS unsigned* st, int tid) {
    XcdBarrier b; b.bar = bar; b.x = xb_xcc_id(); b.st = st; b.tid = tid;
    if (tid == 0) (void)xb_add(&bar[XB_XCNT(b.x)], 1u);
    return b;
}
__device__ __forceinline__ void xcd_barrier_complete(unsigned* bar, unsigned x, unsigned& nloc, unsigned& nx) {
    const unsigned G = gridDim.x * gridDim.y * gridDim.z;
    unsigned sum, cnt, mine, sp = 0u;
    for (;;) {
        sum = 0u; cnt = 0u; mine = 0u;
#pragma unroll
        for (unsigned j = 0; j < 16; ++j) { const unsigned c = xb_ld(&bar[XB_XCNT(j)]); sum += c; cnt += (c > 0u) ? 1u : 0u; mine = (j == x) ? c : mine; }
        if (sum == G) break;
        __builtin_amdgcn_s_sleep(1);
        if ((++sp & 255u) == 0u) { if (xb_ld(&bar[XB_TMO])) break; if (sp > XB_SPIN_CAP) { atomicAdd(&bar[XB_TMO], 1u); break; } }
    }
    nloc = mine > 0u ? mine : 1u; nx = cnt > 0u ? cnt : 1u;
}

__device__ __forceinline__ void xcd_barrier(const XcdBarrier& b) {
    asm volatile("s_waitcnt vmcnt(0)" ::: "memory");
    __syncthreads();
    if (b.tid == 0) {
        unsigned* bar = b.bar;
        __builtin_amdgcn_s_waitcnt(0);
        unsigned nloc = b.st[0], nx = b.st[1];
        if (nloc == 0u) { xcd_barrier_complete(bar, b.x, nloc, nx); b.st[0] = nloc; b.st[1] = nx; }
        const unsigned old = xb_add(&bar[XB_XSUB(b.x)], 1u);
        const unsigned gen = old / nloc;
        if (old + 1u == (gen + 1u) * nloc) {
            __builtin_amdgcn_fence(__ATOMIC_RELEASE, "agent");
            asm volatile("s_waitcnt vmcnt(0)" ::: "memory");
            const unsigned og = xb_add(&bar[XB_TOP], 1u);
            const unsigned tg = og / nx;
            if (og + 1u == (tg + 1u) * nx) xb_add(&bar[XB_TOPGEN], 1u);
            else XB_SPIN(xb_ld(&bar[XB_TOPGEN]) == tg, bar);
            __builtin_amdgcn_fence(__ATOMIC_ACQUIRE, "agent");
            xb_add(&bar[XB_XGEN(b.x)], 1u);
            asm volatile("s_waitcnt vmcnt(0)" ::: "memory");
        } else {
            XB_SPIN(xb_ld(&bar[XB_XGEN(b.x)]) == gen, bar);
            __builtin_amdgcn_fence(__ATOMIC_ACQUIRE, "agent");
            asm volatile("s_waitcnt vmcnt(0)" ::: "memory");
        }
    }
    __syncthreads();
}

namespace mk {
constexpr int NWAVES = 8, NTHR = 512;
constexpr int D = 1024, NBATCH = 4, SEQ = 4096, CTXL = 256;
constexpr int MLAT = NBATCH * SEQ, MCTX = NBATCH * CTXL, MALL = MLAT + MCTX;
constexpr int INW = 2496, INP = 2560, DFF = 2816, NGU = 2 * DFF;
constexpr int C_R = 0, C_K = 256, C_V = 512, C_GD = 768, C_WD = 832, C_AD = 896, C_DFQ = 960, C_DFK = 1216, C_DFV = 1472, C_GQQ = 1728, C_GQK = 2240, C_GQV = 2368;
constexpr float NORM_EPS = 1e-6f, LOG2E = 1.4426950408889634f;
constexpr float SC_DF = 0.17677669529663687f * LOG2E;
constexpr float SC_GQ = 0.125f * LOG2E;

enum { I_X = 0, I_C, I_CTX, I_CCTX, I_ADAW, I_ADAB, I_NORMG, I_WIN, I_WOUT, I_RWCONV, I_RWW0, I_RWWUP, I_RWA0, I_RWAUP, I_RWGUP, I_RWKK, I_RWKA, I_RWRK, I_RWLNG, I_RWLNB,
       I_DFLAM, I_DFNG, I_GQSINK, I_FFG, I_FFU, I_FFD, I_FFCW, I_FFCB, N_IN };

constexpr size_t MiB = 1u << 20;
constexpr size_t WS_CTL = 0, CTL_ZERO_BYTES = 1 * MiB;
constexpr int CW_BAR = 4096;
constexpr size_t WS_MOD = 1 * MiB;
constexpr size_t WS_TAB = 1 * MiB + 256 * 1024;
constexpr size_t WS_WIN = 2 * MiB, WIN_BYTES = (size_t)INP * D * 2;
constexpr size_t WS_WOUT = 12 * MiB, WOUT_BYTES = (size_t)D * D * 2;
constexpr size_t WS_WGU = 16 * MiB, WGU_BYTES = (size_t)NGU * D * 2;
constexpr size_t WS_WD = 38 * MiB, WD_BYTES = (size_t)D * DFF * 2;
constexpr size_t WS_XSC = 49 * MiB;
constexpr size_t WS_XN = 53 * MiB;
constexpr size_t WS_RP = 87 * MiB;
constexpr size_t WS_RF = 172 * MiB;
constexpr size_t FEAT1 = (size_t)MALL * 256 * 2;
constexpr size_t WS_GAL = WS_RF, WS_GBE = WS_GAL + 2 * FEAT1, WS_GKP = WS_GBE + 2 * FEAT1, WS_GRH = WS_GKP + 2 * FEAT1, WS_FV = WS_GRH + 2 * FEAT1;
constexpr size_t WS_GLT = WS_FV + FEAT1;
constexpr size_t WS_BON = WS_GLT + (size_t)2 * 272 * 256 * 4;
constexpr size_t WS_RF_END = WS_BON + (size_t)MALL * 4 * 4;
constexpr size_t WS_ACT = WS_RP;
constexpr size_t WS_XR = 181 * MiB;
constexpr size_t WS_FP = 181 * MiB;
constexpr size_t WS_SLO = WS_RF;
constexpr size_t WS_SLD = 215 * MiB;
constexpr size_t WS_XB = 240 * MiB;
constexpr size_t WS_END = 256 * MiB;
static_assert(WS_RF_END <= WS_END, "feature region");
static_assert(WS_SLD + (size_t)11 * MCTX * D * 2 <= WS_XB && WS_XB + (size_t)8 * MLAT * 4 * 4 <= WS_END, "exchange slots");
static_assert(WS_FP + (size_t)MALL * D * 2 <= WS_SLD && WS_SLD + (size_t)11 * MCTX * D * 2 <= WS_END, "slabs");
static_assert(WS_ACT + (size_t)MALL * DFF * 2 <= WS_FP && WS_FP + (size_t)MALL * D * 4 <= WS_END, "ffn buffers");
static_assert(WS_XN + (size_t)MALL * D * 2 <= WS_RP && WS_RP + (size_t)MALL * INP * 2 <= WS_RF, "map");

constexpr int LDS_BYTES = 163840;
constexpr int LDSCTL_OFF = LDS_BYTES - 512, MISC_OFF = LDSCTL_OFF + 320;
constexpr int CW_QUEUE = 2048, CW_PST = 32768;

struct Args { const float* in[N_IN]; float* out; unsigned char* ws; int ph_lo, ph_hi; };


typedef const __attribute__((address_space(4))) char* kptr_t;
__device__ __forceinline__ kptr_t karg_base() { kptr_t k = (kptr_t)__builtin_amdgcn_kernarg_segment_ptr(); asm volatile("" : "+s"(k)); return k; }
__device__ __forceinline__ const float* kin(int i) { return *(const float* const __attribute__((address_space(4)))*)(karg_base() + 8 * i); }
__device__ __forceinline__ float* kout() { return *(float* const __attribute__((address_space(4)))*)(karg_base() + 8 * N_IN); }
__device__ __forceinline__ unsigned char* kws() { return *(unsigned char* const __attribute__((address_space(4)))*)(karg_base() + 8 * N_IN + 8); }

struct Frame {
    LAS unsigned char* lds;
    int tid, lane, wave, G, bid;
};

__device__ __forceinline__ float bf2f(bf16 h) { return __uint_as_float(((unsigned)h) << 16); }
template <int CTRL> __device__ __forceinline__ float dpp_mov(float x) { return __int_as_float(__builtin_amdgcn_update_dpp(0, __float_as_int(x), CTRL, 0xF, 0xF, false)); }
template <int CTRL> __device__ __forceinline__ float dpp_add(float x) { return x + dpp_mov<CTRL>(x); }
__device__ __forceinline__ float wave_sum(float v) {
    v = dpp_add<0xB1>(v); v = dpp_add<0x4E>(v); v = dpp_add<0x124>(v); v = dpp_add<0x128>(v);
    auto r = __builtin_amdgcn_permlane16_swap(__float_as_uint(v), __float_as_uint(v), false, false); v = __uint_as_float(r[0]) + __uint_as_float(r[1]);
    r = __builtin_amdgcn_permlane32_swap(__float_as_uint(v), __float_as_uint(v), false, false); return __uint_as_float(r[0]) + __uint_as_float(r[1]);
}
__device__ __forceinline__ float rdlane(float v, int l) { return __int_as_float(__builtin_amdgcn_readlane(__float_as_int(v), l)); }
__device__ __forceinline__ float sigmoidf_(float x) { return __builtin_amdgcn_rcpf(1.0f + __expf(-x)); }
typedef unsigned v2u __attribute__((ext_vector_type(2)));
typedef float f32x2_t __attribute__((ext_vector_type(2))); typedef __bf16 bf16x2_t __attribute__((ext_vector_type(2)));
__device__ __forceinline__ unsigned pk2h(float lo, float hi) { f32x2_t v = {lo, hi}; bf16x2_t b = __builtin_convertvector(v, bf16x2_t); return __builtin_bit_cast(unsigned, b); }
__device__ __forceinline__ float xmax4(float v) {
    auto r = __builtin_amdgcn_permlane16_swap(__float_as_uint(v), __float_as_uint(v), false, false); v = fmaxf(__uint_as_float(r[0]), __uint_as_float(r[1]));
    r = __builtin_amdgcn_permlane32_swap(__float_as_uint(v), __float_as_uint(v), false, false); return fmaxf(__uint_as_float(r[0]), __uint_as_float(r[1]));
}

__device__ __forceinline__ void p0_transpose_item(const float* W, int K, int N, bf16* WT, int row_off, LAS float* scr, int item, int lane) {
    const int nblk = N / 32, kb = item / nblk, nb = item % nblk, k0 = 64 * kb, n0 = 32 * nb;
#pragma unroll 8
    for (int i = 0; i < 32; ++i) { const int kk = 2 * i + (lane >> 5); scr[kk * 33 + (lane & 31)] = W[(size_t)(k0 + kk) * N + n0 + (lane & 31)]; }
    LDS_WAIT(); asm volatile("" ::: "memory");
    const int c = lane & 7;
#pragma unroll
    for (int j = 0; j < 4; ++j) { const int n = (lane >> 3) + 8 * j; const LAS float* s = scr + (8 * c) * 33 + n;
        v4u o; o.x = pk2h(s[0 * 33], s[1 * 33]); o.y = pk2h(s[2 * 33], s[3 * 33]); o.z = pk2h(s[4 * 33], s[5 * 33]); o.w = pk2h(s[6 * 33], s[7 * 33]);
        *(GAS v4u*)(WT + (size_t)(row_off + n0 + n) * K + k0 + 8 * c) = o; }
    LDS_WAIT(); asm volatile("" ::: "memory");
}

constexpr int WI_IN = 16 * (INW / 32), WI_OUT = 16 * 32, WI_G = 16 * (DFF / 32), WI_DN = (DFF / 64) * 32, WI_LAYER = WI_IN + WI_OUT + 2 * WI_G + WI_DN;
__device__ __forceinline__ void weight_item(int it, LAS float* scr, int lane) {
    unsigned char* ws = kws();
    const int l = it / WI_LAYER; int r = it % WI_LAYER;
    if (r < WI_IN) { p0_transpose_item(kin(I_WIN) + (size_t)l * D * INW, D, INW, (bf16*)(ws + WS_WIN + l * WIN_BYTES), 0, scr, r, lane); return; } r -= WI_IN;
    if (r < WI_OUT) { p0_transpose_item(kin(I_WOUT) + (size_t)l * D * D, D, D, (bf16*)(ws + WS_WOUT + l * WOUT_BYTES), 0, scr, r, lane); return; } r -= WI_OUT;
    if (r < WI_G) { const int n0 = 32 * (r % (DFF / 32)); p0_transpose_item(kin(I_FFG) + (size_t)l * D * DFF, D, DFF, (bf16*)(ws + WS_WGU + l * WGU_BYTES), 256 * (n0 >> 7) + (n0 & 127) - n0, scr, r, lane); return; } r -= WI_G;
    if (r < WI_G) { const int n0 = 32 * (r % (DFF / 32)); p0_transpose_item(kin(I_FFU) + (size_t)l * D * DFF, D, DFF, (bf16*)(ws + WS_WGU + l * WGU_BYTES), 256 * (n0 >> 7) + (n0 & 127) - n0 + 128, scr, r, lane); return; } r -= WI_G;
    p0_transpose_item(kin(I_FFD) + (size_t)l * DFF * D, DFF, D, (bf16*)(ws + WS_WD + l * WD_BYTES), 0, scr, r, lane);
}
constexpr int WI_FILL = (2 * WI_LAYER - WI_IN + 127) / 128;

__device__ __forceinline__ void p0_prologue(const Args& A, Frame& F) {
    unsigned char* ws = kws();
    {
        LAS float* sc = (LAS float*)F.lds;
        LAS float* red = (LAS float*)(F.lds + 20480);
        float* mod = (float*)(ws + WS_MOD);
        for (int u = F.bid; u < 192; u += F.G) {
            __syncthreads();
            for (int i = F.tid; i < 5 * 1024; i += NTHR) { const int bb = i >> 10, k = i & 1023; const float v = bb < 4 ? kin(I_C)[bb * 1024 + k] : kin(I_CCTX)[k]; sc[i] = v / (1.0f + __expf(-v)); }
            __syncthreads();
            const int l = u / 96, cc = u % 96, col = cc * 64 + (F.tid & 63), ks = F.tid >> 6;
            const float* w = kin(I_ADAW) + (size_t)l * 1024 * 6144 + col;
            float acc[5] = {0.f, 0.f, 0.f, 0.f, 0.f};
            for (int k0 = ks * 128; k0 < ks * 128 + 128; k0 += 16) { float wv[16];
#pragma unroll
                for (int q = 0; q < 16; ++q) wv[q] = w[(size_t)(k0 + q) * 6144];
#pragma unroll
                for (int q = 0; q < 16; ++q)
#pragma unroll
                    for (int bb = 0; bb < 5; ++bb) acc[bb] += sc[bb * 1024 + k0 + q] * wv[q]; }
#pragma unroll
            for (int bb = 0; bb < 5; ++bb) red[(ks * 5 + bb) * 64 + (F.tid & 63)] = acc[bb];
            __syncthreads();
            if (F.tid < 320) { const int bb = F.tid >> 6, c = F.tid & 63; float s = kin(I_ADAB)[l * 6144 + cc * 64 + c];
#pragma unroll
                for (int k8 = 0; k8 < 8; ++k8) s += red[(k8 * 5 + bb) * 64 + c];
                mod[(size_t)(l * 5 + bb) * 6144 + cc * 64 + c] = s; }
        }
        __syncthreads();
    }
    {
        LAS float* scr = (LAS float*)(F.lds + F.wave * 16384);
        const int gw = F.bid * NWAVES + F.wave, NGW = F.G * NWAVES;
        for (int it = gw; it < WI_IN; it += NGW) weight_item(it, scr, F.lane);
        const int gt = F.bid * NTHR + F.tid, NGT = F.G * NTHR;
        for (int i = gt; i < 2 * 8192; i += NGT) { const int l = i >> 13, j = i & 8191;
            unsigned z_ = 0u; asm volatile("" : "+v"(z_)); *(GAS v4u*)(ws + WS_WIN + l * WIN_BYTES + (size_t)INW * D * 2 + (size_t)j * 16) = (v4u){z_, z_, z_, z_}; }
    }
    if (F.bid == 0) {
        float* tab = (float*)(ws + WS_TAB);
        for (int i = F.tid; i < 512; i += NTHR) { const int pos = i >> 3, f = i & 7; const float inv = __builtin_amdgcn_exp2f(-(float)f * (13.287712379549449f / 8.0f)), ang = (float)pos * inv; tab[i] = __cosf(ang); tab[512 + i] = __sinf(ang); }
        for (int i = F.tid; i < 1024; i += NTHR) { const int pos = i >> 4, f = i & 15; const float inv = __builtin_amdgcn_exp2f(-(float)f * (13.287712379549449f / 16.0f)), ang = (float)pos * inv; tab[1024 + i] = __cosf(ang); tab[2048 + i] = __sinf(ang); }
        if (F.tid < 2) { const int l = F.tid; const float* lv = kin(I_DFLAM) + l * 128; float s1 = 0.f, s2 = 0.f;
            for (int i = 0; i < 32; ++i) { s1 += lv[i] * lv[32 + i]; s2 += lv[64 + i] * lv[96 + i]; }
            const float lam_init = 0.8f - 0.6f * __expf(-0.3f * (float)l);
            tab[3072 + l] = __expf(s1) - __expf(s2) + lam_init; tab[3074 + l] = lam_init; }
    }
}

__device__ __forceinline__ const float* mod_vec(const Args& A, int l, int bb, int i) { return (const float*)(kws() + WS_MOD) + ((size_t)(l * 5 + bb) * 6 + i) * 1024; }
__device__ __forceinline__ const float* normg_vec(const Args& A, int l, int i) { return kin(I_NORMG) + (size_t)(l * 4 + i) * 1024; }
__device__ __forceinline__ int row_bb(int row) { return row < MLAT ? (row >> 12) : 4; }
__device__ __forceinline__ void seq_pos(int row, int& t, int& T) { if (row < MLAT) { t = row & (SEQ - 1); T = SEQ; } else { t = (row - MLAT) & (CTXL - 1); T = CTXL; } }
__device__ __forceinline__ void ld16(const float* p, int lane, f32x4 (&v)[4]) {
#pragma unroll
    for (int j = 0; j < 4; ++j) v[j] = *(const f32x4*)(p + 4 * lane + 256 * j);
}
__device__ __forceinline__ void ld16b(const bf16* p, int lane, f32x4 (&v)[4]) {
#pragma unroll
    for (int j = 0; j < 4; ++j) { const v2u u = *(const v2u*)(p + 4 * lane + 256 * j);
        v[j] = (f32x4){__uint_as_float(u.x << 16), __uint_as_float(u.x & 0xffff0000u), __uint_as_float(u.y << 16), __uint_as_float(u.y & 0xffff0000u)}; }
}
__device__ __forceinline__ void st16(float* p, int lane, const f32x4 (&v)[4]) {
#pragma unroll
    for (int j = 0; j < 4; ++j) *(f32x4*)(p + 4 * lane + 256 * j) = v[j];
}
__device__ __forceinline__ float sumsq16(const f32x4 (&v)[4]) {
    float s = 0.f;
#pragma unroll
    for (int j = 0; j < 4; ++j) s += (v[j].x * v[j].x + v[j].y * v[j].y) + (v[j].z * v[j].z + v[j].w * v[j].w);
    return wave_sum(s);
}
__device__ __forceinline__ void norm_mod_store(const f32x4 (&v)[4], float rstd, const float* g, const float* sc, const float* sh, bf16* orow, int lane) {
#pragma unroll
    for (int j = 0; j < 4; ++j) {
        const int c = 4 * lane + 256 * j;
        const f32x4 gg = *(const f32x4*)(g + c), s1 = *(const f32x4*)(sc + c), s0 = *(const f32x4*)(sh + c);
        const f32x4 h = v[j] * rstd * gg * (s1 + 1.0f) + s0;
        v2u o; o.x = pk2h(h.x, h.y); o.y = pk2h(h.z, h.w);
        *(v2u*)(orow + c) = o;
    }
}
__device__ __forceinline__ float* xs_row(const Args& A, int row) { return row < MLAT ? kout() + (size_t)row * D : (float*)(kws() + WS_XSC) + (size_t)(row - MLAT) * D; }
__device__ __forceinline__ const float* xin_row(const Args& A, int row) { return row < MLAT ? kin(I_X) + (size_t)row * D : kin(I_CTX) + (size_t)(row - MLAT) * D; }

__device__ __forceinline__ void phase_prep(const Args& A, Frame& F) {
    const int gw = F.bid * NWAVES + F.wave, NGW = F.G * NWAVES;
    bf16* XN = (bf16*)(kws() + WS_XN);
    f32x4 v[4], vn[4];
    if (gw < MALL) ld16(xin_row(A, gw), F.lane, v);
    for (int row = gw; row < MALL; row += NGW) {
        if (row + NGW < MALL) ld16(xin_row(A, row + NGW), F.lane, vn);
        const float rstd = rsqrtf(sumsq16(v) * (1.0f / D) + NORM_EPS);
        const int bb = row_bb(row);
        norm_mod_store(v, rstd, normg_vec(A, 0, 0), mod_vec(A, 0, bb, 1), mod_vec(A, 0, bb, 0), XN + (size_t)row * D, F.lane);
#pragma unroll
        for (int j = 0; j < 4; ++j) v[j] = vn[j];
    }
}
__device__ __forceinline__ void phase_e1(const Args& A, Frame& F, int l) {
    const int gw = F.bid * NWAVES + F.wave, NGW = F.G * NWAVES, nrows = l == 0 ? MALL : MLAT;
    bf16* XN = (bf16*)(kws() + WS_XN); const bf16* YP = (const bf16*)(kws() + WS_RP);
    for (int row = ((MK_FUSE & 1) && !MK_DBGD ? MLAT : 0) + gw; row < nrows; row += NGW) {
        const int bb = row_bb(row);
        f32x4 y[4], x[4];
        if (l == 0 && row >= MLAT) { const bf16* sl = (const bf16*)(kws() + WS_SLO) + (size_t)(row - MLAT) * D; ld16b(sl, F.lane, y);
            for (int s = 1; s < 4; ++s) { f32x4 t[4]; ld16b(sl + (size_t)s * MCTX * D, F.lane, t);
#pragma unroll
                for (int j = 0; j < 4; ++j) y[j] = y[j] + t[j]; } }
        else ld16b(YP + (size_t)row * D, F.lane, y);
        if (l == 0) ld16(xin_row(A, row), F.lane, x); else ld16(xs_row(A, row), F.lane, x);
        const float ry = rsqrtf(sumsq16(y) * (1.0f / D) + NORM_EPS);
        const float* g1 = normg_vec(A, l, 1); const float* ga = mod_vec(A, l, bb, 2);
#pragma unroll
        for (int j = 0; j < 4; ++j) { const int c = 4 * F.lane + 256 * j; x[j] = x[j] + *(const f32x4*)(ga + c) * (y[j] * ry * *(const f32x4*)(g1 + c)); }
        st16(xs_row(A, row), F.lane, x);
        const float rx = rsqrtf(sumsq16(x) * (1.0f / D) + NORM_EPS);
        norm_mod_store(x, rx, normg_vec(A, l, 2), mod_vec(A, l, bb, 4), mod_vec(A, l, bb, 3), XN + (size_t)row * D, F.lane);
    }
}
__device__ __forceinline__ void phase_e2(const Args& A, Frame& F, int l, int r0, int r1) {
    const int gw = F.bid * NWAVES + F.wave, NGW = F.G * NWAVES;
    bf16* XN = (bf16*)(kws() + WS_XN); const bf16* FP = (const bf16*)(kws() + WS_FP);
    for (int row = ((MK_FUSE & 2) && !MK_DBGD ? (r0 < MLAT ? MLAT : r0) : r0) + gw; row < r1; row += NGW) {
        const int bb = row_bb(row);
        f32x4 y[4], x[4];
        if (l == 0 && row >= MLAT) { const bf16* sl = (const bf16*)(kws() + WS_SLD) + (size_t)(row - MLAT) * D; ld16b(sl, F.lane, y);
            for (int s = 1; s < 11; ++s) { f32x4 t[4]; ld16b(sl + (size_t)s * MCTX * D, F.lane, t);
#pragma unroll
                for (int j = 0; j < 4; ++j) y[j] = y[j] + t[j]; } }
        else ld16b(FP + (size_t)(row - r0) * D, F.lane, y);
        ld16(xs_row(A, row), F.lane, x);
        const float ry = rsqrtf(sumsq16(y) * (1.0f / D) + NORM_EPS);
        const float* g3 = normg_vec(A, l, 3); const float* ga = mod_vec(A, l, bb, 5);
#pragma unroll
        for (int j = 0; j < 4; ++j) { const int c = 4 * F.lane + 256 * j; x[j] = x[j] + *(const f32x4*)(ga + c) * (y[j] * ry * *(const f32x4*)(g3 + c)); }
        st16(xs_row(A, row), F.lane, x);
        if (l == 0) {
            const float rx = rsqrtf(sumsq16(x) * (1.0f / D) + NORM_EPS);
            norm_mod_store(x, rx, normg_vec(A, 1, 0), mod_vec(A, 1, bb, 1), mod_vec(A, 1, bb, 0), XN + (size_t)row * D, F.lane);
        }
    }
}
__device__ __forceinline__ void phase_act(const Args& A, Frame& F, int l, int r0, int r1) {
    const bf16* GU = (const bf16*)(kws() + WS_RP); bf16* ACT = (bf16*)(kws() + WS_ACT);
    const float* cw = kin(I_FFCW) + (size_t)l * 3 * DFF; const float* cb = kin(I_FFCB) + (size_t)l * DFF;
    const int nch = DFF / 8, total = (r1 - r0) * nch;
    for (int i = F.bid * NTHR + F.tid; i < total; i += F.G * NTHR) {
        const int rr = i / nch, ch = i % nch, row = r0 + rr, j0 = ch * 8;
        const int t = row < MLAT ? (row & (SEQ - 1)) : ((row - MLAT) & (CTXL - 1)), T = row < MLAT ? SEQ : CTXL;
        const bf16* gp = GU + (size_t)rr * NGU + j0;
        const v4u gc = *(const v4u*)gp, uu = *(const v4u*)(gp + DFF);
        v4u gm = (v4u){0u, 0u, 0u, 0u}, gn = (v4u){0u, 0u, 0u, 0u};
        if (t > 0) gm = *(const v4u*)(gp - NGU);
        if (t < T - 1) gn = *(const v4u*)(gp + NGU);
        unsigned o[4];
#pragma unroll
        for (int q = 0; q < 4; ++q) {
            float r2[2];
#pragma unroll
            for (int e = 0; e < 2; ++e) {
                const int j = j0 + 2 * q + e;
                const float a = __uint_as_float(e ? (gm[q] & 0xffff0000u) : (gm[q] << 16)), b = __uint_as_float(e ? (gc[q] & 0xffff0000u) : (gc[q] << 16)), c = __uint_as_float(e ? (gn[q] & 0xffff0000u) : (gn[q] << 16));
                const float u = __uint_as_float(e ? (uu[q] & 0xffff0000u) : (uu[q] << 16));
                const float z = a * cw[j] + b * cw[DFF + j] + c * cw[2 * DFF + j] + cb[j];
                r2[e] = z / (1.0f + __expf(-z)) * u;
            }
            o[q] = pk2h(r2[0], r2[1]);
        }
        *(v4u*)(ACT + (size_t)rr * DFF + j0) = (v4u){o[0], o[1], o[2], o[3]};
    }
}

struct EpiMulti {
    static constexpr bool PERM = false, AFTER_DRAIN = false;
    int mode;
    bf16* ob; float* of; int ld; const float* tab;
    const float* cw; const float* cb; int nrows; unsigned ldsx;
    const float* xin; float* xout; bf16* xn; const bf16* xinb; bf16* xoutb;
    const float *gA, *gaA, *gB, *scB, *shB; float* xb0; float* xb1; gu32* cnt0; gu32* cnt1; int two;
    __device__ __forceinline__ bool drain() const { return mode >= 5; }
    __device__ __forceinline__ void row_stats(const pg8::f32x4 (&v)[2][2][4][2], const pg8::Unit& u, int wr, int wc, int fr, int fq, LAS unsigned char* lds, int wid, int lane, float* xb, gu32* cnt) const {
        LAS float* Pp = (LAS float*)lds; LAS float* Ss = (LAS float*)(lds + 8192); LAS unsigned* flag = (LAS unsigned*)(lds + 8192 + 1024);
#pragma unroll
        for (int ai = 0; ai < 2; ++ai)
#pragma unroll
            for (int mm = 0; mm < 4; ++mm) { float s = 0.f;
#pragma unroll
                for (int bj = 0; bj < 2; ++bj)
#pragma unroll
                    for (int n = 0; n < 2; ++n) { const pg8::f32x4 x = v[ai][bj][mm][n]; s += (x[0] * x[0] + x[1] * x[1]) + (x[2] * x[2] + x[3] * x[3]); }
                s += __shfl_xor(s, 16); s += __shfl_xor(s, 32);
                if (fq == 0) Pp[(ai * 128 + wr * 64 + mm * 16 + fr) * 4 + wc] = s; }
        asm volatile("s_waitcnt lgkmcnt(0)" ::: "memory"); __builtin_amdgcn_s_barrier(); asm volatile("" ::: "memory");
        const int row = wid * 32 + (lane & 31);
        if (lane < 32) { const float s = (Pp[row * 4 + 0] + Pp[row * 4 + 1]) + (Pp[row * 4 + 2] + Pp[row * 4 + 3]);
            __hip_atomic_store((gu32*)(xb + ((size_t)u.pn * MLAT + u.pm * 256 + row)), __float_as_uint(s), __ATOMIC_RELAXED, __HIP_MEMORY_SCOPE_AGENT); }
        asm volatile("s_waitcnt vmcnt(0)" ::: "memory");
        if (lane == 0) __hip_atomic_fetch_add(cnt + 64 * u.pm, 1u, __ATOMIC_RELAXED, __HIP_MEMORY_SCOPE_AGENT);
        if (wid == 0) {
            unsigned sp = 0;
            while ((unsigned)__builtin_amdgcn_readfirstlane(__hip_atomic_load(cnt + 64 * u.pm, __ATOMIC_RELAXED, __HIP_MEMORY_SCOPE_AGENT)) < 32u) { __builtin_amdgcn_s_sleep(2); if (++sp > (1u << 22)) break; }
            __builtin_amdgcn_fence(__ATOMIC_ACQUIRE, "agent");
            if (lane == 0) flag[0] = 1u;
        }
        asm volatile("s_waitcnt vmcnt(0) lgkmcnt(0)" ::: "memory"); __builtin_amdgcn_s_barrier(); asm volatile("" ::: "memory");
        if (lane < 32) { float t = 0.f;
#pragma unroll
            for (int q = 0; q < 4; ++q) t += __uint_as_float(__hip_atomic_load((gu32*)(xb + ((size_t)q * MLAT + u.pm * 256 + row)), __ATOMIC_RELAXED, __HIP_MEMORY_SCOPE_AGENT));
            Ss[row] = rsqrtf(t * (1.0f / D) + NORM_EPS); }
        asm volatile("s_waitcnt vmcnt(0) lgkmcnt(0)" ::: "memory"); __builtin_amdgcn_s_barrier(); asm volatile("" ::: "memory");
    }
    __device__ __forceinline__ void fused(pg8::f32x4 (&acc)[2][2][4][2], const pg8::Unit& u, int wr, int wc, int fr_, int fq_, PG8_LAS unsigned char* lds, int wid, int lane) const {
        int fr = fr_, fq = fq_; asm volatile("" : "+v"(fr), "+v"(fq));
#if defined(MK_DBGDRAIN)
        { bf16* obd = mode == 5 ? (bf16*)(kws() + WS_RP) : (bf16*)(kws() + WS_FP);
#pragma unroll
          for (int ai = 0; ai < 2; ++ai)
#pragma unroll
            for (int mm = 0; mm < 4; ++mm) { bf16* rp = obd + (size_t)(u.pm * 256 + ai * 128 + wr * 64 + mm * 16 + fr) * D + u.pn * 256 + wc * 32 + 4 * fq;
#pragma unroll
                for (int bj = 0; bj < 2; ++bj)
#pragma unroll
                    for (int n = 0; n < 2; ++n) { const pg8::f32x4 v = acc[ai][bj][mm][n]; v2u o; o.x = pk2h(v[0], v[1]); o.y = pk2h(v[2], v[3]); *(v2u*)(rp + bj * 128 + n * 16) = o; } }
          return; }
#endif
        const LAS float* Ss = (const LAS float*)((LAS unsigned char*)lds + 8192);
        const int col0 = u.pn * 256 + wc * 32 + 4 * fq, bofs = (u.pm >> 4) * 6144;
        row_stats(acc, u, wr, wc, fr, fq, (LAS unsigned char*)lds, wid, lane, xb0, cnt0);
        pg8::f32x4 cA_[2][2];
#pragma unroll
        for (int bj = 0; bj < 2; ++bj)
#pragma unroll
            for (int n = 0; n < 2; ++n) cA_[bj][n] = *(const pg8::f32x4*)(gA + col0 + 128 * bj + 16 * n) * *(const pg8::f32x4*)(gaA + bofs + col0 + 128 * bj + 16 * n);
#pragma unroll
        for (int ai = 0; ai < 2; ++ai)
#pragma unroll
            for (int mm = 0; mm < 4; ++mm) { const int r = ai * 128 + wr * 64 + mm * 16 + fr; const float rs = Ss[r]; const size_t off = (size_t)(u.pm * 256 + r) * D + col0;
#pragma unroll
                for (int bj = 0; bj < 2; ++bj)
#pragma unroll
                    for (int n = 0; n < 2; ++n) { pg8::f32x4 xi;
                        if (xinb) { const v2u q = *(const v2u*)(xinb + off + 128 * bj + 16 * n); xi = (pg8::f32x4){__uint_as_float(q.x << 16), __uint_as_float(q.x & 0xffff0000u), __uint_as_float(q.y << 16), __uint_as_float(q.y & 0xffff0000u)}; }
                        else xi = *(const pg8::f32x4*)(xin + off + 128 * bj + 16 * n);
                        acc[ai][bj][mm][n] = xi + cA_[bj][n] * (acc[ai][bj][mm][n] * rs); }
                asm volatile("" : "+v"(acc[ai][0][mm][0]), "+v"(acc[ai][0][mm][1]), "+v"(acc[ai][1][mm][0]), "+v"(acc[ai][1][mm][1]));
                if (mm & 1) asm volatile("" ::: "memory"); }
        if (two) {
            asm volatile("s_waitcnt lgkmcnt(0)" ::: "memory"); __builtin_amdgcn_s_barrier(); asm volatile("" ::: "memory");
            row_stats(acc, u, wr, wc, fr, fq, (LAS unsigned char*)lds, wid, lane, xb1, cnt1);
        }
        pg8::f32x4 cB_[2][2], cS_[2][2];
        if (two) {
#pragma unroll
            for (int bj = 0; bj < 2; ++bj)
#pragma unroll
                for (int n = 0; n < 2; ++n) { cB_[bj][n] = *(const pg8::f32x4*)(gB + col0 + 128 * bj + 16 * n) * (*(const pg8::f32x4*)(scB + bofs + col0 + 128 * bj + 16 * n) + 1.0f); cS_[bj][n] = *(const pg8::f32x4*)(shB + bofs + col0 + 128 * bj + 16 * n); }
        }
#pragma unroll
        for (int ai = 0; ai < 2; ++ai)
#pragma unroll
            for (int mm = 0; mm < 4; ++mm) { const int r = ai * 128 + wr * 64 + mm * 16 + fr; const size_t off = (size_t)(u.pm * 256 + r) * D + col0; const float rs = two ? Ss[r] : 0.f;
#pragma unroll
                for (int bj = 0; bj < 2; ++bj)
#pragma unroll
                    for (int n = 0; n < 2; ++n) { const pg8::f32x4 x1 = acc[ai][bj][mm][n];
                        if (xoutb) { v2u q; q.x = pk2h(x1[0], x1[1]); q.y = pk2h(x1[2], x1[3]); *(v2u*)(xoutb + off + 128 * bj + 16 * n) = q; } else *(pg8::f32x4*)(xout + off + 128 * bj + 16 * n) = x1;
                        if (two) { const pg8::f32x4 hh = x1 * rs * cB_[bj][n] + cS_[bj][n]; v2u o; o.x = pk2h(hh[0], hh[1]); o.y = pk2h(hh[2], hh[3]); *(v2u*)(xn + off + 128 * bj + 16 * n) = o; } }
                asm volatile("" ::: "memory"); }
        asm volatile("s_waitcnt lgkmcnt(0)" ::: "memory"); __builtin_amdgcn_s_barrier(); asm volatile("" ::: "memory");
    }
    __device__ __forceinline__ void operator()(const pg8::f32x4 (&acc)[2][2][4][2], const pg8::Unit& u, int wr, int wc, int fr_, int fq_) const {
        int fr = fr_, fq = fq_; asm volatile("" : "+v"(fr), "+v"(fq));
        if (mode == 1) {
#pragma unroll
            for (int ai = 0; ai < 2; ++ai)
#pragma unroll
                for (int m = 0; m < 4; ++m) { float* rp = of + (size_t)(u.pm * 256 + ai * 128 + wr * 64 + m * 16 + fr) * ld + u.pn * 256 + wc * 32 + 4 * fq;
#pragma unroll
                    for (int bj = 0; bj < 2; ++bj)
#pragma unroll
                        for (int n = 0; n < 2; ++n) *(pg8::f32x4*)(rp + bj * 128 + n * 16) = acc[ai][bj][m][n]; }
        } else if (mode == 3) {
            const unsigned par = (unsigned)(u.pm + u.pn) & 1u;
            const unsigned ex = ldsx + par * 4096u + (unsigned)(wc * 32 + 4 * fq) * 4u;
#pragma unroll
            for (int ai = 0; ai < 2; ++ai)
#pragma unroll
                for (int n = 0; n < 2; ++n) {
                    if (fr == 0) *(LAS pg8::f32x4*)(uintptr_t)(ex + (unsigned)(((ai * 2 + wr) * 2 + 0) * 128 + n * 16) * 4u) = acc[ai][0][0][n];
                    if (fr == 15) *(LAS pg8::f32x4*)(uintptr_t)(ex + (unsigned)(((ai * 2 + wr) * 2 + 1) * 128 + n * 16) * 4u) = acc[ai][0][3][n];
                }
            asm volatile("s_waitcnt lgkmcnt(0)" ::: "memory"); __builtin_amdgcn_s_barrier(); asm volatile("" ::: "memory");
            const int jb = u.pn * 128 + wc * 32 + 4 * fq;
#pragma unroll
            for (int n = 0; n < 2; ++n) {
                const int j = jb + 16 * n;
                const pg8::f32x4 w0 = *(const pg8::f32x4*)(cw + j), w1 = *(const pg8::f32x4*)(cw + DFF + j), w2 = *(const pg8::f32x4*)(cw + 2 * DFF + j), bb = *(const pg8::f32x4*)(cb + j);
#pragma unroll
                for (int ai = 0; ai < 2; ++ai) {
                    const int pblk = (ai * 2 + wr) - 1, nblk = (ai * 2 + wr) + 1;
                    pg8::f32x4 eprev = (pg8::f32x4){0.f, 0.f, 0.f, 0.f}, enext = eprev;
                    if (pblk >= 0) eprev = *(LAS const pg8::f32x4*)(uintptr_t)(ex + (unsigned)((pblk * 2 + 1) * 128 + n * 16) * 4u);
                    if (nblk <= 3) enext = *(LAS const pg8::f32x4*)(uintptr_t)(ex + (unsigned)((nblk * 2 + 0) * 128 + n * 16) * 4u);
#pragma unroll
                    for (int mm = 0; mm < 4; ++mm) {
                        const int trow = ai * 128 + wr * 64 + mm * 16 + fr, grow = u.pm * 254 - 1 + trow;
                        int t, T; seq_pos(grow < 0 ? 0 : grow, t, T);
                        const pg8::f32x4 gc = acc[ai][0][mm][n], uu = acc[ai][1][mm][n];
                        pg8::f32x4 gp, gn;
#pragma unroll
                        for (int i = 0; i < 4; ++i) {
                            const float pold = mm > 0 ? __int_as_float(__builtin_amdgcn_update_dpp(0, __float_as_int(acc[ai][0][mm > 0 ? mm - 1 : 0][n][i]), 0x121, 0xF, 0xF, false)) : eprev[i];
                            gp[i] = __int_as_float(__builtin_amdgcn_update_dpp(__float_as_int(pold), __float_as_int(gc[i]), 0x111, 0xF, 0xF, false));
                            const float nold = mm < 3 ? __int_as_float(__builtin_amdgcn_update_dpp(0, __float_as_int(acc[ai][0][mm < 3 ? mm + 1 : 3][n][i]), 0x12F, 0xF, 0xF, false)) : enext[i];
                            gn[i] = __int_as_float(__builtin_amdgcn_update_dpp(__float_as_int(nold), __float_as_int(gc[i]), 0x101, 0xF, 0xF, false));
                        }
                        if (t == 0) gp = (pg8::f32x4){0.f, 0.f, 0.f, 0.f};
                        if (t == T - 1) gn = (pg8::f32x4){0.f, 0.f, 0.f, 0.f};
                        const pg8::f32x4 z = gp * w0 + gc * w1 + gn * w2 + bb;
                        pg8::f32x4 a;
#pragma unroll
                        for (int i = 0; i < 4; ++i) a[i] = z[i] * __builtin_amdgcn_rcpf(1.0f + __expf(-z[i])) * uu[i];
                        if (trow >= 1 && trow <= 254 && grow < nrows) { v2u o; o.x = pk2h(a[0], a[1]); o.y = pk2h(a[2], a[3]); *(v2u*)(ob + (size_t)grow * DFF + j) = o; }
                    }
                }
            }
        } else if (mode == 2) {
#pragma unroll
            for (int ai = 0; ai < 2; ++ai)
#pragma unroll
                for (int m = 0; m < 4; ++m) { bf16* rp = ob + (size_t)(u.pm * 256 + ai * 128 + wr * 64 + m * 16 + fr) * ld + u.pn * 256 + wc * 32 + 4 * fq;
#pragma unroll
                    for (int bj = 0; bj < 2; ++bj)
#pragma unroll
                        for (int n = 0; n < 2; ++n) { const pg8::f32x4 v = acc[ai][bj][m][n]; v2u o; o.x = pk2h(v[0], v[1]); o.y = pk2h(v[2], v[3]); *(v2u*)(rp + bj * 128 + n * 16) = o; } }
        } else {
            const bool latent = u.pm < (MLAT / 256);
#pragma unroll
            for (int bj = 0; bj < 2; ++bj) {
                const int g32 = u.pn * 8 + bj * 4 + wc;
                if (g32 >= INW / 32) continue;
                const bool isdf = (g32 >= C_DFQ / 32 && g32 < C_DFV / 32), isgq = (g32 >= C_GQQ / 32 && g32 < C_GQV / 32);
                const float qs = (g32 >= C_DFQ / 32 && g32 < C_DFK / 32) ? SC_DF : ((g32 >= C_GQQ / 32 && g32 < C_GQK / 32) ? SC_GQ : 1.0f);
#pragma unroll
                for (int ai = 0; ai < 2; ++ai)
#pragma unroll
                    for (int m = 0; m < 4; ++m) {
                        const int row = u.pm * 256 + ai * 128 + wr * 64 + m * 16 + fr, s = row & (SEQ - 1), prow = s >> 6, pcol = s & 63;
                        pg8::f32x4 v0 = acc[ai][bj][m][0], v1 = acc[ai][bj][m][1];
                        if (isdf) {
                            pg8::f32x4 p0, p1;
#pragma unroll
                            for (int i = 0; i < 4; ++i) { p0[i] = __shfl_xor(v0[i], 32); p1[i] = __shfl_xor(v1[i], 32); }
                            if (latent) {
                                const int f0 = 4 * (fq & 1);
                                const pg8::f32x4 c0 = *(const pg8::f32x4*)(tab + prow * 8 + f0), s0 = *(const pg8::f32x4*)(tab + 512 + prow * 8 + f0);
                                const pg8::f32x4 c1 = *(const pg8::f32x4*)(tab + pcol * 8 + f0), s1 = *(const pg8::f32x4*)(tab + 512 + pcol * 8 + f0);
                                if (fq & 2) { v0 = v0 * c0 + p0 * s0; v1 = v1 * c1 + p1 * s1; } else { v0 = v0 * c0 - p0 * s0; v1 = v1 * c1 - p1 * s1; }
                            }
                        } else if (isgq) {
                            if (latent) {
                                const int pos = (g32 & 1) ? pcol : prow;
                                const pg8::f32x4 cc = *(const pg8::f32x4*)(tab + 1024 + pos * 16 + 4 * fq), ss = *(const pg8::f32x4*)(tab + 2048 + pos * 16 + 4 * fq);
                                const pg8::f32x4 a = v0 * cc - v1 * ss, b = v1 * cc + v0 * ss; v0 = a; v1 = b;
                            }
                        }
                        v0 = v0 * qs; v1 = v1 * qs;
                        bf16* rp = ob + (size_t)row * INP + g32 * 32 + 4 * fq;
                        v2u o; o.x = pk2h(v0[0], v0[1]); o.y = pk2h(v0[2], v0[3]); *(v2u*)rp = o;
                        o.x = pk2h(v1[0], v1[1]); o.y = pk2h(v1[2], v1[3]); *(v2u*)(rp + 16) = o;
                        asm volatile("" ::: "memory");
                    }
            }
        }
    }
};


template <int CTRL, int RM> __device__ __forceinline__ float dpp_mul1(float x) {
    return x * __int_as_float(__builtin_amdgcn_update_dpp(0x3f800000, __float_as_int(x), CTRL, RM, 0xF, false));
}
__device__ __forceinline__ float wave_mulscan(float x) {
    x = dpp_mul1<0x111, 0xF>(x); x = dpp_mul1<0x112, 0xF>(x); x = dpp_mul1<0x114, 0xF>(x); x = dpp_mul1<0x118, 0xF>(x);
    x = dpp_mul1<0x142, 0xA>(x); x = dpp_mul1<0x143, 0xC>(x); return x;
}
__device__ __forceinline__ float wave_shr1_one(float x) { return __int_as_float(__builtin_amdgcn_update_dpp(0x3f800000, __float_as_int(x), 0x138, 0xF, 0xF, false)); }
__device__ __forceinline__ bf16 bf1(float x) { return (bf16)(pk2h(x, 0.f) & 0xffffu); }

constexpr int FT_LD = 65, FT_ARR = 64 * FT_LD * 4;
constexpr int FT_BON = 9 * FT_ARR;
constexpr int FT_PR_LD = 200;
static_assert(66 * FT_PR_LD * 2 <= 2 * FT_ARR && FT_BON + 512 <= LDSCTL_OFF, "features LDS map");
__device__ __forceinline__ void rwkv_features(const Args& A, Frame& F, int l) {
    const int w = F.wave, n = F.lane, c15 = n & 15, g = n >> 4, tr = w >> 1, tc0 = (w & 1) * 2;
    const int h = F.bid & 3, c = h * 64 + n;
    const bf16* P = (const bf16*)(kws() + WS_RP);
    bf16* FV = (bf16*)(kws() + WS_FV); float* BON = (float*)(kws() + WS_BON); float* GLT = (float*)(kws() + WS_GLT);
    float cw[3][3];
#pragma unroll
    for (int tp = 0; tp < 3; ++tp)
#pragma unroll
        for (int j = 0; j < 3; ++j) cw[tp][j] = kin(I_RWCONV)[(size_t)(l * 3 + tp) * 768 + j * 256 + c];
    const float kkc = kin(I_RWKK)[l * 256 + c];
    bf16x8 Bw[2][2], Ba[2][2]; float w0c[2][2], a0c[2][2], kac2[2], rkc2[2];
#pragma unroll
    for (int t = 0; t < 2; ++t) { const int cn = h * 64 + 16 * (tc0 + t) + c15;
        kac2[t] = kin(I_RWKA)[l * 256 + cn]; rkc2[t] = kin(I_RWRK)[l * 256 + cn];
#pragma unroll
        for (int d = 0; d < 2; ++d) { w0c[d][t] = kin(I_RWW0)[(l * 2 + d) * 256 + cn]; a0c[d][t] = kin(I_RWA0)[(l * 2 + d) * 256 + cn];
            unsigned pw[4], pa[4];
#pragma unroll
            for (int j = 0; j < 8; j += 2) { const size_t o = ((size_t)(l * 2 + d) * 32 + 8 * g + j) * 256 + cn;
                pw[j >> 1] = pk2h(kin(I_RWWUP)[o], kin(I_RWWUP)[o + 256]); pa[j >> 1] = pk2h(kin(I_RWAUP)[o], kin(I_RWAUP)[o + 256]); }
            Bw[d][t] = __builtin_bit_cast(bf16x8, (v4u){pw[0], pw[1], pw[2], pw[3]}); Ba[d][t] = __builtin_bit_cast(bf16x8, (v4u){pa[0], pa[1], pa[2], pa[3]}); }
    }
    for (int u = F.bid; u < 4 * (MALL / 64); u += F.G) {
        const int gi = u >> 2, row0 = 64 * gi;
        int t0, T; seq_pos(row0, t0, T);
        __syncthreads();
        for (int p = F.tid; p < 66 * 24; p += NTHR) { const int rr = p / 24, q = p % 24, which = q >> 3, ch = q & 7, row = row0 - 1 + rr;
            const bool ok = (rr >= 1 && rr <= 64) || (rr == 0 ? t0 > 0 : t0 + 64 < T);
            unsigned z_ = 0u; asm volatile("" : "+v"(z_)); v4u v = (v4u){z_, z_, z_, z_};
            if (ok) v = *(const v4u*)(P + (size_t)row * INP + which * 256 + h * 64 + 8 * ch);
            *(LAS v4u*)(F.lds + (rr * FT_PR_LD + which * 64 + 8 * ch) * 2) = v; }
        v4u xwd[2], xad[2];
        { const bf16* pr = P + (size_t)(row0 + 16 * tr + c15) * INP + 8 * g;
#pragma unroll
          for (int d = 0; d < 2; ++d) { xwd[d] = *(const v4u*)(pr + C_WD + 32 * d); xad[d] = *(const v4u*)(pr + C_AD + 32 * d); } }
        __syncthreads();
#pragma unroll
        for (int rr = 0; rr < 8; ++rr) {
            const int i = 8 * w + rr;
            float xr[3], xk[3], xv[3];
#pragma unroll
            for (int tp = 0; tp < 3; ++tp) { const LAS bf16* pp = (const LAS bf16*)F.lds + (i + tp) * FT_PR_LD + n; xr[tp] = bf2f(pp[0]); xk[tp] = bf2f(pp[64]); xv[tp] = bf2f(pp[128]); }
            const float rq = bf2f(bf1(xr[0] * cw[0][0] + xr[1] * cw[1][0] + xr[2] * cw[2][0])), kq = bf2f(bf1(xk[0] * cw[0][1] + xk[1] * cw[1][1] + xk[2] * cw[2][1]));
            FV[(size_t)(row0 + i) * 256 + c] = bf1(xv[0] * cw[0][2] + xv[1] * cw[1][2] + xv[2] * cw[2][2]);
            const float kkraw = kq * kkc;
            const float kk = kkraw * (1.0f / fmaxf(sqrtf(wave_sum(kkraw * kkraw)), 1e-12f));
            LAS float* L = (LAS float*)F.lds + i * FT_LD + n;
            L[2 * (FT_ARR / 4)] = kk; L[7 * (FT_ARR / 4)] = rq; L[8 * (FT_ARR / 4)] = kq;
        }
        __syncthreads();
        {
            bf16x8 aw[2], aa[2];
#pragma unroll
            for (int d = 0; d < 2; ++d) { unsigned pw[4];
#pragma unroll
                for (int q = 0; q < 4; ++q) { const float x0 = __uint_as_float(xwd[d][q] << 16), x1 = __uint_as_float(xwd[d][q] & 0xffff0000u);
                    pw[q] = pk2h(1.0f - 2.0f * __builtin_amdgcn_rcpf(1.0f + __expf(2.0f * x0)), 1.0f - 2.0f * __builtin_amdgcn_rcpf(1.0f + __expf(2.0f * x1))); }
                aw[d] = __builtin_bit_cast(bf16x8, (v4u){pw[0], pw[1], pw[2], pw[3]}); aa[d] = __builtin_bit_cast(bf16x8, xad[d]); }
            float bsum[4] = {0.f, 0.f, 0.f, 0.f};
#pragma unroll
            for (int t = 0; t < 2; ++t) {
                float kkv[4], kqv[4], rqv[4];
#pragma unroll
                for (int r = 0; r < 4; ++r) { const LAS float* L = (const LAS float*)F.lds + (16 * tr + 4 * g + r) * FT_LD + 16 * (tc0 + t) + c15;
                    kkv[r] = L[2 * (FT_ARR / 4)]; rqv[r] = L[7 * (FT_ARR / 4)]; kqv[r] = L[8 * (FT_ARR / 4)]; }
#pragma unroll
                for (int d = 0; d < 2; ++d) {
                    const f32x4 wl = __builtin_amdgcn_mfma_f32_16x16x32_bf16(aw[d], Bw[d][t], (f32x4){0.f, 0.f, 0.f, 0.f}, 0, 0, 0);
                    const f32x4 al = __builtin_amdgcn_mfma_f32_16x16x32_bf16(aa[d], Ba[d][t], (f32x4){0.f, 0.f, 0.f, 0.f}, 0, 0, 0);
#pragma unroll
                    for (int r = 0; r < 4; ++r) {
                        const float wv = 1.0f + bf2f(bf1(__expf(-0.6065306597126334f * sigmoidf_(wl[r] + w0c[d][t])) - 1.0f)), aq = bf2f(bf1(sigmoidf_(al[r] + a0c[d][t])));
                        const float kd = kqv[r] * (1.0f + (aq - 1.0f) * kac2[t]);
                        LAS float* L = (LAS float*)F.lds + (16 * tr + 4 * g + r) * FT_LD + 16 * (tc0 + t) + c15;
                        L[(0 + d) * (FT_ARR / 4)] = wv; L[(3 + d) * (FT_ARR / 4)] = kkv[r] * aq; L[(5 + d) * (FT_ARR / 4)] = kd;
                        bsum[r] += rqv[r] * kd * rkc2[t];
                    }
                }
            }
#pragma unroll
            for (int r = 0; r < 4; ++r) { float s = bsum[r]; s = dpp_add<0xB1>(s); s = dpp_add<0x4E>(s); s = dpp_add<0x124>(s); s = dpp_add<0x128>(s);
                if (c15 == 0) *(LAS float*)(F.lds + FT_BON + ((w & 1) * 64 + 16 * tr + 4 * g + r) * 4) = s; }
        }
        __syncthreads();
        if (F.tid < 64) BON[(row0 + F.tid) * 4 + h] = *(LAS float*)(F.lds + FT_BON + F.tid * 4) + *(LAS float*)(F.lds + FT_BON + (64 + F.tid) * 4);
#pragma unroll
        for (int d = 0; d < 2; ++d) {
            const int i = d ? 63 - n : n;
            const LAS float* L = (const LAS float*)F.lds + i * FT_LD + 8 * w;
            unsigned al8[4], be8[4], kp8[4], rh8[4]; float g63[8];
#pragma unroll
            for (int e2 = 0; e2 < 4; ++e2) {
                float alv[2], bev[2], kpv[2], rhv[2];
#pragma unroll
                for (int q = 0; q < 2; ++q) { const int e = 2 * e2 + q;
                    const float gi_ = wave_mulscan(L[(0 + d) * (FT_ARR / 4) + e]), gim1 = wave_shr1_one(gi_), ig = __builtin_amdgcn_rcpf(gi_);
                    g63[e] = rdlane(gi_, 63);
                    alv[q] = gim1 * L[2 * (FT_ARR / 4) + e]; bev[q] = L[(3 + d) * (FT_ARR / 4) + e] * ig; kpv[q] = L[(5 + d) * (FT_ARR / 4) + e] * ig; rhv[q] = gi_ * L[7 * (FT_ARR / 4) + e]; }
                al8[e2] = pk2h(alv[0], alv[1]); be8[e2] = pk2h(bev[0], bev[1]); kp8[e2] = pk2h(kpv[0], kpv[1]); rh8[e2] = pk2h(rhv[0], rhv[1]);
            }
            const size_t o = (size_t)d * MALL * 256 + (size_t)(64 * gi + i) * 256 + h * 64 + 8 * w;
            *(v4u*)((bf16*)(kws() + WS_GAL) + o) = (v4u){al8[0], al8[1], al8[2], al8[3]}; *(v4u*)((bf16*)(kws() + WS_GBE) + o) = (v4u){be8[0], be8[1], be8[2], be8[3]};
            *(v4u*)((bf16*)(kws() + WS_GKP) + o) = (v4u){kp8[0], kp8[1], kp8[2], kp8[3]}; *(v4u*)((bf16*)(kws() + WS_GRH) + o) = (v4u){rh8[0], rh8[1], rh8[2], rh8[3]};
            if (n < 8) { float gl = g63[0];
#pragma unroll
                for (int e = 1; e < 8; ++e) gl = (n == e) ? g63[e] : gl;
                GLT[((size_t)d * 272 + gi) * 256 + h * 64 + 8 * w + n] = gl; }
        }
    }
}

__device__ __forceinline__ int scan_row(int d, int b, int i) { if (i < CTXL) { const int t = d ? CTXL - 1 - i : i; return MLAT + b * CTXL + t; } const int j = i - CTXL, t = d ? SEQ - 1 - j : j; return b * SEQ + t; }

__device__ __forceinline__ void rwkv_readout(const Args& A, Frame& F, int l) {
    const int gw = F.bid * NWAVES + F.wave, NGW = F.G * NWAVES, nrows = l == 0 ? MALL : MLAT;
    const int h = gw & 3, c15 = F.lane & 15, g = F.lane >> 4;
    const bf16* P = (const bf16*)(kws() + WS_RP); const bf16* FV = (const bf16*)(kws() + WS_FV);
    const float* BON = (const float*)(kws() + WS_BON); bf16* Y = (bf16*)(kws() + WS_XN);
    bf16x8 ga[4][2];
#pragma unroll
    for (int nt = 0; nt < 4; ++nt)
#pragma unroll
        for (int ks = 0; ks < 2; ++ks) { unsigned pw[4]; const float* gp = kin(I_RWGUP) + ((size_t)l * 64 + 32 * ks + 8 * g) * 256 + h * 64 + 16 * nt + c15;
#pragma unroll
            for (int i = 0; i < 8; i += 2) pw[i >> 1] = pk2h(gp[(size_t)i * 256], gp[(size_t)(i + 1) * 256]);
            ga[nt][ks] = __builtin_bit_cast(bf16x8, (v4u){pw[0], pw[1], pw[2], pw[3]}); }
    f32x4 lg[4], lb[4];
#pragma unroll
    for (int nt = 0; nt < 4; ++nt) { lg[nt] = *(const f32x4*)(kin(I_RWLNG) + l * 256 + h * 64 + 16 * nt + 4 * g); lb[nt] = *(const f32x4*)(kin(I_RWLNB) + l * 256 + h * 64 + 16 * nt + 4 * g); }
    for (int task = gw >> 2; task < nrows / 16; task += NGW >> 2) {
        const int row = 16 * task + c15;
        const bf16* pr = P + (size_t)row * INP;
        const v4u gd0 = *(const v4u*)(pr + C_GD + 8 * g), gd1 = *(const v4u*)(pr + C_GD + 32 + 8 * g);
        v2u of[4], ob[4], fv[4];
#pragma unroll
        for (int nt = 0; nt < 4; ++nt) { of[nt] = *(const v2u*)(pr + h * 64 + 16 * nt + 4 * g); ob[nt] = *(const v2u*)(pr + 256 + h * 64 + 16 * nt + 4 * g); fv[nt] = *(const v2u*)(FV + (size_t)row * 256 + h * 64 + 16 * nt + 4 * g); }
        const float bon = BON[row * 4 + h];
        bf16x8 sb[2];
#pragma unroll
        for (int ks = 0; ks < 2; ++ks) { const v4u q = ks ? gd1 : gd0; unsigned pw[4];
#pragma unroll
            for (int i = 0; i < 4; ++i) pw[i] = pk2h(sigmoidf_(__uint_as_float(q[i] << 16)), sigmoidf_(__uint_as_float(q[i] & 0xffff0000u)));
            sb[ks] = __builtin_bit_cast(bf16x8, (v4u){pw[0], pw[1], pw[2], pw[3]}); }
        f32x4 gt[4], ov[4]; float s = 0.f;
#pragma unroll
        for (int nt = 0; nt < 4; ++nt) { gt[nt] = (f32x4){0.f, 0.f, 0.f, 0.f};
#pragma unroll
            for (int ks = 0; ks < 2; ++ks) gt[nt] = __builtin_amdgcn_mfma_f32_16x16x32_bf16(ga[nt][ks], sb[ks], gt[nt], 0, 0, 0);
            ov[nt] = (f32x4){__uint_as_float(of[nt].x << 16) + __uint_as_float(ob[nt].x << 16), __uint_as_float(of[nt].x & 0xffff0000u) + __uint_as_float(ob[nt].x & 0xffff0000u),
                             __uint_as_float(of[nt].y << 16) + __uint_as_float(ob[nt].y << 16), __uint_as_float(of[nt].y & 0xffff0000u) + __uint_as_float(ob[nt].y & 0xffff0000u)};
            s += (ov[nt][0] + ov[nt][1]) + (ov[nt][2] + ov[nt][3]); }
        s += __shfl_xor(s, 16); s += __shfl_xor(s, 32);
        const float mu = s * (1.0f / 64.0f); float q2 = 0.f;
#pragma unroll
        for (int nt = 0; nt < 4; ++nt) { ov[nt] = ov[nt] - mu; q2 += (ov[nt][0] * ov[nt][0] + ov[nt][1] * ov[nt][1]) + (ov[nt][2] * ov[nt][2] + ov[nt][3] * ov[nt][3]); }
        q2 += __shfl_xor(q2, 16); q2 += __shfl_xor(q2, 32);
        const float rs = rsqrtf(q2 * (1.0f / 64.0f) + 64e-5f);
        bf16* yp = Y + (size_t)row * D + h * 64 + 4 * g;
#pragma unroll
        for (int nt = 0; nt < 4; ++nt) {
            const f32x4 vv = (f32x4){__uint_as_float(fv[nt].x << 16), __uint_as_float(fv[nt].x & 0xffff0000u), __uint_as_float(fv[nt].y << 16), __uint_as_float(fv[nt].y & 0xffff0000u)};
            const f32x4 y = (ov[nt] * rs * lg[nt] + lb[nt] + vv * bon) * gt[nt];
            v2u w; w.x = pk2h(y[0], y[1]); w.y = pk2h(y[2], y[3]); *(v2u*)(yp + 16 * nt) = w; }
    }
}


constexpr int CK_LD = 72, CK_MAT = 64 * CK_LD * 2, CK_HALF = 32 * CK_LD * 2;
constexpr int O_AL = 0, O_BE = 2 * CK_MAT, O_RH = 4 * CK_MAT, O_KP = 6 * CK_MAT, O_V = 7 * CK_MAT, O_AOFF = 8 * CK_MAT, O_MB = 10 * CK_MAT, O_BM = 12 * CK_MAT, O_MK = 13 * CK_MAT;
constexpr int O_SB = 14 * CK_MAT, O_YZ = O_SB + 2 * CK_HALF, O_UT = O_YZ + CK_HALF;
constexpr int CK_TD_LD = 40, CK_TDSZ = 64 * CK_TD_LD * 2;
constexpr int CK_TD = O_UT + CK_HALF;
constexpr int CK_ADG = CK_TD + 2 * CK_TDSZ;
constexpr int CK_GL = CK_ADG + 4096;
constexpr int CK_END = CK_GL + 512;
static_assert(CK_END <= LDSCTL_OFF, "chunk scan LDS map");
struct CkAddr { unsigned v1t, lds, vX0, vT0, vR0; };
typedef short v4s16 __attribute__((ext_vector_type(4)));
#define CKP(T, addr) ((LAS T*)(uintptr_t)(addr))
__device__ __forceinline__ bf16x8 ldtr(unsigned addr) {
    const v4s16 lo = __builtin_amdgcn_ds_read_tr16_b64_v4i16((LAS v4s16*)(uintptr_t)addr), hi = __builtin_amdgcn_ds_read_tr16_b64_v4i16((LAS v4s16*)(uintptr_t)(addr + 4 * CK_LD * 2));
    return __builtin_bit_cast(bf16x8, __builtin_shufflevector(lo, hi, 0, 1, 2, 3, 4, 5, 6, 7));
}
template <int KS, bool TRX, bool TRY> __device__ __forceinline__ void mm1(f32x4& acc, const CkAddr& K, unsigned ox, unsigned oy, int xt, int yt) {
    const unsigned ax = (TRX ? K.vR0 + xt * 32 : K.vX0 + xt * (16 * CK_LD * 2)) + ox;
    const unsigned ay = (TRY ? K.vR0 + yt * 32 : K.vX0 + yt * (16 * CK_LD * 2)) + oy;
#pragma unroll
    for (int ks = 0; ks < KS; ++ks) {
        const bf16x8 a = TRX ? ldtr(ax + ks * (32 * CK_LD * 2)) : *CKP(const bf16x8, ax + 64 * ks);
        const bf16x8 bq = TRY ? ldtr(ay + ks * (32 * CK_LD * 2)) : *CKP(const bf16x8, ay + 64 * ks);
        acc = __builtin_amdgcn_mfma_f32_16x16x32_bf16(a, bq, acc, 0, 0, 0); }
}
__device__ __forceinline__ void stT1(const CkAddr& K, unsigned o, int rt, int ct, const f32x4 v) {
    v2u q; q.x = pk2h(v[0], v[1]); q.y = pk2h(v[2], v[3]); *CKP(v2u, K.vT0 + o + ct * (16 * CK_LD * 2) + rt * 32) = q;
}
__device__ __forceinline__ void ck_tile4(const CkAddr& K, int xt, int yt, unsigned oAL, unsigned oBE, unsigned oRH, f32x4& pa, f32x4& pb, f32x4& pm, f32x4& pk) {
    pa = (f32x4){0.f, 0.f, 0.f, 0.f}; pb = pa; pm = pa; pk = pa;
    mm1<2, false, false>(pa, K, oBE, oAL, xt, yt); mm1<2, false, false>(pb, K, O_KP, oAL, xt, yt); mm1<2, false, false>(pm, K, oBE, oRH, xt, yt); mm1<2, false, false>(pk, K, O_KP, oRH, xt, yt);
}
__device__ __forceinline__ void rwkv_chunk_unit(const Args& A, Frame& F, int l, int sc, int vh) {
    const bool last = (l == 1);
    const int d = sc >> 4, b = (sc >> 2) & 3, h = sc & 3;
    const int w = F.wave, n = F.lane;
    const bf16* GAL = (const bf16*)(kws() + WS_GAL) + (size_t)d * MALL * 256; const bf16* GBE = (const bf16*)(kws() + WS_GBE) + (size_t)d * MALL * 256;
    const bf16* GKP = (const bf16*)(kws() + WS_GKP) + (size_t)d * MALL * 256; const bf16* GRH = (const bf16*)(kws() + WS_GRH) + (size_t)d * MALL * 256;
    const bf16* FV = (const bf16*)(kws() + WS_FV); const float* GLT = (const float*)(kws() + WS_GLT) + (size_t)d * 272 * 256;
    bf16* O = (bf16*)(kws() + WS_RP) + d * 256;
    constexpr int NCK = (CTXL + SEQ) / 64;
    v4u ual, ube, ukp, urh, uv; float fgl = 0.f;
#define CK_FETCH(cc_) do { const int cq_ = (cc_) < NCK ? (cc_) : NCK - 1; const int row_ = scan_row(d, b, 64 * cq_ + 8 * w + (n >> 3)); const size_t o_ = (size_t)row_ * 256 + h * 64 + 8 * (n & 7); \
        ual = *(const v4u*)(GAL + o_); ube = *(const v4u*)(GBE + o_); ukp = *(const v4u*)(GKP + o_); urh = *(const v4u*)(GRH + o_); uv = *(const v4u*)(FV + o_); \
        if (w == 0) fgl = GLT[(size_t)(scan_row(d, b, 64 * cq_) >> 6) * 256 + h * 64 + n]; } while (0)
    CK_FETCH(0);
    __syncthreads();
    { unsigned z_ = 0u; asm volatile("" : "+v"(z_));
      for (int i = F.tid; i < CK_END / 16; i += NTHR) *(LAS v4u*)(F.lds + i * 16) = (v4u){z_, z_, z_, z_}; }
    f32x4 st = (f32x4){0.f, 0.f, 0.f, 0.f};
    f32x4 st0 = st, yb0 = st, ob0 = st;
    __syncthreads();
    for (int c = -1; c < NCK; ++c) {
        int c15 = n & 15, g = n >> 4; asm volatile("" : "+v"(c15), "+v"(g));
        CkAddr K; K.lds = (unsigned)(uintptr_t)F.lds;
        K.v1t = K.lds + ((8 * w + (n >> 3)) * CK_LD + 8 * (n & 7)) * 2;
        K.vR0 = K.lds + ((8 * g + (c15 >> 2)) * CK_LD + 4 * (c15 & 3)) * 2;
        K.vX0 = K.lds + (c15 * CK_LD + 8 * g) * 2; K.vT0 = K.lds + (c15 * CK_LD + 4 * g) * 2;
        asm volatile("" : "+v"(K.v1t), "+v"(K.vX0), "+v"(K.vT0), "+v"(K.vR0));
        const int ti = w >> 1, tv = w & 1, tv2 = w >> 2, tk = w & 3;
        const unsigned pc = (unsigned)(c & 1), pn = pc ^ 1u;
        const unsigned oAL = O_AL + pc * CK_MAT, oBE = O_BE + pc * CK_MAT, oRH = O_RH + pc * CK_MAT, oAOFF = O_AOFF + pc * CK_MAT, oMB = O_MB + pc * CK_MAT, oSB = O_SB + pc * CK_HALF, oTD = CK_TD + pc * CK_TDSZ, oGL = CK_GL + pc * 256;
        const unsigned nAL = O_AL + pn * CK_MAT, nBE = O_BE + pn * CK_MAT, nRH = O_RH + pn * CK_MAT, nAOFF = O_AOFF + pn * CK_MAT, nMB = O_MB + pn * CK_MAT, nSB = O_SB + pn * CK_HALF, nTD = CK_TD + pn * CK_TDSZ, nGL = CK_GL + pn * 256;
        const bool skip_o = c < 0 || (last && c < CTXL / 64), skip_on = last && c + 1 < CTXL / 64;
        *CKP(v4u, K.v1t + nAL) = ual; *CKP(v4u, K.v1t + nBE) = ube; *CKP(v4u, K.v1t + O_KP) = ukp; *CKP(v4u, K.v1t + nRH) = urh; *CKP(v4u, K.v1t + O_V) = uv;
        if (w == 0) *CKP(float, K.lds + nGL + n * 4) = fgl;
        asm volatile("" ::: "memory");
        CK_FETCH(c + 2);
        { f32x4 yb = yb0; mm1<2, false, false>(yb, K, oAL, oSB, ti, tv); stT1(K, O_YZ, ti, tv, yb); }
        __syncthreads();
        if (w < 2) {
            const unsigned aX = K.lds + ((c15) * CK_LD + 8 * g) * 2;
            const unsigned bY = K.lds + ((16 * w + c15) * CK_LD + 8 * g) * 2;
            const unsigned cT = K.lds + ((16 * w + c15) * CK_LD + 4 * g) * 2;
#pragma unroll
            for (int blk = 0; blk < 4; ++blk) {
                f32x4 z = (f32x4){0.f, 0.f, 0.f, 0.f};
                if (blk > 0) {
#pragma unroll
                    for (int ks = 0; ks < (blk == 3 ? 2 : 1); ++ks) {
                        const bf16x8 a = *CKP(const bf16x8, aX + oAOFF + blk * (16 * CK_LD * 2) + 64 * ks);
                        const bf16x8 u = *CKP(const bf16x8, bY + O_UT + 64 * ks);
                        z = __builtin_amdgcn_mfma_f32_16x16x32_bf16(a, u, z, 0, 0, 0); }
                }
                { const v2u yv = *CKP(const v2u, cT + O_YZ + 32 * blk);
                  z[0] += __uint_as_float(yv.x << 16); z[1] += __uint_as_float(yv.x & 0xffff0000u); z[2] += __uint_as_float(yv.y << 16); z[3] += __uint_as_float(yv.y & 0xffff0000u); }
                { v2u zo; zo.x = pk2h(z[0], z[1]); zo.y = pk2h(z[2], z[3]); *CKP(v2u, cT + O_YZ + 32 * blk) = zo; }
                asm volatile("s_waitcnt lgkmcnt(0)" ::: "memory");
                const bf16x8 ta = *CKP(const bf16x8, K.lds + oTD + ((16 * blk + c15) * CK_TD_LD + 8 * g) * 2);
                const bf16x8 zb = *CKP(const bf16x8, bY + O_YZ + 32 * blk);
                f32x4 u = __builtin_amdgcn_mfma_f32_16x16x32_bf16(ta, zb, (f32x4){0.f, 0.f, 0.f, 0.f}, 0, 0, 0);
                { v2u uo; uo.x = pk2h(-u[0], -u[1]); uo.y = pk2h(-u[2], -u[3]); *CKP(v2u, cT + O_UT + 32 * blk) = uo; }
                asm volatile("s_waitcnt lgkmcnt(0)" ::: "memory");
            }
        } else if (w < 6) {
            const int bb = w - 2;
            f32x4 pa, pb, pm, pk; ck_tile4(K, bb, bb, nAL, nBE, nRH, pa, pb, pm, pk);
#pragma unroll
            for (int r = 0; r < 4; ++r) { const bool strict = 4 * g + r < c15, incl = 4 * g + r <= c15;
                pa[r] = strict ? pa[r] : 0.f; pb[r] = strict ? pb[r] : 0.f; pm[r] = incl ? pm[r] : 0.f; pk[r] = incl ? pk[r] : 0.f; }
            *CKP(f32x4, K.lds + CK_ADG + ((bb * 16 + c15) * 16 + 4 * g) * 4) = pa;
            stT1(K, O_BM, bb, bb, pb); stT1(K, nMB, bb, bb, pm); stT1(K, O_MK, bb, bb, pk);
            asm volatile("s_waitcnt lgkmcnt(0)" ::: "memory");
            if (n < 16) { float tcol[16];
                f32x4 arow[16][4];
#pragma unroll
                for (int r = 1; r < 16; ++r)
#pragma unroll
                    for (int s4 = 0; s4 * 4 < r; ++s4) arow[r][s4] = *CKP(const f32x4, K.lds + CK_ADG + ((bb * 16 + r) * 16 + 4 * s4) * 4);
#pragma unroll
                for (int r = 0; r < 16; ++r) { float acc = (r == n) ? 1.f : 0.f;
#pragma unroll
                    for (int s = 0; s < r; ++s) acc = fmaf(-arow[r][s >> 2][s & 3], tcol[s], acc);
                    tcol[r] = acc; *CKP(bf16, K.lds + nTD + ((16 * bb + r) * CK_TD_LD + n) * 2) = bf1(acc); }
            }
        } else {
#pragma unroll
            for (int q = 0; q < 3; ++q) {
                const int xt = (w & 1) ? (q == 0 ? 1 : 0) : (q == 0 ? 0 : q == 1 ? 2 : 1), yt = (w & 1) ? (q == 2 ? 3 : 2) : (q == 0 ? 1 : 3);
                f32x4 pa, pb, pm, pk; ck_tile4(K, xt, yt, nAL, nBE, nRH, pa, pb, pm, pk);
                stT1(K, nAOFF, xt, yt, pa); stT1(K, O_BM, xt, yt, pb); stT1(K, nMB, xt, yt, pm); stT1(K, O_MK, xt, yt, pk);
            }
        }
        __syncthreads();
        if (!skip_o) {
            f32x4 ob = ob0;
            mm1<2, false, false>(ob, K, oSB, oRH, tv, ti); mm1<2, false, false>(ob, K, O_UT, oMB, tv, ti);
            const int row = scan_row(d, b, 64 * c + 16 * ti + c15); v2u oo; oo.x = pk2h(ob[0], ob[1]); oo.y = pk2h(ob[2], ob[3]);
            *(v2u*)(O + (size_t)row * INP + h * 64 + 32 * vh + 16 * tv + 4 * g) = oo;
        }
        { mm1<2, true, false>(st, K, oBE, O_UT, tk, tv2);
          const f32x4 gl = *CKP(const f32x4, K.lds + oGL + (16 * tk + 4 * g) * 4); st = (st + st0) * gl; stT1(K, nSB, tk, tv2, st); }
        yb0 = (f32x4){0.f, 0.f, 0.f, 0.f}; ob0 = yb0; st0 = yb0;
        mm1<2, false, true>(yb0, K, O_BM, O_V, ti, 2 * vh + tv);
        if (!skip_on) mm1<2, true, false>(ob0, K, O_V, O_MK, 2 * vh + tv, ti);
        mm1<2, true, true>(st0, K, O_KP, O_V, tk, 2 * vh + tv2);
        __syncthreads();
    }
#undef CK_FETCH
}
#undef CKP

struct KeyStream { int ctx_row0, nloc, loc_row0, loc_pos0; };
constexpr int AT_KSZ = 9216, AT_VSZ = 9472, AT_KB = 0, AT_VB = 3 * AT_KSZ;
typedef float f32x4a __attribute__((ext_vector_type(4)));

typedef __bf16 bf16v2 __attribute__((ext_vector_type(2)));
__device__ __forceinline__ float dot2_ones(unsigned pair, float acc) { return __builtin_amdgcn_fdot2_f32_bf16(__builtin_bit_cast(bf16v2, pair), __builtin_bit_cast(bf16v2, 0x3f803f80u), acc, false); }
template <int NMAP, int DK, int QS, bool MASK, bool XT>
__device__ __forceinline__ void attn_core(Frame& F, const bf16* P, int kcol, int vcol, const KeyStream ks, const bf16x8 (&qf)[QS][NMAP][DK / 32], int qpos0,
                                          f32x4 (&o)[QS][NMAP][4], float (&m)[QS][NMAP], float (&lsum)[QS][NMAP]) {
    const int c15 = F.lane & 15, g = F.lane >> 4;
    const int lkey = F.tid >> 3, lch = F.tid & 7;
    const int ntiles = 4 + ks.nloc;
#pragma unroll
    for (int qs = 0; qs < QS; ++qs)
#pragma unroll
        for (int mp = 0; mp < NMAP; ++mp) { m[qs][mp] = 0.f; lsum[qs][mp] = 0.f;
#pragma unroll
            for (int dt = 0; dt < 4; ++dt) o[qs][mp][dt] = (f32x4){0.f, 0.f, 0.f, 0.f}; }
    v4u stgk, stgv; const unsigned lofs = (unsigned)(lkey * INP + 8 * lch) * 2u;
#define AT_ROW(ti) ((ti) < 4 ? ks.ctx_row0 + 64 * (ti) : ks.loc_row0 + 64 * ((ti) - 4))
#define AT_LOADK(ti) do { const int t_ = (ti) < ntiles ? (ti) : ntiles - 1; unsigned long long pb_ = (unsigned long long)(uintptr_t)(P + (size_t)AT_ROW(t_) * INP + kcol); asm volatile("" : "+s"(pb_)); stgk = *(const GAS v4u*)(uintptr_t)(pb_ + lofs); } while (0)
#define AT_LOADV(ti) do { const int t_ = (ti) < ntiles ? (ti) : ntiles - 1; unsigned long long pb_ = (unsigned long long)(uintptr_t)(P + (size_t)AT_ROW(t_) * INP + vcol); asm volatile("" : "+s"(pb_)); stgv = *(const GAS v4u*)(uintptr_t)(pb_ + lofs); } while (0)
#define AT_WRITEK(kb_) do { *(LAS v4u*)(F.lds + (kb_) + lkey * 144 + lch * 16) = stgk; } while (0)
#define AT_WRITEV(vb_) do { _Pragma("unroll") for (int i_ = 0; i_ < 8; ++i_) { const unsigned w_ = stgv[i_ >> 1]; \
        *(LAS bf16*)(F.lds + (vb_) + (8 * lch + i_) * 144 + 16 * lch + lkey * 2) = (bf16)((i_ & 1) ? (w_ >> 16) : (w_ & 0xffffu)); } } while (0)
#define AT_QK(dst, kb_, sx_) do { bf16x8 kf_[2][NMAP][DK / 32]; \
        _Pragma("unroll") for (int kh = 0; kh < 2; ++kh) _Pragma("unroll") for (int mp = 0; mp < NMAP; ++mp) _Pragma("unroll") for (int kx = 0; kx < DK / 32; ++kx) \
            kf_[kh][mp][kx] = *(LAS bf16x8*)(F.lds + (kb_) + (32 * (sx_) + 16 * kh + c15) * 144 + (mp * DK + 32 * kx + 8 * g) * 2); \
        _Pragma("unroll") for (int qs = 0; qs < QS; ++qs) _Pragma("unroll") for (int mp = 0; mp < NMAP; ++mp) { const float negm = -m[qs][mp]; \
            _Pragma("unroll") for (int kh = 0; kh < 2; ++kh) { dst[qs][mp][kh] = (f32x4){negm, negm, negm, negm}; \
                _Pragma("unroll") for (int kx = 0; kx < DK / 32; ++kx) dst[qs][mp][kh] = __builtin_amdgcn_mfma_f32_16x16x32_bf16(kf_[kh][mp][kx], qf[qs][mp][kx], dst[qs][mp][kh], 0, 0, 0); } } } while (0)
#define AT_MASK(dst, ti_, sx_) do { if (MASK && (ti_) >= 4) { const int kb_ = ks.loc_pos0 + 64 * ((ti_) - 4) + 32 * (sx_); \
        if (kb_ + 31 - qpos0 > 128 || kb_ - (qpos0 + 16 * QS - 1) < -128) {       \
            _Pragma("unroll") for (int qs = 0; qs < QS; ++qs) { const int qp_ = qpos0 + 16 * qs + c15; \
                _Pragma("unroll") for (int mp = 0; mp < NMAP; ++mp) _Pragma("unroll") for (int kh = 0; kh < 2; ++kh) _Pragma("unroll") for (int r = 0; r < 4; ++r) { \
                    const int dd_ = kb_ + 4 * g + 16 * kh + r - qp_; dst[qs][mp][kh][r] = (dd_ > 128 || dd_ < -128) ? -INFINITY : dst[qs][mp][kh][r]; } } } } } while (0)
    __syncthreads();
    AT_LOADK(0); AT_WRITEK(AT_KB); AT_LOADV(0); AT_WRITEV(AT_VB); AT_LOADK(1); AT_WRITEK(AT_KB + AT_KSZ); AT_LOADV(1);
    __syncthreads();
    f32x4 st[QS][NMAP][2], sn[QS][NMAP][2];
    if (XT) AT_QK(st, AT_KB, 0);
    unsigned kcur = AT_KB, knxt = AT_KB + AT_KSZ, kfar = AT_KB + 2 * AT_KSZ;
    for (int ti = 0; ti < ntiles; ++ti) {
        const unsigned vcur = AT_VB + (ti & 1) * AT_VSZ, vnxt = AT_VB + ((ti + 1) & 1) * AT_VSZ;
        if (!XT) AT_QK(st, kcur, 0);
#pragma unroll
        for (int sx = 0; sx < 2; ++sx) {
        if (sx == 0) AT_QK(sn, kcur, 1); else if (XT) AT_QK(sn, knxt, 0);
        if (sx == 0) AT_LOADK(ti + 2); else AT_LOADV(ti + 2);
        bf16x8 vf[4];
#pragma unroll
        for (int dt = 0; dt < 4; ++dt) { const v2u a = *(LAS v2u*)(F.lds + vcur + (c15 + 16 * dt) * 144 + 16 * (2 * dt + (c15 >> 3)) + (32 * sx + 4 * g) * 2), b2 = *(LAS v2u*)(F.lds + vcur + (c15 + 16 * dt) * 144 + 16 * (2 * dt + (c15 >> 3)) + (32 * sx + 16 + 4 * g) * 2);
            const v4u w = (v4u){a.x, a.y, b2.x, b2.y}; vf[dt] = __builtin_bit_cast(bf16x8, w); }
        v4u pw[QS][NMAP]; float ps[QS][NMAP];
        AT_MASK(st, ti, sx);
        float big = 0.f;
#pragma unroll
        for (int qs = 0; qs < QS; ++qs)
#pragma unroll
            for (int mp = 0; mp < NMAP; ++mp) { float e[8];
#pragma unroll
                for (int kh = 0; kh < 2; ++kh)
#pragma unroll
                    for (int r = 0; r < 4; ++r) e[kh * 4 + r] = __builtin_amdgcn_exp2f(st[qs][mp][kh][r]);
                pw[qs][mp] = (v4u){pk2h(e[0], e[1]), pk2h(e[2], e[3]), pk2h(e[4], e[5]), pk2h(e[6], e[7])};
                const float s_ = dot2_ones(pw[qs][mp].w, dot2_ones(pw[qs][mp].z, dot2_ones(pw[qs][mp].y, dot2_ones(pw[qs][mp].x, 0.f))));
                ps[qs][mp] = s_; big = fmaxf(big, s_); }
        if (__builtin_amdgcn_ballot_w64(!(big < 1048576.0f)) != 0ull) {
            f32x4 sr[QS][NMAP][2];
            AT_QK(sr, kcur, sx); AT_MASK(sr, ti, sx);
#pragma unroll
            for (int qs = 0; qs < QS; ++qs)
#pragma unroll
                for (int mp = 0; mp < NMAP; ++mp) {
                    float mt = fmaxf(fmaxf(fmaxf(sr[qs][mp][0][0], sr[qs][mp][0][1]), fmaxf(sr[qs][mp][0][2], sr[qs][mp][0][3])), fmaxf(fmaxf(sr[qs][mp][1][0], sr[qs][mp][1][1]), fmaxf(sr[qs][mp][1][2], sr[qs][mp][1][3])));
                    mt = xmax4(mt);
                    const float delta = mt > 8.0f ? mt : 0.f, alpha = __builtin_amdgcn_exp2f(-delta);
                    m[qs][mp] += delta; lsum[qs][mp] *= alpha;
#pragma unroll
                    for (int dt = 0; dt < 4; ++dt) o[qs][mp][dt] = o[qs][mp][dt] * alpha;
                    if (sx == 0 || XT) {
#pragma unroll
                        for (int kh = 0; kh < 2; ++kh) sn[qs][mp][kh] = sn[qs][mp][kh] - delta; }
                    float e[8];
#pragma unroll
                    for (int kh = 0; kh < 2; ++kh)
#pragma unroll
                        for (int r = 0; r < 4; ++r) e[kh * 4 + r] = __builtin_amdgcn_exp2f(sr[qs][mp][kh][r] - delta);
                    pw[qs][mp] = (v4u){pk2h(e[0], e[1]), pk2h(e[2], e[3]), pk2h(e[4], e[5]), pk2h(e[6], e[7])};
                    ps[qs][mp] = dot2_ones(pw[qs][mp].w, dot2_ones(pw[qs][mp].z, dot2_ones(pw[qs][mp].y, dot2_ones(pw[qs][mp].x, 0.f))));
                }
        }
#pragma unroll
        for (int qs = 0; qs < QS; ++qs)
#pragma unroll
            for (int mp = 0; mp < NMAP; ++mp) {
                lsum[qs][mp] += ps[qs][mp];
                const bf16x8 pf = __builtin_bit_cast(bf16x8, pw[qs][mp]);
#pragma unroll
                for (int dt = 0; dt < 4; ++dt) o[qs][mp][dt] = __builtin_amdgcn_mfma_f32_16x16x32_bf16(vf[dt], pf, o[qs][mp][dt], 0, 0, 0);
            }
        if (sx == 0 || XT) {
#pragma unroll
            for (int qs = 0; qs < QS; ++qs)
#pragma unroll
                for (int mp = 0; mp < NMAP; ++mp) { st[qs][mp][0] = sn[qs][mp][0]; st[qs][mp][1] = sn[qs][mp][1]; } }
        if (sx == 0) AT_WRITEV(vnxt); else AT_WRITEK(kfar);
        }
        { const unsigned t_ = kcur; kcur = knxt; knxt = kfar; kfar = t_; }
        __syncthreads();
    }
#undef AT_QK
#undef AT_MASK
#undef AT_ROW
#undef AT_LOADK
#undef AT_LOADV
#undef AT_WRITEK
#undef AT_WRITEV
}

template <int QS>
__device__ __forceinline__ void diff_unit(const Args& A, Frame& F, int l, int b, int h, int qrow0, int nloc) {
    const bf16* P = (const bf16*)(kws() + WS_RP); bf16* Y = (bf16*)(kws() + WS_XN); const float* tab = (const float*)(kws() + WS_TAB);
    const int c15 = F.lane & 15, g = F.lane >> 4;
    bf16x8 qf[QS][2][1];
#pragma unroll
    for (int qs = 0; qs < QS; ++qs)
#pragma unroll
        for (int mp = 0; mp < 2; ++mp) qf[qs][mp][0] = *(const bf16x8*)(P + (size_t)(qrow0 + 16 * QS * F.wave + 16 * qs + c15) * INP + C_DFQ + h * 64 + mp * 32 + 8 * g);
    f32x4 o[QS][2][4]; float m[QS][2], ls[QS][2];
    const KeyStream ks{MLAT + b * CTXL, nloc, b * SEQ, 0};
    attn_core<2, 32, QS, false, true>(F, P, C_DFK + h * 64, C_DFV + h * 64, ks, qf, 0, o, m, ls);
    const float lam = tab[3072 + l], oscale = 1.0f - tab[3074 + l];
    const float* ng = kin(I_DFNG) + l * 64;
#pragma unroll
    for (int qs = 0; qs < QS; ++qs) {
        float inv[2];
#pragma unroll
        for (int mp = 0; mp < 2; ++mp) { float t = ls[qs][mp]; t += __shfl_xor(t, 16); t += __shfl_xor(t, 32); inv[mp] = 1.0f / t; }
        f32x4 ov[4]; float ss = 0.f;
#pragma unroll
        for (int dt = 0; dt < 4; ++dt) { ov[dt] = o[qs][0][dt] * inv[0] - o[qs][1][dt] * (lam * inv[1]); ss += (ov[dt][0] * ov[dt][0] + ov[dt][1] * ov[dt][1]) + (ov[dt][2] * ov[dt][2] + ov[dt][3] * ov[dt][3]); }
        ss += __shfl_xor(ss, 16); ss += __shfl_xor(ss, 32);
        const float r = rsqrtf(ss * (1.0f / 64.0f) + NORM_EPS) * oscale;
        bf16* yp = Y + (size_t)(qrow0 + 16 * QS * F.wave + 16 * qs + c15) * D + 256 + h * 64 + 4 * g;
#pragma unroll
        for (int dt = 0; dt < 4; ++dt) { const f32x4 gg = *(const f32x4*)(ng + 16 * dt + 4 * g); const f32x4 v = ov[dt] * r * gg;
            v2u w; w.x = pk2h(v[0], v[1]); w.y = pk2h(v[2], v[3]); *(v2u*)(yp + 16 * dt) = w; }
    }
}
__device__ __forceinline__ void gq_unit(const Args& A, Frame& F, int l, int b, int kv, int qrow0, int qpos_blk  ) {
    const bf16* P = (const bf16*)(kws() + WS_RP); bf16* Y = (bf16*)(kws() + WS_XN);
    const int c15 = F.lane & 15, g = F.lane >> 4;
    const int hq = kv * 4 + (F.wave >> 1), rbase = qrow0 + 64 * (F.wave & 1);
    bf16x8 qf[4][1][2];
#pragma unroll
    for (int qs = 0; qs < 4; ++qs)
#pragma unroll
        for (int kx = 0; kx < 2; ++kx) qf[qs][0][kx] = *(const bf16x8*)(P + (size_t)(rbase + 16 * qs + c15) * INP + C_GQQ + hq * 64 + 32 * kx + 8 * g);
    KeyStream ks{MLAT + b * CTXL, 0, 0, 0}; int qpos0 = 0;
    if (qpos_blk >= 0) { const int lo = qpos_blk > 0 ? (qpos_blk - 1) * 128 : 0, hi = qpos_blk < 31 ? (qpos_blk + 2) * 128 : SEQ;
        ks.nloc = (hi - lo) / 64; ks.loc_row0 = b * SEQ + lo; ks.loc_pos0 = lo; qpos0 = qpos_blk * 128 + 64 * (F.wave & 1); }
    f32x4 o[4][1][4]; float m[4][1], ls[4][1];
    attn_core<1, 64, 4, true, false>(F, P, C_GQK + kv * 64, C_GQV + kv * 64, ks, qf, qpos0, o, m, ls);
    const float sink2 = kin(I_GQSINK)[l * 8 + hq] * LOG2E;
#pragma unroll
    for (int qs = 0; qs < 4; ++qs) {
        float t = ls[qs][0]; t += __shfl_xor(t, 16); t += __shfl_xor(t, 32);
        const float mf = fmaxf(m[qs][0], sink2), e = __builtin_amdgcn_exp2f(m[qs][0] - mf), den = t * e + __builtin_amdgcn_exp2f(sink2 - mf), scl = e / den;
        bf16* yp = Y + (size_t)(rbase + 16 * qs + c15) * D + 512 + hq * 64 + 4 * g;
#pragma unroll
        for (int dt = 0; dt < 4; ++dt) { const f32x4 v = o[qs][0][dt] * scl; v2u w; w.x = pk2h(v[0], v[1]); w.y = pk2h(v[2], v[3]); *(v2u*)(yp + 16 * dt) = w; }
    }
}
__device__ __forceinline__ void phase_queue(const Args& A, Frame& F, int l, int rep) {
    gu32* head = (gu32*)(kws() + WS_CTL) + CW_QUEUE + 64 * l + 16 * rep;
    constexpr int DF_BIG = 256;
    const int total = 64 + DF_BIG + 2 * (256 - DF_BIG) + 256 + (l == 0 ? 48 + WI_FILL : 0);
    volatile LAS int* slot = (volatile LAS int*)(F.lds + MISC_OFF) + 16;
    for (;;) {
        asm volatile("" : "+v"(F.tid), "+v"(F.lane));
        __syncthreads();
        if (F.tid == 0) *slot = (int)__hip_atomic_fetch_add(head, 1u, __ATOMIC_RELAXED, __HIP_MEMORY_SCOPE_AGENT);
        __syncthreads();
        int u = __builtin_amdgcn_readfirstlane(*slot);
        if (u >= total) break;
#if MK_AMP & 1
        if (u < 64) { const unsigned long long t0_ = __builtin_amdgcn_s_memrealtime(); rwkv_chunk_unit(A, F, l, u >> 1, u & 1); const unsigned long long t1_ = __builtin_amdgcn_s_memrealtime();
            while (__builtin_amdgcn_s_memrealtime() - t1_ < t1_ - t0_) __builtin_amdgcn_s_sleep(8); continue; }
#endif
        if (u < 64) { rwkv_chunk_unit(A, F, l, u >> 1, u & 1); continue; }
        u -= 64;
#if MK_AMP & 2
        if (u < DF_BIG) { const unsigned long long t0_ = __builtin_amdgcn_s_memrealtime(); { const int b = u >> 6, h = (u >> 4) & 3, qb = u & 15; diff_unit<2>(A, F, l, b, h, b * SEQ + qb * 256, SEQ / 64); } const unsigned long long t1_ = __builtin_amdgcn_s_memrealtime();
            while (__builtin_amdgcn_s_memrealtime() - t1_ < t1_ - t0_) __builtin_amdgcn_s_sleep(8); continue; }
#endif
        if (u < DF_BIG) { const int b = u >> 6, h = (u >> 4) & 3, qb = u & 15; diff_unit<2>(A, F, l, b, h, b * SEQ + qb * 256, SEQ / 64); continue; }
        if (u < DF_BIG + 2 * (256 - DF_BIG)) { const int v = 2 * DF_BIG + (u - DF_BIG), b = v >> 7, h = (v >> 5) & 3, qh = v & 31; diff_unit<1>(A, F, l, b, h, b * SEQ + qh * 128, SEQ / 64); continue; }
        u -= DF_BIG + 2 * (256 - DF_BIG) - 512;
        u -= 512;
        if (u < 256) { const int b = u >> 6, kv = (u >> 5) & 1, nb = u & 31; gq_unit(A, F, l, b, kv, b * SEQ + nb * 128, nb); continue; }
        u -= 256;
        if (u < 32) { const int b = u >> 3, h = (u >> 1) & 3, hf = u & 1; diff_unit<1>(A, F, l, b, h, MLAT + b * CTXL + hf * 128, 0); continue; }
        u -= 32;
        if (u < 16) { const int b = u >> 2, kv = (u >> 1) & 1, hf = u & 1; gq_unit(A, F, l, b, kv, MLAT + b * CTXL + hf * 128, -1); continue; }
        u -= 16;
        { LAS float* scr = (LAS float*)(F.lds + F.wave * 16384);
          for (int k = 0; k < 16; ++k) { const int it = WI_IN + u * 128 + F.wave * 16 + k; if (it < 2 * WI_LAYER) weight_item(it, scr, F.lane); } }
    }
}

constexpr int N_PHASES = (MK_FUSE == 3) ? 18 : 20;
}

__global__ void __launch_bounds__(mk::NTHR, 2) mega_fwd(mk::Args A) {
    using namespace mk;
    extern __shared__ __attribute__((aligned(16))) unsigned char lds_raw[];
    Frame F;
    F.lds = (LAS unsigned char*)lds_raw;
    F.tid = threadIdx.x; asm volatile("" : "+v"(F.tid)); F.lane = F.tid & 63; F.wave = __builtin_amdgcn_readfirstlane(F.tid >> 6);
    F.G = gridDim.x; F.bid = blockIdx.x;
    for (int u = F.tid; u < (LDS_BYTES - LDSCTL_OFF) / 4; u += NTHR) ((LAS unsigned*)(F.lds + LDSCTL_OFF))[u] = 0u;
    __syncthreads();
    gu32* ctl = (gu32*)(kws() + WS_CTL);
    XcdBarrier bar; bar.bar = (unsigned*)(ctl + CW_BAR); bar.x = 0; bar.st = nullptr; bar.tid = F.tid;
    const bool multi = (A.ph_hi - A.ph_lo) > 1;
    if (multi) bar = xcd_barrier_post((unsigned*)(ctl + CW_BAR), (volatile LAS unsigned*)(F.lds + MISC_OFF) + 8, F.tid);

    for (int ph = A.ph_lo, rep = 0; ph < A.ph_hi;) {
        { int t_ = F.tid, l_ = F.lane, w_ = F.wave, g_ = F.G, b_ = F.bid; unsigned p_ = (unsigned)(uintptr_t)F.lds;
          w_ = __builtin_amdgcn_readfirstlane(w_); g_ = __builtin_amdgcn_readfirstlane(g_); b_ = __builtin_amdgcn_readfirstlane(b_); p_ = __builtin_amdgcn_readfirstlane(p_);
          asm volatile("" : "+v"(t_), "+v"(l_)); asm volatile("" : "+s"(w_), "+s"(g_), "+s"(b_), "+s"(p_));
          F.tid = t_; F.lane = l_; F.wave = w_; F.G = g_; F.bid = b_; F.lds = (LAS unsigned char*)(uintptr_t)p_; }
        int kind = 0, l = 0, hf = 0;
        if (ph == 1) kind = 1;
        else if (ph > 1 && ph < 11) { l = 0; const int r = ph - 2; kind = r < 6 ? 2 + r : (r == 6 ? 8 : (r == 7 ? 10 : 11)); }
        else if (ph >= 11) { l = 1; const int r = ph - 11; kind = r < 5 ? 2 + r : (r == 5 ? 8 : 10); }
        const int nrows = (l == 0) ? MALL : MLAT;
        const int r0 = 0, r1 = nrows; (void)hf;
        const bool is_gemm = (kind == 2 || kind == 6 || kind == 8 || kind == 10);
        if (is_gemm) { if (MK_KINDS & 0x544) {
          const int nparts = ((kind == 6 || kind == 10) && l == 0) ? 2 : 1;
          for (int part = 0; part < nparts; ++part) {
            pg8::Gemm g; EpiMulti E; E.tab = (const float*)(kws() + WS_TAB); E.ob = nullptr; E.of = nullptr; E.ld = 0; E.mode = 0; E.cw = nullptr; E.cb = nullptr; E.nrows = 0; E.ldsx = 0u; E.xin = nullptr; E.xout = nullptr; E.xn = nullptr; E.xinb = nullptr; E.xoutb = nullptr; E.gA = E.gaA = E.gB = E.scB = E.shB = nullptr; E.xb0 = E.xb1 = nullptr; E.cnt0 = E.cnt1 = nullptr; E.two = 0;
            if (kind == 2) { g = pg8::Gemm{(const pg8::bf16_t*)(kws() + WS_XN), (const pg8::bf16_t*)(kws() + WS_WIN + l * WIN_BYTES), MALL, INP, D, 256, D, 0}; E.mode = 0; E.ob = (bf16*)(kws() + WS_RP); E.ld = INP; }
            else if (kind == 6 && part == 0 && !(MK_FUSE & 1)) { g = pg8::Gemm{(const pg8::bf16_t*)(kws() + WS_XN), (const pg8::bf16_t*)(kws() + WS_WOUT + l * WOUT_BYTES), MLAT, D, D, 256, D, 0}; E.mode = 2; E.ob = (bf16*)(kws() + WS_RP); E.ld = D; }
            else if (kind == 6 && part == 0) { g = pg8::Gemm{(const pg8::bf16_t*)(kws() + WS_XN), (const pg8::bf16_t*)(kws() + WS_WOUT + l * WOUT_BYTES), MLAT, D, D, 256, D, 0};
                E.mode = 5; E.xin = l == 0 ? kin(I_X) : kout(); E.xinb = nullptr; E.xout = nullptr; E.xoutb = (bf16*)(kws() + WS_XR); E.xn = (bf16*)(kws() + WS_XN); E.gA = normg_vec(A, l, 1); E.gaA = mod_vec(A, l, 0, 2); E.two = 1; E.gB = normg_vec(A, l, 2); E.scB = mod_vec(A, l, 0, 4); E.shB = mod_vec(A, l, 0, 3);
                E.xb0 = (float*)(kws() + WS_XB) + (size_t)((l * 2 + 0) * 2 + 0) * MLAT * 4; E.xb1 = (float*)(kws() + WS_XB) + (size_t)((l * 2 + 0) * 2 + 1) * MLAT * 4;
                E.cnt0 = (gu32*)(kws() + WS_CTL) + CW_PST + ((l * 2 + 0) * 2 + 0) * 4096; E.cnt1 = (gu32*)(kws() + WS_CTL) + CW_PST + ((l * 2 + 0) * 2 + 1) * 4096; }
            else if (kind == 6) { g = pg8::Gemm{(const pg8::bf16_t*)(kws() + WS_XN) + (size_t)MLAT * D, (const pg8::bf16_t*)(kws() + WS_WOUT + l * WOUT_BYTES), 256 * 4 * 4, D, 256, 256, D, 4}; E.mode = 2; E.ob = (bf16*)(kws() + WS_SLO); E.ld = D; }
            else if (kind == 8) { const int nmu = (nrows + 253) / 254;
                g = pg8::Gemm{(const pg8::bf16_t*)(kws() + WS_XN) - D, (const pg8::bf16_t*)(kws() + WS_WGU + l * WGU_BYTES), 256 * nmu, NGU, D, 254, D, 0};
                E.mode = 3; E.ob = (bf16*)(kws() + WS_ACT); E.ld = DFF; E.cw = kin(I_FFCW) + (size_t)l * 3 * DFF; E.cb = kin(I_FFCB) + (size_t)l * DFF; E.nrows = nrows; E.ldsx = (unsigned)(uintptr_t)F.lds + 131072u; }
            else if (part == 0 && !(MK_FUSE & 2)) { g = pg8::Gemm{(const pg8::bf16_t*)(kws() + WS_ACT), (const pg8::bf16_t*)(kws() + WS_WD + l * WD_BYTES), MLAT, D, DFF, 256, DFF, 0}; E.mode = 2; E.ob = (bf16*)(kws() + WS_FP); E.ld = D; }
            else if (part == 0) { g = pg8::Gemm{(const pg8::bf16_t*)(kws() + WS_ACT), (const pg8::bf16_t*)(kws() + WS_WD + l * WD_BYTES), MLAT, D, DFF, 256, DFF, 0};
                E.mode = 6; E.xin = nullptr; E.xinb = (const bf16*)(kws() + WS_XR); E.xout = kout(); E.xoutb = nullptr; E.xn = (bf16*)(kws() + WS_XN); E.gA = normg_vec(A, l, 3); E.gaA = mod_vec(A, l, 0, 5); E.two = l == 0; E.gB = normg_vec(A, 1, 0); E.scB = mod_vec(A, 1, 0, 1); E.shB = mod_vec(A, 1, 0, 0);
                E.xb0 = (float*)(kws() + WS_XB) + (size_t)((l * 2 + 1) * 2 + 0) * MLAT * 4; E.xb1 = (float*)(kws() + WS_XB) + (size_t)((l * 2 + 1) * 2 + 1) * MLAT * 4;
                E.cnt0 = (gu32*)(kws() + WS_CTL) + CW_PST + ((l * 2 + 1) * 2 + 0) * 4096; E.cnt1 = (gu32*)(kws() + WS_CTL) + CW_PST + ((l * 2 + 1) * 2 + 1) * 4096; }
            else { g = pg8::Gemm{(const pg8::bf16_t*)(kws() + WS_ACT) + (size_t)MLAT * DFF, (const pg8::bf16_t*)(kws() + WS_WD + l * WD_BYTES), 256 * 4 * 11, D, 256, 256, DFF, 4}; E.mode = 2; E.ob = (bf16*)(kws() + WS_SLD); E.ld = D; }
            pg8::StaticOrder S; S.init(g.M, g.N, F.G, F.bid);
            pg8::gemm_phase<EpiMulti, pg8::StaticOrder, true, true>(F.lds, g, S, E, F.tid);
          }
        } } else {
            switch (kind) {
                case 0: if ((MK_KINDS >> 0) & 1) { p0_prologue(A, F); } break;
                case 1: if (((MK_KINDS >> 1) & 1) && l == 0) phase_prep(A, F); break;
                case 3: if ((MK_KINDS >> 3) & 1) rwkv_features(A, F, l); break;
                case 4: if ((MK_KINDS >> 4) & 1) phase_queue(A, F, l, rep); break;
                case 5: if ((MK_KINDS >> 5) & 1) rwkv_readout(A, F, l); break;
                case 7: if ((MK_KINDS >> 7) & 1) phase_e1(A, F, l); break;
                case 9: if ((MK_KINDS >> 9) & 1) phase_act(A, F, l, r0, r1); break;
                case 11: if ((MK_KINDS >> 11) & 1) phase_e2(A, F, l, r0, r1); break;
                default: break;
            }
        }
        const bool again = (rep == 0) && ((MK_REPEAT >> kind) & 1);
        if (ph + 1 < A.ph_hi || again) { bar.bar = (unsigned*)((gu32*)(kws() + WS_CTL) + CW_BAR); bar.tid = F.tid; xcd_barrier(bar); }
        if (again) rep = 1; else { rep = 0; ++ph; }
    }
}

extern "C" void kernel_launch(void* const* d_in, const int* in_sizes, int n_in, void* d_out, int out_size, void* d_ws, size_t ws_size, hipStream_t stream) {
    using namespace mk;
    static int grid = 0;
    if (grid == 0) {
        if (n_in != N_IN || out_size != MLAT * D || ws_size < WS_END) { fprintf(stderr, "kernel_launch: unexpected shapes (n_in %d, out %d, ws %zu); nothing launched\n", n_in, out_size, ws_size); grid = -1; return; }
        int dev = 0, cus = 0, per_cu = 0;
        if (hipGetDevice(&dev) != hipSuccess || hipDeviceGetAttribute(&cus, hipDeviceAttributeMultiprocessorCount, dev) != hipSuccess) { grid = -1; return; }
        if (hipFuncSetAttribute((const void*)mega_fwd, hipFuncAttributeMaxDynamicSharedMemorySize, LDS_BYTES) != hipSuccess) { fprintf(stderr, "kernel_launch: hipFuncSetAttribute failed\n"); grid = -1; return; }
        if (hipOccupancyMaxActiveBlocksPerMultiprocessor(&per_cu, (const void*)mega_fwd, NTHR, LDS_BYTES) != hipSuccess || per_cu < 1) { fprintf(stderr, "kernel_launch: occupancy query says %d blocks/CU\n", per_cu); per_cu = 1; }
        (void)hipGetLastError();
        grid = cus;
    }
    if (grid < 0) return;
    (void)hipMemsetAsync((char*)d_ws + WS_CTL, 0, CTL_ZERO_BYTES, stream);
    Args a{};
    for (int i = 0; i < N_IN; ++i) a.in[i] = (const float*)d_in[i];
    a.out = (float*)d_out; a.ws = (unsigned char*)d_ws;
#if MK_PER_PHASE
    for (int ph = 0; ph < N_PHASES; ++ph) { a.ph_lo = ph; a.ph_hi = ph + 1; hipLaunchKernelGGL(mega_fwd, dim3(grid), dim3(NTHR), LDS_BYTES, stream, a); }
#else
    a.ph_lo = 0; a.ph_hi = N_PHASES;
    void* args[] = {&a};
    hipError_t e = hipLaunchCooperativeKernel((const void*)mega_fwd, dim3(grid), dim3(NTHR), args, LDS_BYTES, stream);
    if (e != hipSuccess) fprintf(stderr, "kernel_launch: cooperative launch failed: %s (grid %d)\n", hipGetErrorString(e), grid);
#endif
}
```

```cpp
#include <hip/hip_runtime.h>
#include <hip/hip_cooperative_groups.h>
#include <cstdio>
#include <cstdint>
#ifndef MK_PER_PHASE
#define MK_PER_PHASE 0
#endif
#ifndef MK_KINDS
#define MK_KINDS 0xFFF
#endif
#ifndef MK_REPEAT
#define MK_REPEAT 0
#endif
#ifndef MK_RWDUP
#define MK_RWDUP 0
#endif
#ifndef MK_AMP
#define MK_AMP 0
#endif
#ifndef MK_FTDUP
#define MK_FTDUP 0
#endif
#ifndef MK_FUSE
#define MK_FUSE 3
#endif
#ifdef MK_DBGDRAIN
#define MK_DBGD 1
#else
#define MK_DBGD 0
#endif
namespace pg8 {
#define PG8_LAS __attribute__((address_space(3)))
typedef unsigned short bf16_t;
typedef short bf16x8 __attribute__((ext_vector_type(8)));
typedef float f32x4 __attribute__((ext_vector_type(4)));
typedef unsigned u32x4 __attribute__((ext_vector_type(4)));
constexpr int BM = 256, BK = 64, HALF = 128, HTB = HALF * BK * 2  , STAGE_BYTES = 8 * HTB, NXCD = 8, WGM = 8;

__host__ __device__ __forceinline__ int lds_byte(int r, int c) { const int st = (r >> 4) * 2 + (c >> 5), rr = r & 15, cc = c & 31, ob = rr * 64 + cc * 2; return st * 1024 + (ob ^ (((ob >> 9) & 1) << 5)); }
__host__ __device__ __forceinline__ void stage_rc(int b, int& R, int& C) { const int st = b / 1024, sb = b % 1024, swz = sb ^ (((sb >> 9) & 1) << 5); R = (st >> 1) * 16 + swz / 64; C = (st & 1) * 32 + (swz % 64) / 2; }
__host__ __device__ __forceinline__ int perm32(int rho) { const int n = rho >> 4, i = rho & 15; return 8 * (i >> 2) + 4 * n + (i & 3); }

__device__ __forceinline__ float pg8_zero() { float z = 0.f; asm volatile("" : "+v"(z)); return z; }
struct Unit { int pm, pn; };
struct Gemm { const bf16_t* A; const bf16_t* Bt; int M, N, K; int trows; int ld, mt; };

struct StaticOrder {
    int nM, nN, nwg, G, c;
    __host__ __device__ void init(int M, int N, int G_, int c_) { nM = M / BM; nN = N / BM; nwg = nM * nN; G = G_; c = c_; }
    __host__ __device__ bool next(int i, Unit& u) const {
        const long L = (long)i * G + c; if (L >= nwg) return false;
        int wgid = (int)L; { const int q = nwg / NXCD, r = nwg % NXCD, xcd = wgid % NXCD, off = wgid / NXCD; wgid = (xcd < r ? xcd * (q + 1) : r * (q + 1) + (xcd - r) * q) + off; }
        const int nig = WGM * nN, gid = wgid / nig, fm = gid * WGM, gsz = (nM - fm) < WGM ? (nM - fm) : WGM;
        u.pm = fm + ((wgid % nig) % gsz); u.pn = (wgid % nig) / gsz; return true;
    }
    __device__ __forceinline__ void a_ready(const Unit&) const {}
    __device__ __forceinline__ void done(const Unit&) const {}
};

__device__ __forceinline__ unsigned cvt_pk_bf16(float lo, float hi) { unsigned r; asm volatile("v_cvt_pk_bf16_f32 %0, %1, %2" : "=v"(r) : "v"(lo), "v"(hi)); return r; }
typedef float f32x2 __attribute__((ext_vector_type(2)));
__device__ __forceinline__ f32x2 gelu_pk(f32x2 v) {
    const f32x2 av = __builtin_elementwise_abs(v), d = av * 0.2316418882f + 1.0f;
    f32x2 t; t.x = __builtin_amdgcn_rcpf(d.x); t.y = __builtin_amdgcn_rcpf(d.y);
    f32x2 q = t * 0.5307027145f + (-0.7265760135f); q = q * t + 0.7107068705f; q = q * t + (-0.142248368f); q = q * t + 0.127414796f; q = q * t;
    const f32x2 s = (v * v) * (-0.72134752044f);
    f32x2 e; e.x = __builtin_amdgcn_exp2f(s.x); e.y = __builtin_amdgcn_exp2f(s.y);
    const f32x2 m = v * (q * e), r = v - m;
    f32x2 o; o.x = v.x < 0.f ? m.x : r.x; o.y = v.y < 0.f ? m.y : r.y; return o;
}

template <int ACT  > struct EpiBf16 {
    static constexpr bool PERM = true, AFTER_DRAIN = false; static_assert(ACT == 0 || ACT == 1, "EpiBf16: ACT is 0 (none) or 1 (gelu_pk)");
    bf16_t* O; int ldc; const float* bias; int split_cols; size_t split_stride; float scale0;
    __device__ __forceinline__ void operator()(const f32x4 (&acc)[2][2][4][2], const Unit& u, int wr, int wc, int fr, int fq) const {
        const int row0 = u.pm * BM + wr * 64 + fr; int colt = u.pn * BM; bf16_t* base = O;
        float sc = 1.f; if (split_cols) { const int t = colt / split_cols; base += (size_t)t * split_stride; colt -= t * split_cols; if (t == 0) sc = scale0; }
        const int col0 = colt + wc * 32 + 8 * fq, bcol0 = u.pn * BM + wc * 32 + 8 * fq;
        f32x4 bv[2][2];
#pragma unroll
        for (int bj = 0; bj < 2; ++bj)
#pragma unroll
            for (int n = 0; n < 2; ++n) bv[bj][n] = bias ? *(const f32x4*)(bias + bcol0 + bj * HALF + 4 * n) : (f32x4){0.f, 0.f, 0.f, 0.f};
#pragma unroll
        for (int ai = 0; ai < 2; ++ai)
#pragma unroll
            for (int m = 0; m < 4; ++m) { bf16_t* rowp = base + (size_t)(row0 + ai * HALF + m * 16) * ldc + col0;
#pragma unroll
                for (int bj = 0; bj < 2; ++bj) { f32x4 v0 = acc[ai][bj][m][0] + bv[bj][0], v1 = acc[ai][bj][m][1] + bv[bj][1];
                    if (ACT == 1) { f32x2 a = gelu_pk((f32x2){v0[0], v0[1]}), b = gelu_pk((f32x2){v0[2], v0[3]}), c = gelu_pk((f32x2){v1[0], v1[1]}), d = gelu_pk((f32x2){v1[2], v1[3]});
                        v0 = (f32x4){a.x, a.y, b.x, b.y}; v1 = (f32x4){c.x, c.y, d.x, d.y}; }
                    v0 = v0 * sc; v1 = v1 * sc; u32x4 w; w.x = cvt_pk_bf16(v0[0], v0[1]); w.y = cvt_pk_bf16(v0[2], v0[3]); w.z = cvt_pk_bf16(v1[0], v1[1]); w.w = cvt_pk_bf16(v1[2], v1[3]);
                    *(u32x4*)(rowp + bj * HALF) = w; } }
    }
};

template <class Epi, class Sched, bool ALIGN_EPI = false, bool SP2 = false>
__device__ __forceinline__ void gemm_phase(PG8_LAS unsigned char* lds, const Gemm g, const Sched& S, const Epi& E, int tid_in) {
    int tid_ = tid_in; asm volatile("" : "+v"(tid_));
    const int tid = tid_, wid = __builtin_amdgcn_readfirstlane(tid >> 6), lane = tid & 63, wr = wid >> 2, wc = wid & 3, fr = lane & 15, fq = lane >> 4;
    const int K = g.ld, nt = g.K / BK;
    unsigned voffA[2], voffB[2];
#pragma unroll
    for (int i = 0; i < 2; ++i) { int R, C; stage_rc(tid * 16 + i * 8192, R, C); const int Rb = Epi::PERM ? ((R & ~31) + perm32(R & 31)) : R;
        voffA[i] = (unsigned)(R * K + C) * 2u; voffB[i] = (unsigned)(Rb * K + C) * 2u; }
    const size_t kstep = (size_t)(BK * 2);
    const size_t hstep = (size_t)HALF * K * 2;
    const size_t tstep = 2 * hstep;
    const size_t tstepA = (size_t)g.trows * K * 2;
    const unsigned ldsw = (unsigned)wid * 1024u;
    const int aoff = lds_byte(wr * 64 + fr, fq * 8), boff = lds_byte(wc * 32 + fr, fq * 8);
#define PG8_SA(b, h) (((b) * 2 + (h)) * HTB)
#define PG8_SB(b, h) ((4 + (b) * 2 + (h)) * HTB)
#define PG8_STAGE(bufoff, gbase, voff) do { _Pragma("unroll") for (int _i = 0; _i < 2; ++_i) \
        __builtin_amdgcn_global_load_lds((const unsigned*)((const char*)(gbase) + (voff)[_i]), (PG8_LAS unsigned*)(lds + (bufoff) + ldsw + _i * 8192), 16, 0, 0); } while (0)
#define PG8_LDA(dst, b, h) do { _Pragma("unroll") for (int m = 0; m < 4; ++m) _Pragma("unroll") for (int k = 0; k < 2; ++k) dst[m][k] = *(const PG8_LAS bf16x8*)(lds + PG8_SA(b, h) + aoff + m * 2048 + k * 1024); } while (0)
#define PG8_LDB(dst, b, h) do { _Pragma("unroll") for (int n = 0; n < 2; ++n) _Pragma("unroll") for (int k = 0; k < 2; ++k) dst[n][k] = *(const PG8_LAS bf16x8*)(lds + PG8_SB(b, h) + boff + n * 2048 + k * 1024); } while (0)
#define PG8_MMA(ai, bj, At, Bt) do { __builtin_amdgcn_s_setprio(1); _Pragma("unroll") for (int m = 0; m < 4; ++m) _Pragma("unroll") for (int n = 0; n < 2; ++n) _Pragma("unroll") for (int k = 0; k < 2; ++k) \
        acc[ai][bj][m][n] = __builtin_amdgcn_mfma_f32_16x16x32_bf16(Bt[n][k], At[m][k], acc[ai][bj][m][n], 0, 0, 0); __builtin_amdgcn_s_setprio(0); } while (0)
#define PG8_WAIT_V(n) asm volatile("s_waitcnt vmcnt(" #n ")" ::: "memory")
#define PG8_WAIT_L(n) asm volatile("s_waitcnt lgkmcnt(" #n ")" ::: "memory")
#define PG8_BAR __builtin_amdgcn_s_barrier()
#define PG8_SCHED __builtin_amdgcn_sched_barrier(0)
    Unit cur, nxt; int ui = 0;
    if (!S.next(0, cur)) return;
    f32x4 acc[2][2][4][2];
#pragma unroll
    for (int a = 0; a < 2; ++a)
#pragma unroll
        for (int b = 0; b < 2; ++b)
#pragma unroll
            for (int m = 0; m < 4; ++m)
#pragma unroll
                for (int n = 0; n < 2; ++n) acc[a][b][m][n] = (f32x4){pg8_zero(), pg8_zero(), pg8_zero(), pg8_zero()};
    bf16x8 At[4][2], B0[2][2], B1[2][2];
#define PG8_BASEA(un) ((const char*)g.A + (size_t)(g.mt ? (un).pm % g.mt : (un).pm) * tstepA + (g.mt ? (size_t)((un).pm / g.mt) * g.K * 2 : 0))
#define PG8_BASEB(un) ((const char*)g.Bt + (size_t)(un).pn * tstep + (g.mt ? (size_t)((un).pm / g.mt) * g.K * 2 : 0))
    const char* cA = PG8_BASEA(cur); const char* cB = PG8_BASEB(cur);
    S.a_ready(cur);
    if constexpr (SP2) {
        PG8_STAGE(PG8_SB(0, 0), cB, voffB); PG8_STAGE(PG8_SB(0, 1), cB + hstep, voffB); PG8_STAGE(PG8_SA(0, 0), cA, voffA); PG8_STAGE(PG8_SA(0, 1), cA + hstep, voffA);
        if (wr == 1) PG8_BAR;
        PG8_WAIT_V(2); PG8_BAR;
        PG8_STAGE(PG8_SB(1, 0), cB + kstep, voffB); PG8_STAGE(PG8_SA(1, 0), cA + kstep, voffA); PG8_STAGE(PG8_SB(1, 1), cB + hstep + kstep, voffB);
        PG8_WAIT_V(6); PG8_BAR;
    } else {
        PG8_STAGE(PG8_SB(0, 0), cB, voffB); PG8_STAGE(PG8_SA(0, 0), cA, voffA); PG8_STAGE(PG8_SB(0, 1), cB + hstep, voffB); PG8_STAGE(PG8_SA(0, 1), cA + hstep, voffA);
        if (wr == 1) PG8_BAR;
        PG8_WAIT_V(4); PG8_BAR;
        PG8_STAGE(PG8_SB(1, 0), cB + kstep, voffB); PG8_STAGE(PG8_SA(1, 0), cA + kstep, voffA); PG8_STAGE(PG8_SB(1, 1), cB + hstep + kstep, voffB);
        PG8_WAIT_V(6); PG8_BAR;
    }
    for (;;) {
        const bool has_next = S.next(ui + 1, nxt);
        const char* nA = has_next ? PG8_BASEA(nxt) : cA; const char* nB = has_next ? PG8_BASEB(nxt) : cB;
        for (int t = 0; t < nt; t += 2) {
            const bool last = (t == nt - 2);
            const char* a1 = cA + (size_t)(t + 1) * kstep;
            const char* a2 = last ? nA : cA + (size_t)(t + 2) * kstep; const char* b2 = last ? nB : cB + (size_t)(t + 2) * kstep;
            const char* a3 = a2 + kstep; const char* b3 = b2 + kstep;
            if (last && has_next) S.a_ready(nxt);
            if constexpr (SP2) {
            PG8_LDB(B0, 0, 0); PG8_LDB(B1, 0, 1); PG8_SCHED; PG8_LDA(At, 0, 0); PG8_STAGE(PG8_SA(1, 1), a1 + hstep, voffA);
            PG8_WAIT_V(8); PG8_WAIT_L(0); PG8_BAR; PG8_MMA(0, 0, At, B0); PG8_MMA(0, 1, At, B1); PG8_BAR; PG8_SCHED;
            PG8_LDA(At, 0, 1); PG8_STAGE(PG8_SB(0, 0), b2, voffB); PG8_STAGE(PG8_SB(0, 1), b2 + hstep, voffB); PG8_STAGE(PG8_SA(0, 0), a2, voffA);
            PG8_WAIT_V(8); PG8_WAIT_L(0); PG8_BAR; PG8_MMA(1, 0, At, B0); PG8_MMA(1, 1, At, B1); PG8_BAR; PG8_SCHED;
            PG8_LDB(B0, 1, 0); PG8_LDB(B1, 1, 1); PG8_SCHED; PG8_LDA(At, 1, 0); PG8_STAGE(PG8_SA(0, 1), a2 + hstep, voffA);
            PG8_WAIT_V(8); PG8_WAIT_L(0); PG8_BAR; PG8_MMA(0, 0, At, B0); PG8_MMA(0, 1, At, B1); PG8_BAR; PG8_SCHED;
            PG8_LDA(At, 1, 1); PG8_STAGE(PG8_SB(1, 0), b3, voffB); PG8_STAGE(PG8_SB(1, 1), b3 + hstep, voffB); PG8_STAGE(PG8_SA(1, 0), a3, voffA);
            PG8_WAIT_V(8); PG8_WAIT_L(0); PG8_BAR; PG8_MMA(1, 0, At, B0); PG8_MMA(1, 1, At, B1); PG8_BAR; PG8_SCHED;
            } else {
            PG8_LDB(B0, 0, 0); PG8_SCHED; PG8_LDA(At, 0, 0); PG8_STAGE(PG8_SA(1, 1), a1 + hstep, voffA);
            PG8_WAIT_L(8); PG8_BAR; PG8_WAIT_L(0); PG8_MMA(0, 0, At, B0); PG8_BAR; PG8_SCHED;
            PG8_LDB(B1, 0, 1); PG8_STAGE(PG8_SB(0, 0), b2, voffB);
            PG8_BAR; PG8_WAIT_L(0); PG8_MMA(0, 1, At, B1); PG8_BAR;
            PG8_LDA(At, 0, 1); PG8_STAGE(PG8_SA(0, 0), a2, voffA);
            PG8_BAR; PG8_WAIT_L(0); PG8_MMA(1, 0, At, B0); PG8_BAR; PG8_SCHED;
            PG8_STAGE(PG8_SB(0, 1), b2 + hstep, voffB);
            PG8_WAIT_V(6); PG8_BAR; PG8_MMA(1, 1, At, B1); PG8_BAR;
            PG8_LDB(B0, 1, 0); PG8_SCHED; PG8_LDA(At, 1, 0); PG8_STAGE(PG8_SA(0, 1), a2 + hstep, voffA);
            PG8_WAIT_L(8); PG8_BAR; PG8_WAIT_L(0); PG8_MMA(0, 0, At, B0); PG8_BAR; PG8_SCHED;
            PG8_LDB(B1, 1, 1); PG8_STAGE(PG8_SB(1, 0), b3, voffB);
            PG8_BAR; PG8_WAIT_L(0); PG8_MMA(0, 1, At, B1); PG8_BAR;
            PG8_LDA(At, 1, 1); PG8_STAGE(PG8_SA(1, 0), a3, voffA);
            PG8_BAR; PG8_WAIT_L(0); PG8_MMA(1, 0, At, B0); PG8_BAR; PG8_SCHED;
            PG8_STAGE(PG8_SB(1, 1), b3 + hstep, voffB);
            PG8_WAIT_V(6); PG8_BAR; PG8_MMA(1, 1, At, B1); PG8_BAR;
            }
        }
        if constexpr (ALIGN_EPI) { if (wr == 0) PG8_BAR; }
        if (!E.drain()) { E(acc, cur, wr, wc, fr, fq); S.done(cur); }
        if (!has_next) break;
#pragma unroll
        for (int a = 0; a < 2; ++a)
#pragma unroll
            for (int b = 0; b < 2; ++b)
#pragma unroll
                for (int m = 0; m < 4; ++m)
#pragma unroll
                    for (int n = 0; n < 2; ++n) acc[a][b][m][n] = (f32x4){pg8_zero(), pg8_zero(), pg8_zero(), pg8_zero()};
        cur = nxt; cA = nA; cB = nB; ++ui;
        if constexpr (ALIGN_EPI) { if (wr == 1) PG8_BAR; }
    }
    PG8_WAIT_V(0);
    if constexpr (!ALIGN_EPI) { if (wr == 0) PG8_BAR; }
    PG8_BAR;
    if (E.drain()) { E.fused(acc, cur, wr, wc, fr, fq, lds, wid, lane); S.done(cur); }
#undef PG8_BASEA
#undef PG8_BASEB
#undef PG8_SA
#undef PG8_SB
#undef PG8_STAGE
#undef PG8_LDA
#undef PG8_LDB
#undef PG8_MMA
#undef PG8_WAIT_V
#undef PG8_WAIT_L
#undef PG8_BAR
#undef PG8_SCHED
}
}
#define GAS __attribute__((address_space(1)))
#define LAS __attribute__((address_space(3)))
typedef unsigned short bf16;
typedef unsigned v4u __attribute__((ext_vector_type(4)));
typedef float f32x4 __attribute__((ext_vector_type(4)));
typedef short bf16x8 __attribute__((ext_vector_type(8)));
typedef GAS unsigned gu32;
typedef GAS unsigned long long gu64;
#define RLX_AGENT __ATOMIC_RELAXED, __HIP_MEMORY_SCOPE_AGENT
#define LDS_WAIT() asm volatile("s_waitcnt lgkmcnt(0)" ::: "memory")
#define VM_WAIT() asm volatile("s_waitcnt vmcnt(0)" ::: "memory")
__device__ __forceinline__ unsigned long long rt() { return __builtin_amdgcn_s_memrealtime(); }
__device__ __forceinline__ unsigned f2bf(float f) { unsigned u = __builtin_bit_cast(unsigned, f); return (u + 0x7fffu + ((u >> 16) & 1u)) >> 16; }
__device__ __forceinline__ unsigned pk2(float lo, float hi) { return f2bf(lo) | (f2bf(hi) << 16); }
#define XB_TMO      128
#define XB_XCNT(j)  (256  + 64 * (j))
#define XB_XSUB(j)  (1280 + 64 * (j))
#define XB_XGEN(j)  (2304 + 64 * (j))
#define XB_TOP      3328
#define XB_TOPGEN   3392
#define XCD_BAR_WORDS 3456
#define XB_SPIN_CAP (1u << 18)

__device__ __forceinline__ unsigned xb_ld(unsigned* p)              { return __hip_atomic_load(p, __ATOMIC_RELAXED, __HIP_MEMORY_SCOPE_AGENT); }
__device__ __forceinline__ unsigned xb_add(unsigned* p, unsigned v) { return __hip_atomic_fetch_add(p, v, __ATOMIC_RELAXED, __HIP_MEMORY_SCOPE_AGENT); }
__device__ __forceinline__ unsigned xb_xcc_id() { return (unsigned)__builtin_amdgcn_s_getreg((3 << 11) | 20) & 0xFu; }
#define XB_SPIN(cond, bar) do { unsigned _sp = 0; while (cond) { __builtin_amdgcn_s_sleep(1); \
    if ((++_sp & 255u) == 0u) { if (xb_ld(&(bar)[XB_TMO])) break; if (_sp > XB_SPIN_CAP) { atomicAdd(&(bar)[XB_TMO], 1u); break; } } } } while (0)

struct XcdBarrier {
    int tid; unsigned* bar; unsigned x;
    volatile LAS unsigned* st;
};

__device__ __forceinline__ XcdBarrier xcd_barrier_post(unsigned* bar, volatile LAS unsigned* st, int tid) {
    XcdBarrier b; b.bar = bar; b.x = xb_xcc_id(); b.st = st; b.tid = tid;
    if (tid == 0) (void)xb_add(&bar[XB_XCNT(b.x)], 1u);
    return b;
}
__device__ __forceinline__ void xcd_barrier_complete(unsigned* bar, unsigned x, unsigned& nloc, unsigned& nx) {
    const unsigned G = gridDim.x * gridDim.y * gridDim.z;
    unsigned sum, cnt, mine, sp = 0u;
    for (;;) {
        sum = 0u; cnt = 0u; mine = 0u;
#pragma unroll
        for (unsigned j = 0; j < 16; ++j) { const unsigned c = xb_ld(&bar[XB_XCNT(j)]); sum += c; cnt += (c > 0u) ? 1u : 0u; mine = (j == x) ? c : mine; }
        if (sum == G) break;
        __builtin_amdgcn_s_sleep(1);
        if ((++sp & 255u) == 0u) { if (xb_ld(&bar[XB_TMO])) break; if (sp > XB_SPIN_CAP) { atomicAdd(&bar[XB_TMO], 1u); break; } }
    }
    nloc = mine > 0u ? mine : 1u; nx = cnt > 0u ? cnt : 1u;
}

__device__ __forceinline__ void xcd_barrier(const XcdBarrier& b) {
    asm volatile("s_waitcnt vmcnt(0)" ::: "memory");
    __syncthreads();
    if (b.tid == 0) {
        unsigned* bar = b.bar;
        __builtin_amdgcn_s_waitcnt(0);
        unsigned nloc = b.st[0], nx = b.st[1];
        if (nloc == 0u) { xcd_barrier_complete(bar, b.x, nloc, nx); b.st[0] = nloc; b.st[1] = nx; }
        const unsigned old = xb_add(&bar[XB_XSUB(b.x)], 1u);
        const unsigned gen = old / nloc;
        if (old + 1u == (gen + 1u) * nloc) {
            __builtin_amdgcn_fence(__ATOMIC_RELEASE, "agent");
            asm volatile("s_waitcnt vmcnt(0)" ::: "memory");
            const unsigned og = xb_add(&bar[XB_TOP], 1u);
            const unsigned tg = og / nx;
            if (og + 1u == (tg + 1u) * nx) xb_add(&bar[XB_TOPGEN], 1u);
            else XB_SPIN(xb_ld(&bar[XB_TOPGEN]) == tg, bar);
            __builtin_amdgcn_fence(__ATOMIC_ACQUIRE, "agent");
            xb_add(&bar[XB_XGEN(b.x)], 1u);
            asm volatile("s_waitcnt vmcnt(0)" ::: "memory");
        } else {
            XB_SPIN(xb_ld(&bar[XB_XGEN(b.x)]) == gen, bar);
            __builtin_amdgcn_fence(__ATOMIC_ACQUIRE, "agent");
            asm volatile("s_waitcnt vmcnt(0)" ::: "memory");
        }
    }
    __syncthreads();
}

namespace mk {
constexpr int NWAVES = 8, NTHR = 512;
constexpr int D = 1024, NBATCH = 4, SEQ = 4096, CTXL = 256;
constexpr int MLAT = NBATCH * SEQ, MCTX = NBATCH * CTXL, MALL = MLAT + MCTX;
constexpr int INW = 2496, INP = 2560, DFF = 2816, NGU = 2 * DFF;
constexpr int C_R = 0, C_K = 256, C_V = 512, C_GD = 768, C_WD = 832, C_AD = 896, C_DFQ = 960, C_DFK = 1216, C_DFV = 1472, C_GQQ = 1728, C_GQK = 2240, C_GQV = 2368;
constexpr float NORM_EPS = 1e-6f, LOG2E = 1.4426950408889634f;
constexpr float SC_DF = 0.17677669529663687f * LOG2E;
constexpr float SC_GQ = 0.125f * LOG2E;

enum { I_X = 0, I_C, I_CTX, I_CCTX, I_ADAW, I_ADAB, I_NORMG, I_WIN, I_WOUT, I_RWCONV, I_RWW0, I_RWWUP, I_RWA0, I_RWAUP, I_RWGUP, I_RWKK, I_RWKA, I_RWRK, I_RWLNG, I_RWLNB,
       I_DFLAM, I_DFNG, I_GQSINK, I_FFG, I_FFU, I_FFD, I_FFCW, I_FFCB, N_IN };

constexpr size_t MiB = 1u << 20;
constexpr size_t WS_CTL = 0, CTL_ZERO_BYTES = 1 * MiB;
constexpr int CW_BAR = 4096;
constexpr size_t WS_MOD = 1 * MiB;
constexpr size_t WS_TAB = 1 * MiB + 256 * 1024;
constexpr size_t WS_WIN = 2 * MiB, WIN_BYTES = (size_t)INP * D * 2;
constexpr size_t WS_WOUT = 12 * MiB, WOUT_BYTES = (size_t)D * D * 2;
constexpr size_t WS_WGU = 16 * MiB, WGU_BYTES = (size_t)NGU * D * 2;
constexpr size_t WS_WD = 38 * MiB, WD_BYTES = (size_t)D * DFF * 2;
constexpr size_t WS_XSC = 49 * MiB;
constexpr size_t WS_XN = 53 * MiB;
constexpr size_t WS_RP = 87 * MiB;
constexpr size_t WS_RF = 172 * MiB;
constexpr size_t FEAT1 = (size_t)MALL * 256 * 2;
constexpr size_t WS_GAL = WS_RF, WS_GBE = WS_GAL + 2 * FEAT1, WS_GKP = WS_GBE + 2 * FEAT1, WS_GRH = WS_GKP + 2 * FEAT1, WS_FV = WS_GRH + 2 * FEAT1;
constexpr size_t WS_GLT = WS_FV + FEAT1;
constexpr size_t WS_BON = WS_GLT + (size_t)2 * 272 * 256 * 4;
constexpr size_t WS_RF_END = WS_BON + (size_t)MALL * 4 * 4;
constexpr size_t WS_ACT = WS_RP;
constexpr size_t WS_XR = 181 * MiB;
constexpr size_t WS_FP = 181 * MiB;
constexpr size_t WS_SLO = WS_RF;
constexpr size_t WS_SLD = 215 * MiB;
constexpr size_t WS_XB = 240 * MiB;
constexpr size_t WS_END = 256 * MiB;
static_assert(WS_RF_END <= WS_END, "feature region");
static_assert(WS_SLD + (size_t)11 * MCTX * D * 2 <= WS_XB && WS_XB + (size_t)8 * MLAT * 4 * 4 <= WS_END, "exchange slots");
static_assert(WS_FP + (size_t)MALL * D * 2 <= WS_SLD && WS_SLD + (size_t)11 * MCTX * D * 2 <= WS_END, "slabs");
static_assert(WS_ACT + (size_t)MALL * DFF * 2 <= WS_FP && WS_FP + (size_t)MALL * D * 4 <= WS_END, "ffn buffers");
static_assert(WS_XN + (size_t)MALL * D * 2 <= WS_RP && WS_RP + (size_t)MALL * INP * 2 <= WS_RF, "map");

constexpr int LDS_BYTES = 163840;
constexpr int LDSCTL_OFF = LDS_BYTES - 512, MISC_OFF = LDSCTL_OFF + 320;
constexpr int CW_QUEUE = 2048, CW_PST = 32768;

struct Args { const float* in[N_IN]; float* out; unsigned char* ws; int ph_lo, ph_hi; };


typedef const __attribute__((address_space(4))) char* kptr_t;
__device__ __forceinline__ kptr_t karg_base() { kptr_t k = (kptr_t)__builtin_amdgcn_kernarg_segment_ptr(); asm volatile("" : "+s"(k)); return k; }
__device__ __forceinline__ const float* kin(int i) { return *(const float* const __attribute__((address_space(4)))*)(karg_base() + 8 * i); }
__device__ __forceinline__ float* kout() { return *(float* const __attribute__((address_space(4)))*)(karg_base() + 8 * N_IN); }
__device__ __forceinline__ unsigned char* kws() { return *(unsigned char* const __attribute__((address_space(4)))*)(karg_base() + 8 * N_IN + 8); }

struct Frame {
    LAS unsigned char* lds;
    int tid, lane, wave, G, bid;
};

__device__ __forceinline__ float bf2f(bf16 h) { return __uint_as_float(((unsigned)h) << 16); }
template <int CTRL> __device__ __forceinline__ float dpp_mov(float x) { return __int_as_float(__builtin_amdgcn_update_dpp(0, __float_as_int(x), CTRL, 0xF, 0xF, false)); }
template <int CTRL> __device__ __forceinline__ float dpp_add(float x) { return x + dpp_mov<CTRL>(x); }
__device__ __forceinline__ float wave_sum(float v) {
    v = dpp_add<0xB1>(v); v = dpp_add<0x4E>(v); v = dpp_add<0x124>(v); v = dpp_add<0x128>(v);
    auto r = __builtin_amdgcn_permlane16_swap(__float_as_uint(v), __float_as_uint(v), false, false); v = __uint_as_float(r[0]) + __uint_as_float(r[1]);
    r = __builtin_amdgcn_permlane32_swap(__float_as_uint(v), __float_as_uint(v), false, false); return __uint_as_float(r[0]) + __uint_as_float(r[1]);
}
__device__ __forceinline__ float rdlane(float v, int l) { return __int_as_float(__builtin_amdgcn_readlane(__float_as_int(v), l)); }
__device__ __forceinline__ float sigmoidf_(float x) { return __builtin_amdgcn_rcpf(1.0f + __expf(-x)); }
typedef unsigned v2u __attribute__((ext_vector_type(2)));
typedef float f32x2_t __attribute__((ext_vector_type(2))); typedef __bf16 bf16x2_t __attribute__((ext_vector_type(2)));
__device__ __forceinline__ unsigned pk2h(float lo, float hi) { f32x2_t v = {lo, hi}; bf16x2_t b = __builtin_convertvector(v, bf16x2_t); return __builtin_bit_cast(unsigned, b); }
__device__ __forceinline__ float xmax4(float v) {
    auto r = __builtin_amdgcn_permlane16_swap(__float_as_uint(v), __float_as_uint(v), false, false); v = fmaxf(__uint_as_float(r[0]), __uint_as_float(r[1]));
    r = __builtin_amdgcn_permlane32_swap(__float_as_uint(v), __float_as_uint(v), false, false); return fmaxf(__uint_as_float(r[0]), __uint_as_float(r[1]));
}

__device__ __forceinline__ void p0_transpose_item(const float* W, int K, int N, bf16* WT, int row_off, LAS float* scr, int item, int lane) {
    const int nblk = N / 32, kb = item / nblk, nb = item % nblk, k0 = 64 * kb, n0 = 32 * nb;
#pragma unroll 8
    for (int i = 0; i < 32; ++i) { const int kk = 2 * i + (lane >> 5); scr[kk * 33 + (lane & 31)] = W[(size_t)(k0 + kk) * N + n0 + (lane & 31)]; }
    LDS_WAIT(); asm volatile("" ::: "memory");
    const int c = lane & 7;
#pragma unroll
    for (int j = 0; j < 4; ++j) { const int n = (lane >> 3) + 8 * j; const LAS float* s = scr + (8 * c) * 33 + n;
        v4u o; o.x = pk2h(s[0 * 33], s[1 * 33]); o.y = pk2h(s[2 * 33], s[3 * 33]); o.z = pk2h(s[4 * 33], s[5 * 33]); o.w = pk2h(s[6 * 33], s[7 * 33]);
        *(GAS v4u*)(WT + (size_t)(row_off + n0 + n) * K + k0 + 8 * c) = o; }
    LDS_WAIT(); asm volatile("" ::: "memory");
}

constexpr int WI_IN = 16 * (INW / 32), WI_OUT = 16 * 32, WI_G = 16 * (DFF / 32), WI_DN = (DFF / 64) * 32, WI_LAYER = WI_IN + WI_OUT + 2 * WI_G + WI_DN;
__device__ __forceinline__ void weight_item(int it, LAS float* scr, int lane) {
    unsigned char* ws = kws();
    const int l = it / WI_LAYER; int r = it % WI_LAYER;
    if (r < WI_IN) { p0_transpose_item(kin(I_WIN) + (size_t)l * D * INW, D, INW, (bf16*)(ws + WS_WIN + l * WIN_BYTES), 0, scr, r, lane); return; } r -= WI_IN;
    if (r < WI_OUT) { p0_transpose_item(kin(I_WOUT) + (size_t)l * D * D, D, D, (bf16*)(ws + WS_WOUT + l * WOUT_BYTES), 0, scr, r, lane); return; } r -= WI_OUT;
    if (r < WI_G) { const int n0 = 32 * (r % (DFF / 32)); p0_transpose_item(kin(I_FFG) + (size_t)l * D * DFF, D, DFF, (bf16*)(ws + WS_WGU + l * WGU_BYTES), 256 * (n0 >> 7) + (n0 & 127) - n0, scr, r, lane); return; } r -= WI_G;
    if (r < WI_G) { const int n0 = 32 * (r % (DFF / 32)); p0_transpose_item(kin(I_FFU) + (size_t)l * D * DFF, D, DFF, (bf16*)(ws + WS_WGU + l * WGU_BYTES), 256 * (n0 >> 7) + (n0 & 127) - n0 + 128, scr, r, lane); return; } r -= WI_G;
    p0_transpose_item(kin(I_FFD) + (size_t)l * DFF * D, DFF, D, (bf16*)(ws + WS_WD + l * WD_BYTES), 0, scr, r, lane);
}
constexpr int WI_FILL = (2 * WI_LAYER - WI_IN + 127) / 128;

__device__ __forceinline__ void p0_prologue(const Args& A, Frame& F) {
    unsigned char* ws = kws();
    {
        LAS float* sc = (LAS float*)F.lds;
        LAS float* red = (LAS float*)(F.lds + 20480);
        float* mod = (float*)(ws + WS_MOD);
        for (int u = F.bid; u < 192; u += F.G) {
            __syncthreads();
            for (int i = F.tid; i < 5 * 1024; i += NTHR) { const int bb = i >> 10, k = i & 1023; const float v = bb < 4 ? kin(I_C)[bb * 1024 + k] : kin(I_CCTX)[k]; sc[i] = v / (1.0f + __expf(-v)); }
            __syncthreads();
            const int l = u / 96, cc = u % 96, col = cc * 64 + (F.tid & 63), ks = F.tid >> 6;
            const float* w = kin(I_ADAW) + (size_t)l * 1024 * 6144 + col;
            float acc[5] = {0.f, 0.f, 0.f, 0.f, 0.f};
            for (int k0 = ks * 128; k0 < ks * 128 + 128; k0 += 16) { float wv[16];
#pragma unroll
                for (int q = 0; q < 16; ++q) wv[q] = w[(size_t)(k0 + q) * 6144];
#pragma unroll
                for (int q = 0; q < 16; ++q)
#pragma unroll
                    for (int bb = 0; bb < 5; ++bb) acc[bb] += sc[bb * 1024 + k0 + q] * wv[q]; }
#pragma unroll
            for (int bb = 0; bb < 5; ++bb) red[(ks * 5 + bb) * 64 + (F.tid & 63)] = acc[bb];
            __syncthreads();
            if (F.tid < 320) { const int bb = F.tid >> 6, c = F.tid & 63; float s = kin(I_ADAB)[l * 6144 + cc * 64 + c];
#pragma unroll
                for (int k8 = 0; k8 < 8; ++k8) s += red[(k8 * 5 + bb) * 64 + c];
                mod[(size_t)(l * 5 + bb) * 6144 + cc * 64 + c] = s; }
        }
        __syncthreads();
    }
    {
        LAS float* scr = (LAS float*)(F.lds + F.wave * 16384);
        const int gw = F.bid * NWAVES + F.wave, NGW = F.G * NWAVES;
        for (int it = gw; it < WI_IN; it += NGW) weight_item(it, scr, F.lane);
        const int gt = F.bid * NTHR + F.tid, NGT = F.G * NTHR;
        for (int i = gt; i < 2 * 8192; i += NGT) { const int l = i >> 13, j = i & 8191;
            unsigned z_ = 0u; asm volatile("" : "+v"(z_)); *(GAS v4u*)(ws + WS_WIN + l * WIN_BYTES + (size_t)INW * D * 2 + (size_t)j * 16) = (v4u){z_, z_, z_, z_}; }
    }
    if (F.bid == 0) {
        float* tab = (float*)(ws + WS_TAB);
        for (int i = F.tid; i < 512; i += NTHR) { const int pos = i >> 3, f = i & 7; const float inv = __builtin_amdgcn_exp2f(-(float)f * (13.287712379549449f / 8.0f)), ang = (float)pos * inv; tab[i] = __cosf(ang); tab[512 + i] = __sinf(ang); }
        for (int i = F.tid; i < 1024; i += NTHR) { const int pos = i >> 4, f = i & 15; const float inv = __builtin_amdgcn_exp2f(-(float)f * (13.287712379549449f / 16.0f)), ang = (float)pos * inv; tab[1024 + i] = __cosf(ang); tab[2048 + i] = __sinf(ang); }
        if (F.tid < 2) { const int l = F.tid; const float* lv = kin(I_DFLAM) + l * 128; float s1 = 0.f, s2 = 0.f;
            for (int i = 0; i < 32; ++i) { s1 += lv[i] * lv[32 + i]; s2 += lv[64 + i] * lv[96 + i]; }
            const float lam_init = 0.8f - 0.6f * __expf(-0.3f * (float)l);
            tab[3072 + l] = __expf(s1) - __expf(s2) + lam_init; tab[3074 + l] = lam_init; }
    }
}

__device__ __forceinline__ const float* mod_vec(const Args& A, int l, int bb, int i) { return (const float*)(kws() + WS_MOD) + ((size_t)(l * 5 + bb) * 6 + i) * 1024; }
__device__ __forceinline__ const float* normg_vec(const Args& A, int l, int i) { return kin(I_NORMG) + (size_t)(l * 4 + i) * 1024; }
__device__ __forceinline__ int row_bb(int row) { return row < MLAT ? (row >> 12) : 4; }
__device__ __forceinline__ void seq_pos(int row, int& t, int& T) { if (row < MLAT) { t = row & (SEQ - 1); T = SEQ; } else { t = (row - MLAT) & (CTXL - 1); T = CTXL; } }
__device__ __forceinline__ void ld16(const float* p, int lane, f32x4 (&v)[4]) {
#pragma unroll
    for (int j = 0; j < 4; ++j) v[j] = *(const f32x4*)(p + 4 * lane + 256 * j);
}
__device__ __forceinline__ void ld16b(const bf16* p, int lane, f32x4 (&v)[4]) {
#pragma unroll
    for (int j = 0; j < 4; ++j) { const v2u u = *(const v2u*)(p + 4 * lane + 256 * j);
        v[j] = (f32x4){__uint_as_float(u.x << 16), __uint_as_float(u.x & 0xffff0000u), __uint_as_float(u.y << 16), __uint_as_float(u.y & 0xffff0000u)}; }
}
__device__ __forceinline__ void st16(float* p, int lane, const f32x4 (&v)[4]) {
#pragma unroll
    for (int j = 0; j < 4; ++j) *(f32x4*)(p + 4 * lane + 256 * j) = v[j];
}
__device__ __forceinline__ float sumsq16(const f32x4 (&v)[4]) {
    float s = 0.f;
#pragma unroll
    for (int j = 0; j < 4; ++j) s += (v[j].x * v[j].x + v[j].y * v[j].y) + (v[j].z * v[j].z + v[j].w * v[j].w);
    return wave_sum(s);
}
__device__ __forceinline__ void norm_mod_store(const f32x4 (&v)[4], float rstd, const float* g, const float* sc, const float* sh, bf16* orow, int lane) {
#pragma unroll
    for (int j = 0; j < 4; ++j) {
        const int c = 4 * lane + 256 * j;
        const f32x4 gg = *(const f32x4*)(g + c), s1 = *(const f32x4*)(sc + c), s0 = *(const f32x4*)(sh + c);
        const f32x4 h = v[j] * rstd * gg * (s1 + 1.0f) + s0;
        v2u o; o.x = pk2h(h.x, h.y); o.y = pk2h(h.z, h.w);
        *(v2u*)(orow + c) = o;
    }
}
__device__ __forceinline__ float* xs_row(const Args& A, int row) { return row < MLAT ? kout() + (size_t)row * D : (float*)(kws() + WS_XSC) + (size_t)(row - MLAT) * D; }
__device__ __forceinline__ const float* xin_row(const Args& A, int row) { return row < MLAT ? kin(I_X) + (size_t)row * D : kin(I_CTX) + (size_t)(row - MLAT) * D; }

__device__ __forceinline__ void phase_prep(const Args& A, Frame& F) {
    const int gw = F.bid * NWAVES + F.wave, NGW = F.G * NWAVES;
    bf16* XN = (bf16*)(kws() + WS_XN);
    f32x4 v[4], vn[4];
    if (gw < MALL) ld16(xin_row(A, gw), F.lane, v);
    for (int row = gw; row < MALL; row += NGW) {
        if (row + NGW < MALL) ld16(xin_row(A, row + NGW), F.lane, vn);
        const float rstd = rsqrtf(sumsq16(v) * (1.0f / D) + NORM_EPS);
        const int bb = row_bb(row);
        norm_mod_store(v, rstd, normg_vec(A, 0, 0), mod_vec(A, 0, bb, 1), mod_vec(A, 0, bb, 0), XN + (size_t)row * D, F.lane);
#pragma unroll
        for (int j = 0; j < 4; ++j) v[j] = vn[j];
    }
}
__device__ __forceinline__ void phase_e1(const Args& A, Frame& F, int l) {
    const int gw = F.bid * NWAVES + F.wave, NGW = F.G * NWAVES, nrows = l == 0 ? MALL : MLAT;
    bf16* XN = (bf16*)(kws() + WS_XN); const bf16* YP = (const bf16*)(kws() + WS_RP);
    for (int row = ((MK_FUSE & 1) && !MK_DBGD ? MLAT : 0) + gw; row < nrows; row += NGW) {
        const int bb = row_bb(row);
        f32x4 y[4], x[4];
        if (l == 0 && row >= MLAT) { const bf16* sl = (const bf16*)(kws() + WS_SLO) + (size_t)(row - MLAT) * D; ld16b(sl, F.lane, y);
            for (int s = 1; s < 4; ++s) { f32x4 t[4]; ld16b(sl + (size_t)s * MCTX * D, F.lane, t);
#pragma unroll
                for (int j = 0; j < 4; ++j) y[j] = y[j] + t[j]; } }
        else ld16b(YP + (size_t)row * D, F.lane, y);
        if (l == 0) ld16(xin_row(A, row), F.lane, x); else ld16(xs_row(A, row), F.lane, x);
        const float ry = rsqrtf(sumsq16(y) * (1.0f / D) + NORM_EPS);
        const float* g1 = normg_vec(A, l, 1); const float* ga = mod_vec(A, l, bb, 2);
#pragma unroll
        for (int j = 0; j < 4; ++j) { const int c = 4 * F.lane + 256 * j; x[j] = x[j] + *(const f32x4*)(ga + c) * (y[j] * ry * *(const f32x4*)(g1 + c)); }
        st16(xs_row(A, row), F.lane, x);
        const float rx = rsqrtf(sumsq16(x) * (1.0f / D) + NORM_EPS);
        norm_mod_store(x, rx, normg_vec(A, l, 2), mod_vec(A, l, bb, 4), mod_vec(A, l, bb, 3), XN + (size_t)row * D, F.lane);
    }
}
__device__ __forceinline__ void phase_e2(const Args& A, Frame& F, int l, int r0, int r1) {
    const int gw = F.bid * NWAVES + F.wave, NGW = F.G * NWAVES;
    bf16* XN = (bf16*)(kws() + WS_XN); const bf16* FP = (const bf16*)(kws() + WS_FP);
    for (int row = ((MK_FUSE & 2) && !MK_DBGD ? (r0 < MLAT ? MLAT : r0) : r0) + gw; row < r1; row += NGW) {
        const int bb = row_bb(row);
        f32x4 y[4], x[4];
        if (l == 0 && row >= MLAT) { const bf16* sl = (const bf16*)(kws() + WS_SLD) + (size_t)(row - MLAT) * D; ld16b(sl, F.lane, y);
            for (int s = 1; s < 11; ++s) { f32x4 t[4]; ld16b(sl + (size_t)s * MCTX * D, F.lane, t);
#pragma unroll
                for (int j = 0; j < 4; ++j) y[j] = y[j] + t[j]; } }
        else ld16b(FP + (size_t)(row - r0) * D, F.lane, y);
        ld16(xs_row(A, row), F.lane, x);
        const float ry = rsqrtf(sumsq16(y) * (1.0f / D) + NORM_EPS);
        const float* g3 = normg_vec(A, l, 3); const float* ga = mod_vec(A, l, bb, 5);
#pragma unroll
        for (int j = 0; j < 4; ++j) { const int c = 4 * F.lane + 256 * j; x[j] = x[j] + *(const f32x4*)(ga + c) * (y[j] * ry * *(const f32x4*)(g3 + c)); }
        st16(xs_row(A, row), F.lane, x);
        if (l == 0) {
            const float rx = rsqrtf(sumsq16(x) * (1.0f / D) + NORM_EPS);
            norm_mod_store(x, rx, normg_vec(A, 1, 0), mod_vec(A, 1, bb, 1), mod_vec(A, 1, bb, 0), XN + (size_t)row * D, F.lane);
        }
    }
}
__device__ __forceinline__ void phase_act(const Args& A, Frame& F, int l, int r0, int r1) {
    const bf16* GU = (const bf16*)(kws() + WS_RP); bf16* ACT = (bf16*)(kws() + WS_ACT);
    const float* cw = kin(I_FFCW) + (size_t)l * 3 * DFF; const float* cb = kin(I_FFCB) + (size_t)l * DFF;
    const int nch = DFF / 8, total = (r1 - r0) * nch;
    for (int i = F.bid * NTHR + F.tid; i < total; i += F.G * NTHR) {
        const int rr = i / nch, ch = i % nch, row = r0 + rr, j0 = ch * 8;
        const int t = row < MLAT ? (row & (SEQ - 1)) : ((row - MLAT) & (CTXL - 1)), T = row < MLAT ? SEQ : CTXL;
        const bf16* gp = GU + (size_t)rr * NGU + j0;
        const v4u gc = *(const v4u*)gp, uu = *(const v4u*)(gp + DFF);
        v4u gm = (v4u){0u, 0u, 0u, 0u}, gn = (v4u){0u, 0u, 0u, 0u};
        if (t > 0) gm = *(const v4u*)(gp - NGU);
        if (t < T - 1) gn = *(const v4u*)(gp + NGU);
        unsigned o[4];
#pragma unroll
        for (int q = 0; q < 4; ++q) {
            float r2[2];
#pragma unroll
            for (int e = 0; e < 2; ++e) {
                const int j = j0 + 2 * q + e;
                const float a = __uint_as_float(e ? (gm[q] & 0xffff0000u) : (gm[q] << 16)), b = __uint_as_float(e ? (gc[q] & 0xffff0000u) : (gc[q] << 16)), c = __uint_as_float(e ? (gn[q] & 0xffff0000u) : (gn[q] << 16));
                const float u = __uint_as_float(e ? (uu[q] & 0xffff0000u) : (uu[q] << 16));
                const float z = a * cw[j] + b * cw[DFF + j] + c * cw[2 * DFF + j] + cb[j];
                r2[e] = z / (1.0f + __expf(-z)) * u;
            }
            o[q] = pk2h(r2[0], r2[1]);
        }
        *(v4u*)(ACT + (size_t)rr * DFF + j0) = (v4u){o[0], o[1], o[2], o[3]};
    }
}

struct EpiMulti {
    static constexpr bool PERM = false, AFTER_DRAIN = false;
    int mode;
    bf16* ob; float* of; int ld; const float* tab;
    const float* cw; const float* cb; int nrows; unsigned ldsx;
    const float* xin; float* xout; bf16* xn; const bf16* xinb; bf16* xoutb;
    const float *gA, *gaA, *gB, *scB, *shB; float* xb0; float* xb1; gu32* cnt0; gu32* cnt1; int two;
    __device__ __forceinline__ bool drain() const { return mode >= 5; }
    __device__ __forceinline__ void row_stats(const pg8::f32x4 (&v)[2][2][4][2], const pg8::Unit& u, int wr, int wc, int fr, int fq, LAS unsigned char* lds, int wid, int lane, float* xb, gu32* cnt) const {
        LAS float* Pp = (LAS float*)lds; LAS float* Ss = (LAS float*)(lds + 8192); LAS unsigned* flag = (LAS unsigned*)(lds + 8192 + 1024);
#pragma unroll
        for (int ai = 0; ai < 2; ++ai)
#pragma unroll
            for (int mm = 0; mm < 4; ++mm) { float s = 0.f;
#pragma unroll
                for (int bj = 0; bj < 2; ++bj)
#pragma unroll
                    for (int n = 0; n < 2; ++n) { const pg8::f32x4 x = v[ai][bj][mm][n]; s += (x[0] * x[0] + x[1] * x[1]) + (x[2] * x[2] + x[3] * x[3]); }
                s += __shfl_xor(s, 16); s += __shfl_xor(s, 32);
                if (fq == 0) Pp[(ai * 128 + wr * 64 + mm * 16 + fr) * 4 + wc] = s; }
        asm volatile("s_waitcnt lgkmcnt(0)" ::: "memory"); __builtin_amdgcn_s_barrier(); asm volatile("" ::: "memory");
        const int row = wid * 32 + (lane & 31);
        if (lane < 32) { const float s = (Pp[row * 4 + 0] + Pp[row * 4 + 1]) + (Pp[row * 4 + 2] + Pp[row * 4 + 3]);
            __hip_atomic_store((gu32*)(xb + ((size_t)u.pn * MLAT + u.pm * 256 + row)), __float_as_uint(s), __ATOMIC_RELAXED, __HIP_MEMORY_SCOPE_AGENT); }
        asm volatile("s_waitcnt vmcnt(0)" ::: "memory");
        if (lane == 0) __hip_atomic_fetch_add(cnt + 64 * u.pm, 1u, __ATOMIC_RELAXED, __HIP_MEMORY_SCOPE_AGENT);
        if (wid == 0) {
            unsigned sp = 0;
            while ((unsigned)__builtin_amdgcn_readfirstlane(__hip_atomic_load(cnt + 64 * u.pm, __ATOMIC_RELAXED, __HIP_MEMORY_SCOPE_AGENT)) < 32u) { __builtin_amdgcn_s_sleep(2); if (++sp > (1u << 22)) break; }
            __builtin_amdgcn_fence(__ATOMIC_ACQUIRE, "agent");
            if (lane == 0) flag[0] = 1u;
        }
        asm volatile("s_waitcnt vmcnt(0) lgkmcnt(0)" ::: "memory"); __builtin_amdgcn_s_barrier(); asm volatile("" ::: "memory");
        if (lane < 32) { float t = 0.f;
#pragma unroll
            for (int q = 0; q < 4; ++q) t += __uint_as_float(__hip_atomic_load((gu32*)(xb + ((size_t)q * MLAT + u.pm * 256 + row)), __ATOMIC_RELAXED, __HIP_MEMORY_SCOPE_AGENT));
            Ss[row] = rsqrtf(t * (1.0f / D) + NORM_EPS); }
        asm volatile("s_waitcnt vmcnt(0) lgkmcnt(0)" ::: "memory"); __builtin_amdgcn_s_barrier(); asm volatile("" ::: "memory");
    }
    __device__ __forceinline__ void fused(pg8::f32x4 (&acc)[2][2][4][2], const pg8::Unit& u, int wr, int wc, int fr_, int fq_, PG8_LAS unsigned char* lds, int wid, int lane) const {
        int fr = fr_, fq = fq_; asm volatile("" : "+v"(fr), "+v"(fq));
#if defined(MK_DBGDRAIN)
        { bf16* obd = mode == 5 ? (bf16*)(kws() + WS_RP) : (bf16*)(kws() + WS_FP);
#pragma unroll
          for (int ai = 0; ai < 2; ++ai)
#pragma unroll
            for (int mm = 0; mm < 4; ++mm) { bf16* rp = obd + (size_t)(u.pm * 256 + ai * 128 + wr * 64 + mm * 16 + fr) * D + u.pn * 256 + wc * 32 + 4 * fq;
#pragma unroll
                for (int bj = 0; bj < 2; ++bj)
#pragma unroll
                    for (int n = 0; n < 2; ++n) { const pg8::f32x4 v = acc[ai][bj][mm][n]; v2u o; o.x = pk2h(v[0], v[1]); o.y = pk2h(v[2], v[3]); *(v2u*)(rp + bj * 128 + n * 16) = o; } }
          return; }
#endif
        const LAS float* Ss = (const LAS float*)((LAS unsigned char*)lds + 8192);
        const int col0 = u.pn * 256 + wc * 32 + 4 * fq, bofs = (u.pm >> 4) * 6144;
        row_stats(acc, u, wr, wc, fr, fq, (LAS unsigned char*)lds, wid, lane, xb0, cnt0);
        pg8::f32x4 cA_[2][2];
#pragma unroll
        for (int bj = 0; bj < 2; ++bj)
#pragma unroll
            for (int n = 0; n < 2; ++n) cA_[bj][n] = *(const pg8::f32x4*)(gA + col0 + 128 * bj + 16 * n) * *(const pg8::f32x4*)(gaA + bofs + col0 + 128 * bj + 16 * n);
#pragma unroll
        for (int ai = 0; ai < 2; ++ai)
#pragma unroll
            for (int mm = 0; mm < 4; ++mm) { const int r = ai * 128 + wr * 64 + mm * 16 + fr; const float rs = Ss[r]; const size_t off = (size_t)(u.pm * 256 + r) * D + col0;
#pragma unroll
                for (int bj = 0; bj < 2; ++bj)
#pragma unroll
                    for (int n = 0; n < 2; ++n) { pg8::f32x4 xi;
                        if (xinb) { const v2u q = *(const v2u*)(xinb + off + 128 * bj + 16 * n); xi = (pg8::f32x4){__uint_as_float(q.x << 16), __uint_as_float(q.x & 0xffff0000u), __uint_as_float(q.y << 16), __uint_as_float(q.y & 0xffff0000u)}; }
                        else xi = *(const pg8::f32x4*)(xin + off + 128 * bj + 16 * n);
                        acc[ai][bj][mm][n] = xi + cA_[bj][n] * (acc[ai][bj][mm][n] * rs); }
                asm volatile("" : "+v"(acc[ai][0][mm][0]), "+v"(acc[ai][0][mm][1]), "+v"(acc[ai][1][mm][0]), "+v"(acc[ai][1][mm][1]));
                if (mm & 1) asm volatile("" ::: "memory"); }
        if (two) {
            asm volatile("s_waitcnt lgkmcnt(0)" ::: "memory"); __builtin_amdgcn_s_barrier(); asm volatile("" ::: "memory");
            row_stats(acc, u, wr, wc, fr, fq, (LAS unsigned char*)lds, wid, lane, xb1, cnt1);
        }
        pg8::f32x4 cB_[2][2], cS_[2][2];
        if (two) {
#pragma unroll
            for (int bj = 0; bj < 2; ++bj)
#pragma unroll
                for (int n = 0; n < 2; ++n) { cB_[bj][n] = *(const pg8::f32x4*)(gB + col0 + 128 * bj + 16 * n) * (*(const pg8::f32x4*)(scB + bofs + col0 + 128 * bj + 16 * n) + 1.0f); cS_[bj][n] = *(const pg8::f32x4*)(shB + bofs + col0 + 128 * bj + 16 * n); }
        }
#pragma unroll
        for (int ai = 0; ai < 2; ++ai)
#pragma unroll
            for (int mm = 0; mm < 4; ++mm) { const int r = ai * 128 + wr * 64 + mm * 16 + fr; const size_t off = (size_t)(u.pm * 256 + r) * D + col0; const float rs = two ? Ss[r] : 0.f;
#pragma unroll
                for (int bj = 0; bj < 2; ++bj)
#pragma unroll
                    for (int n = 0; n < 2; ++n) { const pg8::f32x4 x1 = acc[ai][bj][mm][n];
                        if (xoutb) { v2u q; q.x = pk2h(x1[0], x1[1]); q.y = pk2h(x1[2], x1[3]); *(v2u*)(xoutb + off + 128 * bj + 16 * n) = q; } else *(pg8::f32x4*)(xout + off + 128 * bj + 16 * n) = x1;
                        if (two) { const pg8::f32x4 hh = x1 * rs * cB_[bj][n] + cS_[bj][n]; v2u o; o.x = pk2h(hh[0], hh[1]); o.y = pk2h(hh[2], hh[3]); *(v2u*)(xn + off + 128 * bj + 16 * n) = o; } }
                asm volatile("" ::: "memory"); }
        asm volatile("s_waitcnt lgkmcnt(0)" ::: "memory"); __builtin_amdgcn_s_barrier(); asm volatile("" ::: "memory");
    }
    __device__ __forceinline__ void operator()(const pg8::f32x4 (&acc)[2][2][4][2], const pg8::Unit& u, int wr, int wc, int fr_, int fq_) const {
        int fr = fr_, fq = fq_; asm volatile("" : "+v"(fr), "+v"(fq));
        if (mode == 1) {
#pragma unroll
            for (int ai = 0; ai < 2; ++ai)
#pragma unroll
                for (int m = 0; m < 4; ++m) { float* rp = of + (size_t)(u.pm * 256 + ai * 128 + wr * 64 + m * 16 + fr) * ld + u.pn * 256 + wc * 32 + 4 * fq;
#pragma unroll
                    for (int bj = 0; bj < 2; ++bj)
#pragma unroll
                        for (int n = 0; n < 2; ++n) *(pg8::f32x4*)(rp + bj * 128 + n * 16) = acc[ai][bj][m][n]; }
        } else if (mode == 3) {
            const unsigned par = (unsigned)(u.pm + u.pn) & 1u;
            const unsigned ex = ldsx + par * 4096u + (unsigned)(wc * 32 + 4 * fq) * 4u;
#pragma unroll
            for (int ai = 0; ai < 2; ++ai)
#pragma unroll
                for (int n = 0; n < 2; ++n) {
                    if (fr == 0) *(LAS pg8::f32x4*)(uintptr_t)(ex + (unsigned)(((ai * 2 + wr) * 2 + 0) * 128 + n * 16) * 4u) = acc[ai][0][0][n];
                    if (fr == 15) *(LAS pg8::f32x4*)(uintptr_t)(ex + (unsigned)(((ai * 2 + wr) * 2 + 1) * 128 + n * 16) * 4u) = acc[ai][0][3][n];
                }
            asm volatile("s_waitcnt lgkmcnt(0)" ::: "memory"); __builtin_amdgcn_s_barrier(); asm volatile("" ::: "memory");
            const int jb = u.pn * 128 + wc * 32 + 4 * fq;
#pragma unroll
            for (int n = 0; n < 2; ++n) {
                const int j = jb + 16 * n;
                const pg8::f32x4 w0 = *(const pg8::f32x4*)(cw + j), w1 = *(const pg8::f32x4*)(cw + DFF + j), w2 = *(const pg8::f32x4*)(cw + 2 * DFF + j), bb = *(const pg8::f32x4*)(cb + j);
#pragma unroll
                for (int ai = 0; ai < 2; ++ai) {
                    const int pblk = (ai * 2 + wr) - 1, nblk = (ai * 2 + wr) + 1;
                    pg8::f32x4 eprev = (pg8::f32x4){0.f, 0.f, 0.f, 0.f}, enext = eprev;
                    if (pblk >= 0) eprev = *(LAS const pg8::f32x4*)(uintptr_t)(ex + (unsigned)((pblk * 2 + 1) * 128 + n * 16) * 4u);
                    if (nblk <= 3) enext = *(LAS const pg8::f32x4*)(uintptr_t)(ex + (unsigned)((nblk * 2 + 0) * 128 + n * 16) * 4u);
#pragma unroll
                    for (int mm = 0; mm < 4; ++mm) {
                        const int trow = ai * 128 + wr * 64 + mm * 16 + fr, grow = u.pm * 254 - 1 + trow;
                        int t, T; seq_pos(grow < 0 ? 0 : grow, t, T);
                        const pg8::f32x4 gc = acc[ai][0][mm][n], uu = acc[ai][1][mm][n];
                        pg8::f32x4 gp, gn;
#pragma unroll
                        for (int i = 0; i < 4; ++i) {
                            const float pold = mm > 0 ? __int_as_float(__builtin_amdgcn_update_dpp(0, __float_as_int(acc[ai][0][mm > 0 ? mm - 1 : 0][n][i]), 0x121, 0xF, 0xF, false)) : eprev[i];
                            gp[i] = __int_as_float(__builtin_amdgcn_update_dpp(__float_as_int(pold), __float_as_int(gc[i]), 0x111, 0xF, 0xF, false));
                            const float nold = mm < 3 ? __int_as_float(__builtin_amdgcn_update_dpp(0, __float_as_int(acc[ai][0][mm < 3 ? mm + 1 : 3][n][i]), 0x12F, 0xF, 0xF, false)) : enext[i];
                            gn[i] = __int_as_float(__builtin_amdgcn_update_dpp(__float_as_int(nold), __float_as_int(gc[i]), 0x101, 0xF, 0xF, false));
                        }
                        if (t == 0) gp = (pg8::f32x4){0.f, 0.f, 0.f, 0.f};
                        if (t == T - 1) gn = (pg8::f32x4){0.f, 0.f, 0.f, 0.f};
                        const pg8::f32x4 z = gp * w0 + gc * w1 + gn * w2 + bb;
                        pg8::f32x4 a;
#pragma unroll
                        for (int i = 0; i < 4; ++i) a[i] = z[i] * __builtin_amdgcn_rcpf(1.0f + __expf(-z[i])) * uu[i];
                        if (trow >= 1 && trow <= 254 && grow < nrows) { v2u o; o.x = pk2h(a[0], a[1]); o.y = pk2h(a[2], a[3]); *(v2u*)(ob + (size_t)grow * DFF + j) = o; }
                    }
                }
            }
        } else if (mode == 2) {
#pragma unroll
            for (int ai = 0; ai < 2; ++ai)
#pragma unroll
                for (int m = 0; m < 4; ++m) { bf16* rp = ob + (size_t)(u.pm * 256 + ai * 128 + wr * 64 + m * 16 + fr) * ld + u.pn * 256 + wc * 32 + 4 * fq;
#pragma unroll
                    for (int bj = 0; bj < 2; ++bj)
#pragma unroll
                        for (int n = 0; n < 2; ++n) { const pg8::f32x4 v = acc[ai][bj][m][n]; v2u o; o.x = pk2h(v[0], v[1]); o.y = pk2h(v[2], v[3]); *(v2u*)(rp + bj * 128 + n * 16) = o; } }
        } else {
            const bool latent = u.pm < (MLAT / 256);
#pragma unroll
            for (int bj = 0; bj < 2; ++bj) {
                const int g32 = u.pn * 8 + bj * 4 + wc;
                if (g32 >= INW / 32) continue;
                const bool isdf = (g32 >= C_DFQ / 32 && g32 < C_DFV / 32), isgq = (g32 >= C_GQQ / 32 && g32 < C_GQV / 32);
                const float qs = (g32 >= C_DFQ / 32 && g32 < C_DFK / 32) ? SC_DF : ((g32 >= C_GQQ / 32 && g32 < C_GQK / 32) ? SC_GQ : 1.0f);
#pragma unroll
                for (int ai = 0; ai < 2; ++ai)
#pragma unroll
                    for (int m = 0; m < 4; ++m) {
                        const int row = u.pm * 256 + ai * 128 + wr * 64 + m * 16 + fr, s = row & (SEQ - 1), prow = s >> 6, pcol = s & 63;
                        pg8::f32x4 v0 = acc[ai][bj][m][0], v1 = acc[ai][bj][m][1];
                        if (isdf) {
                            pg8::f32x4 p0, p1;
#pragma unroll
                            for (int i = 0; i < 4; ++i) { p0[i] = __shfl_xor(v0[i], 32); p1[i] = __shfl_xor(v1[i], 32); }
                            if (latent) {
                                const int f0 = 4 * (fq & 1);
                                const pg8::f32x4 c0 = *(const pg8::f32x4*)(tab + prow * 8 + f0), s0 = *(const pg8::f32x4*)(tab + 512 + prow * 8 + f0);
                                const pg8::f32x4 c1 = *(const pg8::f32x4*)(tab + pcol * 8 + f0), s1 = *(const pg8::f32x4*)(tab + 512 + pcol * 8 + f0);
                                if (fq & 2) { v0 = v0 * c0 + p0 * s0; v1 = v1 * c1 + p1 * s1; } else { v0 = v0 * c0 - p0 * s0; v1 = v1 * c1 - p1 * s1; }
                            }
                        } else if (isgq) {
                            if (latent) {
                                const int pos = (g32 & 1) ? pcol : prow;
                                const pg8::f32x4 cc = *(const pg8::f32x4*)(tab + 1024 + pos * 16 + 4 * fq), ss = *(const pg8::f32x4*)(tab + 2048 + pos * 16 + 4 * fq);
                                const pg8::f32x4 a = v0 * cc - v1 * ss, b = v1 * cc + v0 * ss; v0 = a; v1 = b;
                            }
                        }
                        v0 = v0 * qs; v1 = v1 * qs;
                        bf16* rp = ob + (size_t)row * INP + g32 * 32 + 4 * fq;
                        v2u o; o.x = pk2h(v0[0], v0[1]); o.y = pk2h(v0[2], v0[3]); *(v2u*)rp = o;
                        o.x = pk2h(v1[0], v1[1]); o.y = pk2h(v1[2], v1[3]); *(v2u*)(rp + 16) = o;
                        asm volatile("" ::: "memory");
                    }
            }
        }
    }
};


template <int CTRL, int RM> __device__ __forceinline__ float dpp_mul1(float x) {
    return x * __int_as_float(__builtin_amdgcn_update_dpp(0x3f800000, __float_as_int(x), CTRL, RM, 0xF, false));
}
__device__ __forceinline__ float wave_mulscan(float x) {
    x = dpp_mul1<0x111, 0xF>(x); x = dpp_mul1<0x112, 0xF>(x); x = dpp_mul1<0x114, 0xF>(x); x = dpp_mul1<0x118, 0xF>(x);
    x = dpp_mul1<0x142, 0xA>(x); x = dpp_mul1<0x143, 0xC>(x); return x;
}
__device__ __forceinline__ float wave_shr1_one(float x) { return __int_as_float(__builtin_amdgcn_update_dpp(0x3f800000, __float_as_int(x), 0x138, 0xF, 0xF, false)); }
__device__ __forceinline__ bf16 bf1(float x) { return (bf16)(pk2h(x, 0.f) & 0xffffu); }

constexpr int FT_LD = 65, FT_ARR = 64 * FT_LD * 4;
constexpr int FT_BON = 9 * FT_ARR;
constexpr int FT_PR_LD = 200;
static_assert(66 * FT_PR_LD * 2 <= 2 * FT_ARR && FT_BON + 512 <= LDSCTL_OFF, "features LDS map");
__device__ __forceinline__ void rwkv_features(const Args& A, Frame& F, int l) {
    const int w = F.wave, n = F.lane, c15 = n & 15, g = n >> 4, tr = w >> 1, tc0 = (w & 1) * 2;
    const int h = F.bid & 3, c = h * 64 + n;
    const bf16* P = (const bf16*)(kws() + WS_RP);
    bf16* FV = (bf16*)(kws() + WS_FV); float* BON = (float*)(kws() + WS_BON); float* GLT = (float*)(kws() + WS_GLT);
    float cw[3][3];
#pragma unroll
    for (int tp = 0; tp < 3; ++tp)
#pragma unroll
        for (int j = 0; j < 3; ++j) cw[tp][j] = kin(I_RWCONV)[(size_t)(l * 3 + tp) * 768 + j * 256 + c];
    const float kkc = kin(I_RWKK)[l * 256 + c];
    bf16x8 Bw[2][2], Ba[2][2]; float w0c[2][2], a0c[2][2], kac2[2], rkc2[2];
#pragma unroll
    for (int t = 0; t < 2; ++t) { const int cn = h * 64 + 16 * (tc0 + t) + c15;
        kac2[t] = kin(I_RWKA)[l * 256 + cn]; rkc2[t] = kin(I_RWRK)[l * 256 + cn];
#pragma unroll
        for (int d = 0; d < 2; ++d) { w0c[d][t] = kin(I_RWW0)[(l * 2 + d) * 256 + cn]; a0c[d][t] = kin(I_RWA0)[(l * 2 + d) * 256 + cn];
            unsigned pw[4], pa[4];
#pragma unroll
            for (int j = 0; j < 8; j += 2) { const size_t o = ((size_t)(l * 2 + d) * 32 + 8 * g + j) * 256 + cn;
                pw[j >> 1] = pk2h(kin(I_RWWUP)[o], kin(I_RWWUP)[o + 256]); pa[j >> 1] = pk2h(kin(I_RWAUP)[o], kin(I_RWAUP)[o + 256]); }
            Bw[d][t] = __builtin_bit_cast(bf16x8, (v4u){pw[0], pw[1], pw[2], pw[3]}); Ba[d][t] = __builtin_bit_cast(bf16x8, (v4u){pa[0], pa[1], pa[2], pa[3]}); }
    }
    for (int u = F.bid; u < 4 * (MALL / 64); u += F.G) {
        const int gi = u >> 2, row0 = 64 * gi;
        int t0, T; seq_pos(row0, t0, T);
        __syncthreads();
        for (int p = F.tid; p < 66 * 24; p += NTHR) { const int rr = p / 24, q = p % 24, which = q >> 3, ch = q & 7, row = row0 - 1 + rr;
            const bool ok = (rr >= 1 && rr <= 64) || (rr == 0 ? t0 > 0 : t0 + 64 < T);
            unsigned z_ = 0u; asm volatile("" : "+v"(z_)); v4u v = (v4u){z_, z_, z_, z_};
            if (ok) v = *(const v4u*)(P + (size_t)row * INP + which * 256 + h * 64 + 8 * ch);
            *(LAS v4u*)(F.lds + (rr * FT_PR_LD + which * 64 + 8 * ch) * 2) = v; }
        v4u xwd[2], xad[2];
        { const bf16* pr = P + (size_t)(row0 + 16 * tr + c15) * INP + 8 * g;
#pragma unroll
          for (int d = 0; d < 2; ++d) { xwd[d] = *(const v4u*)(pr + C_WD + 32 * d); xad[d] = *(const v4u*)(pr + C_AD + 32 * d); } }
        __syncthreads();
#pragma unroll
        for (int rr = 0; rr < 8; ++rr) {
            const int i = 8 * w + rr;
            float xr[3], xk[3], xv[3];
#pragma unroll
            for (int tp = 0; tp < 3; ++tp) { const LAS bf16* pp = (const LAS bf16*)F.lds + (i + tp) * FT_PR_LD + n; xr[tp] = bf2f(pp[0]); xk[tp] = bf2f(pp[64]); xv[tp] = bf2f(pp[128]); }
            const float rq = bf2f(bf1(xr[0] * cw[0][0] + xr[1] * cw[1][0] + xr[2] * cw[2][0])), kq = bf2f(bf1(xk[0] * cw[0][1] + xk[1] * cw[1][1] + xk[2] * cw[2][1]));
            FV[(size_t)(row0 + i) * 256 + c] = bf1(xv[0] * cw[0][2] + xv[1] * cw[1][2] + xv[2] * cw[2][2]);
            const float kkraw = kq * kkc;
            const float kk = kkraw * (1.0f / fmaxf(sqrtf(wave_sum(kkraw * kkraw)), 1e-12f));
            LAS float* L = (LAS float*)F.lds + i * FT_LD + n;
            L[2 * (FT_ARR / 4)] = kk; L[7 * (FT_ARR / 4)] = rq; L[8 * (FT_ARR / 4)] = kq;
        }
        __syncthreads();
        {
            bf16x8 aw[2], aa[2];
#pragma unroll
            for (int d = 0; d < 2; ++d) { unsigned pw[4];
#pragma unroll
                for (int q = 0; q < 4; ++q) { const float x0 = __uint_as_float(xwd[d][q] << 16), x1 = __uint_as_float(xwd[d][q] & 0xffff0000u);
                    pw[q] = pk2h(1.0f - 2.0f * __builtin_amdgcn_rcpf(1.0f + __expf(2.0f * x0)), 1.0f - 2.0f * __builtin_amdgcn_rcpf(1.0f + __expf(2.0f * x1))); }
                aw[d] = __builtin_bit_cast(bf16x8, (v4u){pw[0], pw[1], pw[2], pw[3]}); aa[d] = __builtin_bit_cast(bf16x8, xad[d]); }
            float bsum[4] = {0.f, 0.f, 0.f, 0.f};
#pragma unroll
            for (int t = 0; t < 2; ++t) {
                float kkv[4], kqv[4], rqv[4];
#pragma unroll
                for (int r = 0; r < 4; ++r) { const LAS float* L = (const LAS float*)F.lds + (16 * tr + 4 * g + r) * FT_LD + 16 * (tc0 + t) + c15;
                    kkv[r] = L[2 * (FT_ARR / 4)]; rqv[r] = L[7 * (FT_ARR / 4)]; kqv[r] = L[8 * (FT_ARR / 4)]; }
#pragma unroll
                for (int d = 0; d < 2; ++d) {
                    const f32x4 wl = __builtin_amdgcn_mfma_f32_16x16x32_bf16(aw[d], Bw[d][t], (f32x4){0.f, 0.f, 0.f, 0.f}, 0, 0, 0);
                    const f32x4 al = __builtin_amdgcn_mfma_f32_16x16x32_bf16(aa[d], Ba[d][t], (f32x4){0.f, 0.f, 0.f, 0.f}, 0, 0, 0);
#pragma unroll
                    for (int r = 0; r < 4; ++r) {
                        const float wv = 1.0f + bf2f(bf1(__expf(-0.6065306597126334f * sigmoidf_(wl[r] + w0c[d][t])) - 1.0f)), aq = bf2f(bf1(sigmoidf_(al[r] + a0c[d][t])));
                        const float kd = kqv[r] * (1.0f + (aq - 1.0f) * kac2[t]);
                        LAS float* L = (LAS float*)F.lds + (16 * tr + 4 * g + r) * FT_LD + 16 * (tc0 + t) + c15;
                        L[(0 + d) * (FT_ARR / 4)] = wv; L[(3 + d) * (FT_ARR / 4)] = kkv[r] * aq; L[(5 + d) * (FT_ARR / 4)] = kd;
                        bsum[r] += rqv[r] * kd * rkc2[t];
                    }
                }
            }
#pragma unroll
            for (int r = 0; r < 4; ++r) { float s = bsum[r]; s = dpp_add<0xB1>(s); s = dpp_add<0x4E>(s); s = dpp_add<0x124>(s); s = dpp_add<0x128>(s);
                if (c15 == 0) *(LAS float*)(F.lds + FT_BON + ((w & 1) * 64 + 16 * tr + 4 * g + r) * 4) = s; }
        }
        __syncthreads();
        if (F.tid < 64) BON[(row0 + F.tid) * 4 + h] = *(LAS float*)(F.lds + FT_BON + F.tid * 4) + *(LAS float*)(F.lds + FT_BON + (64 + F.tid) * 4);
#pragma unroll
        for (int d = 0; d < 2; ++d) {
            const int i = d ? 63 - n : n;
            const LAS float* L = (const LAS float*)F.lds + i * FT_LD + 8 * w;
            unsigned al8[4], be8[4], kp8[4], rh8[4]; float g63[8];
#pragma unroll
            for (int e2 = 0; e2 < 4; ++e2) {
                float alv[2], bev[2], kpv[2], rhv[2];
#pragma unroll
                for (int q = 0; q < 2; ++q) { const int e = 2 * e2 + q;
                    const float gi_ = wave_mulscan(L[(0 + d) * (FT_ARR / 4) + e]), gim1 = wave_shr1_one(gi_), ig = __builtin_amdgcn_rcpf(gi_);
                    g63[e] = rdlane(gi_, 63);
                    alv[q] = gim1 * L[2 * (FT_ARR / 4) + e]; bev[q] = L[(3 + d) * (FT_ARR / 4) + e] * ig; kpv[q] = L[(5 + d) * (FT_ARR / 4) + e] * ig; rhv[q] = gi_ * L[7 * (FT_ARR / 4) + e]; }
                al8[e2] = pk2h(alv[0], alv[1]); be8[e2] = pk2h(bev[0], bev[1]); kp8[e2] = pk2h(kpv[0], kpv[1]); rh8[e2] = pk2h(rhv[0], rhv[1]);
            }
            const size_t o = (size_t)d * MALL * 256 + (size_t)(64 * gi + i) * 256 + h * 64 + 8 * w;
            *(v4u*)((bf16*)(kws() + WS_GAL) + o) = (v4u){al8[0], al8[1], al8[2], al8[3]}; *(v4u*)((bf16*)(kws() + WS_GBE) + o) = (v4u){be8[0], be8[1], be8[2], be8[3]};
            *(v4u*)((bf16*)(kws() + WS_GKP) + o) = (v4u){kp8[0], kp8[1], kp8[2], kp8[3]}; *(v4u*)((bf16*)(kws() + WS_GRH) + o) = (v4u){rh8[0], rh8[1], rh8[2], rh8[3]};
            if (n < 8) { float gl = g63[0];
#pragma unroll
                for (int e = 1; e < 8; ++e) gl = (n == e) ? g63[e] : gl;
                GLT[((size_t)d * 272 + gi) * 256 + h * 64 + 8 * w + n] = gl; }
        }
    }
}

__device__ __forceinline__ int scan_row(int d, int b, int i) { if (i < CTXL) { const int t = d ? CTXL - 1 - i : i; return MLAT + b * CTXL + t; } const int j = i - CTXL, t = d ? SEQ - 1 - j : j; return b * SEQ + t; }

__device__ __forceinline__ void rwkv_readout(const Args& A, Frame& F, int l) {
    const int gw = F.bid * NWAVES + F.wave, NGW = F.G * NWAVES, nrows = l == 0 ? MALL : MLAT;
    const int h = gw & 3, c15 = F.lane & 15, g = F.lane >> 4;
    const bf16* P = (const bf16*)(kws() + WS_RP); const bf16* FV = (const bf16*)(kws() + WS_FV);
    const float* BON = (const float*)(kws() + WS_BON); bf16* Y = (bf16*)(kws() + WS_XN);
    bf16x8 ga[4][2];
#pragma unroll
    for (int nt = 0; nt < 4; ++nt)
#pragma unroll
        for (int ks = 0; ks < 2; ++ks) { unsigned pw[4]; const float* gp = kin(I_RWGUP) + ((size_t)l * 64 + 32 * ks + 8 * g) * 256 + h * 64 + 16 * nt + c15;
#pragma unroll
            for (int i = 0; i < 8; i += 2) pw[i >> 1] = pk2h(gp[(size_t)i * 256], gp[(size_t)(i + 1) * 256]);
            ga[nt][ks] = __builtin_bit_cast(bf16x8, (v4u){pw[0], pw[1], pw[2], pw[3]}); }
    f32x4 lg[4], lb[4];
#pragma unroll
    for (int nt = 0; nt < 4; ++nt) { lg[nt] = *(const f32x4*)(kin(I_RWLNG) + l * 256 + h * 64 + 16 * nt + 4 * g); lb[nt] = *(const f32x4*)(kin(I_RWLNB) + l * 256 + h * 64 + 16 * nt + 4 * g); }
    for (int task = gw >> 2; task < nrows / 16; task += NGW >> 2) {
        const int row = 16 * task + c15;
        const bf16* pr = P + (size_t)row * INP;
        const v4u gd0 = *(const v4u*)(pr + C_GD + 8 * g), gd1 = *(const v4u*)(pr + C_GD + 32 + 8 * g);
        v2u of[4], ob[4], fv[4];
#pragma unroll
        for (int nt = 0; nt < 4; ++nt) { of[nt] = *(const v2u*)(pr + h * 64 + 16 * nt + 4 * g); ob[nt] = *(const v2u*)(pr + 256 + h * 64 + 16 * nt + 4 * g); fv[nt] = *(const v2u*)(FV + (size_t)row * 256 + h * 64 + 16 * nt + 4 * g); }
        const float bon = BON[row * 4 + h];
        bf16x8 sb[2];
#pragma unroll
        for (int ks = 0; ks < 2; ++ks) { const v4u q = ks ? gd1 : gd0; unsigned pw[4];
#pragma unroll
            for (int i = 0; i < 4; ++i) pw[i] = pk2h(sigmoidf_(__uint_as_float(q[i] << 16)), sigmoidf_(__uint_as_float(q[i] & 0xffff0000u)));
            sb[ks] = __builtin_bit_cast(bf16x8, (v4u){pw[0], pw[1], pw[2], pw[3]}); }
        f32x4 gt[4], ov[4]; float s = 0.f;
#pragma unroll
        for (int nt = 0; nt < 4; ++nt) { gt[nt] = (f32x4){0.f, 0.f, 0.f, 0.f};
#pragma unroll
            for (int ks = 0; ks < 2; ++ks) gt[nt] = __builtin_amdgcn_mfma_f32_16x16x32_bf16(ga[nt][ks], sb[ks], gt[nt], 0, 0, 0);
            ov[nt] = (f32x4){__uint_as_float(of[nt].x << 16) + __uint_as_float(ob[nt].x << 16), __uint_as_float(of[nt].x & 0xffff0000u) + __uint_as_float(ob[nt].x & 0xffff0000u),
                             __uint_as_float(of[nt].y << 16) + __uint_as_float(ob[nt].y << 16), __uint_as_float(of[nt].y & 0xffff0000u) + __uint_as_float(ob[nt].y & 0xffff0000u)};
            s += (ov[nt][0] + ov[nt][1]) + (ov[nt][2] + ov[nt][3]); }
        s += __shfl_xor(s, 16); s += __shfl_xor(s, 32);
        const float mu = s * (1.0f / 64.0f); float q2 = 0.f;
#pragma unroll
        for (int nt = 0; nt < 4; ++nt) { ov[nt] = ov[nt] - mu; q2 += (ov[nt][0] * ov[nt][0] + ov[nt][1] * ov[nt][1]) + (ov[nt][2] * ov[nt][2] + ov[nt][3] * ov[nt][3]); }
        q2 += __shfl_xor(q2, 16); q2 += __shfl_xor(q2, 32);
        const float rs = rsqrtf(q2 * (1.0f / 64.0f) + 64e-5f);
        bf16* yp = Y + (size_t)row * D + h * 64 + 4 * g;
#pragma unroll
        for (int nt = 0; nt < 4; ++nt) {
            const f32x4 vv = (f32x4){__uint_as_float(fv[nt].x << 16), __uint_as_float(fv[nt].x & 0xffff0000u), __uint_as_float(fv[nt].y << 16), __uint_as_float(fv[nt].y & 0xffff0000u)};
            const f32x4 y = (ov[nt] * rs * lg[nt] + lb[nt] + vv * bon) * gt[nt];
            v2u w; w.x = pk2h(y[0], y[1]); w.y = pk2h(y[2], y[3]); *(v2u*)(yp + 16 * nt) = w; }
    }
}


constexpr int CK_LD = 72, CK_MAT = 64 * CK_LD * 2, CK_HALF = 32 * CK_LD * 2;
constexpr int O_AL = 0, O_BE = 2 * CK_MAT, O_RH = 4 * CK_MAT, O_KP = 6 * CK_MAT, O_V = 7 * CK_MAT, O_AOFF = 8 * CK_MAT, O_MB = 10 * CK_MAT, O_BM = 12 * CK_MAT, O_MK = 13 * CK_MAT;
constexpr int O_SB = 14 * CK_MAT, O_YZ = O_SB + 2 * CK_HALF, O_UT = O_YZ + CK_HALF;
constexpr int CK_TD_LD = 40, CK_TDSZ = 64 * CK_TD_LD * 2;
constexpr int CK_TD = O_UT + CK_HALF;
constexpr int CK_ADG = CK_TD + 2 * CK_TDSZ;
constexpr int CK_GL = CK_ADG + 4096;
constexpr int CK_END = CK_GL + 512;
static_assert(CK_END <= LDSCTL_OFF, "chunk scan LDS map");
struct CkAddr { unsigned v1t, lds, vX0, vT0, vR0; };
typedef short v4s16 __attribute__((ext_vector_type(4)));
#define CKP(T, addr) ((LAS T*)(uintptr_t)(addr))
__device__ __forceinline__ bf16x8 ldtr(unsigned addr) {
    const v4s16 lo = __builtin_amdgcn_ds_read_tr16_b64_v4i16((LAS v4s16*)(uintptr_t)addr), hi = __builtin_amdgcn_ds_read_tr16_b64_v4i16((LAS v4s16*)(uintptr_t)(addr + 4 * CK_LD * 2));
    return __builtin_bit_cast(bf16x8, __builtin_shufflevector(lo, hi, 0, 1, 2, 3, 4, 5, 6, 7));
}
template <int KS, bool TRX, bool TRY> __device__ __forceinline__ void mm1(f32x4& acc, const CkAddr& K, unsigned ox, unsigned oy, int xt, int yt) {
    const unsigned ax = (TRX ? K.vR0 + xt * 32 : K.vX0 + xt * (16 * CK_LD * 2)) + ox;
    const unsigned ay = (TRY ? K.vR0 + yt * 32 : K.vX0 + yt * (16 * CK_LD * 2)) + oy;
#pragma unroll
    for (int ks = 0; ks < KS; ++ks) {
        const bf16x8 a = TRX ? ldtr(ax + ks * (32 * CK_LD * 2)) : *CKP(const bf16x8, ax + 64 * ks);
        const bf16x8 bq = TRY ? ldtr(ay + ks * (32 * CK_LD * 2)) : *CKP(const bf16x8, ay + 64 * ks);
        acc = __builtin_amdgcn_mfma_f32_16x16x32_bf16(a, bq, acc, 0, 0, 0); }
}
__device__ __forceinline__ void stT1(const CkAddr& K, unsigned o, int rt, int ct, const f32x4 v) {
    v2u q; q.x = pk2h(v[0], v[1]); q.y = pk2h(v[2], v[3]); *CKP(v2u, K.vT0 + o + ct * (16 * CK_LD * 2) + rt * 32) = q;
}
__device__ __forceinline__ void ck_tile4(const CkAddr& K, int xt, int yt, unsigned oAL, unsigned oBE, unsigned oRH, f32x4& pa, f32x4& pb, f32x4& pm, f32x4& pk) {
    pa = (f32x4){0.f, 0.f, 0.f, 0.f}; pb = pa; pm = pa; pk = pa;
    mm1<2, false, false>(pa, K, oBE, oAL, xt, yt); mm1<2, false, false>(pb, K, O_KP, oAL, xt, yt); mm1<2, false, false>(pm, K, oBE, oRH, xt, yt); mm1<2, false, false>(pk, K, O_KP, oRH, xt, yt);
}
__device__ __forceinline__ void rwkv_chunk_unit(const Args& A, Frame& F, int l, int sc, int vh) {
    const bool last = (l == 1);
    const int d = sc >> 4, b = (sc >> 2) & 3, h = sc & 3;
    const int w = F.wave, n = F.lane;
    const bf16* GAL = (const bf16*)(kws() + WS_GAL) + (size_t)d * MALL * 256; const bf16* GBE = (const bf16*)(kws() + WS_GBE) + (size_t)d * MALL * 256;
    const bf16* GKP = (const bf16*)(kws() + WS_GKP) + (size_t)d * MALL * 256; const bf16* GRH = (const bf16*)(kws() + WS_GRH) + (size_t)d * MALL * 256;
    const bf16* FV = (const bf16*)(kws() + WS_FV); const float* GLT = (const float*)(kws() + WS_GLT) + (size_t)d * 272 * 256;
    bf16* O = (bf16*)(kws() + WS_RP) + d * 256;
    constexpr int NCK = (CTXL + SEQ) / 64;
    v4u ual, ube, ukp, urh, uv; float fgl = 0.f;
#define CK_FETCH(cc_) do { const int cq_ = (cc_) < NCK ? (cc_) : NCK - 1; const int row_ = scan_row(d, b, 64 * cq_ + 8 * w + (n >> 3)); const size_t o_ = (size_t)row_ * 256 + h * 64 + 8 * (n & 7); \
        ual = *(const v4u*)(GAL + o_); ube = *(const v4u*)(GBE + o_); ukp = *(const v4u*)(GKP + o_); urh = *(const v4u*)(GRH + o_); uv = *(const v4u*)(FV + o_); \
        if (w == 0) fgl = GLT[(size_t)(scan_row(d, b, 64 * cq_) >> 6) * 256 + h * 64 + n]; } while (0)
    CK_FETCH(0);
    __syncthreads();
    { unsigned z_ = 0u; asm volatile("" : "+v"(z_));
      for (int i = F.tid; i < CK_END / 16; i += NTHR) *(LAS v4u*)(F.lds + i * 16) = (v4u){z_, z_, z_, z_}; }
    f32x4 st = (f32x4){0.f, 0.f, 0.f, 0.f};
    f32x4 st0 = st, yb0 = st, ob0 = st;
    __syncthreads();
    for (int c = -1; c < NCK; ++c) {
        int c15 = n & 15, g = n >> 4; asm volatile("" : "+v"(c15), "+v"(g));
        CkAddr K; K.lds = (unsigned)(uintptr_t)F.lds;
        K.v1t = K.lds + ((8 * w + (n >> 3)) * CK_LD + 8 * (n & 7)) * 2;
        K.vR0 = K.lds + ((8 * g + (c15 >> 2)) * CK_LD + 4 * (c15 & 3)) * 2;
        K.vX0 = K.lds + (c15 * CK_LD + 8 * g) * 2; K.vT0 = K.lds + (c15 * CK_LD + 4 * g) * 2;
        asm volatile("" : "+v"(K.v1t), "+v"(K.vX0), "+v"(K.vT0), "+v"(K.vR0));
        const int ti = w >> 1, tv = w & 1, tv2 = w >> 2, tk = w & 3;
        const unsigned pc = (unsigned)(c & 1), pn = pc ^ 1u;
        const unsigned oAL = O_AL + pc * CK_MAT, oBE = O_BE + pc * CK_MAT, oRH = O_RH + pc * CK_MAT, oAOFF = O_AOFF + pc * CK_MAT, oMB = O_MB + pc * CK_MAT, oSB = O_SB + pc * CK_HALF, oTD = CK_TD + pc * CK_TDSZ, oGL = CK_GL + pc * 256;
        const unsigned nAL = O_AL + pn * CK_MAT, nBE = O_BE + pn * CK_MAT, nRH = O_RH + pn * CK_MAT, nAOFF = O_AOFF + pn * CK_MAT, nMB = O_MB + pn * CK_MAT, nSB = O_SB + pn * CK_HALF, nTD = CK_TD + pn * CK_TDSZ, nGL = CK_GL + pn * 256;
        const bool skip_o = c < 0 || (last && c < CTXL / 64), skip_on = last && c + 1 < CTXL / 64;
        *CKP(v4u, K.v1t + nAL) = ual; *CKP(v4u, K.v1t + nBE) = ube; *CKP(v4u, K.v1t + O_KP) = ukp; *CKP(v4u, K.v1t + nRH) = urh; *CKP(v4u, K.v1t + O_V) = uv;
        if (w == 0) *CKP(float, K.lds + nGL + n * 4) = fgl;
        asm volatile("" ::: "memory");
        CK_FETCH(c + 2);
        { f32x4 yb = yb0; mm1<2, false, false>(yb, K, oAL, oSB, ti, tv); stT1(K, O_YZ, ti, tv, yb); }
        __syncthreads();
        if (w < 2) {
            const unsigned aX = K.lds + ((c15) * CK_LD + 8 * g) * 2;
            const unsigned bY = K.lds + ((16 * w + c15) * CK_LD + 8 * g) * 2;
            const unsigned cT = K.lds + ((16 * w + c15) * CK_LD + 4 * g) * 2;
#pragma unroll
            for (int blk = 0; blk < 4; ++blk) {
                f32x4 z = (f32x4){0.f, 0.f, 0.f, 0.f};
                if (blk > 0) {
#pragma unroll
                    for (int ks = 0; ks < (blk == 3 ? 2 : 1); ++ks) {
                        const bf16x8 a = *CKP(const bf16x8, aX + oAOFF + blk * (16 * CK_LD * 2) + 64 * ks);
                        const bf16x8 u = *CKP(const bf16x8, bY + O_UT + 64 * ks);
                        z = __builtin_amdgcn_mfma_f32_16x16x32_bf16(a, u, z, 0, 0, 0); }
                }
                { const v2u yv = *CKP(const v2u, cT + O_YZ + 32 * blk);
                  z[0] += __uint_as_float(yv.x << 16); z[1] += __uint_as_float(yv.x & 0xffff0000u); z[2] += __uint_as_float(yv.y << 16); z[3] += __uint_as_float(yv.y & 0xffff0000u); }
                { v2u zo; zo.x = pk2h(z[0], z[1]); zo.y = pk2h(z[2], z[3]); *CKP(v2u, cT + O_YZ + 32 * blk) = zo; }
                asm volatile("s_waitcnt lgkmcnt(0)" ::: "memory");
                const bf16x8 ta = *CKP(const bf16x8, K.lds + oTD + ((16 * blk + c15) * CK_TD_LD + 8 * g) * 2);
                const bf16x8 zb = *CKP(const bf16x8, bY + O_YZ + 32 * blk);
                f32x4 u = __builtin_amdgcn_mfma_f32_16x16x32_bf16(ta, zb, (f32x4){0.f, 0.f, 0.f, 0.f}, 0, 0, 0);
                { v2u uo; uo.x = pk2h(-u[0], -u[1]); uo.y = pk2h(-u[2], -u[3]); *CKP(v2u, cT + O_UT + 32 * blk) = uo; }
                asm volatile("s_waitcnt lgkmcnt(0)" ::: "memory");
            }
        } else if (w < 6) {
            const int bb = w - 2;
            f32x4 pa, pb, pm, pk; ck_tile4(K, bb, bb, nAL, nBE, nRH, pa, pb, pm, pk);
#pragma unroll
            for (int r = 0; r < 4; ++r) { const bool strict = 4 * g + r < c15, incl = 4 * g + r <= c15;
                pa[r] = strict ? pa[r] : 0.f; pb[r] = strict ? pb[r] : 0.f; pm[r] = incl ? pm[r] : 0.f; pk[r] = incl ? pk[r] : 0.f; }
            *CKP(f32x4, K.lds + CK_ADG + ((bb * 16 + c15) * 16 + 4 * g) * 4) = pa;
            stT1(K, O_BM, bb, bb, pb); stT1(K, nMB, bb, bb, pm); stT1(K, O_MK, bb, bb, pk);
            asm volatile("s_waitcnt lgkmcnt(0)" ::: "memory");
            if (n < 16) { float tcol[16];
                f32x4 arow[16][4];
#pragma unroll
                for (int r = 1; r < 16; ++r)
#pragma unroll
                    for (int s4 = 0; s4 * 4 < r; ++s4) arow[r][s4] = *CKP(const f32x4, K.lds + CK_ADG + ((bb * 16 + r) * 16 + 4 * s4) * 4);
#pragma unroll
                for (int r = 0; r < 16; ++r) { float acc = (r == n) ? 1.f : 0.f;
#pragma unroll
                    for (int s = 0; s < r; ++s) acc = fmaf(-arow[r][s >> 2][s & 3], tcol[s], acc);
                    tcol[r] = acc; *CKP(bf16, K.lds + nTD + ((16 * bb + r) * CK_TD_LD + n) * 2) = bf1(acc); }
            }
        } else {
#pragma unroll
            for (int q = 0; q < 3; ++q) {
                const int xt = (w & 1) ? (q == 0 ? 1 : 0) : (q == 0 ? 0 : q == 1 ? 2 : 1), yt = (w & 1) ? (q == 2 ? 3 : 2) : (q == 0 ? 1 : 3);
                f32x4 pa, pb, pm, pk; ck_tile4(K, xt, yt, nAL, nBE, nRH, pa, pb, pm, pk);
                stT1(K, nAOFF, xt, yt, pa); stT1(K, O_BM, xt, yt, pb); stT1(K, nMB, xt, yt, pm); stT1(K, O_MK, xt, yt, pk);
            }
        }
        __syncthreads();
        if (!skip_o) {
            f32x4 ob = ob0;
            mm1<2, false, false>(ob, K, oSB, oRH, tv, ti); mm1<2, false, false>(ob, K, O_UT, oMB, tv, ti);
            const int row = scan_row(d, b, 64 * c + 16 * ti + c15); v2u oo; oo.x = pk2h(ob[0], ob[1]); oo.y = pk2h(ob[2], ob[3]);
            *(v2u*)(O + (size_t)row * INP + h * 64 + 32 * vh + 16 * tv + 4 * g) = oo;
        }
        { mm1<2, true, false>(st, K, oBE, O_UT, tk, tv2);
          const f32x4 gl = *CKP(const f32x4, K.lds + oGL + (16 * tk + 4 * g) * 4); st = (st + st0) * gl; stT1(K, nSB, tk, tv2, st); }
        yb0 = (f32x4){0.f, 0.f, 0.f, 0.f}; ob0 = yb0; st0 = yb0;
        mm1<2, false, true>(yb0, K, O_BM, O_V, ti, 2 * vh + tv);
        if (!skip_on) mm1<2, true, false>(ob0, K, O_V, O_MK, 2 * vh + tv, ti);
        mm1<2, true, true>(st0, K, O_KP, O_V, tk, 2 * vh + tv2);
        __syncthreads();
    }
#undef CK_FETCH
}
#undef CKP

struct KeyStream { int ctx_row0, nloc, loc_row0, loc_pos0; };
constexpr int AT_KSZ = 9216, AT_VSZ = 9216, AT_KB = 0, AT_VB = 3 * AT_KSZ;
typedef float f32x4a __attribute__((ext_vector_type(4)));

typedef __bf16 bf16v2 __attribute__((ext_vector_type(2)));
__device__ __forceinline__ float dot2_ones(unsigned pair, float acc) { return __builtin_amdgcn_fdot2_f32_bf16(__builtin_bit_cast(bf16v2, pair), __builtin_bit_cast(bf16v2, 0x3f803f80u), acc, false); }
template <int NMAP, int DK, int QS, bool MASK, bool XT>
__device__ __forceinline__ void attn_core(Frame& F, const bf16* P, int kcol, int vcol, const KeyStream ks, const bf16x8 (&qf)[QS][NMAP][DK / 32], int qpos0,
                                          f32x4 (&o)[QS][NMAP][4], float (&m)[QS][NMAP], float (&lsum)[QS][NMAP]) {
    const int c15 = F.lane & 15, g = F.lane >> 4;
    const int lkey = F.tid >> 3, lch = F.tid & 7;
    const int ntiles = 4 + ks.nloc;
#pragma unroll
    for (int qs = 0; qs < QS; ++qs)
#pragma unroll
        for (int mp = 0; mp < NMAP; ++mp) { m[qs][mp] = 0.f; lsum[qs][mp] = 0.f;
#pragma unroll
            for (int dt = 0; dt < 4; ++dt) o[qs][mp][dt] = (f32x4){0.f, 0.f, 0.f, 0.f}; }
    v4u stgk, stgv; const unsigned lofs = (unsigned)(lkey * INP + 8 * lch) * 2u;
#define AT_ROW(ti) ((ti) < 4 ? ks.ctx_row0 + 64 * (ti) : ks.loc_row0 + 64 * ((ti) - 4))
#define AT_LOADK(ti) do { const int t_ = (ti) < ntiles ? (ti) : ntiles - 1; unsigned long long pb_ = (unsigned long long)(uintptr_t)(P + (size_t)AT_ROW(t_) * INP + kcol); asm volatile("" : "+s"(pb_)); stgk = *(const GAS v4u*)(uintptr_t)(pb_ + lofs); } while (0)
#define AT_LOADV(ti) do { const int t_ = (ti) < ntiles ? (ti) : ntiles - 1; unsigned long long pb_ = (unsigned long long)(uintptr_t)(P + (size_t)AT_ROW(t_) * INP + vcol); asm volatile("" : "+s"(pb_)); stgv = *(const GAS v4u*)(uintptr_t)(pb_ + lofs); } while (0)
#define AT_WRITEK(kb_) do { *(LAS v4u*)(F.lds + (kb_) + lkey * 144 + lch * 16) = stgk; } while (0)
#define AT_WRITEV(vb_) do { *(LAS v4u*)(F.lds + (vb_) + lkey * 144 + lch * 16) = stgv; } while (0)
#define AT_QK(dst, kb_, sx_) do { bf16x8 kf_[2][NMAP][DK / 32]; \
        _Pragma("unroll") for (int kh = 0; kh < 2; ++kh) _Pragma("unroll") for (int mp = 0; mp < NMAP; ++mp) _Pragma("unroll") for (int kx = 0; kx < DK / 32; ++kx) \
            kf_[kh][mp][kx] = *(LAS bf16x8*)(F.lds + (kb_) + (32 * (sx_) + 16 * kh + c15) * 144 + (mp * DK + 32 * kx + 8 * g) * 2); \
        _Pragma("unroll") for (int qs = 0; qs < QS; ++qs) _Pragma("unroll") for (int mp = 0; mp < NMAP; ++mp) { const float negm = -m[qs][mp]; \
            _Pragma("unroll") for (int kh = 0; kh < 2; ++kh) { dst[qs][mp][kh] = (f32x4){negm, negm, negm, negm}; \
                _Pragma("unroll") for (int kx = 0; kx < DK / 32; ++kx) dst[qs][mp][kh] = __builtin_amdgcn_mfma_f32_16x16x32_bf16(kf_[kh][mp][kx], qf[qs][mp][kx], dst[qs][mp][kh], 0, 0, 0); } } } while (0)
#define AT_MASK(dst, ti_, sx_) do { if (MASK && (ti_) >= 4) { const int kb_ = ks.loc_pos0 + 64 * ((ti_) - 4) + 32 * (sx_); \
        if (kb_ + 31 - qpos0 > 128 || kb_ - (qpos0 + 16 * QS - 1) < -128) {       \
            _Pragma("unroll") for (int qs = 0; qs < QS; ++qs) { const int qp_ = qpos0 + 16 * qs + c15; \
                _Pragma("unroll") for (int mp = 0; mp < NMAP; ++mp) _Pragma("unroll") for (int kh = 0; kh < 2; ++kh) _Pragma("unroll") for (int r = 0; r < 4; ++r) { \
                    const int dd_ = kb_ + 4 * g + 16 * kh + r - qp_; dst[qs][mp][kh][r] = (dd_ > 128 || dd_ < -128) ? -INFINITY : dst[qs][mp][kh][r]; } } } } } while (0)
    __syncthreads();
    AT_LOADK(0); AT_WRITEK(AT_KB); AT_LOADV(0); AT_WRITEV(AT_VB); AT_LOADK(1); AT_WRITEK(AT_KB + AT_KSZ); AT_LOADV(1);
    __syncthreads();
    f32x4 st[QS][NMAP][2], sn[QS][NMAP][2];
    if (XT) AT_QK(st, AT_KB, 0);
    unsigned kcur = AT_KB, knxt = AT_KB + AT_KSZ, kfar = AT_KB + 2 * AT_KSZ;
    for (int ti = 0; ti < ntiles; ++ti) {
        const unsigned vcur = AT_VB + (ti & 1) * AT_VSZ, vnxt = AT_VB + ((ti + 1) & 1) * AT_VSZ;
        if (!XT) AT_QK(st, kcur, 0);
#pragma unroll
        for (int sx = 0; sx < 2; ++sx) {
        if (sx == 0) AT_QK(sn, kcur, 1); else if (XT) AT_QK(sn, knxt, 0);
        if (sx == 0) AT_LOADK(ti + 2); else AT_LOADV(ti + 2);
        bf16x8 vf[4];
#pragma unroll
        for (int dt = 0; dt < 4; ++dt) { const unsigned va_ = (unsigned)(uintptr_t)F.lds + vcur + (32 * sx + 4 * g + (c15 >> 2)) * 144 + (16 * dt + 4 * (c15 & 3)) * 2;
            const v4s16 lo = __builtin_amdgcn_ds_read_tr16_b64_v4i16((LAS v4s16*)(uintptr_t)va_), hi = __builtin_amdgcn_ds_read_tr16_b64_v4i16((LAS v4s16*)(uintptr_t)(va_ + 16 * 144));
            vf[dt] = __builtin_bit_cast(bf16x8, __builtin_shufflevector(lo, hi, 0, 1, 2, 3, 4, 5, 6, 7)); }
        v4u pw[QS][NMAP]; float ps[QS][NMAP];
        AT_MASK(st, ti, sx);
        float big = 0.f;
#pragma unroll
        for (int qs = 0; qs < QS; ++qs)
#pragma unroll
            for (int mp = 0; mp < NMAP; ++mp) { float e[8];
#pragma unroll
                for (int kh = 0; kh < 2; ++kh)
#pragma unroll
                    for (int r = 0; r < 4; ++r) e[kh * 4 + r] = __builtin_amdgcn_exp2f(st[qs][mp][kh][r]);
                pw[qs][mp] = (v4u){pk2h(e[0], e[1]), pk2h(e[2], e[3]), pk2h(e[4], e[5]), pk2h(e[6], e[7])};
                const float s_ = dot2_ones(pw[qs][mp].w, dot2_ones(pw[qs][mp].z, dot2_ones(pw[qs][mp].y, dot2_ones(pw[qs][mp].x, 0.f))));
                ps[qs][mp] = s_; big = fmaxf(big, s_); }
        if (__builtin_amdgcn_ballot_w64(!(big < 1048576.0f)) != 0ull) {
            f32x4 sr[QS][NMAP][2];
            AT_QK(sr, kcur, sx); AT_MASK(sr, ti, sx);
#pragma unroll
            for (int qs = 0; qs < QS; ++qs)
#pragma unroll
                for (int mp = 0; mp < NMAP; ++mp) {
                    float mt = fmaxf(fmaxf(fmaxf(sr[qs][mp][0][0], sr[qs][mp][0][1]), fmaxf(sr[qs][mp][0][2], sr[qs][mp][0][3])), fmaxf(fmaxf(sr[qs][mp][1][0], sr[qs][mp][1][1]), fmaxf(sr[qs][mp][1][2], sr[qs][mp][1][3])));
                    mt = xmax4(mt);
                    const float delta = mt > 8.0f ? mt : 0.f, alpha = __builtin_amdgcn_exp2f(-delta);
                    m[qs][mp] += delta; lsum[qs][mp] *= alpha;
#pragma unroll
                    for (int dt = 0; dt < 4; ++dt) o[qs][mp][dt] = o[qs][mp][dt] * alpha;
                    if (sx == 0 || XT) {
#pragma unroll
                        for (int kh = 0; kh < 2; ++kh) sn[qs][mp][kh] = sn[qs][mp][kh] - delta; }
                    float e[8];
#pragma unroll
                    for (int kh = 0; kh < 2; ++kh)
#pragma unroll
                        for (int r = 0; r < 4; ++r) e[kh * 4 + r] = __builtin_amdgcn_exp2f(sr[qs][mp][kh][r] - delta);
                    pw[qs][mp] = (v4u){pk2h(e[0], e[1]), pk2h(e[2], e[3]), pk2h(e[4], e[5]), pk2h(e[6], e[7])};
                    ps[qs][mp] = dot2_ones(pw[qs][mp].w, dot2_ones(pw[qs][mp].z, dot2_ones(pw[qs][mp].y, dot2_ones(pw[qs][mp].x, 0.f))));
                }
        }
#pragma unroll
        for (int qs = 0; qs < QS; ++qs)
#pragma unroll
            for (int mp = 0; mp < NMAP; ++mp) {
                lsum[qs][mp] += ps[qs][mp];
                const bf16x8 pf = __builtin_bit_cast(bf16x8, pw[qs][mp]);
#pragma unroll
                for (int dt = 0; dt < 4; ++dt) o[qs][mp][dt] = __builtin_amdgcn_mfma_f32_16x16x32_bf16(vf[dt], pf, o[qs][mp][dt], 0, 0, 0);
            }
        if (sx == 0 || XT) {
#pragma unroll
            for (int qs = 0; qs < QS; ++qs)
#pragma unroll
                for (int mp = 0; mp < NMAP; ++mp) { st[qs][mp][0] = sn[qs][mp][0]; st[qs][mp][1] = sn[qs][mp][1]; } }
        if (sx == 0) AT_WRITEV(vnxt); else AT_WRITEK(kfar);
        }
        { const unsigned t_ = kcur; kcur = knxt; knxt = kfar; kfar = t_; }
        __syncthreads();
    }
#undef AT_QK
#undef AT_MASK
#undef AT_ROW
#undef AT_LOADK
#undef AT_LOADV
#undef AT_WRITEK
#undef AT_WRITEV
}

template <int QS>
__device__ __forceinline__ void diff_unit(const Args& A, Frame& F, int l, int b, int h, int qrow0, int nloc) {
    const bf16* P = (const bf16*)(kws() + WS_RP); bf16* Y = (bf16*)(kws() + WS_XN); const float* tab = (const float*)(kws() + WS_TAB);
    const int c15 = F.lane & 15, g = F.lane >> 4;
    bf16x8 qf[QS][2][1];
#pragma unroll
    for (int qs = 0; qs < QS; ++qs)
#pragma unroll
        for (int mp = 0; mp < 2; ++mp) qf[qs][mp][0] = *(const bf16x8*)(P + (size_t)(qrow0 + 16 * QS * F.wave + 16 * qs + c15) * INP + C_DFQ + h * 64 + mp * 32 + 8 * g);
    f32x4 o[QS][2][4]; float m[QS][2], ls[QS][2];
    const KeyStream ks{MLAT + b * CTXL, nloc, b * SEQ, 0};
    attn_core<2, 32, QS, false, true>(F, P, C_DFK + h * 64, C_DFV + h * 64, ks, qf, 0, o, m, ls);
    const float lam = tab[3072 + l], oscale = 1.0f - tab[3074 + l];
    const float* ng = kin(I_DFNG) + l * 64;
#pragma unroll
    for (int qs = 0; qs < QS; ++qs) {
        float inv[2];
#pragma unroll
        for (int mp = 0; mp < 2; ++mp) { float t = ls[qs][mp]; t += __shfl_xor(t, 16); t += __shfl_xor(t, 32); inv[mp] = 1.0f / t; }
        f32x4 ov[4]; float ss = 0.f;
#pragma unroll
        for (int dt = 0; dt < 4; ++dt) { ov[dt] = o[qs][0][dt] * inv[0] - o[qs][1][dt] * (lam * inv[1]); ss += (ov[dt][0] * ov[dt][0] + ov[dt][1] * ov[dt][1]) + (ov[dt][2] * ov[dt][2] + ov[dt][3] * ov[dt][3]); }
        ss += __shfl_xor(ss, 16); ss += __shfl_xor(ss, 32);
        const float r = rsqrtf(ss * (1.0f / 64.0f) + NORM_EPS) * oscale;
        bf16* yp = Y + (size_t)(qrow0 + 16 * QS * F.wave + 16 * qs + c15) * D + 256 + h * 64 + 4 * g;
#pragma unroll
        for (int dt = 0; dt < 4; ++dt) { const f32x4 gg = *(const f32x4*)(ng + 16 * dt + 4 * g); const f32x4 v = ov[dt] * r * gg;
            v2u w; w.x = pk2h(v[0], v[1]); w.y = pk2h(v[2], v[3]); *(v2u*)(yp + 16 * dt) = w; }
    }
}
__device__ __forceinline__ void gq_unit(const Args& A, Frame& F, int l, int b, int kv, int qrow0, int qpos_blk  ) {
    const bf16* P = (const bf16*)(kws() + WS_RP); bf16* Y = (bf16*)(kws() + WS_XN);
    const int c15 = F.lane & 15, g = F.lane >> 4;
    const int hq = kv * 4 + (F.wave >> 1), rbase = qrow0 + 64 * (F.wave & 1);
    bf16x8 qf[4][1][2];
#pragma unroll
    for (int qs = 0; qs < 4; ++qs)
#pragma unroll
        for (int kx = 0; kx < 2; ++kx) qf[qs][0][kx] = *(const bf16x8*)(P + (size_t)(rbase + 16 * qs + c15) * INP + C_GQQ + hq * 64 + 32 * kx + 8 * g);
    KeyStream ks{MLAT + b * CTXL, 0, 0, 0}; int qpos0 = 0;
    if (qpos_blk >= 0) { const int lo = qpos_blk > 0 ? (qpos_blk - 1) * 128 : 0, hi = qpos_blk < 31 ? (qpos_blk + 2) * 128 : SEQ;
        ks.nloc = (hi - lo) / 64; ks.loc_row0 = b * SEQ + lo; ks.loc_pos0 = lo; qpos0 = qpos_blk * 128 + 64 * (F.wave & 1); }
    f32x4 o[4][1][4]; float m[4][1], ls[4][1];
    attn_core<1, 64, 4, true, false>(F, P, C_GQK + kv * 64, C_GQV + kv * 64, ks, qf, qpos0, o, m, ls);
    const float sink2 = kin(I_GQSINK)[l * 8 + hq] * LOG2E;
#pragma unroll
    for (int qs = 0; qs < 4; ++qs) {
        float t = ls[qs][0]; t += __shfl_xor(t, 16); t += __shfl_xor(t, 32);
        const float mf = fmaxf(m[qs][0], sink2), e = __builtin_amdgcn_exp2f(m[qs][0] - mf), den = t * e + __builtin_amdgcn_exp2f(sink2 - mf), scl = e / den;
        bf16* yp = Y + (size_t)(rbase + 16 * qs + c15) * D + 512 + hq * 64 + 4 * g;
#pragma unroll
        for (int dt = 0; dt < 4; ++dt) { const f32x4 v = o[qs][0][dt] * scl; v2u w; w.x = pk2h(v[0], v[1]); w.y = pk2h(v[2], v[3]); *(v2u*)(yp + 16 * dt) = w; }
    }
}
__device__ __forceinline__ void phase_queue(const Args& A, Frame& F, int l, int rep) {
    gu32* head = (gu32*)(kws() + WS_CTL) + CW_QUEUE + 64 * l + 16 * rep;
    constexpr int DF_BIG = 256;
    const int total = 64 + DF_BIG + 2 * (256 - DF_BIG) + 256 + (l == 0 ? 48 + WI_FILL : 0);
    volatile LAS int* slot = (volatile LAS int*)(F.lds + MISC_OFF) + 16;
    for (;;) {
        asm volatile("" : "+v"(F.tid), "+v"(F.lane));
        __syncthreads();
        if (F.tid == 0) *slot = (int)__hip_atomic_fetch_add(head, 1u, __ATOMIC_RELAXED, __HIP_MEMORY_SCOPE_AGENT);
        __syncthreads();
        int u = __builtin_amdgcn_readfirstlane(*slot);
        if (u >= total) break;
#if MK_AMP & 1
        if (u < 64) { const unsigned long long t0_ = __builtin_amdgcn_s_memrealtime(); rwkv_chunk_unit(A, F, l, u >> 1, u & 1); const unsigned long long t1_ = __builtin_amdgcn_s_memrealtime();
            while (__builtin_amdgcn_s_memrealtime() - t1_ < t1_ - t0_) __builtin_amdgcn_s_sleep(8); continue; }
#endif
        if (u < 64) { rwkv_chunk_unit(A, F, l, u >> 1, u & 1); continue; }
        u -= 64;
#if MK_AMP & 2
        if (u < DF_BIG) { const unsigned long long t0_ = __builtin_amdgcn_s_memrealtime(); { const int b = u >> 6, h = (u >> 4) & 3, qb = u & 15; diff_unit<2>(A, F, l, b, h, b * SEQ + qb * 256, SEQ / 64); } const unsigned long long t1_ = __builtin_amdgcn_s_memrealtime();
            while (__builtin_amdgcn_s_memrealtime() - t1_ < t1_ - t0_) __builtin_amdgcn_s_sleep(8); continue; }
#endif
        if (u < DF_BIG) { const int b = u >> 6, h = (u >> 4) & 3, qb = u & 15; diff_unit<2>(A, F, l, b, h, b * SEQ + qb * 256, SEQ / 64); continue; }
        if (u < DF_BIG + 2 * (256 - DF_BIG)) { const int v = 2 * DF_BIG + (u - DF_BIG), b = v >> 7, h = (v >> 5) & 3, qh = v & 31; diff_unit<1>(A, F, l, b, h, b * SEQ + qh * 128, SEQ / 64); continue; }
        u -= DF_BIG + 2 * (256 - DF_BIG) - 512;
        u -= 512;
        if (u < 256) { const int b = u >> 6, kv = (u >> 5) & 1, nb = u & 31; gq_unit(A, F, l, b, kv, b * SEQ + nb * 128, nb); continue; }
        u -= 256;
        if (u < 32) { const int b = u >> 3, h = (u >> 1) & 3, hf = u & 1; diff_unit<1>(A, F, l, b, h, MLAT + b * CTXL + hf * 128, 0); continue; }
        u -= 32;
        if (u < 16) { const int b = u >> 2, kv = (u >> 1) & 1, hf = u & 1; gq_unit(A, F, l, b, kv, MLAT + b * CTXL + hf * 128, -1); continue; }
        u -= 16;
        { LAS float* scr = (LAS float*)(F.lds + F.wave * 16384);
          for (int k = 0; k < 16; ++k) { const int it = WI_IN + u * 128 + F.wave * 16 + k; if (it < 2 * WI_LAYER) weight_item(it, scr, F.lane); } }
    }
}

constexpr int N_PHASES = (MK_FUSE == 3) ? 18 : 20;
}

__global__ void __launch_bounds__(mk::NTHR, 2) mega_fwd(mk::Args A) {
    using namespace mk;
    extern __shared__ __attribute__((aligned(16))) unsigned char lds_raw[];
    Frame F;
    F.lds = (LAS unsigned char*)lds_raw;
    F.tid = threadIdx.x; asm volatile("" : "+v"(F.tid)); F.lane = F.tid & 63; F.wave = __builtin_amdgcn_readfirstlane(F.tid >> 6);
    F.G = gridDim.x; F.bid = blockIdx.x;
    for (int u = F.tid; u < (LDS_BYTES - LDSCTL_OFF) / 4; u += NTHR) ((LAS unsigned*)(F.lds + LDSCTL_OFF))[u] = 0u;
    __syncthreads();
    gu32* ctl = (gu32*)(kws() + WS_CTL);
    XcdBarrier bar; bar.bar = (unsigned*)(ctl + CW_BAR); bar.x = 0; bar.st = nullptr; bar.tid = F.tid;
    const bool multi = (A.ph_hi - A.ph_lo) > 1;
    if (multi) bar = xcd_barrier_post((unsigned*)(ctl + CW_BAR), (volatile LAS unsigned*)(F.lds + MISC_OFF) + 8, F.tid);

    for (int ph = A.ph_lo, rep = 0; ph < A.ph_hi;) {
        { int t_ = F.tid, l_ = F.lane, w_ = F.wave, g_ = F.G, b_ = F.bid; unsigned p_ = (unsigned)(uintptr_t)F.lds;
          w_ = __builtin_amdgcn_readfirstlane(w_); g_ = __builtin_amdgcn_readfirstlane(g_); b_ = __builtin_amdgcn_readfirstlane(b_); p_ = __builtin_amdgcn_readfirstlane(p_);
          asm volatile("" : "+v"(t_), "+v"(l_)); asm volatile("" : "+s"(w_), "+s"(g_), "+s"(b_), "+s"(p_));
          F.tid = t_; F.lane = l_; F.wave = w_; F.G = g_; F.bid = b_; F.lds = (LAS unsigned char*)(uintptr_t)p_; }
        int kind = 0, l = 0, hf = 0;
        if (ph == 1) kind = 1;
        else if (ph > 1 && ph < 11) { l = 0; const int r = ph - 2; kind = r < 6 ? 2 + r : (r == 6 ? 8 : (r == 7 ? 10 : 11)); }
        else if (ph >= 11) { l = 1; const int r = ph - 11; kind = r < 5 ? 2 + r : (r == 5 ? 8 : 10); }
        const int nrows = (l == 0) ? MALL : MLAT;
        const int r0 = 0, r1 = nrows; (void)hf;
        const bool is_gemm = (kind == 2 || kind == 6 || kind == 8 || kind == 10);
        if (is_gemm) { if (MK_KINDS & 0x544) {
          const int nparts = ((kind == 6 || kind == 10) && l == 0) ? 2 : 1;
          for (int part = 0; part < nparts; ++part) {
            pg8::Gemm g; EpiMulti E; E.tab = (const float*)(kws() + WS_TAB); E.ob = nullptr; E.of = nullptr; E.ld = 0; E.mode = 0; E.cw = nullptr; E.cb = nullptr; E.nrows = 0; E.ldsx = 0u; E.xin = nullptr; E.xout = nullptr; E.xn = nullptr; E.xinb = nullptr; E.xoutb = nullptr; E.gA = E.gaA = E.gB = E.scB = E.shB = nullptr; E.xb0 = E.xb1 = nullptr; E.cnt0 = E.cnt1 = nullptr; E.two = 0;
            if (kind == 2) { g = pg8::Gemm{(const pg8::bf16_t*)(kws() + WS_XN), (const pg8::bf16_t*)(kws() + WS_WIN + l * WIN_BYTES), MALL, INP, D, 256, D, 0}; E.mode = 0; E.ob = (bf16*)(kws() + WS_RP); E.ld = INP; }
            else if (kind == 6 && part == 0 && !(MK_FUSE & 1)) { g = pg8::Gemm{(const pg8::bf16_t*)(kws() + WS_XN), (const pg8::bf16_t*)(kws() + WS_WOUT + l * WOUT_BYTES), MLAT, D, D, 256, D, 0}; E.mode = 2; E.ob = (bf16*)(kws() + WS_RP); E.ld = D; }
            else if (kind == 6 && part == 0) { g = pg8::Gemm{(const pg8::bf16_t*)(kws() + WS_XN), (const pg8::bf16_t*)(kws() + WS_WOUT + l * WOUT_BYTES), MLAT, D, D, 256, D, 0};
                E.mode = 5; E.xin = l == 0 ? kin(I_X) : kout(); E.xinb = nullptr; E.xout = nullptr; E.xoutb = (bf16*)(kws() + WS_XR); E.xn = (bf16*)(kws() + WS_XN); E.gA = normg_vec(A, l, 1); E.gaA = mod_vec(A, l, 0, 2); E.two = 1; E.gB = normg_vec(A, l, 2); E.scB = mod_vec(A, l, 0, 4); E.shB = mod_vec(A, l, 0, 3);
                E.xb0 = (float*)(kws() + WS_XB) + (size_t)((l * 2 + 0) * 2 + 0) * MLAT * 4; E.xb1 = (float*)(kws() + WS_XB) + (size_t)((l * 2 + 0) * 2 + 1) * MLAT * 4;
                E.cnt0 = (gu32*)(kws() + WS_CTL) + CW_PST + ((l * 2 + 0) * 2 + 0) * 4096; E.cnt1 = (gu32*)(kws() + WS_CTL) + CW_PST + ((l * 2 + 0) * 2 + 1) * 4096; }
            else if (kind == 6) { g = pg8::Gemm{(const pg8::bf16_t*)(kws() + WS_XN) + (size_t)MLAT * D, (const pg8::bf16_t*)(kws() + WS_WOUT + l * WOUT_BYTES), 256 * 4 * 4, D, 256, 256, D, 4}; E.mode = 2; E.ob = (bf16*)(kws() + WS_SLO); E.ld = D; }
            else if (kind == 8) { const int nmu = (nrows + 253) / 254;
                g = pg8::Gemm{(const pg8::bf16_t*)(kws() + WS_XN) - D, (const pg8::bf16_t*)(kws() + WS_WGU + l * WGU_BYTES), 256 * nmu, NGU, D, 254, D, 0};
                E.mode = 3; E.ob = (bf16*)(kws() + WS_ACT); E.ld = DFF; E.cw = kin(I_FFCW) + (size_t)l * 3 * DFF; E.cb = kin(I_FFCB) + (size_t)l * DFF; E.nrows = nrows; E.ldsx = (unsigned)(uintptr_t)F.lds + 131072u; }
            else if (part == 0 && !(MK_FUSE & 2)) { g = pg8::Gemm{(const pg8::bf16_t*)(kws() + WS_ACT), (const pg8::bf16_t*)(kws() + WS_WD + l * WD_BYTES), MLAT, D, DFF, 256, DFF, 0}; E.mode = 2; E.ob = (bf16*)(kws() + WS_FP); E.ld = D; }
            else if (part == 0) { g = pg8::Gemm{(const pg8::bf16_t*)(kws() + WS_ACT), (const pg8::bf16_t*)(kws() + WS_WD + l * WD_BYTES), MLAT, D, DFF, 256, DFF, 0};
                E.mode = 6; E.xin = nullptr; E.xinb = (const bf16*)(kws() + WS_XR); E.xout = kout(); E.xoutb = nullptr; E.xn = (bf16*)(kws() + WS_XN); E.gA = normg_vec(A, l, 3); E.gaA = mod_vec(A, l, 0, 5); E.two = l == 0; E.gB = normg_vec(A, 1, 0); E.scB = mod_vec(A, 1, 0, 1); E.shB = mod_vec(A, 1, 0, 0);
                E.xb0 = (float*)(kws() + WS_XB) + (size_t)((l * 2 + 1) * 2 + 0) * MLAT * 4; E.xb1 = (float*)(kws() + WS_XB) + (size_t)((l * 2 + 1) * 2 + 1) * MLAT * 4;
                E.cnt0 = (gu32*)(kws() + WS_CTL) + CW_PST + ((l * 2 + 1) * 2 + 0) * 4096; E.cnt1 = (gu32*)(kws() + WS_CTL) + CW_PST + ((l * 2 + 1) * 2 + 1) * 4096; }
            else { g = pg8::Gemm{(const pg8::bf16_t*)(kws() + WS_ACT) + (size_t)MLAT * DFF, (const pg8::bf16_t*)(kws() + WS_WD + l * WD_BYTES), 256 * 4 * 11, D, 256, 256, DFF, 4}; E.mode = 2; E.ob = (bf16*)(kws() + WS_SLD); E.ld = D; }
            pg8::StaticOrder S; S.init(g.M, g.N, F.G, F.bid);
            pg8::gemm_phase<EpiMulti, pg8::StaticOrder, true, true>(F.lds, g, S, E, F.tid);
          }
        } } else {
            switch (kind) {
                case 0: if ((MK_KINDS >> 0) & 1) { p0_prologue(A, F); } break;
                case 1: if (((MK_KINDS >> 1) & 1) && l == 0) phase_prep(A, F); break;
                case 3: if ((MK_KINDS >> 3) & 1) rwkv_features(A, F, l); break;
                case 4: if ((MK_KINDS >> 4) & 1) phase_queue(A, F, l, rep); break;
                case 5: if ((MK_KINDS >> 5) & 1) rwkv_readout(A, F, l); break;
                case 7: if ((MK_KINDS >> 7) & 1) phase_e1(A, F, l); break;
                case 9: if ((MK_KINDS >> 9) & 1) phase_act(A, F, l, r0, r1); break;
                case 11: if ((MK_KINDS >> 11) & 1) phase_e2(A, F, l, r0, r1); break;
                default: break;
            }
        }
        const bool again = (rep == 0) && ((MK_REPEAT >> kind) & 1);
        if (ph + 1 < A.ph_hi || again) { bar.bar = (unsigned*)((gu32*)(kws() + WS_CTL) + CW_BAR); bar.tid = F.tid; xcd_barrier(bar); }
        if (again) rep = 1; else { rep = 0; ++ph; }
    }
}

extern "C" void kernel_launch(void* const* d_in, const int* in_sizes, int n_in, void* d_out, int out_size, void* d_ws, size_t ws_size, hipStream_t stream) {
    using namespace mk;
    static int grid = 0;
    if (grid == 0) {
        if (n_in != N_IN || out_size != MLAT * D || ws_size < WS_END) { fprintf(stderr, "kernel_launch: unexpected shapes (n_in %d, out %d, ws %zu); nothing launched\n", n_in, out_size, ws_size); grid = -1; return; }
        int dev = 0, cus = 0, per_cu = 0;
        if (hipGetDevice(&dev) != hipSuccess || hipDeviceGetAttribute(&cus, hipDeviceAttributeMultiprocessorCount, dev) != hipSuccess) { grid = -1; return; }
        if (hipFuncSetAttribute((const void*)mega_fwd, hipFuncAttributeMaxDynamicSharedMemorySize, LDS_BYTES) != hipSuccess) { fprintf(stderr, "kernel_launch: hipFuncSetAttribute failed\n"); grid = -1; return; }
        if (hipOccupancyMaxActiveBlocksPerMultiprocessor(&per_cu, (const void*)mega_fwd, NTHR, LDS_BYTES) != hipSuccess || per_cu < 1) { fprintf(stderr, "kernel_launch: occupancy query says %d blocks/CU\n", per_cu); per_cu = 1; }
        (void)hipGetLastError();
        grid = cus;
    }
    if (grid < 0) return;
    (void)hipMemsetAsync((char*)d_ws + WS_CTL, 0, CTL_ZERO_BYTES, stream);
    Args a{};
    for (int i = 0; i < N_IN; ++i) a.in[i] = (const float*)d_in[i];
    a.out = (float*)d_out; a.ws = (unsigned char*)d_ws;
#if MK_PER_PHASE
    for (int ph = 0; ph < N_PHASES; ++ph) { a.ph_lo = ph; a.ph_hi = ph + 1; hipLaunchKernelGGL(mega_fwd, dim3(grid), dim3(NTHR), LDS_BYTES, stream, a); }
#else
    a.ph_lo = 0; a.ph_hi = N_PHASES;
    void* args[] = {&a};
    hipError_t e = hipLaunchCooperativeKernel((const void*)mega_fwd, dim3(grid), dim3(NTHR), args, LDS_BYTES, stream);
    if (e != hipSuccess) fprintf(stderr, "kernel_launch: cooperative launch failed: %s (grid %d)\n", hipGetErrorString(e), grid);
#endif
}
```
